# Optimizing an MI355X kernel written in HIP

```python
import math
import jax, jax.numpy as jnp
from jax import lax
import numpy as np

D_MODEL = 1024
BATCH = 4
SEQ = 8192
DEPTH = 1

CHUNK = 64
D_MIX = D_MODEL
ATTN_HEADS = 8
ATTN_KV_HEADS = 2
HEAD_DIM = 64
ATTN_GROUP = ATTN_HEADS // ATTN_KV_HEADS
WINDOW = 128
WIN_CHUNKS = WINDOW // CHUNK
BAND = (WIN_CHUNKS + 1) * CHUNK
D_ATTN = ATTN_HEADS * HEAD_DIM
D_KV = ATTN_KV_HEADS * HEAD_DIM
POOL_WINDOWS = (2, 4, 8, 16)
POOL_GROUPS = len(POOL_WINDOWS)
D_POOL = D_MIX - D_ATTN
POOL_GROUP_DIM = D_POOL // POOL_GROUPS
D_IN = D_ATTN + 2 * D_KV + D_POOL
REL_BUCKETS = 32
REL_MAX_DIST = 128
PEER_KEYS = 128
PEER_EXPERTS = PEER_KEYS * PEER_KEYS
PEER_HEADS = 8
PEER_TOPK = 16
PEER_QDIM = 256
PEER_HALF = PEER_QDIM // 2
PEER_TOKEN_BLOCK = 128
EPS = 1e-6
NEG_INF = -1e30

kernel_name = "hybrid_swa_pool_peer_block"


def rms_norm(x, g):
    xf = x.astype(jnp.float32)
    y = xf * lax.rsqrt(jnp.mean(xf * xf, axis=-1, keepdims=True) + EPS)
    return (y * g.astype(jnp.float32)).astype(x.dtype)


def t5_bucket(rel):
    nb = REL_BUCKETS // 2
    max_exact = nb // 2
    base = jnp.where(rel > 0, nb, 0)
    n = jnp.abs(rel)
    nf = jnp.maximum(n, 1).astype(jnp.float32)
    large = max_exact + (jnp.log(nf / max_exact) / math.log(REL_MAX_DIST / max_exact)
                         * (nb - max_exact)).astype(jnp.int32)
    large = jnp.minimum(large, nb - 1)
    return base + jnp.where(n < max_exact, n, large)


def band_bias(rel_bias):
    i = jnp.arange(CHUNK)[:, None]
    j = jnp.arange(BAND)[None, :]
    rel = (j - WIN_CHUNKS * CHUNK) - i
    b = jnp.take(rel_bias, t5_bucket(rel), axis=0)
    b = jnp.transpose(b, (2, 0, 1)).astype(jnp.float32)
    return b.reshape(ATTN_KV_HEADS, ATTN_GROUP, CHUNK, BAND)


def to_band(t, n_chunks):
    pad = [(0, 0), (WIN_CHUNKS, 0)] + [(0, 0)] * (t.ndim - 2)
    tp = jnp.pad(t, pad)
    return jnp.concatenate([tp[:, i:i + n_chunks] for i in range(WIN_CHUNKS + 1)], axis=2)


def swa_attention(q, k, v, q_norm_g, k_norm_g, sinks, rel_bias):
    B, S, _ = q.shape
    nc = S // CHUNK
    q = rms_norm(q.reshape(B, S, ATTN_HEADS, HEAD_DIM), q_norm_g)
    k = rms_norm(k.reshape(B, S, ATTN_KV_HEADS, HEAD_DIM), k_norm_g)
    v = v.reshape(B, S, ATTN_KV_HEADS, HEAD_DIM)
    qc = q.reshape(B, nc, CHUNK, ATTN_KV_HEADS, ATTN_GROUP, HEAD_DIM)
    kb = to_band(k.reshape(B, nc, CHUNK, ATTN_KV_HEADS, HEAD_DIM), nc)
    vb = to_band(v.reshape(B, nc, CHUNK, ATTN_KV_HEADS, HEAD_DIM), nc)
    s = jnp.einsum('bcqhgd,bckhd->bchgqk', qc, kb,
                   preferred_element_type=jnp.float32) * (HEAD_DIM ** -0.5)
    s = s + band_bias(rel_bias)[None, None]
    key_chunk = jnp.arange(nc)[:, None] - WIN_CHUNKS + jnp.arange(BAND)[None, :] // CHUNK
    valid = (key_chunk >= 0)[None, :, None, None, None, :]
    s = jnp.where(valid, s, NEG_INF)
    sink = sinks.astype(jnp.float32).reshape(1, 1, ATTN_KV_HEADS, ATTN_GROUP, 1, 1)
    m = jnp.maximum(jnp.max(s, axis=-1, keepdims=True), sink)
    p = jnp.exp(s - m)
    p = p / (jnp.sum(p, axis=-1, keepdims=True) + jnp.exp(sink - m))
    o = jnp.einsum('bchgqk,bckhd->bcqhgd', p.astype(vb.dtype), vb)
    return o.reshape(B, S, D_ATTN)


def causal_mean(xg, w):
    S = xg.shape[1]
    cs = jnp.pad(jnp.cumsum(xg, axis=1), ((0, 0), (1, 0), (0, 0)))
    t = jnp.arange(S)
    lo = jnp.maximum(t + 1 - w, 0)
    total = cs[:, 1:] - jnp.take(cs, lo, axis=1)
    cnt = jnp.minimum(t + 1, w).astype(jnp.float32)
    return total / cnt[None, :, None]


def pool_mixer(p, pool_w, pool_scale):
    B, S, _ = p.shape
    pf = p.astype(jnp.float32).reshape(B, S, POOL_GROUPS, POOL_GROUP_DIM)
    pooled = jnp.stack([causal_mean(pf[:, :, g], w) for g, w in enumerate(POOL_WINDOWS)], axis=2)
    d = (pooled - pf).astype(p.dtype)
    o = jnp.einsum('bsgc,gcd->bsgd', d, pool_w)
    o = o * pool_scale.reshape(POOL_GROUPS, POOL_GROUP_DIM)
    return o.reshape(B, S, D_POOL)


def peer(h, wq, subkeys, u_tab, v_tab):
    B, S, D = h.shape
    T = B * S
    ht = h.reshape(T, D)
    q = (ht @ wq).reshape(T, PEER_HEADS, 2, PEER_HALF)
    sc = jnp.einsum('thpd,hpnd->thpn', q, subkeys, preferred_element_type=jnp.float32)
    v1, i1 = lax.top_k(sc[:, :, 0], PEER_TOPK)
    v2, i2 = lax.top_k(sc[:, :, 1], PEER_TOPK)
    cand = (v1[..., :, None] + v2[..., None, :]).reshape(T, PEER_HEADS, PEER_TOPK * PEER_TOPK)
    best, pos = lax.top_k(cand, PEER_TOPK)
    e1 = jnp.take_along_axis(i1, pos // PEER_TOPK, axis=-1)
    e2 = jnp.take_along_axis(i2, pos % PEER_TOPK, axis=-1)
    experts = (e1 * PEER_KEYS + e2).reshape(T, PEER_HEADS * PEER_TOPK)
    gates = jax.nn.softmax(best, axis=-1).reshape(T, PEER_HEADS * PEER_TOPK).astype(h.dtype)

    def block(args):
        xb, eb, gb = args
        u = jnp.take(u_tab, eb, axis=0)
        vv = jnp.take(v_tab, eb, axis=0)
        act = jax.nn.gelu(jnp.einsum('tkd,td->tk', u, xb), approximate=False)
        return jnp.einsum('tk,tkd->td', gb * act, vv)

    nb = T // PEER_TOKEN_BLOCK
    out = lax.map(block, (ht.reshape(nb, PEER_TOKEN_BLOCK, D),
                          experts.reshape(nb, PEER_TOKEN_BLOCK, -1),
                          gates.reshape(nb, PEER_TOKEN_BLOCK, -1)))
    return out.reshape(B, S, D)


def setup_inputs(seed: int = 0) -> dict:
    key = jax.random.key(seed)
    ks = jax.random.split(key, 15)
    n = jax.random.normal
    L = DEPTH
    return {
        "x": n(ks[0], (BATCH, SEQ, D_MODEL), jnp.float32),
        "norm1_g": 1.0 + 0.02 * n(ks[1], (L, D_MODEL), jnp.float32),
        "w_in": n(ks[2], (L, D_MODEL, D_IN), jnp.float32) * D_MODEL ** -0.5,
        "q_norm_g": 1.0 + 0.02 * n(ks[3], (L, HEAD_DIM), jnp.float32),
        "k_norm_g": 1.0 + 0.02 * n(ks[4], (L, HEAD_DIM), jnp.float32),
        "attn_sinks": 0.5 * n(ks[5], (L, ATTN_HEADS), jnp.float32),
        "rel_bias": 0.5 * n(ks[6], (REL_BUCKETS, ATTN_HEADS), jnp.float32),
        "pool_w": n(ks[7], (L, POOL_GROUPS, POOL_GROUP_DIM, POOL_GROUP_DIM), jnp.float32) * POOL_GROUP_DIM ** -0.5,
        "pool_scale": 1.0 + 0.02 * n(ks[8], (L, D_POOL), jnp.float32),
        "w_out": n(ks[9], (L, D_MIX, D_MODEL), jnp.float32) * D_MIX ** -0.5,
        "norm2_g": 1.0 + 0.02 * n(ks[10], (L, D_MODEL), jnp.float32),
        "peer_wq": n(ks[11], (L, D_MODEL, PEER_HEADS * PEER_QDIM), jnp.float32) * D_MODEL ** -0.5,
        "peer_subkeys": n(ks[12], (L, PEER_HEADS, 2, PEER_KEYS, PEER_HALF), jnp.float32) * PEER_HALF ** -0.5,
        "peer_u": n(ks[13], (L, PEER_EXPERTS, D_MODEL), jnp.float32) * D_MODEL ** -0.5,
        "peer_v": n(ks[14], (L, PEER_EXPERTS, D_MODEL), jnp.float32) * (PEER_HEADS * PEER_TOPK) ** -0.5,
    }


def reference(x, norm1_g, w_in, q_norm_g, k_norm_g, attn_sinks, rel_bias, pool_w, pool_scale,
              w_out, norm2_g, peer_wq, peer_subkeys, peer_u, peer_v):
    for l in range(DEPTH):
        h = rms_norm(x, norm1_g[l])
        y = h @ w_in[l]
        q = y[..., :D_ATTN]
        k = y[..., D_ATTN:D_ATTN + D_KV]
        v = y[..., D_ATTN + D_KV:D_ATTN + 2 * D_KV]
        p = y[..., D_ATTN + 2 * D_KV:]
        a = swa_attention(q, k, v, q_norm_g[l], k_norm_g[l], attn_sinks[l], rel_bias)
        b = pool_mixer(p, pool_w[l], pool_scale[l])
        x = x + jnp.concatenate([a, b], axis=-1) @ w_out[l]
        h2 = rms_norm(x, norm2_g[l])
        x = x + peer(h2, peer_wq[l], peer_subkeys[l], peer_u[l], peer_v[l])
    return x
```

```cpp
#include <hip/hip_runtime.h>
#include <cstdio>
#include <cstdint>
namespace pg8 {
#define PG8_LAS __attribute__((address_space(3)))
typedef unsigned short bf16_t;
typedef short bf16x8 __attribute__((ext_vector_type(8)));
typedef float f32x4 __attribute__((ext_vector_type(4)));
typedef unsigned u32x4 __attribute__((ext_vector_type(4)));
constexpr int BM = 256, BK = 64, HALF = 128, HTB = HALF * BK * 2  , STAGE_BYTES = 8 * HTB, NXCD = 8, WGM = 8;

__host__ __device__ __forceinline__ int lds_byte(int r, int c) { const int st = (r >> 4) * 2 + (c >> 5), rr = r & 15, cc = c & 31, ob = rr * 64 + cc * 2; return st * 1024 + (ob ^ (((ob >> 9) & 1) << 5)); }
__host__ __device__ __forceinline__ void stage_rc(int b, int& R, int& C) { const int st = b / 1024, sb = b % 1024, swz = sb ^ (((sb >> 9) & 1) << 5); R = (st >> 1) * 16 + swz / 64; C = (st & 1) * 32 + (swz % 64) / 2; }
__host__ __device__ __forceinline__ int perm32(int rho) { const int n = rho >> 4, i = rho & 15; return 8 * (i >> 2) + 4 * n + (i & 3); }

struct Unit { int pm, pn; };
struct Gemm { const bf16_t* A; const bf16_t* Bt; int M, N, K; };

struct StaticOrder {
    int nM, nN, nwg, G, c;
    __host__ __device__ void init(int M, int N, int G_, int c_) { nM = M / BM; nN = N / BM; nwg = nM * nN; G = G_; c = c_; }
    __host__ __device__ bool next(int i, Unit& u) const {
        const long L = (long)i * G + c; if (L >= nwg) return false;
        int wgid = (int)L; { const int q = nwg / NXCD, r = nwg % NXCD, xcd = wgid % NXCD, off = wgid / NXCD; wgid = (xcd < r ? xcd * (q + 1) : r * (q + 1) + (xcd - r) * q) + off; }
        const int nig = WGM * nN, gid = wgid / nig, fm = gid * WGM, gsz = (nM - fm) < WGM ? (nM - fm) : WGM;
        u.pm = fm + ((wgid % nig) % gsz); u.pn = (wgid % nig) / gsz; return true;
    }
    __device__ __forceinline__ void a_ready(const Unit&) const {}
    __device__ __forceinline__ void done(const Unit&) const {}
};

__device__ __forceinline__ unsigned cvt_pk_bf16(float lo, float hi) { unsigned r; asm volatile("v_cvt_pk_bf16_f32 %0, %1, %2" : "=v"(r) : "v"(lo), "v"(hi)); return r; }
struct EpiScaleBf16 {
    static constexpr bool PERM = true, AFTER_DRAIN = false;
    bf16_t* O; int ldc; const float* rs;
    __device__ __forceinline__ void operator()(const f32x4 (&acc)[2][2][4][2], const Unit& u, int wr, int wc, int fr, int fq) const {
        const int row0 = u.pm * BM + wr * 64 + fr, col0 = u.pn * BM + wc * 32 + 8 * fq;
#pragma unroll
        for (int ai = 0; ai < 2; ++ai)
#pragma unroll
            for (int m = 0; m < 4; ++m) { const int row = row0 + ai * HALF + m * 16; const float s = rs ? rs[row] : 1.f; bf16_t* rowp = O + (size_t)row * ldc + col0;
#pragma unroll
                for (int bj = 0; bj < 2; ++bj) { const f32x4 v0 = acc[ai][bj][m][0] * s, v1 = acc[ai][bj][m][1] * s;
                    u32x4 w; w.x = cvt_pk_bf16(v0[0], v0[1]); w.y = cvt_pk_bf16(v0[2], v0[3]); w.z = cvt_pk_bf16(v1[0], v1[1]); w.w = cvt_pk_bf16(v1[2], v1[3]);
                    *(u32x4*)(rowp + bj * HALF) = w; } }
    }
};
struct EpiResid {
    static constexpr bool PERM = true, AFTER_DRAIN = false;
    const float* base; float* out; bf16_t* xb; float* ss; int ldc;
    __device__ __forceinline__ void operator()(const f32x4 (&acc)[2][2][4][2], const Unit& u, int wr, int wc, int fr, int fq) const {
        const int row0 = u.pm * BM + wr * 64 + fr, col0 = u.pn * BM + wc * 32 + 8 * fq;
#pragma unroll
        for (int ai = 0; ai < 2; ++ai)
#pragma unroll
            for (int m = 0; m < 4; ++m) { const int row = row0 + ai * HALF + m * 16; const size_t off = (size_t)row * ldc + col0; float q = 0.f;
#pragma unroll
                for (int bj = 0; bj < 2; ++bj) { const f32x4 xa = *(const f32x4*)(base + off + bj * HALF), xc = *(const f32x4*)(base + off + bj * HALF + 4);
                    const f32x4 v0 = acc[ai][bj][m][0] + xa, v1 = acc[ai][bj][m][1] + xc;
                    *(f32x4*)(out + off + bj * HALF) = v0; *(f32x4*)(out + off + bj * HALF + 4) = v1;
                    u32x4 w; w.x = cvt_pk_bf16(v0[0], v0[1]); w.y = cvt_pk_bf16(v0[2], v0[3]); w.z = cvt_pk_bf16(v1[0], v1[1]); w.w = cvt_pk_bf16(v1[2], v1[3]);
                    *(u32x4*)(xb + off + bj * HALF) = w;
                    q += (v0[0] * v0[0] + v0[1] * v0[1]) + (v0[2] * v0[2] + v0[3] * v0[3]) + (v1[0] * v1[0] + v1[1] * v1[1]) + (v1[2] * v1[2] + v1[3] * v1[3]); }
                q += __shfl_xor(q, 16); q += __shfl_xor(q, 32);
                if (fq == 0) ss[(size_t)row * 16 + u.pn * 4 + wc] = q; }
    }
};
template <class Epi, class Sched, bool ALIGN_EPI = false, bool SP2 = false>
__device__ __forceinline__ void gemm_phase(PG8_LAS unsigned char* lds, const Gemm g, const Sched& S, const Epi& E) {
    const int tid = threadIdx.x, wid = __builtin_amdgcn_readfirstlane(tid >> 6), lane = tid & 63, wr = wid >> 2, wc = wid & 3, fr = lane & 15, fq = lane >> 4;
    const int K = g.K, nt = K / BK;
    unsigned voffA[2], voffB[2];
#pragma unroll
    for (int i = 0; i < 2; ++i) { int R, C; stage_rc(tid * 16 + i * 8192, R, C); const int Rb = Epi::PERM ? ((R & ~31) + perm32(R & 31)) : R;
        voffA[i] = (unsigned)(R * K + C) * 2u; voffB[i] = (unsigned)(Rb * K + C) * 2u; }
    const size_t kstep = (size_t)(BK * 2);
    const size_t hstep = (size_t)HALF * K * 2;
    const size_t tstep = 2 * hstep;
    const unsigned ldsw = (unsigned)wid * 1024u;
    const int aoff = lds_byte(wr * 64 + fr, fq * 8), boff = lds_byte(wc * 32 + fr, fq * 8);
#define PG8_SA(b, h) (((b) * 2 + (h)) * HTB)
#define PG8_SB(b, h) ((4 + (b) * 2 + (h)) * HTB)
#define PG8_STAGE(bufoff, gbase, voff) do { _Pragma("unroll") for (int _i = 0; _i < 2; ++_i) \
        __builtin_amdgcn_global_load_lds((const unsigned*)((const char*)(gbase) + (voff)[_i]), (PG8_LAS unsigned*)(lds + (bufoff) + ldsw + _i * 8192), 16, 0, 0); } while (0)
#define PG8_LDA(dst, b, h) do { _Pragma("unroll") for (int m = 0; m < 4; ++m) _Pragma("unroll") for (int k = 0; k < 2; ++k) dst[m][k] = *(const PG8_LAS bf16x8*)(lds + PG8_SA(b, h) + aoff + m * 2048 + k * 1024); } while (0)
#define PG8_LDB(dst, b, h) do { _Pragma("unroll") for (int n = 0; n < 2; ++n) _Pragma("unroll") for (int k = 0; k < 2; ++k) dst[n][k] = *(const PG8_LAS bf16x8*)(lds + PG8_SB(b, h) + boff + n * 2048 + k * 1024); } while (0)
#define PG8_MMA(ai, bj, At, Bt) do { __builtin_amdgcn_s_setprio(1); _Pragma("unroll") for (int m = 0; m < 4; ++m) _Pragma("unroll") for (int n = 0; n < 2; ++n) _Pragma("unroll") for (int k = 0; k < 2; ++k) \
        acc[ai][bj][m][n] = __builtin_amdgcn_mfma_f32_16x16x32_bf16(Bt[n][k], At[m][k], acc[ai][bj][m][n], 0, 0, 0); __builtin_amdgcn_s_setprio(0); } while (0)
#define PG8_WAIT_V(n) asm volatile("s_waitcnt vmcnt(" #n ")" ::: "memory")
#define PG8_WAIT_L(n) asm volatile("s_waitcnt lgkmcnt(" #n ")" ::: "memory")
#define PG8_BAR __builtin_amdgcn_s_barrier()
#define PG8_SCHED __builtin_amdgcn_sched_barrier(0)
    Unit cur, nxt; int ui = 0;
    if (!S.next(0, cur)) return;
    f32x4 acc[2][2][4][2];
#pragma unroll
    for (int a = 0; a < 2; ++a)
#pragma unroll
        for (int b = 0; b < 2; ++b)
#pragma unroll
            for (int m = 0; m < 4; ++m)
#pragma unroll
                for (int n = 0; n < 2; ++n) acc[a][b][m][n] = (f32x4){0.f, 0.f, 0.f, 0.f};
    bf16x8 At[4][2], B0[2][2], B1[2][2];
    const char* cA = (const char*)g.A + (size_t)cur.pm * tstep; const char* cB = (const char*)g.Bt + (size_t)cur.pn * tstep;
    S.a_ready(cur);
    if constexpr (SP2) {
        PG8_STAGE(PG8_SB(0, 0), cB, voffB); PG8_STAGE(PG8_SB(0, 1), cB + hstep, voffB); PG8_STAGE(PG8_SA(0, 0), cA, voffA); PG8_STAGE(PG8_SA(0, 1), cA + hstep, voffA);
        if (wr == 1) PG8_BAR;
        PG8_WAIT_V(2); PG8_BAR;
        PG8_STAGE(PG8_SB(1, 0), cB + kstep, voffB); PG8_STAGE(PG8_SA(1, 0), cA + kstep, voffA); PG8_STAGE(PG8_SB(1, 1), cB + hstep + kstep, voffB);
        PG8_WAIT_V(6); PG8_BAR;
    } else {
        PG8_STAGE(PG8_SB(0, 0), cB, voffB); PG8_STAGE(PG8_SA(0, 0), cA, voffA); PG8_STAGE(PG8_SB(0, 1), cB + hstep, voffB); PG8_STAGE(PG8_SA(0, 1), cA + hstep, voffA);
        if (wr == 1) PG8_BAR;
        PG8_WAIT_V(4); PG8_BAR;
        PG8_STAGE(PG8_SB(1, 0), cB + kstep, voffB); PG8_STAGE(PG8_SA(1, 0), cA + kstep, voffA); PG8_STAGE(PG8_SB(1, 1), cB + hstep + kstep, voffB);
        PG8_WAIT_V(6); PG8_BAR;
    }
    for (;;) {
        const bool has_next = S.next(ui + 1, nxt);
        const char* nA = has_next ? (const char*)g.A + (size_t)nxt.pm * tstep : cA; const char* nB = has_next ? (const char*)g.Bt + (size_t)nxt.pn * tstep : cB;
        for (int t = 0; t < nt; t += 2) {
            const bool last = (t == nt - 2);
            const char* a1 = cA + (size_t)(t + 1) * kstep;
            const char* a2 = last ? nA : cA + (size_t)(t + 2) * kstep; const char* b2 = last ? nB : cB + (size_t)(t + 2) * kstep;
            const char* a3 = a2 + kstep; const char* b3 = b2 + kstep;
            if (last && has_next) S.a_ready(nxt);
            if constexpr (SP2) {
            PG8_LDB(B0, 0, 0); PG8_LDB(B1, 0, 1); PG8_SCHED; PG8_LDA(At, 0, 0); PG8_STAGE(PG8_SA(1, 1), a1 + hstep, voffA);
            PG8_WAIT_V(8); PG8_WAIT_L(0); PG8_BAR; PG8_MMA(0, 0, At, B0); PG8_MMA(0, 1, At, B1); PG8_BAR; PG8_SCHED;
            PG8_LDA(At, 0, 1); PG8_STAGE(PG8_SB(0, 0), b2, voffB); PG8_STAGE(PG8_SB(0, 1), b2 + hstep, voffB); PG8_STAGE(PG8_SA(0, 0), a2, voffA);
            PG8_WAIT_V(8); PG8_WAIT_L(0); PG8_BAR; PG8_MMA(1, 0, At, B0); PG8_MMA(1, 1, At, B1); PG8_BAR; PG8_SCHED;
            PG8_LDB(B0, 1, 0); PG8_LDB(B1, 1, 1); PG8_SCHED; PG8_LDA(At, 1, 0); PG8_STAGE(PG8_SA(0, 1), a2 + hstep, voffA);
            PG8_WAIT_V(8); PG8_WAIT_L(0); PG8_BAR; PG8_MMA(0, 0, At, B0); PG8_MMA(0, 1, At, B1); PG8_BAR; PG8_SCHED;
            PG8_LDA(At, 1, 1); PG8_STAGE(PG8_SB(1, 0), b3, voffB); PG8_STAGE(PG8_SB(1, 1), b3 + hstep, voffB); PG8_STAGE(PG8_SA(1, 0), a3, voffA);
            PG8_WAIT_V(8); PG8_WAIT_L(0); PG8_BAR; PG8_MMA(1, 0, At, B0); PG8_MMA(1, 1, At, B1); PG8_BAR; PG8_SCHED;
            } else {
            PG8_LDB(B0, 0, 0); PG8_SCHED; PG8_LDA(At, 0, 0); PG8_STAGE(PG8_SA(1, 1), a1 + hstep, voffA);
            PG8_WAIT_L(8); PG8_BAR; PG8_WAIT_L(0); PG8_MMA(0, 0, At, B0); PG8_BAR; PG8_SCHED;
            PG8_LDB(B1, 0, 1); PG8_STAGE(PG8_SB(0, 0), b2, voffB);
            PG8_BAR; PG8_WAIT_L(0); PG8_MMA(0, 1, At, B1); PG8_BAR;
            PG8_LDA(At, 0, 1); PG8_STAGE(PG8_SA(0, 0), a2, voffA);
            PG8_BAR; PG8_WAIT_L(0); PG8_MMA(1, 0, At, B0); PG8_BAR; PG8_SCHED;
            PG8_STAGE(PG8_SB(0, 1), b2 + hstep, voffB);
            PG8_WAIT_V(6); PG8_BAR; PG8_MMA(1, 1, At, B1); PG8_BAR;
            PG8_LDB(B0, 1, 0); PG8_SCHED; PG8_LDA(At, 1, 0); PG8_STAGE(PG8_SA(0, 1), a2 + hstep, voffA);
            PG8_WAIT_L(8); PG8_BAR; PG8_WAIT_L(0); PG8_MMA(0, 0, At, B0); PG8_BAR; PG8_SCHED;
            PG8_LDB(B1, 1, 1); PG8_STAGE(PG8_SB(1, 0), b3, voffB);
            PG8_BAR; PG8_WAIT_L(0); PG8_MMA(0, 1, At, B1); PG8_BAR;
            PG8_LDA(At, 1, 1); PG8_STAGE(PG8_SA(1, 0), a3, voffA);
            PG8_BAR; PG8_WAIT_L(0); PG8_MMA(1, 0, At, B0); PG8_BAR; PG8_SCHED;
            PG8_STAGE(PG8_SB(1, 1), b3 + hstep, voffB);
            PG8_WAIT_V(6); PG8_BAR; PG8_MMA(1, 1, At, B1); PG8_BAR;
            }
        }
        if constexpr (ALIGN_EPI) { if (wr == 0) PG8_BAR; }
        if constexpr (!Epi::AFTER_DRAIN) { E(acc, cur, wr, wc, fr, fq); S.done(cur); }
        if (!has_next) break;
#pragma unroll
        for (int a = 0; a < 2; ++a)
#pragma unroll
            for (int b = 0; b < 2; ++b)
#pragma unroll
                for (int m = 0; m < 4; ++m)
#pragma unroll
                    for (int n = 0; n < 2; ++n) acc[a][b][m][n] = (f32x4){0.f, 0.f, 0.f, 0.f};
        cur = nxt; cA = nA; cB = nB; ++ui;
        if constexpr (ALIGN_EPI) { if (wr == 1) PG8_BAR; }
    }
    PG8_WAIT_V(0);
    if constexpr (!ALIGN_EPI) { if (wr == 0) PG8_BAR; }
    PG8_BAR;
    if constexpr (Epi::AFTER_DRAIN) { E.fused(acc, cur, wr, wc, fr, fq, lds, wid, lane); S.done(cur); }
#undef PG8_SA
#undef PG8_SB
#undef PG8_STAGE
#undef PG8_LDA
#undef PG8_LDB
#undef PG8_MMA
#undef PG8_WAIT_V
#undef PG8_WAIT_L
#undef PG8_BAR
#undef PG8_SCHED
}
}
constexpr int NWAVES = 8;
#ifndef MK_N_LAUNCHES
#define MK_N_LAUNCHES 7
#endif
constexpr int PER_PHASE = 7;
constexpr int N_LAUNCHES = MK_N_LAUNCHES;

constexpr int NB = 4, SEQ = 8192, T = NB * SEQ, D = 1024, DIN = 1280, NEXP = 16384, DQ = 2048;
constexpr float EPS = 1e-6f;

constexpr size_t MiB = 1u << 20;
constexpr size_t WS_CTL = 0, CTL_ZERO_BYTES = 1 * MiB;
constexpr size_t WS_WIN = 2 * MiB;
constexpr size_t WS_WOUT = 5 * MiB;
constexpr size_t WS_WQ = 7 * MiB;
constexpr size_t WS_SK = 11 * MiB;
constexpr size_t WS_POOLT = 11 * MiB + 512 * 1024;
constexpr size_t WS_RSTD1 = 12 * MiB;
constexpr size_t WS_SS2 = 13 * MiB;
constexpr size_t WS_EXP = 16 * MiB;
constexpr size_t WS_BEST = 32 * MiB;
constexpr size_t WS_UB = 48 * MiB;
constexpr size_t WS_VB = 80 * MiB;
constexpr size_t WS_AB = 112 * MiB;
constexpr size_t WS_X1B = 176 * MiB;
constexpr size_t WS_XB = 240 * MiB;
constexpr size_t WS_Y = 304 * MiB;
constexpr size_t WS_QP = 240 * MiB;
constexpr size_t WS_END = 384 * MiB;
constexpr int CW_BAR = 4096;

constexpr int RING_OFF = 0, RING_BYTES = 131072;
constexpr int LDSCTL_OFF = RING_BYTES, MISC_OFF = LDSCTL_OFF + 320;
constexpr int LDS_BYTES = 147456;
#define GAS __attribute__((address_space(1)))
#define LAS __attribute__((address_space(3)))
typedef unsigned short bf16;
typedef unsigned v4u __attribute__((ext_vector_type(4)));
typedef float f32x4 __attribute__((ext_vector_type(4)));
typedef short bf16x8 __attribute__((ext_vector_type(8)));
typedef GAS unsigned gu32;
typedef GAS unsigned long long gu64;
#define RLX_AGENT __ATOMIC_RELAXED, __HIP_MEMORY_SCOPE_AGENT
#define LDS_WAIT() asm volatile("s_waitcnt lgkmcnt(0)" ::: "memory")
#define VM_WAIT() asm volatile("s_waitcnt vmcnt(0)" ::: "memory")
__device__ __forceinline__ unsigned long long rt() { return __builtin_amdgcn_s_memrealtime(); }
__device__ __forceinline__ unsigned f2bf(float f) { unsigned u = __builtin_bit_cast(unsigned, f); return (u + 0x7fffu + ((u >> 16) & 1u)) >> 16; }
__device__ __forceinline__ unsigned pk2(float lo, float hi) { return f2bf(lo) | (f2bf(hi) << 16); }
#define XB_TMO      128
#define XB_XCNT(j)  (256  + 64 * (j))
#define XB_XSUB(j)  (1280 + 64 * (j))
#define XB_XGEN(j)  (2304 + 64 * (j))
#define XB_TOP      3328
#define XB_TOPGEN   3392
#define XCD_BAR_WORDS 3456
#define XB_SPIN_CAP (1u << 18)

__device__ __forceinline__ unsigned xb_ld(unsigned* p)              { return __hip_atomic_load(p, __ATOMIC_RELAXED, __HIP_MEMORY_SCOPE_AGENT); }
__device__ __forceinline__ unsigned xb_add(unsigned* p, unsigned v) { return __hip_atomic_fetch_add(p, v, __ATOMIC_RELAXED, __HIP_MEMORY_SCOPE_AGENT); }
__device__ __forceinline__ unsigned xb_xcc_id() { return (unsigned)__builtin_amdgcn_s_getreg((3 << 11) | 20) & 0xFu; }
#define XB_SPIN(cond, bar) do { unsigned _sp = 0; while (cond) { __builtin_amdgcn_s_sleep(1); \
    if ((++_sp & 255u) == 0u) { if (xb_ld(&(bar)[XB_TMO])) break; if (_sp > XB_SPIN_CAP) { atomicAdd(&(bar)[XB_TMO], 1u); break; } } } } while (0)

struct XcdBarrier {
    unsigned* bar; unsigned x;
    volatile LAS unsigned* st;
};

__device__ __forceinline__ XcdBarrier xcd_barrier_post(unsigned* bar, volatile LAS unsigned* st) {
    XcdBarrier b; b.bar = bar; b.x = xb_xcc_id(); b.st = st;
    if (threadIdx.x == 0) (void)xb_add(&bar[XB_XCNT(b.x)], 1u);
    return b;
}
__device__ __forceinline__ void xcd_barrier_complete(unsigned* bar, unsigned x, unsigned& nloc, unsigned& nx) {
    const unsigned G = gridDim.x * gridDim.y * gridDim.z;
    unsigned sum, cnt, mine, sp = 0u;
    for (;;) {
        sum = 0u; cnt = 0u; mine = 0u;
#pragma unroll
        for (unsigned j = 0; j < 16; ++j) { const unsigned c = xb_ld(&bar[XB_XCNT(j)]); sum += c; cnt += (c > 0u) ? 1u : 0u; mine = (j == x) ? c : mine; }
        if (sum == G) break;
        __builtin_amdgcn_s_sleep(1);
        if ((++sp & 255u) == 0u) { if (xb_ld(&bar[XB_TMO])) break; if (sp > XB_SPIN_CAP) { atomicAdd(&bar[XB_TMO], 1u); break; } }
    }
    nloc = mine > 0u ? mine : 1u; nx = cnt > 0u ? cnt : 1u;
}

__device__ __forceinline__ void xcd_barrier(const XcdBarrier& b) {
    asm volatile("s_waitcnt vmcnt(0)" ::: "memory");
    __syncthreads();
    if (threadIdx.x == 0) {
        unsigned* bar = b.bar;
        __builtin_amdgcn_s_waitcnt(0);
        unsigned nloc = b.st[0], nx = b.st[1];
        if (nloc == 0u) { xcd_barrier_complete(bar, b.x, nloc, nx); b.st[0] = nloc; b.st[1] = nx; }
        const unsigned old = xb_add(&bar[XB_XSUB(b.x)], 1u);
        const unsigned gen = old / nloc;
        if (old + 1u == (gen + 1u) * nloc) {
            __builtin_amdgcn_fence(__ATOMIC_RELEASE, "agent");
            asm volatile("s_waitcnt vmcnt(0)" ::: "memory");
            const unsigned og = xb_add(&bar[XB_TOP], 1u);
            const unsigned tg = og / nx;
            if (og + 1u == (tg + 1u) * nx) xb_add(&bar[XB_TOPGEN], 1u);
            else XB_SPIN(xb_ld(&bar[XB_TOPGEN]) == tg, bar);
            __builtin_amdgcn_fence(__ATOMIC_ACQUIRE, "agent");
            xb_add(&bar[XB_XGEN(b.x)], 1u);
            asm volatile("s_waitcnt vmcnt(0)" ::: "memory");
        } else {
            XB_SPIN(xb_ld(&bar[XB_XGEN(b.x)]) == gen, bar);
            __builtin_amdgcn_fence(__ATOMIC_ACQUIRE, "agent");
            asm volatile("s_waitcnt vmcnt(0)" ::: "memory");
        }
    }
    __syncthreads();
}
typedef float f32x16 __attribute__((ext_vector_type(16)));
typedef __bf16 bf16x2_t __attribute__((ext_vector_type(2)));
#define MFMA32(a, b, c) __builtin_amdgcn_mfma_f32_32x32x16_bf16((a), (b), (c), 0, 0, 0)
__device__ __forceinline__ float bf_lo(unsigned u) { return __builtin_bit_cast(float, u << 16); }
__device__ __forceinline__ float bf_hi(unsigned u) { return __builtin_bit_cast(float, u & 0xffff0000u); }
__device__ __forceinline__ float dot2_bf16(unsigned w, unsigned x, float acc) { return __builtin_amdgcn_fdot2_f32_bf16(__builtin_bit_cast(bf16x2_t, w), __builtin_bit_cast(bf16x2_t, x), acc, false); }
__device__ __forceinline__ float wave_sum(float v) {
#pragma unroll
    for (int o = 1; o < 64; o <<= 1) v += __shfl_xor(v, o);
    return v;
}

__device__ __forceinline__ void p0_transpose_item(const float* W, int K, int N, bf16* WT, const float* gk, LAS float* scr, int item, int lane) {
    const int nblk = N / 32, kb = item / nblk, nb = item % nblk, k0 = 64 * kb, n0 = 32 * nb;
#pragma unroll 8
    for (int i = 0; i < 32; ++i) { const int kk = 2 * i + (lane >> 5); float w = W[(size_t)(k0 + kk) * N + n0 + (lane & 31)]; if (gk) w *= gk[k0 + kk]; scr[kk * 33 + (lane & 31)] = w; }
    LDS_WAIT(); asm volatile("" ::: "memory");
    const int c = lane & 7;
#pragma unroll
    for (int j = 0; j < 4; ++j) { const int n = (lane >> 3) + 8 * j; const LAS float* s = scr + (8 * c) * 33 + n;
        v4u o; o.x = pk2(s[0 * 33], s[1 * 33]); o.y = pk2(s[2 * 33], s[3 * 33]); o.z = pk2(s[4 * 33], s[5 * 33]); o.w = pk2(s[6 * 33], s[7 * 33]);
        *(GAS v4u*)(WT + (size_t)(n0 + n) * K + k0 + 8 * c) = o; }
    LDS_WAIT(); asm volatile("" ::: "memory");
}
__device__ __forceinline__ float row_to_bf16(const float* src, bf16* dst, const float* g, int lane) {
    const GAS f32x4* xr = (const GAS f32x4*)src + lane; float s = 0.f;
    GAS unsigned long long* o8 = (GAS unsigned long long*)dst + lane;
#pragma unroll
    for (int j = 0; j < 4; ++j) { f32x4 v = xr[64 * j]; s += (v.x * v.x + v.y * v.y) + (v.z * v.z + v.w * v.w);
        if (g) { const f32x4 gv = ((const GAS f32x4*)g)[64 * j + lane]; v = v * gv; }
        o8[64 * j] = (unsigned long long)pk2(v.x, v.y) | ((unsigned long long)pk2(v.z, v.w) << 32); }
    return s;
}
struct P0Args { const float *x, *g1, *w_in, *pool_w, *w_out, *g2, *wq, *sk, *u, *v; bf16 *XB, *WinT, *WoutT, *WqT, *SK, *PoolT, *UB, *VB; float* rstd1; };
__device__ __forceinline__ void p0_prologue(const P0Args& a, LAS unsigned char* lds, int gw, int NGW, int wave, int lane) {
    LAS float* scr = (LAS float*)(lds + RING_OFF + wave * 16384);
    constexpr int I_IN = (D / 64) * (DIN / 32), I_OUT = (D / 64) * (D / 32), I_Q = (D / 64) * (DQ / 32), I_P = 4 * 2 * 4;
    constexpr int NITEMS = I_IN + I_OUT + I_Q + I_P;
    for (int it = gw; it < NITEMS; it += NGW) {
        int r = it;
        if (r < I_IN) { p0_transpose_item(a.w_in, D, DIN, a.WinT, a.g1, scr, r, lane); continue; } r -= I_IN;
        if (r < I_OUT) { p0_transpose_item(a.w_out, D, D, a.WoutT, nullptr, scr, r, lane); continue; } r -= I_OUT;
        if (r < I_Q) { p0_transpose_item(a.wq, D, DQ, a.WqT, a.g2, scr, r, lane); continue; } r -= I_Q;
        { const int g = r >> 3; p0_transpose_item(a.pool_w + (size_t)g * 16384, 128, 128, a.PoolT + (size_t)g * 16384, nullptr, scr, r & 7, lane); }
    }
    for (int m = gw; m < T; m += NGW) {
        const float s = wave_sum(row_to_bf16(a.x + (size_t)m * D, a.XB + (size_t)m * D, nullptr, lane));
        if (lane == 0) a.rstd1[m] = 1.0f / sqrtf(s * (1.0f / D) + EPS);
    }
    for (int m = gw; m < NEXP; m += NGW) {
        (void)row_to_bf16(a.u + (size_t)m * D, a.UB + (size_t)m * D, a.g2, lane);
        (void)row_to_bf16(a.v + (size_t)m * D, a.VB + (size_t)m * D, nullptr, lane);
    }
    for (int m = gw; m < 256; m += NGW) (void)row_to_bf16(a.sk + (size_t)m * D, a.SK + (size_t)m * D, nullptr, lane);
}

__device__ __forceinline__ int t5_bucket(int rel) {
    const int n = rel < 0 ? -rel : rel; const int base = rel > 0 ? 16 : 0;
    const int v = n < 8 ? n : (n < 12 ? 8 : (n < 16 ? 9 : (n < 23 ? 10 : (n < 32 ? 11 : (n < 46 ? 12 : (n < 64 ? 13 : (n < 91 ? 14 : 15)))))));
    return base + v;
}
__device__ __forceinline__ void attn_unit(LAS unsigned char* lds, const bf16* Y, bf16* AB, const float* qg, const float* kg, const float* sinks, const float* relb,
                                          int unit, int tid, int wave, int lane) {
    const int kvh = unit & 1, c = (unit >> 1) & 127, b = unit >> 8;
    LAS bf16* Ks = (LAS bf16*)lds;
    LAS bf16* Vt = (LAS bf16*)(lds + 27648);
    LAS float* bt = (LAS float*)(lds + 53248);
    const int row0 = b * SEQ + (c - 2) * 64;
#pragma unroll
    for (int rep = 0; rep < 3; ++rep) {
        const int it = tid + rep * 512, j = it >> 3, ch = it & 7;
        const bool valid = (c - 2 + (j >> 6)) >= 0;
        v4u kraw = {0u, 0u, 0u, 0u}, vraw = {0u, 0u, 0u, 0u};
        if (valid) { const bf16* rp = Y + (size_t)(row0 + j) * DIN; kraw = *(const GAS v4u*)(rp + 512 + 64 * kvh + 8 * ch); vraw = *(const GAS v4u*)(rp + 640 + 64 * kvh + 8 * ch); }
        float kf[8] = {bf_lo(kraw.x), bf_hi(kraw.x), bf_lo(kraw.y), bf_hi(kraw.y), bf_lo(kraw.z), bf_hi(kraw.z), bf_lo(kraw.w), bf_hi(kraw.w)};
        float ss = 0.f;
#pragma unroll
        for (int e = 0; e < 8; ++e) ss += kf[e] * kf[e];
        ss += __shfl_xor(ss, 1); ss += __shfl_xor(ss, 2); ss += __shfl_xor(ss, 4);
        const float r = 1.0f / sqrtf(ss * (1.0f / 64.0f) + EPS);
        const f32x4 g0 = *(const GAS f32x4*)(kg + 8 * ch), g1 = *(const GAS f32x4*)(kg + 8 * ch + 4);
        v4u ko; ko.x = pk2(kf[0] * r * g0.x, kf[1] * r * g0.y); ko.y = pk2(kf[2] * r * g0.z, kf[3] * r * g0.w); ko.z = pk2(kf[4] * r * g1.x, kf[5] * r * g1.y); ko.w = pk2(kf[6] * r * g1.z, kf[7] * r * g1.w);
        *(LAS v4u*)(Ks + j * 72 + 8 * ch) = ko;
        const int s16 = j >> 4, kk = j & 15, hh = (kk >> 2) & 1, jj = ((kk >> 3) << 2) | (kk & 3), pos = 16 * s16 + 8 * hh + jj;
        LAS bf16* vp = Vt + (8 * ch) * 200 + pos;
        vp[0 * 200] = (bf16)(vraw.x & 0xffffu); vp[1 * 200] = (bf16)(vraw.x >> 16); vp[2 * 200] = (bf16)(vraw.y & 0xffffu); vp[3 * 200] = (bf16)(vraw.y >> 16);
        vp[4 * 200] = (bf16)(vraw.z & 0xffffu); vp[5 * 200] = (bf16)(vraw.z >> 16); vp[6 * 200] = (bf16)(vraw.w & 0xffffu); vp[7 * 200] = (bf16)(vraw.w >> 16);
    }
#pragma unroll
    for (int rep = 0; rep < 2; ++rep) { const int it = tid + rep * 512, g = it >> 8, r = it & 255; bt[it] = relb[t5_bucket(r - 191) * 8 + kvh * 4 + g]; }
    LDS_WAIT(); __syncthreads();

    const int g = wave >> 1, i = 32 * (wave & 1) + (lane & 31), hh = lane >> 5, habs = kvh * 4 + g;
    const size_t qrow = (size_t)b * SEQ + (size_t)c * 64 + i;
    const bf16* qp = Y + qrow * DIN + habs * 64 + 8 * hh;
    v4u qraw[4]; float ss = 0.f;
#pragma unroll
    for (int s = 0; s < 4; ++s) { qraw[s] = *(const GAS v4u*)(qp + 16 * s);
        const float f0 = bf_lo(qraw[s].x), f1 = bf_hi(qraw[s].x), f2 = bf_lo(qraw[s].y), f3 = bf_hi(qraw[s].y), f4 = bf_lo(qraw[s].z), f5 = bf_hi(qraw[s].z), f6 = bf_lo(qraw[s].w), f7 = bf_hi(qraw[s].w);
        ss += (f0 * f0 + f1 * f1) + (f2 * f2 + f3 * f3) + (f4 * f4 + f5 * f5) + (f6 * f6 + f7 * f7); }
    ss += __shfl_xor(ss, 32);
    const float rq = 0.125f / sqrtf(ss * (1.0f / 64.0f) + EPS);
    bf16x8 qf[4];
#pragma unroll
    for (int s = 0; s < 4; ++s) { const f32x4 g0 = *(const GAS f32x4*)(qg + 16 * s + 8 * hh), g1 = *(const GAS f32x4*)(qg + 16 * s + 8 * hh + 4);
        v4u w; w.x = pk2(bf_lo(qraw[s].x) * rq * g0.x, bf_hi(qraw[s].x) * rq * g0.y); w.y = pk2(bf_lo(qraw[s].y) * rq * g0.z, bf_hi(qraw[s].y) * rq * g0.w);
        w.z = pk2(bf_lo(qraw[s].z) * rq * g1.x, bf_hi(qraw[s].z) * rq * g1.y); w.w = pk2(bf_lo(qraw[s].w) * rq * g1.z, bf_hi(qraw[s].w) * rq * g1.w);
        qf[s] = __builtin_bit_cast(bf16x8, w); }
    f32x16 sacc[6];
#pragma unroll
    for (int kt = 0; kt < 6; ++kt) {
#pragma unroll
        for (int r = 0; r < 16; ++r) sacc[kt][r] = 0.f;
#pragma unroll
        for (int s = 0; s < 4; ++s) { const bf16x8 a = *(const LAS bf16x8*)(Ks + (32 * kt + (lane & 31)) * 72 + 16 * s + 8 * hh); sacc[kt] = MFMA32(a, qf[s], sacc[kt]); }
    }
    const LAS float* btg = bt + g * 256 + 63 - i;
    float mx = -3.0e38f;
#pragma unroll
    for (int kt = 0; kt < 6; ++kt) { const bool masked = (c - 2 + (kt >> 1)) < 0;
#pragma unroll
        for (int r = 0; r < 16; ++r) { const int j = 32 * kt + (r & 3) + 8 * (r >> 2) + 4 * hh; float v = sacc[kt][r] + btg[j]; v = masked ? -1.0e30f : v; sacc[kt][r] = v; mx = fmaxf(mx, v); } }
    mx = fmaxf(mx, __shfl_xor(mx, 32));
    const float sink = sinks[habs], m = fmaxf(mx, sink);
    float sum = 0.f;
#pragma unroll
    for (int kt = 0; kt < 6; ++kt)
#pragma unroll
        for (int r = 0; r < 16; ++r) { const float p = __expf(sacc[kt][r] - m); sacc[kt][r] = p; sum += p; }
    sum += __shfl_xor(sum, 32);
    const float inv = 1.0f / (sum + __expf(sink - m));
    f32x16 oacc[2];
#pragma unroll
    for (int dt = 0; dt < 2; ++dt)
#pragma unroll
        for (int r = 0; r < 16; ++r) oacc[dt][r] = 0.f;
#pragma unroll
    for (int kt = 0; kt < 6; ++kt)
#pragma unroll
        for (int s2 = 0; s2 < 2; ++s2) {
            v4u w; w.x = pk2(sacc[kt][8 * s2 + 0], sacc[kt][8 * s2 + 1]); w.y = pk2(sacc[kt][8 * s2 + 2], sacc[kt][8 * s2 + 3]); w.z = pk2(sacc[kt][8 * s2 + 4], sacc[kt][8 * s2 + 5]); w.w = pk2(sacc[kt][8 * s2 + 6], sacc[kt][8 * s2 + 7]);
            const bf16x8 pb = __builtin_bit_cast(bf16x8, w);
#pragma unroll
            for (int dt = 0; dt < 2; ++dt) { const bf16x8 a = *(const LAS bf16x8*)(Vt + (32 * dt + (lane & 31)) * 200 + 32 * kt + 16 * s2 + 8 * hh); oacc[dt] = MFMA32(a, pb, oacc[dt]); }
        }
    bf16* op = AB + qrow * D + habs * 64;
#pragma unroll
    for (int dt = 0; dt < 2; ++dt)
#pragma unroll
        for (int q4 = 0; q4 < 4; ++q4) { const int d = 32 * dt + 8 * q4 + 4 * hh;
            const unsigned long long o = (unsigned long long)pk2(oacc[dt][4 * q4 + 0] * inv, oacc[dt][4 * q4 + 1] * inv) | ((unsigned long long)pk2(oacc[dt][4 * q4 + 2] * inv, oacc[dt][4 * q4 + 3] * inv) << 32);
            *(GAS unsigned long long*)(op + d) = o; }
    __syncthreads();
}

__device__ __forceinline__ void pool_unit(LAS unsigned char* lds, const bf16* Y, bf16* AB, const bf16* PoolT, const float* pscale, int unit, int tid, int wave, int lane) {
    const int g = unit & 3, tt = unit >> 2, w = 2 << g;
    LAS bf16* dt_ = (LAS bf16*)lds;
    {
        const int cp = tid & 63, rs = tid >> 6;
        const int r0 = tt * 256 + rs * 32, pos0 = r0 & (SEQ - 1);
        const bf16* colp = Y + 768 + 128 * g + 2 * cp;
        for (int k = 0; k < 32; ++k) {
            const int pos = pos0 + k; const int cnt = pos + 1 < w ? pos + 1 : w;
            float s0 = 0.f, s1 = 0.f, c0 = 0.f, c1 = 0.f;
            for (int q = 0; q < cnt; ++q) { const unsigned u = *(const GAS unsigned*)(colp + (size_t)(r0 + k - q) * DIN); const float a0 = bf_lo(u), a1 = bf_hi(u); s0 += a0; s1 += a1; if (q == 0) { c0 = a0; c1 = a1; } }
            const float ic = 1.0f / (float)cnt;
            *(LAS unsigned*)(dt_ + (rs * 32 + k) * 136 + 2 * cp) = pk2(s0 * ic - c0, s1 * ic - c1);
        }
    }
    LDS_WAIT(); __syncthreads();
    const int hh = lane >> 5, tok = 32 * wave + (lane & 31);
    f32x16 acc[4];
#pragma unroll
    for (int nt = 0; nt < 4; ++nt)
#pragma unroll
        for (int r = 0; r < 16; ++r) acc[nt][r] = 0.f;
    const bf16* pw = PoolT + (size_t)g * 16384 + (size_t)(lane & 31) * 128 + 8 * hh;
#pragma unroll
    for (int s = 0; s < 8; ++s) {
        const bf16x8 bfr = *(const LAS bf16x8*)(dt_ + tok * 136 + 16 * s + 8 * hh);
#pragma unroll
        for (int nt = 0; nt < 4; ++nt) { const bf16x8 a = __builtin_bit_cast(bf16x8, *(const GAS v4u*)(pw + (size_t)nt * 32 * 128 + 16 * s)); acc[nt] = MFMA32(a, bfr, acc[nt]); }
    }
    bf16* op = AB + (size_t)(tt * 256 + tok) * D + 512 + 128 * g;
#pragma unroll
    for (int nt = 0; nt < 4; ++nt)
#pragma unroll
        for (int q4 = 0; q4 < 4; ++q4) { const int dd = 32 * nt + 8 * q4 + 4 * hh; const f32x4 sc = *(const GAS f32x4*)(pscale + 128 * g + dd);
            const unsigned long long o = (unsigned long long)pk2(acc[nt][4 * q4 + 0] * sc.x, acc[nt][4 * q4 + 1] * sc.y) | ((unsigned long long)pk2(acc[nt][4 * q4 + 2] * sc.z, acc[nt][4 * q4 + 3] * sc.w) << 32);
            *(GAS unsigned long long*)(op + dd) = o; }
    __syncthreads();
}

__device__ __forceinline__ int f2key(float f) { int i = __builtin_bit_cast(int, f); return i ^ ((i >> 31) & 0x7fffffff); }
__device__ __forceinline__ float key2f(int k) { return __builtin_bit_cast(float, k ^ ((k >> 31) & 0x7fffffff)); }
#define CE_DESC(a, b) do { const int _x = (a), _y = (b); (a) = _x > _y ? _x : _y; (b) = _x > _y ? _y : _x; } while (0)
__device__ __forceinline__ void sort16_desc(int (&a)[16]) {
#pragma unroll
    for (int k = 2; k <= 16; k <<= 1)
#pragma unroll
        for (int j = k >> 1; j > 0; j >>= 1)
#pragma unroll
            for (int i = 0; i < 16; ++i) { const int l = i ^ j; if (l > i) { if ((i & k) == 0) CE_DESC(a[i], a[l]); else CE_DESC(a[l], a[i]); } }
}
__device__ __forceinline__ void merge_top16(int (&a)[16], const int (&b)[16]) {
#pragma unroll
    for (int i = 0; i < 16; ++i) a[i] = a[i] > b[15 - i] ? a[i] : b[15 - i];
#pragma unroll
    for (int j = 8; j > 0; j >>= 1)
#pragma unroll
        for (int i = 0; i < 16; ++i) { const int l = i ^ j; if (l > i) CE_DESC(a[i], a[l]); }
}
__device__ __forceinline__ void top16_of_64(int (&g0)[16], int (&g1)[16], int (&g2)[16], int (&g3)[16]) {
    sort16_desc(g0); sort16_desc(g1); sort16_desc(g2); sort16_desc(g3);
    merge_top16(g0, g1); merge_top16(g2, g3); merge_top16(g0, g2);
}
__device__ __forceinline__ void topk_unit(LAS unsigned char* lds, const bf16* QP, const bf16* SK, int* EXPERTS, float* BEST, int unit, int tid, int wave, int lane) {
    const int h = unit & 7, tt = unit >> 3, hh = lane >> 5;
    const int tok = tt * 256 + wave * 32 + (lane & 31);
    LAS int* mine = (LAS int*)lds + tid * 33;
    int top[2][16];
#pragma unroll
    for (int p = 0; p < 2; ++p) {
        const bf16* qp = QP + (size_t)tok * DQ + h * 256 + p * 128 + 8 * hh;
        const bf16* kp = SK + (size_t)(h * 2 + p) * 16384 + (size_t)(lane & 31) * 128 + 8 * hh;
        f32x16 acc[4];
#pragma unroll
        for (int nt = 0; nt < 4; ++nt)
#pragma unroll
            for (int r = 0; r < 16; ++r) acc[nt][r] = 0.f;
#pragma unroll
        for (int s = 0; s < 8; ++s) { const bf16x8 bq = __builtin_bit_cast(bf16x8, *(const GAS v4u*)(qp + 16 * s));
#pragma unroll
            for (int nt = 0; nt < 4; ++nt) { const bf16x8 a = __builtin_bit_cast(bf16x8, *(const GAS v4u*)(kp + (size_t)nt * 32 * 128 + 16 * s)); acc[nt] = MFMA32(a, bq, acc[nt]); } }
        int k0[16], k1[16], k2[16], k3[16];
#pragma unroll
        for (int r = 0; r < 16; ++r) { const int n = (r & 3) + 8 * (r >> 2) + 4 * hh;
            k0[r] = (f2key(acc[0][r]) & ~127) | n; k1[r] = (f2key(acc[1][r]) & ~127) | (32 + n); k2[r] = (f2key(acc[2][r]) & ~127) | (64 + n); k3[r] = (f2key(acc[3][r]) & ~127) | (96 + n); }
        top16_of_64(k0, k1, k2, k3);
#pragma unroll
        for (int r = 0; r < 16; ++r) k1[r] = __shfl_xor(k0[r], 32);
        merge_top16(k0, k1);
#pragma unroll
        for (int r = 0; r < 16; ++r) top[p][r] = k0[r];
    }
    int c0[16], c1[16], c2[16], c3[16];
    {
        float v1[16], v2[16];
#pragma unroll
        for (int r = 0; r < 16; ++r) { v1[r] = key2f(top[0][r] & ~127); v2[r] = key2f(top[1][r] & ~127); mine[r] = top[0][r]; mine[16 + r] = top[1][r]; }
        int cnt = 0;
#pragma unroll
        for (int i = 0; i < 16; ++i)
#pragma unroll
            for (int j = 0; j < 16; ++j) if ((i + 1) * (j + 1) <= 16) { const int key = (f2key(v1[i] + v2[j]) & ~255) | (i << 4) | j;
                if (cnt < 16) c0[cnt] = key; else if (cnt < 32) c1[cnt - 16] = key; else if (cnt < 48) c2[cnt - 32] = key; else c3[cnt - 48] = key; ++cnt; }
#pragma unroll
        for (int r = 0; r < 16; ++r) if (48 + r >= cnt) c3[r] = (int)0x80000000;
    }
    top16_of_64(c0, c1, c2, c3);
    LDS_WAIT();
    if (hh == 0) {
        int ev[16]; float bv[16];
#pragma unroll
        for (int r = 0; r < 16; ++r) { const int id = c0[r] & 255; const int ka = mine[id >> 4], kb = mine[16 + (id & 15)];
            ev[r] = (ka & 127) * 128 + (kb & 127); bv[r] = key2f(ka & ~127) + key2f(kb & ~127); }
        int* ep = EXPERTS + (size_t)tok * 128 + h * 16; float* bp = BEST + (size_t)tok * 128 + h * 16;
#pragma unroll
        for (int r = 0; r < 16; r += 4) { *(GAS v4u*)(ep + r) = (v4u){(unsigned)ev[r], (unsigned)ev[r + 1], (unsigned)ev[r + 2], (unsigned)ev[r + 3]}; *(GAS f32x4*)(bp + r) = (f32x4){bv[r], bv[r + 1], bv[r + 2], bv[r + 3]}; }
    }
    LDS_WAIT();
}

__device__ __forceinline__ float gelu_erf(float x) { return 0.5f * x * (1.0f + erff(x * 0.70710678118654752f)); }
__device__ __forceinline__ void peer_token(const bf16* X1B, const bf16* UB, const bf16* VB, const int* EXPERTS, const float* BEST, const float* SS2, float* OUT, int t, int lane) {
    const bf16* xr = X1B + (size_t)t * D + 8 * lane;
    const v4u xa = *(const GAS v4u*)xr, xb = *(const GAS v4u*)(xr + 512);
    float ssq = 0.f;
    { const GAS f32x4* sp = (const GAS f32x4*)(SS2 + (size_t)t * 16);
#pragma unroll
      for (int q = 0; q < 4; ++q) { const f32x4 v = sp[q]; ssq += (v.x + v.y) + (v.z + v.w); } }
    const float rstd2 = 1.0f / sqrtf(ssq * (1.0f / D) + EPS);
    int e[2]; float c[2];
#pragma unroll
    for (int hf = 0; hf < 2; ++hf) {
        e[hf] = EXPERTS[(size_t)t * 128 + 64 * hf + lane];
        const float sb = BEST[(size_t)t * 128 + 64 * hf + lane] * rstd2;
        float mx = sb;
#pragma unroll
        for (int o = 1; o < 16; o <<= 1) mx = fmaxf(mx, __shfl_xor(mx, o));
        const float ex = __expf(sb - mx); float sm = ex;
#pragma unroll
        for (int o = 1; o < 16; o <<= 1) sm += __shfl_xor(sm, o);
        const float gate = ex / sm;
        float part[64];
#pragma unroll
        for (int k = 0; k < 64; ++k) { const int ek = __builtin_amdgcn_readlane(e[hf], k); const bf16* ur = UB + (size_t)ek * D + 8 * lane;
            const v4u ua = *(const GAS v4u*)ur, ub = *(const GAS v4u*)(ur + 512);
            float a0 = dot2_bf16(ua.x, xa.x, 0.f), a1 = dot2_bf16(ua.y, xa.y, 0.f); a0 = dot2_bf16(ua.z, xa.z, a0); a1 = dot2_bf16(ua.w, xa.w, a1);
            a0 = dot2_bf16(ub.x, xb.x, a0); a1 = dot2_bf16(ub.y, xb.y, a1); a0 = dot2_bf16(ub.z, xb.z, a0); a1 = dot2_bf16(ub.w, xb.w, a1);
            part[k] = a0 + a1; }
#pragma unroll
        for (int o = 32; o > 0; o >>= 1) { const bool up = (lane & o) != 0;
#pragma unroll
            for (int i2 = 0; i2 < o; ++i2) { const float keep = up ? part[i2 + o] : part[i2], send = up ? part[i2] : part[i2 + o]; part[i2] = keep + __shfl_xor(send, o); } }
        c[hf] = gate * gelu_erf(part[0] * rstd2);
    }
    float* orow = OUT + (size_t)t * D + 8 * lane;
    f32x4 o0 = *(const GAS f32x4*)orow, o1 = *(const GAS f32x4*)(orow + 4), o2 = *(const GAS f32x4*)(orow + 512), o3 = *(const GAS f32x4*)(orow + 516);
#pragma unroll
    for (int hf = 0; hf < 2; ++hf)
#pragma unroll
        for (int k = 0; k < 64; ++k) { const int ek = __builtin_amdgcn_readlane(e[hf], k); const float ck = __builtin_bit_cast(float, __builtin_amdgcn_readlane(__builtin_bit_cast(int, c[hf]), k));
            const bf16* vr = VB + (size_t)ek * D + 8 * lane; const v4u va = *(const GAS v4u*)vr, vb = *(const GAS v4u*)(vr + 512);
            o0.x += ck * bf_lo(va.x); o0.y += ck * bf_hi(va.x); o0.z += ck * bf_lo(va.y); o0.w += ck * bf_hi(va.y);
            o1.x += ck * bf_lo(va.z); o1.y += ck * bf_hi(va.z); o1.z += ck * bf_lo(va.w); o1.w += ck * bf_hi(va.w);
            o2.x += ck * bf_lo(vb.x); o2.y += ck * bf_hi(vb.x); o2.z += ck * bf_lo(vb.y); o2.w += ck * bf_hi(vb.y);
            o3.x += ck * bf_lo(vb.z); o3.y += ck * bf_hi(vb.z); o3.z += ck * bf_lo(vb.w); o3.w += ck * bf_hi(vb.w); }
    *(GAS f32x4*)orow = o0; *(GAS f32x4*)(orow + 4) = o1; *(GAS f32x4*)(orow + 512) = o2; *(GAS f32x4*)(orow + 516) = o3;
}
struct Args { const float* in[15]; float* out; unsigned char* ws; int ph_lo, ph_hi, li, pad; };
__global__ void __launch_bounds__(NWAVES * 64, 2) fwd_kernel(Args args) {
    extern __shared__ __attribute__((aligned(16))) unsigned char lds_raw[];
    LAS unsigned char* lds = (LAS unsigned char*)lds_raw;
    volatile LAS unsigned* MISC = (volatile LAS unsigned*)(lds + MISC_OFF);
    const int tid = threadIdx.x, lane = tid & 63, wave = __builtin_amdgcn_readfirstlane(tid >> 6);
    const int G = gridDim.x, bx = blockIdx.x;
    unsigned char* ws = args.ws;
    gu32* ctl = (gu32*)(ws + WS_CTL);
    for (int u = tid; u < (LDS_BYTES - LDSCTL_OFF) / 4; u += NWAVES * 64) ((LAS unsigned*)(lds + LDSCTL_OFF))[u] = 0u;
    __syncthreads();
    XcdBarrier bar; bar.bar = (unsigned*)(ctl + CW_BAR); bar.x = 0; bar.st = nullptr;
    if (N_LAUNCHES != PER_PHASE) bar = xcd_barrier_post((unsigned*)(ctl + CW_BAR) + args.li * XCD_BAR_WORDS, MISC + 8);
#define GRID_BAR() do { if (N_LAUNCHES != PER_PHASE) xcd_barrier(bar); } while (0)
    const int lo = args.ph_lo, hi = args.ph_hi;
#define IN(k) (lo <= (k) && (k) < hi)
#define BOTH(k) (IN(k) && IN((k) + 1))

    const float* x = args.in[0]; float* out = args.out;
    bf16* XB = (bf16*)(ws + WS_XB); bf16* WinT = (bf16*)(ws + WS_WIN); bf16* WoutT = (bf16*)(ws + WS_WOUT); bf16* WqT = (bf16*)(ws + WS_WQ);
    bf16* SK = (bf16*)(ws + WS_SK); bf16* PoolT = (bf16*)(ws + WS_POOLT); bf16* UB = (bf16*)(ws + WS_UB); bf16* VB = (bf16*)(ws + WS_VB);
    bf16* Y = (bf16*)(ws + WS_Y); bf16* AB = (bf16*)(ws + WS_AB); bf16* X1B = (bf16*)(ws + WS_X1B); bf16* QP = (bf16*)(ws + WS_QP);
    float* rstd1 = (float*)(ws + WS_RSTD1); float* SS2 = (float*)(ws + WS_SS2); int* EXPERTS = (int*)(ws + WS_EXP); float* BEST = (float*)(ws + WS_BEST);
    const int gw = bx * NWAVES + wave, NGW = G * NWAVES;

    if (IN(0)) {
        P0Args a{x, args.in[1], args.in[2], args.in[7], args.in[9], args.in[10], args.in[11], args.in[12], args.in[13], args.in[14], XB, WinT, WoutT, WqT, SK, PoolT, UB, VB, rstd1};
        p0_prologue(a, lds, gw, NGW, wave, lane);
        if (BOTH(0)) GRID_BAR();
    }
    if (IN(1)) {
        pg8::Gemm g{XB, WinT, T, DIN, D}; pg8::StaticOrder S; S.init(T, DIN, G, bx);
        pg8::EpiScaleBf16 E{Y, DIN, rstd1};
        pg8::gemm_phase<pg8::EpiScaleBf16, pg8::StaticOrder, true, true>(lds + RING_OFF, g, S, E);
        if (BOTH(1)) GRID_BAR();
    }
    if (IN(2)) {
        for (int u = bx; u < NB * 128 * 2; u += G) attn_unit(lds, Y, AB, args.in[3], args.in[4], args.in[5], args.in[6], u, tid, wave, lane);
        for (int u = bx; u < (T / 256) * 4; u += G) pool_unit(lds, Y, AB, PoolT, args.in[8], u, tid, wave, lane);
        if (BOTH(2)) GRID_BAR();
    }
    if (IN(3)) {
        pg8::Gemm g{AB, WoutT, T, D, D}; pg8::StaticOrder S; S.init(T, D, G, bx);
        pg8::EpiResid E{x, out, X1B, SS2, D};
        pg8::gemm_phase<pg8::EpiResid, pg8::StaticOrder, true, true>(lds + RING_OFF, g, S, E);
        if (BOTH(3)) GRID_BAR();
    }
    if (IN(4)) {
        pg8::Gemm g{X1B, WqT, T, DQ, D}; pg8::StaticOrder S; S.init(T, DQ, G, bx);
        pg8::EpiScaleBf16 E{QP, DQ, nullptr};
        pg8::gemm_phase<pg8::EpiScaleBf16, pg8::StaticOrder, true, true>(lds + RING_OFF, g, S, E);
        if (BOTH(4)) GRID_BAR();
    }
    if (IN(5)) {
        for (int u = bx; u < (T / 256) * 8; u += G) topk_unit(lds, QP, SK, EXPERTS, BEST, u, tid, wave, lane);
        if (BOTH(5)) GRID_BAR();
    }
    if (IN(6)) {
        for (int t = gw; t < T; t += NGW) peer_token(X1B, UB, VB, EXPERTS, BEST, SS2, out, t, lane);
    }
#undef IN
#undef BOTH
}

extern "C" void kernel_launch(void* const* d_in, const int* in_sizes, int n_in, void* d_out, int out_size, void* d_ws, size_t ws_size, hipStream_t stream) {
    static int grid = 0;
    if (grid == 0) {
        if (n_in != 15 || in_sizes[0] != T * D || out_size != T * D || ws_size < WS_END) { fprintf(stderr, "kernel_launch: unexpected shapes (n_in %d, in0 %d, out %d, ws %zu)\n", n_in, n_in > 0 ? in_sizes[0] : -1, out_size, ws_size); grid = -1; return; }
        int dev = 0, cus = 0, per_cu = 0;
        if (hipGetDevice(&dev) != hipSuccess || hipDeviceGetAttribute(&cus, hipDeviceAttributeMultiprocessorCount, dev) != hipSuccess) { grid = -1; return; }
        if (hipFuncSetAttribute((const void*)fwd_kernel, hipFuncAttributeMaxDynamicSharedMemorySize, LDS_BYTES) != hipSuccess) { fprintf(stderr, "kernel_launch: hipFuncSetAttribute failed\n"); grid = -1; return; }
        if (hipOccupancyMaxActiveBlocksPerMultiprocessor(&per_cu, (const void*)fwd_kernel, NWAVES * 64, LDS_BYTES) != hipSuccess || per_cu < 1) { fprintf(stderr, "kernel_launch: occupancy query reports %d blocks per CU\n", per_cu); }
        (void)hipGetLastError();
        grid = cus;
    }
    if (grid < 0) return;
    if (hipMemsetAsync((char*)d_ws + WS_CTL, 0, CTL_ZERO_BYTES, stream) != hipSuccess) return;
    Args a{};
    for (int i = 0; i < 15; ++i) a.in[i] = (const float*)d_in[i];
    a.out = (float*)d_out; a.ws = (unsigned char*)d_ws;
    for (int li = 0; li < N_LAUNCHES; ++li) {
        a.ph_lo = (N_LAUNCHES == PER_PHASE) ? li : 0; a.ph_hi = (N_LAUNCHES == PER_PHASE) ? li + 1 : PER_PHASE; a.li = (N_LAUNCHES == PER_PHASE) ? 0 : li;
        hipLaunchKernelGGL(fwd_kernel, dim3(grid), dim3(NWAVES * 64), LDS_BYTES, stream, a);
        const hipError_t le = hipPeekAtLastError();
        if (le != hipSuccess) { fprintf(stderr, "kernel_launch: launch %d failed: %s\n", li, hipGetErrorName(le)); break; }
    }
}
```

```cpp
#include <hip/hip_runtime.h>
#include <cstdio>
#include <cstdint>
namespace pg8 {
#define PG8_LAS __attribute__((address_space(3)))
typedef unsigned short bf16_t;
typedef short bf16x8 __attribute__((ext_vector_type(8)));
typedef float f32x4 __attribute__((ext_vector_type(4)));
typedef unsigned u32x4 __attribute__((ext_vector_type(4)));
constexpr int BM = 256, BK = 64, HALF = 128, HTB = HALF * BK * 2  , STAGE_BYTES = 8 * HTB, NXCD = 8, WGM = 8;

__host__ __device__ __forceinline__ int lds_byte(int r, int c) { const int st = (r >> 4) * 2 + (c >> 5), rr = r & 15, cc = c & 31, ob = rr * 64 + cc * 2; return st * 1024 + (ob ^ (((ob >> 9) & 1) << 5)); }
__host__ __device__ __forceinline__ void stage_rc(int b, int& R, int& C) { const int st = b / 1024, sb = b % 1024, swz = sb ^ (((sb >> 9) & 1) << 5); R = (st >> 1) * 16 + swz / 64; C = (st & 1) * 32 + (swz % 64) / 2; }
__host__ __device__ __forceinline__ int perm32(int rho) { const int n = rho >> 4, i = rho & 15; return 8 * (i >> 2) + 4 * n + (i & 3); }

struct Unit { int pm, pn; };
struct Gemm { const bf16_t* A; const bf16_t* Bt; int M, N, K; };

struct StaticOrder {
    int nM, nN, nwg, G, c;
    __host__ __device__ void init(int M, int N, int G_, int c_) { nM = M / BM; nN = N / BM; nwg = nM * nN; G = G_; c = c_; }
    __host__ __device__ bool next(int i, Unit& u) const {
        const long L = (long)i * G + c; if (L >= nwg) return false;
        int wgid = (int)L; { const int q = nwg / NXCD, r = nwg % NXCD, xcd = wgid % NXCD, off = wgid / NXCD; wgid = (xcd < r ? xcd * (q + 1) : r * (q + 1) + (xcd - r) * q) + off; }
        const int nig = WGM * nN, gid = wgid / nig, fm = gid * WGM, gsz = (nM - fm) < WGM ? (nM - fm) : WGM;
        u.pm = fm + ((wgid % nig) % gsz); u.pn = (wgid % nig) / gsz; return true;
    }
    __device__ __forceinline__ void a_ready(const Unit&) const {}
    __device__ __forceinline__ void done(const Unit&) const {}
};

__device__ __forceinline__ unsigned cvt_pk_bf16(float lo, float hi) { unsigned r; asm volatile("v_cvt_pk_bf16_f32 %0, %1, %2" : "=v"(r) : "v"(lo), "v"(hi)); return r; }
struct EpiScaleBf16 {
    static constexpr bool PERM = true, AFTER_DRAIN = false;
    bf16_t* O; int ldc; const float* rs;
    __device__ __forceinline__ void operator()(const f32x4 (&acc)[2][2][4][2], const Unit& u, int wr, int wc, int fr, int fq) const {
        const int row0 = u.pm * BM + wr * 64 + fr, col0 = u.pn * BM + wc * 32 + 8 * fq;
#pragma unroll
        for (int ai = 0; ai < 2; ++ai)
#pragma unroll
            for (int m = 0; m < 4; ++m) { const int row = row0 + ai * HALF + m * 16; const float s = rs ? rs[row] : 1.f; bf16_t* rowp = O + (size_t)row * ldc + col0;
#pragma unroll
                for (int bj = 0; bj < 2; ++bj) { const f32x4 v0 = acc[ai][bj][m][0] * s, v1 = acc[ai][bj][m][1] * s;
                    u32x4 w; w.x = cvt_pk_bf16(v0[0], v0[1]); w.y = cvt_pk_bf16(v0[2], v0[3]); w.z = cvt_pk_bf16(v1[0], v1[1]); w.w = cvt_pk_bf16(v1[2], v1[3]);
                    *(u32x4*)(rowp + bj * HALF) = w; } }
    }
};
struct EpiResid {
    static constexpr bool PERM = true, AFTER_DRAIN = false;
    const float* base; float* out; bf16_t* xb; float* ss; int ldc;
    __device__ __forceinline__ void operator()(const f32x4 (&acc)[2][2][4][2], const Unit& u, int wr, int wc, int fr, int fq) const {
        const int row0 = u.pm * BM + wr * 64 + fr, col0 = u.pn * BM + wc * 32 + 8 * fq;
#pragma unroll
        for (int ai = 0; ai < 2; ++ai)
#pragma unroll
            for (int m = 0; m < 4; ++m) { const int row = row0 + ai * HALF + m * 16; const size_t off = (size_t)row * ldc + col0; float q = 0.f;
#pragma unroll
                for (int bj = 0; bj < 2; ++bj) { const f32x4 xa = *(const f32x4*)(base + off + bj * HALF), xc = *(const f32x4*)(base + off + bj * HALF + 4);
                    const f32x4 v0 = acc[ai][bj][m][0] + xa, v1 = acc[ai][bj][m][1] + xc;
                    *(f32x4*)(out + off + bj * HALF) = v0; *(f32x4*)(out + off + bj * HALF + 4) = v1;
                    u32x4 w; w.x = cvt_pk_bf16(v0[0], v0[1]); w.y = cvt_pk_bf16(v0[2], v0[3]); w.z = cvt_pk_bf16(v1[0], v1[1]); w.w = cvt_pk_bf16(v1[2], v1[3]);
                    *(u32x4*)(xb + off + bj * HALF) = w;
                    q += (v0[0] * v0[0] + v0[1] * v0[1]) + (v0[2] * v0[2] + v0[3] * v0[3]) + (v1[0] * v1[0] + v1[1] * v1[1]) + (v1[2] * v1[2] + v1[3] * v1[3]); }
                q += __shfl_xor(q, 16); q += __shfl_xor(q, 32);
                if (fq == 0) ss[(size_t)row * 16 + u.pn * 4 + wc] = q; }
    }
};
template <class Epi, class Sched, bool ALIGN_EPI = false, bool SP2 = false>
__device__ __forceinline__ void gemm_phase(PG8_LAS unsigned char* lds, const Gemm g, const Sched& S, const Epi& E) {
    const int tid = threadIdx.x, wid = __builtin_amdgcn_readfirstlane(tid >> 6), lane = tid & 63, wr = wid >> 2, wc = wid & 3, fr = lane & 15, fq = lane >> 4;
    const int K = g.K, nt = K / BK;
    unsigned voffA[2], voffB[2];
#pragma unroll
    for (int i = 0; i < 2; ++i) { int R, C; stage_rc(tid * 16 + i * 8192, R, C); const int Rb = Epi::PERM ? ((R & ~31) + perm32(R & 31)) : R;
        voffA[i] = (unsigned)(R * K + C) * 2u; voffB[i] = (unsigned)(Rb * K + C) * 2u; }
    const size_t kstep = (size_t)(BK * 2);
    const size_t hstep = (size_t)HALF * K * 2;
    const size_t tstep = 2 * hstep;
    const unsigned ldsw = (unsigned)wid * 1024u;
    const int aoff = lds_byte(wr * 64 + fr, fq * 8), boff = lds_byte(wc * 32 + fr, fq * 8);
#define PG8_SA(b, h) (((b) * 2 + (h)) * HTB)
#define PG8_SB(b, h) ((4 + (b) * 2 + (h)) * HTB)
#define PG8_STAGE(bufoff, gbase, voff) do { _Pragma("unroll") for (int _i = 0; _i < 2; ++_i) \
        __builtin_amdgcn_global_load_lds((const unsigned*)((const char*)(gbase) + (voff)[_i]), (PG8_LAS unsigned*)(lds + (bufoff) + ldsw + _i * 8192), 16, 0, 0); } while (0)
#define PG8_LDA(dst, b, h) do { _Pragma("unroll") for (int m = 0; m < 4; ++m) _Pragma("unroll") for (int k = 0; k < 2; ++k) dst[m][k] = *(const PG8_LAS bf16x8*)(lds + PG8_SA(b, h) + aoff + m * 2048 + k * 1024); } while (0)
#define PG8_LDB(dst, b, h) do { _Pragma("unroll") for (int n = 0; n < 2; ++n) _Pragma("unroll") for (int k = 0; k < 2; ++k) dst[n][k] = *(const PG8_LAS bf16x8*)(lds + PG8_SB(b, h) + boff + n * 2048 + k * 1024); } while (0)
#define PG8_MMA(ai, bj, At, Bt) do { __builtin_amdgcn_s_setprio(1); _Pragma("unroll") for (int m = 0; m < 4; ++m) _Pragma("unroll") for (int n = 0; n < 2; ++n) _Pragma("unroll") for (int k = 0; k < 2; ++k) \
        acc[ai][bj][m][n] = __builtin_amdgcn_mfma_f32_16x16x32_bf16(Bt[n][k], At[m][k], acc[ai][bj][m][n], 0, 0, 0); __builtin_amdgcn_s_setprio(0); } while (0)
#define PG8_WAIT_V(n) asm volatile("s_waitcnt vmcnt(" #n ")" ::: "memory")
#define PG8_WAIT_L(n) asm volatile("s_waitcnt lgkmcnt(" #n ")" ::: "memory")
#define PG8_BAR __builtin_amdgcn_s_barrier()
#define PG8_SCHED __builtin_amdgcn_sched_barrier(0)
    Unit cur, nxt; int ui = 0;
    if (!S.next(0, cur)) return;
    f32x4 acc[2][2][4][2];
#pragma unroll
    for (int a = 0; a < 2; ++a)
#pragma unroll
        for (int b = 0; b < 2; ++b)
#pragma unroll
            for (int m = 0; m < 4; ++m)
#pragma unroll
                for (int n = 0; n < 2; ++n) acc[a][b][m][n] = (f32x4){0.f, 0.f, 0.f, 0.f};
    bf16x8 At[4][2], B0[2][2], B1[2][2];
    const char* cA = (const char*)g.A + (size_t)cur.pm * tstep; const char* cB = (const char*)g.Bt + (size_t)cur.pn * tstep;
    S.a_ready(cur);
    if constexpr (SP2) {
        PG8_STAGE(PG8_SB(0, 0), cB, voffB); PG8_STAGE(PG8_SB(0, 1), cB + hstep, voffB); PG8_STAGE(PG8_SA(0, 0), cA, voffA); PG8_STAGE(PG8_SA(0, 1), cA + hstep, voffA);
        if (wr == 1) PG8_BAR;
        PG8_WAIT_V(2); PG8_BAR;
        PG8_STAGE(PG8_SB(1, 0), cB + kstep, voffB); PG8_STAGE(PG8_SA(1, 0), cA + kstep, voffA); PG8_STAGE(PG8_SB(1, 1), cB + hstep + kstep, voffB);
        PG8_WAIT_V(6); PG8_BAR;
    } else {
        PG8_STAGE(PG8_SB(0, 0), cB, voffB); PG8_STAGE(PG8_SA(0, 0), cA, voffA); PG8_STAGE(PG8_SB(0, 1), cB + hstep, voffB); PG8_STAGE(PG8_SA(0, 1), cA + hstep, voffA);
        if (wr == 1) PG8_BAR;
        PG8_WAIT_V(4); PG8_BAR;
        PG8_STAGE(PG8_SB(1, 0), cB + kstep, voffB); PG8_STAGE(PG8_SA(1, 0), cA + kstep, voffA); PG8_STAGE(PG8_SB(1, 1), cB + hstep + kstep, voffB);
        PG8_WAIT_V(6); PG8_BAR;
    }
    for (;;) {
        const bool has_next = S.next(ui + 1, nxt);
        const char* nA = has_next ? (const char*)g.A + (size_t)nxt.pm * tstep : cA; const char* nB = has_next ? (const char*)g.Bt + (size_t)nxt.pn * tstep : cB;
        for (int t = 0; t < nt; t += 2) {
            const bool last = (t == nt - 2);
            const char* a1 = cA + (size_t)(t + 1) * kstep;
            const char* a2 = last ? nA : cA + (size_t)(t + 2) * kstep; const char* b2 = last ? nB : cB + (size_t)(t + 2) * kstep;
            const char* a3 = a2 + kstep; const char* b3 = b2 + kstep;
            if (last && has_next) S.a_ready(nxt);
            if constexpr (SP2) {
            PG8_LDB(B0, 0, 0); PG8_LDB(B1, 0, 1); PG8_SCHED; PG8_LDA(At, 0, 0); PG8_STAGE(PG8_SA(1, 1), a1 + hstep, voffA);
            PG8_WAIT_V(8); PG8_WAIT_L(0); PG8_BAR; PG8_MMA(0, 0, At, B0); PG8_MMA(0, 1, At, B1); PG8_BAR; PG8_SCHED;
            PG8_LDA(At, 0, 1); PG8_STAGE(PG8_SB(0, 0), b2, voffB); PG8_STAGE(PG8_SB(0, 1), b2 + hstep, voffB); PG8_STAGE(PG8_SA(0, 0), a2, voffA);
            PG8_WAIT_V(8); PG8_WAIT_L(0); PG8_BAR; PG8_MMA(1, 0, At, B0); PG8_MMA(1, 1, At, B1); PG8_BAR; PG8_SCHED;
            PG8_LDB(B0, 1, 0); PG8_LDB(B1, 1, 1); PG8_SCHED; PG8_LDA(At, 1, 0); PG8_STAGE(PG8_SA(0, 1), a2 + hstep, voffA);
            PG8_WAIT_V(8); PG8_WAIT_L(0); PG8_BAR; PG8_MMA(0, 0, At, B0); PG8_MMA(0, 1, At, B1); PG8_BAR; PG8_SCHED;
            PG8_LDA(At, 1, 1); PG8_STAGE(PG8_SB(1, 0), b3, voffB); PG8_STAGE(PG8_SB(1, 1), b3 + hstep, voffB); PG8_STAGE(PG8_SA(1, 0), a3, voffA);
            PG8_WAIT_V(8); PG8_WAIT_L(0); PG8_BAR; PG8_MMA(1, 0, At, B0); PG8_MMA(1, 1, At, B1); PG8_BAR; PG8_SCHED;
            } else {
            PG8_LDB(B0, 0, 0); PG8_SCHED; PG8_LDA(At, 0, 0); PG8_STAGE(PG8_SA(1, 1), a1 + hstep, voffA);
            PG8_WAIT_L(8); PG8_BAR; PG8_WAIT_L(0); PG8_MMA(0, 0, At, B0); PG8_BAR; PG8_SCHED;
            PG8_LDB(B1, 0, 1); PG8_STAGE(PG8_SB(0, 0), b2, voffB);
            PG8_BAR; PG8_WAIT_L(0); PG8_MMA(0, 1, At, B1); PG8_BAR;
            PG8_LDA(At, 0, 1); PG8_STAGE(PG8_SA(0, 0), a2, voffA);
            PG8_BAR; PG8_WAIT_L(0); PG8_MMA(1, 0, At, B0); PG8_BAR; PG8_SCHED;
            PG8_STAGE(PG8_SB(0, 1), b2 + hstep, voffB);
            PG8_WAIT_V(6); PG8_BAR; PG8_MMA(1, 1, At, B1); PG8_BAR;
            PG8_LDB(B0, 1, 0); PG8_SCHED; PG8_LDA(At, 1, 0); PG8_STAGE(PG8_SA(0, 1), a2 + hstep, voffA);
            PG8_WAIT_L(8); PG8_BAR; PG8_WAIT_L(0); PG8_MMA(0, 0, At, B0); PG8_BAR; PG8_SCHED;
            PG8_LDB(B1, 1, 1); PG8_STAGE(PG8_SB(1, 0), b3, voffB);
            PG8_BAR; PG8_WAIT_L(0); PG8_MMA(0, 1, At, B1); PG8_BAR;
            PG8_LDA(At, 1, 1); PG8_STAGE(PG8_SA(1, 0), a3, voffA);
            PG8_BAR; PG8_WAIT_L(0); PG8_MMA(1, 0, At, B0); PG8_BAR; PG8_SCHED;
            PG8_STAGE(PG8_SB(1, 1), b3 + hstep, voffB);
            PG8_WAIT_V(6); PG8_BAR; PG8_MMA(1, 1, At, B1); PG8_BAR;
            }
        }
        if constexpr (ALIGN_EPI) { if (wr == 0) PG8_BAR; }
        if constexpr (!Epi::AFTER_DRAIN) { E(acc, cur, wr, wc, fr, fq); S.done(cur); }
        if (!has_next) break;
#pragma unroll
        for (int a = 0; a < 2; ++a)
#pragma unroll
            for (int b = 0; b < 2; ++b)
#pragma unroll
                for (int m = 0; m < 4; ++m)
#pragma unroll
                    for (int n = 0; n < 2; ++n) acc[a][b][m][n] = (f32x4){0.f, 0.f, 0.f, 0.f};
        cur = nxt; cA = nA; cB = nB; ++ui;
        if constexpr (ALIGN_EPI) { if (wr == 1) PG8_BAR; }
    }
    PG8_WAIT_V(0);
    if constexpr (!ALIGN_EPI) { if (wr == 0) PG8_BAR; }
    PG8_BAR;
    if constexpr (Epi::AFTER_DRAIN) { E.fused(acc, cur, wr, wc, fr, fq, lds, wid, lane); S.done(cur); }
#undef PG8_SA
#undef PG8_SB
#undef PG8_STAGE
#undef PG8_LDA
#undef PG8_LDB
#undef PG8_MMA
#undef PG8_WAIT_V
#undef PG8_WAIT_L
#undef PG8_BAR
#undef PG8_SCHED
}
}
constexpr int NWAVES = 8;
#ifndef MK_N_LAUNCHES
#define MK_N_LAUNCHES 1
#endif
constexpr int PER_PHASE = 7;
constexpr int N_LAUNCHES = MK_N_LAUNCHES;

constexpr int NB = 4, SEQ = 8192, T = NB * SEQ, D = 1024, DIN = 1280, NEXP = 16384, DQ = 2048;
constexpr float EPS = 1e-6f;

constexpr size_t MiB = 1u << 20;
constexpr size_t WS_CTL = 0, CTL_ZERO_BYTES = 1 * MiB;
constexpr size_t WS_WIN = 2 * MiB;
constexpr size_t WS_WOUT = 5 * MiB;
constexpr size_t WS_WQ = 7 * MiB;
constexpr size_t WS_SK = 11 * MiB;
constexpr size_t WS_POOLT = 11 * MiB + 512 * 1024;
constexpr size_t WS_RSTD1 = 12 * MiB;
constexpr size_t WS_SS2 = 13 * MiB;
constexpr size_t WS_EXP = 16 * MiB;
constexpr size_t WS_BEST = 32 * MiB;
constexpr size_t WS_UB = 48 * MiB;
constexpr size_t WS_VB = 80 * MiB;
constexpr size_t WS_AB = 112 * MiB;
constexpr size_t WS_X1B = 176 * MiB;
constexpr size_t WS_XB = 240 * MiB;
constexpr size_t WS_Y = 304 * MiB;
constexpr size_t WS_QP = 240 * MiB;
constexpr size_t WS_END = 384 * MiB;
constexpr int CW_BAR = 4096;

constexpr int RING_OFF = 0, RING_BYTES = 131072;
constexpr int LDSCTL_OFF = RING_BYTES, MISC_OFF = LDSCTL_OFF + 320;
constexpr int LDS_BYTES = 147456;
#define GAS __attribute__((address_space(1)))
#define LAS __attribute__((address_space(3)))
typedef unsigned short bf16;
typedef unsigned v4u __attribute__((ext_vector_type(4)));
typedef float f32x4 __attribute__((ext_vector_type(4)));
typedef short bf16x8 __attribute__((ext_vector_type(8)));
typedef GAS unsigned gu32;
typedef GAS unsigned long long gu64;
#define RLX_AGENT __ATOMIC_RELAXED, __HIP_MEMORY_SCOPE_AGENT
#define LDS_WAIT() asm volatile("s_waitcnt lgkmcnt(0)" ::: "memory")
#define VM_WAIT() asm volatile("s_waitcnt vmcnt(0)" ::: "memory")
__device__ __forceinline__ unsigned long long rt() { return __builtin_amdgcn_s_memrealtime(); }
__device__ __forceinline__ unsigned f2bf(float f) { unsigned u = __builtin_bit_cast(unsigned, f); return (u + 0x7fffu + ((u >> 16) & 1u)) >> 16; }
__device__ __forceinline__ unsigned pk2(float lo, float hi) { return f2bf(lo) | (f2bf(hi) << 16); }
#define XB_TMO      128
#define XB_XCNT(j)  (256  + 64 * (j))
#define XB_XSUB(j)  (1280 + 64 * (j))
#define XB_XGEN(j)  (2304 + 64 * (j))
#define XB_TOP      3328
#define XB_TOPGEN   3392
#define XCD_BAR_WORDS 3456
#define XB_SPIN_CAP (1u << 18)

__device__ __forceinline__ unsigned xb_ld(unsigned* p)              { return __hip_atomic_load(p, __ATOMIC_RELAXED, __HIP_MEMORY_SCOPE_AGENT); }
__device__ __forceinline__ unsigned xb_add(unsigned* p, unsigned v) { return __hip_atomic_fetch_add(p, v, __ATOMIC_RELAXED, __HIP_MEMORY_SCOPE_AGENT); }
__device__ __forceinline__ unsigned xb_xcc_id() { return (unsigned)__builtin_amdgcn_s_getreg((3 << 11) | 20) & 0xFu; }
#define XB_SPIN(cond, bar) do { unsigned _sp = 0; while (cond) { __builtin_amdgcn_s_sleep(1); \
    if ((++_sp & 255u) == 0u) { if (xb_ld(&(bar)[XB_TMO])) break; if (_sp > XB_SPIN_CAP) { atomicAdd(&(bar)[XB_TMO], 1u); break; } } } } while (0)

struct XcdBarrier {
    unsigned* bar; unsigned x;
    volatile LAS unsigned* st;
};

__device__ __forceinline__ XcdBarrier xcd_barrier_post(unsigned* bar, volatile LAS unsigned* st) {
    XcdBarrier b; b.bar = bar; b.x = xb_xcc_id(); b.st = st;
    if (threadIdx.x == 0) (void)xb_add(&bar[XB_XCNT(b.x)], 1u);
    return b;
}
__device__ __forceinline__ void xcd_barrier_complete(unsigned* bar, unsigned x, unsigned& nloc, unsigned& nx) {
    const unsigned G = gridDim.x * gridDim.y * gridDim.z;
    unsigned sum, cnt, mine, sp = 0u;
    for (;;) {
        sum = 0u; cnt = 0u; mine = 0u;
#pragma unroll
        for (unsigned j = 0; j < 16; ++j) { const unsigned c = xb_ld(&bar[XB_XCNT(j)]); sum += c; cnt += (c > 0u) ? 1u : 0u; mine = (j == x) ? c : mine; }
        if (sum == G) break;
        __builtin_amdgcn_s_sleep(1);
        if ((++sp & 255u) == 0u) { if (xb_ld(&bar[XB_TMO])) break; if (sp > XB_SPIN_CAP) { atomicAdd(&bar[XB_TMO], 1u); break; } }
    }
    nloc = mine > 0u ? mine : 1u; nx = cnt > 0u ? cnt : 1u;
}

__device__ __forceinline__ void xcd_barrier(const XcdBarrier& b) {
    asm volatile("s_waitcnt vmcnt(0)" ::: "memory");
    __syncthreads();
    if (threadIdx.x == 0) {
        unsigned* bar = b.bar;
        __builtin_amdgcn_s_waitcnt(0);
        unsigned nloc = b.st[0], nx = b.st[1];
        if (nloc == 0u) { xcd_barrier_complete(bar, b.x, nloc, nx); b.st[0] = nloc; b.st[1] = nx; }
        const unsigned old = xb_add(&bar[XB_XSUB(b.x)], 1u);
        const unsigned gen = old / nloc;
        if (old + 1u == (gen + 1u) * nloc) {
            __builtin_amdgcn_fence(__ATOMIC_RELEASE, "agent");
            asm volatile("s_waitcnt vmcnt(0)" ::: "memory");
            const unsigned og = xb_add(&bar[XB_TOP], 1u);
            const unsigned tg = og / nx;
            if (og + 1u == (tg + 1u) * nx) xb_add(&bar[XB_TOPGEN], 1u);
            else XB_SPIN(xb_ld(&bar[XB_TOPGEN]) == tg, bar);
            __builtin_amdgcn_fence(__ATOMIC_ACQUIRE, "agent");
            xb_add(&bar[XB_XGEN(b.x)], 1u);
            asm volatile("s_waitcnt vmcnt(0)" ::: "memory");
        } else {
            XB_SPIN(xb_ld(&bar[XB_XGEN(b.x)]) == gen, bar);
            __builtin_amdgcn_fence(__ATOMIC_ACQUIRE, "agent");
            asm volatile("s_waitcnt vmcnt(0)" ::: "memory");
        }
    }
    __syncthreads();
}
typedef float f32x16 __attribute__((ext_vector_type(16)));
typedef __bf16 bf16x2_t __attribute__((ext_vector_type(2)));
#define MFMA32(a, b, c) __builtin_amdgcn_mfma_f32_32x32x16_bf16((a), (b), (c), 0, 0, 0)
__device__ __forceinline__ float bf_lo(unsigned u) { return __builtin_bit_cast(float, u << 16); }
__device__ __forceinline__ float bf_hi(unsigned u) { return __builtin_bit_cast(float, u & 0xffff0000u); }
__device__ __forceinline__ float dot2_bf16(unsigned w, unsigned x, float acc) { return __builtin_amdgcn_fdot2_f32_bf16(__builtin_bit_cast(bf16x2_t, w), __builtin_bit_cast(bf16x2_t, x), acc, false); }
__device__ __forceinline__ float wave_sum(float v) {
#pragma unroll
    for (int o = 1; o < 64; o <<= 1) v += __shfl_xor(v, o);
    return v;
}

__device__ __forceinline__ void p0_transpose_item(const float* W, int K, int N, bf16* WT, const float* gk, LAS float* scr, int item, int lane) {
    const int nblk = N / 32, kb = item / nblk, nb = item % nblk, k0 = 64 * kb, n0 = 32 * nb;
#pragma unroll 8
    for (int i = 0; i < 32; ++i) { const int kk = 2 * i + (lane >> 5); float w = W[(size_t)(k0 + kk) * N + n0 + (lane & 31)]; if (gk) w *= gk[k0 + kk]; scr[kk * 33 + (lane & 31)] = w; }
    LDS_WAIT(); asm volatile("" ::: "memory");
    const int c = lane & 7;
#pragma unroll
    for (int j = 0; j < 4; ++j) { const int n = (lane >> 3) + 8 * j; const LAS float* s = scr + (8 * c) * 33 + n;
        v4u o; o.x = pk2(s[0 * 33], s[1 * 33]); o.y = pk2(s[2 * 33], s[3 * 33]); o.z = pk2(s[4 * 33], s[5 * 33]); o.w = pk2(s[6 * 33], s[7 * 33]);
        *(GAS v4u*)(WT + (size_t)(n0 + n) * K + k0 + 8 * c) = o; }
    LDS_WAIT(); asm volatile("" ::: "memory");
}
__device__ __forceinline__ float row_to_bf16(const float* src, bf16* dst, const float* g, int lane) {
    const GAS f32x4* xr = (const GAS f32x4*)src + lane; float s = 0.f;
    GAS unsigned long long* o8 = (GAS unsigned long long*)dst + lane;
#pragma unroll
    for (int j = 0; j < 4; ++j) { f32x4 v = xr[64 * j]; s += (v.x * v.x + v.y * v.y) + (v.z * v.z + v.w * v.w);
        if (g) { const f32x4 gv = ((const GAS f32x4*)g)[64 * j + lane]; v = v * gv; }
        o8[64 * j] = (unsigned long long)pk2(v.x, v.y) | ((unsigned long long)pk2(v.z, v.w) << 32); }
    return s;
}
struct P0Args { const float *x, *g1, *w_in, *pool_w, *w_out, *g2, *wq, *sk, *u, *v; bf16 *XB, *WinT, *WoutT, *WqT, *SK, *PoolT, *UB, *VB; float* rstd1; };
__device__ __forceinline__ void p0_prologue(const P0Args& a, LAS unsigned char* lds, int gw, int NGW, int wave, int lane) {
    LAS float* scr = (LAS float*)(lds + RING_OFF + wave * 16384);
    constexpr int I_IN = (D / 64) * (DIN / 32), I_OUT = (D / 64) * (D / 32), I_Q = (D / 64) * (DQ / 32), I_P = 4 * 2 * 4;
    constexpr int NITEMS = I_IN + I_OUT + I_Q + I_P;
    for (int it = gw; it < NITEMS; it += NGW) {
        int r = it;
        if (r < I_IN) { p0_transpose_item(a.w_in, D, DIN, a.WinT, a.g1, scr, r, lane); continue; } r -= I_IN;
        if (r < I_OUT) { p0_transpose_item(a.w_out, D, D, a.WoutT, nullptr, scr, r, lane); continue; } r -= I_OUT;
        if (r < I_Q) { p0_transpose_item(a.wq, D, DQ, a.WqT, a.g2, scr, r, lane); continue; } r -= I_Q;
        { const int g = r >> 3; p0_transpose_item(a.pool_w + (size_t)g * 16384, 128, 128, a.PoolT + (size_t)g * 16384, nullptr, scr, r & 7, lane); }
    }
    for (int m = gw; m < T; m += NGW) {
        const float s = wave_sum(row_to_bf16(a.x + (size_t)m * D, a.XB + (size_t)m * D, nullptr, lane));
        if (lane == 0) a.rstd1[m] = 1.0f / sqrtf(s * (1.0f / D) + EPS);
    }
    for (int m = gw; m < NEXP; m += NGW) {
        (void)row_to_bf16(a.u + (size_t)m * D, a.UB + (size_t)m * D, a.g2, lane);
        (void)row_to_bf16(a.v + (size_t)m * D, a.VB + (size_t)m * D, nullptr, lane);
    }
    for (int m = gw; m < 256; m += NGW) (void)row_to_bf16(a.sk + (size_t)m * D, a.SK + (size_t)m * D, nullptr, lane);
}

__device__ __forceinline__ int t5_bucket(int rel) {
    const int n = rel < 0 ? -rel : rel; const int base = rel > 0 ? 16 : 0;
    const int v = n < 8 ? n : (n < 12 ? 8 : (n < 16 ? 9 : (n < 23 ? 10 : (n < 32 ? 11 : (n < 46 ? 12 : (n < 64 ? 13 : (n < 91 ? 14 : 15)))))));
    return base + v;
}
__device__ __forceinline__ void attn_unit(LAS unsigned char* lds, const bf16* Y, bf16* AB, const float* qg, const float* kg, const float* sinks, const float* relb,
                                          int unit, int tid, int wave, int lane) {
    const int kvh = unit & 1, c = (unit >> 1) & 127, b = unit >> 8;
    LAS bf16* Ks = (LAS bf16*)lds;
    LAS bf16* Vt = (LAS bf16*)(lds + 27648);
    LAS float* bt = (LAS float*)(lds + 53248);
    const int row0 = b * SEQ + (c - 2) * 64;
#pragma unroll
    for (int rep = 0; rep < 3; ++rep) {
        const int it = tid + rep * 512, j = it >> 3, ch = it & 7;
        const bool valid = (c - 2 + (j >> 6)) >= 0;
        v4u kraw = {0u, 0u, 0u, 0u}, vraw = {0u, 0u, 0u, 0u};
        if (valid) { const bf16* rp = Y + (size_t)(row0 + j) * DIN; kraw = *(const GAS v4u*)(rp + 512 + 64 * kvh + 8 * ch); vraw = *(const GAS v4u*)(rp + 640 + 64 * kvh + 8 * ch); }
        float kf[8] = {bf_lo(kraw.x), bf_hi(kraw.x), bf_lo(kraw.y), bf_hi(kraw.y), bf_lo(kraw.z), bf_hi(kraw.z), bf_lo(kraw.w), bf_hi(kraw.w)};
        float ss = 0.f;
#pragma unroll
        for (int e = 0; e < 8; ++e) ss += kf[e] * kf[e];
        ss += __shfl_xor(ss, 1); ss += __shfl_xor(ss, 2); ss += __shfl_xor(ss, 4);
        const float r = 1.0f / sqrtf(ss * (1.0f / 64.0f) + EPS);
        const f32x4 g0 = *(const GAS f32x4*)(kg + 8 * ch), g1 = *(const GAS f32x4*)(kg + 8 * ch + 4);
        v4u ko; ko.x = pk2(kf[0] * r * g0.x, kf[1] * r * g0.y); ko.y = pk2(kf[2] * r * g0.z, kf[3] * r * g0.w); ko.z = pk2(kf[4] * r * g1.x, kf[5] * r * g1.y); ko.w = pk2(kf[6] * r * g1.z, kf[7] * r * g1.w);
        *(LAS v4u*)(Ks + j * 72 + 8 * ch) = ko;
        const int s16 = j >> 4, kk = j & 15, hh = (kk >> 2) & 1, jj = ((kk >> 3) << 2) | (kk & 3), pos = 16 * s16 + 8 * hh + jj;
        LAS bf16* vp = Vt + (8 * ch) * 200 + pos;
        vp[0 * 200] = (bf16)(vraw.x & 0xffffu); vp[1 * 200] = (bf16)(vraw.x >> 16); vp[2 * 200] = (bf16)(vraw.y & 0xffffu); vp[3 * 200] = (bf16)(vraw.y >> 16);
        vp[4 * 200] = (bf16)(vraw.z & 0xffffu); vp[5 * 200] = (bf16)(vraw.z >> 16); vp[6 * 200] = (bf16)(vraw.w & 0xffffu); vp[7 * 200] = (bf16)(vraw.w >> 16);
    }
#pragma unroll
    for (int rep = 0; rep < 2; ++rep) { const int it = tid + rep * 512, g = it >> 8, r = it & 255; bt[it] = relb[t5_bucket(r - 191) * 8 + kvh * 4 + g]; }
    LDS_WAIT(); __syncthreads();

    const int g = wave >> 1, i = 32 * (wave & 1) + (lane & 31), hh = lane >> 5, habs = kvh * 4 + g;
    const size_t qrow = (size_t)b * SEQ + (size_t)c * 64 + i;
    const bf16* qp = Y + qrow * DIN + habs * 64 + 8 * hh;
    v4u qraw[4]; float ss = 0.f;
#pragma unroll
    for (int s = 0; s < 4; ++s) { qraw[s] = *(const GAS v4u*)(qp + 16 * s);
        const float f0 = bf_lo(qraw[s].x), f1 = bf_hi(qraw[s].x), f2 = bf_lo(qraw[s].y), f3 = bf_hi(qraw[s].y), f4 = bf_lo(qraw[s].z), f5 = bf_hi(qraw[s].z), f6 = bf_lo(qraw[s].w), f7 = bf_hi(qraw[s].w);
        ss += (f0 * f0 + f1 * f1) + (f2 * f2 + f3 * f3) + (f4 * f4 + f5 * f5) + (f6 * f6 + f7 * f7); }
    ss += __shfl_xor(ss, 32);
    const float rq = 0.125f / sqrtf(ss * (1.0f / 64.0f) + EPS);
    bf16x8 qf[4];
#pragma unroll
    for (int s = 0; s < 4; ++s) { const f32x4 g0 = *(const GAS f32x4*)(qg + 16 * s + 8 * hh), g1 = *(const GAS f32x4*)(qg + 16 * s + 8 * hh + 4);
        v4u w; w.x = pk2(bf_lo(qraw[s].x) * rq * g0.x, bf_hi(qraw[s].x) * rq * g0.y); w.y = pk2(bf_lo(qraw[s].y) * rq * g0.z, bf_hi(qraw[s].y) * rq * g0.w);
        w.z = pk2(bf_lo(qraw[s].z) * rq * g1.x, bf_hi(qraw[s].z) * rq * g1.y); w.w = pk2(bf_lo(qraw[s].w) * rq * g1.z, bf_hi(qraw[s].w) * rq * g1.w);
        qf[s] = __builtin_bit_cast(bf16x8, w); }
    f32x16 sacc[6];
#pragma unroll
    for (int kt = 0; kt < 6; ++kt) {
#pragma unroll
        for (int r = 0; r < 16; ++r) sacc[kt][r] = 0.f;
#pragma unroll
        for (int s = 0; s < 4; ++s) { const bf16x8 a = *(const LAS bf16x8*)(Ks + (32 * kt + (lane & 31)) * 72 + 16 * s + 8 * hh); sacc[kt] = MFMA32(a, qf[s], sacc[kt]); }
    }
    const LAS float* btg = bt + g * 256 + 63 - i;
    float mx = -3.0e38f;
#pragma unroll
    for (int kt = 0; kt < 6; ++kt) { const bool masked = (c - 2 + (kt >> 1)) < 0;
#pragma unroll
        for (int r = 0; r < 16; ++r) { const int j = 32 * kt + (r & 3) + 8 * (r >> 2) + 4 * hh; float v = sacc[kt][r] + btg[j]; v = masked ? -1.0e30f : v; sacc[kt][r] = v; mx = fmaxf(mx, v); } }
    mx = fmaxf(mx, __shfl_xor(mx, 32));
    const float sink = sinks[habs], m = fmaxf(mx, sink);
    float sum = 0.f;
#pragma unroll
    for (int kt = 0; kt < 6; ++kt)
#pragma unroll
        for (int r = 0; r < 16; ++r) { const float p = __expf(sacc[kt][r] - m); sacc[kt][r] = p; sum += p; }
    sum += __shfl_xor(sum, 32);
    const float inv = 1.0f / (sum + __expf(sink - m));
    f32x16 oacc[2];
#pragma unroll
    for (int dt = 0; dt < 2; ++dt)
#pragma unroll
        for (int r = 0; r < 16; ++r) oacc[dt][r] = 0.f;
#pragma unroll
    for (int kt = 0; kt < 6; ++kt)
#pragma unroll
        for (int s2 = 0; s2 < 2; ++s2) {
            v4u w; w.x = pk2(sacc[kt][8 * s2 + 0], sacc[kt][8 * s2 + 1]); w.y = pk2(sacc[kt][8 * s2 + 2], sacc[kt][8 * s2 + 3]); w.z = pk2(sacc[kt][8 * s2 + 4], sacc[kt][8 * s2 + 5]); w.w = pk2(sacc[kt][8 * s2 + 6], sacc[kt][8 * s2 + 7]);
            const bf16x8 pb = __builtin_bit_cast(bf16x8, w);
#pragma unroll
            for (int dt = 0; dt < 2; ++dt) { const bf16x8 a = *(const LAS bf16x8*)(Vt + (32 * dt + (lane & 31)) * 200 + 32 * kt + 16 * s2 + 8 * hh); oacc[dt] = MFMA32(a, pb, oacc[dt]); }
        }
    bf16* op = AB + qrow * D + habs * 64;
#pragma unroll
    for (int dt = 0; dt < 2; ++dt)
#pragma unroll
        for (int q4 = 0; q4 < 4; ++q4) { const int d = 32 * dt + 8 * q4 + 4 * hh;
            const unsigned long long o = (unsigned long long)pk2(oacc[dt][4 * q4 + 0] * inv, oacc[dt][4 * q4 + 1] * inv) | ((unsigned long long)pk2(oacc[dt][4 * q4 + 2] * inv, oacc[dt][4 * q4 + 3] * inv) << 32);
            *(GAS unsigned long long*)(op + d) = o; }
    __syncthreads();
}

__device__ __forceinline__ void pool_unit(LAS unsigned char* lds, const bf16* Y, bf16* AB, const bf16* PoolT, const float* pscale, int unit, int tid, int wave, int lane) {
    const int g = unit & 3, tt = unit >> 2, w = 2 << g;
    LAS bf16* dt_ = (LAS bf16*)lds;
    {
        const int cp = tid & 63, rs = tid >> 6;
        const int r0 = tt * 256 + rs * 32, pos0 = r0 & (SEQ - 1);
        const bf16* colp = Y + 768 + 128 * g + 2 * cp;
        for (int k = 0; k < 32; ++k) {
            const int pos = pos0 + k; const int cnt = pos + 1 < w ? pos + 1 : w;
            float s0 = 0.f, s1 = 0.f, c0 = 0.f, c1 = 0.f;
            for (int q = 0; q < cnt; ++q) { const unsigned u = *(const GAS unsigned*)(colp + (size_t)(r0 + k - q) * DIN); const float a0 = bf_lo(u), a1 = bf_hi(u); s0 += a0; s1 += a1; if (q == 0) { c0 = a0; c1 = a1; } }
            const float ic = 1.0f / (float)cnt;
            *(LAS unsigned*)(dt_ + (rs * 32 + k) * 136 + 2 * cp) = pk2(s0 * ic - c0, s1 * ic - c1);
        }
    }
    LDS_WAIT(); __syncthreads();
    const int hh = lane >> 5, tok = 32 * wave + (lane & 31);
    f32x16 acc[4];
#pragma unroll
    for (int nt = 0; nt < 4; ++nt)
#pragma unroll
        for (int r = 0; r < 16; ++r) acc[nt][r] = 0.f;
    const bf16* pw = PoolT + (size_t)g * 16384 + (size_t)(lane & 31) * 128 + 8 * hh;
#pragma unroll
    for (int s = 0; s < 8; ++s) {
        const bf16x8 bfr = *(const LAS bf16x8*)(dt_ + tok * 136 + 16 * s + 8 * hh);
#pragma unroll
        for (int nt = 0; nt < 4; ++nt) { const bf16x8 a = __builtin_bit_cast(bf16x8, *(const GAS v4u*)(pw + (size_t)nt * 32 * 128 + 16 * s)); acc[nt] = MFMA32(a, bfr, acc[nt]); }
    }
    bf16* op = AB + (size_t)(tt * 256 + tok) * D + 512 + 128 * g;
#pragma unroll
    for (int nt = 0; nt < 4; ++nt)
#pragma unroll
        for (int q4 = 0; q4 < 4; ++q4) { const int dd = 32 * nt + 8 * q4 + 4 * hh; const f32x4 sc = *(const GAS f32x4*)(pscale + 128 * g + dd);
            const unsigned long long o = (unsigned long long)pk2(acc[nt][4 * q4 + 0] * sc.x, acc[nt][4 * q4 + 1] * sc.y) | ((unsigned long long)pk2(acc[nt][4 * q4 + 2] * sc.z, acc[nt][4 * q4 + 3] * sc.w) << 32);
            *(GAS unsigned long long*)(op + dd) = o; }
    __syncthreads();
}

__device__ __forceinline__ int f2key(float f) { int i = __builtin_bit_cast(int, f); return i ^ ((i >> 31) & 0x7fffffff); }
__device__ __forceinline__ float key2f(int k) { return __builtin_bit_cast(float, k ^ ((k >> 31) & 0x7fffffff)); }
#define CE_DESC(a, b) do { const int _x = (a), _y = (b); (a) = _x > _y ? _x : _y; (b) = _x > _y ? _y : _x; } while (0)
__device__ __forceinline__ void sort16_desc(int (&a)[16]) {
#pragma unroll
    for (int k = 2; k <= 16; k <<= 1)
#pragma unroll
        for (int j = k >> 1; j > 0; j >>= 1)
#pragma unroll
            for (int i = 0; i < 16; ++i) { const int l = i ^ j; if (l > i) { if ((i & k) == 0) CE_DESC(a[i], a[l]); else CE_DESC(a[l], a[i]); } }
}
__device__ __forceinline__ void merge_top16(int (&a)[16], const int (&b)[16]) {
#pragma unroll
    for (int i = 0; i < 16; ++i) a[i] = a[i] > b[15 - i] ? a[i] : b[15 - i];
#pragma unroll
    for (int j = 8; j > 0; j >>= 1)
#pragma unroll
        for (int i = 0; i < 16; ++i) { const int l = i ^ j; if (l > i) CE_DESC(a[i], a[l]); }
}
__device__ __forceinline__ void top16_of_64(int (&g0)[16], int (&g1)[16], int (&g2)[16], int (&g3)[16]) {
    sort16_desc(g0); sort16_desc(g1); sort16_desc(g2); sort16_desc(g3);
    merge_top16(g0, g1); merge_top16(g2, g3); merge_top16(g0, g2);
}
__device__ __forceinline__ void topk_unit(LAS unsigned char* lds, const bf16* QP, const bf16* SK, int* EXPERTS, float* BEST, int unit, int tid, int wave, int lane) {
    const int h = unit & 7, tt = unit >> 3, hh = lane >> 5;
    const int tok = tt * 256 + wave * 32 + (lane & 31);
    LAS int* mine = (LAS int*)lds + tid * 33;
    int top[2][16];
#pragma unroll
    for (int p = 0; p < 2; ++p) {
        const bf16* qp = QP + (size_t)tok * DQ + h * 256 + p * 128 + 8 * hh;
        const bf16* kp = SK + (size_t)(h * 2 + p) * 16384 + (size_t)(lane & 31) * 128 + 8 * hh;
        f32x16 acc[4];
#pragma unroll
        for (int nt = 0; nt < 4; ++nt)
#pragma unroll
            for (int r = 0; r < 16; ++r) acc[nt][r] = 0.f;
#pragma unroll
        for (int s = 0; s < 8; ++s) { const bf16x8 bq = __builtin_bit_cast(bf16x8, *(const GAS v4u*)(qp + 16 * s));
#pragma unroll
            for (int nt = 0; nt < 4; ++nt) { const bf16x8 a = __builtin_bit_cast(bf16x8, *(const GAS v4u*)(kp + (size_t)nt * 32 * 128 + 16 * s)); acc[nt] = MFMA32(a, bq, acc[nt]); } }
        int k0[16], k1[16], k2[16], k3[16];
#pragma unroll
        for (int r = 0; r < 16; ++r) { const int n = (r & 3) + 8 * (r >> 2) + 4 * hh;
            k0[r] = (f2key(acc[0][r]) & ~127) | n; k1[r] = (f2key(acc[1][r]) & ~127) | (32 + n); k2[r] = (f2key(acc[2][r]) & ~127) | (64 + n); k3[r] = (f2key(acc[3][r]) & ~127) | (96 + n); }
        top16_of_64(k0, k1, k2, k3);
#pragma unroll
        for (int r = 0; r < 16; ++r) k1[r] = __shfl_xor(k0[r], 32);
        merge_top16(k0, k1);
#pragma unroll
        for (int r = 0; r < 16; ++r) top[p][r] = k0[r];
    }
    int c0[16], c1[16], c2[16], c3[16];
    {
        float v1[16], v2[16];
#pragma unroll
        for (int r = 0; r < 16; ++r) { v1[r] = key2f(top[0][r] & ~127); v2[r] = key2f(top[1][r] & ~127); mine[r] = top[0][r]; mine[16 + r] = top[1][r]; }
        int cnt = 0;
#pragma unroll
        for (int i = 0; i < 16; ++i)
#pragma unroll
            for (int j = 0; j < 16; ++j) if ((i + 1) * (j + 1) <= 16) { const int key = (f2key(v1[i] + v2[j]) & ~255) | (i << 4) | j;
                if (cnt < 16) c0[cnt] = key; else if (cnt < 32) c1[cnt - 16] = key; else if (cnt < 48) c2[cnt - 32] = key; else c3[cnt - 48] = key; ++cnt; }
#pragma unroll
        for (int r = 0; r < 16; ++r) if (48 + r >= cnt) c3[r] = (int)0x80000000;
    }
    top16_of_64(c0, c1, c2, c3);
    LDS_WAIT();
    if (hh == 0) {
        int ev[16]; float bv[16];
#pragma unroll
        for (int r = 0; r < 16; ++r) { const int id = c0[r] & 255; const int ka = mine[id >> 4], kb = mine[16 + (id & 15)];
            ev[r] = (ka & 127) * 128 + (kb & 127); bv[r] = key2f(ka & ~127) + key2f(kb & ~127); }
        int* ep = EXPERTS + (size_t)tok * 128 + h * 16; float* bp = BEST + (size_t)tok * 128 + h * 16;
#pragma unroll
        for (int r = 0; r < 16; r += 4) { *(GAS v4u*)(ep + r) = (v4u){(unsigned)ev[r], (unsigned)ev[r + 1], (unsigned)ev[r + 2], (unsigned)ev[r + 3]}; *(GAS f32x4*)(bp + r) = (f32x4){bv[r], bv[r + 1], bv[r + 2], bv[r + 3]}; }
    }
    LDS_WAIT();
}

__device__ __forceinline__ float gelu_erf(float x) { return 0.5f * x * (1.0f + erff(x * 0.70710678118654752f)); }
__device__ __forceinline__ void peer_token(const bf16* X1B, const bf16* UB, const bf16* VB, const int* EXPERTS, const float* BEST, const float* SS2, float* OUT, int t, int lane) {
    const bf16* xr = X1B + (size_t)t * D + 8 * lane;
    const v4u xa = *(const GAS v4u*)xr, xb = *(const GAS v4u*)(xr + 512);
    float ssq = 0.f;
    { const GAS f32x4* sp = (const GAS f32x4*)(SS2 + (size_t)t * 16);
#pragma unroll
      for (int q = 0; q < 4; ++q) { const f32x4 v = sp[q]; ssq += (v.x + v.y) + (v.z + v.w); } }
    const float rstd2 = 1.0f / sqrtf(ssq * (1.0f / D) + EPS);
    int e[2]; float c[2];
#pragma unroll
    for (int hf = 0; hf < 2; ++hf) {
        e[hf] = EXPERTS[(size_t)t * 128 + 64 * hf + lane];
        const float sb = BEST[(size_t)t * 128 + 64 * hf + lane] * rstd2;
        float mx = sb;
#pragma unroll
        for (int o = 1; o < 16; o <<= 1) mx = fmaxf(mx, __shfl_xor(mx, o));
        const float ex = __expf(sb - mx); float sm = ex;
#pragma unroll
        for (int o = 1; o < 16; o <<= 1) sm += __shfl_xor(sm, o);
        const float gate = ex / sm;
        float part[64];
#pragma unroll
        for (int k = 0; k < 64; ++k) { const int ek = __builtin_amdgcn_readlane(e[hf], k); const bf16* ur = UB + (size_t)ek * D + 8 * lane;
            const v4u ua = *(const GAS v4u*)ur, ub = *(const GAS v4u*)(ur + 512);
            float a0 = dot2_bf16(ua.x, xa.x, 0.f), a1 = dot2_bf16(ua.y, xa.y, 0.f); a0 = dot2_bf16(ua.z, xa.z, a0); a1 = dot2_bf16(ua.w, xa.w, a1);
            a0 = dot2_bf16(ub.x, xb.x, a0); a1 = dot2_bf16(ub.y, xb.y, a1); a0 = dot2_bf16(ub.z, xb.z, a0); a1 = dot2_bf16(ub.w, xb.w, a1);
            part[k] = a0 + a1; }
#pragma unroll
        for (int o = 32; o > 0; o >>= 1) { const bool up = (lane & o) != 0;
#pragma unroll
            for (int i2 = 0; i2 < o; ++i2) { const float keep = up ? part[i2 + o] : part[i2], send = up ? part[i2] : part[i2 + o]; part[i2] = keep + __shfl_xor(send, o); } }
        c[hf] = gate * gelu_erf(part[0] * rstd2);
    }
    float* orow = OUT + (size_t)t * D + 8 * lane;
    f32x4 o0 = *(const GAS f32x4*)orow, o1 = *(const GAS f32x4*)(orow + 4), o2 = *(const GAS f32x4*)(orow + 512), o3 = *(const GAS f32x4*)(orow + 516);
#pragma unroll
    for (int hf = 0; hf < 2; ++hf)
#pragma unroll
        for (int k = 0; k < 64; ++k) { const int ek = __builtin_amdgcn_readlane(e[hf], k); const float ck = __builtin_bit_cast(float, __builtin_amdgcn_readlane(__builtin_bit_cast(int, c[hf]), k));
            const bf16* vr = VB + (size_t)ek * D + 8 * lane; const v4u va = *(const GAS v4u*)vr, vb = *(const GAS v4u*)(vr + 512);
            o0.x += ck * bf_lo(va.x); o0.y += ck * bf_hi(va.x); o0.z += ck * bf_lo(va.y); o0.w += ck * bf_hi(va.y);
            o1.x += ck * bf_lo(va.z); o1.y += ck * bf_hi(va.z); o1.z += ck * bf_lo(va.w); o1.w += ck * bf_hi(va.w);
            o2.x += ck * bf_lo(vb.x); o2.y += ck * bf_hi(vb.x); o2.z += ck * bf_lo(vb.y); o2.w += ck * bf_hi(vb.y);
            o3.x += ck * bf_lo(vb.z); o3.y += ck * bf_hi(vb.z); o3.z += ck * bf_lo(vb.w); o3.w += ck * bf_hi(vb.w); }
    *(GAS f32x4*)orow = o0; *(GAS f32x4*)(orow + 4) = o1; *(GAS f32x4*)(orow + 512) = o2; *(GAS f32x4*)(orow + 516) = o3;
}
struct Args { const float* in[15]; float* out; unsigned char* ws; int ph_lo, ph_hi, li, pad; };
__global__ void __launch_bounds__(NWAVES * 64, 2) fwd_kernel(Args args) {
    extern __shared__ __attribute__((aligned(16))) unsigned char lds_raw[];
    LAS unsigned char* lds = (LAS unsigned char*)lds_raw;
    volatile LAS unsigned* MISC = (volatile LAS unsigned*)(lds + MISC_OFF);
    const int tid = threadIdx.x, lane = tid & 63, wave = __builtin_amdgcn_readfirstlane(tid >> 6);
    const int G = gridDim.x, bx = blockIdx.x;
    unsigned char* ws = args.ws;
    gu32* ctl = (gu32*)(ws + WS_CTL);
    for (int u = tid; u < (LDS_BYTES - LDSCTL_OFF) / 4; u += NWAVES * 64) ((LAS unsigned*)(lds + LDSCTL_OFF))[u] = 0u;
    __syncthreads();
    XcdBarrier bar; bar.bar = (unsigned*)(ctl + CW_BAR); bar.x = 0; bar.st = nullptr;
    if (N_LAUNCHES != PER_PHASE) bar = xcd_barrier_post((unsigned*)(ctl + CW_BAR) + args.li * XCD_BAR_WORDS, MISC + 8);
#define GRID_BAR() do { if (N_LAUNCHES != PER_PHASE) xcd_barrier(bar); } while (0)
    const int lo = args.ph_lo, hi = args.ph_hi;
#define IN(k) (lo <= (k) && (k) < hi)
#define BOTH(k) (IN(k) && IN((k) + 1))

    const float* x = args.in[0]; float* out = args.out;
    bf16* XB = (bf16*)(ws + WS_XB); bf16* WinT = (bf16*)(ws + WS_WIN); bf16* WoutT = (bf16*)(ws + WS_WOUT); bf16* WqT = (bf16*)(ws + WS_WQ);
    bf16* SK = (bf16*)(ws + WS_SK); bf16* PoolT = (bf16*)(ws + WS_POOLT); bf16* UB = (bf16*)(ws + WS_UB); bf16* VB = (bf16*)(ws + WS_VB);
    bf16* Y = (bf16*)(ws + WS_Y); bf16* AB = (bf16*)(ws + WS_AB); bf16* X1B = (bf16*)(ws + WS_X1B); bf16* QP = (bf16*)(ws + WS_QP);
    float* rstd1 = (float*)(ws + WS_RSTD1); float* SS2 = (float*)(ws + WS_SS2); int* EXPERTS = (int*)(ws + WS_EXP); float* BEST = (float*)(ws + WS_BEST);
    const int gw = bx * NWAVES + wave, NGW = G * NWAVES;

    if (IN(0)) {
        P0Args a{x, args.in[1], args.in[2], args.in[7], args.in[9], args.in[10], args.in[11], args.in[12], args.in[13], args.in[14], XB, WinT, WoutT, WqT, SK, PoolT, UB, VB, rstd1};
        p0_prologue(a, lds, gw, NGW, wave, lane);
        if (BOTH(0)) GRID_BAR();
    }
    if (IN(1)) {
        pg8::Gemm g{XB, WinT, T, DIN, D}; pg8::StaticOrder S; S.init(T, DIN, G, bx);
        pg8::EpiScaleBf16 E{Y, DIN, rstd1};
        pg8::gemm_phase<pg8::EpiScaleBf16, pg8::StaticOrder, true, true>(lds + RING_OFF, g, S, E);
        if (BOTH(1)) GRID_BAR();
    }
    if (IN(2)) {
        for (int u = bx; u < NB * 128 * 2; u += G) attn_unit(lds, Y, AB, args.in[3], args.in[4], args.in[5], args.in[6], u, tid, wave, lane);
        for (int u = bx; u < (T / 256) * 4; u += G) pool_unit(lds, Y, AB, PoolT, args.in[8], u, tid, wave, lane);
        if (BOTH(2)) GRID_BAR();
    }
    if (IN(3)) {
        pg8::Gemm g{AB, WoutT, T, D, D}; pg8::StaticOrder S; S.init(T, D, G, bx);
        pg8::EpiResid E{x, out, X1B, SS2, D};
        pg8::gemm_phase<pg8::EpiResid, pg8::StaticOrder, true, true>(lds + RING_OFF, g, S, E);
        if (BOTH(3)) GRID_BAR();
    }
    if (IN(4)) {
        pg8::Gemm g{X1B, WqT, T, DQ, D}; pg8::StaticOrder S; S.init(T, DQ, G, bx);
        pg8::EpiScaleBf16 E{QP, DQ, nullptr};
        pg8::gemm_phase<pg8::EpiScaleBf16, pg8::StaticOrder, true, true>(lds + RING_OFF, g, S, E);
        if (BOTH(4)) GRID_BAR();
    }
    if (IN(5)) {
        for (int u = bx; u < (T / 256) * 8; u += G) topk_unit(lds, QP, SK, EXPERTS, BEST, u, tid, wave, lane);
        if (BOTH(5)) GRID_BAR();
    }
    if (IN(6)) {
        for (int t = gw; t < T; t += NGW) peer_token(X1B, UB, VB, EXPERTS, BEST, SS2, out, t, lane);
    }
#undef IN
#undef BOTH
}

extern "C" void kernel_launch(void* const* d_in, const int* in_sizes, int n_in, void* d_out, int out_size, void* d_ws, size_t ws_size, hipStream_t stream) {
    static int grid = 0;
    if (grid == 0) {
        if (n_in != 15 || in_sizes[0] != T * D || out_size != T * D || ws_size < WS_END) { fprintf(stderr, "kernel_launch: unexpected shapes (n_in %d, in0 %d, out %d, ws %zu)\n", n_in, n_in > 0 ? in_sizes[0] : -1, out_size, ws_size); grid = -1; return; }
        int dev = 0, cus = 0, per_cu = 0;
        if (hipGetDevice(&dev) != hipSuccess || hipDeviceGetAttribute(&cus, hipDeviceAttributeMultiprocessorCount, dev) != hipSuccess) { grid = -1; return; }
        if (hipFuncSetAttribute((const void*)fwd_kernel, hipFuncAttributeMaxDynamicSharedMemorySize, LDS_BYTES) != hipSuccess) { fprintf(stderr, "kernel_launch: hipFuncSetAttribute failed\n"); grid = -1; return; }
        if (hipOccupancyMaxActiveBlocksPerMultiprocessor(&per_cu, (const void*)fwd_kernel, NWAVES * 64, LDS_BYTES) != hipSuccess || per_cu < 1) { fprintf(stderr, "kernel_launch: occupancy query reports %d blocks per CU\n", per_cu); }
        (void)hipGetLastError();
        grid = cus;
    }
    if (grid < 0) return;
    if (hipMemsetAsync((char*)d_ws + WS_CTL, 0, CTL_ZERO_BYTES, stream) != hipSuccess) return;
    Args a{};
    for (int i = 0; i < 15; ++i) a.in[i] = (const float*)d_in[i];
    a.out = (float*)d_out; a.ws = (unsigned char*)d_ws;
    for (int li = 0; li < N_LAUNCHES; ++li) {
        a.ph_lo = (N_LAUNCHES == PER_PHASE) ? li : 0; a.ph_hi = (N_LAUNCHES == PER_PHASE) ? li + 1 : PER_PHASE; a.li = (N_LAUNCHES == PER_PHASE) ? 0 : li;
        hipLaunchKernelGGL(fwd_kernel, dim3(grid), dim3(NWAVES * 64), LDS_BYTES, stream, a);
        const hipError_t le = hipPeekAtLastError();
        if (le != hipSuccess) { fprintf(stderr, "kernel_launch: launch %d failed: %s\n", li, hipGetErrorName(le)); break; }
    }
}
```

```cpp
#include <hip/hip_runtime.h>
#include <cstdio>
#include <cstdint>
namespace pg8 {
#define PG8_LAS __attribute__((address_space(3)))
typedef unsigned short bf16_t;
typedef short bf16x8 __attribute__((ext_vector_type(8)));
typedef float f32x4 __attribute__((ext_vector_type(4)));
typedef unsigned u32x4 __attribute__((ext_vector_type(4)));
constexpr int BM = 256, BK = 64, HALF = 128, HTB = HALF * BK * 2  , STAGE_BYTES = 8 * HTB, NXCD = 8, WGM = 8;

__host__ __device__ __forceinline__ int lds_byte(int r, int c) { const int st = (r >> 4) * 2 + (c >> 5), rr = r & 15, cc = c & 31, ob = rr * 64 + cc * 2; return st * 1024 + (ob ^ (((ob >> 9) & 1) << 5)); }
__host__ __device__ __forceinline__ void stage_rc(int b, int& R, int& C) { const int st = b / 1024, sb = b % 1024, swz = sb ^ (((sb >> 9) & 1) << 5); R = (st >> 1) * 16 + swz / 64; C = (st & 1) * 32 + (swz % 64) / 2; }
__host__ __device__ __forceinline__ int perm32(int rho) { const int n = rho >> 4, i = rho & 15; return 8 * (i >> 2) + 4 * n + (i & 3); }

struct Unit { int pm, pn; };
struct Gemm { const bf16_t* A; const bf16_t* Bt; int M, N, K; };

struct StaticOrder {
    int nM, nN, nwg, G, c;
    __host__ __device__ void init(int M, int N, int G_, int c_) { nM = M / BM; nN = N / BM; nwg = nM * nN; G = G_; c = c_; }
    __host__ __device__ bool next(int i, Unit& u) const {
        const long L = (long)i * G + c; if (L >= nwg) return false;
        int wgid = (int)L; { const int q = nwg / NXCD, r = nwg % NXCD, xcd = wgid % NXCD, off = wgid / NXCD; wgid = (xcd < r ? xcd * (q + 1) : r * (q + 1) + (xcd - r) * q) + off; }
        const int nig = WGM * nN, gid = wgid / nig, fm = gid * WGM, gsz = (nM - fm) < WGM ? (nM - fm) : WGM;
        u.pm = fm + ((wgid % nig) % gsz); u.pn = (wgid % nig) / gsz; return true;
    }
    __device__ __forceinline__ void a_ready(const Unit&) const {}
    __device__ __forceinline__ void done(const Unit&) const {}
};

__device__ __forceinline__ unsigned cvt_pk_bf16(float lo, float hi) { unsigned r; asm volatile("v_cvt_pk_bf16_f32 %0, %1, %2" : "=v"(r) : "v"(lo), "v"(hi)); return r; }
struct EpiScaleBf16 {
    static constexpr bool PERM = true, AFTER_DRAIN = false;
    bf16_t* O; int ldc; const float* rs;
    __device__ __forceinline__ void operator()(const f32x4 (&acc)[2][2][4][2], const Unit& u, int wr, int wc, int fr, int fq) const {
        const int row0 = u.pm * BM + wr * 64 + fr, col0 = u.pn * BM + wc * 32 + 8 * fq;
#pragma unroll
        for (int ai = 0; ai < 2; ++ai)
#pragma unroll
            for (int m = 0; m < 4; ++m) { const int row = row0 + ai * HALF + m * 16; const float s = rs ? rs[row] : 1.f; bf16_t* rowp = O + (size_t)row * ldc + col0;
#pragma unroll
                for (int bj = 0; bj < 2; ++bj) { const f32x4 v0 = acc[ai][bj][m][0] * s, v1 = acc[ai][bj][m][1] * s;
                    u32x4 w; w.x = cvt_pk_bf16(v0[0], v0[1]); w.y = cvt_pk_bf16(v0[2], v0[3]); w.z = cvt_pk_bf16(v1[0], v1[1]); w.w = cvt_pk_bf16(v1[2], v1[3]);
                    *(u32x4*)(rowp + bj * HALF) = w; } }
    }
};
struct EpiResid {
    static constexpr bool PERM = true, AFTER_DRAIN = false;
    const float* base; float* out; bf16_t* xb; float* ss; int ldc;
    __device__ __forceinline__ void operator()(const f32x4 (&acc)[2][2][4][2], const Unit& u, int wr, int wc, int fr, int fq) const {
        const int row0 = u.pm * BM + wr * 64 + fr, col0 = u.pn * BM + wc * 32 + 8 * fq;
#pragma unroll
        for (int ai = 0; ai < 2; ++ai)
#pragma unroll
            for (int m = 0; m < 4; ++m) { const int row = row0 + ai * HALF + m * 16; const size_t off = (size_t)row * ldc + col0; float q = 0.f;
#pragma unroll
                for (int bj = 0; bj < 2; ++bj) { const f32x4 xa = *(const f32x4*)(base + off + bj * HALF), xc = *(const f32x4*)(base + off + bj * HALF + 4);
                    const f32x4 v0 = acc[ai][bj][m][0] + xa, v1 = acc[ai][bj][m][1] + xc;
                    *(f32x4*)(out + off + bj * HALF) = v0; *(f32x4*)(out + off + bj * HALF + 4) = v1;
                    u32x4 w; w.x = cvt_pk_bf16(v0[0], v0[1]); w.y = cvt_pk_bf16(v0[2], v0[3]); w.z = cvt_pk_bf16(v1[0], v1[1]); w.w = cvt_pk_bf16(v1[2], v1[3]);
                    *(u32x4*)(xb + off + bj * HALF) = w;
                    q += (v0[0] * v0[0] + v0[1] * v0[1]) + (v0[2] * v0[2] + v0[3] * v0[3]) + (v1[0] * v1[0] + v1[1] * v1[1]) + (v1[2] * v1[2] + v1[3] * v1[3]); }
                q += __shfl_xor(q, 16); q += __shfl_xor(q, 32);
                if (fq == 0) ss[(size_t)row * 16 + u.pn * 4 + wc] = q; }
    }
};
template <class Epi, class Sched, bool ALIGN_EPI = false, bool SP2 = false>
__device__ __forceinline__ void gemm_phase(PG8_LAS unsigned char* lds, const Gemm g, const Sched& S, const Epi& E) {
    const int tid = threadIdx.x, wid = __builtin_amdgcn_readfirstlane(tid >> 6), lane = tid & 63, wr = wid >> 2, wc = wid & 3, fr = lane & 15, fq = lane >> 4;
    const int K = g.K, nt = K / BK;
    unsigned voffA[2], voffB[2];
#pragma unroll
    for (int i = 0; i < 2; ++i) { int R, C; stage_rc(tid * 16 + i * 8192, R, C); const int Rb = Epi::PERM ? ((R & ~31) + perm32(R & 31)) : R;
        voffA[i] = (unsigned)(R * K + C) * 2u; voffB[i] = (unsigned)(Rb * K + C) * 2u; }
    const size_t kstep = (size_t)(BK * 2);
    const size_t hstep = (size_t)HALF * K * 2;
    const size_t tstep = 2 * hstep;
    const unsigned ldsw = (unsigned)wid * 1024u;
    const int aoff = lds_byte(wr * 64 + fr, fq * 8), boff = lds_byte(wc * 32 + fr, fq * 8);
#define PG8_SA(b, h) (((b) * 2 + (h)) * HTB)
#define PG8_SB(b, h) ((4 + (b) * 2 + (h)) * HTB)
#define PG8_STAGE(bufoff, gbase, voff) do { _Pragma("unroll") for (int _i = 0; _i < 2; ++_i) \
        __builtin_amdgcn_global_load_lds((const unsigned*)((const char*)(gbase) + (voff)[_i]), (PG8_LAS unsigned*)(lds + (bufoff) + ldsw + _i * 8192), 16, 0, 0); } while (0)
#define PG8_LDA(dst, b, h) do { _Pragma("unroll") for (int m = 0; m < 4; ++m) _Pragma("unroll") for (int k = 0; k < 2; ++k) dst[m][k] = *(const PG8_LAS bf16x8*)(lds + PG8_SA(b, h) + aoff + m * 2048 + k * 1024); } while (0)
#define PG8_LDB(dst, b, h) do { _Pragma("unroll") for (int n = 0; n < 2; ++n) _Pragma("unroll") for (int k = 0; k < 2; ++k) dst[n][k] = *(const PG8_LAS bf16x8*)(lds + PG8_SB(b, h) + boff + n * 2048 + k * 1024); } while (0)
#define PG8_MMA(ai, bj, At, Bt) do { __builtin_amdgcn_s_setprio(1); _Pragma("unroll") for (int m = 0; m < 4; ++m) _Pragma("unroll") for (int n = 0; n < 2; ++n) _Pragma("unroll") for (int k = 0; k < 2; ++k) \
        acc[ai][bj][m][n] = __builtin_amdgcn_mfma_f32_16x16x32_bf16(Bt[n][k], At[m][k], acc[ai][bj][m][n], 0, 0, 0); __builtin_amdgcn_s_setprio(0); } while (0)
#define PG8_WAIT_V(n) asm volatile("s_waitcnt vmcnt(" #n ")" ::: "memory")
#define PG8_WAIT_L(n) asm volatile("s_waitcnt lgkmcnt(" #n ")" ::: "memory")
#define PG8_BAR __builtin_amdgcn_s_barrier()
#define PG8_SCHED __builtin_amdgcn_sched_barrier(0)
    Unit cur, nxt; int ui = 0;
    if (!S.next(0, cur)) return;
    f32x4 acc[2][2][4][2];
#pragma unroll
    for (int a = 0; a < 2; ++a)
#pragma unroll
        for (int b = 0; b < 2; ++b)
#pragma unroll
            for (int m = 0; m < 4; ++m)
#pragma unroll
                for (int n = 0; n < 2; ++n) acc[a][b][m][n] = (f32x4){0.f, 0.f, 0.f, 0.f};
    bf16x8 At[4][2], B0[2][2], B1[2][2];
    const char* cA = (const char*)g.A + (size_t)cur.pm * tstep; const char* cB = (const char*)g.Bt + (size_t)cur.pn * tstep;
    S.a_ready(cur);
    if constexpr (SP2) {
        PG8_STAGE(PG8_SB(0, 0), cB, voffB); PG8_STAGE(PG8_SB(0, 1), cB + hstep, voffB); PG8_STAGE(PG8_SA(0, 0), cA, voffA); PG8_STAGE(PG8_SA(0, 1), cA + hstep, voffA);
        if (wr == 1) PG8_BAR;
        PG8_WAIT_V(2); PG8_BAR;
        PG8_STAGE(PG8_SB(1, 0), cB + kstep, voffB); PG8_STAGE(PG8_SA(1, 0), cA + kstep, voffA); PG8_STAGE(PG8_SB(1, 1), cB + hstep + kstep, voffB);
        PG8_WAIT_V(6); PG8_BAR;
    } else {
        PG8_STAGE(PG8_SB(0, 0), cB, voffB); PG8_STAGE(PG8_SA(0, 0), cA, voffA); PG8_STAGE(PG8_SB(0, 1), cB + hstep, voffB); PG8_STAGE(PG8_SA(0, 1), cA + hstep, voffA);
        if (wr == 1) PG8_BAR;
        PG8_WAIT_V(4); PG8_BAR;
        PG8_STAGE(PG8_SB(1, 0), cB + kstep, voffB); PG8_STAGE(PG8_SA(1, 0), cA + kstep, voffA); PG8_STAGE(PG8_SB(1, 1), cB + hstep + kstep, voffB);
        PG8_WAIT_V(6); PG8_BAR;
    }
    for (;;) {
        const bool has_next = S.next(ui + 1, nxt);
        const char* nA = has_next ? (const char*)g.A + (size_t)nxt.pm * tstep : cA; const char* nB = has_next ? (const char*)g.Bt + (size_t)nxt.pn * tstep : cB;
        for (int t = 0; t < nt; t += 2) {
            const bool last = (t == nt - 2);
            const char* a1 = cA + (size_t)(t + 1) * kstep;
            const char* a2 = last ? nA : cA + (size_t)(t + 2) * kstep; const char* b2 = last ? nB : cB + (size_t)(t + 2) * kstep;
            const char* a3 = a2 + kstep; const char* b3 = b2 + kstep;
            if (last && has_next) S.a_ready(nxt);
            if constexpr (SP2) {
            PG8_LDB(B0, 0, 0); PG8_LDB(B1, 0, 1); PG8_SCHED; PG8_LDA(At, 0, 0); PG8_STAGE(PG8_SA(1, 1), a1 + hstep, voffA);
            PG8_WAIT_V(8); PG8_WAIT_L(0); PG8_BAR; PG8_MMA(0, 0, At, B0); PG8_MMA(0, 1, At, B1); PG8_BAR; PG8_SCHED;
            PG8_LDA(At, 0, 1); PG8_STAGE(PG8_SB(0, 0), b2, voffB); PG8_STAGE(PG8_SB(0, 1), b2 + hstep, voffB); PG8_STAGE(PG8_SA(0, 0), a2, voffA);
            PG8_WAIT_V(8); PG8_WAIT_L(0); PG8_BAR; PG8_MMA(1, 0, At, B0); PG8_MMA(1, 1, At, B1); PG8_BAR; PG8_SCHED;
            PG8_LDB(B0, 1, 0); PG8_LDB(B1, 1, 1); PG8_SCHED; PG8_LDA(At, 1, 0); PG8_STAGE(PG8_SA(0, 1), a2 + hstep, voffA);
            PG8_WAIT_V(8); PG8_WAIT_L(0); PG8_BAR; PG8_MMA(0, 0, At, B0); PG8_MMA(0, 1, At, B1); PG8_BAR; PG8_SCHED;
            PG8_LDA(At, 1, 1); PG8_STAGE(PG8_SB(1, 0), b3, voffB); PG8_STAGE(PG8_SB(1, 1), b3 + hstep, voffB); PG8_STAGE(PG8_SA(1, 0), a3, voffA);
            PG8_WAIT_V(8); PG8_WAIT_L(0); PG8_BAR; PG8_MMA(1, 0, At, B0); PG8_MMA(1, 1, At, B1); PG8_BAR; PG8_SCHED;
            } else {
            PG8_LDB(B0, 0, 0); PG8_SCHED; PG8_LDA(At, 0, 0); PG8_STAGE(PG8_SA(1, 1), a1 + hstep, voffA);
            PG8_WAIT_L(8); PG8_BAR; PG8_WAIT_L(0); PG8_MMA(0, 0, At, B0); PG8_BAR; PG8_SCHED;
            PG8_LDB(B1, 0, 1); PG8_STAGE(PG8_SB(0, 0), b2, voffB);
            PG8_BAR; PG8_WAIT_L(0); PG8_MMA(0, 1, At, B1); PG8_BAR;
            PG8_LDA(At, 0, 1); PG8_STAGE(PG8_SA(0, 0), a2, voffA);
            PG8_BAR; PG8_WAIT_L(0); PG8_MMA(1, 0, At, B0); PG8_BAR; PG8_SCHED;
            PG8_STAGE(PG8_SB(0, 1), b2 + hstep, voffB);
            PG8_WAIT_V(6); PG8_BAR; PG8_MMA(1, 1, At, B1); PG8_BAR;
            PG8_LDB(B0, 1, 0); PG8_SCHED; PG8_LDA(At, 1, 0); PG8_STAGE(PG8_SA(0, 1), a2 + hstep, voffA);
            PG8_WAIT_L(8); PG8_BAR; PG8_WAIT_L(0); PG8_MMA(0, 0, At, B0); PG8_BAR; PG8_SCHED;
            PG8_LDB(B1, 1, 1); PG8_STAGE(PG8_SB(1, 0), b3, voffB);
            PG8_BAR; PG8_WAIT_L(0); PG8_MMA(0, 1, At, B1); PG8_BAR;
            PG8_LDA(At, 1, 1); PG8_STAGE(PG8_SA(1, 0), a3, voffA);
            PG8_BAR; PG8_WAIT_L(0); PG8_MMA(1, 0, At, B0); PG8_BAR; PG8_SCHED;
            PG8_STAGE(PG8_SB(1, 1), b3 + hstep, voffB);
            PG8_WAIT_V(6); PG8_BAR; PG8_MMA(1, 1, At, B1); PG8_BAR;
            }
        }
        if constexpr (ALIGN_EPI) { if (wr == 0) PG8_BAR; }
        if constexpr (!Epi::AFTER_DRAIN) { E(acc, cur, wr, wc, fr, fq); S.done(cur); }
        if (!has_next) break;
#pragma unroll
        for (int a = 0; a < 2; ++a)
#pragma unroll
            for (int b = 0; b < 2; ++b)
#pragma unroll
                for (int m = 0; m < 4; ++m)
#pragma unroll
                    for (int n = 0; n < 2; ++n) acc[a][b][m][n] = (f32x4){0.f, 0.f, 0.f, 0.f};
        cur = nxt; cA = nA; cB = nB; ++ui;
        if constexpr (ALIGN_EPI) { if (wr == 1) PG8_BAR; }
    }
    PG8_WAIT_V(0);
    if constexpr (!ALIGN_EPI) { if (wr == 0) PG8_BAR; }
    PG8_BAR;
    if constexpr (Epi::AFTER_DRAIN) { E.fused(acc, cur, wr, wc, fr, fq, lds, wid, lane); S.done(cur); }
#undef PG8_SA
#undef PG8_SB
#undef PG8_STAGE
#undef PG8_LDA
#undef PG8_LDB
#undef PG8_MMA
#undef PG8_WAIT_V
#undef PG8_WAIT_L
#undef PG8_BAR
#undef PG8_SCHED
}
}
constexpr int NWAVES = 8;
#ifndef MK_N_LAUNCHES
#define MK_N_LAUNCHES 1
#endif
constexpr int PER_PHASE = 9;
constexpr int N_LAUNCHES = MK_N_LAUNCHES;

constexpr int NB = 4, SEQ = 8192, T = NB * SEQ, D = 1024, DIN = 1280, NEXP = 16384, DQ = 2048;
constexpr float EPS = 1e-6f;

constexpr size_t MiB = 1u << 20;
constexpr size_t WS_CTL = 0, CTL_ZERO_BYTES = 1 * MiB;
constexpr size_t WS_WIN = 2 * MiB;
constexpr size_t WS_WOUT = 5 * MiB;
constexpr size_t WS_WQ = 7 * MiB;
constexpr size_t WS_SK = 11 * MiB;
constexpr size_t WS_POOLT = 11 * MiB + 512 * 1024;
constexpr size_t WS_RSTD1 = 12 * MiB;
constexpr size_t WS_SS2 = 13 * MiB;
constexpr size_t WS_SU = 15 * MiB;
constexpr size_t WS_SV = 15 * MiB + 256 * 1024;
constexpr size_t WS_EXP = 16 * MiB;
constexpr size_t WS_BEST = 24 * MiB;
constexpr size_t WS_CC = 40 * MiB;
constexpr size_t WS_U8 = 56 * MiB;
constexpr size_t WS_V8 = 72 * MiB;
constexpr size_t WS_AB = 88 * MiB;
constexpr size_t WS_X1B = 152 * MiB;
constexpr size_t WS_PD = 88 * MiB;
constexpr size_t WS_XB = 216 * MiB;
constexpr size_t WS_Y = 280 * MiB;
constexpr size_t WS_QP = 216 * MiB;
constexpr size_t WS_END = 360 * MiB;
constexpr int CW_BAR = 4096;

constexpr int RING_OFF = 0, RING_BYTES = 131072;
constexpr int LDSCTL_OFF = RING_BYTES, MISC_OFF = LDSCTL_OFF + 320;
constexpr int LDS_BYTES = 147456;
#define GAS __attribute__((address_space(1)))
#define LAS __attribute__((address_space(3)))
typedef unsigned short bf16;
typedef unsigned v4u __attribute__((ext_vector_type(4)));
typedef float f32x4 __attribute__((ext_vector_type(4)));
typedef short bf16x8 __attribute__((ext_vector_type(8)));
typedef GAS unsigned gu32;
typedef GAS unsigned long long gu64;
#define RLX_AGENT __ATOMIC_RELAXED, __HIP_MEMORY_SCOPE_AGENT
#define LDS_WAIT() asm volatile("s_waitcnt lgkmcnt(0)" ::: "memory")
#define VM_WAIT() asm volatile("s_waitcnt vmcnt(0)" ::: "memory")
__device__ __forceinline__ unsigned long long rt() { return __builtin_amdgcn_s_memrealtime(); }
__device__ __forceinline__ unsigned f2bf(float f) { unsigned u = __builtin_bit_cast(unsigned, f); return (u + 0x7fffu + ((u >> 16) & 1u)) >> 16; }
__device__ __forceinline__ unsigned pk2(float lo, float hi) { return f2bf(lo) | (f2bf(hi) << 16); }
#define XB_TMO      128
#define XB_XCNT(j)  (256  + 64 * (j))
#define XB_XSUB(j)  (1280 + 64 * (j))
#define XB_XGEN(j)  (2304 + 64 * (j))
#define XB_TOP      3328
#define XB_TOPGEN   3392
#define XCD_BAR_WORDS 3456
#define XB_SPIN_CAP (1u << 18)

__device__ __forceinline__ unsigned xb_ld(unsigned* p)              { return __hip_atomic_load(p, __ATOMIC_RELAXED, __HIP_MEMORY_SCOPE_AGENT); }
__device__ __forceinline__ unsigned xb_add(unsigned* p, unsigned v) { return __hip_atomic_fetch_add(p, v, __ATOMIC_RELAXED, __HIP_MEMORY_SCOPE_AGENT); }
__device__ __forceinline__ unsigned xb_xcc_id() { return (unsigned)__builtin_amdgcn_s_getreg((3 << 11) | 20) & 0xFu; }
#define XB_SPIN(cond, bar) do { unsigned _sp = 0; while (cond) { __builtin_amdgcn_s_sleep(1); \
    if ((++_sp & 255u) == 0u) { if (xb_ld(&(bar)[XB_TMO])) break; if (_sp > XB_SPIN_CAP) { atomicAdd(&(bar)[XB_TMO], 1u); break; } } } } while (0)

struct XcdBarrier {
    unsigned* bar; unsigned x;
    volatile LAS unsigned* st;
};

__device__ __forceinline__ XcdBarrier xcd_barrier_post(unsigned* bar, volatile LAS unsigned* st) {
    XcdBarrier b; b.bar = bar; b.x = xb_xcc_id(); b.st = st;
    if (threadIdx.x == 0) (void)xb_add(&bar[XB_XCNT(b.x)], 1u);
    return b;
}
__device__ __forceinline__ void xcd_barrier_complete(unsigned* bar, unsigned x, unsigned& nloc, unsigned& nx) {
    const unsigned G = gridDim.x * gridDim.y * gridDim.z;
    unsigned sum, cnt, mine, sp = 0u;
    for (;;) {
        sum = 0u; cnt = 0u; mine = 0u;
#pragma unroll
        for (unsigned j = 0; j < 16; ++j) { const unsigned c = xb_ld(&bar[XB_XCNT(j)]); sum += c; cnt += (c > 0u) ? 1u : 0u; mine = (j == x) ? c : mine; }
        if (sum == G) break;
        __builtin_amdgcn_s_sleep(1);
        if ((++sp & 255u) == 0u) { if (xb_ld(&bar[XB_TMO])) break; if (sp > XB_SPIN_CAP) { atomicAdd(&bar[XB_TMO], 1u); break; } }
    }
    nloc = mine > 0u ? mine : 1u; nx = cnt > 0u ? cnt : 1u;
}

__device__ __forceinline__ void xcd_barrier(const XcdBarrier& b) {
    asm volatile("s_waitcnt vmcnt(0)" ::: "memory");
    __syncthreads();
    if (threadIdx.x == 0) {
        unsigned* bar = b.bar;
        __builtin_amdgcn_s_waitcnt(0);
        unsigned nloc = b.st[0], nx = b.st[1];
        if (nloc == 0u) { xcd_barrier_complete(bar, b.x, nloc, nx); b.st[0] = nloc; b.st[1] = nx; }
        const unsigned old = xb_add(&bar[XB_XSUB(b.x)], 1u);
        const unsigned gen = old / nloc;
        if (old + 1u == (gen + 1u) * nloc) {
            __builtin_amdgcn_fence(__ATOMIC_RELEASE, "agent");
            asm volatile("s_waitcnt vmcnt(0)" ::: "memory");
            const unsigned og = xb_add(&bar[XB_TOP], 1u);
            const unsigned tg = og / nx;
            if (og + 1u == (tg + 1u) * nx) xb_add(&bar[XB_TOPGEN], 1u);
            else XB_SPIN(xb_ld(&bar[XB_TOPGEN]) == tg, bar);
            __builtin_amdgcn_fence(__ATOMIC_ACQUIRE, "agent");
            xb_add(&bar[XB_XGEN(b.x)], 1u);
            asm volatile("s_waitcnt vmcnt(0)" ::: "memory");
        } else {
            XB_SPIN(xb_ld(&bar[XB_XGEN(b.x)]) == gen, bar);
            __builtin_amdgcn_fence(__ATOMIC_ACQUIRE, "agent");
            asm volatile("s_waitcnt vmcnt(0)" ::: "memory");
        }
    }
    __syncthreads();
}
typedef float f32x16 __attribute__((ext_vector_type(16)));
typedef __bf16 bf16x2_t __attribute__((ext_vector_type(2)));
#define MFMA32(a, b, c) __builtin_amdgcn_mfma_f32_32x32x16_bf16((a), (b), (c), 0, 0, 0)
__device__ __forceinline__ float bf_lo(unsigned u) { return __builtin_bit_cast(float, u << 16); }
__device__ __forceinline__ float bf_hi(unsigned u) { return __builtin_bit_cast(float, u & 0xffff0000u); }
__device__ __forceinline__ float dot2_bf16(unsigned w, unsigned x, float acc) { return __builtin_amdgcn_fdot2_f32_bf16(__builtin_bit_cast(bf16x2_t, w), __builtin_bit_cast(bf16x2_t, x), acc, false); }
__device__ __forceinline__ float wave_sum(float v) {
#pragma unroll
    for (int o = 1; o < 64; o <<= 1) v += __shfl_xor(v, o);
    return v;
}

__device__ __forceinline__ void p0_transpose_item(const float* W, int K, int N, bf16* WT, const float* gk, LAS float* scr, int item, int lane) {
    const int nblk = N / 32, kb = item / nblk, nb = item % nblk, k0 = 64 * kb, n0 = 32 * nb;
#pragma unroll 8
    for (int i = 0; i < 32; ++i) { const int kk = 2 * i + (lane >> 5); float w = W[(size_t)(k0 + kk) * N + n0 + (lane & 31)]; if (gk) w *= gk[k0 + kk]; scr[kk * 33 + (lane & 31)] = w; }
    LDS_WAIT(); asm volatile("" ::: "memory");
    const int c = lane & 7;
#pragma unroll
    for (int j = 0; j < 4; ++j) { const int n = (lane >> 3) + 8 * j; const LAS float* s = scr + (8 * c) * 33 + n;
        v4u o; o.x = pk2(s[0 * 33], s[1 * 33]); o.y = pk2(s[2 * 33], s[3 * 33]); o.z = pk2(s[4 * 33], s[5 * 33]); o.w = pk2(s[6 * 33], s[7 * 33]);
        *(GAS v4u*)(WT + (size_t)(n0 + n) * K + k0 + 8 * c) = o; }
    LDS_WAIT(); asm volatile("" ::: "memory");
}
__device__ __forceinline__ float row_to_bf16(const float* src, bf16* dst, const float* g, int lane) {
    const GAS f32x4* xr = (const GAS f32x4*)src + lane; float s = 0.f;
    GAS unsigned long long* o8 = (GAS unsigned long long*)dst + lane;
#pragma unroll
    for (int j = 0; j < 4; ++j) { f32x4 v = xr[64 * j]; s += (v.x * v.x + v.y * v.y) + (v.z * v.z + v.w * v.w);
        if (g) { const f32x4 gv = ((const GAS f32x4*)g)[64 * j + lane]; v = v * gv; }
        o8[64 * j] = (unsigned long long)pk2(v.x, v.y) | ((unsigned long long)pk2(v.z, v.w) << 32); }
    return s;
}
__device__ __forceinline__ void row_to_fp8(const float* src, unsigned char* dst, const float* g, float* sc, int m, int lane) {
    const GAS f32x4* xr = (const GAS f32x4*)src + lane; f32x4 v[4]; float amax = 0.f;
#pragma unroll
    for (int j = 0; j < 4; ++j) { v[j] = xr[64 * j]; if (g) { const f32x4 gv = ((const GAS f32x4*)g)[64 * j + lane]; v[j] = v[j] * gv; }
        amax = fmaxf(fmaxf(amax, fmaxf(fabsf(v[j].x), fabsf(v[j].y))), fmaxf(fabsf(v[j].z), fabsf(v[j].w))); }
#pragma unroll
    for (int o = 1; o < 64; o <<= 1) amax = fmaxf(amax, __shfl_xor(amax, o));
    const unsigned be = (__builtin_bit_cast(unsigned, amax) >> 23) & 0xffu;
    float qs = 1.f, su = 1.f;
    if (be >= 20u && be <= 230u) { qs = __builtin_bit_cast(float, (261u - be) << 23); su = __builtin_bit_cast(float, (be - 7u) << 23); }
    GAS unsigned* o4 = (GAS unsigned*)dst + lane;
#pragma unroll
    for (int j = 0; j < 4; ++j) { int p = 0; p = __builtin_amdgcn_cvt_pk_fp8_f32(v[j].x * qs, v[j].y * qs, p, false); p = __builtin_amdgcn_cvt_pk_fp8_f32(v[j].z * qs, v[j].w * qs, p, true); o4[64 * j] = (unsigned)p; }
    if (lane == 0) sc[m] = su;
}
struct P0Args { const float *x, *g1, *w_in, *pool_w, *w_out, *g2, *wq, *sk, *u, *v; bf16 *XB, *WinT, *WoutT, *WqT, *SK, *PoolT; unsigned char *U8, *V8; float *su, *sv; float* rstd1; };
__device__ __forceinline__ void p0_prologue(const P0Args& a, LAS unsigned char* lds, int gw, int NGW, int wave, int lane) {
    LAS float* scr = (LAS float*)(lds + RING_OFF + wave * 16384);
    constexpr int I_IN = (D / 64) * (DIN / 32), I_OUT = (D / 64) * (D / 32), I_Q = (D / 64) * (DQ / 32), I_P = 4 * 2 * 4;
    constexpr int NITEMS = I_IN + I_OUT + I_Q + I_P;
    for (int it = gw; it < NITEMS; it += NGW) {
        int r = it;
        if (r < I_IN) { p0_transpose_item(a.w_in, D, DIN, a.WinT, a.g1, scr, r, lane); continue; } r -= I_IN;
        if (r < I_OUT) { p0_transpose_item(a.w_out, D, D, a.WoutT, nullptr, scr, r, lane); continue; } r -= I_OUT;
        if (r < I_Q) { p0_transpose_item(a.wq, D, DQ, a.WqT, a.g2, scr, r, lane); continue; } r -= I_Q;
        { const int g = r >> 3; p0_transpose_item(a.pool_w + (size_t)g * 16384, 128, 128, a.PoolT + (size_t)g * 16384, nullptr, scr, r & 7, lane); }
    }
    for (int m = gw; m < T; m += NGW) {
        const float s = wave_sum(row_to_bf16(a.x + (size_t)m * D, a.XB + (size_t)m * D, nullptr, lane));
        if (lane == 0) a.rstd1[m] = 1.0f / sqrtf(s * (1.0f / D) + EPS);
    }
    for (int m = gw; m < NEXP; m += NGW) {
        row_to_fp8(a.u + (size_t)m * D, a.U8 + (size_t)m * D, a.g2, a.su, m, lane);
        row_to_fp8(a.v + (size_t)m * D, a.V8 + (size_t)m * D, nullptr, a.sv, m, lane);
    }
    for (int m = gw; m < 256; m += NGW) (void)row_to_bf16(a.sk + (size_t)m * D, a.SK + (size_t)m * D, nullptr, lane);
}

__device__ __forceinline__ int t5_bucket(int rel) {
    const int n = rel < 0 ? -rel : rel; const int base = rel > 0 ? 16 : 0;
    const int v = n < 8 ? n : (n < 12 ? 8 : (n < 16 ? 9 : (n < 23 ? 10 : (n < 32 ? 11 : (n < 46 ? 12 : (n < 64 ? 13 : (n < 91 ? 14 : 15)))))));
    return base + v;
}
__device__ __forceinline__ void attn_unit(LAS unsigned char* lds, const bf16* Y, bf16* AB, const float* qg, const float* kg, const float* sinks, const float* relb,
                                          int unit, int tid, int wave, int lane) {
    const int kvh = unit & 1, c = (unit >> 1) & 127, b = unit >> 8;
    LAS bf16* Ks = (LAS bf16*)lds;
    LAS bf16* Vt = (LAS bf16*)(lds + 27648);
    LAS float* bt = (LAS float*)(lds + 53248);
    const int row0 = b * SEQ + (c - 2) * 64;
#pragma unroll
    for (int rep = 0; rep < 3; ++rep) {
        const int it = tid + rep * 512, j = it >> 3, ch = it & 7;
        const bool valid = (c - 2 + (j >> 6)) >= 0;
        v4u kraw = {0u, 0u, 0u, 0u}, vraw = {0u, 0u, 0u, 0u};
        if (valid) { const bf16* rp = Y + (size_t)(row0 + j) * DIN; kraw = *(const GAS v4u*)(rp + 512 + 64 * kvh + 8 * ch); vraw = *(const GAS v4u*)(rp + 640 + 64 * kvh + 8 * ch); }
        float kf[8] = {bf_lo(kraw.x), bf_hi(kraw.x), bf_lo(kraw.y), bf_hi(kraw.y), bf_lo(kraw.z), bf_hi(kraw.z), bf_lo(kraw.w), bf_hi(kraw.w)};
        float ss = 0.f;
#pragma unroll
        for (int e = 0; e < 8; ++e) ss += kf[e] * kf[e];
        ss += __shfl_xor(ss, 1); ss += __shfl_xor(ss, 2); ss += __shfl_xor(ss, 4);
        const float r = 1.0f / sqrtf(ss * (1.0f / 64.0f) + EPS);
        const f32x4 g0 = *(const GAS f32x4*)(kg + 8 * ch), g1 = *(const GAS f32x4*)(kg + 8 * ch + 4);
        v4u ko; ko.x = pk2(kf[0] * r * g0.x, kf[1] * r * g0.y); ko.y = pk2(kf[2] * r * g0.z, kf[3] * r * g0.w); ko.z = pk2(kf[4] * r * g1.x, kf[5] * r * g1.y); ko.w = pk2(kf[6] * r * g1.z, kf[7] * r * g1.w);
        *(LAS v4u*)(Ks + j * 72 + 8 * ch) = ko;
        const int s16 = j >> 4, kk = j & 15, hh = (kk >> 2) & 1, jj = ((kk >> 3) << 2) | (kk & 3), pos = 16 * s16 + 8 * hh + jj;
        LAS bf16* vp = Vt + (8 * ch) * 200 + pos;
        vp[0 * 200] = (bf16)(vraw.x & 0xffffu); vp[1 * 200] = (bf16)(vraw.x >> 16); vp[2 * 200] = (bf16)(vraw.y & 0xffffu); vp[3 * 200] = (bf16)(vraw.y >> 16);
        vp[4 * 200] = (bf16)(vraw.z & 0xffffu); vp[5 * 200] = (bf16)(vraw.z >> 16); vp[6 * 200] = (bf16)(vraw.w & 0xffffu); vp[7 * 200] = (bf16)(vraw.w >> 16);
    }
#pragma unroll
    for (int rep = 0; rep < 2; ++rep) { const int it = tid + rep * 512, g = it >> 8, r = it & 255; bt[it] = relb[t5_bucket(r - 191) * 8 + kvh * 4 + g]; }
    LDS_WAIT(); __syncthreads();

    const int g = wave >> 1, i = 32 * (wave & 1) + (lane & 31), hh = lane >> 5, habs = kvh * 4 + g;
    const size_t qrow = (size_t)b * SEQ + (size_t)c * 64 + i;
    const bf16* qp = Y + qrow * DIN + habs * 64 + 8 * hh;
    v4u qraw[4]; float ss = 0.f;
#pragma unroll
    for (int s = 0; s < 4; ++s) { qraw[s] = *(const GAS v4u*)(qp + 16 * s);
        const float f0 = bf_lo(qraw[s].x), f1 = bf_hi(qraw[s].x), f2 = bf_lo(qraw[s].y), f3 = bf_hi(qraw[s].y), f4 = bf_lo(qraw[s].z), f5 = bf_hi(qraw[s].z), f6 = bf_lo(qraw[s].w), f7 = bf_hi(qraw[s].w);
        ss += (f0 * f0 + f1 * f1) + (f2 * f2 + f3 * f3) + (f4 * f4 + f5 * f5) + (f6 * f6 + f7 * f7); }
    ss += __shfl_xor(ss, 32);
    const float rq = 0.125f / sqrtf(ss * (1.0f / 64.0f) + EPS);
    bf16x8 qf[4];
#pragma unroll
    for (int s = 0; s < 4; ++s) { const f32x4 g0 = *(const GAS f32x4*)(qg + 16 * s + 8 * hh), g1 = *(const GAS f32x4*)(qg + 16 * s + 8 * hh + 4);
        v4u w; w.x = pk2(bf_lo(qraw[s].x) * rq * g0.x, bf_hi(qraw[s].x) * rq * g0.y); w.y = pk2(bf_lo(qraw[s].y) * rq * g0.z, bf_hi(qraw[s].y) * rq * g0.w);
        w.z = pk2(bf_lo(qraw[s].z) * rq * g1.x, bf_hi(qraw[s].z) * rq * g1.y); w.w = pk2(bf_lo(qraw[s].w) * rq * g1.z, bf_hi(qraw[s].w) * rq * g1.w);
        qf[s] = __builtin_bit_cast(bf16x8, w); }
    f32x16 sacc[6];
#pragma unroll
    for (int kt = 0; kt < 6; ++kt) {
#pragma unroll
        for (int r = 0; r < 16; ++r) sacc[kt][r] = 0.f;
#pragma unroll
        for (int s = 0; s < 4; ++s) { const bf16x8 a = *(const LAS bf16x8*)(Ks + (32 * kt + (lane & 31)) * 72 + 16 * s + 8 * hh); sacc[kt] = MFMA32(a, qf[s], sacc[kt]); }
    }
    const LAS float* btg = bt + g * 256 + 63 - i;
    float mx = -3.0e38f;
#pragma unroll
    for (int kt = 0; kt < 6; ++kt) { const bool masked = (c - 2 + (kt >> 1)) < 0;
#pragma unroll
        for (int r = 0; r < 16; ++r) { const int j = 32 * kt + (r & 3) + 8 * (r >> 2) + 4 * hh; float v = sacc[kt][r] + btg[j]; v = masked ? -1.0e30f : v; sacc[kt][r] = v; mx = fmaxf(mx, v); } }
    mx = fmaxf(mx, __shfl_xor(mx, 32));
    const float sink = sinks[habs], m = fmaxf(mx, sink);
    float sum = 0.f;
#pragma unroll
    for (int kt = 0; kt < 6; ++kt)
#pragma unroll
        for (int r = 0; r < 16; ++r) { const float p = __expf(sacc[kt][r] - m); sacc[kt][r] = p; sum += p; }
    sum += __shfl_xor(sum, 32);
    const float inv = 1.0f / (sum + __expf(sink - m));
    f32x16 oacc[2];
#pragma unroll
    for (int dt = 0; dt < 2; ++dt)
#pragma unroll
        for (int r = 0; r < 16; ++r) oacc[dt][r] = 0.f;
#pragma unroll
    for (int kt = 0; kt < 6; ++kt)
#pragma unroll
        for (int s2 = 0; s2 < 2; ++s2) {
            v4u w; w.x = pk2(sacc[kt][8 * s2 + 0], sacc[kt][8 * s2 + 1]); w.y = pk2(sacc[kt][8 * s2 + 2], sacc[kt][8 * s2 + 3]); w.z = pk2(sacc[kt][8 * s2 + 4], sacc[kt][8 * s2 + 5]); w.w = pk2(sacc[kt][8 * s2 + 6], sacc[kt][8 * s2 + 7]);
            const bf16x8 pb = __builtin_bit_cast(bf16x8, w);
#pragma unroll
            for (int dt = 0; dt < 2; ++dt) { const bf16x8 a = *(const LAS bf16x8*)(Vt + (32 * dt + (lane & 31)) * 200 + 32 * kt + 16 * s2 + 8 * hh); oacc[dt] = MFMA32(a, pb, oacc[dt]); }
        }
    bf16* op = AB + qrow * D + habs * 64;
#pragma unroll
    for (int dt = 0; dt < 2; ++dt)
#pragma unroll
        for (int q4 = 0; q4 < 4; ++q4) { const int d = 32 * dt + 8 * q4 + 4 * hh;
            const unsigned long long o = (unsigned long long)pk2(oacc[dt][4 * q4 + 0] * inv, oacc[dt][4 * q4 + 1] * inv) | ((unsigned long long)pk2(oacc[dt][4 * q4 + 2] * inv, oacc[dt][4 * q4 + 3] * inv) << 32);
            *(GAS unsigned long long*)(op + d) = o; }
    __syncthreads();
}

__device__ __forceinline__ void pool_unit(LAS unsigned char* lds, const bf16* Y, bf16* AB, const bf16* PoolT, const float* pscale, int unit, int tid, int wave, int lane) {
    const int g = unit & 3, tt = unit >> 2, w = 2 << g;
    LAS bf16* dt_ = (LAS bf16*)lds;
    {
        const int cp = tid & 63, rs = tid >> 6;
        const int r0 = tt * 256 + rs * 32, pos0 = r0 & (SEQ - 1);
        const bf16* colp = Y + 768 + 128 * g + 2 * cp;
        for (int k = 0; k < 32; ++k) {
            const int pos = pos0 + k; const int cnt = pos + 1 < w ? pos + 1 : w;
            float s0 = 0.f, s1 = 0.f, c0 = 0.f, c1 = 0.f;
            for (int q = 0; q < cnt; ++q) { const unsigned u = *(const GAS unsigned*)(colp + (size_t)(r0 + k - q) * DIN); const float a0 = bf_lo(u), a1 = bf_hi(u); s0 += a0; s1 += a1; if (q == 0) { c0 = a0; c1 = a1; } }
            const float ic = 1.0f / (float)cnt;
            *(LAS unsigned*)(dt_ + (rs * 32 + k) * 136 + 2 * cp) = pk2(s0 * ic - c0, s1 * ic - c1);
        }
    }
    LDS_WAIT(); __syncthreads();
    const int hh = lane >> 5, tok = 32 * wave + (lane & 31);
    f32x16 acc[4];
#pragma unroll
    for (int nt = 0; nt < 4; ++nt)
#pragma unroll
        for (int r = 0; r < 16; ++r) acc[nt][r] = 0.f;
    const bf16* pw = PoolT + (size_t)g * 16384 + (size_t)(lane & 31) * 128 + 8 * hh;
#pragma unroll
    for (int s = 0; s < 8; ++s) {
        const bf16x8 bfr = *(const LAS bf16x8*)(dt_ + tok * 136 + 16 * s + 8 * hh);
#pragma unroll
        for (int nt = 0; nt < 4; ++nt) { const bf16x8 a = __builtin_bit_cast(bf16x8, *(const GAS v4u*)(pw + (size_t)nt * 32 * 128 + 16 * s)); acc[nt] = MFMA32(a, bfr, acc[nt]); }
    }
    bf16* op = AB + (size_t)(tt * 256 + tok) * D + 512 + 128 * g;
#pragma unroll
    for (int nt = 0; nt < 4; ++nt)
#pragma unroll
        for (int q4 = 0; q4 < 4; ++q4) { const int dd = 32 * nt + 8 * q4 + 4 * hh; const f32x4 sc = *(const GAS f32x4*)(pscale + 128 * g + dd);
            const unsigned long long o = (unsigned long long)pk2(acc[nt][4 * q4 + 0] * sc.x, acc[nt][4 * q4 + 1] * sc.y) | ((unsigned long long)pk2(acc[nt][4 * q4 + 2] * sc.z, acc[nt][4 * q4 + 3] * sc.w) << 32);
            *(GAS unsigned long long*)(op + dd) = o; }
    __syncthreads();
}

__device__ __forceinline__ int f2key(float f) { int i = __builtin_bit_cast(int, f); return i ^ ((i >> 31) & 0x7fffffff); }
__device__ __forceinline__ float key2f(int k) { return __builtin_bit_cast(float, k ^ ((k >> 31) & 0x7fffffff)); }
#define CE_DESC(a, b) do { const int _x = (a), _y = (b); (a) = _x > _y ? _x : _y; (b) = _x > _y ? _y : _x; } while (0)
__device__ __forceinline__ void sort16_desc(int (&a)[16]) {
#pragma unroll
    for (int k = 2; k <= 16; k <<= 1)
#pragma unroll
        for (int j = k >> 1; j > 0; j >>= 1)
#pragma unroll
            for (int i = 0; i < 16; ++i) { const int l = i ^ j; if (l > i) { if ((i & k) == 0) CE_DESC(a[i], a[l]); else CE_DESC(a[l], a[i]); } }
}
__device__ __forceinline__ void merge_top16(int (&a)[16], const int (&b)[16]) {
#pragma unroll
    for (int i = 0; i < 16; ++i) a[i] = a[i] > b[15 - i] ? a[i] : b[15 - i];
#pragma unroll
    for (int j = 8; j > 0; j >>= 1)
#pragma unroll
        for (int i = 0; i < 16; ++i) { const int l = i ^ j; if (l > i) CE_DESC(a[i], a[l]); }
}
__device__ __forceinline__ void top16_of_64(int (&g0)[16], int (&g1)[16], int (&g2)[16], int (&g3)[16]) {
    sort16_desc(g0); sort16_desc(g1); sort16_desc(g2); sort16_desc(g3);
    merge_top16(g0, g1); merge_top16(g2, g3); merge_top16(g0, g2);
}
__device__ __forceinline__ void topk_unit(LAS unsigned char* lds, const bf16* QP, const bf16* SK, unsigned short* EXPERTS, float* BEST, int unit, int tid, int wave, int lane) {
    const int h = unit & 7, tt = unit >> 3, hh = lane >> 5;
    const int tok = tt * 256 + wave * 32 + (lane & 31);
    LAS int* mine = (LAS int*)lds + tid * 33;
    int top[2][16];
#pragma unroll
    for (int p = 0; p < 2; ++p) {
        const bf16* qp = QP + (size_t)tok * DQ + h * 256 + p * 128 + 8 * hh;
        const bf16* kp = SK + (size_t)(h * 2 + p) * 16384 + (size_t)(lane & 31) * 128 + 8 * hh;
        f32x16 acc[4];
#pragma unroll
        for (int nt = 0; nt < 4; ++nt)
#pragma unroll
            for (int r = 0; r < 16; ++r) acc[nt][r] = 0.f;
#pragma unroll
        for (int s = 0; s < 8; ++s) { const bf16x8 bq = __builtin_bit_cast(bf16x8, *(const GAS v4u*)(qp + 16 * s));
#pragma unroll
            for (int nt = 0; nt < 4; ++nt) { const bf16x8 a = __builtin_bit_cast(bf16x8, *(const GAS v4u*)(kp + (size_t)nt * 32 * 128 + 16 * s)); acc[nt] = MFMA32(a, bq, acc[nt]); } }
        int k0[16], k1[16], k2[16], k3[16];
#pragma unroll
        for (int r = 0; r < 16; ++r) { const int n = (r & 3) + 8 * (r >> 2) + 4 * hh;
            k0[r] = (f2key(acc[0][r]) & ~127) | n; k1[r] = (f2key(acc[1][r]) & ~127) | (32 + n); k2[r] = (f2key(acc[2][r]) & ~127) | (64 + n); k3[r] = (f2key(acc[3][r]) & ~127) | (96 + n); }
        top16_of_64(k0, k1, k2, k3);
#pragma unroll
        for (int r = 0; r < 16; ++r) k1[r] = __shfl_xor(k0[r], 32);
        merge_top16(k0, k1);
#pragma unroll
        for (int r = 0; r < 16; ++r) top[p][r] = k0[r];
    }
    int c0[16], c1[16], c2[16], c3[16];
    {
        float v1[16], v2[16];
#pragma unroll
        for (int r = 0; r < 16; ++r) { v1[r] = key2f(top[0][r] & ~127); v2[r] = key2f(top[1][r] & ~127); mine[r] = top[0][r]; mine[16 + r] = top[1][r]; }
        int cnt = 0;
#pragma unroll
        for (int i = 0; i < 16; ++i)
#pragma unroll
            for (int j = 0; j < 16; ++j) if ((i + 1) * (j + 1) <= 16) { const int key = (f2key(v1[i] + v2[j]) & ~255) | (i << 4) | j;
                if (cnt < 16) c0[cnt] = key; else if (cnt < 32) c1[cnt - 16] = key; else if (cnt < 48) c2[cnt - 32] = key; else c3[cnt - 48] = key; ++cnt; }
#pragma unroll
        for (int r = 0; r < 16; ++r) if (48 + r >= cnt) c3[r] = (int)0x80000000;
    }
    top16_of_64(c0, c1, c2, c3);
    LDS_WAIT();
    if (hh == 0) {
        int ev[16]; float bv[16];
#pragma unroll
        for (int r = 0; r < 16; ++r) { const int id = c0[r] & 255; const int ka = mine[id >> 4], kb = mine[16 + (id & 15)];
            ev[r] = (ka & 127) * 128 + (kb & 127); bv[r] = key2f(ka & ~127) + key2f(kb & ~127); }
        unsigned short* ep = EXPERTS + (size_t)tok * 128 + h * 16; float* bp = BEST + (size_t)tok * 128 + h * 16;
#pragma unroll
        for (int r = 0; r < 16; r += 8) *(GAS v4u*)(ep + r) = (v4u){(unsigned)ev[r] | ((unsigned)ev[r + 1] << 16), (unsigned)ev[r + 2] | ((unsigned)ev[r + 3] << 16), (unsigned)ev[r + 4] | ((unsigned)ev[r + 5] << 16), (unsigned)ev[r + 6] | ((unsigned)ev[r + 7] << 16)};
#pragma unroll
        for (int r = 0; r < 16; r += 4) *(GAS f32x4*)(bp + r) = (f32x4){bv[r], bv[r + 1], bv[r + 2], bv[r + 3]};
    }
    LDS_WAIT();
}

typedef float f32x2 __attribute__((ext_vector_type(2)));
__device__ __forceinline__ float gelu_erf(float x) { return 0.5f * x * (1.0f + erff(x * 0.70710678118654752f)); }
__device__ __forceinline__ float dot16_fp8(const v4u u, const f32x2 (&xs)[8]) {
    f32x2 a0 = {0.f, 0.f}, a1 = {0.f, 0.f};
    a0 = __builtin_elementwise_fma(__builtin_amdgcn_cvt_pk_f32_fp8(u.x, false), xs[0], a0); a1 = __builtin_elementwise_fma(__builtin_amdgcn_cvt_pk_f32_fp8(u.x, true), xs[1], a1);
    a0 = __builtin_elementwise_fma(__builtin_amdgcn_cvt_pk_f32_fp8(u.y, false), xs[2], a0); a1 = __builtin_elementwise_fma(__builtin_amdgcn_cvt_pk_f32_fp8(u.y, true), xs[3], a1);
    a0 = __builtin_elementwise_fma(__builtin_amdgcn_cvt_pk_f32_fp8(u.z, false), xs[4], a0); a1 = __builtin_elementwise_fma(__builtin_amdgcn_cvt_pk_f32_fp8(u.z, true), xs[5], a1);
    a0 = __builtin_elementwise_fma(__builtin_amdgcn_cvt_pk_f32_fp8(u.w, false), xs[6], a0); a1 = __builtin_elementwise_fma(__builtin_amdgcn_cvt_pk_f32_fp8(u.w, true), xs[7], a1);
    a0 = a0 + a1; return a0.x + a0.y;
}
#define PEER_ROWS(r, tab, q) do { const v4u _ev = *(const LAS v4u*)(evp + 16 * (q)); \
        r[0] = *(const GAS v4u*)(tab + (size_t)(_ev.x & 0xffffu) * D); r[1] = *(const GAS v4u*)(tab + (size_t)(_ev.x >> 16) * D); \
        r[2] = *(const GAS v4u*)(tab + (size_t)(_ev.y & 0xffffu) * D); r[3] = *(const GAS v4u*)(tab + (size_t)(_ev.y >> 16) * D); \
        r[4] = *(const GAS v4u*)(tab + (size_t)(_ev.z & 0xffffu) * D); r[5] = *(const GAS v4u*)(tab + (size_t)(_ev.z >> 16) * D); \
        r[6] = *(const GAS v4u*)(tab + (size_t)(_ev.w & 0xffffu) * D); r[7] = *(const GAS v4u*)(tab + (size_t)(_ev.w >> 16) * D); } while (0)
__device__ __forceinline__ void peer_u_phase(LAS unsigned char* lds, const float* X1, const unsigned char* U8, const unsigned short* EXP16, float* PD, int j, int w, int nw, int wave, int lane) {
    const int grp = lane >> 3, sub = lane & 7;
    LAS unsigned char* wl = lds + wave * 8192;
    const LAS unsigned char* evp = wl + grp * 256;
    const int stride = nw * NWAVES * 8;
    int tb = (w * NWAVES + wave) * 8;
    v4u pe0 = {0u, 0u, 0u, 0u}, pe1 = {0u, 0u, 0u, 0u};
    if (tb < T) { const GAS v4u* e = (const GAS v4u*)(EXP16 + (size_t)tb * 128) + lane; pe0 = e[0]; pe1 = e[64]; }
    const unsigned char* ub = U8 + 128 * j + 16 * sub;
    for (; tb < T; tb += stride) {
        *(LAS v4u*)(wl + 16 * lane) = pe0; *(LAS v4u*)(wl + 1024 + 16 * lane) = pe1;
        if (tb + stride < T) { const GAS v4u* e = (const GAS v4u*)(EXP16 + (size_t)(tb + stride) * 128) + lane; pe0 = e[0]; pe1 = e[64]; }
        const int t = tb + grp;
        const GAS f32x4* xp = (const GAS f32x4*)(X1 + (size_t)t * D + 128 * j + 16 * sub);
        f32x2 xs[8];
#pragma unroll
        for (int q = 0; q < 4; ++q) { const f32x4 v = xp[q]; xs[2 * q] = (f32x2){v.x, v.y}; xs[2 * q + 1] = (f32x2){v.z, v.w}; }
        float* pd = PD + ((size_t)j * T + t) * 128 + sub;
        LDS_WAIT();
        v4u ra[8], rb[8];
        PEER_ROWS(ra, ub, 0);
#define PEER_UDOT(r, q) do { float p[8]; _Pragma("unroll") for (int i = 0; i < 8; ++i) p[i] = dot16_fp8(r[i], xs); \
            _Pragma("unroll") for (int o = 4; o > 0; o >>= 1) { const bool up = (sub & o) != 0; \
                _Pragma("unroll") for (int i = 0; i < o; ++i) { const float keep = up ? p[i + o] : p[i], send = up ? p[i] : p[i + o]; p[i] = keep + __shfl_xor(send, o); } } \
            pd[8 * (q)] = p[0]; } while (0)
        for (int q = 0; q < 16; q += 2) {
            PEER_ROWS(rb, ub, q + 1);
            PEER_UDOT(ra, q);
            if (q + 2 < 16) PEER_ROWS(ra, ub, q + 2);
            PEER_UDOT(rb, q + 1);
        }
    }
}
__device__ __forceinline__ void peer_combine(const float* PD, const unsigned short* EXP16, const float* BEST, const float* SS2, const float* su, const float* sv, float* CC, int t, int lane) {
    float ssq = 0.f;
    { const GAS f32x4* sp = (const GAS f32x4*)(SS2 + (size_t)t * 16);
#pragma unroll
      for (int q = 0; q < 4; ++q) { const f32x4 v = sp[q]; ssq += (v.x + v.y) + (v.z + v.w); } }
    const float rstd2 = 1.0f / sqrtf(ssq * (1.0f / D) + EPS);
#pragma unroll
    for (int hf = 0; hf < 2; ++hf) {
        const int k = 64 * hf + lane; const int e = EXP16[(size_t)t * 128 + k];
        const float sb = BEST[(size_t)t * 128 + k] * rstd2;
        float mx = sb;
#pragma unroll
        for (int o = 1; o < 16; o <<= 1) mx = fmaxf(mx, __shfl_xor(mx, o));
        const float ex = __expf(sb - mx); float sm = ex;
#pragma unroll
        for (int o = 1; o < 16; o <<= 1) sm += __shfl_xor(sm, o);
        float dot = 0.f;
#pragma unroll
        for (int j = 0; j < 8; ++j) dot += PD[((size_t)j * T + t) * 128 + k];
        CC[(size_t)t * 128 + k] = (ex / sm) * gelu_erf(dot * rstd2 * su[e]) * sv[e];
    }
}
__device__ __forceinline__ void peer_v_phase(LAS unsigned char* lds, float* OUT, const unsigned char* V8, const unsigned short* EXP16, const float* CC, int j, int w, int nw, int wave, int lane) {
    const int grp = lane >> 3, sub = lane & 7;
    LAS unsigned char* wl = lds + wave * 8192;
    const LAS unsigned char* evp = wl + grp * 256;
    const LAS unsigned char* ccp = wl + 2048 + grp * 512;
    const int stride = nw * NWAVES * 8;
    int tb = (w * NWAVES + wave) * 8;
    v4u pe0 = {0u, 0u, 0u, 0u}, pe1 = {0u, 0u, 0u, 0u}; f32x4 pc0 = {0.f, 0.f, 0.f, 0.f}, pc1 = pc0, pc2 = pc0, pc3 = pc0;
    if (tb < T) { const GAS v4u* e = (const GAS v4u*)(EXP16 + (size_t)tb * 128) + lane; pe0 = e[0]; pe1 = e[64];
        const GAS f32x4* c = (const GAS f32x4*)(CC + (size_t)tb * 128) + lane; pc0 = c[0]; pc1 = c[64]; pc2 = c[128]; pc3 = c[192]; }
    const unsigned char* vb = V8 + 128 * j + 16 * sub;
    for (; tb < T; tb += stride) {
        *(LAS v4u*)(wl + 16 * lane) = pe0; *(LAS v4u*)(wl + 1024 + 16 * lane) = pe1;
        *(LAS f32x4*)(wl + 2048 + 16 * lane) = pc0; *(LAS f32x4*)(wl + 3072 + 16 * lane) = pc1; *(LAS f32x4*)(wl + 4096 + 16 * lane) = pc2; *(LAS f32x4*)(wl + 5120 + 16 * lane) = pc3;
        if (tb + stride < T) { const GAS v4u* e = (const GAS v4u*)(EXP16 + (size_t)(tb + stride) * 128) + lane; pe0 = e[0]; pe1 = e[64];
            const GAS f32x4* c = (const GAS f32x4*)(CC + (size_t)(tb + stride) * 128) + lane; pc0 = c[0]; pc1 = c[64]; pc2 = c[128]; pc3 = c[192]; }
        const int t = tb + grp;
        GAS f32x4* op = (GAS f32x4*)(OUT + (size_t)t * D + 128 * j + 16 * sub);
        f32x2 acc[8];
#pragma unroll
        for (int q = 0; q < 4; ++q) { const f32x4 v = op[q]; acc[2 * q] = (f32x2){v.x, v.y}; acc[2 * q + 1] = (f32x2){v.z, v.w}; }
        LDS_WAIT();
        v4u ra[8], rb[8];
        PEER_ROWS(ra, vb, 0);
#define PEER_VACC(r, q) do { const f32x4 ca = *(const LAS f32x4*)(ccp + 32 * (q)), cb = *(const LAS f32x4*)(ccp + 32 * (q) + 16); \
            const float cc[8] = {ca.x, ca.y, ca.z, ca.w, cb.x, cb.y, cb.z, cb.w}; \
            _Pragma("unroll") for (int i = 0; i < 8; ++i) { const f32x2 c2 = {cc[i], cc[i]}; \
                acc[0] = __builtin_elementwise_fma(__builtin_amdgcn_cvt_pk_f32_fp8(r[i].x, false), c2, acc[0]); acc[1] = __builtin_elementwise_fma(__builtin_amdgcn_cvt_pk_f32_fp8(r[i].x, true), c2, acc[1]); \
                acc[2] = __builtin_elementwise_fma(__builtin_amdgcn_cvt_pk_f32_fp8(r[i].y, false), c2, acc[2]); acc[3] = __builtin_elementwise_fma(__builtin_amdgcn_cvt_pk_f32_fp8(r[i].y, true), c2, acc[3]); \
                acc[4] = __builtin_elementwise_fma(__builtin_amdgcn_cvt_pk_f32_fp8(r[i].z, false), c2, acc[4]); acc[5] = __builtin_elementwise_fma(__builtin_amdgcn_cvt_pk_f32_fp8(r[i].z, true), c2, acc[5]); \
                acc[6] = __builtin_elementwise_fma(__builtin_amdgcn_cvt_pk_f32_fp8(r[i].w, false), c2, acc[6]); acc[7] = __builtin_elementwise_fma(__builtin_amdgcn_cvt_pk_f32_fp8(r[i].w, true), c2, acc[7]); } } while (0)
        for (int q = 0; q < 16; q += 2) {
            PEER_ROWS(rb, vb, q + 1);
            PEER_VACC(ra, q);
            if (q + 2 < 16) PEER_ROWS(ra, vb, q + 2);
            PEER_VACC(rb, q + 1);
        }
#pragma unroll
        for (int q = 0; q < 4; ++q) op[q] = (f32x4){acc[2 * q].x, acc[2 * q].y, acc[2 * q + 1].x, acc[2 * q + 1].y};
    }
}
struct Args { const float* in[15]; float* out; unsigned char* ws; int ph_lo, ph_hi, li, pad; };
__global__ void __launch_bounds__(NWAVES * 64, 2) fwd_kernel(Args args) {
    extern __shared__ __attribute__((aligned(16))) unsigned char lds_raw[];
    LAS unsigned char* lds = (LAS unsigned char*)lds_raw;
    volatile LAS unsigned* MISC = (volatile LAS unsigned*)(lds + MISC_OFF);
    const int tid = threadIdx.x, lane = tid & 63, wave = __builtin_amdgcn_readfirstlane(tid >> 6);
    const int G = gridDim.x, bx = blockIdx.x;
    unsigned char* ws = args.ws;
    gu32* ctl = (gu32*)(ws + WS_CTL);
    for (int u = tid; u < (LDS_BYTES - LDSCTL_OFF) / 4; u += NWAVES * 64) ((LAS unsigned*)(lds + LDSCTL_OFF))[u] = 0u;
    __syncthreads();
    XcdBarrier bar; bar.bar = (unsigned*)(ctl + CW_BAR); bar.x = 0; bar.st = nullptr;
    if (N_LAUNCHES != PER_PHASE) bar = xcd_barrier_post((unsigned*)(ctl + CW_BAR) + args.li * XCD_BAR_WORDS, MISC + 8);
#define GRID_BAR() do { if (N_LAUNCHES != PER_PHASE) xcd_barrier(bar); } while (0)
    const int lo = args.ph_lo, hi = args.ph_hi;
#define IN(k) (lo <= (k) && (k) < hi)
#define BOTH(k) (IN(k) && IN((k) + 1))
#ifndef MK_REPEAT
#define MK_REPEAT -1
#endif
#define REP(k) for (int _r = 0; _r < ((MK_REPEAT == (k)) ? 2 : 1); ++_r)

    const float* x = args.in[0]; float* out = args.out;
    bf16* XB = (bf16*)(ws + WS_XB); bf16* WinT = (bf16*)(ws + WS_WIN); bf16* WoutT = (bf16*)(ws + WS_WOUT); bf16* WqT = (bf16*)(ws + WS_WQ);
    bf16* SK = (bf16*)(ws + WS_SK); bf16* PoolT = (bf16*)(ws + WS_POOLT); unsigned char* U8 = ws + WS_U8; unsigned char* V8 = ws + WS_V8; float* SU = (float*)(ws + WS_SU); float* SV = (float*)(ws + WS_SV);
    bf16* Y = (bf16*)(ws + WS_Y); bf16* AB = (bf16*)(ws + WS_AB); bf16* X1B = (bf16*)(ws + WS_X1B); bf16* QP = (bf16*)(ws + WS_QP);
    float* rstd1 = (float*)(ws + WS_RSTD1); float* SS2 = (float*)(ws + WS_SS2); unsigned short* EXPERTS = (unsigned short*)(ws + WS_EXP); float* BEST = (float*)(ws + WS_BEST);
    float* PD = (float*)(ws + WS_PD); float* CC = (float*)(ws + WS_CC);
    const int gw = bx * NWAVES + wave, NGW = G * NWAVES;

    if (IN(0)) REP(0) {
        P0Args a{x, args.in[1], args.in[2], args.in[7], args.in[9], args.in[10], args.in[11], args.in[12], args.in[13], args.in[14], XB, WinT, WoutT, WqT, SK, PoolT, U8, V8, SU, SV, rstd1};
        p0_prologue(a, lds, gw, NGW, wave, lane);
        if (BOTH(0)) GRID_BAR();
    }
    if (IN(1)) REP(1) {
        pg8::Gemm g{XB, WinT, T, DIN, D}; pg8::StaticOrder S; S.init(T, DIN, G, bx);
        pg8::EpiScaleBf16 E{Y, DIN, rstd1};
        pg8::gemm_phase<pg8::EpiScaleBf16, pg8::StaticOrder, true, true>(lds + RING_OFF, g, S, E);
        if (BOTH(1)) GRID_BAR();
    }
    if (IN(2)) REP(2) {
        for (int u = bx; u < NB * 128 * 2; u += G) attn_unit(lds, Y, AB, args.in[3], args.in[4], args.in[5], args.in[6], u, tid, wave, lane);
        for (int u = bx; u < (T / 256) * 4; u += G) pool_unit(lds, Y, AB, PoolT, args.in[8], u, tid, wave, lane);
        if (BOTH(2)) GRID_BAR();
    }
    if (IN(3)) REP(3) {
        pg8::Gemm g{AB, WoutT, T, D, D}; pg8::StaticOrder S; S.init(T, D, G, bx);
        pg8::EpiResid E{x, out, X1B, SS2, D};
        pg8::gemm_phase<pg8::EpiResid, pg8::StaticOrder, true, true>(lds + RING_OFF, g, S, E);
        if (BOTH(3)) GRID_BAR();
    }
    if (IN(4)) REP(4) {
        pg8::Gemm g{X1B, WqT, T, DQ, D}; pg8::StaticOrder S; S.init(T, DQ, G, bx);
        pg8::EpiScaleBf16 E{QP, DQ, nullptr};
        pg8::gemm_phase<pg8::EpiScaleBf16, pg8::StaticOrder, true, true>(lds + RING_OFF, g, S, E);
        if (BOTH(4)) GRID_BAR();
    }
    if (IN(5)) REP(5) {
        for (int u = bx; u < (T / 256) * 8; u += G) topk_unit(lds, QP, SK, EXPERTS, BEST, u, tid, wave, lane);
        if (BOTH(5)) GRID_BAR();
    }
    if (IN(6)) REP(6) {
        if ((G & 7) == 0) peer_u_phase(lds, out, U8, EXPERTS, PD, bx & 7, bx >> 3, G >> 3, wave, lane);
        else for (int j = 0; j < 8; ++j) peer_u_phase(lds, out, U8, EXPERTS, PD, j, bx, G, wave, lane);
        if (BOTH(6)) GRID_BAR();
    }
    if (IN(7)) REP(7) {
        for (int t = gw; t < T; t += NGW) peer_combine(PD, EXPERTS, BEST, SS2, SU, SV, CC, t, lane);
        if (BOTH(7)) GRID_BAR();
    }
    if (IN(8)) {
        if ((G & 7) == 0) peer_v_phase(lds, out, V8, EXPERTS, CC, bx & 7, bx >> 3, G >> 3, wave, lane);
        else for (int j = 0; j < 8; ++j) peer_v_phase(lds, out, V8, EXPERTS, CC, j, bx, G, wave, lane);
    }
#undef IN
#undef BOTH
}

extern "C" void kernel_launch(void* const* d_in, const int* in_sizes, int n_in, void* d_out, int out_size, void* d_ws, size_t ws_size, hipStream_t stream) {
    static int grid = 0;
    if (grid == 0) {
        if (n_in != 15 || in_sizes[0] != T * D || out_size != T * D || ws_size < WS_END) { fprintf(stderr, "kernel_launch: unexpected shapes (n_in %d, in0 %d, out %d, ws %zu)\n", n_in, n_in > 0 ? in_sizes[0] : -1, out_size, ws_size); grid = -1; return; }
        int dev = 0, cus = 0, per_cu = 0;
        if (hipGetDevice(&dev) != hipSuccess || hipDeviceGetAttribute(&cus, hipDeviceAttributeMultiprocessorCount, dev) != hipSuccess) { grid = -1; return; }
        if (hipFuncSetAttribute((const void*)fwd_kernel, hipFuncAttributeMaxDynamicSharedMemorySize, LDS_BYTES) != hipSuccess) { fprintf(stderr, "kernel_launch: hipFuncSetAttribute failed\n"); grid = -1; return; }
        if (hipOccupancyMaxActiveBlocksPerMultiprocessor(&per_cu, (const void*)fwd_kernel, NWAVES * 64, LDS_BYTES) != hipSuccess || per_cu < 1) { fprintf(stderr, "kernel_launch: occupancy query reports %d blocks per CU\n", per_cu); }
        (void)hipGetLastError();
        grid = cus;
    }
    if (grid < 0) return;
    if (hipMemsetAsync((char*)d_ws + WS_CTL, 0, CTL_ZERO_BYTES, stream) != hipSuccess) return;
    Args a{};
    for (int i = 0; i < 15; ++i) a.in[i] = (const float*)d_in[i];
    a.out = (float*)d_out; a.ws = (unsigned char*)d_ws;
    for (int li = 0; li < N_LAUNCHES; ++li) {
        a.ph_lo = (N_LAUNCHES == PER_PHASE) ? li : 0; a.ph_hi = (N_LAUNCHES == PER_PHASE) ? li + 1 : PER_PHASE; a.li = (N_LAUNCHES == PER_PHASE) ? 0 : li;
        hipLaunchKernelGGL(fwd_kernel, dim3(grid), dim3(NWAVES * 64), LDS_BYTES, stream, a);
        const hipError_t le = hipPeekAtLastError();
        if (le != hipSuccess) { fprintf(stderr, "kernel_launch: launch %d failed: %s\n", li, hipGetErrorName(le)); break; }
    }
}
```

```cpp
#include <hip/hip_runtime.h>
#include <cstdio>
#include <cstdint>
namespace pg8 {
#define PG8_LAS __attribute__((address_space(3)))
typedef unsigned short bf16_t;
typedef short bf16x8 __attribute__((ext_vector_type(8)));
typedef float f32x4 __attribute__((ext_vector_type(4)));
typedef unsigned u32x4 __attribute__((ext_vector_type(4)));
constexpr int BM = 256, BK = 64, HALF = 128, HTB = HALF * BK * 2  , STAGE_BYTES = 8 * HTB, NXCD = 8, WGM = 8;

__host__ __device__ __forceinline__ int lds_byte(int r, int c) { const int st = (r >> 4) * 2 + (c >> 5), rr = r & 15, cc = c & 31, ob = rr * 64 + cc * 2; return st * 1024 + (ob ^ (((ob >> 9) & 1) << 5)); }
__host__ __device__ __forceinline__ void stage_rc(int b, int& R, int& C) { const int st = b / 1024, sb = b % 1024, swz = sb ^ (((sb >> 9) & 1) << 5); R = (st >> 1) * 16 + swz / 64; C = (st & 1) * 32 + (swz % 64) / 2; }
__host__ __device__ __forceinline__ int perm32(int rho) { const int n = rho >> 4, i = rho & 15; return 8 * (i >> 2) + 4 * n + (i & 3); }

struct Unit { int pm, pn; };
struct Gemm { const bf16_t* A; const bf16_t* Bt; int M, N, K; };

struct StaticOrder {
    int nM, nN, nwg, G, c;
    __host__ __device__ void init(int M, int N, int G_, int c_) { nM = M / BM; nN = N / BM; nwg = nM * nN; G = G_; c = c_; }
    __host__ __device__ bool next(int i, Unit& u) const {
        const long L = (long)i * G + c; if (L >= nwg) return false;
        int wgid = (int)L; { const int q = nwg / NXCD, r = nwg % NXCD, xcd = wgid % NXCD, off = wgid / NXCD; wgid = (xcd < r ? xcd * (q + 1) : r * (q + 1) + (xcd - r) * q) + off; }
        const int nig = WGM * nN, gid = wgid / nig, fm = gid * WGM, gsz = (nM - fm) < WGM ? (nM - fm) : WGM;
        u.pm = fm + ((wgid % nig) % gsz); u.pn = (wgid % nig) / gsz; return true;
    }
    __device__ __forceinline__ void a_ready(const Unit&) const {}
    __device__ __forceinline__ void done(const Unit&) const {}
};

__device__ __forceinline__ unsigned cvt_pk_bf16(float lo, float hi) { unsigned r; asm volatile("v_cvt_pk_bf16_f32 %0, %1, %2" : "=v"(r) : "v"(lo), "v"(hi)); return r; }
struct EpiScaleBf16 {
    static constexpr bool PERM = true, AFTER_DRAIN = false;
    bf16_t* O; int ldc; const float* rs;
    __device__ __forceinline__ void operator()(const f32x4 (&acc)[2][2][4][2], const Unit& u, int wr, int wc, int fr, int fq) const {
        const int row0 = u.pm * BM + wr * 64 + fr, col0 = u.pn * BM + wc * 32 + 8 * fq;
#pragma unroll
        for (int ai = 0; ai < 2; ++ai)
#pragma unroll
            for (int m = 0; m < 4; ++m) { const int row = row0 + ai * HALF + m * 16; const float s = rs ? rs[row] : 1.f; bf16_t* rowp = O + (size_t)row * ldc + col0;
#pragma unroll
                for (int bj = 0; bj < 2; ++bj) { const f32x4 v0 = acc[ai][bj][m][0] * s, v1 = acc[ai][bj][m][1] * s;
                    u32x4 w; w.x = cvt_pk_bf16(v0[0], v0[1]); w.y = cvt_pk_bf16(v0[2], v0[3]); w.z = cvt_pk_bf16(v1[0], v1[1]); w.w = cvt_pk_bf16(v1[2], v1[3]);
                    *(u32x4*)(rowp + bj * HALF) = w; } }
    }
};
struct EpiResid {
    static constexpr bool PERM = true, AFTER_DRAIN = false;
    const float* base; float* out; bf16_t* xb; float* ss; int ldc;
    __device__ __forceinline__ void operator()(const f32x4 (&acc)[2][2][4][2], const Unit& u, int wr, int wc, int fr, int fq) const {
        const int row0 = u.pm * BM + wr * 64 + fr, col0 = u.pn * BM + wc * 32 + 8 * fq;
#pragma unroll
        for (int ai = 0; ai < 2; ++ai)
#pragma unroll
            for (int m = 0; m < 4; ++m) { const int row = row0 + ai * HALF + m * 16; const size_t off = (size_t)row * ldc + col0; float q = 0.f;
#pragma unroll
                for (int bj = 0; bj < 2; ++bj) { const f32x4 xa = *(const f32x4*)(base + off + bj * HALF), xc = *(const f32x4*)(base + off + bj * HALF + 4);
                    const f32x4 v0 = acc[ai][bj][m][0] + xa, v1 = acc[ai][bj][m][1] + xc;
                    *(f32x4*)(out + off + bj * HALF) = v0; *(f32x4*)(out + off + bj * HALF + 4) = v1;
                    u32x4 w; w.x = cvt_pk_bf16(v0[0], v0[1]); w.y = cvt_pk_bf16(v0[2], v0[3]); w.z = cvt_pk_bf16(v1[0], v1[1]); w.w = cvt_pk_bf16(v1[2], v1[3]);
                    *(u32x4*)(xb + off + bj * HALF) = w;
                    q += (v0[0] * v0[0] + v0[1] * v0[1]) + (v0[2] * v0[2] + v0[3] * v0[3]) + (v1[0] * v1[0] + v1[1] * v1[1]) + (v1[2] * v1[2] + v1[3] * v1[3]); }
                q += __shfl_xor(q, 16); q += __shfl_xor(q, 32);
                if (fq == 0) ss[(size_t)row * 16 + u.pn * 4 + wc] = q; }
    }
};
template <class Epi, class Sched, bool ALIGN_EPI = false, bool SP2 = false>
__device__ __forceinline__ void gemm_phase(PG8_LAS unsigned char* lds, const Gemm g, const Sched& S, const Epi& E) {
    const int tid = threadIdx.x, wid = __builtin_amdgcn_readfirstlane(tid >> 6), lane = tid & 63, wr = wid >> 2, wc = wid & 3, fr = lane & 15, fq = lane >> 4;
    const int K = g.K, nt = K / BK;
    unsigned voffA[2], voffB[2];
#pragma unroll
    for (int i = 0; i < 2; ++i) { int R, C; stage_rc(tid * 16 + i * 8192, R, C); const int Rb = Epi::PERM ? ((R & ~31) + perm32(R & 31)) : R;
        voffA[i] = (unsigned)(R * K + C) * 2u; voffB[i] = (unsigned)(Rb * K + C) * 2u; }
    const size_t kstep = (size_t)(BK * 2);
    const size_t hstep = (size_t)HALF * K * 2;
    const size_t tstep = 2 * hstep;
    const unsigned ldsw = (unsigned)wid * 1024u;
    const int aoff = lds_byte(wr * 64 + fr, fq * 8), boff = lds_byte(wc * 32 + fr, fq * 8);
#define PG8_SA(b, h) (((b) * 2 + (h)) * HTB)
#define PG8_SB(b, h) ((4 + (b) * 2 + (h)) * HTB)
#define PG8_STAGE(bufoff, gbase, voff) do { _Pragma("unroll") for (int _i = 0; _i < 2; ++_i) \
        __builtin_amdgcn_global_load_lds((const unsigned*)((const char*)(gbase) + (voff)[_i]), (PG8_LAS unsigned*)(lds + (bufoff) + ldsw + _i * 8192), 16, 0, 0); } while (0)
#define PG8_LDA(dst, b, h) do { _Pragma("unroll") for (int m = 0; m < 4; ++m) _Pragma("unroll") for (int k = 0; k < 2; ++k) dst[m][k] = *(const PG8_LAS bf16x8*)(lds + PG8_SA(b, h) + aoff + m * 2048 + k * 1024); } while (0)
#define PG8_LDB(dst, b, h) do { _Pragma("unroll") for (int n = 0; n < 2; ++n) _Pragma("unroll") for (int k = 0; k < 2; ++k) dst[n][k] = *(const PG8_LAS bf16x8*)(lds + PG8_SB(b, h) + boff + n * 2048 + k * 1024); } while (0)
#define PG8_MMA(ai, bj, At, Bt) do { __builtin_amdgcn_s_setprio(1); _Pragma("unroll") for (int m = 0; m < 4; ++m) _Pragma("unroll") for (int n = 0; n < 2; ++n) _Pragma("unroll") for (int k = 0; k < 2; ++k) \
        acc[ai][bj][m][n] = __builtin_amdgcn_mfma_f32_16x16x32_bf16(Bt[n][k], At[m][k], acc[ai][bj][m][n], 0, 0, 0); __builtin_amdgcn_s_setprio(0); } while (0)
#define PG8_WAIT_V(n) asm volatile("s_waitcnt vmcnt(" #n ")" ::: "memory")
#define PG8_WAIT_L(n) asm volatile("s_waitcnt lgkmcnt(" #n ")" ::: "memory")
#define PG8_BAR __builtin_amdgcn_s_barrier()
#define PG8_SCHED __builtin_amdgcn_sched_barrier(0)
    Unit cur, nxt; int ui = 0;
    if (!S.next(0, cur)) return;
    f32x4 acc[2][2][4][2];
#pragma unroll
    for (int a = 0; a < 2; ++a)
#pragma unroll
        for (int b = 0; b < 2; ++b)
#pragma unroll
            for (int m = 0; m < 4; ++m)
#pragma unroll
                for (int n = 0; n < 2; ++n) acc[a][b][m][n] = (f32x4){0.f, 0.f, 0.f, 0.f};
    bf16x8 At[4][2], B0[2][2], B1[2][2];
    const char* cA = (const char*)g.A + (size_t)cur.pm * tstep; const char* cB = (const char*)g.Bt + (size_t)cur.pn * tstep;
    S.a_ready(cur);
    if constexpr (SP2) {
        PG8_STAGE(PG8_SB(0, 0), cB, voffB); PG8_STAGE(PG8_SB(0, 1), cB + hstep, voffB); PG8_STAGE(PG8_SA(0, 0), cA, voffA); PG8_STAGE(PG8_SA(0, 1), cA + hstep, voffA);
        if (wr == 1) PG8_BAR;
        PG8_WAIT_V(2); PG8_BAR;
        PG8_STAGE(PG8_SB(1, 0), cB + kstep, voffB); PG8_STAGE(PG8_SA(1, 0), cA + kstep, voffA); PG8_STAGE(PG8_SB(1, 1), cB + hstep + kstep, voffB);
        PG8_WAIT_V(6); PG8_BAR;
    } else {
        PG8_STAGE(PG8_SB(0, 0), cB, voffB); PG8_STAGE(PG8_SA(0, 0), cA, voffA); PG8_STAGE(PG8_SB(0, 1), cB + hstep, voffB); PG8_STAGE(PG8_SA(0, 1), cA + hstep, voffA);
        if (wr == 1) PG8_BAR;
        PG8_WAIT_V(4); PG8_BAR;
        PG8_STAGE(PG8_SB(1, 0), cB + kstep, voffB); PG8_STAGE(PG8_SA(1, 0), cA + kstep, voffA); PG8_STAGE(PG8_SB(1, 1), cB + hstep + kstep, voffB);
        PG8_WAIT_V(6); PG8_BAR;
    }
    for (;;) {
        const bool has_next = S.next(ui + 1, nxt);
        const char* nA = has_next ? (const char*)g.A + (size_t)nxt.pm * tstep : cA; const char* nB = has_next ? (const char*)g.Bt + (size_t)nxt.pn * tstep : cB;
        for (int t = 0; t < nt; t += 2) {
            const bool last = (t == nt - 2);
            const char* a1 = cA + (size_t)(t + 1) * kstep;
            const char* a2 = last ? nA : cA + (size_t)(t + 2) * kstep; const char* b2 = last ? nB : cB + (size_t)(t + 2) * kstep;
            const char* a3 = a2 + kstep; const char* b3 = b2 + kstep;
            if (last && has_next) S.a_ready(nxt);
            if constexpr (SP2) {
            PG8_LDB(B0, 0, 0); PG8_LDB(B1, 0, 1); PG8_SCHED; PG8_LDA(At, 0, 0); PG8_STAGE(PG8_SA(1, 1), a1 + hstep, voffA);
            PG8_WAIT_V(8); PG8_WAIT_L(0); PG8_BAR; PG8_MMA(0, 0, At, B0); PG8_MMA(0, 1, At, B1); PG8_BAR; PG8_SCHED;
            PG8_LDA(At, 0, 1); PG8_STAGE(PG8_SB(0, 0), b2, voffB); PG8_STAGE(PG8_SB(0, 1), b2 + hstep, voffB); PG8_STAGE(PG8_SA(0, 0), a2, voffA);
            PG8_WAIT_V(8); PG8_WAIT_L(0); PG8_BAR; PG8_MMA(1, 0, At, B0); PG8_MMA(1, 1, At, B1); PG8_BAR; PG8_SCHED;
            PG8_LDB(B0, 1, 0); PG8_LDB(B1, 1, 1); PG8_SCHED; PG8_LDA(At, 1, 0); PG8_STAGE(PG8_SA(0, 1), a2 + hstep, voffA);
            PG8_WAIT_V(8); PG8_WAIT_L(0); PG8_BAR; PG8_MMA(0, 0, At, B0); PG8_MMA(0, 1, At, B1); PG8_BAR; PG8_SCHED;
            PG8_LDA(At, 1, 1); PG8_STAGE(PG8_SB(1, 0), b3, voffB); PG8_STAGE(PG8_SB(1, 1), b3 + hstep, voffB); PG8_STAGE(PG8_SA(1, 0), a3, voffA);
            PG8_WAIT_V(8); PG8_WAIT_L(0); PG8_BAR; PG8_MMA(1, 0, At, B0); PG8_MMA(1, 1, At, B1); PG8_BAR; PG8_SCHED;
            } else {
            PG8_LDB(B0, 0, 0); PG8_SCHED; PG8_LDA(At, 0, 0); PG8_STAGE(PG8_SA(1, 1), a1 + hstep, voffA);
            PG8_WAIT_L(8); PG8_BAR; PG8_WAIT_L(0); PG8_MMA(0, 0, At, B0); PG8_BAR; PG8_SCHED;
            PG8_LDB(B1, 0, 1); PG8_STAGE(PG8_SB(0, 0), b2, voffB);
            PG8_BAR; PG8_WAIT_L(0); PG8_MMA(0, 1, At, B1); PG8_BAR;
            PG8_LDA(At, 0, 1); PG8_STAGE(PG8_SA(0, 0), a2, voffA);
            PG8_BAR; PG8_WAIT_L(0); PG8_MMA(1, 0, At, B0); PG8_BAR; PG8_SCHED;
            PG8_STAGE(PG8_SB(0, 1), b2 + hstep, voffB);
            PG8_WAIT_V(6); PG8_BAR; PG8_MMA(1, 1, At, B1); PG8_BAR;
            PG8_LDB(B0, 1, 0); PG8_SCHED; PG8_LDA(At, 1, 0); PG8_STAGE(PG8_SA(0, 1), a2 + hstep, voffA);
            PG8_WAIT_L(8); PG8_BAR; PG8_WAIT_L(0); PG8_MMA(0, 0, At, B0); PG8_BAR; PG8_SCHED;
            PG8_LDB(B1, 1, 1); PG8_STAGE(PG8_SB(1, 0), b3, voffB);
            PG8_BAR; PG8_WAIT_L(0); PG8_MMA(0, 1, At, B1); PG8_BAR;
            PG8_LDA(At, 1, 1); PG8_STAGE(PG8_SA(1, 0), a3, voffA);
            PG8_BAR; PG8_WAIT_L(0); PG8_MMA(1, 0, At, B0); PG8_BAR; PG8_SCHED;
            PG8_STAGE(PG8_SB(1, 1), b3 + hstep, voffB);
            PG8_WAIT_V(6); PG8_BAR; PG8_MMA(1, 1, At, B1); PG8_BAR;
            }
        }
        if constexpr (ALIGN_EPI) { if (wr == 0) PG8_BAR; }
        if constexpr (!Epi::AFTER_DRAIN) { E(acc, cur, wr, wc, fr, fq); S.done(cur); }
        if (!has_next) break;
#pragma unroll
        for (int a = 0; a < 2; ++a)
#pragma unroll
            for (int b = 0; b < 2; ++b)
#pragma unroll
                for (int m = 0; m < 4; ++m)
#pragma unroll
                    for (int n = 0; n < 2; ++n) acc[a][b][m][n] = (f32x4){0.f, 0.f, 0.f, 0.f};
        cur = nxt; cA = nA; cB = nB; ++ui;
        if constexpr (ALIGN_EPI) { if (wr == 1) PG8_BAR; }
    }
    PG8_WAIT_V(0);
    if constexpr (!ALIGN_EPI) { if (wr == 0) PG8_BAR; }
    PG8_BAR;
    if constexpr (Epi::AFTER_DRAIN) { E.fused(acc, cur, wr, wc, fr, fq, lds, wid, lane); S.done(cur); }
#undef PG8_SA
#undef PG8_SB
#undef PG8_STAGE
#undef PG8_LDA
#undef PG8_LDB
#undef PG8_MMA
#undef PG8_WAIT_V
#undef PG8_WAIT_L
#undef PG8_BAR
#undef PG8_SCHED
}
}
constexpr int NWAVES = 8;
#ifndef MK_N_LAUNCHES
#define MK_N_LAUNCHES 1
#endif
constexpr int PER_PHASE = 9;
constexpr int N_LAUNCHES = MK_N_LAUNCHES;

constexpr int NB = 4, SEQ = 8192, T = NB * SEQ, D = 1024, DIN = 1280, NEXP = 16384, DQ = 2048;
constexpr float EPS = 1e-6f;

constexpr size_t MiB = 1u << 20;
constexpr size_t WS_CTL = 0, CTL_ZERO_BYTES = 1 * MiB;
constexpr size_t WS_WIN = 2 * MiB;
constexpr size_t WS_WOUT = 5 * MiB;
constexpr size_t WS_WQ = 7 * MiB;
constexpr size_t WS_SK = 11 * MiB;
constexpr size_t WS_POOLT = 11 * MiB + 512 * 1024;
constexpr size_t WS_RSTD1 = 12 * MiB;
constexpr size_t WS_SS2 = 13 * MiB;
constexpr size_t WS_SU = 15 * MiB;
constexpr size_t WS_SV = 15 * MiB + 256 * 1024;
constexpr size_t WS_EXP = 16 * MiB;
constexpr size_t WS_BEST = 24 * MiB;
constexpr size_t WS_CC = 40 * MiB;
constexpr size_t WS_SCC = 44 * MiB;
constexpr size_t WS_U8 = 56 * MiB;
constexpr size_t WS_V8 = 72 * MiB;
constexpr size_t WS_AB = 88 * MiB;
constexpr size_t WS_X1B = 152 * MiB;
constexpr size_t WS_PD = 88 * MiB;
constexpr size_t WS_XB = 216 * MiB;
constexpr size_t WS_Y = 280 * MiB;
constexpr size_t WS_QP = 216 * MiB;
constexpr size_t WS_END = 360 * MiB;
constexpr int CW_BAR = 4096;

constexpr int RING_OFF = 0, RING_BYTES = 131072;
constexpr int LDSCTL_OFF = RING_BYTES, MISC_OFF = LDSCTL_OFF + 320;
constexpr int LDS_BYTES = 147456;
#define GAS __attribute__((address_space(1)))
#define LAS __attribute__((address_space(3)))
typedef unsigned short bf16;
typedef unsigned v4u __attribute__((ext_vector_type(4)));
typedef float f32x4 __attribute__((ext_vector_type(4)));
typedef short bf16x8 __attribute__((ext_vector_type(8)));
typedef GAS unsigned gu32;
typedef GAS unsigned long long gu64;
#define RLX_AGENT __ATOMIC_RELAXED, __HIP_MEMORY_SCOPE_AGENT
#define LDS_WAIT() asm volatile("s_waitcnt lgkmcnt(0)" ::: "memory")
#define VM_WAIT() asm volatile("s_waitcnt vmcnt(0)" ::: "memory")
__device__ __forceinline__ unsigned long long rt() { return __builtin_amdgcn_s_memrealtime(); }
__device__ __forceinline__ unsigned f2bf(float f) { unsigned u = __builtin_bit_cast(unsigned, f); return (u + 0x7fffu + ((u >> 16) & 1u)) >> 16; }
__device__ __forceinline__ unsigned pk2(float lo, float hi) { return f2bf(lo) | (f2bf(hi) << 16); }
#define XB_TMO      128
#define XB_XCNT(j)  (256  + 64 * (j))
#define XB_XSUB(j)  (1280 + 64 * (j))
#define XB_XGEN(j)  (2304 + 64 * (j))
#define XB_TOP      3328
#define XB_TOPGEN   3392
#define XCD_BAR_WORDS 3456
#define XB_SPIN_CAP (1u << 18)

__device__ __forceinline__ unsigned xb_ld(unsigned* p)              { return __hip_atomic_load(p, __ATOMIC_RELAXED, __HIP_MEMORY_SCOPE_AGENT); }
__device__ __forceinline__ unsigned xb_add(unsigned* p, unsigned v) { return __hip_atomic_fetch_add(p, v, __ATOMIC_RELAXED, __HIP_MEMORY_SCOPE_AGENT); }
__device__ __forceinline__ unsigned xb_xcc_id() { return (unsigned)__builtin_amdgcn_s_getreg((3 << 11) | 20) & 0xFu; }
#define XB_SPIN(cond, bar) do { unsigned _sp = 0; while (cond) { __builtin_amdgcn_s_sleep(1); \
    if ((++_sp & 255u) == 0u) { if (xb_ld(&(bar)[XB_TMO])) break; if (_sp > XB_SPIN_CAP) { atomicAdd(&(bar)[XB_TMO], 1u); break; } } } } while (0)

struct XcdBarrier {
    unsigned* bar; unsigned x;
    volatile LAS unsigned* st;
};

__device__ __forceinline__ XcdBarrier xcd_barrier_post(unsigned* bar, volatile LAS unsigned* st) {
    XcdBarrier b; b.bar = bar; b.x = xb_xcc_id(); b.st = st;
    if (threadIdx.x == 0) (void)xb_add(&bar[XB_XCNT(b.x)], 1u);
    return b;
}
__device__ __forceinline__ void xcd_barrier_complete(unsigned* bar, unsigned x, unsigned& nloc, unsigned& nx) {
    const unsigned G = gridDim.x * gridDim.y * gridDim.z;
    unsigned sum, cnt, mine, sp = 0u;
    for (;;) {
        sum = 0u; cnt = 0u; mine = 0u;
#pragma unroll
        for (unsigned j = 0; j < 16; ++j) { const unsigned c = xb_ld(&bar[XB_XCNT(j)]); sum += c; cnt += (c > 0u) ? 1u : 0u; mine = (j == x) ? c : mine; }
        if (sum == G) break;
        __builtin_amdgcn_s_sleep(1);
        if ((++sp & 255u) == 0u) { if (xb_ld(&bar[XB_TMO])) break; if (sp > XB_SPIN_CAP) { atomicAdd(&bar[XB_TMO], 1u); break; } }
    }
    nloc = mine > 0u ? mine : 1u; nx = cnt > 0u ? cnt : 1u;
}

__device__ __forceinline__ void xcd_barrier(const XcdBarrier& b) {
    asm volatile("s_waitcnt vmcnt(0)" ::: "memory");
    __syncthreads();
    if (threadIdx.x == 0) {
        unsigned* bar = b.bar;
        __builtin_amdgcn_s_waitcnt(0);
        unsigned nloc = b.st[0], nx = b.st[1];
        if (nloc == 0u) { xcd_barrier_complete(bar, b.x, nloc, nx); b.st[0] = nloc; b.st[1] = nx; }
        const unsigned old = xb_add(&bar[XB_XSUB(b.x)], 1u);
        const unsigned gen = old / nloc;
        if (old + 1u == (gen + 1u) * nloc) {
            __builtin_amdgcn_fence(__ATOMIC_RELEASE, "agent");
            asm volatile("s_waitcnt vmcnt(0)" ::: "memory");
            const unsigned og = xb_add(&bar[XB_TOP], 1u);
            const unsigned tg = og / nx;
            if (og + 1u == (tg + 1u) * nx) xb_add(&bar[XB_TOPGEN], 1u);
            else XB_SPIN(xb_ld(&bar[XB_TOPGEN]) == tg, bar);
            __builtin_amdgcn_fence(__ATOMIC_ACQUIRE, "agent");
            xb_add(&bar[XB_XGEN(b.x)], 1u);
            asm volatile("s_waitcnt vmcnt(0)" ::: "memory");
        } else {
            XB_SPIN(xb_ld(&bar[XB_XGEN(b.x)]) == gen, bar);
            __builtin_amdgcn_fence(__ATOMIC_ACQUIRE, "agent");
            asm volatile("s_waitcnt vmcnt(0)" ::: "memory");
        }
    }
    __syncthreads();
}
typedef float f32x16 __attribute__((ext_vector_type(16)));
typedef __bf16 bf16x2_t __attribute__((ext_vector_type(2)));
#define MFMA32(a, b, c) __builtin_amdgcn_mfma_f32_32x32x16_bf16((a), (b), (c), 0, 0, 0)
__device__ __forceinline__ float bf_lo(unsigned u) { return __builtin_bit_cast(float, u << 16); }
__device__ __forceinline__ float bf_hi(unsigned u) { return __builtin_bit_cast(float, u & 0xffff0000u); }
__device__ __forceinline__ float dot2_bf16(unsigned w, unsigned x, float acc) { return __builtin_amdgcn_fdot2_f32_bf16(__builtin_bit_cast(bf16x2_t, w), __builtin_bit_cast(bf16x2_t, x), acc, false); }
__device__ __forceinline__ float wave_sum(float v) {
#pragma unroll
    for (int o = 1; o < 64; o <<= 1) v += __shfl_xor(v, o);
    return v;
}

__device__ __forceinline__ void p0_transpose_item(const float* W, int K, int N, bf16* WT, const float* gk, LAS float* scr, int item, int lane) {
    const int nblk = N / 32, kb = item / nblk, nb = item % nblk, k0 = 64 * kb, n0 = 32 * nb;
#pragma unroll 8
    for (int i = 0; i < 32; ++i) { const int kk = 2 * i + (lane >> 5); float w = W[(size_t)(k0 + kk) * N + n0 + (lane & 31)]; if (gk) w *= gk[k0 + kk]; scr[kk * 33 + (lane & 31)] = w; }
    LDS_WAIT(); asm volatile("" ::: "memory");
    const int c = lane & 7;
#pragma unroll
    for (int j = 0; j < 4; ++j) { const int n = (lane >> 3) + 8 * j; const LAS float* s = scr + (8 * c) * 33 + n;
        v4u o; o.x = pk2(s[0 * 33], s[1 * 33]); o.y = pk2(s[2 * 33], s[3 * 33]); o.z = pk2(s[4 * 33], s[5 * 33]); o.w = pk2(s[6 * 33], s[7 * 33]);
        *(GAS v4u*)(WT + (size_t)(n0 + n) * K + k0 + 8 * c) = o; }
    LDS_WAIT(); asm volatile("" ::: "memory");
}
__device__ __forceinline__ float row_to_bf16(const float* src, bf16* dst, const float* g, int lane) {
    const GAS f32x4* xr = (const GAS f32x4*)src + lane; float s = 0.f;
    GAS unsigned long long* o8 = (GAS unsigned long long*)dst + lane;
#pragma unroll
    for (int j = 0; j < 4; ++j) { f32x4 v = xr[64 * j]; s += (v.x * v.x + v.y * v.y) + (v.z * v.z + v.w * v.w);
        if (g) { const f32x4 gv = ((const GAS f32x4*)g)[64 * j + lane]; v = v * gv; }
        o8[64 * j] = (unsigned long long)pk2(v.x, v.y) | ((unsigned long long)pk2(v.z, v.w) << 32); }
    return s;
}
__device__ __forceinline__ void row_to_i8(const float* src, unsigned char* dst, const float* g, float* sc, int m, int lane) {
    const GAS f32x4* xr = (const GAS f32x4*)src + lane; f32x4 v[4]; float amax = 0.f;
#pragma unroll
    for (int j = 0; j < 4; ++j) { v[j] = xr[64 * j]; if (g) { const f32x4 gv = ((const GAS f32x4*)g)[64 * j + lane]; v[j] = v[j] * gv; }
        amax = fmaxf(fmaxf(amax, fmaxf(fabsf(v[j].x), fabsf(v[j].y))), fmaxf(fabsf(v[j].z), fabsf(v[j].w))); }
#pragma unroll
    for (int o = 1; o < 64; o <<= 1) amax = fmaxf(amax, __shfl_xor(amax, o));
    const float inv = amax > 0.f ? 127.0f / amax : 0.f;
    GAS unsigned* o4 = (GAS unsigned*)dst + lane;
#pragma unroll
    for (int j = 0; j < 4; ++j) { const unsigned q0 = (unsigned)__float2int_rn(v[j].x * inv) & 0xffu, q1 = (unsigned)__float2int_rn(v[j].y * inv) & 0xffu, q2 = (unsigned)__float2int_rn(v[j].z * inv) & 0xffu, q3 = (unsigned)__float2int_rn(v[j].w * inv) & 0xffu;
        o4[64 * j] = q0 | (q1 << 8) | (q2 << 16) | (q3 << 24); }
    if (lane == 0) sc[m] = amax * (1.0f / 127.0f);
}
struct P0Args { const float *x, *g1, *w_in, *pool_w, *w_out, *g2, *wq, *sk, *u, *v; bf16 *XB, *WinT, *WoutT, *WqT, *SK, *PoolT; unsigned char *U8, *V8; float *su, *sv; float* rstd1; };
__device__ __forceinline__ void p0_prologue(const P0Args& a, LAS unsigned char* lds, int gw, int NGW, int wave, int lane) {
    LAS float* scr = (LAS float*)(lds + RING_OFF + wave * 16384);
    constexpr int I_IN = (D / 64) * (DIN / 32), I_OUT = (D / 64) * (D / 32), I_Q = (D / 64) * (DQ / 32), I_P = 4 * 2 * 4;
    constexpr int NITEMS = I_IN + I_OUT + I_Q + I_P;
    for (int it = gw; it < NITEMS; it += NGW) {
        int r = it;
        if (r < I_IN) { p0_transpose_item(a.w_in, D, DIN, a.WinT, a.g1, scr, r, lane); continue; } r -= I_IN;
        if (r < I_OUT) { p0_transpose_item(a.w_out, D, D, a.WoutT, nullptr, scr, r, lane); continue; } r -= I_OUT;
        if (r < I_Q) { p0_transpose_item(a.wq, D, DQ, a.WqT, a.g2, scr, r, lane); continue; } r -= I_Q;
        { const int g = r >> 3; p0_transpose_item(a.pool_w + (size_t)g * 16384, 128, 128, a.PoolT + (size_t)g * 16384, nullptr, scr, r & 7, lane); }
    }
    for (int m = gw; m < T; m += NGW) {
        const float s = wave_sum(row_to_bf16(a.x + (size_t)m * D, a.XB + (size_t)m * D, nullptr, lane));
        if (lane == 0) a.rstd1[m] = 1.0f / sqrtf(s * (1.0f / D) + EPS);
    }
    for (int m = gw; m < NEXP; m += NGW) {
        row_to_i8(a.u + (size_t)m * D, a.U8 + (size_t)m * D, a.g2, a.su, m, lane);
        row_to_i8(a.v + (size_t)m * D, a.V8 + (size_t)m * D, nullptr, a.sv, m, lane);
    }
    for (int m = gw; m < 256; m += NGW) (void)row_to_bf16(a.sk + (size_t)m * D, a.SK + (size_t)m * D, nullptr, lane);
}

__device__ __forceinline__ int t5_bucket(int rel) {
    const int n = rel < 0 ? -rel : rel; const int base = rel > 0 ? 16 : 0;
    const int v = n < 8 ? n : (n < 12 ? 8 : (n < 16 ? 9 : (n < 23 ? 10 : (n < 32 ? 11 : (n < 46 ? 12 : (n < 64 ? 13 : (n < 91 ? 14 : 15)))))));
    return base + v;
}
__device__ __forceinline__ void attn_unit(LAS unsigned char* lds, const bf16* Y, bf16* AB, const float* qg, const float* kg, const float* sinks, const float* relb,
                                          int unit, int tid, int wave, int lane) {
    const int kvh = unit & 1, c = (unit >> 1) & 127, b = unit >> 8;
    LAS bf16* Ks = (LAS bf16*)lds;
    LAS bf16* Vt = (LAS bf16*)(lds + 27648);
    LAS float* bt = (LAS float*)(lds + 53248);
    const int row0 = b * SEQ + (c - 2) * 64;
#pragma unroll
    for (int rep = 0; rep < 3; ++rep) {
        const int it = tid + rep * 512, j = it >> 3, ch = it & 7;
        const bool valid = (c - 2 + (j >> 6)) >= 0;
        v4u kraw = {0u, 0u, 0u, 0u}, vraw = {0u, 0u, 0u, 0u};
        if (valid) { const bf16* rp = Y + (size_t)(row0 + j) * DIN; kraw = *(const GAS v4u*)(rp + 512 + 64 * kvh + 8 * ch); vraw = *(const GAS v4u*)(rp + 640 + 64 * kvh + 8 * ch); }
        float kf[8] = {bf_lo(kraw.x), bf_hi(kraw.x), bf_lo(kraw.y), bf_hi(kraw.y), bf_lo(kraw.z), bf_hi(kraw.z), bf_lo(kraw.w), bf_hi(kraw.w)};
        float ss = 0.f;
#pragma unroll
        for (int e = 0; e < 8; ++e) ss += kf[e] * kf[e];
        ss += __shfl_xor(ss, 1); ss += __shfl_xor(ss, 2); ss += __shfl_xor(ss, 4);
        const float r = 1.0f / sqrtf(ss * (1.0f / 64.0f) + EPS);
        const f32x4 g0 = *(const GAS f32x4*)(kg + 8 * ch), g1 = *(const GAS f32x4*)(kg + 8 * ch + 4);
        v4u ko; ko.x = pk2(kf[0] * r * g0.x, kf[1] * r * g0.y); ko.y = pk2(kf[2] * r * g0.z, kf[3] * r * g0.w); ko.z = pk2(kf[4] * r * g1.x, kf[5] * r * g1.y); ko.w = pk2(kf[6] * r * g1.z, kf[7] * r * g1.w);
        *(LAS v4u*)(Ks + j * 72 + 8 * ch) = ko;
        const int s16 = j >> 4, kk = j & 15, hh = (kk >> 2) & 1, jj = ((kk >> 3) << 2) | (kk & 3), pos = 16 * s16 + 8 * hh + jj;
        LAS bf16* vp = Vt + (8 * ch) * 200 + pos;
        vp[0 * 200] = (bf16)(vraw.x & 0xffffu); vp[1 * 200] = (bf16)(vraw.x >> 16); vp[2 * 200] = (bf16)(vraw.y & 0xffffu); vp[3 * 200] = (bf16)(vraw.y >> 16);
        vp[4 * 200] = (bf16)(vraw.z & 0xffffu); vp[5 * 200] = (bf16)(vraw.z >> 16); vp[6 * 200] = (bf16)(vraw.w & 0xffffu); vp[7 * 200] = (bf16)(vraw.w >> 16);
    }
#pragma unroll
    for (int rep = 0; rep < 2; ++rep) { const int it = tid + rep * 512, g = it >> 8, r = it & 255; bt[it] = relb[t5_bucket(r - 191) * 8 + kvh * 4 + g]; }
    LDS_WAIT(); __syncthreads();

    const int g = wave >> 1, i = 32 * (wave & 1) + (lane & 31), hh = lane >> 5, habs = kvh * 4 + g;
    const size_t qrow = (size_t)b * SEQ + (size_t)c * 64 + i;
    const bf16* qp = Y + qrow * DIN + habs * 64 + 8 * hh;
    v4u qraw[4]; float ss = 0.f;
#pragma unroll
    for (int s = 0; s < 4; ++s) { qraw[s] = *(const GAS v4u*)(qp + 16 * s);
        const float f0 = bf_lo(qraw[s].x), f1 = bf_hi(qraw[s].x), f2 = bf_lo(qraw[s].y), f3 = bf_hi(qraw[s].y), f4 = bf_lo(qraw[s].z), f5 = bf_hi(qraw[s].z), f6 = bf_lo(qraw[s].w), f7 = bf_hi(qraw[s].w);
        ss += (f0 * f0 + f1 * f1) + (f2 * f2 + f3 * f3) + (f4 * f4 + f5 * f5) + (f6 * f6 + f7 * f7); }
    ss += __shfl_xor(ss, 32);
    const float rq = 0.125f / sqrtf(ss * (1.0f / 64.0f) + EPS);
    bf16x8 qf[4];
#pragma unroll
    for (int s = 0; s < 4; ++s) { const f32x4 g0 = *(const GAS f32x4*)(qg + 16 * s + 8 * hh), g1 = *(const GAS f32x4*)(qg + 16 * s + 8 * hh + 4);
        v4u w; w.x = pk2(bf_lo(qraw[s].x) * rq * g0.x, bf_hi(qraw[s].x) * rq * g0.y); w.y = pk2(bf_lo(qraw[s].y) * rq * g0.z, bf_hi(qraw[s].y) * rq * g0.w);
        w.z = pk2(bf_lo(qraw[s].z) * rq * g1.x, bf_hi(qraw[s].z) * rq * g1.y); w.w = pk2(bf_lo(qraw[s].w) * rq * g1.z, bf_hi(qraw[s].w) * rq * g1.w);
        qf[s] = __builtin_bit_cast(bf16x8, w); }
    f32x16 sacc[6];
#pragma unroll
    for (int kt = 0; kt < 6; ++kt) {
#pragma unroll
        for (int r = 0; r < 16; ++r) sacc[kt][r] = 0.f;
#pragma unroll
        for (int s = 0; s < 4; ++s) { const bf16x8 a = *(const LAS bf16x8*)(Ks + (32 * kt + (lane & 31)) * 72 + 16 * s + 8 * hh); sacc[kt] = MFMA32(a, qf[s], sacc[kt]); }
    }
    const LAS float* btg = bt + g * 256 + 63 - i;
    float mx = -3.0e38f;
#pragma unroll
    for (int kt = 0; kt < 6; ++kt) { const bool masked = (c - 2 + (kt >> 1)) < 0;
#pragma unroll
        for (int r = 0; r < 16; ++r) { const int j = 32 * kt + (r & 3) + 8 * (r >> 2) + 4 * hh; float v = sacc[kt][r] + btg[j]; v = masked ? -1.0e30f : v; sacc[kt][r] = v; mx = fmaxf(mx, v); } }
    mx = fmaxf(mx, __shfl_xor(mx, 32));
    const float sink = sinks[habs], m = fmaxf(mx, sink);
    float sum = 0.f;
#pragma unroll
    for (int kt = 0; kt < 6; ++kt)
#pragma unroll
        for (int r = 0; r < 16; ++r) { const float p = __expf(sacc[kt][r] - m); sacc[kt][r] = p; sum += p; }
    sum += __shfl_xor(sum, 32);
    const float inv = 1.0f / (sum + __expf(sink - m));
    f32x16 oacc[2];
#pragma unroll
    for (int dt = 0; dt < 2; ++dt)
#pragma unroll
        for (int r = 0; r < 16; ++r) oacc[dt][r] = 0.f;
#pragma unroll
    for (int kt = 0; kt < 6; ++kt)
#pragma unroll
        for (int s2 = 0; s2 < 2; ++s2) {
            v4u w; w.x = pk2(sacc[kt][8 * s2 + 0], sacc[kt][8 * s2 + 1]); w.y = pk2(sacc[kt][8 * s2 + 2], sacc[kt][8 * s2 + 3]); w.z = pk2(sacc[kt][8 * s2 + 4], sacc[kt][8 * s2 + 5]); w.w = pk2(sacc[kt][8 * s2 + 6], sacc[kt][8 * s2 + 7]);
            const bf16x8 pb = __builtin_bit_cast(bf16x8, w);
#pragma unroll
            for (int dt = 0; dt < 2; ++dt) { const bf16x8 a = *(const LAS bf16x8*)(Vt + (32 * dt + (lane & 31)) * 200 + 32 * kt + 16 * s2 + 8 * hh); oacc[dt] = MFMA32(a, pb, oacc[dt]); }
        }
    bf16* op = AB + qrow * D + habs * 64;
#pragma unroll
    for (int dt = 0; dt < 2; ++dt)
#pragma unroll
        for (int q4 = 0; q4 < 4; ++q4) { const int d = 32 * dt + 8 * q4 + 4 * hh;
            const unsigned long long o = (unsigned long long)pk2(oacc[dt][4 * q4 + 0] * inv, oacc[dt][4 * q4 + 1] * inv) | ((unsigned long long)pk2(oacc[dt][4 * q4 + 2] * inv, oacc[dt][4 * q4 + 3] * inv) << 32);
            *(GAS unsigned long long*)(op + d) = o; }
    __syncthreads();
}

__device__ __forceinline__ void pool_unit(LAS unsigned char* lds, const bf16* Y, bf16* AB, const bf16* PoolT, const float* pscale, int unit, int tid, int wave, int lane) {
    const int g = unit & 3, tt = unit >> 2, w = 2 << g;
    LAS bf16* dt_ = (LAS bf16*)lds;
    {
        const int cp = tid & 63, rs = tid >> 6;
        const int r0 = tt * 256 + rs * 32, pos0 = r0 & (SEQ - 1);
        const bf16* colp = Y + 768 + 128 * g + 2 * cp;
        for (int k = 0; k < 32; ++k) {
            const int pos = pos0 + k; const int cnt = pos + 1 < w ? pos + 1 : w;
            float s0 = 0.f, s1 = 0.f, c0 = 0.f, c1 = 0.f;
            for (int q = 0; q < cnt; ++q) { const unsigned u = *(const GAS unsigned*)(colp + (size_t)(r0 + k - q) * DIN); const float a0 = bf_lo(u), a1 = bf_hi(u); s0 += a0; s1 += a1; if (q == 0) { c0 = a0; c1 = a1; } }
            const float ic = 1.0f / (float)cnt;
            *(LAS unsigned*)(dt_ + (rs * 32 + k) * 136 + 2 * cp) = pk2(s0 * ic - c0, s1 * ic - c1);
        }
    }
    LDS_WAIT(); __syncthreads();
    const int hh = lane >> 5, tok = 32 * wave + (lane & 31);
    f32x16 acc[4];
#pragma unroll
    for (int nt = 0; nt < 4; ++nt)
#pragma unroll
        for (int r = 0; r < 16; ++r) acc[nt][r] = 0.f;
    const bf16* pw = PoolT + (size_t)g * 16384 + (size_t)(lane & 31) * 128 + 8 * hh;
#pragma unroll
    for (int s = 0; s < 8; ++s) {
        const bf16x8 bfr = *(const LAS bf16x8*)(dt_ + tok * 136 + 16 * s + 8 * hh);
#pragma unroll
        for (int nt = 0; nt < 4; ++nt) { const bf16x8 a = __builtin_bit_cast(bf16x8, *(const GAS v4u*)(pw + (size_t)nt * 32 * 128 + 16 * s)); acc[nt] = MFMA32(a, bfr, acc[nt]); }
    }
    bf16* op = AB + (size_t)(tt * 256 + tok) * D + 512 + 128 * g;
#pragma unroll
    for (int nt = 0; nt < 4; ++nt)
#pragma unroll
        for (int q4 = 0; q4 < 4; ++q4) { const int dd = 32 * nt + 8 * q4 + 4 * hh; const f32x4 sc = *(const GAS f32x4*)(pscale + 128 * g + dd);
            const unsigned long long o = (unsigned long long)pk2(acc[nt][4 * q4 + 0] * sc.x, acc[nt][4 * q4 + 1] * sc.y) | ((unsigned long long)pk2(acc[nt][4 * q4 + 2] * sc.z, acc[nt][4 * q4 + 3] * sc.w) << 32);
            *(GAS unsigned long long*)(op + dd) = o; }
    __syncthreads();
}

__device__ __forceinline__ int f2key(float f) { int i = __builtin_bit_cast(int, f); return i ^ ((i >> 31) & 0x7fffffff); }
__device__ __forceinline__ float key2f(int k) { return __builtin_bit_cast(float, k ^ ((k >> 31) & 0x7fffffff)); }
#define CE_DESC(a, b) do { const int _x = (a), _y = (b); (a) = _x > _y ? _x : _y; (b) = _x > _y ? _y : _x; } while (0)
__device__ __forceinline__ void sort16_desc(int (&a)[16]) {
#pragma unroll
    for (int k = 2; k <= 16; k <<= 1)
#pragma unroll
        for (int j = k >> 1; j > 0; j >>= 1)
#pragma unroll
            for (int i = 0; i < 16; ++i) { const int l = i ^ j; if (l > i) { if ((i & k) == 0) CE_DESC(a[i], a[l]); else CE_DESC(a[l], a[i]); } }
}
__device__ __forceinline__ void merge_top16(int (&a)[16], const int (&b)[16]) {
#pragma unroll
    for (int i = 0; i < 16; ++i) a[i] = a[i] > b[15 - i] ? a[i] : b[15 - i];
#pragma unroll
    for (int j = 8; j > 0; j >>= 1)
#pragma unroll
        for (int i = 0; i < 16; ++i) { const int l = i ^ j; if (l > i) CE_DESC(a[i], a[l]); }
}
__device__ __forceinline__ void top16_of_64(int (&g0)[16], int (&g1)[16], int (&g2)[16], int (&g3)[16]) {
    sort16_desc(g0); sort16_desc(g1); sort16_desc(g2); sort16_desc(g3);
    merge_top16(g0, g1); merge_top16(g2, g3); merge_top16(g0, g2);
}
__device__ __forceinline__ void topk_unit(LAS unsigned char* lds, const bf16* QP, const bf16* SK, unsigned short* EXPERTS, float* BEST, int unit, int tid, int wave, int lane) {
    const int h = unit & 7, tt = unit >> 3, hh = lane >> 5;
    const int tok = tt * 256 + wave * 32 + (lane & 31);
    LAS int* mine = (LAS int*)lds + tid * 33;
    int top[2][16];
#pragma unroll
    for (int p = 0; p < 2; ++p) {
        const bf16* qp = QP + (size_t)tok * DQ + h * 256 + p * 128 + 8 * hh;
        const bf16* kp = SK + (size_t)(h * 2 + p) * 16384 + (size_t)(lane & 31) * 128 + 8 * hh;
        f32x16 acc[4];
#pragma unroll
        for (int nt = 0; nt < 4; ++nt)
#pragma unroll
            for (int r = 0; r < 16; ++r) acc[nt][r] = 0.f;
#pragma unroll
        for (int s = 0; s < 8; ++s) { const bf16x8 bq = __builtin_bit_cast(bf16x8, *(const GAS v4u*)(qp + 16 * s));
#pragma unroll
            for (int nt = 0; nt < 4; ++nt) { const bf16x8 a = __builtin_bit_cast(bf16x8, *(const GAS v4u*)(kp + (size_t)nt * 32 * 128 + 16 * s)); acc[nt] = MFMA32(a, bq, acc[nt]); } }
        int k0[16], k1[16], k2[16], k3[16];
#pragma unroll
        for (int r = 0; r < 16; ++r) { const int n = (r & 3) + 8 * (r >> 2) + 4 * hh;
            k0[r] = (f2key(acc[0][r]) & ~127) | n; k1[r] = (f2key(acc[1][r]) & ~127) | (32 + n); k2[r] = (f2key(acc[2][r]) & ~127) | (64 + n); k3[r] = (f2key(acc[3][r]) & ~127) | (96 + n); }
        top16_of_64(k0, k1, k2, k3);
#pragma unroll
        for (int r = 0; r < 16; ++r) k1[r] = __shfl_xor(k0[r], 32);
        merge_top16(k0, k1);
#pragma unroll
        for (int r = 0; r < 16; ++r) top[p][r] = k0[r];
    }
    int c0[16], c1[16], c2[16], c3[16];
    {
        float v1[16], v2[16];
#pragma unroll
        for (int r = 0; r < 16; ++r) { v1[r] = key2f(top[0][r] & ~127); v2[r] = key2f(top[1][r] & ~127); mine[r] = top[0][r]; mine[16 + r] = top[1][r]; }
        int cnt = 0;
#pragma unroll
        for (int i = 0; i < 16; ++i)
#pragma unroll
            for (int j = 0; j < 16; ++j) if ((i + 1) * (j + 1) <= 16) { const int key = (f2key(v1[i] + v2[j]) & ~255) | (i << 4) | j;
                if (cnt < 16) c0[cnt] = key; else if (cnt < 32) c1[cnt - 16] = key; else if (cnt < 48) c2[cnt - 32] = key; else c3[cnt - 48] = key; ++cnt; }
#pragma unroll
        for (int r = 0; r < 16; ++r) if (48 + r >= cnt) c3[r] = (int)0x80000000;
    }
    top16_of_64(c0, c1, c2, c3);
    LDS_WAIT();
    if (hh == 0) {
        int ev[16]; float bv[16];
#pragma unroll
        for (int r = 0; r < 16; ++r) { const int id = c0[r] & 255; const int ka = mine[id >> 4], kb = mine[16 + (id & 15)];
            ev[r] = (ka & 127) * 128 + (kb & 127); bv[r] = key2f(ka & ~127) + key2f(kb & ~127); }
        unsigned short* ep = EXPERTS + (size_t)tok * 128 + h * 16; float* bp = BEST + (size_t)tok * 128 + h * 16;
#pragma unroll
        for (int r = 0; r < 16; r += 8) *(GAS v4u*)(ep + r) = (v4u){(unsigned)ev[r] | ((unsigned)ev[r + 1] << 16), (unsigned)ev[r + 2] | ((unsigned)ev[r + 3] << 16), (unsigned)ev[r + 4] | ((unsigned)ev[r + 5] << 16), (unsigned)ev[r + 6] | ((unsigned)ev[r + 7] << 16)};
#pragma unroll
        for (int r = 0; r < 16; r += 4) *(GAS f32x4*)(bp + r) = (f32x4){bv[r], bv[r + 1], bv[r + 2], bv[r + 3]};
    }
    LDS_WAIT();
}

__device__ __forceinline__ float gelu_erf(float x) { return 0.5f * x * (1.0f + erff(x * 0.70710678118654752f)); }
#define PEER_ROWS(r, tab, q) do { const v4u _ev = *(const LAS v4u*)(evp + 16 * (q)); \
        r[0] = *(const GAS v4u*)(tab + (size_t)(_ev.x & 0xffffu) * D); r[1] = *(const GAS v4u*)(tab + (size_t)(_ev.x >> 16) * D); \
        r[2] = *(const GAS v4u*)(tab + (size_t)(_ev.y & 0xffffu) * D); r[3] = *(const GAS v4u*)(tab + (size_t)(_ev.y >> 16) * D); \
        r[4] = *(const GAS v4u*)(tab + (size_t)(_ev.z & 0xffffu) * D); r[5] = *(const GAS v4u*)(tab + (size_t)(_ev.z >> 16) * D); \
        r[6] = *(const GAS v4u*)(tab + (size_t)(_ev.w & 0xffffu) * D); r[7] = *(const GAS v4u*)(tab + (size_t)(_ev.w >> 16) * D); } while (0)
__device__ __forceinline__ unsigned pack_i8x4(float a, float b, float c, float d) {
    return ((unsigned)__float2int_rn(a) & 0xffu) | (((unsigned)__float2int_rn(b) & 0xffu) << 8) | (((unsigned)__float2int_rn(c) & 0xffu) << 16) | (((unsigned)__float2int_rn(d) & 0xffu) << 24);
}
__device__ __forceinline__ void peer_u_phase(LAS unsigned char* lds, const float* X1, const unsigned char* U8, const unsigned short* EXP16, float* PD, int j, int w, int nw, int wave, int lane) {
    const int grp = lane >> 3, sub = lane & 7;
    LAS unsigned char* wl = lds + wave * 8192;
    const LAS unsigned char* evp = wl + grp * 256;
    const int stride = nw * NWAVES * 8;
    int tb = (w * NWAVES + wave) * 8;
    v4u pe0 = {0u, 0u, 0u, 0u}, pe1 = {0u, 0u, 0u, 0u};
    if (tb < T) { const GAS v4u* e = (const GAS v4u*)(EXP16 + (size_t)tb * 128) + lane; pe0 = e[0]; pe1 = e[64]; }
    const unsigned char* ub = U8 + 128 * j + 16 * sub;
    for (; tb < T; tb += stride) {
        *(LAS v4u*)(wl + 16 * lane) = pe0; *(LAS v4u*)(wl + 1024 + 16 * lane) = pe1;
        if (tb + stride < T) { const GAS v4u* e = (const GAS v4u*)(EXP16 + (size_t)(tb + stride) * 128) + lane; pe0 = e[0]; pe1 = e[64]; }
        const int t = tb + grp;
        const GAS f32x4* xp = (const GAS f32x4*)(X1 + (size_t)t * D + 128 * j + 16 * sub);
        const f32x4 x0 = xp[0], x1 = xp[1], x2 = xp[2], x3 = xp[3];
        float amax = fmaxf(fmaxf(fmaxf(fabsf(x0.x), fabsf(x0.y)), fmaxf(fabsf(x0.z), fabsf(x0.w))), fmaxf(fmaxf(fabsf(x1.x), fabsf(x1.y)), fmaxf(fabsf(x1.z), fabsf(x1.w))));
        amax = fmaxf(amax, fmaxf(fmaxf(fmaxf(fabsf(x2.x), fabsf(x2.y)), fmaxf(fabsf(x2.z), fabsf(x2.w))), fmaxf(fmaxf(fabsf(x3.x), fabsf(x3.y)), fmaxf(fabsf(x3.z), fabsf(x3.w)))));
        amax = fmaxf(amax, __shfl_xor(amax, 1)); amax = fmaxf(amax, __shfl_xor(amax, 2)); amax = fmaxf(amax, __shfl_xor(amax, 4));
        const float inv = amax > 0.f ? 127.0f / amax : 0.f, sx = amax * (1.0f / 127.0f);
        const unsigned xq0 = pack_i8x4(x0.x * inv, x0.y * inv, x0.z * inv, x0.w * inv), xq1 = pack_i8x4(x1.x * inv, x1.y * inv, x1.z * inv, x1.w * inv);
        const unsigned xq2 = pack_i8x4(x2.x * inv, x2.y * inv, x2.z * inv, x2.w * inv), xq3 = pack_i8x4(x3.x * inv, x3.y * inv, x3.z * inv, x3.w * inv);
        float* pd = PD + ((size_t)j * T + t) * 128 + sub;
        LDS_WAIT();
        v4u ra[8], rb[8], rc[8];
        PEER_ROWS(ra, ub, 0); PEER_ROWS(rb, ub, 1);
#define PEER_UDOT(r, q) do { int p[8]; _Pragma("unroll") for (int i = 0; i < 8; ++i) { int a = __builtin_amdgcn_sdot4((int)r[i].x, (int)xq0, 0, false); a = __builtin_amdgcn_sdot4((int)r[i].y, (int)xq1, a, false); \
                a = __builtin_amdgcn_sdot4((int)r[i].z, (int)xq2, a, false); p[i] = __builtin_amdgcn_sdot4((int)r[i].w, (int)xq3, a, false); } \
            _Pragma("unroll") for (int o = 4; o > 0; o >>= 1) { const bool up = (sub & o) != 0; \
                _Pragma("unroll") for (int i = 0; i < o; ++i) { const int keep = up ? p[i + o] : p[i], send = up ? p[i] : p[i + o]; p[i] = keep + __shfl_xor(send, o); } } \
            pd[8 * (q)] = (float)p[0] * sx; } while (0)
        for (int q = 0; q < 15; q += 3) {
            PEER_ROWS(rc, ub, q + 2); PEER_UDOT(ra, q);
            PEER_ROWS(ra, ub, q + 3); PEER_UDOT(rb, q + 1);
            if (q + 4 < 16) PEER_ROWS(rb, ub, q + 4);
            PEER_UDOT(rc, q + 2);
        }
        PEER_UDOT(ra, 15);
    }
}
__device__ __forceinline__ void peer_combine(const float* PD, const unsigned short* EXP16, const float* BEST, const float* SS2, const float* su, const float* sv, unsigned char* CC8, float* SCC, int t, int lane) {
    float ssq = 0.f;
    { const GAS f32x4* sp = (const GAS f32x4*)(SS2 + (size_t)t * 16);
#pragma unroll
      for (int q = 0; q < 4; ++q) { const f32x4 v = sp[q]; ssq += (v.x + v.y) + (v.z + v.w); } }
    const float rstd2 = 1.0f / sqrtf(ssq * (1.0f / D) + EPS);
    float c[2];
#pragma unroll
    for (int hf = 0; hf < 2; ++hf) {
        const int k = 64 * hf + lane; const int e = EXP16[(size_t)t * 128 + k];
        const float sb = BEST[(size_t)t * 128 + k] * rstd2;
        float mx = sb;
#pragma unroll
        for (int o = 1; o < 16; o <<= 1) mx = fmaxf(mx, __shfl_xor(mx, o));
        const float ex = __expf(sb - mx); float sm = ex;
#pragma unroll
        for (int o = 1; o < 16; o <<= 1) sm += __shfl_xor(sm, o);
        float dot = 0.f;
#pragma unroll
        for (int j = 0; j < 8; ++j) dot += PD[((size_t)j * T + t) * 128 + k];
        c[hf] = (ex / sm) * gelu_erf(dot * rstd2 * su[e]) * sv[e];
    }
    float amax = fmaxf(fabsf(c[0]), fabsf(c[1]));
#pragma unroll
    for (int o = 1; o < 64; o <<= 1) amax = fmaxf(amax, __shfl_xor(amax, o));
    const float inv = amax > 0.f ? 127.0f / amax : 0.f;
    CC8[(size_t)t * 128 + lane] = (unsigned char)(__float2int_rn(c[0] * inv) & 0xff);
    CC8[(size_t)t * 128 + 64 + lane] = (unsigned char)(__float2int_rn(c[1] * inv) & 0xff);
    if (lane == 0) SCC[t] = amax * (1.0f / 127.0f);
}
__device__ __forceinline__ void peer_v_phase(LAS unsigned char* lds, float* OUT, const unsigned char* V8, const unsigned short* EXP16, const unsigned char* CC8, const float* SCC, int j, int w, int nw, int wave, int lane) {
    const int grp = lane >> 3, sub = lane & 7;
    LAS unsigned char* wl = lds + wave * 8192;
    const LAS unsigned char* evp = wl + grp * 256;
    const LAS unsigned char* ccp = wl + 2048 + grp * 128;
    const int stride = nw * NWAVES * 8;
    int tb = (w * NWAVES + wave) * 8;
    v4u pe0 = {0u, 0u, 0u, 0u}, pe1 = {0u, 0u, 0u, 0u}, pc0 = {0u, 0u, 0u, 0u};
    if (tb < T) { const GAS v4u* e = (const GAS v4u*)(EXP16 + (size_t)tb * 128) + lane; pe0 = e[0]; pe1 = e[64]; pc0 = ((const GAS v4u*)(CC8 + (size_t)tb * 128))[lane]; }
    const unsigned char* vb = V8 + 128 * j + 16 * sub;
    for (; tb < T; tb += stride) {
        *(LAS v4u*)(wl + 16 * lane) = pe0; *(LAS v4u*)(wl + 1024 + 16 * lane) = pe1; *(LAS v4u*)(wl + 2048 + 16 * lane) = pc0;
        if (tb + stride < T) { const GAS v4u* e = (const GAS v4u*)(EXP16 + (size_t)(tb + stride) * 128) + lane; pe0 = e[0]; pe1 = e[64]; pc0 = ((const GAS v4u*)(CC8 + (size_t)(tb + stride) * 128))[lane]; }
        const int t = tb + grp;
        const float scc = SCC[t];
        int acc[16];
#pragma unroll
        for (int i = 0; i < 16; ++i) acc[i] = 0;
        LDS_WAIT();
        v4u ra[8], rb[8], rc[8];
        PEER_ROWS(ra, vb, 0); PEER_ROWS(rb, vb, 1);
#define PEER_T4(w_, r0, r1, r2, r3, cpk) do { const unsigned tl0 = __builtin_amdgcn_perm(r1, r0, 0x05010400u), th0 = __builtin_amdgcn_perm(r1, r0, 0x07030602u); \
            const unsigned tl1 = __builtin_amdgcn_perm(r3, r2, 0x05010400u), th1 = __builtin_amdgcn_perm(r3, r2, 0x07030602u); \
            acc[4 * (w_) + 0] = __builtin_amdgcn_sdot4((int)__builtin_amdgcn_perm(tl1, tl0, 0x05040100u), (int)(cpk), acc[4 * (w_) + 0], false); \
            acc[4 * (w_) + 1] = __builtin_amdgcn_sdot4((int)__builtin_amdgcn_perm(tl1, tl0, 0x07060302u), (int)(cpk), acc[4 * (w_) + 1], false); \
            acc[4 * (w_) + 2] = __builtin_amdgcn_sdot4((int)__builtin_amdgcn_perm(th1, th0, 0x05040100u), (int)(cpk), acc[4 * (w_) + 2], false); \
            acc[4 * (w_) + 3] = __builtin_amdgcn_sdot4((int)__builtin_amdgcn_perm(th1, th0, 0x07060302u), (int)(cpk), acc[4 * (w_) + 3], false); } while (0)
#define PEER_VACC(r, q) do { const unsigned long long c8 = *(const LAS unsigned long long*)(ccp + 8 * (q)); const unsigned ca = (unsigned)c8, cb = (unsigned)(c8 >> 32); \
            PEER_T4(0, r[0].x, r[1].x, r[2].x, r[3].x, ca); PEER_T4(1, r[0].y, r[1].y, r[2].y, r[3].y, ca); PEER_T4(2, r[0].z, r[1].z, r[2].z, r[3].z, ca); PEER_T4(3, r[0].w, r[1].w, r[2].w, r[3].w, ca); \
            PEER_T4(0, r[4].x, r[5].x, r[6].x, r[7].x, cb); PEER_T4(1, r[4].y, r[5].y, r[6].y, r[7].y, cb); PEER_T4(2, r[4].z, r[5].z, r[6].z, r[7].z, cb); PEER_T4(3, r[4].w, r[5].w, r[6].w, r[7].w, cb); } while (0)
        for (int q = 0; q < 15; q += 3) {
            PEER_ROWS(rc, vb, q + 2); PEER_VACC(ra, q);
            PEER_ROWS(ra, vb, q + 3); PEER_VACC(rb, q + 1);
            if (q + 4 < 16) PEER_ROWS(rb, vb, q + 4);
            PEER_VACC(rc, q + 2);
        }
        PEER_VACC(ra, 15);
        GAS f32x4* op = (GAS f32x4*)(OUT + (size_t)t * D + 128 * j + 16 * sub);
#pragma unroll
        for (int q = 0; q < 4; ++q) { f32x4 v = op[q]; v.x += scc * (float)acc[4 * q + 0]; v.y += scc * (float)acc[4 * q + 1]; v.z += scc * (float)acc[4 * q + 2]; v.w += scc * (float)acc[4 * q + 3]; op[q] = v; }
    }
}
struct Args { const float* in[15]; float* out; unsigned char* ws; int ph_lo, ph_hi, li, pad; };
__global__ void __launch_bounds__(NWAVES * 64, 2) fwd_kernel(Args args) {
    extern __shared__ __attribute__((aligned(16))) unsigned char lds_raw[];
    LAS unsigned char* lds = (LAS unsigned char*)lds_raw;
    volatile LAS unsigned* MISC = (volatile LAS unsigned*)(lds + MISC_OFF);
    const int tid = threadIdx.x, lane = tid & 63, wave = __builtin_amdgcn_readfirstlane(tid >> 6);
    const int G = gridDim.x, bx = blockIdx.x;
    unsigned char* ws = args.ws;
    gu32* ctl = (gu32*)(ws + WS_CTL);
    for (int u = tid; u < (LDS_BYTES - LDSCTL_OFF) / 4; u += NWAVES * 64) ((LAS unsigned*)(lds + LDSCTL_OFF))[u] = 0u;
    __syncthreads();
    XcdBarrier bar; bar.bar = (unsigned*)(ctl + CW_BAR); bar.x = 0; bar.st = nullptr;
    if (N_LAUNCHES != PER_PHASE) bar = xcd_barrier_post((unsigned*)(ctl + CW_BAR) + args.li * XCD_BAR_WORDS, MISC + 8);
#define GRID_BAR() do { if (N_LAUNCHES != PER_PHASE) xcd_barrier(bar); } while (0)
    const int lo = args.ph_lo, hi = args.ph_hi;
#define IN(k) (lo <= (k) && (k) < hi)
#define BOTH(k) (IN(k) && IN((k) + 1))
#ifndef MK_REPEAT
#define MK_REPEAT -1
#endif
#define REP(k) for (int _r = 0; _r < ((MK_REPEAT == (k)) ? 2 : 1); ++_r)

    const float* x = args.in[0]; float* out = args.out;
    bf16* XB = (bf16*)(ws + WS_XB); bf16* WinT = (bf16*)(ws + WS_WIN); bf16* WoutT = (bf16*)(ws + WS_WOUT); bf16* WqT = (bf16*)(ws + WS_WQ);
    bf16* SK = (bf16*)(ws + WS_SK); bf16* PoolT = (bf16*)(ws + WS_POOLT); unsigned char* U8 = ws + WS_U8; unsigned char* V8 = ws + WS_V8; float* SU = (float*)(ws + WS_SU); float* SV = (float*)(ws + WS_SV);
    bf16* Y = (bf16*)(ws + WS_Y); bf16* AB = (bf16*)(ws + WS_AB); bf16* X1B = (bf16*)(ws + WS_X1B); bf16* QP = (bf16*)(ws + WS_QP);
    float* rstd1 = (float*)(ws + WS_RSTD1); float* SS2 = (float*)(ws + WS_SS2); unsigned short* EXPERTS = (unsigned short*)(ws + WS_EXP); float* BEST = (float*)(ws + WS_BEST);
    float* PD = (float*)(ws + WS_PD); unsigned char* CC8 = ws + WS_CC; float* SCC = (float*)(ws + WS_SCC);
    const int gw = bx * NWAVES + wave, NGW = G * NWAVES;

    if (IN(0)) REP(0) {
        P0Args a{x, args.in[1], args.in[2], args.in[7], args.in[9], args.in[10], args.in[11], args.in[12], args.in[13], args.in[14], XB, WinT, WoutT, WqT, SK, PoolT, U8, V8, SU, SV, rstd1};
        p0_prologue(a, lds, gw, NGW, wave, lane);
        if (BOTH(0)) GRID_BAR();
    }
    if (IN(1)) REP(1) {
        pg8::Gemm g{XB, WinT, T, DIN, D}; pg8::StaticOrder S; S.init(T, DIN, G, bx);
        pg8::EpiScaleBf16 E{Y, DIN, rstd1};
        pg8::gemm_phase<pg8::EpiScaleBf16, pg8::StaticOrder, true, true>(lds + RING_OFF, g, S, E);
        if (BOTH(1)) GRID_BAR();
    }
    if (IN(2)) REP(2) {
        for (int u = bx; u < NB * 128 * 2; u += G) attn_unit(lds, Y, AB, args.in[3], args.in[4], args.in[5], args.in[6], u, tid, wave, lane);
        for (int u = bx; u < (T / 256) * 4; u += G) pool_unit(lds, Y, AB, PoolT, args.in[8], u, tid, wave, lane);
        if (BOTH(2)) GRID_BAR();
    }
    if (IN(3)) REP(3) {
        pg8::Gemm g{AB, WoutT, T, D, D}; pg8::StaticOrder S; S.init(T, D, G, bx);
        pg8::EpiResid E{x, out, X1B, SS2, D};
        pg8::gemm_phase<pg8::EpiResid, pg8::StaticOrder, true, true>(lds + RING_OFF, g, S, E);
        if (BOTH(3)) GRID_BAR();
    }
    if (IN(4)) REP(4) {
        pg8::Gemm g{X1B, WqT, T, DQ, D}; pg8::StaticOrder S; S.init(T, DQ, G, bx);
        pg8::EpiScaleBf16 E{QP, DQ, nullptr};
        pg8::gemm_phase<pg8::EpiScaleBf16, pg8::StaticOrder, true, true>(lds + RING_OFF, g, S, E);
        if (BOTH(4)) GRID_BAR();
    }
    if (IN(5)) REP(5) {
        for (int u = bx; u < (T / 256) * 8; u += G) topk_unit(lds, QP, SK, EXPERTS, BEST, u, tid, wave, lane);
        if (BOTH(5)) GRID_BAR();
    }
    if (IN(6)) REP(6) {
        if ((G & 7) == 0) peer_u_phase(lds, out, U8, EXPERTS, PD, bx & 7, bx >> 3, G >> 3, wave, lane);
        else for (int j = 0; j < 8; ++j) peer_u_phase(lds, out, U8, EXPERTS, PD, j, bx, G, wave, lane);
        if (BOTH(6)) GRID_BAR();
    }
    if (IN(7)) REP(7) {
        for (int t = gw; t < T; t += NGW) peer_combine(PD, EXPERTS, BEST, SS2, SU, SV, CC8, SCC, t, lane);
        if (BOTH(7)) GRID_BAR();
    }
    if (IN(8)) {
        if ((G & 7) == 0) peer_v_phase(lds, out, V8, EXPERTS, CC8, SCC, bx & 7, bx >> 3, G >> 3, wave, lane);
        else for (int j = 0; j < 8; ++j) peer_v_phase(lds, out, V8, EXPERTS, CC8, SCC, j, bx, G, wave, lane);
    }
#undef IN
#undef BOTH
}

extern "C" void kernel_launch(void* const* d_in, const int* in_sizes, int n_in, void* d_out, int out_size, void* d_ws, size_t ws_size, hipStream_t stream) {
    static int grid = 0;
    if (grid == 0) {
        if (n_in != 15 || in_sizes[0] != T * D || out_size != T * D || ws_size < WS_END) { fprintf(stderr, "kernel_launch: unexpected shapes (n_in %d, in0 %d, out %d, ws %zu)\n", n_in, n_in > 0 ? in_sizes[0] : -1, out_size, ws_size); grid = -1; return; }
        int dev = 0, cus = 0, per_cu = 0;
        if (hipGetDevice(&dev) != hipSuccess || hipDeviceGetAttribute(&cus, hipDeviceAttributeMultiprocessorCount, dev) != hipSuccess) { grid = -1; return; }
        if (hipFuncSetAttribute((const void*)fwd_kernel, hipFuncAttributeMaxDynamicSharedMemorySize, LDS_BYTES) != hipSuccess) { fprintf(stderr, "kernel_launch: hipFuncSetAttribute failed\n"); grid = -1; return; }
        if (hipOccupancyMaxActiveBlocksPerMultiprocessor(&per_cu, (const void*)fwd_kernel, NWAVES * 64, LDS_BYTES) != hipSuccess || per_cu < 1) { fprintf(stderr, "kernel_launch: occupancy query reports %d blocks per CU\n", per_cu); }
        (void)hipGetLastError();
        grid = cus;
    }
    if (grid < 0) return;
    if (hipMemsetAsync((char*)d_ws + WS_CTL, 0, CTL_ZERO_BYTES, stream) != hipSuccess) return;
    Args a{};
    for (int i = 0; i < 15; ++i) a.in[i] = (const float*)d_in[i];
    a.out = (float*)d_out; a.ws = (unsigned char*)d_ws;
    for (int li = 0; li < N_LAUNCHES; ++li) {
        a.ph_lo = (N_LAUNCHES == PER_PHASE) ? li : 0; a.ph_hi = (N_LAUNCHES == PER_PHASE) ? li + 1 : PER_PHASE; a.li = (N_LAUNCHES == PER_PHASE) ? 0 : li;
        hipLaunchKernelGGL(fwd_kernel, dim3(grid), dim3(NWAVES * 64), LDS_BYTES, stream, a);
        const hipError_t le = hipPeekAtLastError();
        if (le != hipSuccess) { fprintf(stderr, "kernel_launch: launch %d failed: %s\n", li, hipGetErrorName(le)); break; }
    }
}
```

```cpp
#include <hip/hip_runtime.h>
#include <cstdio>
#include <cstdint>
namespace pg8 {
#define PG8_LAS __attribute__((address_space(3)))
typedef unsigned short bf16_t;
typedef short bf16x8 __attribute__((ext_vector_type(8)));
typedef float f32x4 __attribute__((ext_vector_type(4)));
typedef unsigned u32x4 __attribute__((ext_vector_type(4)));
constexpr int BM = 256, BK = 64, HALF = 128, HTB = HALF * BK * 2  , STAGE_BYTES = 8 * HTB, NXCD = 8, WGM = 8;

__host__ __device__ __forceinline__ int lds_byte(int r, int c) { const int st = (r >> 4) * 2 + (c >> 5), rr = r & 15, cc = c & 31, ob = rr * 64 + cc * 2; return st * 1024 + (ob ^ (((ob >> 9) & 1) << 5)); }
__host__ __device__ __forceinline__ void stage_rc(int b, int& R, int& C) { const int st = b / 1024, sb = b % 1024, swz = sb ^ (((sb >> 9) & 1) << 5); R = (st >> 1) * 16 + swz / 64; C = (st & 1) * 32 + (swz % 64) / 2; }
__host__ __device__ __forceinline__ int perm32(int rho) { const int n = rho >> 4, i = rho & 15; return 8 * (i >> 2) + 4 * n + (i & 3); }

struct Unit { int pm, pn; };
struct Gemm { const bf16_t* A; const bf16_t* Bt; int M, N, K; };

struct StaticOrder {
    int nM, nN, nwg, G, c;
    __host__ __device__ void init(int M, int N, int G_, int c_) { nM = M / BM; nN = N / BM; nwg = nM * nN; G = G_; c = c_; }
    __host__ __device__ bool next(int i, Unit& u) const {
        const long L = (long)i * G + c; if (L >= nwg) return false;
        int wgid = (int)L; { const int q = nwg / NXCD, r = nwg % NXCD, xcd = wgid % NXCD, off = wgid / NXCD; wgid = (xcd < r ? xcd * (q + 1) : r * (q + 1) + (xcd - r) * q) + off; }
        const int nig = WGM * nN, gid = wgid / nig, fm = gid * WGM, gsz = (nM - fm) < WGM ? (nM - fm) : WGM;
        u.pm = fm + ((wgid % nig) % gsz); u.pn = (wgid % nig) / gsz; return true;
    }
    __device__ __forceinline__ void a_ready(const Unit&) const {}
    __device__ __forceinline__ void done(const Unit&) const {}
};

__device__ __forceinline__ unsigned cvt_pk_bf16(float lo, float hi) { unsigned r; asm volatile("v_cvt_pk_bf16_f32 %0, %1, %2" : "=v"(r) : "v"(lo), "v"(hi)); return r; }
struct EpiScaleBf16 {
    static constexpr bool PERM = true, AFTER_DRAIN = false;
    bf16_t* O; int ldc; const float* rs;
    __device__ __forceinline__ void operator()(const f32x4 (&acc)[2][2][4][2], const Unit& u, int wr, int wc, int fr, int fq) const {
        const int row0 = u.pm * BM + wr * 64 + fr, col0 = u.pn * BM + wc * 32 + 8 * fq;
#pragma unroll
        for (int ai = 0; ai < 2; ++ai)
#pragma unroll
            for (int m = 0; m < 4; ++m) { const int row = row0 + ai * HALF + m * 16; const float s = rs ? rs[row] : 1.f; bf16_t* rowp = O + (size_t)row * ldc + col0;
#pragma unroll
                for (int bj = 0; bj < 2; ++bj) { const f32x4 v0 = acc[ai][bj][m][0] * s, v1 = acc[ai][bj][m][1] * s;
                    u32x4 w; w.x = cvt_pk_bf16(v0[0], v0[1]); w.y = cvt_pk_bf16(v0[2], v0[3]); w.z = cvt_pk_bf16(v1[0], v1[1]); w.w = cvt_pk_bf16(v1[2], v1[3]);
                    *(u32x4*)(rowp + bj * HALF) = w; } }
    }
};
struct EpiResid {
    static constexpr bool PERM = true, AFTER_DRAIN = false;
    const float* base; float* out; bf16_t* xb; float* ss; int ldc;
    __device__ __forceinline__ void operator()(const f32x4 (&acc)[2][2][4][2], const Unit& u, int wr, int wc, int fr, int fq) const {
        const int row0 = u.pm * BM + wr * 64 + fr, col0 = u.pn * BM + wc * 32 + 8 * fq;
#pragma unroll
        for (int ai = 0; ai < 2; ++ai)
#pragma unroll
            for (int m = 0; m < 4; ++m) { const int row = row0 + ai * HALF + m * 16; const size_t off = (size_t)row * ldc + col0; float q = 0.f;
#pragma unroll
                for (int bj = 0; bj < 2; ++bj) { const f32x4 xa = *(const f32x4*)(base + off + bj * HALF), xc = *(const f32x4*)(base + off + bj * HALF + 4);
                    const f32x4 v0 = acc[ai][bj][m][0] + xa, v1 = acc[ai][bj][m][1] + xc;
                    *(f32x4*)(out + off + bj * HALF) = v0; *(f32x4*)(out + off + bj * HALF + 4) = v1;
                    u32x4 w; w.x = cvt_pk_bf16(v0[0], v0[1]); w.y = cvt_pk_bf16(v0[2], v0[3]); w.z = cvt_pk_bf16(v1[0], v1[1]); w.w = cvt_pk_bf16(v1[2], v1[3]);
                    *(u32x4*)(xb + off + bj * HALF) = w;
                    q += (v0[0] * v0[0] + v0[1] * v0[1]) + (v0[2] * v0[2] + v0[3] * v0[3]) + (v1[0] * v1[0] + v1[1] * v1[1]) + (v1[2] * v1[2] + v1[3] * v1[3]); }
                q += __shfl_xor(q, 16); q += __shfl_xor(q, 32);
                if (fq == 0) ss[(size_t)row * 16 + u.pn * 4 + wc] = q; }
    }
};
template <class Epi, class Sched, bool ALIGN_EPI = false, bool SP2 = false>
__device__ __forceinline__ void gemm_phase(PG8_LAS unsigned char* lds, const Gemm g, const Sched& S, const Epi& E) {
    const int tid = threadIdx.x, wid = __builtin_amdgcn_readfirstlane(tid >> 6), lane = tid & 63, wr = wid >> 2, wc = wid & 3, fr = lane & 15, fq = lane >> 4;
    const int K = g.K, nt = K / BK;
    unsigned voffA[2], voffB[2];
#pragma unroll
    for (int i = 0; i < 2; ++i) { int R, C; stage_rc(tid * 16 + i * 8192, R, C); const int Rb = Epi::PERM ? ((R & ~31) + perm32(R & 31)) : R;
        voffA[i] = (unsigned)(R * K + C) * 2u; voffB[i] = (unsigned)(Rb * K + C) * 2u; }
    const size_t kstep = (size_t)(BK * 2);
    const size_t hstep = (size_t)HALF * K * 2;
    const size_t tstep = 2 * hstep;
    const unsigned ldsw = (unsigned)wid * 1024u;
    const int aoff = lds_byte(wr * 64 + fr, fq * 8), boff = lds_byte(wc * 32 + fr, fq * 8);
#define PG8_SA(b, h) (((b) * 2 + (h)) * HTB)
#define PG8_SB(b, h) ((4 + (b) * 2 + (h)) * HTB)
#define PG8_STAGE(bufoff, gbase, voff) do { _Pragma("unroll") for (int _i = 0; _i < 2; ++_i) \
        __builtin_amdgcn_global_load_lds((const unsigned*)((const char*)(gbase) + (voff)[_i]), (PG8_LAS unsigned*)(lds + (bufoff) + ldsw + _i * 8192), 16, 0, 0); } while (0)
#define PG8_LDA(dst, b, h) do { _Pragma("unroll") for (int m = 0; m < 4; ++m) _Pragma("unroll") for (int k = 0; k < 2; ++k) dst[m][k] = *(const PG8_LAS bf16x8*)(lds + PG8_SA(b, h) + aoff + m * 2048 + k * 1024); } while (0)
#define PG8_LDB(dst, b, h) do { _Pragma("unroll") for (int n = 0; n < 2; ++n) _Pragma("unroll") for (int k = 0; k < 2; ++k) dst[n][k] = *(const PG8_LAS bf16x8*)(lds + PG8_SB(b, h) + boff + n * 2048 + k * 1024); } while (0)
#define PG8_MMA(ai, bj, At, Bt) do { __builtin_amdgcn_s_setprio(1); _Pragma("unroll") for (int m = 0; m < 4; ++m) _Pragma("unroll") for (int n = 0; n < 2; ++n) _Pragma("unroll") for (int k = 0; k < 2; ++k) \
        acc[ai][bj][m][n] = __builtin_amdgcn_mfma_f32_16x16x32_bf16(Bt[n][k], At[m][k], acc[ai][bj][m][n], 0, 0, 0); __builtin_amdgcn_s_setprio(0); } while (0)
#define PG8_WAIT_V(n) asm volatile("s_waitcnt vmcnt(" #n ")" ::: "memory")
#define PG8_WAIT_L(n) asm volatile("s_waitcnt lgkmcnt(" #n ")" ::: "memory")
#define PG8_BAR __builtin_amdgcn_s_barrier()
#define PG8_SCHED __builtin_amdgcn_sched_barrier(0)
    Unit cur, nxt; int ui = 0;
    if (!S.next(0, cur)) return;
    f32x4 acc[2][2][4][2];
#pragma unroll
    for (int a = 0; a < 2; ++a)
#pragma unroll
        for (int b = 0; b < 2; ++b)
#pragma unroll
            for (int m = 0; m < 4; ++m)
#pragma unroll
                for (int n = 0; n < 2; ++n) acc[a][b][m][n] = (f32x4){0.f, 0.f, 0.f, 0.f};
    bf16x8 At[4][2], B0[2][2], B1[2][2];
    const char* cA = (const char*)g.A + (size_t)cur.pm * tstep; const char* cB = (const char*)g.Bt + (size_t)cur.pn * tstep;
    S.a_ready(cur);
    if constexpr (SP2) {
        PG8_STAGE(PG8_SB(0, 0), cB, voffB); PG8_STAGE(PG8_SB(0, 1), cB + hstep, voffB); PG8_STAGE(PG8_SA(0, 0), cA, voffA); PG8_STAGE(PG8_SA(0, 1), cA + hstep, voffA);
        if (wr == 1) PG8_BAR;
        PG8_WAIT_V(2); PG8_BAR;
        PG8_STAGE(PG8_SB(1, 0), cB + kstep, voffB); PG8_STAGE(PG8_SA(1, 0), cA + kstep, voffA); PG8_STAGE(PG8_SB(1, 1), cB + hstep + kstep, voffB);
        PG8_WAIT_V(6); PG8_BAR;
    } else {
        PG8_STAGE(PG8_SB(0, 0), cB, voffB); PG8_STAGE(PG8_SA(0, 0), cA, voffA); PG8_STAGE(PG8_SB(0, 1), cB + hstep, voffB); PG8_STAGE(PG8_SA(0, 1), cA + hstep, voffA);
        if (wr == 1) PG8_BAR;
        PG8_WAIT_V(4); PG8_BAR;
        PG8_STAGE(PG8_SB(1, 0), cB + kstep, voffB); PG8_STAGE(PG8_SA(1, 0), cA + kstep, voffA); PG8_STAGE(PG8_SB(1, 1), cB + hstep + kstep, voffB);
        PG8_WAIT_V(6); PG8_BAR;
    }
    for (;;) {
        const bool has_next = S.next(ui + 1, nxt);
        const char* nA = has_next ? (const char*)g.A + (size_t)nxt.pm * tstep : cA; const char* nB = has_next ? (const char*)g.Bt + (size_t)nxt.pn * tstep : cB;
        for (int t = 0; t < nt; t += 2) {
            const bool last = (t == nt - 2);
            const char* a1 = cA + (size_t)(t + 1) * kstep;
            const char* a2 = last ? nA : cA + (size_t)(t + 2) * kstep; const char* b2 = last ? nB : cB + (size_t)(t + 2) * kstep;
            const char* a3 = a2 + kstep; const char* b3 = b2 + kstep;
            if (last && has_next) S.a_ready(nxt);
            if constexpr (SP2) {
            PG8_LDB(B0, 0, 0); PG8_LDB(B1, 0, 1); PG8_SCHED; PG8_LDA(At, 0, 0); PG8_STAGE(PG8_SA(1, 1), a1 + hstep, voffA);
            PG8_WAIT_V(8); PG8_WAIT_L(0); PG8_BAR; PG8_MMA(0, 0, At, B0); PG8_MMA(0, 1, At, B1); PG8_BAR; PG8_SCHED;
            PG8_LDA(At, 0, 1); PG8_STAGE(PG8_SB(0, 0), b2, voffB); PG8_STAGE(PG8_SB(0, 1), b2 + hstep, voffB); PG8_STAGE(PG8_SA(0, 0), a2, voffA);
            PG8_WAIT_V(8); PG8_WAIT_L(0); PG8_BAR; PG8_MMA(1, 0, At, B0); PG8_MMA(1, 1, At, B1); PG8_BAR; PG8_SCHED;
            PG8_LDB(B0, 1, 0); PG8_LDB(B1, 1, 1); PG8_SCHED; PG8_LDA(At, 1, 0); PG8_STAGE(PG8_SA(0, 1), a2 + hstep, voffA);
            PG8_WAIT_V(8); PG8_WAIT_L(0); PG8_BAR; PG8_MMA(0, 0, At, B0); PG8_MMA(0, 1, At, B1); PG8_BAR; PG8_SCHED;
            PG8_LDA(At, 1, 1); PG8_STAGE(PG8_SB(1, 0), b3, voffB); PG8_STAGE(PG8_SB(1, 1), b3 + hstep, voffB); PG8_STAGE(PG8_SA(1, 0), a3, voffA);
            PG8_WAIT_V(8); PG8_WAIT_L(0); PG8_BAR; PG8_MMA(1, 0, At, B0); PG8_MMA(1, 1, At, B1); PG8_BAR; PG8_SCHED;
            } else {
            PG8_LDB(B0, 0, 0); PG8_SCHED; PG8_LDA(At, 0, 0); PG8_STAGE(PG8_SA(1, 1), a1 + hstep, voffA);
            PG8_WAIT_L(8); PG8_BAR; PG8_WAIT_L(0); PG8_MMA(0, 0, At, B0); PG8_BAR; PG8_SCHED;
            PG8_LDB(B1, 0, 1); PG8_STAGE(PG8_SB(0, 0), b2, voffB);
            PG8_BAR; PG8_WAIT_L(0); PG8_MMA(0, 1, At, B1); PG8_BAR;
            PG8_LDA(At, 0, 1); PG8_STAGE(PG8_SA(0, 0), a2, voffA);
            PG8_BAR; PG8_WAIT_L(0); PG8_MMA(1, 0, At, B0); PG8_BAR; PG8_SCHED;
            PG8_STAGE(PG8_SB(0, 1), b2 + hstep, voffB);
            PG8_WAIT_V(6); PG8_BAR; PG8_MMA(1, 1, At, B1); PG8_BAR;
            PG8_LDB(B0, 1, 0); PG8_SCHED; PG8_LDA(At, 1, 0); PG8_STAGE(PG8_SA(0, 1), a2 + hstep, voffA);
            PG8_WAIT_L(8); PG8_BAR; PG8_WAIT_L(0); PG8_MMA(0, 0, At, B0); PG8_BAR; PG8_SCHED;
            PG8_LDB(B1, 1, 1); PG8_STAGE(PG8_SB(1, 0), b3, voffB);
            PG8_BAR; PG8_WAIT_L(0); PG8_MMA(0, 1, At, B1); PG8_BAR;
            PG8_LDA(At, 1, 1); PG8_STAGE(PG8_SA(1, 0), a3, voffA);
            PG8_BAR; PG8_WAIT_L(0); PG8_MMA(1, 0, At, B0); PG8_BAR; PG8_SCHED;
            PG8_STAGE(PG8_SB(1, 1), b3 + hstep, voffB);
            PG8_WAIT_V(6); PG8_BAR; PG8_MMA(1, 1, At, B1); PG8_BAR;
            }
        }
        if constexpr (ALIGN_EPI) { if (wr == 0) PG8_BAR; }
        if constexpr (!Epi::AFTER_DRAIN) { E(acc, cur, wr, wc, fr, fq); S.done(cur); }
        if (!has_next) break;
#pragma unroll
        for (int a = 0; a < 2; ++a)
#pragma unroll
            for (int b = 0; b < 2; ++b)
#pragma unroll
                for (int m = 0; m < 4; ++m)
#pragma unroll
                    for (int n = 0; n < 2; ++n) acc[a][b][m][n] = (f32x4){0.f, 0.f, 0.f, 0.f};
        cur = nxt; cA = nA; cB = nB; ++ui;
        if constexpr (ALIGN_EPI) { if (wr == 1) PG8_BAR; }
    }
    PG8_WAIT_V(0);
    if constexpr (!ALIGN_EPI) { if (wr == 0) PG8_BAR; }
    PG8_BAR;
    if constexpr (Epi::AFTER_DRAIN) { E.fused(acc, cur, wr, wc, fr, fq, lds, wid, lane); S.done(cur); }
#undef PG8_SA
#undef PG8_SB
#undef PG8_STAGE
#undef PG8_LDA
#undef PG8_LDB
#undef PG8_MMA
#undef PG8_WAIT_V
#undef PG8_WAIT_L
#undef PG8_BAR
#undef PG8_SCHED
}
}
constexpr int NWAVES = 8;
#ifndef MK_N_LAUNCHES
#define MK_N_LAUNCHES 1
#endif
constexpr int PER_PHASE = 9;
constexpr int N_LAUNCHES = MK_N_LAUNCHES;

constexpr int NB = 4, SEQ = 8192, T = NB * SEQ, D = 1024, DIN = 1280, NEXP = 16384, DQ = 2048;
constexpr float EPS = 1e-6f;

constexpr size_t MiB = 1u << 20;
constexpr size_t WS_CTL = 0, CTL_ZERO_BYTES = 1 * MiB;
constexpr size_t WS_WIN = 2 * MiB;
constexpr size_t WS_WOUT = 5 * MiB;
constexpr size_t WS_WQ = 7 * MiB;
constexpr size_t WS_SK = 11 * MiB;
constexpr size_t WS_POOLT = 11 * MiB + 512 * 1024;
constexpr size_t WS_RSTD1 = 12 * MiB;
constexpr size_t WS_SS2 = 13 * MiB;
constexpr size_t WS_SU = 15 * MiB;
constexpr size_t WS_SV = 15 * MiB + 256 * 1024;
constexpr size_t WS_EXP = 16 * MiB;
constexpr size_t WS_BEST = 24 * MiB;
constexpr size_t WS_CC = 40 * MiB;
constexpr size_t WS_SCC = 44 * MiB;
constexpr size_t WS_U8 = 56 * MiB;
constexpr size_t WS_V8 = 72 * MiB;
constexpr size_t WS_AB = 88 * MiB;
constexpr size_t WS_X1B = 152 * MiB;
constexpr size_t WS_PD = 88 * MiB;
constexpr size_t WS_XB = 216 * MiB;
constexpr size_t WS_Y = 280 * MiB;
constexpr size_t WS_QP = 216 * MiB;
constexpr size_t WS_END = 360 * MiB;
constexpr int CW_BAR = 4096;

constexpr int RING_OFF = 0, RING_BYTES = 131072;
constexpr int LDSCTL_OFF = RING_BYTES, MISC_OFF = LDSCTL_OFF + 320;
constexpr int LDS_BYTES = 147456;
#define GAS __attribute__((address_space(1)))
#define LAS __attribute__((address_space(3)))
typedef unsigned short bf16;
typedef unsigned v4u __attribute__((ext_vector_type(4)));
typedef float f32x4 __attribute__((ext_vector_type(4)));
typedef short bf16x8 __attribute__((ext_vector_type(8)));
typedef GAS unsigned gu32;
typedef GAS unsigned long long gu64;
#define RLX_AGENT __ATOMIC_RELAXED, __HIP_MEMORY_SCOPE_AGENT
#define LDS_WAIT() asm volatile("s_waitcnt lgkmcnt(0)" ::: "memory")
#define VM_WAIT() asm volatile("s_waitcnt vmcnt(0)" ::: "memory")
__device__ __forceinline__ unsigned long long rt() { return __builtin_amdgcn_s_memrealtime(); }
__device__ __forceinline__ unsigned f2bf(float f) { unsigned u = __builtin_bit_cast(unsigned, f); return (u + 0x7fffu + ((u >> 16) & 1u)) >> 16; }
__device__ __forceinline__ unsigned pk2(float lo, float hi) { return f2bf(lo) | (f2bf(hi) << 16); }
#define XB_TMO      128
#define XB_XCNT(j)  (256  + 64 * (j))
#define XB_XSUB(j)  (1280 + 64 * (j))
#define XB_XGEN(j)  (2304 + 64 * (j))
#define XB_TOP      3328
#define XB_TOPGEN   3392
#define XCD_BAR_WORDS 3456
#define XB_SPIN_CAP (1u << 18)

__device__ __forceinline__ unsigned xb_ld(unsigned* p)              { return __hip_atomic_load(p, __ATOMIC_RELAXED, __HIP_MEMORY_SCOPE_AGENT); }
__device__ __forceinline__ unsigned xb_add(unsigned* p, unsigned v) { return __hip_atomic_fetch_add(p, v, __ATOMIC_RELAXED, __HIP_MEMORY_SCOPE_AGENT); }
__device__ __forceinline__ unsigned xb_xcc_id() { return (unsigned)__builtin_amdgcn_s_getreg((3 << 11) | 20) & 0xFu; }
#define XB_SPIN(cond, bar) do { unsigned _sp = 0; while (cond) { __builtin_amdgcn_s_sleep(1); \
    if ((++_sp & 255u) == 0u) { if (xb_ld(&(bar)[XB_TMO])) break; if (_sp > XB_SPIN_CAP) { atomicAdd(&(bar)[XB_TMO], 1u); break; } } } } while (0)

struct XcdBarrier {
    unsigned* bar; unsigned x;
    volatile LAS unsigned* st;
};

__device__ __forceinline__ XcdBarrier xcd_barrier_post(unsigned* bar, volatile LAS unsigned* st) {
    XcdBarrier b; b.bar = bar; b.x = xb_xcc_id(); b.st = st;
    if (threadIdx.x == 0) (void)xb_add(&bar[XB_XCNT(b.x)], 1u);
    return b;
}
__device__ __forceinline__ void xcd_barrier_complete(unsigned* bar, unsigned x, unsigned& nloc, unsigned& nx) {
    const unsigned G = gridDim.x * gridDim.y * gridDim.z;
    unsigned sum, cnt, mine, sp = 0u;
    for (;;) {
        sum = 0u; cnt = 0u; mine = 0u;
#pragma unroll
        for (unsigned j = 0; j < 16; ++j) { const unsigned c = xb_ld(&bar[XB_XCNT(j)]); sum += c; cnt += (c > 0u) ? 1u : 0u; mine = (j == x) ? c : mine; }
        if (sum == G) break;
        __builtin_amdgcn_s_sleep(1);
        if ((++sp & 255u) == 0u) { if (xb_ld(&bar[XB_TMO])) break; if (sp > XB_SPIN_CAP) { atomicAdd(&bar[XB_TMO], 1u); break; } }
    }
    nloc = mine > 0u ? mine : 1u; nx = cnt > 0u ? cnt : 1u;
}

__device__ __forceinline__ void xcd_barrier(const XcdBarrier& b) {
    asm volatile("s_waitcnt vmcnt(0)" ::: "memory");
    __syncthreads();
    if (threadIdx.x == 0) {
        unsigned* bar = b.bar;
        __builtin_amdgcn_s_waitcnt(0);
        unsigned nloc = b.st[0], nx = b.st[1];
        if (nloc == 0u) { xcd_barrier_complete(bar, b.x, nloc, nx); b.st[0] = nloc; b.st[1] = nx; }
        const unsigned old = xb_add(&bar[XB_XSUB(b.x)], 1u);
        const unsigned gen = old / nloc;
        if (old + 1u == (gen + 1u) * nloc) {
            __builtin_amdgcn_fence(__ATOMIC_RELEASE, "agent");
            asm volatile("s_waitcnt vmcnt(0)" ::: "memory");
            const unsigned og = xb_add(&bar[XB_TOP], 1u);
            const unsigned tg = og / nx;
            if (og + 1u == (tg + 1u) * nx) xb_add(&bar[XB_TOPGEN], 1u);
            else XB_SPIN(xb_ld(&bar[XB_TOPGEN]) == tg, bar);
            __builtin_amdgcn_fence(__ATOMIC_ACQUIRE, "agent");
            xb_add(&bar[XB_XGEN(b.x)], 1u);
            asm volatile("s_waitcnt vmcnt(0)" ::: "memory");
        } else {
            XB_SPIN(xb_ld(&bar[XB_XGEN(b.x)]) == gen, bar);
            __builtin_amdgcn_fence(__ATOMIC_ACQUIRE, "agent");
            asm volatile("s_waitcnt vmcnt(0)" ::: "memory");
        }
    }
    __syncthreads();
}
typedef float f32x16 __attribute__((ext_vector_type(16)));
typedef __bf16 bf16x2_t __attribute__((ext_vector_type(2)));
#define MFMA32(a, b, c) __builtin_amdgcn_mfma_f32_32x32x16_bf16((a), (b), (c), 0, 0, 0)
__device__ __forceinline__ float bf_lo(unsigned u) { return __builtin_bit_cast(float, u << 16); }
__device__ __forceinline__ float bf_hi(unsigned u) { return __builtin_bit_cast(float, u & 0xffff0000u); }
__device__ __forceinline__ float dot2_bf16(unsigned w, unsigned x, float acc) { return __builtin_amdgcn_fdot2_f32_bf16(__builtin_bit_cast(bf16x2_t, w), __builtin_bit_cast(bf16x2_t, x), acc, false); }
__device__ __forceinline__ float wave_sum(float v) {
#pragma unroll
    for (int o = 1; o < 64; o <<= 1) v += __shfl_xor(v, o);
    return v;
}

__device__ __forceinline__ void p0_transpose_item(const float* W, int K, int N, bf16* WT, const float* gk, LAS float* scr, int item, int lane) {
    const int nblk = N / 32, kb = item / nblk, nb = item % nblk, k0 = 64 * kb, n0 = 32 * nb;
#pragma unroll 8
    for (int i = 0; i < 32; ++i) { const int kk = 2 * i + (lane >> 5); float w = W[(size_t)(k0 + kk) * N + n0 + (lane & 31)]; if (gk) w *= gk[k0 + kk]; scr[kk * 33 + (lane & 31)] = w; }
    LDS_WAIT(); asm volatile("" ::: "memory");
    const int c = lane & 7;
#pragma unroll
    for (int j = 0; j < 4; ++j) { const int n = (lane >> 3) + 8 * j; const LAS float* s = scr + (8 * c) * 33 + n;
        v4u o; o.x = pk2(s[0 * 33], s[1 * 33]); o.y = pk2(s[2 * 33], s[3 * 33]); o.z = pk2(s[4 * 33], s[5 * 33]); o.w = pk2(s[6 * 33], s[7 * 33]);
        *(GAS v4u*)(WT + (size_t)(n0 + n) * K + k0 + 8 * c) = o; }
    LDS_WAIT(); asm volatile("" ::: "memory");
}
__device__ __forceinline__ float row_to_bf16(const float* src, bf16* dst, const float* g, int lane) {
    const GAS f32x4* xr = (const GAS f32x4*)src + lane; float s = 0.f;
    GAS unsigned long long* o8 = (GAS unsigned long long*)dst + lane;
#pragma unroll
    for (int j = 0; j < 4; ++j) { f32x4 v = xr[64 * j]; s += (v.x * v.x + v.y * v.y) + (v.z * v.z + v.w * v.w);
        if (g) { const f32x4 gv = ((const GAS f32x4*)g)[64 * j + lane]; v = v * gv; }
        o8[64 * j] = (unsigned long long)pk2(v.x, v.y) | ((unsigned long long)pk2(v.z, v.w) << 32); }
    return s;
}
__device__ __forceinline__ void row_to_i8(const float* src, unsigned char* dst, const float* g, float* sc, int m, int lane) {
    const GAS f32x4* xr = (const GAS f32x4*)src + lane; f32x4 v[4]; float amax = 0.f;
#pragma unroll
    for (int j = 0; j < 4; ++j) { v[j] = xr[64 * j]; if (g) { const f32x4 gv = ((const GAS f32x4*)g)[64 * j + lane]; v[j] = v[j] * gv; }
        amax = fmaxf(fmaxf(amax, fmaxf(fabsf(v[j].x), fabsf(v[j].y))), fmaxf(fabsf(v[j].z), fabsf(v[j].w))); }
#pragma unroll
    for (int o = 1; o < 64; o <<= 1) amax = fmaxf(amax, __shfl_xor(amax, o));
    const float inv = amax > 0.f ? 127.0f / amax : 0.f;
    GAS unsigned* o4 = (GAS unsigned*)dst + lane;
#pragma unroll
    for (int j = 0; j < 4; ++j) { const unsigned q0 = (unsigned)__float2int_rn(v[j].x * inv) & 0xffu, q1 = (unsigned)__float2int_rn(v[j].y * inv) & 0xffu, q2 = (unsigned)__float2int_rn(v[j].z * inv) & 0xffu, q3 = (unsigned)__float2int_rn(v[j].w * inv) & 0xffu;
        o4[64 * j] = q0 | (q1 << 8) | (q2 << 16) | (q3 << 24); }
    if (lane == 0) sc[m] = amax * (1.0f / 127.0f);
}
__device__ __forceinline__ void p0_poolfold_item(const float* w_in, const float* pool_w, const float* g1, bf16* WinT, int item, int lane) {
    const int kb = item & 15, nb = (item >> 4) & 15, g = item >> 8, k = 64 * kb + lane, n0 = 8 * nb;
    const GAS f32x4* wr = (const GAS f32x4*)(w_in + (size_t)k * DIN + 768 + 128 * g);
    const float* pw = pool_w + (size_t)g * 16384 + n0;
    float acc[8];
#pragma unroll
    for (int n = 0; n < 8; ++n) acc[n] = 0.f;
    for (int c4 = 0; c4 < 32; ++c4) { const f32x4 a = wr[c4];
#pragma unroll
        for (int n = 0; n < 8; ++n) { acc[n] = fmaf(a.x, pw[(4 * c4 + 0) * 128 + n], acc[n]); acc[n] = fmaf(a.y, pw[(4 * c4 + 1) * 128 + n], acc[n]); acc[n] = fmaf(a.z, pw[(4 * c4 + 2) * 128 + n], acc[n]); acc[n] = fmaf(a.w, pw[(4 * c4 + 3) * 128 + n], acc[n]); } }
    const float gk = g1[k];
#pragma unroll
    for (int n = 0; n < 8; ++n) WinT[(size_t)(768 + 128 * g + n0 + n) * D + k] = (bf16)f2bf(acc[n] * gk);
}
struct P0Args { const float *x, *g1, *w_in, *pool_w, *w_out, *g2, *wq, *sk, *u, *v; bf16 *XB, *WinT, *WoutT, *WqT, *SK, *PoolT; unsigned char *U8, *V8; float *su, *sv; float* rstd1; };
__device__ __forceinline__ void p0_prologue(const P0Args& a, LAS unsigned char* lds, int gw, int NGW, int wave, int lane) {
    LAS float* scr = (LAS float*)(lds + RING_OFF + wave * 16384);
    constexpr int I_IN = (D / 64) * (768 / 32), I_OUT = (D / 64) * (D / 32), I_Q = (D / 64) * (DQ / 32), I_P = 4 * 16 * 16;
    constexpr int NITEMS = I_P + I_IN + I_OUT + I_Q;
    for (int it = gw; it < NITEMS; it += NGW) {
        int r = it;
        if (r < I_P) { p0_poolfold_item(a.w_in, a.pool_w, a.g1, a.WinT, r, lane); continue; } r -= I_P;
        if (r < I_IN) { const int kb = r / 24, nb = r % 24; p0_transpose_item(a.w_in, D, DIN, a.WinT, a.g1, scr, kb * 40 + nb, lane); continue; } r -= I_IN;
        if (r < I_OUT) { p0_transpose_item(a.w_out, D, D, a.WoutT, nullptr, scr, r, lane); continue; } r -= I_OUT;
        p0_transpose_item(a.wq, D, DQ, a.WqT, a.g2, scr, r, lane);
    }
    for (int m = gw; m < T; m += NGW) {
        const float s = wave_sum(row_to_bf16(a.x + (size_t)m * D, a.XB + (size_t)m * D, nullptr, lane));
        if (lane == 0) a.rstd1[m] = 1.0f / sqrtf(s * (1.0f / D) + EPS);
    }
    for (int m = gw; m < NEXP; m += NGW) {
        row_to_i8(a.u + (size_t)m * D, a.U8 + (size_t)m * D, a.g2, a.su, m, lane);
        row_to_i8(a.v + (size_t)m * D, a.V8 + (size_t)m * D, nullptr, a.sv, m, lane);
    }
    for (int m = gw; m < 256; m += NGW) (void)row_to_bf16(a.sk + (size_t)m * D, a.SK + (size_t)m * D, nullptr, lane);
}

__device__ __forceinline__ int t5_bucket(int rel) {
    const int n = rel < 0 ? -rel : rel; const int base = rel > 0 ? 16 : 0;
    const int v = n < 8 ? n : (n < 12 ? 8 : (n < 16 ? 9 : (n < 23 ? 10 : (n < 32 ? 11 : (n < 46 ? 12 : (n < 64 ? 13 : (n < 91 ? 14 : 15)))))));
    return base + v;
}
__device__ __forceinline__ void attn_unit(LAS unsigned char* lds, const bf16* Y, bf16* AB, const float* qg, const float* kg, const float* sinks, const float* relb,
                                          int unit, int tid, int wave, int lane) {
    const int kvh = unit & 1, c = (unit >> 1) & 127, b = unit >> 8;
    LAS bf16* Ks = (LAS bf16*)lds;
    LAS bf16* Vt = (LAS bf16*)(lds + 27648);
    LAS float* bt = (LAS float*)(lds + 53248);
    const int row0 = b * SEQ + (c - 2) * 64;
#pragma unroll
    for (int rep = 0; rep < 3; ++rep) {
        const int it = tid + rep * 512, j = it >> 3, ch = it & 7;
        const bool valid = (c - 2 + (j >> 6)) >= 0;
        v4u kraw = {0u, 0u, 0u, 0u}, vraw = {0u, 0u, 0u, 0u};
        if (valid) { const bf16* rp = Y + (size_t)(row0 + j) * DIN; kraw = *(const GAS v4u*)(rp + 512 + 64 * kvh + 8 * ch); vraw = *(const GAS v4u*)(rp + 640 + 64 * kvh + 8 * ch); }
        float kf[8] = {bf_lo(kraw.x), bf_hi(kraw.x), bf_lo(kraw.y), bf_hi(kraw.y), bf_lo(kraw.z), bf_hi(kraw.z), bf_lo(kraw.w), bf_hi(kraw.w)};
        float ss = 0.f;
#pragma unroll
        for (int e = 0; e < 8; ++e) ss += kf[e] * kf[e];
        ss += __shfl_xor(ss, 1); ss += __shfl_xor(ss, 2); ss += __shfl_xor(ss, 4);
        const float r = 1.0f / sqrtf(ss * (1.0f / 64.0f) + EPS);
        const f32x4 g0 = *(const GAS f32x4*)(kg + 8 * ch), g1 = *(const GAS f32x4*)(kg + 8 * ch + 4);
        v4u ko; ko.x = pk2(kf[0] * r * g0.x, kf[1] * r * g0.y); ko.y = pk2(kf[2] * r * g0.z, kf[3] * r * g0.w); ko.z = pk2(kf[4] * r * g1.x, kf[5] * r * g1.y); ko.w = pk2(kf[6] * r * g1.z, kf[7] * r * g1.w);
        *(LAS v4u*)(Ks + j * 72 + 8 * ch) = ko;
        const int s16 = j >> 4, kk = j & 15, hh = (kk >> 2) & 1, jj = ((kk >> 3) << 2) | (kk & 3), pos = 16 * s16 + 8 * hh + jj;
        LAS bf16* vp = Vt + (8 * ch) * 200 + pos;
        vp[0 * 200] = (bf16)(vraw.x & 0xffffu); vp[1 * 200] = (bf16)(vraw.x >> 16); vp[2 * 200] = (bf16)(vraw.y & 0xffffu); vp[3 * 200] = (bf16)(vraw.y >> 16);
        vp[4 * 200] = (bf16)(vraw.z & 0xffffu); vp[5 * 200] = (bf16)(vraw.z >> 16); vp[6 * 200] = (bf16)(vraw.w & 0xffffu); vp[7 * 200] = (bf16)(vraw.w >> 16);
    }
#pragma unroll
    for (int rep = 0; rep < 2; ++rep) { const int it = tid + rep * 512, g = it >> 8, r = it & 255; bt[it] = relb[t5_bucket(r - 191) * 8 + kvh * 4 + g]; }
    LDS_WAIT(); __syncthreads();

    const int g = wave >> 1, i = 32 * (wave & 1) + (lane & 31), hh = lane >> 5, habs = kvh * 4 + g;
    const size_t qrow = (size_t)b * SEQ + (size_t)c * 64 + i;
    const bf16* qp = Y + qrow * DIN + habs * 64 + 8 * hh;
    v4u qraw[4]; float ss = 0.f;
#pragma unroll
    for (int s = 0; s < 4; ++s) { qraw[s] = *(const GAS v4u*)(qp + 16 * s);
        const float f0 = bf_lo(qraw[s].x), f1 = bf_hi(qraw[s].x), f2 = bf_lo(qraw[s].y), f3 = bf_hi(qraw[s].y), f4 = bf_lo(qraw[s].z), f5 = bf_hi(qraw[s].z), f6 = bf_lo(qraw[s].w), f7 = bf_hi(qraw[s].w);
        ss += (f0 * f0 + f1 * f1) + (f2 * f2 + f3 * f3) + (f4 * f4 + f5 * f5) + (f6 * f6 + f7 * f7); }
    ss += __shfl_xor(ss, 32);
    const float rq = 0.125f / sqrtf(ss * (1.0f / 64.0f) + EPS);
    bf16x8 qf[4];
#pragma unroll
    for (int s = 0; s < 4; ++s) { const f32x4 g0 = *(const GAS f32x4*)(qg + 16 * s + 8 * hh), g1 = *(const GAS f32x4*)(qg + 16 * s + 8 * hh + 4);
        v4u w; w.x = pk2(bf_lo(qraw[s].x) * rq * g0.x, bf_hi(qraw[s].x) * rq * g0.y); w.y = pk2(bf_lo(qraw[s].y) * rq * g0.z, bf_hi(qraw[s].y) * rq * g0.w);
        w.z = pk2(bf_lo(qraw[s].z) * rq * g1.x, bf_hi(qraw[s].z) * rq * g1.y); w.w = pk2(bf_lo(qraw[s].w) * rq * g1.z, bf_hi(qraw[s].w) * rq * g1.w);
        qf[s] = __builtin_bit_cast(bf16x8, w); }
    f32x16 sacc[6];
#pragma unroll
    for (int kt = 0; kt < 6; ++kt) {
#pragma unroll
        for (int r = 0; r < 16; ++r) sacc[kt][r] = 0.f;
#pragma unroll
        for (int s = 0; s < 4; ++s) { const bf16x8 a = *(const LAS bf16x8*)(Ks + (32 * kt + (lane & 31)) * 72 + 16 * s + 8 * hh); sacc[kt] = MFMA32(a, qf[s], sacc[kt]); }
    }
    const LAS float* btg = bt + g * 256 + 63 - i;
    float mx = -3.0e38f;
#pragma unroll
    for (int kt = 0; kt < 6; ++kt) { const bool masked = (c - 2 + (kt >> 1)) < 0;
#pragma unroll
        for (int r = 0; r < 16; ++r) { const int j = 32 * kt + (r & 3) + 8 * (r >> 2) + 4 * hh; float v = sacc[kt][r] + btg[j]; v = masked ? -1.0e30f : v; sacc[kt][r] = v; mx = fmaxf(mx, v); } }
    mx = fmaxf(mx, __shfl_xor(mx, 32));
    const float sink = sinks[habs], m = fmaxf(mx, sink);
    float sum = 0.f;
#pragma unroll
    for (int kt = 0; kt < 6; ++kt)
#pragma unroll
        for (int r = 0; r < 16; ++r) { const float p = __expf(sacc[kt][r] - m); sacc[kt][r] = p; sum += p; }
    sum += __shfl_xor(sum, 32);
    const float inv = 1.0f / (sum + __expf(sink - m));
    f32x16 oacc[2];
#pragma unroll
    for (int dt = 0; dt < 2; ++dt)
#pragma unroll
        for (int r = 0; r < 16; ++r) oacc[dt][r] = 0.f;
#pragma unroll
    for (int kt = 0; kt < 6; ++kt)
#pragma unroll
        for (int s2 = 0; s2 < 2; ++s2) {
            v4u w; w.x = pk2(sacc[kt][8 * s2 + 0], sacc[kt][8 * s2 + 1]); w.y = pk2(sacc[kt][8 * s2 + 2], sacc[kt][8 * s2 + 3]); w.z = pk2(sacc[kt][8 * s2 + 4], sacc[kt][8 * s2 + 5]); w.w = pk2(sacc[kt][8 * s2 + 6], sacc[kt][8 * s2 + 7]);
            const bf16x8 pb = __builtin_bit_cast(bf16x8, w);
#pragma unroll
            for (int dt = 0; dt < 2; ++dt) { const bf16x8 a = *(const LAS bf16x8*)(Vt + (32 * dt + (lane & 31)) * 200 + 32 * kt + 16 * s2 + 8 * hh); oacc[dt] = MFMA32(a, pb, oacc[dt]); }
        }
    bf16* op = AB + qrow * D + habs * 64;
#pragma unroll
    for (int dt = 0; dt < 2; ++dt)
#pragma unroll
        for (int q4 = 0; q4 < 4; ++q4) { const int d = 32 * dt + 8 * q4 + 4 * hh;
            const unsigned long long o = (unsigned long long)pk2(oacc[dt][4 * q4 + 0] * inv, oacc[dt][4 * q4 + 1] * inv) | ((unsigned long long)pk2(oacc[dt][4 * q4 + 2] * inv, oacc[dt][4 * q4 + 3] * inv) << 32);
            *(GAS unsigned long long*)(op + d) = o; }
    __syncthreads();
}

template <int W> __device__ __forceinline__ void pool_walk(const bf16* zc, bf16* oc, float s0, float s1, int pos0) {
    unsigned ring[16];
    float a0 = 0.f, a1 = 0.f;
#pragma unroll
    for (int q = 0; q < 16; ++q) ring[q] = 0u;
#pragma unroll
    for (int q = 1; q < W; ++q) { if (pos0 - q >= 0) { const unsigned u = *(const GAS unsigned*)(zc - (size_t)q * DIN); ring[(16 - q) & 15] = u; a0 += bf_lo(u); a1 += bf_hi(u); } }
    for (int rb = 0; rb < 64; rb += 16) {
#pragma unroll
        for (int i = 0; i < 16; ++i) {
            const unsigned u = *(const GAS unsigned*)(zc + (size_t)(rb + i) * DIN);
            const float c0 = bf_lo(u), c1 = bf_hi(u);
            a0 += c0; a1 += c1;
            const int pos = pos0 + rb + i; const float ic = 1.0f / (float)(pos + 1 < W ? pos + 1 : W);
            *(GAS unsigned*)(oc + (size_t)(rb + i) * D) = pk2((a0 * ic - c0) * s0, (a1 * ic - c1) * s1);
            const unsigned old = ring[(i + 17 - W) & 15];
            a0 -= bf_lo(old); a1 -= bf_hi(old);
            ring[i] = u;
        }
    }
}
__device__ __forceinline__ void pool_rows(const bf16* Y, bf16* AB, const float* pscale, int unit, int tid) {
    const int cp = tid & 255, seg = tid >> 8, g = cp >> 6;
    const int r0 = unit * 128 + seg * 64, pos0 = r0 & (SEQ - 1);
    const bf16* zc = Y + (size_t)r0 * DIN + 768 + 2 * cp; bf16* oc = AB + (size_t)r0 * D + 512 + 2 * cp;
    const float s0 = pscale[2 * cp], s1 = pscale[2 * cp + 1];
    if (g == 0) pool_walk<2>(zc, oc, s0, s1, pos0); else if (g == 1) pool_walk<4>(zc, oc, s0, s1, pos0); else if (g == 2) pool_walk<8>(zc, oc, s0, s1, pos0); else pool_walk<16>(zc, oc, s0, s1, pos0);
}

__device__ __forceinline__ int f2key(float f) { int i = __builtin_bit_cast(int, f); return i ^ ((i >> 31) & 0x7fffffff); }
__device__ __forceinline__ float key2f(int k) { return __builtin_bit_cast(float, k ^ ((k >> 31) & 0x7fffffff)); }
#define CE_DESC(a, b) do { const int _x = (a), _y = (b); (a) = _x > _y ? _x : _y; (b) = _x > _y ? _y : _x; } while (0)
__device__ __forceinline__ void sort16_desc(int (&a)[16]) {
#pragma unroll
    for (int k = 2; k <= 16; k <<= 1)
#pragma unroll
        for (int j = k >> 1; j > 0; j >>= 1)
#pragma unroll
            for (int i = 0; i < 16; ++i) { const int l = i ^ j; if (l > i) { if ((i & k) == 0) CE_DESC(a[i], a[l]); else CE_DESC(a[l], a[i]); } }
}
__device__ __forceinline__ void merge_top16(int (&a)[16], const int (&b)[16]) {
#pragma unroll
    for (int i = 0; i < 16; ++i) a[i] = a[i] > b[15 - i] ? a[i] : b[15 - i];
#pragma unroll
    for (int j = 8; j > 0; j >>= 1)
#pragma unroll
        for (int i = 0; i < 16; ++i) { const int l = i ^ j; if (l > i) CE_DESC(a[i], a[l]); }
}
__device__ __forceinline__ void top16_of_64(int (&g0)[16], int (&g1)[16], int (&g2)[16], int (&g3)[16]) {
    sort16_desc(g0); sort16_desc(g1); sort16_desc(g2); sort16_desc(g3);
    merge_top16(g0, g1); merge_top16(g2, g3); merge_top16(g0, g2);
}
__device__ __forceinline__ void topk_unit(LAS unsigned char* lds, const bf16* QP, const bf16* SK, unsigned short* EXPERTS, float* BEST, int unit, int tid, int wave, int lane) {
    const int h = unit & 7, tt = unit >> 3, hh = lane >> 5;
    const int tok = tt * 256 + wave * 32 + (lane & 31);
    LAS int* mine = (LAS int*)lds + tid * 33;
    int top[2][16];
#pragma unroll
    for (int p = 0; p < 2; ++p) {
        const bf16* qp = QP + (size_t)tok * DQ + h * 256 + p * 128 + 8 * hh;
        const bf16* kp = SK + (size_t)(h * 2 + p) * 16384 + (size_t)(lane & 31) * 128 + 8 * hh;
        f32x16 acc[4];
#pragma unroll
        for (int nt = 0; nt < 4; ++nt)
#pragma unroll
            for (int r = 0; r < 16; ++r) acc[nt][r] = 0.f;
#pragma unroll
        for (int s = 0; s < 8; ++s) { const bf16x8 bq = __builtin_bit_cast(bf16x8, *(const GAS v4u*)(qp + 16 * s));
#pragma unroll
            for (int nt = 0; nt < 4; ++nt) { const bf16x8 a = __builtin_bit_cast(bf16x8, *(const GAS v4u*)(kp + (size_t)nt * 32 * 128 + 16 * s)); acc[nt] = MFMA32(a, bq, acc[nt]); } }
        int k0[16], k1[16], k2[16], k3[16];
#pragma unroll
        for (int r = 0; r < 16; ++r) { const int n = (r & 3) + 8 * (r >> 2) + 4 * hh;
            k0[r] = (f2key(acc[0][r]) & ~127) | n; k1[r] = (f2key(acc[1][r]) & ~127) | (32 + n); k2[r] = (f2key(acc[2][r]) & ~127) | (64 + n); k3[r] = (f2key(acc[3][r]) & ~127) | (96 + n); }
        top16_of_64(k0, k1, k2, k3);
#pragma unroll
        for (int r = 0; r < 16; ++r) k1[r] = __shfl_xor(k0[r], 32);
        merge_top16(k0, k1);
#pragma unroll
        for (int r = 0; r < 16; ++r) top[p][r] = k0[r];
    }
    int c0[16], c1[16], c2[16], c3[16];
    {
        float v1[16], v2[16];
#pragma unroll
        for (int r = 0; r < 16; ++r) { v1[r] = key2f(top[0][r] & ~127); v2[r] = key2f(top[1][r] & ~127); mine[r] = top[0][r]; mine[16 + r] = top[1][r]; }
        int cnt = 0;
#pragma unroll
        for (int i = 0; i < 16; ++i)
#pragma unroll
            for (int j = 0; j < 16; ++j) if ((i + 1) * (j + 1) <= 16) { const int key = (f2key(v1[i] + v2[j]) & ~255) | (i << 4) | j;
                if (cnt < 16) c0[cnt] = key; else if (cnt < 32) c1[cnt - 16] = key; else if (cnt < 48) c2[cnt - 32] = key; else c3[cnt - 48] = key; ++cnt; }
#pragma unroll
        for (int r = 0; r < 16; ++r) if (48 + r >= cnt) c3[r] = (int)0x80000000;
    }
    top16_of_64(c0, c1, c2, c3);
    LDS_WAIT();
    if (hh == 0) {
        int ev[16]; float bv[16];
#pragma unroll
        for (int r = 0; r < 16; ++r) { const int id = c0[r] & 255; const int ka = mine[id >> 4], kb = mine[16 + (id & 15)];
            ev[r] = (ka & 127) * 128 + (kb & 127); bv[r] = key2f(ka & ~127) + key2f(kb & ~127); }
        unsigned short* ep = EXPERTS + (size_t)tok * 128 + h * 16; float* bp = BEST + (size_t)tok * 128 + h * 16;
#pragma unroll
        for (int r = 0; r < 16; r += 8) *(GAS v4u*)(ep + r) = (v4u){(unsigned)ev[r] | ((unsigned)ev[r + 1] << 16), (unsigned)ev[r + 2] | ((unsigned)ev[r + 3] << 16), (unsigned)ev[r + 4] | ((unsigned)ev[r + 5] << 16), (unsigned)ev[r + 6] | ((unsigned)ev[r + 7] << 16)};
#pragma unroll
        for (int r = 0; r < 16; r += 4) *(GAS f32x4*)(bp + r) = (f32x4){bv[r], bv[r + 1], bv[r + 2], bv[r + 3]};
    }
    LDS_WAIT();
}

__device__ __forceinline__ float gelu_erf(float x) { return 0.5f * x * (1.0f + erff(x * 0.70710678118654752f)); }
#define PEER_ROWS(r, tab, q) do { const v4u _ev = *(const LAS v4u*)(evp + 16 * (q)); \
        r[0] = *(const GAS v4u*)(tab + (size_t)(_ev.x & 0xffffu) * D); r[1] = *(const GAS v4u*)(tab + (size_t)(_ev.x >> 16) * D); \
        r[2] = *(const GAS v4u*)(tab + (size_t)(_ev.y & 0xffffu) * D); r[3] = *(const GAS v4u*)(tab + (size_t)(_ev.y >> 16) * D); \
        r[4] = *(const GAS v4u*)(tab + (size_t)(_ev.z & 0xffffu) * D); r[5] = *(const GAS v4u*)(tab + (size_t)(_ev.z >> 16) * D); \
        r[6] = *(const GAS v4u*)(tab + (size_t)(_ev.w & 0xffffu) * D); r[7] = *(const GAS v4u*)(tab + (size_t)(_ev.w >> 16) * D); } while (0)
__device__ __forceinline__ unsigned pack_i8x4(float a, float b, float c, float d) {
    return ((unsigned)__float2int_rn(a) & 0xffu) | (((unsigned)__float2int_rn(b) & 0xffu) << 8) | (((unsigned)__float2int_rn(c) & 0xffu) << 16) | (((unsigned)__float2int_rn(d) & 0xffu) << 24);
}
__device__ __forceinline__ void peer_u_phase(LAS unsigned char* lds, const float* X1, const unsigned char* U8, const unsigned short* EXP16, float* PD, int j, int w, int nw, int wave, int lane) {
    const int grp = lane >> 3, sub = lane & 7;
    LAS unsigned char* wl = lds + wave * 8192;
    const LAS unsigned char* evp = wl + grp * 256;
    const int stride = nw * NWAVES * 8;
    int tb = (w * NWAVES + wave) * 8;
    v4u pe0 = {0u, 0u, 0u, 0u}, pe1 = {0u, 0u, 0u, 0u};
    if (tb < T) { const GAS v4u* e = (const GAS v4u*)(EXP16 + (size_t)tb * 128) + lane; pe0 = e[0]; pe1 = e[64]; }
    const unsigned char* ub = U8 + 128 * j + 16 * sub;
    for (; tb < T; tb += stride) {
        *(LAS v4u*)(wl + 16 * lane) = pe0; *(LAS v4u*)(wl + 1024 + 16 * lane) = pe1;
        if (tb + stride < T) { const GAS v4u* e = (const GAS v4u*)(EXP16 + (size_t)(tb + stride) * 128) + lane; pe0 = e[0]; pe1 = e[64]; }
        const int t = tb + grp;
        const GAS f32x4* xp = (const GAS f32x4*)(X1 + (size_t)t * D + 128 * j + 16 * sub);
        const f32x4 x0 = xp[0], x1 = xp[1], x2 = xp[2], x3 = xp[3];
        float amax = fmaxf(fmaxf(fmaxf(fabsf(x0.x), fabsf(x0.y)), fmaxf(fabsf(x0.z), fabsf(x0.w))), fmaxf(fmaxf(fabsf(x1.x), fabsf(x1.y)), fmaxf(fabsf(x1.z), fabsf(x1.w))));
        amax = fmaxf(amax, fmaxf(fmaxf(fmaxf(fabsf(x2.x), fabsf(x2.y)), fmaxf(fabsf(x2.z), fabsf(x2.w))), fmaxf(fmaxf(fabsf(x3.x), fabsf(x3.y)), fmaxf(fabsf(x3.z), fabsf(x3.w)))));
        amax = fmaxf(amax, __shfl_xor(amax, 1)); amax = fmaxf(amax, __shfl_xor(amax, 2)); amax = fmaxf(amax, __shfl_xor(amax, 4));
        const float inv = amax > 0.f ? 127.0f / amax : 0.f, sx = amax * (1.0f / 127.0f);
        const unsigned xq0 = pack_i8x4(x0.x * inv, x0.y * inv, x0.z * inv, x0.w * inv), xq1 = pack_i8x4(x1.x * inv, x1.y * inv, x1.z * inv, x1.w * inv);
        const unsigned xq2 = pack_i8x4(x2.x * inv, x2.y * inv, x2.z * inv, x2.w * inv), xq3 = pack_i8x4(x3.x * inv, x3.y * inv, x3.z * inv, x3.w * inv);
        float* pd = PD + ((size_t)j * T + t) * 128 + sub;
        LDS_WAIT();
        v4u ra[8], rb[8], rc[8];
        PEER_ROWS(ra, ub, 0); PEER_ROWS(rb, ub, 1);
#define PEER_UDOT(r, q) do { int p[8]; _Pragma("unroll") for (int i = 0; i < 8; ++i) { int a = __builtin_amdgcn_sdot4((int)r[i].x, (int)xq0, 0, false); a = __builtin_amdgcn_sdot4((int)r[i].y, (int)xq1, a, false); \
                a = __builtin_amdgcn_sdot4((int)r[i].z, (int)xq2, a, false); p[i] = __builtin_amdgcn_sdot4((int)r[i].w, (int)xq3, a, false); } \
            _Pragma("unroll") for (int o = 4; o > 0; o >>= 1) { const bool up = (sub & o) != 0; \
                _Pragma("unroll") for (int i = 0; i < o; ++i) { const int keep = up ? p[i + o] : p[i], send = up ? p[i] : p[i + o]; p[i] = keep + __shfl_xor(send, o); } } \
            pd[8 * (q)] = (float)p[0] * sx; } while (0)
        for (int q = 0; q < 15; q += 3) {
            PEER_ROWS(rc, ub, q + 2); PEER_UDOT(ra, q);
            PEER_ROWS(ra, ub, q + 3); PEER_UDOT(rb, q + 1);
            if (q + 4 < 16) PEER_ROWS(rb, ub, q + 4);
            PEER_UDOT(rc, q + 2);
        }
        PEER_UDOT(ra, 15);
    }
}
__device__ __forceinline__ void peer_combine(const float* PD, const unsigned short* EXP16, const float* BEST, const float* SS2, const float* su, const float* sv, unsigned char* CC8, float* SCC, int t, int lane) {
    float ssq = 0.f;
    { const GAS f32x4* sp = (const GAS f32x4*)(SS2 + (size_t)t * 16);
#pragma unroll
      for (int q = 0; q < 4; ++q) { const f32x4 v = sp[q]; ssq += (v.x + v.y) + (v.z + v.w); } }
    const float rstd2 = 1.0f / sqrtf(ssq * (1.0f / D) + EPS);
    float c[2];
#pragma unroll
    for (int hf = 0; hf < 2; ++hf) {
        const int k = 64 * hf + lane; const int e = EXP16[(size_t)t * 128 + k];
        const float sb = BEST[(size_t)t * 128 + k] * rstd2;
        float mx = sb;
#pragma unroll
        for (int o = 1; o < 16; o <<= 1) mx = fmaxf(mx, __shfl_xor(mx, o));
        const float ex = __expf(sb - mx); float sm = ex;
#pragma unroll
        for (int o = 1; o < 16; o <<= 1) sm += __shfl_xor(sm, o);
        float dot = 0.f;
#pragma unroll
        for (int j = 0; j < 8; ++j) dot += PD[((size_t)j * T + t) * 128 + k];
        c[hf] = (ex / sm) * gelu_erf(dot * rstd2 * su[e]) * sv[e];
    }
    float amax = fmaxf(fabsf(c[0]), fabsf(c[1]));
#pragma unroll
    for (int o = 1; o < 64; o <<= 1) amax = fmaxf(amax, __shfl_xor(amax, o));
    const float inv = amax > 0.f ? 127.0f / amax : 0.f;
    CC8[(size_t)t * 128 + lane] = (unsigned char)(__float2int_rn(c[0] * inv) & 0xff);
    CC8[(size_t)t * 128 + 64 + lane] = (unsigned char)(__float2int_rn(c[1] * inv) & 0xff);
    if (lane == 0) SCC[t] = amax * (1.0f / 127.0f);
}
__device__ __forceinline__ void peer_v_phase(LAS unsigned char* lds, float* OUT, const unsigned char* V8, const unsigned short* EXP16, const unsigned char* CC8, const float* SCC, int j, int w, int nw, int wave, int lane) {
    const int grp = lane >> 3, sub = lane & 7;
    LAS unsigned char* wl = lds + wave * 8192;
    const LAS unsigned char* evp = wl + grp * 256;
    const LAS unsigned char* ccp = wl + 2048 + grp * 128;
    const int stride = nw * NWAVES * 8;
    int tb = (w * NWAVES + wave) * 8;
    v4u pe0 = {0u, 0u, 0u, 0u}, pe1 = {0u, 0u, 0u, 0u}, pc0 = {0u, 0u, 0u, 0u};
    if (tb < T) { const GAS v4u* e = (const GAS v4u*)(EXP16 + (size_t)tb * 128) + lane; pe0 = e[0]; pe1 = e[64]; pc0 = ((const GAS v4u*)(CC8 + (size_t)tb * 128))[lane]; }
    const unsigned char* vb = V8 + 128 * j + 16 * sub;
    for (; tb < T; tb += stride) {
        *(LAS v4u*)(wl + 16 * lane) = pe0; *(LAS v4u*)(wl + 1024 + 16 * lane) = pe1; *(LAS v4u*)(wl + 2048 + 16 * lane) = pc0;
        if (tb + stride < T) { const GAS v4u* e = (const GAS v4u*)(EXP16 + (size_t)(tb + stride) * 128) + lane; pe0 = e[0]; pe1 = e[64]; pc0 = ((const GAS v4u*)(CC8 + (size_t)(tb + stride) * 128))[lane]; }
        const int t = tb + grp;
        const float scc = SCC[t];
        int acc[16];
#pragma unroll
        for (int i = 0; i < 16; ++i) acc[i] = 0;
        LDS_WAIT();
        v4u ra[8], rb[8], rc[8];
        PEER_ROWS(ra, vb, 0); PEER_ROWS(rb, vb, 1);
#define PEER_T4(w_, r0, r1, r2, r3, cpk) do { const unsigned tl0 = __builtin_amdgcn_perm(r1, r0, 0x05010400u), th0 = __builtin_amdgcn_perm(r1, r0, 0x07030602u); \
            const unsigned tl1 = __builtin_amdgcn_perm(r3, r2, 0x05010400u), th1 = __builtin_amdgcn_perm(r3, r2, 0x07030602u); \
            acc[4 * (w_) + 0] = __builtin_amdgcn_sdot4((int)__builtin_amdgcn_perm(tl1, tl0, 0x05040100u), (int)(cpk), acc[4 * (w_) + 0], false); \
            acc[4 * (w_) + 1] = __builtin_amdgcn_sdot4((int)__builtin_amdgcn_perm(tl1, tl0, 0x07060302u), (int)(cpk), acc[4 * (w_) + 1], false); \
            acc[4 * (w_) + 2] = __builtin_amdgcn_sdot4((int)__builtin_amdgcn_perm(th1, th0, 0x05040100u), (int)(cpk), acc[4 * (w_) + 2], false); \
            acc[4 * (w_) + 3] = __builtin_amdgcn_sdot4((int)__builtin_amdgcn_perm(th1, th0, 0x07060302u), (int)(cpk), acc[4 * (w_) + 3], false); } while (0)
#define PEER_VACC(r, q) do { const unsigned long long c8 = *(const LAS unsigned long long*)(ccp + 8 * (q)); const unsigned ca = (unsigned)c8, cb = (unsigned)(c8 >> 32); \
            PEER_T4(0, r[0].x, r[1].x, r[2].x, r[3].x, ca); PEER_T4(1, r[0].y, r[1].y, r[2].y, r[3].y, ca); PEER_T4(2, r[0].z, r[1].z, r[2].z, r[3].z, ca); PEER_T4(3, r[0].w, r[1].w, r[2].w, r[3].w, ca); \
            PEER_T4(0, r[4].x, r[5].x, r[6].x, r[7].x, cb); PEER_T4(1, r[4].y, r[5].y, r[6].y, r[7].y, cb); PEER_T4(2, r[4].z, r[5].z, r[6].z, r[7].z, cb); PEER_T4(3, r[4].w, r[5].w, r[6].w, r[7].w, cb); } while (0)
        for (int q = 0; q < 15; q += 3) {
            PEER_ROWS(rc, vb, q + 2); PEER_VACC(ra, q);
            PEER_ROWS(ra, vb, q + 3); PEER_VACC(rb, q + 1);
            if (q + 4 < 16) PEER_ROWS(rb, vb, q + 4);
            PEER_VACC(rc, q + 2);
        }
        PEER_VACC(ra, 15);
        GAS f32x4* op = (GAS f32x4*)(OUT + (size_t)t * D + 128 * j + 16 * sub);
#pragma unroll
        for (int q = 0; q < 4; ++q) { f32x4 v = op[q]; v.x += scc * (float)acc[4 * q + 0]; v.y += scc * (float)acc[4 * q + 1]; v.z += scc * (float)acc[4 * q + 2]; v.w += scc * (float)acc[4 * q + 3]; op[q] = v; }
    }
}
struct Args { const float* in[15]; float* out; unsigned char* ws; int ph_lo, ph_hi, li, pad; };
__global__ void __launch_bounds__(NWAVES * 64, 2) fwd_kernel(Args args) {
    extern __shared__ __attribute__((aligned(16))) unsigned char lds_raw[];
    LAS unsigned char* lds = (LAS unsigned char*)lds_raw;
    volatile LAS unsigned* MISC = (volatile LAS unsigned*)(lds + MISC_OFF);
    const int tid = threadIdx.x, lane = tid & 63, wave = __builtin_amdgcn_readfirstlane(tid >> 6);
    const int G = gridDim.x, bx = blockIdx.x;
    unsigned char* ws = args.ws;
    gu32* ctl = (gu32*)(ws + WS_CTL);
    for (int u = tid; u < (LDS_BYTES - LDSCTL_OFF) / 4; u += NWAVES * 64) ((LAS unsigned*)(lds + LDSCTL_OFF))[u] = 0u;
    __syncthreads();
    XcdBarrier bar; bar.bar = (unsigned*)(ctl + CW_BAR); bar.x = 0; bar.st = nullptr;
    if (N_LAUNCHES != PER_PHASE) bar = xcd_barrier_post((unsigned*)(ctl + CW_BAR) + args.li * XCD_BAR_WORDS, MISC + 8);
#define GRID_BAR() do { if (N_LAUNCHES != PER_PHASE) xcd_barrier(bar); } while (0)
    const int lo = args.ph_lo, hi = args.ph_hi;
#define IN(k) (lo <= (k) && (k) < hi)
#define BOTH(k) (IN(k) && IN((k) + 1))
#ifndef MK_REPEAT
#define MK_REPEAT -1
#endif
#define REP(k) for (int _r = 0; _r < ((MK_REPEAT == (k)) ? 2 : 1); ++_r)

    const float* x = args.in[0]; float* out = args.out;
    bf16* XB = (bf16*)(ws + WS_XB); bf16* WinT = (bf16*)(ws + WS_WIN); bf16* WoutT = (bf16*)(ws + WS_WOUT); bf16* WqT = (bf16*)(ws + WS_WQ);
    bf16* SK = (bf16*)(ws + WS_SK); bf16* PoolT = (bf16*)(ws + WS_POOLT); unsigned char* U8 = ws + WS_U8; unsigned char* V8 = ws + WS_V8; float* SU = (float*)(ws + WS_SU); float* SV = (float*)(ws + WS_SV);
    bf16* Y = (bf16*)(ws + WS_Y); bf16* AB = (bf16*)(ws + WS_AB); bf16* X1B = (bf16*)(ws + WS_X1B); bf16* QP = (bf16*)(ws + WS_QP);
    float* rstd1 = (float*)(ws + WS_RSTD1); float* SS2 = (float*)(ws + WS_SS2); unsigned short* EXPERTS = (unsigned short*)(ws + WS_EXP); float* BEST = (float*)(ws + WS_BEST);
    float* PD = (float*)(ws + WS_PD); unsigned char* CC8 = ws + WS_CC; float* SCC = (float*)(ws + WS_SCC);
    const int gw = bx * NWAVES + wave, NGW = G * NWAVES;

    if (IN(0)) REP(0) {
        P0Args a{x, args.in[1], args.in[2], args.in[7], args.in[9], args.in[10], args.in[11], args.in[12], args.in[13], args.in[14], XB, WinT, WoutT, WqT, SK, PoolT, U8, V8, SU, SV, rstd1};
        p0_prologue(a, lds, gw, NGW, wave, lane);
        if (BOTH(0)) GRID_BAR();
    }
    if (IN(1)) REP(1) {
        pg8::Gemm g{XB, WinT, T, DIN, D}; pg8::StaticOrder S; S.init(T, DIN, G, bx);
        pg8::EpiScaleBf16 E{Y, DIN, rstd1};
        pg8::gemm_phase<pg8::EpiScaleBf16, pg8::StaticOrder, true, true>(lds + RING_OFF, g, S, E);
        if (BOTH(1)) GRID_BAR();
    }
    if (IN(2)) REP(2) {
        for (int u = bx; u < NB * 128 * 2; u += G) attn_unit(lds, Y, AB, args.in[3], args.in[4], args.in[5], args.in[6], u, tid, wave, lane);
        for (int u = bx; u < T / 128; u += G) pool_rows(Y, AB, args.in[8], u, tid);
        if (BOTH(2)) GRID_BAR();
    }
    if (IN(3)) REP(3) {
        pg8::Gemm g{AB, WoutT, T, D, D}; pg8::StaticOrder S; S.init(T, D, G, bx);
        pg8::EpiResid E{x, out, X1B, SS2, D};
        pg8::gemm_phase<pg8::EpiResid, pg8::StaticOrder, true, true>(lds + RING_OFF, g, S, E);
        if (BOTH(3)) GRID_BAR();
    }
    if (IN(4)) REP(4) {
        pg8::Gemm g{X1B, WqT, T, DQ, D}; pg8::StaticOrder S; S.init(T, DQ, G, bx);
        pg8::EpiScaleBf16 E{QP, DQ, nullptr};
        pg8::gemm_phase<pg8::EpiScaleBf16, pg8::StaticOrder, true, true>(lds + RING_OFF, g, S, E);
        if (BOTH(4)) GRID_BAR();
    }
    if (IN(5)) REP(5) {
        for (int u = bx; u < (T / 256) * 8; u += G) topk_unit(lds, QP, SK, EXPERTS, BEST, u, tid, wave, lane);
        if (BOTH(5)) GRID_BAR();
    }
    if (IN(6)) REP(6) {
        if ((G & 7) == 0) peer_u_phase(lds, out, U8, EXPERTS, PD, bx & 7, bx >> 3, G >> 3, wave, lane);
        else for (int j = 0; j < 8; ++j) peer_u_phase(lds, out, U8, EXPERTS, PD, j, bx, G, wave, lane);
        if (BOTH(6)) GRID_BAR();
    }
    if (IN(7)) REP(7) {
        for (int t = gw; t < T; t += NGW) peer_combine(PD, EXPERTS, BEST, SS2, SU, SV, CC8, SCC, t, lane);
        if (BOTH(7)) GRID_BAR();
    }
    if (IN(8)) {
        if ((G & 7) == 0) peer_v_phase(lds, out, V8, EXPERTS, CC8, SCC, bx & 7, bx >> 3, G >> 3, wave, lane);
        else for (int j = 0; j < 8; ++j) peer_v_phase(lds, out, V8, EXPERTS, CC8, SCC, j, bx, G, wave, lane);
    }
#undef IN
#undef BOTH
}

extern "C" void kernel_launch(void* const* d_in, const int* in_sizes, int n_in, void* d_out, int out_size, void* d_ws, size_t ws_size, hipStream_t stream) {
    static int grid = 0;
    if (grid == 0) {
        if (n_in != 15 || in_sizes[0] != T * D || out_size != T * D || ws_size < WS_END) { fprintf(stderr, "kernel_launch: unexpected shapes (n_in %d, in0 %d, out %d, ws %zu)\n", n_in, n_in > 0 ? in_sizes[0] : -1, out_size, ws_size); grid = -1; return; }
        int dev = 0, cus = 0, per_cu = 0;
        if (hipGetDevice(&dev) != hipSuccess || hipDeviceGetAttribute(&cus, hipDeviceAttributeMultiprocessorCount, dev) != hipSuccess) { grid = -1; return; }
        if (hipFuncSetAttribute((const void*)fwd_kernel, hipFuncAttributeMaxDynamicSharedMemorySize, LDS_BYTES) != hipSuccess) { fprintf(stderr, "kernel_launch: hipFuncSetAttribute failed\n"); grid = -1; return; }
        if (hipOccupancyMaxActiveBlocksPerMultiprocessor(&per_cu, (const void*)fwd_kernel, NWAVES * 64, LDS_BYTES) != hipSuccess || per_cu < 1) { fprintf(stderr, "kernel_launch: occupancy query reports %d blocks per CU\n", per_cu); }
        (void)hipGetLastError();
        grid = cus;
    }
    if (grid < 0) return;
    if (hipMemsetAsync((char*)d_ws + WS_CTL, 0, CTL_ZERO_BYTES, stream) != hipSuccess) return;
    Args a{};
    for (int i = 0; i < 15; ++i) a.in[i] = (const float*)d_in[i];
    a.out = (float*)d_out; a.ws = (unsigned char*)d_ws;
    for (int li = 0; li < N_LAUNCHES; ++li) {
        a.ph_lo = (N_LAUNCHES == PER_PHASE) ? li : 0; a.ph_hi = (N_LAUNCHES == PER_PHASE) ? li + 1 : PER_PHASE; a.li = (N_LAUNCHES == PER_PHASE) ? 0 : li;
        hipLaunchKernelGGL(fwd_kernel, dim3(grid), dim3(NWAVES * 64), LDS_BYTES, stream, a);
        const hipError_t le = hipPeekAtLastError();
        if (le != hipSuccess) { fprintf(stderr, "kernel_launch: launch %d failed: %s\n", li, hipGetErrorName(le)); break; }
    }
}
```

```cpp
#include <hip/hip_runtime.h>
#include <cstdio>
#include <cstdint>
namespace pg8 {
#define PG8_LAS __attribute__((address_space(3)))
typedef unsigned short bf16_t;
typedef short bf16x8 __attribute__((ext_vector_type(8)));
typedef float f32x4 __attribute__((ext_vector_type(4)));
typedef unsigned u32x4 __attribute__((ext_vector_type(4)));
constexpr int BM = 256, BK = 64, HALF = 128, HTB = HALF * BK * 2  , STAGE_BYTES = 8 * HTB, NXCD = 8, WGM = 8;

__host__ __device__ __forceinline__ int lds_byte(int r, int c) { const int st = (r >> 4) * 2 + (c >> 5), rr = r & 15, cc = c & 31, ob = rr * 64 + cc * 2; return st * 1024 + (ob ^ (((ob >> 9) & 1) << 5)); }
__host__ __device__ __forceinline__ void stage_rc(int b, int& R, int& C) { const int st = b / 1024, sb = b % 1024, swz = sb ^ (((sb >> 9) & 1) << 5); R = (st >> 1) * 16 + swz / 64; C = (st & 1) * 32 + (swz % 64) / 2; }
__host__ __device__ __forceinline__ int perm32(int rho) { const int n = rho >> 4, i = rho & 15; return 8 * (i >> 2) + 4 * n + (i & 3); }

struct Unit { int pm, pn; };
struct Gemm { const bf16_t* A; const bf16_t* Bt; int M, N, K; };

struct StaticOrder {
    int nM, nN, nwg, G, c;
    __host__ __device__ void init(int M, int N, int G_, int c_) { nM = M / BM; nN = N / BM; nwg = nM * nN; G = G_; c = c_; }
    __host__ __device__ bool next(int i, Unit& u) const {
        const long L = (long)i * G + c; if (L >= nwg) return false;
        int wgid = (int)L; { const int q = nwg / NXCD, r = nwg % NXCD, xcd = wgid % NXCD, off = wgid / NXCD; wgid = (xcd < r ? xcd * (q + 1) : r * (q + 1) + (xcd - r) * q) + off; }
        const int nig = WGM * nN, gid = wgid / nig, fm = gid * WGM, gsz = (nM - fm) < WGM ? (nM - fm) : WGM;
        u.pm = fm + ((wgid % nig) % gsz); u.pn = (wgid % nig) / gsz; return true;
    }
    __device__ __forceinline__ void a_ready(const Unit&) const {}
    __device__ __forceinline__ void done(const Unit&) const {}
};

__device__ __forceinline__ unsigned cvt_pk_bf16(float lo, float hi) { unsigned r; asm volatile("v_cvt_pk_bf16_f32 %0, %1, %2" : "=v"(r) : "v"(lo), "v"(hi)); return r; }
struct EpiScaleBf16 {
    static constexpr bool PERM = true, AFTER_DRAIN = false, PROBE_TWICE = false;
    bf16_t* O; int ldc; const float* rs;
    __device__ __forceinline__ void operator()(const f32x4 (&acc)[2][2][4][2], const Unit& u, int wr, int wc, int fr, int fq) const {
        const int row0 = u.pm * BM + wr * 64 + fr, col0 = u.pn * BM + wc * 32 + 8 * fq;
#pragma unroll
        for (int ai = 0; ai < 2; ++ai)
#pragma unroll
            for (int m = 0; m < 4; ++m) { const int row = row0 + ai * HALF + m * 16; const float s = rs ? rs[row] : 1.f; bf16_t* rowp = O + (size_t)row * ldc + col0;
#pragma unroll
                for (int bj = 0; bj < 2; ++bj) { const f32x4 v0 = acc[ai][bj][m][0] * s, v1 = acc[ai][bj][m][1] * s;
                    u32x4 w; w.x = cvt_pk_bf16(v0[0], v0[1]); w.y = cvt_pk_bf16(v0[2], v0[3]); w.z = cvt_pk_bf16(v1[0], v1[1]); w.w = cvt_pk_bf16(v1[2], v1[3]);
                    *(u32x4*)(rowp + bj * HALF) = w; } }
    }
};
struct EpiResid {
    static constexpr bool PERM = true, AFTER_DRAIN = false, PROBE_TWICE = false;
    const bf16_t* xbf; bf16_t* dl; bf16_t* xb; float* ss; int ldc;
    __device__ __forceinline__ void operator()(const f32x4 (&acc)[2][2][4][2], const Unit& u, int wr, int wc, int fr, int fq) const {
        const int row0 = u.pm * BM + wr * 64 + fr, col0 = u.pn * BM + wc * 32 + 8 * fq;
#pragma unroll
        for (int ai = 0; ai < 2; ++ai)
#pragma unroll
            for (int m = 0; m < 4; ++m) { const int row = row0 + ai * HALF + m * 16; const size_t off = (size_t)row * ldc + col0; float q = 0.f;
#pragma unroll
                for (int bj = 0; bj < 2; ++bj) { const u32x4 xr = *(const u32x4*)(xbf + off + bj * HALF);
                    const f32x4 a0 = acc[ai][bj][m][0], a1 = acc[ai][bj][m][1];
                    f32x4 v0, v1;
                    v0[0] = a0[0] + __builtin_bit_cast(float, xr.x << 16); v0[1] = a0[1] + __builtin_bit_cast(float, xr.x & 0xffff0000u); v0[2] = a0[2] + __builtin_bit_cast(float, xr.y << 16); v0[3] = a0[3] + __builtin_bit_cast(float, xr.y & 0xffff0000u);
                    v1[0] = a1[0] + __builtin_bit_cast(float, xr.z << 16); v1[1] = a1[1] + __builtin_bit_cast(float, xr.z & 0xffff0000u); v1[2] = a1[2] + __builtin_bit_cast(float, xr.w << 16); v1[3] = a1[3] + __builtin_bit_cast(float, xr.w & 0xffff0000u);
                    u32x4 w; w.x = cvt_pk_bf16(a0[0], a0[1]); w.y = cvt_pk_bf16(a0[2], a0[3]); w.z = cvt_pk_bf16(a1[0], a1[1]); w.w = cvt_pk_bf16(a1[2], a1[3]);
                    *(u32x4*)(dl + off + bj * HALF) = w;
                    w.x = cvt_pk_bf16(v0[0], v0[1]); w.y = cvt_pk_bf16(v0[2], v0[3]); w.z = cvt_pk_bf16(v1[0], v1[1]); w.w = cvt_pk_bf16(v1[2], v1[3]);
                    *(u32x4*)(xb + off + bj * HALF) = w;
                    q += (v0[0] * v0[0] + v0[1] * v0[1]) + (v0[2] * v0[2] + v0[3] * v0[3]) + (v1[0] * v1[0] + v1[1] * v1[1]) + (v1[2] * v1[2] + v1[3] * v1[3]); }
                q += __shfl_xor(q, 16); q += __shfl_xor(q, 32);
                if (fq == 0) ss[(size_t)row * 16 + u.pn * 4 + wc] = q; }
    }
};
template <class Epi, class Sched, bool ALIGN_EPI = false, bool SP2 = false>
__device__ __forceinline__ void gemm_phase(PG8_LAS unsigned char* lds, const Gemm g, const Sched& S, const Epi& E) {
    const int tid = threadIdx.x, wid = __builtin_amdgcn_readfirstlane(tid >> 6), lane = tid & 63, wr = wid >> 2, wc = wid & 3, fr = lane & 15, fq = lane >> 4;
    const int K = g.K, nt = K / BK;
    unsigned voffA[2], voffB[2];
#pragma unroll
    for (int i = 0; i < 2; ++i) { int R, C; stage_rc(tid * 16 + i * 8192, R, C); const int Rb = Epi::PERM ? ((R & ~31) + perm32(R & 31)) : R;
        voffA[i] = (unsigned)(R * K + C) * 2u; voffB[i] = (unsigned)(Rb * K + C) * 2u; }
    const size_t kstep = (size_t)(BK * 2);
    const size_t hstep = (size_t)HALF * K * 2;
    const size_t tstep = 2 * hstep;
    const unsigned ldsw = (unsigned)wid * 1024u;
    const int aoff = lds_byte(wr * 64 + fr, fq * 8), boff = lds_byte(wc * 32 + fr, fq * 8);
#define PG8_SA(b, h) (((b) * 2 + (h)) * HTB)
#define PG8_SB(b, h) ((4 + (b) * 2 + (h)) * HTB)
#define PG8_STAGE(bufoff, gbase, voff) do { _Pragma("unroll") for (int _i = 0; _i < 2; ++_i) \
        __builtin_amdgcn_global_load_lds((const unsigned*)((const char*)(gbase) + (voff)[_i]), (PG8_LAS unsigned*)(lds + (bufoff) + ldsw + _i * 8192), 16, 0, 0); } while (0)
#define PG8_LDA(dst, b, h) do { _Pragma("unroll") for (int m = 0; m < 4; ++m) _Pragma("unroll") for (int k = 0; k < 2; ++k) dst[m][k] = *(const PG8_LAS bf16x8*)(lds + PG8_SA(b, h) + aoff + m * 2048 + k * 1024); } while (0)
#define PG8_LDB(dst, b, h) do { _Pragma("unroll") for (int n = 0; n < 2; ++n) _Pragma("unroll") for (int k = 0; k < 2; ++k) dst[n][k] = *(const PG8_LAS bf16x8*)(lds + PG8_SB(b, h) + boff + n * 2048 + k * 1024); } while (0)
#define PG8_MMA(ai, bj, At, Bt) do { __builtin_amdgcn_s_setprio(1); _Pragma("unroll") for (int m = 0; m < 4; ++m) _Pragma("unroll") for (int n = 0; n < 2; ++n) _Pragma("unroll") for (int k = 0; k < 2; ++k) \
        acc[ai][bj][m][n] = __builtin_amdgcn_mfma_f32_16x16x32_bf16(Bt[n][k], At[m][k], acc[ai][bj][m][n], 0, 0, 0); __builtin_amdgcn_s_setprio(0); } while (0)
#define PG8_WAIT_V(n) asm volatile("s_waitcnt vmcnt(" #n ")" ::: "memory")
#define PG8_WAIT_L(n) asm volatile("s_waitcnt lgkmcnt(" #n ")" ::: "memory")
#define PG8_BAR __builtin_amdgcn_s_barrier()
#define PG8_SCHED __builtin_amdgcn_sched_barrier(0)
    Unit cur, nxt; int ui = 0;
    if (!S.next(0, cur)) return;
    f32x4 acc[2][2][4][2];
#pragma unroll
    for (int a = 0; a < 2; ++a)
#pragma unroll
        for (int b = 0; b < 2; ++b)
#pragma unroll
            for (int m = 0; m < 4; ++m)
#pragma unroll
                for (int n = 0; n < 2; ++n) acc[a][b][m][n] = (f32x4){0.f, 0.f, 0.f, 0.f};
    bf16x8 At[4][2], B0[2][2], B1[2][2];
    const char* cA = (const char*)g.A + (size_t)cur.pm * tstep; const char* cB = (const char*)g.Bt + (size_t)cur.pn * tstep;
    S.a_ready(cur);
    if constexpr (SP2) {
        PG8_STAGE(PG8_SB(0, 0), cB, voffB); PG8_STAGE(PG8_SB(0, 1), cB + hstep, voffB); PG8_STAGE(PG8_SA(0, 0), cA, voffA); PG8_STAGE(PG8_SA(0, 1), cA + hstep, voffA);
        if (wr == 1) PG8_BAR;
        PG8_WAIT_V(2); PG8_BAR;
        PG8_STAGE(PG8_SB(1, 0), cB + kstep, voffB); PG8_STAGE(PG8_SA(1, 0), cA + kstep, voffA); PG8_STAGE(PG8_SB(1, 1), cB + hstep + kstep, voffB);
        PG8_WAIT_V(6); PG8_BAR;
    } else {
        PG8_STAGE(PG8_SB(0, 0), cB, voffB); PG8_STAGE(PG8_SA(0, 0), cA, voffA); PG8_STAGE(PG8_SB(0, 1), cB + hstep, voffB); PG8_STAGE(PG8_SA(0, 1), cA + hstep, voffA);
        if (wr == 1) PG8_BAR;
        PG8_WAIT_V(4); PG8_BAR;
        PG8_STAGE(PG8_SB(1, 0), cB + kstep, voffB); PG8_STAGE(PG8_SA(1, 0), cA + kstep, voffA); PG8_STAGE(PG8_SB(1, 1), cB + hstep + kstep, voffB);
        PG8_WAIT_V(6); PG8_BAR;
    }
    for (;;) {
        const bool has_next = S.next(ui + 1, nxt);
        const char* nA = has_next ? (const char*)g.A + (size_t)nxt.pm * tstep : cA; const char* nB = has_next ? (const char*)g.Bt + (size_t)nxt.pn * tstep : cB;
        for (int t = 0; t < nt; t += 2) {
            const bool last = (t == nt - 2);
            const char* a1 = cA + (size_t)(t + 1) * kstep;
            const char* a2 = last ? nA : cA + (size_t)(t + 2) * kstep; const char* b2 = last ? nB : cB + (size_t)(t + 2) * kstep;
            const char* a3 = a2 + kstep; const char* b3 = b2 + kstep;
            if (last && has_next) S.a_ready(nxt);
            if constexpr (SP2) {
            PG8_LDB(B0, 0, 0); PG8_LDB(B1, 0, 1); PG8_SCHED; PG8_LDA(At, 0, 0); PG8_STAGE(PG8_SA(1, 1), a1 + hstep, voffA);
            PG8_WAIT_V(8); PG8_WAIT_L(0); PG8_BAR; PG8_MMA(0, 0, At, B0); PG8_MMA(0, 1, At, B1); PG8_BAR; PG8_SCHED;
            PG8_LDA(At, 0, 1); PG8_STAGE(PG8_SB(0, 0), b2, voffB); PG8_STAGE(PG8_SB(0, 1), b2 + hstep, voffB); PG8_STAGE(PG8_SA(0, 0), a2, voffA);
            PG8_WAIT_V(8); PG8_WAIT_L(0); PG8_BAR; PG8_MMA(1, 0, At, B0); PG8_MMA(1, 1, At, B1); PG8_BAR; PG8_SCHED;
            PG8_LDB(B0, 1, 0); PG8_LDB(B1, 1, 1); PG8_SCHED; PG8_LDA(At, 1, 0); PG8_STAGE(PG8_SA(0, 1), a2 + hstep, voffA);
            PG8_WAIT_V(8); PG8_WAIT_L(0); PG8_BAR; PG8_MMA(0, 0, At, B0); PG8_MMA(0, 1, At, B1); PG8_BAR; PG8_SCHED;
            PG8_LDA(At, 1, 1); PG8_STAGE(PG8_SB(1, 0), b3, voffB); PG8_STAGE(PG8_SB(1, 1), b3 + hstep, voffB); PG8_STAGE(PG8_SA(1, 0), a3, voffA);
            PG8_WAIT_V(8); PG8_WAIT_L(0); PG8_BAR; PG8_MMA(1, 0, At, B0); PG8_MMA(1, 1, At, B1); PG8_BAR; PG8_SCHED;
            } else {
            PG8_LDB(B0, 0, 0); PG8_SCHED; PG8_LDA(At, 0, 0); PG8_STAGE(PG8_SA(1, 1), a1 + hstep, voffA);
            PG8_WAIT_L(8); PG8_BAR; PG8_WAIT_L(0); PG8_MMA(0, 0, At, B0); PG8_BAR; PG8_SCHED;
            PG8_LDB(B1, 0, 1); PG8_STAGE(PG8_SB(0, 0), b2, voffB);
            PG8_BAR; PG8_WAIT_L(0); PG8_MMA(0, 1, At, B1); PG8_BAR;
            PG8_LDA(At, 0, 1); PG8_STAGE(PG8_SA(0, 0), a2, voffA);
            PG8_BAR; PG8_WAIT_L(0); PG8_MMA(1, 0, At, B0); PG8_BAR; PG8_SCHED;
            PG8_STAGE(PG8_SB(0, 1), b2 + hstep, voffB);
            PG8_WAIT_V(6); PG8_BAR; PG8_MMA(1, 1, At, B1); PG8_BAR;
            PG8_LDB(B0, 1, 0); PG8_SCHED; PG8_LDA(At, 1, 0); PG8_STAGE(PG8_SA(0, 1), a2 + hstep, voffA);
            PG8_WAIT_L(8); PG8_BAR; PG8_WAIT_L(0); PG8_MMA(0, 0, At, B0); PG8_BAR; PG8_SCHED;
            PG8_LDB(B1, 1, 1); PG8_STAGE(PG8_SB(1, 0), b3, voffB);
            PG8_BAR; PG8_WAIT_L(0); PG8_MMA(0, 1, At, B1); PG8_BAR;
            PG8_LDA(At, 1, 1); PG8_STAGE(PG8_SA(1, 0), a3, voffA);
            PG8_BAR; PG8_WAIT_L(0); PG8_MMA(1, 0, At, B0); PG8_BAR; PG8_SCHED;
            PG8_STAGE(PG8_SB(1, 1), b3 + hstep, voffB);
            PG8_WAIT_V(6); PG8_BAR; PG8_MMA(1, 1, At, B1); PG8_BAR;
            }
        }
        if constexpr (ALIGN_EPI) { if (wr == 0) PG8_BAR; }
        if constexpr (!Epi::AFTER_DRAIN) { E(acc, cur, wr, wc, fr, fq);
#if defined(MK_EXTRA)
            if (Epi::PROBE_TWICE) { asm volatile("" ::: "memory"); E(acc, cur, wr, wc, fr, fq); }
#endif
            S.done(cur); }
        if (!has_next) break;
#pragma unroll
        for (int a = 0; a < 2; ++a)
#pragma unroll
            for (int b = 0; b < 2; ++b)
#pragma unroll
                for (int m = 0; m < 4; ++m)
#pragma unroll
                    for (int n = 0; n < 2; ++n) acc[a][b][m][n] = (f32x4){0.f, 0.f, 0.f, 0.f};
        cur = nxt; cA = nA; cB = nB; ++ui;
        if constexpr (ALIGN_EPI) { if (wr == 1) PG8_BAR; }
    }
    PG8_WAIT_V(0);
    if constexpr (!ALIGN_EPI) { if (wr == 0) PG8_BAR; }
    PG8_BAR;
    if constexpr (Epi::AFTER_DRAIN) { E.fused(acc, cur, wr, wc, fr, fq, lds, wid, lane); S.done(cur); }
#undef PG8_SA
#undef PG8_SB
#undef PG8_STAGE
#undef PG8_LDA
#undef PG8_LDB
#undef PG8_MMA
#undef PG8_WAIT_V
#undef PG8_WAIT_L
#undef PG8_BAR
#undef PG8_SCHED
}
}
constexpr int NWAVES = 8;
#ifndef MK_N_LAUNCHES
#define MK_N_LAUNCHES 1
#endif
constexpr int PER_PHASE = 9;
constexpr int N_LAUNCHES = MK_N_LAUNCHES;

constexpr int NB = 4, SEQ = 8192, T = NB * SEQ, D = 1024, DIN = 1280, NEXP = 16384, DQ = 2048;
constexpr float EPS = 1e-6f;

constexpr size_t MiB = 1u << 20;
constexpr size_t WS_CTL = 0, CTL_ZERO_BYTES = 1 * MiB;
constexpr size_t WS_WIN = 2 * MiB;
constexpr size_t WS_WOUT = 5 * MiB;
constexpr size_t WS_WQ = 7 * MiB;
constexpr size_t WS_SK = 11 * MiB;
constexpr size_t WS_POOLT = 11 * MiB + 512 * 1024;
constexpr size_t WS_RSTD1 = 12 * MiB;
constexpr size_t WS_SS2 = 13 * MiB;
constexpr size_t WS_SU = 15 * MiB;
constexpr size_t WS_SV = 15 * MiB + 256 * 1024;
constexpr size_t WS_EXP = 16 * MiB;
constexpr size_t WS_BEST = 24 * MiB;
constexpr size_t WS_CC = 40 * MiB;
constexpr size_t WS_SCC = 44 * MiB;
constexpr size_t WS_U8 = 56 * MiB;
constexpr size_t WS_V8 = 72 * MiB;
constexpr size_t WS_AB = 88 * MiB;
constexpr size_t WS_X1B = 152 * MiB;
constexpr size_t WS_PD = 216 * MiB;
constexpr size_t WS_DELTA = 360 * MiB;
constexpr size_t WS_XB = 216 * MiB;
constexpr size_t WS_Y = 280 * MiB;
constexpr size_t WS_QP = 216 * MiB;
constexpr size_t WS_END = 424 * MiB;
constexpr int CW_BAR = 4096;

constexpr int RING_OFF = 0, RING_BYTES = 131072;
constexpr int LDSCTL_OFF = RING_BYTES, MISC_OFF = LDSCTL_OFF + 320;
constexpr int LDS_BYTES = 147456;
#define GAS __attribute__((address_space(1)))
#define LAS __attribute__((address_space(3)))
typedef unsigned short bf16;
typedef unsigned v4u __attribute__((ext_vector_type(4)));
typedef float f32x4 __attribute__((ext_vector_type(4)));
typedef short bf16x8 __attribute__((ext_vector_type(8)));
typedef GAS unsigned gu32;
typedef GAS unsigned long long gu64;
#define RLX_AGENT __ATOMIC_RELAXED, __HIP_MEMORY_SCOPE_AGENT
#define LDS_WAIT() asm volatile("s_waitcnt lgkmcnt(0)" ::: "memory")
#define VM_WAIT() asm volatile("s_waitcnt vmcnt(0)" ::: "memory")
__device__ __forceinline__ unsigned long long rt() { return __builtin_amdgcn_s_memrealtime(); }
__device__ __forceinline__ unsigned f2bf(float f) { unsigned u = __builtin_bit_cast(unsigned, f); return (u + 0x7fffu + ((u >> 16) & 1u)) >> 16; }
__device__ __forceinline__ unsigned pk2(float lo, float hi) { return f2bf(lo) | (f2bf(hi) << 16); }
#define XB_TMO      128
#define XB_XCNT(j)  (256  + 64 * (j))
#define XB_XSUB(j)  (1280 + 64 * (j))
#define XB_XGEN(j)  (2304 + 64 * (j))
#define XB_TOP      3328
#define XB_TOPGEN   3392
#define XCD_BAR_WORDS 3456
#define XB_SPIN_CAP (1u << 18)

__device__ __forceinline__ unsigned xb_ld(unsigned* p)              { return __hip_atomic_load(p, __ATOMIC_RELAXED, __HIP_MEMORY_SCOPE_AGENT); }
__device__ __forceinline__ unsigned xb_add(unsigned* p, unsigned v) { return __hip_atomic_fetch_add(p, v, __ATOMIC_RELAXED, __HIP_MEMORY_SCOPE_AGENT); }
__device__ __forceinline__ unsigned xb_xcc_id() { return (unsigned)__builtin_amdgcn_s_getreg((3 << 11) | 20) & 0xFu; }
#define XB_SPIN(cond, bar) do { unsigned _sp = 0; while (cond) { __builtin_amdgcn_s_sleep(1); \
    if ((++_sp & 255u) == 0u) { if (xb_ld(&(bar)[XB_TMO])) break; if (_sp > XB_SPIN_CAP) { atomicAdd(&(bar)[XB_TMO], 1u); break; } } } } while (0)

struct XcdBarrier {
    unsigned* bar; unsigned x;
    volatile LAS unsigned* st;
};

__device__ __forceinline__ XcdBarrier xcd_barrier_post(unsigned* bar, volatile LAS unsigned* st) {
    XcdBarrier b; b.bar = bar; b.x = xb_xcc_id(); b.st = st;
    if (threadIdx.x == 0) (void)xb_add(&bar[XB_XCNT(b.x)], 1u);
    return b;
}
__device__ __forceinline__ void xcd_barrier_complete(unsigned* bar, unsigned x, unsigned& nloc, unsigned& nx) {
    const unsigned G = gridDim.x * gridDim.y * gridDim.z;
    unsigned sum, cnt, mine, sp = 0u;
    for (;;) {
        sum = 0u; cnt = 0u; mine = 0u;
#pragma unroll
        for (unsigned j = 0; j < 16; ++j) { const unsigned c = xb_ld(&bar[XB_XCNT(j)]); sum += c; cnt += (c > 0u) ? 1u : 0u; mine = (j == x) ? c : mine; }
        if (sum == G) break;
        __builtin_amdgcn_s_sleep(1);
        if ((++sp & 255u) == 0u) { if (xb_ld(&bar[XB_TMO])) break; if (sp > XB_SPIN_CAP) { atomicAdd(&bar[XB_TMO], 1u); break; } }
    }
    nloc = mine > 0u ? mine : 1u; nx = cnt > 0u ? cnt : 1u;
}

__device__ __forceinline__ void xcd_barrier(const XcdBarrier& b) {
    asm volatile("s_waitcnt vmcnt(0)" ::: "memory");
    __syncthreads();
    if (threadIdx.x == 0) {
        unsigned* bar = b.bar;
        __builtin_amdgcn_s_waitcnt(0);
        unsigned nloc = b.st[0], nx = b.st[1];
        if (nloc == 0u) { xcd_barrier_complete(bar, b.x, nloc, nx); b.st[0] = nloc; b.st[1] = nx; }
        const unsigned old = xb_add(&bar[XB_XSUB(b.x)], 1u);
        const unsigned gen = old / nloc;
        if (old + 1u == (gen + 1u) * nloc) {
            __builtin_amdgcn_fence(__ATOMIC_RELEASE, "agent");
            asm volatile("s_waitcnt vmcnt(0)" ::: "memory");
            const unsigned og = xb_add(&bar[XB_TOP], 1u);
            const unsigned tg = og / nx;
            if (og + 1u == (tg + 1u) * nx) xb_add(&bar[XB_TOPGEN], 1u);
            else XB_SPIN(xb_ld(&bar[XB_TOPGEN]) == tg, bar);
            __builtin_amdgcn_fence(__ATOMIC_ACQUIRE, "agent");
            xb_add(&bar[XB_XGEN(b.x)], 1u);
            asm volatile("s_waitcnt vmcnt(0)" ::: "memory");
        } else {
            XB_SPIN(xb_ld(&bar[XB_XGEN(b.x)]) == gen, bar);
            __builtin_amdgcn_fence(__ATOMIC_ACQUIRE, "agent");
            asm volatile("s_waitcnt vmcnt(0)" ::: "memory");
        }
    }
    __syncthreads();
}
typedef float f32x16 __attribute__((ext_vector_type(16)));
typedef __bf16 bf16x2_t __attribute__((ext_vector_type(2)));
#define MFMA32(a, b, c) __builtin_amdgcn_mfma_f32_32x32x16_bf16((a), (b), (c), 0, 0, 0)
__device__ __forceinline__ float bf_lo(unsigned u) { return __builtin_bit_cast(float, u << 16); }
__device__ __forceinline__ float bf_hi(unsigned u) { return __builtin_bit_cast(float, u & 0xffff0000u); }
__device__ __forceinline__ float dot2_bf16(unsigned w, unsigned x, float acc) { return __builtin_amdgcn_fdot2_f32_bf16(__builtin_bit_cast(bf16x2_t, w), __builtin_bit_cast(bf16x2_t, x), acc, false); }
__device__ __forceinline__ float wave_sum(float v) {
#pragma unroll
    for (int o = 1; o < 64; o <<= 1) v += __shfl_xor(v, o);
    return v;
}

__device__ __forceinline__ unsigned pack_i8x4(float a, float b, float c, float d) {
    return ((unsigned)__float2int_rn(a) & 0xffu) | (((unsigned)__float2int_rn(b) & 0xffu) << 8) | (((unsigned)__float2int_rn(c) & 0xffu) << 16) | (((unsigned)__float2int_rn(d) & 0xffu) << 24);
}

__device__ __forceinline__ void p0_transpose_item(const float* W, int K, int N, bf16* WT, const float* gk, LAS float* scr, int item, int lane) {
    const int nblk = N / 32, kb = item / nblk, nb = item % nblk, k0 = 64 * kb, n0 = 32 * nb;
    float wv[32];
#pragma unroll
    for (int i = 0; i < 32; ++i) wv[i] = W[(size_t)(k0 + 2 * i + (lane >> 5)) * N + n0 + (lane & 31)];
#pragma unroll
    for (int i = 0; i < 32; ++i) { const int kk = 2 * i + (lane >> 5); float w = wv[i]; if (gk) w *= gk[k0 + kk]; scr[kk * 33 + (lane & 31)] = w; }
    LDS_WAIT(); asm volatile("" ::: "memory");
    const int c = lane & 7;
#pragma unroll
    for (int j = 0; j < 4; ++j) { const int n = (lane >> 3) + 8 * j; const LAS float* s = scr + (8 * c) * 33 + n;
        v4u o; o.x = pk2(s[0 * 33], s[1 * 33]); o.y = pk2(s[2 * 33], s[3 * 33]); o.z = pk2(s[4 * 33], s[5 * 33]); o.w = pk2(s[6 * 33], s[7 * 33]);
        *(GAS v4u*)(WT + (size_t)(n0 + n) * K + k0 + 8 * c) = o; }
    LDS_WAIT(); asm volatile("" ::: "memory");
}
__device__ __forceinline__ float row_to_bf16(const float* src, bf16* dst, const float* g, int lane) {
    const GAS f32x4* xr = (const GAS f32x4*)src + lane; float s = 0.f;
    GAS unsigned long long* o8 = (GAS unsigned long long*)dst + lane;
#pragma unroll
    for (int j = 0; j < 4; ++j) { f32x4 v = xr[64 * j]; s += (v.x * v.x + v.y * v.y) + (v.z * v.z + v.w * v.w);
        if (g) { const f32x4 gv = ((const GAS f32x4*)g)[64 * j + lane]; v = v * gv; }
        o8[64 * j] = (unsigned long long)pk2(v.x, v.y) | ((unsigned long long)pk2(v.z, v.w) << 32); }
    return s;
}
__device__ __forceinline__ void row_to_i8(const float* src, unsigned char* dst, const float* g, float* sc, int m, int lane) {
    const GAS f32x4* xr = (const GAS f32x4*)src + lane; f32x4 v[4]; float amax = 0.f;
#pragma unroll
    for (int j = 0; j < 4; ++j) { v[j] = xr[64 * j]; if (g) { const f32x4 gv = ((const GAS f32x4*)g)[64 * j + lane]; v[j] = v[j] * gv; }
        amax = fmaxf(fmaxf(amax, fmaxf(fabsf(v[j].x), fabsf(v[j].y))), fmaxf(fabsf(v[j].z), fabsf(v[j].w))); }
#pragma unroll
    for (int o = 1; o < 64; o <<= 1) amax = fmaxf(amax, __shfl_xor(amax, o));
    const float inv = amax > 0.f ? 127.0f / amax : 0.f;
    GAS unsigned* o4 = (GAS unsigned*)dst + lane;
#pragma unroll
    for (int j = 0; j < 4; ++j) { const unsigned q0 = (unsigned)__float2int_rn(v[j].x * inv) & 0xffu, q1 = (unsigned)__float2int_rn(v[j].y * inv) & 0xffu, q2 = (unsigned)__float2int_rn(v[j].z * inv) & 0xffu, q3 = (unsigned)__float2int_rn(v[j].w * inv) & 0xffu;
        o4[64 * j] = q0 | (q1 << 8) | (q2 << 16) | (q3 << 24); }
    if (lane == 0) sc[m] = amax * (1.0f / 127.0f);
}
__device__ __forceinline__ void p0_poolfold_item(const float* w_in, const float* pool_w, const float* g1, bf16* WinT, int item, int lane) {
    const int kb = item & 15, nb = (item >> 4) & 15, g = item >> 8, k = 64 * kb + lane, n0 = 8 * nb;
    const GAS f32x4* wr = (const GAS f32x4*)(w_in + (size_t)k * DIN + 768 + 128 * g);
    const float* pw = pool_w + (size_t)g * 16384 + n0;
    float acc[8];
#pragma unroll
    for (int n = 0; n < 8; ++n) acc[n] = 0.f;
#pragma unroll 1
    for (int cb = 0; cb < 32; cb += 16) { f32x4 a[16];
#pragma unroll
        for (int c4 = 0; c4 < 16; ++c4) a[c4] = wr[cb + c4];
#pragma unroll
        for (int c4 = 0; c4 < 16; ++c4)
#pragma unroll
            for (int n = 0; n < 8; ++n) { const float* pp = pw + (4 * (cb + c4)) * 128 + n; acc[n] = fmaf(a[c4].x, pp[0], acc[n]); acc[n] = fmaf(a[c4].y, pp[128], acc[n]); acc[n] = fmaf(a[c4].z, pp[256], acc[n]); acc[n] = fmaf(a[c4].w, pp[384], acc[n]); } }
    const float gk = g1[k];
#pragma unroll
    for (int n = 0; n < 8; ++n) WinT[(size_t)(768 + 128 * g + n0 + n) * D + k] = (bf16)f2bf(acc[n] * gk);
}
struct P0Args { const float *x, *g1, *w_in, *pool_w, *w_out, *g2, *wq, *sk, *u, *v; bf16 *XB, *WinT, *WoutT, *WqT, *SK, *PoolT; unsigned char *U8, *V8; float *su, *sv; float* rstd1; };
__device__ __forceinline__ void p0_prologue(const P0Args& a, LAS unsigned char* lds, int gw, int NGW, int wave, int lane) {
    LAS float* scr = (LAS float*)(lds + RING_OFF + wave * 16384);
    constexpr int I_IN = (D / 64) * (768 / 32), I_OUT = (D / 64) * (D / 32), I_Q = (D / 64) * (DQ / 32), I_P = 4 * 16 * 16;
    constexpr int NITEMS = I_P + I_IN + I_OUT + I_Q;
    for (int it = gw; it < NITEMS; it += NGW) {
        int r = it;
        if (r < I_P) { p0_poolfold_item(a.w_in, a.pool_w, a.g1, a.WinT, r, lane); continue; } r -= I_P;
        if (r < I_IN) { const int kb = r / 24, nb = r % 24; p0_transpose_item(a.w_in, D, DIN, a.WinT, a.g1, scr, kb * 40 + nb, lane); continue; } r -= I_IN;
        if (r < I_OUT) { p0_transpose_item(a.w_out, D, D, a.WoutT, nullptr, scr, r, lane); continue; } r -= I_OUT;
        p0_transpose_item(a.wq, D, DQ, a.WqT, a.g2, scr, r, lane);
    }
    for (int m0 = gw; m0 < T; m0 += 4 * NGW) {
        f32x4 v[4][4];
#pragma unroll
        for (int r = 0; r < 4; ++r) { const int m = m0 + r * NGW < T ? m0 + r * NGW : m0; const GAS f32x4* xr = (const GAS f32x4*)(a.x + (size_t)m * D) + lane;
#pragma unroll
            for (int j = 0; j < 4; ++j) v[r][j] = xr[64 * j]; }
#pragma unroll
        for (int r = 0; r < 4; ++r) { const int m = m0 + r * NGW; if (m < T) {
            float s = 0.f; GAS unsigned long long* o8 = (GAS unsigned long long*)(a.XB + (size_t)m * D) + lane;
#pragma unroll
            for (int j = 0; j < 4; ++j) { const f32x4 w = v[r][j]; s += (w.x * w.x + w.y * w.y) + (w.z * w.z + w.w * w.w); o8[64 * j] = (unsigned long long)pk2(w.x, w.y) | ((unsigned long long)pk2(w.z, w.w) << 32); }
            s = wave_sum(s); if (lane == 0) a.rstd1[m] = 1.0f / sqrtf(s * (1.0f / D) + EPS); } }
    }
    for (int m0 = gw; m0 < 2 * NEXP; m0 += 4 * NGW) {
        f32x4 v[4][4];
#pragma unroll
        for (int r = 0; r < 4; ++r) { const int mm = m0 + r * NGW < 2 * NEXP ? m0 + r * NGW : m0; const bool isv = mm >= NEXP; const int m = isv ? mm - NEXP : mm;
            const GAS f32x4* xr = (const GAS f32x4*)((isv ? a.v : a.u) + (size_t)m * D) + lane;
#pragma unroll
            for (int j = 0; j < 4; ++j) v[r][j] = xr[64 * j]; }
#pragma unroll
        for (int r = 0; r < 4; ++r) { const int mm = m0 + r * NGW; if (mm < 2 * NEXP) { const bool isv = mm >= NEXP; const int m = isv ? mm - NEXP : mm;
            float amax = 0.f;
#pragma unroll
            for (int j = 0; j < 4; ++j) { if (!isv) { const f32x4 gv = ((const GAS f32x4*)a.g2)[64 * j + lane]; v[r][j] = v[r][j] * gv; }
                amax = fmaxf(fmaxf(amax, fmaxf(fabsf(v[r][j].x), fabsf(v[r][j].y))), fmaxf(fabsf(v[r][j].z), fabsf(v[r][j].w))); }
#pragma unroll
            for (int o = 1; o < 64; o <<= 1) amax = fmaxf(amax, __shfl_xor(amax, o));
            const float inv = amax > 0.f ? 127.0f / amax : 0.f;
            GAS unsigned* o4 = (GAS unsigned*)((isv ? a.V8 : a.U8) + (size_t)m * D) + lane;
#pragma unroll
            for (int j = 0; j < 4; ++j) o4[64 * j] = pack_i8x4(v[r][j].x * inv, v[r][j].y * inv, v[r][j].z * inv, v[r][j].w * inv);
            if (lane == 0) (isv ? a.sv : a.su)[m] = amax * (1.0f / 127.0f); } }
    }
    for (int m = gw; m < 256; m += NGW) (void)row_to_bf16(a.sk + (size_t)m * D, a.SK + (size_t)m * D, nullptr, lane);
}

__device__ __forceinline__ int t5_bucket(int rel) {
    const int n = rel < 0 ? -rel : rel; const int base = rel > 0 ? 16 : 0;
    const int v = n < 8 ? n : (n < 12 ? 8 : (n < 16 ? 9 : (n < 23 ? 10 : (n < 32 ? 11 : (n < 46 ? 12 : (n < 64 ? 13 : (n < 91 ? 14 : 15)))))));
    return base + v;
}
__device__ __forceinline__ void attn_unit(LAS unsigned char* lds, const bf16* Y, bf16* AB, const float* qg, const float* kg, const float* sinks, const float* relb,
                                          int unit, int tid, int wave, int lane) {
    const int kvh = unit & 1, c = (unit >> 1) & 127, b = unit >> 8;
    LAS bf16* Ks = (LAS bf16*)lds;
    LAS bf16* Vt = (LAS bf16*)(lds + 27648);
    LAS float* bt = (LAS float*)(lds + 53248);
    const int row0 = b * SEQ + (c - 2) * 64;
#pragma unroll
    for (int rep = 0; rep < 3; ++rep) {
        const int it = tid + rep * 512, j = it >> 3, ch = it & 7;
        const bool valid = (c - 2 + (j >> 6)) >= 0;
        v4u kraw = {0u, 0u, 0u, 0u}, vraw = {0u, 0u, 0u, 0u};
        if (valid) { const bf16* rp = Y + (size_t)(row0 + j) * DIN; kraw = *(const GAS v4u*)(rp + 512 + 64 * kvh + 8 * ch); vraw = *(const GAS v4u*)(rp + 640 + 64 * kvh + 8 * ch); }
        float kf[8] = {bf_lo(kraw.x), bf_hi(kraw.x), bf_lo(kraw.y), bf_hi(kraw.y), bf_lo(kraw.z), bf_hi(kraw.z), bf_lo(kraw.w), bf_hi(kraw.w)};
        float ss = 0.f;
#pragma unroll
        for (int e = 0; e < 8; ++e) ss += kf[e] * kf[e];
        ss += __shfl_xor(ss, 1); ss += __shfl_xor(ss, 2); ss += __shfl_xor(ss, 4);
        const float r = 1.0f / sqrtf(ss * (1.0f / 64.0f) + EPS);
        const f32x4 g0 = *(const GAS f32x4*)(kg + 8 * ch), g1 = *(const GAS f32x4*)(kg + 8 * ch + 4);
        v4u ko; ko.x = pk2(kf[0] * r * g0.x, kf[1] * r * g0.y); ko.y = pk2(kf[2] * r * g0.z, kf[3] * r * g0.w); ko.z = pk2(kf[4] * r * g1.x, kf[5] * r * g1.y); ko.w = pk2(kf[6] * r * g1.z, kf[7] * r * g1.w);
        *(LAS v4u*)(Ks + j * 72 + 8 * ch) = ko;
        const int s16 = j >> 4, kk = j & 15, hh = (kk >> 2) & 1, jj = ((kk >> 3) << 2) | (kk & 3), pos = 16 * s16 + 8 * hh + jj;
        LAS bf16* vp = Vt + (8 * ch) * 200 + pos;
        vp[0 * 200] = (bf16)(vraw.x & 0xffffu); vp[1 * 200] = (bf16)(vraw.x >> 16); vp[2 * 200] = (bf16)(vraw.y & 0xffffu); vp[3 * 200] = (bf16)(vraw.y >> 16);
        vp[4 * 200] = (bf16)(vraw.z & 0xffffu); vp[5 * 200] = (bf16)(vraw.z >> 16); vp[6 * 200] = (bf16)(vraw.w & 0xffffu); vp[7 * 200] = (bf16)(vraw.w >> 16);
    }
#pragma unroll
    for (int rep = 0; rep < 2; ++rep) { const int it = tid + rep * 512, g = it >> 8, r = it & 255; bt[it] = relb[t5_bucket(r - 191) * 8 + kvh * 4 + g]; }
    LDS_WAIT(); __syncthreads();

    const int g = wave >> 1, i = 32 * (wave & 1) + (lane & 31), hh = lane >> 5, habs = kvh * 4 + g;
    const size_t qrow = (size_t)b * SEQ + (size_t)c * 64 + i;
    const bf16* qp = Y + qrow * DIN + habs * 64 + 8 * hh;
    v4u qraw[4]; float ss = 0.f;
#pragma unroll
    for (int s = 0; s < 4; ++s) { qraw[s] = *(const GAS v4u*)(qp + 16 * s);
        const float f0 = bf_lo(qraw[s].x), f1 = bf_hi(qraw[s].x), f2 = bf_lo(qraw[s].y), f3 = bf_hi(qraw[s].y), f4 = bf_lo(qraw[s].z), f5 = bf_hi(qraw[s].z), f6 = bf_lo(qraw[s].w), f7 = bf_hi(qraw[s].w);
        ss += (f0 * f0 + f1 * f1) + (f2 * f2 + f3 * f3) + (f4 * f4 + f5 * f5) + (f6 * f6 + f7 * f7); }
    ss += __shfl_xor(ss, 32);
    const float rq = 0.125f / sqrtf(ss * (1.0f / 64.0f) + EPS);
    bf16x8 qf[4];
#pragma unroll
    for (int s = 0; s < 4; ++s) { const f32x4 g0 = *(const GAS f32x4*)(qg + 16 * s + 8 * hh), g1 = *(const GAS f32x4*)(qg + 16 * s + 8 * hh + 4);
        v4u w; w.x = pk2(bf_lo(qraw[s].x) * rq * g0.x, bf_hi(qraw[s].x) * rq * g0.y); w.y = pk2(bf_lo(qraw[s].y) * rq * g0.z, bf_hi(qraw[s].y) * rq * g0.w);
        w.z = pk2(bf_lo(qraw[s].z) * rq * g1.x, bf_hi(qraw[s].z) * rq * g1.y); w.w = pk2(bf_lo(qraw[s].w) * rq * g1.z, bf_hi(qraw[s].w) * rq * g1.w);
        qf[s] = __builtin_bit_cast(bf16x8, w); }
    f32x16 sacc[6];
#pragma unroll
    for (int kt = 0; kt < 6; ++kt) {
#pragma unroll
        for (int r = 0; r < 16; ++r) sacc[kt][r] = 0.f;
#pragma unroll
        for (int s = 0; s < 4; ++s) { const bf16x8 a = *(const LAS bf16x8*)(Ks + (32 * kt + (lane & 31)) * 72 + 16 * s + 8 * hh); sacc[kt] = MFMA32(a, qf[s], sacc[kt]); }
    }
    const LAS float* btg = bt + g * 256 + 63 - i;
    float mx = -3.0e38f;
#pragma unroll
    for (int kt = 0; kt < 6; ++kt) { const bool masked = (c - 2 + (kt >> 1)) < 0;
#pragma unroll
        for (int r = 0; r < 16; ++r) { const int j = 32 * kt + (r & 3) + 8 * (r >> 2) + 4 * hh; float v = sacc[kt][r] + btg[j]; v = masked ? -1.0e30f : v; sacc[kt][r] = v; mx = fmaxf(mx, v); } }
    mx = fmaxf(mx, __shfl_xor(mx, 32));
    const float sink = sinks[habs], m = fmaxf(mx, sink);
    float sum = 0.f;
#pragma unroll
    for (int kt = 0; kt < 6; ++kt)
#pragma unroll
        for (int r = 0; r < 16; ++r) { const float p = __expf(sacc[kt][r] - m); sacc[kt][r] = p; sum += p; }
    sum += __shfl_xor(sum, 32);
    const float inv = 1.0f / (sum + __expf(sink - m));
    f32x16 oacc[2];
#pragma unroll
    for (int dt = 0; dt < 2; ++dt)
#pragma unroll
        for (int r = 0; r < 16; ++r) oacc[dt][r] = 0.f;
#pragma unroll
    for (int kt = 0; kt < 6; ++kt)
#pragma unroll
        for (int s2 = 0; s2 < 2; ++s2) {
            v4u w; w.x = pk2(sacc[kt][8 * s2 + 0], sacc[kt][8 * s2 + 1]); w.y = pk2(sacc[kt][8 * s2 + 2], sacc[kt][8 * s2 + 3]); w.z = pk2(sacc[kt][8 * s2 + 4], sacc[kt][8 * s2 + 5]); w.w = pk2(sacc[kt][8 * s2 + 6], sacc[kt][8 * s2 + 7]);
            const bf16x8 pb = __builtin_bit_cast(bf16x8, w);
#pragma unroll
            for (int dt = 0; dt < 2; ++dt) { const bf16x8 a = *(const LAS bf16x8*)(Vt + (32 * dt + (lane & 31)) * 200 + 32 * kt + 16 * s2 + 8 * hh); oacc[dt] = MFMA32(a, pb, oacc[dt]); }
        }
    bf16* op = AB + qrow * D + habs * 64;
#pragma unroll
    for (int dt = 0; dt < 2; ++dt)
#pragma unroll
        for (int q4 = 0; q4 < 4; ++q4) { const int d = 32 * dt + 8 * q4 + 4 * hh;
            const unsigned long long o = (unsigned long long)pk2(oacc[dt][4 * q4 + 0] * inv, oacc[dt][4 * q4 + 1] * inv) | ((unsigned long long)pk2(oacc[dt][4 * q4 + 2] * inv, oacc[dt][4 * q4 + 3] * inv) << 32);
            *(GAS unsigned long long*)(op + d) = o; }
    __syncthreads();
}

template <int W> __device__ __forceinline__ void pool_walk(const bf16* zc, bf16* oc, float s0, float s1, int pos0) {
    unsigned ring[16];
    float a0 = 0.f, a1 = 0.f;
#pragma unroll
    for (int q = 0; q < 16; ++q) ring[q] = 0u;
#pragma unroll
    for (int q = 1; q < W; ++q) { if (pos0 - q >= 0) { const unsigned u = *(const GAS unsigned*)(zc - (size_t)q * DIN); ring[(16 - q) & 15] = u; a0 += bf_lo(u); a1 += bf_hi(u); } }
    for (int rb = 0; rb < 64; rb += 16) {
#pragma unroll
        for (int i = 0; i < 16; ++i) {
            const unsigned u = *(const GAS unsigned*)(zc + (size_t)(rb + i) * DIN);
            const float c0 = bf_lo(u), c1 = bf_hi(u);
            a0 += c0; a1 += c1;
            const int pos = pos0 + rb + i; const float ic = 1.0f / (float)(pos + 1 < W ? pos + 1 : W);
            *(GAS unsigned*)(oc + (size_t)(rb + i) * D) = pk2((a0 * ic - c0) * s0, (a1 * ic - c1) * s1);
            const unsigned old = ring[(i + 17 - W) & 15];
            a0 -= bf_lo(old); a1 -= bf_hi(old);
            ring[i] = u;
        }
    }
}
__device__ __forceinline__ void pool_rows(const bf16* Y, bf16* AB, const float* pscale, int unit, int tid) {
    const int cp = tid & 255, seg = tid >> 8, g = cp >> 6;
    const int r0 = unit * 128 + seg * 64, pos0 = r0 & (SEQ - 1);
    const bf16* zc = Y + (size_t)r0 * DIN + 768 + 2 * cp; bf16* oc = AB + (size_t)r0 * D + 512 + 2 * cp;
    const float s0 = pscale[2 * cp], s1 = pscale[2 * cp + 1];
    if (g == 0) pool_walk<2>(zc, oc, s0, s1, pos0); else if (g == 1) pool_walk<4>(zc, oc, s0, s1, pos0); else if (g == 2) pool_walk<8>(zc, oc, s0, s1, pos0); else pool_walk<16>(zc, oc, s0, s1, pos0);
}

__device__ __forceinline__ int f2key(float f) { int i = __builtin_bit_cast(int, f); return i ^ ((i >> 31) & 0x7fffffff); }
__device__ __forceinline__ float key2f(int k) { return __builtin_bit_cast(float, k ^ ((k >> 31) & 0x7fffffff)); }
#define CE_DESC(a, b) do { const int _x = (a), _y = (b); (a) = _x > _y ? _x : _y; (b) = _x > _y ? _y : _x; } while (0)
__device__ __forceinline__ void sort16_desc(int (&a)[16]) {
#pragma unroll
    for (int k = 2; k <= 16; k <<= 1)
#pragma unroll
        for (int j = k >> 1; j > 0; j >>= 1)
#pragma unroll
            for (int i = 0; i < 16; ++i) { const int l = i ^ j; if (l > i) { if ((i & k) == 0) CE_DESC(a[i], a[l]); else CE_DESC(a[l], a[i]); } }
}
__device__ __forceinline__ void merge_top16(int (&a)[16], const int (&b)[16]) {
#pragma unroll
    for (int i = 0; i < 16; ++i) a[i] = a[i] > b[15 - i] ? a[i] : b[15 - i];
#pragma unroll
    for (int j = 8; j > 0; j >>= 1)
#pragma unroll
        for (int i = 0; i < 16; ++i) { const int l = i ^ j; if (l > i) CE_DESC(a[i], a[l]); }
}
__device__ __forceinline__ void top16_of_64(int (&g0)[16], int (&g1)[16], int (&g2)[16], int (&g3)[16]) {
    sort16_desc(g0); sort16_desc(g1); sort16_desc(g2); sort16_desc(g3);
    merge_top16(g0, g1); merge_top16(g2, g3); merge_top16(g0, g2);
}
__device__ __forceinline__ void topk_unit(LAS unsigned char* lds, const bf16* QP, const bf16* SK, unsigned short* EXPERTS, float* BEST, int unit, int tid, int wave, int lane) {
    const int h = unit & 7, tt = unit >> 3, hh = lane >> 5;
    const int tok = tt * 256 + wave * 32 + (lane & 31);
    LAS int* mine = (LAS int*)lds + tid * 33;
    int top[2][16];
#pragma unroll
    for (int p = 0; p < 2; ++p) {
        const bf16* qp = QP + (size_t)tok * DQ + h * 256 + p * 128 + 8 * hh;
        const bf16* kp = SK + (size_t)(h * 2 + p) * 16384 + (size_t)(lane & 31) * 128 + 8 * hh;
        f32x16 acc[4];
#pragma unroll
        for (int nt = 0; nt < 4; ++nt)
#pragma unroll
            for (int r = 0; r < 16; ++r) acc[nt][r] = 0.f;
#pragma unroll
        for (int s = 0; s < 8; ++s) { const bf16x8 bq = __builtin_bit_cast(bf16x8, *(const GAS v4u*)(qp + 16 * s));
#pragma unroll
            for (int nt = 0; nt < 4; ++nt) { const bf16x8 a = __builtin_bit_cast(bf16x8, *(const GAS v4u*)(kp + (size_t)nt * 32 * 128 + 16 * s)); acc[nt] = MFMA32(a, bq, acc[nt]); } }
        int k0[16], k1[16], k2[16], k3[16];
#pragma unroll
        for (int r = 0; r < 16; ++r) { const int n = (r & 3) + 8 * (r >> 2) + 4 * hh;
            k0[r] = (f2key(acc[0][r]) & ~127) | n; k1[r] = (f2key(acc[1][r]) & ~127) | (32 + n); k2[r] = (f2key(acc[2][r]) & ~127) | (64 + n); k3[r] = (f2key(acc[3][r]) & ~127) | (96 + n); }
        top16_of_64(k0, k1, k2, k3);
#pragma unroll
        for (int r = 0; r < 16; ++r) k1[r] = __shfl_xor(k0[r], 32);
        merge_top16(k0, k1);
#pragma unroll
        for (int r = 0; r < 16; ++r) top[p][r] = k0[r];
    }
    int c0[16], c1[16], c2[16], c3[16];
    {
        float v1[16], v2[16];
#pragma unroll
        for (int r = 0; r < 16; ++r) { v1[r] = key2f(top[0][r] & ~127); v2[r] = key2f(top[1][r] & ~127); mine[r] = top[0][r]; mine[16 + r] = top[1][r]; }
        int cnt = 0;
#pragma unroll
        for (int i = 0; i < 16; ++i)
#pragma unroll
            for (int j = 0; j < 16; ++j) if ((i + 1) * (j + 1) <= 16) { const int key = (f2key(v1[i] + v2[j]) & ~255) | (i << 4) | j;
                if (cnt < 16) c0[cnt] = key; else if (cnt < 32) c1[cnt - 16] = key; else if (cnt < 48) c2[cnt - 32] = key; else c3[cnt - 48] = key; ++cnt; }
#pragma unroll
        for (int r = 0; r < 16; ++r) if (48 + r >= cnt) c3[r] = (int)0x80000000;
    }
    top16_of_64(c0, c1, c2, c3);
    LDS_WAIT();
    if (hh == 0) {
        int ev[16]; float bv[16];
#pragma unroll
        for (int r = 0; r < 16; ++r) { const int id = c0[r] & 255; const int ka = mine[id >> 4], kb = mine[16 + (id & 15)];
            ev[r] = (ka & 127) * 128 + (kb & 127); bv[r] = key2f(ka & ~127) + key2f(kb & ~127); }
        unsigned short* ep = EXPERTS + (size_t)tok * 128 + h * 16; float* bp = BEST + (size_t)tok * 128 + h * 16;
#pragma unroll
        for (int r = 0; r < 16; r += 8) *(GAS v4u*)(ep + r) = (v4u){(unsigned)ev[r] | ((unsigned)ev[r + 1] << 16), (unsigned)ev[r + 2] | ((unsigned)ev[r + 3] << 16), (unsigned)ev[r + 4] | ((unsigned)ev[r + 5] << 16), (unsigned)ev[r + 6] | ((unsigned)ev[r + 7] << 16)};
#pragma unroll
        for (int r = 0; r < 16; r += 4) *(GAS f32x4*)(bp + r) = (f32x4){bv[r], bv[r + 1], bv[r + 2], bv[r + 3]};
    }
    LDS_WAIT();
}

__device__ __forceinline__ float gelu_erf(float x) { return 0.5f * x * (1.0f + erff(x * 0.70710678118654752f)); }
#define PEER_ROWS(r, tab, q) do { const v4u _ev = *(const LAS v4u*)(evp + 16 * (q)); \
        r[0] = *(const GAS v4u*)(tab + (size_t)(_ev.x & 0xffffu) * D); r[1] = *(const GAS v4u*)(tab + (size_t)(_ev.x >> 16) * D); \
        r[2] = *(const GAS v4u*)(tab + (size_t)(_ev.y & 0xffffu) * D); r[3] = *(const GAS v4u*)(tab + (size_t)(_ev.y >> 16) * D); \
        r[4] = *(const GAS v4u*)(tab + (size_t)(_ev.z & 0xffffu) * D); r[5] = *(const GAS v4u*)(tab + (size_t)(_ev.z >> 16) * D); \
        r[6] = *(const GAS v4u*)(tab + (size_t)(_ev.w & 0xffffu) * D); r[7] = *(const GAS v4u*)(tab + (size_t)(_ev.w >> 16) * D); } while (0)
__device__ __forceinline__ void peer_u_phase(LAS unsigned char* lds, const bf16* X1B, const unsigned char* U8, const unsigned short* EXP16, float* PD, int j, int w, int nw, int wave, int lane) {
    const int grp = lane >> 3, sub = lane & 7;
    LAS unsigned char* wl = lds + wave * 8192;
    const LAS unsigned char* evp = wl + grp * 256;
    const int stride = nw * NWAVES * 8;
    int tb = (w * NWAVES + wave) * 8;
    v4u pe0 = {0u, 0u, 0u, 0u}, pe1 = {0u, 0u, 0u, 0u};
    if (tb < T) { const GAS v4u* e = (const GAS v4u*)(EXP16 + (size_t)tb * 128) + lane; pe0 = e[0]; pe1 = e[64]; }
    const unsigned char* ub = U8 + 128 * j + 16 * sub;
    for (; tb < T; tb += stride) {
        *(LAS v4u*)(wl + 16 * lane) = pe0; *(LAS v4u*)(wl + 1024 + 16 * lane) = pe1;
        if (tb + stride < T) { const GAS v4u* e = (const GAS v4u*)(EXP16 + (size_t)(tb + stride) * 128) + lane; pe0 = e[0]; pe1 = e[64]; }
        const int t = tb + grp;
        const GAS v4u* xp = (const GAS v4u*)(X1B + (size_t)t * D + 128 * j + 16 * sub);
        const v4u xa = xp[0], xc = xp[1];
        const f32x4 x0 = {bf_lo(xa.x), bf_hi(xa.x), bf_lo(xa.y), bf_hi(xa.y)}, x1 = {bf_lo(xa.z), bf_hi(xa.z), bf_lo(xa.w), bf_hi(xa.w)};
        const f32x4 x2 = {bf_lo(xc.x), bf_hi(xc.x), bf_lo(xc.y), bf_hi(xc.y)}, x3 = {bf_lo(xc.z), bf_hi(xc.z), bf_lo(xc.w), bf_hi(xc.w)};
        float amax = fmaxf(fmaxf(fmaxf(fabsf(x0.x), fabsf(x0.y)), fmaxf(fabsf(x0.z), fabsf(x0.w))), fmaxf(fmaxf(fabsf(x1.x), fabsf(x1.y)), fmaxf(fabsf(x1.z), fabsf(x1.w))));
        amax = fmaxf(amax, fmaxf(fmaxf(fmaxf(fabsf(x2.x), fabsf(x2.y)), fmaxf(fabsf(x2.z), fabsf(x2.w))), fmaxf(fmaxf(fabsf(x3.x), fabsf(x3.y)), fmaxf(fabsf(x3.z), fabsf(x3.w)))));
        amax = fmaxf(amax, __shfl_xor(amax, 1)); amax = fmaxf(amax, __shfl_xor(amax, 2)); amax = fmaxf(amax, __shfl_xor(amax, 4));
        const float inv = amax > 0.f ? 127.0f / amax : 0.f, sx = amax * (1.0f / 127.0f);
        const unsigned xq0 = pack_i8x4(x0.x * inv, x0.y * inv, x0.z * inv, x0.w * inv), xq1 = pack_i8x4(x1.x * inv, x1.y * inv, x1.z * inv, x1.w * inv);
        const unsigned xq2 = pack_i8x4(x2.x * inv, x2.y * inv, x2.z * inv, x2.w * inv), xq3 = pack_i8x4(x3.x * inv, x3.y * inv, x3.z * inv, x3.w * inv);
        float* pd = PD + ((size_t)j * T + t) * 128 + sub;
        LDS_WAIT();
        v4u ra[8], rb[8], rc[8];
        PEER_ROWS(ra, ub, 0); PEER_ROWS(rb, ub, 1);
#define PEER_UDOT(r, q) do { int p[8]; _Pragma("unroll") for (int i = 0; i < 8; ++i) { int a = __builtin_amdgcn_sdot4((int)r[i].x, (int)xq0, 0, false); a = __builtin_amdgcn_sdot4((int)r[i].y, (int)xq1, a, false); \
                a = __builtin_amdgcn_sdot4((int)r[i].z, (int)xq2, a, false); p[i] = __builtin_amdgcn_sdot4((int)r[i].w, (int)xq3, a, false); } \
            _Pragma("unroll") for (int o = 4; o > 0; o >>= 1) { const bool up = (sub & o) != 0; \
                _Pragma("unroll") for (int i = 0; i < o; ++i) { const int keep = up ? p[i + o] : p[i], send = up ? p[i] : p[i + o]; p[i] = keep + __shfl_xor(send, o); } } \
            pd[8 * (q)] = (float)p[0] * sx; } while (0)
        for (int q = 0; q < 15; q += 3) {
            PEER_ROWS(rc, ub, q + 2); PEER_UDOT(ra, q);
            PEER_ROWS(ra, ub, q + 3); PEER_UDOT(rb, q + 1);
            if (q + 4 < 16) PEER_ROWS(rb, ub, q + 4);
            PEER_UDOT(rc, q + 2);
        }
        PEER_UDOT(ra, 15);
    }
}
__device__ __forceinline__ void peer_combine(const float* PD, const unsigned short* EXP16, const float* BEST, const float* SS2, const float* su, const float* sv, unsigned char* CC8, float* SCC, int t, int lane) {
    float ssq = 0.f;
    { const GAS f32x4* sp = (const GAS f32x4*)(SS2 + (size_t)t * 16);
#pragma unroll
      for (int q = 0; q < 4; ++q) { const f32x4 v = sp[q]; ssq += (v.x + v.y) + (v.z + v.w); } }
    const float rstd2 = 1.0f / sqrtf(ssq * (1.0f / D) + EPS);
    float c[2];
#pragma unroll
    for (int hf = 0; hf < 2; ++hf) {
        const int k = 64 * hf + lane; const int e = EXP16[(size_t)t * 128 + k];
        const float sb = BEST[(size_t)t * 128 + k] * rstd2;
        float mx = sb;
#pragma unroll
        for (int o = 1; o < 16; o <<= 1) mx = fmaxf(mx, __shfl_xor(mx, o));
        const float ex = __expf(sb - mx); float sm = ex;
#pragma unroll
        for (int o = 1; o < 16; o <<= 1) sm += __shfl_xor(sm, o);
        float dot = 0.f;
#pragma unroll
        for (int j = 0; j < 8; ++j) dot += PD[((size_t)j * T + t) * 128 + k];
        c[hf] = (ex / sm) * gelu_erf(dot * rstd2 * su[e]) * sv[e];
    }
    float amax = fmaxf(fabsf(c[0]), fabsf(c[1]));
#pragma unroll
    for (int o = 1; o < 64; o <<= 1) amax = fmaxf(amax, __shfl_xor(amax, o));
    const float inv = amax > 0.f ? 127.0f / amax : 0.f;
    CC8[(size_t)t * 128 + lane] = (unsigned char)(__float2int_rn(c[0] * inv) & 0xff);
    CC8[(size_t)t * 128 + 64 + lane] = (unsigned char)(__float2int_rn(c[1] * inv) & 0xff);
    if (lane == 0) SCC[t] = amax * (1.0f / 127.0f);
}
__device__ __forceinline__ void peer_v_phase(LAS unsigned char* lds, float* OUT, const float* X, const bf16* DELTA, const unsigned char* V8, const unsigned short* EXP16, const unsigned char* CC8, const float* SCC, int j, int w, int nw, int wave, int lane) {
    const int grp = lane >> 3, sub = lane & 7;
    LAS unsigned char* wl = lds + wave * 8192;
    const LAS unsigned char* evp = wl + grp * 256;
    const LAS unsigned char* ccp = wl + 2048 + grp * 128;
    const int stride = nw * NWAVES * 8;
    int tb = (w * NWAVES + wave) * 8;
    v4u pe0 = {0u, 0u, 0u, 0u}, pe1 = {0u, 0u, 0u, 0u}, pc0 = {0u, 0u, 0u, 0u};
    if (tb < T) { const GAS v4u* e = (const GAS v4u*)(EXP16 + (size_t)tb * 128) + lane; pe0 = e[0]; pe1 = e[64]; pc0 = ((const GAS v4u*)(CC8 + (size_t)tb * 128))[lane]; }
    const unsigned char* vb = V8 + 128 * j + 16 * sub;
    for (; tb < T; tb += stride) {
        *(LAS v4u*)(wl + 16 * lane) = pe0; *(LAS v4u*)(wl + 1024 + 16 * lane) = pe1; *(LAS v4u*)(wl + 2048 + 16 * lane) = pc0;
        if (tb + stride < T) { const GAS v4u* e = (const GAS v4u*)(EXP16 + (size_t)(tb + stride) * 128) + lane; pe0 = e[0]; pe1 = e[64]; pc0 = ((const GAS v4u*)(CC8 + (size_t)(tb + stride) * 128))[lane]; }
        const int t = tb + grp;
        const float scc = SCC[t];
        int acc[16];
#pragma unroll
        for (int i = 0; i < 16; ++i) acc[i] = 0;
        LDS_WAIT();
        v4u ra[8], rb[8], rc[8];
        PEER_ROWS(ra, vb, 0); PEER_ROWS(rb, vb, 1);
#define PEER_T4(w_, r0, r1, r2, r3, cpk) do { const unsigned tl0 = __builtin_amdgcn_perm(r1, r0, 0x05010400u), th0 = __builtin_amdgcn_perm(r1, r0, 0x07030602u); \
            const unsigned tl1 = __builtin_amdgcn_perm(r3, r2, 0x05010400u), th1 = __builtin_amdgcn_perm(r3, r2, 0x07030602u); \
            acc[4 * (w_) + 0] = __builtin_amdgcn_sdot4((int)__builtin_amdgcn_perm(tl1, tl0, 0x05040100u), (int)(cpk), acc[4 * (w_) + 0], false); \
            acc[4 * (w_) + 1] = __builtin_amdgcn_sdot4((int)__builtin_amdgcn_perm(tl1, tl0, 0x07060302u), (int)(cpk), acc[4 * (w_) + 1], false); \
            acc[4 * (w_) + 2] = __builtin_amdgcn_sdot4((int)__builtin_amdgcn_perm(th1, th0, 0x05040100u), (int)(cpk), acc[4 * (w_) + 2], false); \
            acc[4 * (w_) + 3] = __builtin_amdgcn_sdot4((int)__builtin_amdgcn_perm(th1, th0, 0x07060302u), (int)(cpk), acc[4 * (w_) + 3], false); } while (0)
#define PEER_VACC(r, q) do { const unsigned long long c8 = *(const LAS unsigned long long*)(ccp + 8 * (q)); const unsigned ca = (unsigned)c8, cb = (unsigned)(c8 >> 32); \
            PEER_T4(0, r[0].x, r[1].x, r[2].x, r[3].x, ca); PEER_T4(1, r[0].y, r[1].y, r[2].y, r[3].y, ca); PEER_T4(2, r[0].z, r[1].z, r[2].z, r[3].z, ca); PEER_T4(3, r[0].w, r[1].w, r[2].w, r[3].w, ca); \
            PEER_T4(0, r[4].x, r[5].x, r[6].x, r[7].x, cb); PEER_T4(1, r[4].y, r[5].y, r[6].y, r[7].y, cb); PEER_T4(2, r[4].z, r[5].z, r[6].z, r[7].z, cb); PEER_T4(3, r[4].w, r[5].w, r[6].w, r[7].w, cb); } while (0)
        for (int q = 0; q < 15; q += 3) {
            PEER_ROWS(rc, vb, q + 2); PEER_VACC(ra, q);
            PEER_ROWS(ra, vb, q + 3); PEER_VACC(rb, q + 1);
            if (q + 4 < 16) PEER_ROWS(rb, vb, q + 4);
            PEER_VACC(rc, q + 2);
        }
        PEER_VACC(ra, 15);
        const size_t eo = (size_t)t * D + 128 * j + 16 * sub;
        GAS f32x4* op = (GAS f32x4*)(OUT + eo); const GAS f32x4* xp = (const GAS f32x4*)(X + eo); const GAS v4u* dp = (const GAS v4u*)(DELTA + eo);
        const v4u da = dp[0], db = dp[1];
        const float dl[16] = {bf_lo(da.x), bf_hi(da.x), bf_lo(da.y), bf_hi(da.y), bf_lo(da.z), bf_hi(da.z), bf_lo(da.w), bf_hi(da.w), bf_lo(db.x), bf_hi(db.x), bf_lo(db.y), bf_hi(db.y), bf_lo(db.z), bf_hi(db.z), bf_lo(db.w), bf_hi(db.w)};
#pragma unroll
        for (int q = 0; q < 4; ++q) { f32x4 v = xp[q]; v.x += dl[4 * q + 0] + scc * (float)acc[4 * q + 0]; v.y += dl[4 * q + 1] + scc * (float)acc[4 * q + 1]; v.z += dl[4 * q + 2] + scc * (float)acc[4 * q + 2]; v.w += dl[4 * q + 3] + scc * (float)acc[4 * q + 3]; op[q] = v; }
    }
}
struct Args { const float* in[15]; float* out; unsigned char* ws; int ph_lo, ph_hi, li, pad; };
__global__ void __launch_bounds__(NWAVES * 64, 2) fwd_kernel(Args args) {
    extern __shared__ __attribute__((aligned(16))) unsigned char lds_raw[];
    LAS unsigned char* lds = (LAS unsigned char*)lds_raw;
    volatile LAS unsigned* MISC = (volatile LAS unsigned*)(lds + MISC_OFF);
    const int tid = threadIdx.x, lane = tid & 63, wave = __builtin_amdgcn_readfirstlane(tid >> 6);
    const int G = gridDim.x, bx = blockIdx.x;
    unsigned char* ws = args.ws;
    gu32* ctl = (gu32*)(ws + WS_CTL);
    for (int u = tid; u < (LDS_BYTES - LDSCTL_OFF) / 4; u += NWAVES * 64) ((LAS unsigned*)(lds + LDSCTL_OFF))[u] = 0u;
    __syncthreads();
    XcdBarrier bar; bar.bar = (unsigned*)(ctl + CW_BAR); bar.x = 0; bar.st = nullptr;
    if (N_LAUNCHES != PER_PHASE) bar = xcd_barrier_post((unsigned*)(ctl + CW_BAR) + args.li * XCD_BAR_WORDS, MISC + 8);
#define GRID_BAR() do { if (N_LAUNCHES != PER_PHASE) xcd_barrier(bar); } while (0)
    const int lo = args.ph_lo, hi = args.ph_hi;
#define IN(k) (lo <= (k) && (k) < hi)
#define BOTH(k) (IN(k) && IN((k) + 1))
#ifndef MK_REPEAT
#define MK_REPEAT -1
#endif
#define REP(k) for (int _r = 0; _r < ((MK_REPEAT == (k)) ? 2 : 1); ++_r)

    const float* x = args.in[0]; float* out = args.out;
    bf16* XB = (bf16*)(ws + WS_XB); bf16* WinT = (bf16*)(ws + WS_WIN); bf16* WoutT = (bf16*)(ws + WS_WOUT); bf16* WqT = (bf16*)(ws + WS_WQ);
    bf16* SK = (bf16*)(ws + WS_SK); bf16* PoolT = (bf16*)(ws + WS_POOLT); unsigned char* U8 = ws + WS_U8; unsigned char* V8 = ws + WS_V8; float* SU = (float*)(ws + WS_SU); float* SV = (float*)(ws + WS_SV);
    bf16* Y = (bf16*)(ws + WS_Y); bf16* AB = (bf16*)(ws + WS_AB); bf16* X1B = (bf16*)(ws + WS_X1B); bf16* QP = (bf16*)(ws + WS_QP);
    float* rstd1 = (float*)(ws + WS_RSTD1); float* SS2 = (float*)(ws + WS_SS2); unsigned short* EXPERTS = (unsigned short*)(ws + WS_EXP); float* BEST = (float*)(ws + WS_BEST);
    float* PD = (float*)(ws + WS_PD); bf16* DELTA = (bf16*)(ws + WS_DELTA); unsigned char* CC8 = ws + WS_CC; float* SCC = (float*)(ws + WS_SCC);
    const int gw = bx * NWAVES + wave, NGW = G * NWAVES;

    if (IN(0)) REP(0) {
        P0Args a{x, args.in[1], args.in[2], args.in[7], args.in[9], args.in[10], args.in[11], args.in[12], args.in[13], args.in[14], XB, WinT, WoutT, WqT, SK, PoolT, U8, V8, SU, SV, rstd1};
        p0_prologue(a, lds, gw, NGW, wave, lane);
        if (BOTH(0)) GRID_BAR();
    }
    if (IN(1)) REP(1) {
        pg8::Gemm g{XB, WinT, T, DIN, D}; pg8::StaticOrder S; S.init(T, DIN, G, bx);
        pg8::EpiScaleBf16 E{Y, DIN, rstd1};
        pg8::gemm_phase<pg8::EpiScaleBf16, pg8::StaticOrder, true, true>(lds + RING_OFF, g, S, E);
        if (BOTH(1)) GRID_BAR();
    }
    if (IN(2)) REP(2) {
        for (int u = bx; u < NB * 128 * 2; u += G) attn_unit(lds, Y, AB, args.in[3], args.in[4], args.in[5], args.in[6], u, tid, wave, lane);
        for (int u = bx; u < T / 128; u += G) pool_rows(Y, AB, args.in[8], u, tid);
        if (BOTH(2)) GRID_BAR();
    }
    if (IN(3)) REP(3) {
        pg8::Gemm g{AB, WoutT, T, D, D}; pg8::StaticOrder S; S.init(T, D, G, bx);
        pg8::EpiResid E{XB, DELTA, X1B, SS2, D};
        pg8::gemm_phase<pg8::EpiResid, pg8::StaticOrder, true, true>(lds + RING_OFF, g, S, E);
        if (BOTH(3)) GRID_BAR();
    }
    if (IN(4)) REP(4) {
        pg8::Gemm g{X1B, WqT, T, DQ, D}; pg8::StaticOrder S; S.init(T, DQ, G, bx);
        pg8::EpiScaleBf16 E{QP, DQ, nullptr};
        pg8::gemm_phase<pg8::EpiScaleBf16, pg8::StaticOrder, true, true>(lds + RING_OFF, g, S, E);
        if (BOTH(4)) GRID_BAR();
    }
    if (IN(5)) REP(5) {
        for (int u = bx; u < (T / 256) * 8; u += G) topk_unit(lds, QP, SK, EXPERTS, BEST, u, tid, wave, lane);
        if (BOTH(5)) GRID_BAR();
    }
    if (IN(6)) REP(6) {
        if ((G & 7) == 0) peer_u_phase(lds, X1B, U8, EXPERTS, PD, bx & 7, bx >> 3, G >> 3, wave, lane);
        else for (int j = 0; j < 8; ++j) peer_u_phase(lds, X1B, U8, EXPERTS, PD, j, bx, G, wave, lane);
        if (BOTH(6)) GRID_BAR();
    }
    if (IN(7)) REP(7) {
        for (int t = gw; t < T; t += NGW) peer_combine(PD, EXPERTS, BEST, SS2, SU, SV, CC8, SCC, t, lane);
        if (BOTH(7)) GRID_BAR();
    }
    if (IN(8)) {
        if ((G & 7) == 0) peer_v_phase(lds, out, x, DELTA, V8, EXPERTS, CC8, SCC, bx & 7, bx >> 3, G >> 3, wave, lane);
        else for (int j = 0; j < 8; ++j) peer_v_phase(lds, out, x, DELTA, V8, EXPERTS, CC8, SCC, j, bx, G, wave, lane);
    }
#undef IN
#undef BOTH
}

extern "C" void kernel_launch(void* const* d_in, const int* in_sizes, int n_in, void* d_out, int out_size, void* d_ws, size_t ws_size, hipStream_t stream) {
    static int grid = 0;
    if (grid == 0) {
        if (n_in != 15 || in_sizes[0] != T * D || out_size != T * D || ws_size < WS_END) { fprintf(stderr, "kernel_launch: unexpected shapes (n_in %d, in0 %d, out %d, ws %zu)\n", n_in, n_in > 0 ? in_sizes[0] : -1, out_size, ws_size); grid = -1; return; }
        int dev = 0, cus = 0, per_cu = 0;
        if (hipGetDevice(&dev) != hipSuccess || hipDeviceGetAttribute(&cus, hipDeviceAttributeMultiprocessorCount, dev) != hipSuccess) { grid = -1; return; }
        if (hipFuncSetAttribute((const void*)fwd_kernel, hipFuncAttributeMaxDynamicSharedMemorySize, LDS_BYTES) != hipSuccess) { fprintf(stderr, "kernel_launch: hipFuncSetAttribute failed\n"); grid = -1; return; }
        if (hipOccupancyMaxActiveBlocksPerMultiprocessor(&per_cu, (const void*)fwd_kernel, NWAVES * 64, LDS_BYTES) != hipSuccess || per_cu < 1) { fprintf(stderr, "kernel_launch: occupancy query reports %d blocks per CU\n", per_cu); }
        (void)hipGetLastError();
        grid = cus;
    }
    if (grid < 0) return;
    if (hipMemsetAsync((char*)d_ws + WS_CTL, 0, CTL_ZERO_BYTES, stream) != hipSuccess) return;
    Args a{};
    for (int i = 0; i < 15; ++i) a.in[i] = (const float*)d_in[i];
    a.out = (float*)d_out; a.ws = (unsigned char*)d_ws;
    for (int li = 0; li < N_LAUNCHES; ++li) {
        a.ph_lo = (N_LAUNCHES == PER_PHASE) ? li : 0; a.ph_hi = (N_LAUNCHES == PER_PHASE) ? li + 1 : PER_PHASE; a.li = (N_LAUNCHES == PER_PHASE) ? 0 : li;
        hipLaunchKernelGGL(fwd_kernel, dim3(grid), dim3(NWAVES * 64), LDS_BYTES, stream, a);
        const hipError_t le = hipPeekAtLastError();
        if (le != hipSuccess) { fprintf(stderr, "kernel_launch: launch %d failed: %s\n", li, hipGetErrorName(le)); break; }
    }
}
```

```cpp
#include <hip/hip_runtime.h>
#include <cstdio>
#include <cstdint>
namespace pg8 {
#define PG8_LAS __attribute__((address_space(3)))
typedef unsigned short bf16_t;
typedef short bf16x8 __attribute__((ext_vector_type(8)));
typedef float f32x4 __attribute__((ext_vector_type(4)));
typedef unsigned u32x4 __attribute__((ext_vector_type(4)));
constexpr int BM = 256, BK = 64, HALF = 128, HTB = HALF * BK * 2  , STAGE_BYTES = 8 * HTB, NXCD = 8, WGM = 8;

__host__ __device__ __forceinline__ int lds_byte(int r, int c) { const int st = (r >> 4) * 2 + (c >> 5), rr = r & 15, cc = c & 31, ob = rr * 64 + cc * 2; return st * 1024 + (ob ^ (((ob >> 9) & 1) << 5)); }
__host__ __device__ __forceinline__ void stage_rc(int b, int& R, int& C) { const int st = b / 1024, sb = b % 1024, swz = sb ^ (((sb >> 9) & 1) << 5); R = (st >> 1) * 16 + swz / 64; C = (st & 1) * 32 + (swz % 64) / 2; }
__host__ __device__ __forceinline__ int perm32(int rho) { const int n = rho >> 4, i = rho & 15; return 8 * (i >> 2) + 4 * n + (i & 3); }

struct Unit { int pm, pn; };
struct Gemm { const bf16_t* A; const bf16_t* Bt; int M, N, K; };

struct StaticOrder {
    int nM, nN, nwg, G, c;
    __host__ __device__ void init(int M, int N, int G_, int c_) { nM = M / BM; nN = N / BM; nwg = nM * nN; G = G_; c = c_; }
    __host__ __device__ bool next(int i, Unit& u) const {
        const long L = (long)i * G + c; if (L >= nwg) return false;
        int wgid = (int)L; { const int q = nwg / NXCD, r = nwg % NXCD, xcd = wgid % NXCD, off = wgid / NXCD; wgid = (xcd < r ? xcd * (q + 1) : r * (q + 1) + (xcd - r) * q) + off; }
        const int nig = WGM * nN, gid = wgid / nig, fm = gid * WGM, gsz = (nM - fm) < WGM ? (nM - fm) : WGM;
        u.pm = fm + ((wgid % nig) % gsz); u.pn = (wgid % nig) / gsz; return true;
    }
    __device__ __forceinline__ void a_ready(const Unit&) const {}
    __device__ __forceinline__ void done(const Unit&) const {}
};

__device__ __forceinline__ unsigned cvt_pk_bf16(float lo, float hi) { unsigned r; asm volatile("v_cvt_pk_bf16_f32 %0, %1, %2" : "=v"(r) : "v"(lo), "v"(hi)); return r; }
struct EpiScaleBf16 {
    static constexpr bool PERM = true, AFTER_DRAIN = false, PROBE_TWICE = false;
    bf16_t* O; int ldc; const float* rs;
    __device__ __forceinline__ void operator()(const f32x4 (&acc)[2][2][4][2], const Unit& u, int wr, int wc, int fr, int fq) const {
        const int row0 = u.pm * BM + wr * 64 + fr, col0 = u.pn * BM + wc * 32 + 8 * fq;
#pragma unroll
        for (int ai = 0; ai < 2; ++ai)
#pragma unroll
            for (int m = 0; m < 4; ++m) { const int row = row0 + ai * HALF + m * 16; const float s = rs ? rs[row] : 1.f; bf16_t* rowp = O + (size_t)row * ldc + col0;
#pragma unroll
                for (int bj = 0; bj < 2; ++bj) { const f32x4 v0 = acc[ai][bj][m][0] * s, v1 = acc[ai][bj][m][1] * s;
                    u32x4 w; w.x = cvt_pk_bf16(v0[0], v0[1]); w.y = cvt_pk_bf16(v0[2], v0[3]); w.z = cvt_pk_bf16(v1[0], v1[1]); w.w = cvt_pk_bf16(v1[2], v1[3]);
                    *(u32x4*)(rowp + bj * HALF) = w; } }
    }
};
struct EpiResid {
    static constexpr bool PERM = true, AFTER_DRAIN = false, PROBE_TWICE = false;
    const bf16_t* xbf; bf16_t* dl; bf16_t* xb; float* ss; int ldc;
    __device__ __forceinline__ void operator()(const f32x4 (&acc)[2][2][4][2], const Unit& u, int wr, int wc, int fr, int fq) const {
        const int row0 = u.pm * BM + wr * 64 + fr, col0 = u.pn * BM + wc * 32 + 8 * fq;
#pragma unroll
        for (int ai = 0; ai < 2; ++ai)
#pragma unroll
            for (int m = 0; m < 4; ++m) { const int row = row0 + ai * HALF + m * 16; const size_t off = (size_t)row * ldc + col0; float q = 0.f;
#pragma unroll
                for (int bj = 0; bj < 2; ++bj) { const u32x4 xr = *(const u32x4*)(xbf + off + bj * HALF);
                    const f32x4 a0 = acc[ai][bj][m][0], a1 = acc[ai][bj][m][1];
                    f32x4 v0, v1;
                    v0[0] = a0[0] + __builtin_bit_cast(float, xr.x << 16); v0[1] = a0[1] + __builtin_bit_cast(float, xr.x & 0xffff0000u); v0[2] = a0[2] + __builtin_bit_cast(float, xr.y << 16); v0[3] = a0[3] + __builtin_bit_cast(float, xr.y & 0xffff0000u);
                    v1[0] = a1[0] + __builtin_bit_cast(float, xr.z << 16); v1[1] = a1[1] + __builtin_bit_cast(float, xr.z & 0xffff0000u); v1[2] = a1[2] + __builtin_bit_cast(float, xr.w << 16); v1[3] = a1[3] + __builtin_bit_cast(float, xr.w & 0xffff0000u);
                    u32x4 w; w.x = cvt_pk_bf16(a0[0], a0[1]); w.y = cvt_pk_bf16(a0[2], a0[3]); w.z = cvt_pk_bf16(a1[0], a1[1]); w.w = cvt_pk_bf16(a1[2], a1[3]);
                    *(u32x4*)(dl + off + bj * HALF) = w;
                    w.x = cvt_pk_bf16(v0[0], v0[1]); w.y = cvt_pk_bf16(v0[2], v0[3]); w.z = cvt_pk_bf16(v1[0], v1[1]); w.w = cvt_pk_bf16(v1[2], v1[3]);
                    *(u32x4*)(xb + off + bj * HALF) = w;
                    q += (v0[0] * v0[0] + v0[1] * v0[1]) + (v0[2] * v0[2] + v0[3] * v0[3]) + (v1[0] * v1[0] + v1[1] * v1[1]) + (v1[2] * v1[2] + v1[3] * v1[3]); }
                q += __shfl_xor(q, 16); q += __shfl_xor(q, 32);
                if (fq == 0) ss[(size_t)row * 16 + u.pn * 4 + wc] = q; }
    }
};
template <class Epi, class Sched, bool ALIGN_EPI = false, bool SP2 = false>
__device__ __forceinline__ void gemm_phase(PG8_LAS unsigned char* lds, const Gemm g, const Sched& S, const Epi& E) {
    const int tid = threadIdx.x, wid = __builtin_amdgcn_readfirstlane(tid >> 6), lane = tid & 63, wr = wid >> 2, wc = wid & 3, fr = lane & 15, fq = lane >> 4;
    const int K = g.K, nt = K / BK;
    unsigned voffA[2], voffB[2];
#pragma unroll
    for (int i = 0; i < 2; ++i) { int R, C; stage_rc(tid * 16 + i * 8192, R, C); const int Rb = Epi::PERM ? ((R & ~31) + perm32(R & 31)) : R;
        voffA[i] = (unsigned)(R * K + C) * 2u; voffB[i] = (unsigned)(Rb * K + C) * 2u; }
    const size_t kstep = (size_t)(BK * 2);
    const size_t hstep = (size_t)HALF * K * 2;
    const size_t tstep = 2 * hstep;
    const unsigned ldsw = (unsigned)wid * 1024u;
    const int aoff = lds_byte(wr * 64 + fr, fq * 8), boff = lds_byte(wc * 32 + fr, fq * 8);
#define PG8_SA(b, h) (((b) * 2 + (h)) * HTB)
#define PG8_SB(b, h) ((4 + (b) * 2 + (h)) * HTB)
#define PG8_STAGE(bufoff, gbase, voff) do { _Pragma("unroll") for (int _i = 0; _i < 2; ++_i) \
        __builtin_amdgcn_global_load_lds((const unsigned*)((const char*)(gbase) + (voff)[_i]), (PG8_LAS unsigned*)(lds + (bufoff) + ldsw + _i * 8192), 16, 0, 0); } while (0)
#define PG8_LDA(dst, b, h) do { _Pragma("unroll") for (int m = 0; m < 4; ++m) _Pragma("unroll") for (int k = 0; k < 2; ++k) dst[m][k] = *(const PG8_LAS bf16x8*)(lds + PG8_SA(b, h) + aoff + m * 2048 + k * 1024); } while (0)
#define PG8_LDB(dst, b, h) do { _Pragma("unroll") for (int n = 0; n < 2; ++n) _Pragma("unroll") for (int k = 0; k < 2; ++k) dst[n][k] = *(const PG8_LAS bf16x8*)(lds + PG8_SB(b, h) + boff + n * 2048 + k * 1024); } while (0)
#define PG8_MMA(ai, bj, At, Bt) do { __builtin_amdgcn_s_setprio(1); _Pragma("unroll") for (int m = 0; m < 4; ++m) _Pragma("unroll") for (int n = 0; n < 2; ++n) _Pragma("unroll") for (int k = 0; k < 2; ++k) \
        acc[ai][bj][m][n] = __builtin_amdgcn_mfma_f32_16x16x32_bf16(Bt[n][k], At[m][k], acc[ai][bj][m][n], 0, 0, 0); __builtin_amdgcn_s_setprio(0); } while (0)
#define PG8_WAIT_V(n) asm volatile("s_waitcnt vmcnt(" #n ")" ::: "memory")
#define PG8_WAIT_L(n) asm volatile("s_waitcnt lgkmcnt(" #n ")" ::: "memory")
#define PG8_BAR __builtin_amdgcn_s_barrier()
#define PG8_SCHED __builtin_amdgcn_sched_barrier(0)
    Unit cur, nxt; int ui = 0;
    if (!S.next(0, cur)) return;
    f32x4 acc[2][2][4][2];
#pragma unroll
    for (int a = 0; a < 2; ++a)
#pragma unroll
        for (int b = 0; b < 2; ++b)
#pragma unroll
            for (int m = 0; m < 4; ++m)
#pragma unroll
                for (int n = 0; n < 2; ++n) acc[a][b][m][n] = (f32x4){0.f, 0.f, 0.f, 0.f};
    bf16x8 At[4][2], B0[2][2], B1[2][2];
    const char* cA = (const char*)g.A + (size_t)cur.pm * tstep; const char* cB = (const char*)g.Bt + (size_t)cur.pn * tstep;
    S.a_ready(cur);
    if constexpr (SP2) {
        PG8_STAGE(PG8_SB(0, 0), cB, voffB); PG8_STAGE(PG8_SB(0, 1), cB + hstep, voffB); PG8_STAGE(PG8_SA(0, 0), cA, voffA); PG8_STAGE(PG8_SA(0, 1), cA + hstep, voffA);
        if (wr == 1) PG8_BAR;
        PG8_WAIT_V(2); PG8_BAR;
        PG8_STAGE(PG8_SB(1, 0), cB + kstep, voffB); PG8_STAGE(PG8_SA(1, 0), cA + kstep, voffA); PG8_STAGE(PG8_SB(1, 1), cB + hstep + kstep, voffB);
        PG8_WAIT_V(6); PG8_BAR;
    } else {
        PG8_STAGE(PG8_SB(0, 0), cB, voffB); PG8_STAGE(PG8_SA(0, 0), cA, voffA); PG8_STAGE(PG8_SB(0, 1), cB + hstep, voffB); PG8_STAGE(PG8_SA(0, 1), cA + hstep, voffA);
        if (wr == 1) PG8_BAR;
        PG8_WAIT_V(4); PG8_BAR;
        PG8_STAGE(PG8_SB(1, 0), cB + kstep, voffB); PG8_STAGE(PG8_SA(1, 0), cA + kstep, voffA); PG8_STAGE(PG8_SB(1, 1), cB + hstep + kstep, voffB);
        PG8_WAIT_V(6); PG8_BAR;
    }
    for (;;) {
        const bool has_next = S.next(ui + 1, nxt);
        const char* nA = has_next ? (const char*)g.A + (size_t)nxt.pm * tstep : cA; const char* nB = has_next ? (const char*)g.Bt + (size_t)nxt.pn * tstep : cB;
        for (int t = 0; t < nt; t += 2) {
            const bool last = (t == nt - 2);
            const char* a1 = cA + (size_t)(t + 1) * kstep;
            const char* a2 = last ? nA : cA + (size_t)(t + 2) * kstep; const char* b2 = last ? nB : cB + (size_t)(t + 2) * kstep;
            const char* a3 = a2 + kstep; const char* b3 = b2 + kstep;
            if (last && has_next) S.a_ready(nxt);
            if constexpr (SP2) {
            PG8_LDB(B0, 0, 0); PG8_LDB(B1, 0, 1); PG8_SCHED; PG8_LDA(At, 0, 0); PG8_STAGE(PG8_SA(1, 1), a1 + hstep, voffA);
            PG8_WAIT_V(8); PG8_WAIT_L(0); PG8_BAR; PG8_MMA(0, 0, At, B0); PG8_MMA(0, 1, At, B1); PG8_BAR; PG8_SCHED;
            PG8_LDA(At, 0, 1); PG8_STAGE(PG8_SB(0, 0), b2, voffB); PG8_STAGE(PG8_SB(0, 1), b2 + hstep, voffB); PG8_STAGE(PG8_SA(0, 0), a2, voffA);
            PG8_WAIT_V(8); PG8_WAIT_L(0); PG8_BAR; PG8_MMA(1, 0, At, B0); PG8_MMA(1, 1, At, B1); PG8_BAR; PG8_SCHED;
            PG8_LDB(B0, 1, 0); PG8_LDB(B1, 1, 1); PG8_SCHED; PG8_LDA(At, 1, 0); PG8_STAGE(PG8_SA(0, 1), a2 + hstep, voffA);
            PG8_WAIT_V(8); PG8_WAIT_L(0); PG8_BAR; PG8_MMA(0, 0, At, B0); PG8_MMA(0, 1, At, B1); PG8_BAR; PG8_SCHED;
            PG8_LDA(At, 1, 1); PG8_STAGE(PG8_SB(1, 0), b3, voffB); PG8_STAGE(PG8_SB(1, 1), b3 + hstep, voffB); PG8_STAGE(PG8_SA(1, 0), a3, voffA);
            PG8_WAIT_V(8); PG8_WAIT_L(0); PG8_BAR; PG8_MMA(1, 0, At, B0); PG8_MMA(1, 1, At, B1); PG8_BAR; PG8_SCHED;
            } else {
            PG8_LDB(B0, 0, 0); PG8_SCHED; PG8_LDA(At, 0, 0); PG8_STAGE(PG8_SA(1, 1), a1 + hstep, voffA);
            PG8_WAIT_L(8); PG8_BAR; PG8_WAIT_L(0); PG8_MMA(0, 0, At, B0); PG8_BAR; PG8_SCHED;
            PG8_LDB(B1, 0, 1); PG8_STAGE(PG8_SB(0, 0), b2, voffB);
            PG8_BAR; PG8_WAIT_L(0); PG8_MMA(0, 1, At, B1); PG8_BAR;
            PG8_LDA(At, 0, 1); PG8_STAGE(PG8_SA(0, 0), a2, voffA);
            PG8_BAR; PG8_WAIT_L(0); PG8_MMA(1, 0, At, B0); PG8_BAR; PG8_SCHED;
            PG8_STAGE(PG8_SB(0, 1), b2 + hstep, voffB);
            PG8_WAIT_V(6); PG8_BAR; PG8_MMA(1, 1, At, B1); PG8_BAR;
            PG8_LDB(B0, 1, 0); PG8_SCHED; PG8_LDA(At, 1, 0); PG8_STAGE(PG8_SA(0, 1), a2 + hstep, voffA);
            PG8_WAIT_L(8); PG8_BAR; PG8_WAIT_L(0); PG8_MMA(0, 0, At, B0); PG8_BAR; PG8_SCHED;
            PG8_LDB(B1, 1, 1); PG8_STAGE(PG8_SB(1, 0), b3, voffB);
            PG8_BAR; PG8_WAIT_L(0); PG8_MMA(0, 1, At, B1); PG8_BAR;
            PG8_LDA(At, 1, 1); PG8_STAGE(PG8_SA(1, 0), a3, voffA);
            PG8_BAR; PG8_WAIT_L(0); PG8_MMA(1, 0, At, B0); PG8_BAR; PG8_SCHED;
            PG8_STAGE(PG8_SB(1, 1), b3 + hstep, voffB);
            PG8_WAIT_V(6); PG8_BAR; PG8_MMA(1, 1, At, B1); PG8_BAR;
            }
        }
        if constexpr (ALIGN_EPI) { if (wr == 0) PG8_BAR; }
        if constexpr (!Epi::AFTER_DRAIN) { E(acc, cur, wr, wc, fr, fq);
#if defined(MK_EXTRA)
            if (Epi::PROBE_TWICE) { asm volatile("" ::: "memory"); E(acc, cur, wr, wc, fr, fq); }
#endif
            S.done(cur); }
        if (!has_next) break;
#pragma unroll
        for (int a = 0; a < 2; ++a)
#pragma unroll
            for (int b = 0; b < 2; ++b)
#pragma unroll
                for (int m = 0; m < 4; ++m)
#pragma unroll
                    for (int n = 0; n < 2; ++n) acc[a][b][m][n] = (f32x4){0.f, 0.f, 0.f, 0.f};
        cur = nxt; cA = nA; cB = nB; ++ui;
        if constexpr (ALIGN_EPI) { if (wr == 1) PG8_BAR; }
    }
    PG8_WAIT_V(0);
    if constexpr (!ALIGN_EPI) { if (wr == 0) PG8_BAR; }
    PG8_BAR;
    if constexpr (Epi::AFTER_DRAIN) { E.fused(acc, cur, wr, wc, fr, fq, lds, wid, lane); S.done(cur); }
#undef PG8_SA
#undef PG8_SB
#undef PG8_STAGE
#undef PG8_LDA
#undef PG8_LDB
#undef PG8_MMA
#undef PG8_WAIT_V
#undef PG8_WAIT_L
#undef PG8_BAR
#undef PG8_SCHED
}
}
constexpr int NWAVES = 8;
#ifndef MK_N_LAUNCHES
#define MK_N_LAUNCHES 1
#endif
constexpr int PER_PHASE = 9;
constexpr int N_LAUNCHES = MK_N_LAUNCHES;

constexpr int NB = 4, SEQ = 8192, T = NB * SEQ, D = 1024, DIN = 1280, NEXP = 16384, DQ = 2048;
constexpr float EPS = 1e-6f;

constexpr size_t MiB = 1u << 20;
constexpr size_t WS_CTL = 0, CTL_ZERO_BYTES = 1 * MiB;
constexpr size_t WS_WIN = 2 * MiB;
constexpr size_t WS_WOUT = 5 * MiB;
constexpr size_t WS_WQ = 7 * MiB;
constexpr size_t WS_SK = 11 * MiB;
constexpr size_t WS_POOLT = 11 * MiB + 512 * 1024;
constexpr size_t WS_RSTD1 = 12 * MiB;
constexpr size_t WS_SS2 = 13 * MiB;
constexpr size_t WS_SU = 15 * MiB;
constexpr size_t WS_SV = 15 * MiB + 256 * 1024;
constexpr size_t WS_EXP = 16 * MiB;
constexpr size_t WS_BEST = 24 * MiB;
constexpr size_t WS_CC = 40 * MiB;
constexpr size_t WS_SCC = 44 * MiB;
constexpr size_t WS_U8 = 56 * MiB;
constexpr size_t WS_V8 = 72 * MiB;
constexpr size_t WS_AB = 88 * MiB;
constexpr size_t WS_X1B = 152 * MiB;
constexpr size_t WS_PD = 216 * MiB;
constexpr size_t WS_DELTA = 360 * MiB;
constexpr size_t WS_XB = 216 * MiB;
constexpr size_t WS_Y = 280 * MiB;
constexpr size_t WS_QP = 216 * MiB;
constexpr size_t WS_END = 424 * MiB;
constexpr int CW_BAR = 4096;

constexpr int RING_OFF = 0, RING_BYTES = 131072;
constexpr int LDSCTL_OFF = RING_BYTES, MISC_OFF = LDSCTL_OFF + 320;
constexpr int LDS_BYTES = 147456;
#define GAS __attribute__((address_space(1)))
#define LAS __attribute__((address_space(3)))
typedef unsigned short bf16;
typedef unsigned v4u __attribute__((ext_vector_type(4)));
typedef float f32x4 __attribute__((ext_vector_type(4)));
typedef short bf16x8 __attribute__((ext_vector_type(8)));
typedef GAS unsigned gu32;
typedef GAS unsigned long long gu64;
#define RLX_AGENT __ATOMIC_RELAXED, __HIP_MEMORY_SCOPE_AGENT
#define LDS_WAIT() asm volatile("s_waitcnt lgkmcnt(0)" ::: "memory")
#define VM_WAIT() asm volatile("s_waitcnt vmcnt(0)" ::: "memory")
__device__ __forceinline__ unsigned long long rt() { return __builtin_amdgcn_s_memrealtime(); }
__device__ __forceinline__ unsigned f2bf(float f) { unsigned u = __builtin_bit_cast(unsigned, f); return (u + 0x7fffu + ((u >> 16) & 1u)) >> 16; }
__device__ __forceinline__ unsigned pk2(float lo, float hi) { return f2bf(lo) | (f2bf(hi) << 16); }
#define XB_TMO      128
#define XB_XCNT(j)  (256  + 64 * (j))
#define XB_XSUB(j)  (1280 + 64 * (j))
#define XB_XGEN(j)  (2304 + 64 * (j))
#define XB_TOP      3328
#define XB_TOPGEN   3392
#define XCD_BAR_WORDS 3456
#define XB_SPIN_CAP (1u << 18)

__device__ __forceinline__ unsigned xb_ld(unsigned* p)              { return __hip_atomic_load(p, __ATOMIC_RELAXED, __HIP_MEMORY_SCOPE_AGENT); }
__device__ __forceinline__ unsigned xb_add(unsigned* p, unsigned v) { return __hip_atomic_fetch_add(p, v, __ATOMIC_RELAXED, __HIP_MEMORY_SCOPE_AGENT); }
__device__ __forceinline__ unsigned xb_xcc_id() { return (unsigned)__builtin_amdgcn_s_getreg((3 << 11) | 20) & 0xFu; }
#define XB_SPIN(cond, bar) do { unsigned _sp = 0; while (cond) { __builtin_amdgcn_s_sleep(1); \
    if ((++_sp & 255u) == 0u) { if (xb_ld(&(bar)[XB_TMO])) break; if (_sp > XB_SPIN_CAP) { atomicAdd(&(bar)[XB_TMO], 1u); break; } } } } while (0)

struct XcdBarrier {
    unsigned* bar; unsigned x;
    volatile LAS unsigned* st;
};

__device__ __forceinline__ XcdBarrier xcd_barrier_post(unsigned* bar, volatile LAS unsigned* st) {
    XcdBarrier b; b.bar = bar; b.x = xb_xcc_id(); b.st = st;
    if (threadIdx.x == 0) (void)xb_add(&bar[XB_XCNT(b.x)], 1u);
    return b;
}
__device__ __forceinline__ void xcd_barrier_complete(unsigned* bar, unsigned x, unsigned& nloc, unsigned& nx) {
    const unsigned G = gridDim.x * gridDim.y * gridDim.z;
    unsigned sum, cnt, mine, sp = 0u;
    for (;;) {
        sum = 0u; cnt = 0u; mine = 0u;
#pragma unroll
        for (unsigned j = 0; j < 16; ++j) { const unsigned c = xb_ld(&bar[XB_XCNT(j)]); sum += c; cnt += (c > 0u) ? 1u : 0u; mine = (j == x) ? c : mine; }
        if (sum == G) break;
        __builtin_amdgcn_s_sleep(1);
        if ((++sp & 255u) == 0u) { if (xb_ld(&bar[XB_TMO])) break; if (sp > XB_SPIN_CAP) { atomicAdd(&bar[XB_TMO], 1u); break; } }
    }
    nloc = mine > 0u ? mine : 1u; nx = cnt > 0u ? cnt : 1u;
}

__device__ __forceinline__ void xcd_barrier(const XcdBarrier& b) {
    asm volatile("s_waitcnt vmcnt(0)" ::: "memory");
    __syncthreads();
    if (threadIdx.x == 0) {
        unsigned* bar = b.bar;
        __builtin_amdgcn_s_waitcnt(0);
        unsigned nloc = b.st[0], nx = b.st[1];
        if (nloc == 0u) { xcd_barrier_complete(bar, b.x, nloc, nx); b.st[0] = nloc; b.st[1] = nx; }
        const unsigned old = xb_add(&bar[XB_XSUB(b.x)], 1u);
        const unsigned gen = old / nloc;
        if (old + 1u == (gen + 1u) * nloc) {
            __builtin_amdgcn_fence(__ATOMIC_RELEASE, "agent");
            asm volatile("s_waitcnt vmcnt(0)" ::: "memory");
            const unsigned og = xb_add(&bar[XB_TOP], 1u);
            const unsigned tg = og / nx;
            if (og + 1u == (tg + 1u) * nx) xb_add(&bar[XB_TOPGEN], 1u);
            else XB_SPIN(xb_ld(&bar[XB_TOPGEN]) == tg, bar);
            __builtin_amdgcn_fence(__ATOMIC_ACQUIRE, "agent");
            xb_add(&bar[XB_XGEN(b.x)], 1u);
            asm volatile("s_waitcnt vmcnt(0)" ::: "memory");
        } else {
            XB_SPIN(xb_ld(&bar[XB_XGEN(b.x)]) == gen, bar);
            __builtin_amdgcn_fence(__ATOMIC_ACQUIRE, "agent");
            asm volatile("s_waitcnt vmcnt(0)" ::: "memory");
        }
    }
    __syncthreads();
}
typedef float f32x16 __attribute__((ext_vector_type(16)));
typedef __bf16 bf16x2_t __attribute__((ext_vector_type(2)));
#define MFMA32(a, b, c) __builtin_amdgcn_mfma_f32_32x32x16_bf16((a), (b), (c), 0, 0, 0)
__device__ __forceinline__ float bf_lo(unsigned u) { return __builtin_bit_cast(float, u << 16); }
__device__ __forceinline__ float bf_hi(unsigned u) { return __builtin_bit_cast(float, u & 0xffff0000u); }
__device__ __forceinline__ float dot2_bf16(unsigned w, unsigned x, float acc) { return __builtin_amdgcn_fdot2_f32_bf16(__builtin_bit_cast(bf16x2_t, w), __builtin_bit_cast(bf16x2_t, x), acc, false); }
__device__ __forceinline__ float wave_sum(float v) {
#pragma unroll
    for (int o = 1; o < 64; o <<= 1) v += __shfl_xor(v, o);
    return v;
}

__device__ __forceinline__ unsigned pack_i8x4(float a, float b, float c, float d) {
    return ((unsigned)__float2int_rn(a) & 0xffu) | (((unsigned)__float2int_rn(b) & 0xffu) << 8) | (((unsigned)__float2int_rn(c) & 0xffu) << 16) | (((unsigned)__float2int_rn(d) & 0xffu) << 24);
}

__device__ __forceinline__ void p0_transpose_item(const float* W, int K, int N, bf16* WT, const float* gk, LAS float* scr, int item, int lane) {
    const int nblk = N / 32, kb = item / nblk, nb = item % nblk, k0 = 64 * kb, n0 = 32 * nb;
    float wv[32];
#pragma unroll
    for (int i = 0; i < 32; ++i) wv[i] = W[(size_t)(k0 + 2 * i + (lane >> 5)) * N + n0 + (lane & 31)];
#pragma unroll
    for (int i = 0; i < 32; ++i) { const int kk = 2 * i + (lane >> 5); float w = wv[i]; if (gk) w *= gk[k0 + kk]; scr[kk * 33 + (lane & 31)] = w; }
    LDS_WAIT(); asm volatile("" ::: "memory");
    const int c = lane & 7;
#pragma unroll
    for (int j = 0; j < 4; ++j) { const int n = (lane >> 3) + 8 * j; const LAS float* s = scr + (8 * c) * 33 + n;
        v4u o; o.x = pk2(s[0 * 33], s[1 * 33]); o.y = pk2(s[2 * 33], s[3 * 33]); o.z = pk2(s[4 * 33], s[5 * 33]); o.w = pk2(s[6 * 33], s[7 * 33]);
        *(GAS v4u*)(WT + (size_t)(n0 + n) * K + k0 + 8 * c) = o; }
    LDS_WAIT(); asm volatile("" ::: "memory");
}
__device__ __forceinline__ float row_to_bf16(const float* src, bf16* dst, const float* g, int lane) {
    const GAS f32x4* xr = (const GAS f32x4*)src + lane; float s = 0.f;
    GAS unsigned long long* o8 = (GAS unsigned long long*)dst + lane;
#pragma unroll
    for (int j = 0; j < 4; ++j) { f32x4 v = xr[64 * j]; s += (v.x * v.x + v.y * v.y) + (v.z * v.z + v.w * v.w);
        if (g) { const f32x4 gv = ((const GAS f32x4*)g)[64 * j + lane]; v = v * gv; }
        o8[64 * j] = (unsigned long long)pk2(v.x, v.y) | ((unsigned long long)pk2(v.z, v.w) << 32); }
    return s;
}
__device__ __forceinline__ void row_to_i8(const float* src, unsigned char* dst, const float* g, float* sc, int m, int lane) {
    const GAS f32x4* xr = (const GAS f32x4*)src + lane; f32x4 v[4]; float amax = 0.f;
#pragma unroll
    for (int j = 0; j < 4; ++j) { v[j] = xr[64 * j]; if (g) { const f32x4 gv = ((const GAS f32x4*)g)[64 * j + lane]; v[j] = v[j] * gv; }
        amax = fmaxf(fmaxf(amax, fmaxf(fabsf(v[j].x), fabsf(v[j].y))), fmaxf(fabsf(v[j].z), fabsf(v[j].w))); }
#pragma unroll
    for (int o = 1; o < 64; o <<= 1) amax = fmaxf(amax, __shfl_xor(amax, o));
    const float inv = amax > 0.f ? 127.0f / amax : 0.f;
    GAS unsigned* o4 = (GAS unsigned*)dst + lane;
#pragma unroll
    for (int j = 0; j < 4; ++j) { const unsigned q0 = (unsigned)__float2int_rn(v[j].x * inv) & 0xffu, q1 = (unsigned)__float2int_rn(v[j].y * inv) & 0xffu, q2 = (unsigned)__float2int_rn(v[j].z * inv) & 0xffu, q3 = (unsigned)__float2int_rn(v[j].w * inv) & 0xffu;
        o4[64 * j] = q0 | (q1 << 8) | (q2 << 16) | (q3 << 24); }
    if (lane == 0) sc[m] = amax * (1.0f / 127.0f);
}
__device__ __forceinline__ void p0_poolfold_item(const float* w_in, const float* pool_w, const float* g1, bf16* WinT, int item, int lane) {
    const int kb = item & 15, nb = (item >> 4) & 15, g = item >> 8, k = 64 * kb + lane, n0 = 8 * nb;
    const GAS f32x4* wr = (const GAS f32x4*)(w_in + (size_t)k * DIN + 768 + 128 * g);
    const float* pw = pool_w + (size_t)g * 16384 + n0;
    float acc[8];
#pragma unroll
    for (int n = 0; n < 8; ++n) acc[n] = 0.f;
#pragma unroll 1
    for (int cb = 0; cb < 32; cb += 16) { f32x4 a[16];
#pragma unroll
        for (int c4 = 0; c4 < 16; ++c4) a[c4] = wr[cb + c4];
#pragma unroll
        for (int c4 = 0; c4 < 16; ++c4)
#pragma unroll
            for (int n = 0; n < 8; ++n) { const float* pp = pw + (4 * (cb + c4)) * 128 + n; acc[n] = fmaf(a[c4].x, pp[0], acc[n]); acc[n] = fmaf(a[c4].y, pp[128], acc[n]); acc[n] = fmaf(a[c4].z, pp[256], acc[n]); acc[n] = fmaf(a[c4].w, pp[384], acc[n]); } }
    const float gk = g1[k];
#pragma unroll
    for (int n = 0; n < 8; ++n) WinT[(size_t)(768 + 128 * g + n0 + n) * D + k] = (bf16)f2bf(acc[n] * gk);
}
struct P0Args { const float *x, *g1, *w_in, *pool_w, *w_out, *g2, *wq, *sk, *u, *v; bf16 *XB, *WinT, *WoutT, *WqT, *SK, *PoolT; unsigned char *U8, *V8; float *su, *sv; float* rstd1; };
__device__ __forceinline__ void p0_prologue(const P0Args& a, LAS unsigned char* lds, int gw, int NGW, int wave, int lane) {
    LAS float* scr = (LAS float*)(lds + RING_OFF + wave * 16384);
    constexpr int I_IN = (D / 64) * (768 / 32), I_OUT = (D / 64) * (D / 32), I_Q = (D / 64) * (DQ / 32), I_P = 4 * 16 * 16;
    constexpr int NITEMS = I_P + I_IN + I_OUT + I_Q;
    for (int it = gw; it < NITEMS; it += NGW) {
        int r = it;
        if (r < I_P) { p0_poolfold_item(a.w_in, a.pool_w, a.g1, a.WinT, r, lane); continue; } r -= I_P;
        if (r < I_IN) { const int kb = r / 24, nb = r % 24; p0_transpose_item(a.w_in, D, DIN, a.WinT, a.g1, scr, kb * 40 + nb, lane); continue; } r -= I_IN;
        if (r < I_OUT) { p0_transpose_item(a.w_out, D, D, a.WoutT, nullptr, scr, r, lane); continue; } r -= I_OUT;
        p0_transpose_item(a.wq, D, DQ, a.WqT, a.g2, scr, r, lane);
    }
    for (int m0 = gw; m0 < T; m0 += 4 * NGW) {
        f32x4 v[4][4];
#pragma unroll
        for (int r = 0; r < 4; ++r) { const int m = m0 + r * NGW < T ? m0 + r * NGW : m0; const GAS f32x4* xr = (const GAS f32x4*)(a.x + (size_t)m * D) + lane;
#pragma unroll
            for (int j = 0; j < 4; ++j) v[r][j] = xr[64 * j]; }
#pragma unroll
        for (int r = 0; r < 4; ++r) { const int m = m0 + r * NGW; if (m < T) {
            float s = 0.f; GAS unsigned long long* o8 = (GAS unsigned long long*)(a.XB + (size_t)m * D) + lane;
#pragma unroll
            for (int j = 0; j < 4; ++j) { const f32x4 w = v[r][j]; s += (w.x * w.x + w.y * w.y) + (w.z * w.z + w.w * w.w); o8[64 * j] = (unsigned long long)pk2(w.x, w.y) | ((unsigned long long)pk2(w.z, w.w) << 32); }
            s = wave_sum(s); if (lane == 0) a.rstd1[m] = 1.0f / sqrtf(s * (1.0f / D) + EPS); } }
    }
    for (int m0 = gw; m0 < 2 * NEXP; m0 += 4 * NGW) {
        f32x4 v[4][4];
#pragma unroll
        for (int r = 0; r < 4; ++r) { const int mm = m0 + r * NGW < 2 * NEXP ? m0 + r * NGW : m0; const bool isv = mm >= NEXP; const int m = isv ? mm - NEXP : mm;
            const GAS f32x4* xr = (const GAS f32x4*)((isv ? a.v : a.u) + (size_t)m * D) + lane;
#pragma unroll
            for (int j = 0; j < 4; ++j) v[r][j] = xr[64 * j]; }
#pragma unroll
        for (int r = 0; r < 4; ++r) { const int mm = m0 + r * NGW; if (mm < 2 * NEXP) { const bool isv = mm >= NEXP; const int m = isv ? mm - NEXP : mm;
            float amax = 0.f;
#pragma unroll
            for (int j = 0; j < 4; ++j) { if (!isv) { const f32x4 gv = ((const GAS f32x4*)a.g2)[64 * j + lane]; v[r][j] = v[r][j] * gv; }
                amax = fmaxf(fmaxf(amax, fmaxf(fabsf(v[r][j].x), fabsf(v[r][j].y))), fmaxf(fabsf(v[r][j].z), fabsf(v[r][j].w))); }
#pragma unroll
            for (int o = 1; o < 64; o <<= 1) amax = fmaxf(amax, __shfl_xor(amax, o));
            const float inv = amax > 0.f ? 127.0f / amax : 0.f;
            unsigned char* tb_ = (isv ? a.V8 : a.U8) + (size_t)m * 128 + ((4 * lane) & 127);
#pragma unroll
            for (int j = 0; j < 4; ++j) *(GAS unsigned*)(tb_ + (size_t)((4 * lane + 256 * j) >> 7) * ((size_t)NEXP * 128)) = pack_i8x4(v[r][j].x * inv, v[r][j].y * inv, v[r][j].z * inv, v[r][j].w * inv);
            if (lane == 0) (isv ? a.sv : a.su)[m] = amax * (1.0f / 127.0f); } }
    }
    for (int m = gw; m < 256; m += NGW) (void)row_to_bf16(a.sk + (size_t)m * D, a.SK + (size_t)m * D, nullptr, lane);
}

__device__ __forceinline__ int t5_bucket(int rel) {
    const int n = rel < 0 ? -rel : rel; const int base = rel > 0 ? 16 : 0;
    const int v = n < 8 ? n : (n < 12 ? 8 : (n < 16 ? 9 : (n < 23 ? 10 : (n < 32 ? 11 : (n < 46 ? 12 : (n < 64 ? 13 : (n < 91 ? 14 : 15)))))));
    return base + v;
}
__device__ __forceinline__ void attn_unit(LAS unsigned char* lds, const bf16* Y, bf16* AB, const float* qg, const float* kg, const float* sinks, const float* relb,
                                          int unit, int tid, int wave, int lane) {
    const int kvh = unit & 1, c = (unit >> 1) & 127, b = unit >> 8;
    LAS bf16* Ks = (LAS bf16*)lds;
    LAS bf16* Vt = (LAS bf16*)(lds + 27648);
    LAS float* bt = (LAS float*)(lds + 53248);
    const int row0 = b * SEQ + (c - 2) * 64;
#pragma unroll
    for (int rep = 0; rep < 3; ++rep) {
        const int it = tid + rep * 512, j = it >> 3, ch = it & 7;
        const bool valid = (c - 2 + (j >> 6)) >= 0;
        v4u kraw = {0u, 0u, 0u, 0u}, vraw = {0u, 0u, 0u, 0u};
        if (valid) { const bf16* rp = Y + (size_t)(row0 + j) * DIN; kraw = *(const GAS v4u*)(rp + 512 + 64 * kvh + 8 * ch); vraw = *(const GAS v4u*)(rp + 640 + 64 * kvh + 8 * ch); }
        float kf[8] = {bf_lo(kraw.x), bf_hi(kraw.x), bf_lo(kraw.y), bf_hi(kraw.y), bf_lo(kraw.z), bf_hi(kraw.z), bf_lo(kraw.w), bf_hi(kraw.w)};
        float ss = 0.f;
#pragma unroll
        for (int e = 0; e < 8; ++e) ss += kf[e] * kf[e];
        ss += __shfl_xor(ss, 1); ss += __shfl_xor(ss, 2); ss += __shfl_xor(ss, 4);
        const float r = 1.0f / sqrtf(ss * (1.0f / 64.0f) + EPS);
        const f32x4 g0 = *(const GAS f32x4*)(kg + 8 * ch), g1 = *(const GAS f32x4*)(kg + 8 * ch + 4);
        v4u ko; ko.x = pk2(kf[0] * r * g0.x, kf[1] * r * g0.y); ko.y = pk2(kf[2] * r * g0.z, kf[3] * r * g0.w); ko.z = pk2(kf[4] * r * g1.x, kf[5] * r * g1.y); ko.w = pk2(kf[6] * r * g1.z, kf[7] * r * g1.w);
        *(LAS v4u*)(Ks + j * 72 + 8 * ch) = ko;
        const int s16 = j >> 4, kk = j & 15, hh = (kk >> 2) & 1, jj = ((kk >> 3) << 2) | (kk & 3), pos = 16 * s16 + 8 * hh + jj;
        LAS bf16* vp = Vt + (8 * ch) * 200 + pos;
        vp[0 * 200] = (bf16)(vraw.x & 0xffffu); vp[1 * 200] = (bf16)(vraw.x >> 16); vp[2 * 200] = (bf16)(vraw.y & 0xffffu); vp[3 * 200] = (bf16)(vraw.y >> 16);
        vp[4 * 200] = (bf16)(vraw.z & 0xffffu); vp[5 * 200] = (bf16)(vraw.z >> 16); vp[6 * 200] = (bf16)(vraw.w & 0xffffu); vp[7 * 200] = (bf16)(vraw.w >> 16);
    }
#pragma unroll
    for (int rep = 0; rep < 2; ++rep) { const int it = tid + rep * 512, g = it >> 8, r = it & 255; bt[it] = relb[t5_bucket(r - 191) * 8 + kvh * 4 + g]; }
    LDS_WAIT(); __syncthreads();

    const int g = wave >> 1, i = 32 * (wave & 1) + (lane & 31), hh = lane >> 5, habs = kvh * 4 + g;
    const size_t qrow = (size_t)b * SEQ + (size_t)c * 64 + i;
    const bf16* qp = Y + qrow * DIN + habs * 64 + 8 * hh;
    v4u qraw[4]; float ss = 0.f;
#pragma unroll
    for (int s = 0; s < 4; ++s) { qraw[s] = *(const GAS v4u*)(qp + 16 * s);
        const float f0 = bf_lo(qraw[s].x), f1 = bf_hi(qraw[s].x), f2 = bf_lo(qraw[s].y), f3 = bf_hi(qraw[s].y), f4 = bf_lo(qraw[s].z), f5 = bf_hi(qraw[s].z), f6 = bf_lo(qraw[s].w), f7 = bf_hi(qraw[s].w);
        ss += (f0 * f0 + f1 * f1) + (f2 * f2 + f3 * f3) + (f4 * f4 + f5 * f5) + (f6 * f6 + f7 * f7); }
    ss += __shfl_xor(ss, 32);
    const float rq = 0.125f / sqrtf(ss * (1.0f / 64.0f) + EPS);
    bf16x8 qf[4];
#pragma unroll
    for (int s = 0; s < 4; ++s) { const f32x4 g0 = *(const GAS f32x4*)(qg + 16 * s + 8 * hh), g1 = *(const GAS f32x4*)(qg + 16 * s + 8 * hh + 4);
        v4u w; w.x = pk2(bf_lo(qraw[s].x) * rq * g0.x, bf_hi(qraw[s].x) * rq * g0.y); w.y = pk2(bf_lo(qraw[s].y) * rq * g0.z, bf_hi(qraw[s].y) * rq * g0.w);
        w.z = pk2(bf_lo(qraw[s].z) * rq * g1.x, bf_hi(qraw[s].z) * rq * g1.y); w.w = pk2(bf_lo(qraw[s].w) * rq * g1.z, bf_hi(qraw[s].w) * rq * g1.w);
        qf[s] = __builtin_bit_cast(bf16x8, w); }
    f32x16 sacc[6];
#pragma unroll
    for (int kt = 0; kt < 6; ++kt) {
#pragma unroll
        for (int r = 0; r < 16; ++r) sacc[kt][r] = 0.f;
#pragma unroll
        for (int s = 0; s < 4; ++s) { const bf16x8 a = *(const LAS bf16x8*)(Ks + (32 * kt + (lane & 31)) * 72 + 16 * s + 8 * hh); sacc[kt] = MFMA32(a, qf[s], sacc[kt]); }
    }
    const LAS float* btg = bt + g * 256 + 63 - i;
    float mx = -3.0e38f;
#pragma unroll
    for (int kt = 0; kt < 6; ++kt) { const bool masked = (c - 2 + (kt >> 1)) < 0;
#pragma unroll
        for (int r = 0; r < 16; ++r) { const int j = 32 * kt + (r & 3) + 8 * (r >> 2) + 4 * hh; float v = sacc[kt][r] + btg[j]; v = masked ? -1.0e30f : v; sacc[kt][r] = v; mx = fmaxf(mx, v); } }
    mx = fmaxf(mx, __shfl_xor(mx, 32));
    const float sink = sinks[habs], m = fmaxf(mx, sink);
    float sum = 0.f;
#pragma unroll
    for (int kt = 0; kt < 6; ++kt)
#pragma unroll
        for (int r = 0; r < 16; ++r) { const float p = __expf(sacc[kt][r] - m); sacc[kt][r] = p; sum += p; }
    sum += __shfl_xor(sum, 32);
    const float inv = 1.0f / (sum + __expf(sink - m));
    f32x16 oacc[2];
#pragma unroll
    for (int dt = 0; dt < 2; ++dt)
#pragma unroll
        for (int r = 0; r < 16; ++r) oacc[dt][r] = 0.f;
#pragma unroll
    for (int kt = 0; kt < 6; ++kt)
#pragma unroll
        for (int s2 = 0; s2 < 2; ++s2) {
            v4u w; w.x = pk2(sacc[kt][8 * s2 + 0], sacc[kt][8 * s2 + 1]); w.y = pk2(sacc[kt][8 * s2 + 2], sacc[kt][8 * s2 + 3]); w.z = pk2(sacc[kt][8 * s2 + 4], sacc[kt][8 * s2 + 5]); w.w = pk2(sacc[kt][8 * s2 + 6], sacc[kt][8 * s2 + 7]);
            const bf16x8 pb = __builtin_bit_cast(bf16x8, w);
#pragma unroll
            for (int dt = 0; dt < 2; ++dt) { const bf16x8 a = *(const LAS bf16x8*)(Vt + (32 * dt + (lane & 31)) * 200 + 32 * kt + 16 * s2 + 8 * hh); oacc[dt] = MFMA32(a, pb, oacc[dt]); }
        }
    bf16* op = AB + qrow * D + habs * 64;
#pragma unroll
    for (int dt = 0; dt < 2; ++dt)
#pragma unroll
        for (int q4 = 0; q4 < 4; ++q4) { const int d = 32 * dt + 8 * q4 + 4 * hh;
            const unsigned long long o = (unsigned long long)pk2(oacc[dt][4 * q4 + 0] * inv, oacc[dt][4 * q4 + 1] * inv) | ((unsigned long long)pk2(oacc[dt][4 * q4 + 2] * inv, oacc[dt][4 * q4 + 3] * inv) << 32);
            *(GAS unsigned long long*)(op + d) = o; }
    __syncthreads();
}

template <int W> __device__ __forceinline__ void pool_walk(const bf16* zc, bf16* oc, float s0, float s1, int pos0) {
    unsigned ring[16];
    float a0 = 0.f, a1 = 0.f;
#pragma unroll
    for (int q = 0; q < 16; ++q) ring[q] = 0u;
#pragma unroll
    for (int q = 1; q < W; ++q) { if (pos0 - q >= 0) { const unsigned u = *(const GAS unsigned*)(zc - (size_t)q * DIN); ring[(16 - q) & 15] = u; a0 += bf_lo(u); a1 += bf_hi(u); } }
    for (int rb = 0; rb < 64; rb += 16) {
#pragma unroll
        for (int i = 0; i < 16; ++i) {
            const unsigned u = *(const GAS unsigned*)(zc + (size_t)(rb + i) * DIN);
            const float c0 = bf_lo(u), c1 = bf_hi(u);
            a0 += c0; a1 += c1;
            const int pos = pos0 + rb + i; const float ic = 1.0f / (float)(pos + 1 < W ? pos + 1 : W);
            *(GAS unsigned*)(oc + (size_t)(rb + i) * D) = pk2((a0 * ic - c0) * s0, (a1 * ic - c1) * s1);
            const unsigned old = ring[(i + 17 - W) & 15];
            a0 -= bf_lo(old); a1 -= bf_hi(old);
            ring[i] = u;
        }
    }
}
__device__ __forceinline__ void pool_rows(const bf16* Y, bf16* AB, const float* pscale, int unit, int tid) {
    const int cp = tid & 255, seg = tid >> 8, g = cp >> 6;
    const int r0 = unit * 128 + seg * 64, pos0 = r0 & (SEQ - 1);
    const bf16* zc = Y + (size_t)r0 * DIN + 768 + 2 * cp; bf16* oc = AB + (size_t)r0 * D + 512 + 2 * cp;
    const float s0 = pscale[2 * cp], s1 = pscale[2 * cp + 1];
    if (g == 0) pool_walk<2>(zc, oc, s0, s1, pos0); else if (g == 1) pool_walk<4>(zc, oc, s0, s1, pos0); else if (g == 2) pool_walk<8>(zc, oc, s0, s1, pos0); else pool_walk<16>(zc, oc, s0, s1, pos0);
}

__device__ __forceinline__ int f2key(float f) { return __builtin_bit_cast(int, f); }
__device__ __forceinline__ float key2f(int k) { return __builtin_bit_cast(float, k); }
#define CE_DESC(a, b) do { const int _x = (a), _y = (b); (a) = _x > _y ? _x : _y; (b) = _x > _y ? _y : _x; } while (0)
__device__ __forceinline__ void sort16_desc(int (&a)[16]) {
#pragma unroll
    for (int k = 2; k <= 16; k <<= 1)
#pragma unroll
        for (int j = k >> 1; j > 0; j >>= 1)
#pragma unroll
            for (int i = 0; i < 16; ++i) { const int l = i ^ j; if (l > i) { if ((i & k) == 0) CE_DESC(a[i], a[l]); else CE_DESC(a[l], a[i]); } }
}
__device__ __forceinline__ void merge_top16(int (&a)[16], const int (&b)[16]) {
#pragma unroll
    for (int i = 0; i < 16; ++i) a[i] = a[i] > b[15 - i] ? a[i] : b[15 - i];
#pragma unroll
    for (int j = 8; j > 0; j >>= 1)
#pragma unroll
        for (int i = 0; i < 16; ++i) { const int l = i ^ j; if (l > i) CE_DESC(a[i], a[l]); }
}
__device__ __forceinline__ void top16_of_64(int (&g0)[16], int (&g1)[16], int (&g2)[16], int (&g3)[16]) {
    sort16_desc(g0); sort16_desc(g1); sort16_desc(g2); sort16_desc(g3);
    merge_top16(g0, g1); merge_top16(g2, g3); merge_top16(g0, g2);
}
__device__ __forceinline__ void topk_unit(LAS unsigned char* lds, const bf16* QP, const bf16* SK, unsigned short* EXPERTS, float* BEST, int unit, int tid, int wave, int lane) {
    const int h = unit & 7, tt = unit >> 3, hh = lane >> 5;
    const int tok = tt * 256 + wave * 32 + (lane & 31);
    LAS int* mine = (LAS int*)lds + tid * 33;
    int top[2][16];
#pragma unroll
    for (int p = 0; p < 2; ++p) {
        const bf16* qp = QP + (size_t)tok * DQ + h * 256 + p * 128 + 8 * hh;
        const bf16* kp = SK + (size_t)(h * 2 + p) * 16384 + (size_t)(lane & 31) * 128 + 8 * hh;
        f32x16 acc[4];
#pragma unroll
        for (int nt = 0; nt < 4; ++nt)
#pragma unroll
            for (int r = 0; r < 16; ++r) acc[nt][r] = 8.0f;
#pragma unroll
        for (int s = 0; s < 8; ++s) { const bf16x8 bq = __builtin_bit_cast(bf16x8, *(const GAS v4u*)(qp + 16 * s));
#pragma unroll
            for (int nt = 0; nt < 4; ++nt) { const bf16x8 a = __builtin_bit_cast(bf16x8, *(const GAS v4u*)(kp + (size_t)nt * 32 * 128 + 16 * s)); acc[nt] = MFMA32(a, bq, acc[nt]); } }
        int k0[16], k1[16], k2[16], k3[16];
#pragma unroll
        for (int r = 0; r < 16; ++r) { const int n = (r & 3) + 8 * (r >> 2) + 4 * hh;
            k0[r] = (f2key(acc[0][r]) & ~127) | n; k1[r] = (f2key(acc[1][r]) & ~127) | (32 + n); k2[r] = (f2key(acc[2][r]) & ~127) | (64 + n); k3[r] = (f2key(acc[3][r]) & ~127) | (96 + n); }
        top16_of_64(k0, k1, k2, k3);
#pragma unroll
        for (int r = 0; r < 16; ++r) k1[r] = __shfl_xor(k0[r], 32);
        merge_top16(k0, k1);
#pragma unroll
        for (int r = 0; r < 16; ++r) top[p][r] = k0[r];
    }
    int c0[16], c1[16], c2[16], c3[16];
    {
        float v1[16], v2[16];
#pragma unroll
        for (int r = 0; r < 16; ++r) { v1[r] = key2f(top[0][r] & ~127); v2[r] = key2f(top[1][r] & ~127); mine[r] = top[0][r]; mine[16 + r] = top[1][r]; }
        int cnt = 0;
#pragma unroll
        for (int i = 0; i < 16; ++i)
#pragma unroll
            for (int j = 0; j < 16; ++j) if ((i + 1) * (j + 1) <= 16) { const int key = (f2key(v1[i] + v2[j]) & ~255) | (i << 4) | j;
                if (cnt < 16) c0[cnt] = key; else if (cnt < 32) c1[cnt - 16] = key; else if (cnt < 48) c2[cnt - 32] = key; else c3[cnt - 48] = key; ++cnt; }
#pragma unroll
        for (int r = 0; r < 16; ++r) if (48 + r >= cnt) c3[r] = (int)0x80000000;
    }
    top16_of_64(c0, c1, c2, c3);
    LDS_WAIT();
    if (hh == 0) {
        int ev[16]; float bv[16];
#pragma unroll
        for (int r = 0; r < 16; ++r) { const int id = c0[r] & 255; const int ka = mine[id >> 4], kb = mine[16 + (id & 15)];
            ev[r] = (ka & 127) * 128 + (kb & 127); bv[r] = (key2f(ka & ~127) - 8.0f) + (key2f(kb & ~127) - 8.0f); }
        unsigned short* ep = EXPERTS + (size_t)tok * 128 + h * 16; float* bp = BEST + (size_t)tok * 128 + h * 16;
#pragma unroll
        for (int r = 0; r < 16; r += 8) *(GAS v4u*)(ep + r) = (v4u){(unsigned)ev[r] | ((unsigned)ev[r + 1] << 16), (unsigned)ev[r + 2] | ((unsigned)ev[r + 3] << 16), (unsigned)ev[r + 4] | ((unsigned)ev[r + 5] << 16), (unsigned)ev[r + 6] | ((unsigned)ev[r + 7] << 16)};
#pragma unroll
        for (int r = 0; r < 16; r += 4) *(GAS f32x4*)(bp + r) = (f32x4){bv[r], bv[r + 1], bv[r + 2], bv[r + 3]};
    }
    LDS_WAIT();
}

__device__ __forceinline__ float gelu_erf(float x) { return 0.5f * x * (1.0f + erff(x * 0.70710678118654752f)); }
#define PEER_BL(rs, e_, c_) __builtin_amdgcn_raw_buffer_load_b128(rs, (int)(((e_) << 7) + (c_)), 0, 0)
#define PEER_ROWS(r, rs, c_, q) do { const v4u _ev = *(const LAS v4u*)(evp + 16 * (q)); \
        r[0] = PEER_BL(rs, _ev.x & 0xffffu, c_); r[1] = PEER_BL(rs, _ev.x >> 16, c_); r[2] = PEER_BL(rs, _ev.y & 0xffffu, c_); r[3] = PEER_BL(rs, _ev.y >> 16, c_); \
        r[4] = PEER_BL(rs, _ev.z & 0xffffu, c_); r[5] = PEER_BL(rs, _ev.z >> 16, c_); r[6] = PEER_BL(rs, _ev.w & 0xffffu, c_); r[7] = PEER_BL(rs, _ev.w >> 16, c_); } while (0)
__device__ __forceinline__ void peer_u_phase(LAS unsigned char* lds, const bf16* X1B, const unsigned char* U8, const unsigned short* EXP16, float* PD, int j, int w, int nw, int wave, int lane) {
    const int grp = lane >> 3, sub = lane & 7;
    LAS unsigned char* wl = lds + wave * 8192;
    const LAS unsigned char* evp = wl + grp * 256;
    const int stride = nw * NWAVES * 8;
    int tb = (w * NWAVES + wave) * 8;
    v4u pe0 = {0u, 0u, 0u, 0u}, pe1 = {0u, 0u, 0u, 0u};
    v4u px0 = {0u, 0u, 0u, 0u}, px1 = {0u, 0u, 0u, 0u};
    if (tb < T) { const GAS v4u* e = (const GAS v4u*)(EXP16 + (size_t)tb * 128) + lane; pe0 = e[0]; pe1 = e[64];
        const GAS v4u* xp = (const GAS v4u*)(X1B + (size_t)(tb + grp) * D + 128 * j + 16 * sub); px0 = xp[0]; px1 = xp[1]; }
    const __amdgpu_buffer_rsrc_t urs = __builtin_amdgcn_make_buffer_rsrc((void*)U8, (short)0, NEXP * D, 0x00020000); const unsigned uc = (unsigned)j * (NEXP * 128u) + 16u * sub;
    for (; tb < T; tb += stride) {
        *(LAS v4u*)(wl + 16 * lane) = pe0; *(LAS v4u*)(wl + 1024 + 16 * lane) = pe1;
        const v4u xa = px0, xc = px1;
        if (tb + stride < T) { const GAS v4u* e = (const GAS v4u*)(EXP16 + (size_t)(tb + stride) * 128) + lane; pe0 = e[0]; pe1 = e[64];
            const GAS v4u* xp = (const GAS v4u*)(X1B + (size_t)(tb + stride + grp) * D + 128 * j + 16 * sub); px0 = xp[0]; px1 = xp[1]; }
        const int t = tb + grp;
        const f32x4 x0 = {bf_lo(xa.x), bf_hi(xa.x), bf_lo(xa.y), bf_hi(xa.y)}, x1 = {bf_lo(xa.z), bf_hi(xa.z), bf_lo(xa.w), bf_hi(xa.w)};
        const f32x4 x2 = {bf_lo(xc.x), bf_hi(xc.x), bf_lo(xc.y), bf_hi(xc.y)}, x3 = {bf_lo(xc.z), bf_hi(xc.z), bf_lo(xc.w), bf_hi(xc.w)};
        float amax = fmaxf(fmaxf(fmaxf(fabsf(x0.x), fabsf(x0.y)), fmaxf(fabsf(x0.z), fabsf(x0.w))), fmaxf(fmaxf(fabsf(x1.x), fabsf(x1.y)), fmaxf(fabsf(x1.z), fabsf(x1.w))));
        amax = fmaxf(amax, fmaxf(fmaxf(fmaxf(fabsf(x2.x), fabsf(x2.y)), fmaxf(fabsf(x2.z), fabsf(x2.w))), fmaxf(fmaxf(fabsf(x3.x), fabsf(x3.y)), fmaxf(fabsf(x3.z), fabsf(x3.w)))));
        amax = fmaxf(amax, __shfl_xor(amax, 1)); amax = fmaxf(amax, __shfl_xor(amax, 2)); amax = fmaxf(amax, __shfl_xor(amax, 4));
        const float inv = amax > 0.f ? 127.0f / amax : 0.f, sx = amax * (1.0f / 127.0f);
        const unsigned xq0 = pack_i8x4(x0.x * inv, x0.y * inv, x0.z * inv, x0.w * inv), xq1 = pack_i8x4(x1.x * inv, x1.y * inv, x1.z * inv, x1.w * inv);
        const unsigned xq2 = pack_i8x4(x2.x * inv, x2.y * inv, x2.z * inv, x2.w * inv), xq3 = pack_i8x4(x3.x * inv, x3.y * inv, x3.z * inv, x3.w * inv);
        float* pd = PD + ((size_t)j * T + t) * 128 + sub;
        LDS_WAIT();
        v4u ra[8], rb[8], rc[8];
        PEER_ROWS(ra, urs, uc, 0); PEER_ROWS(rb, urs, uc, 1);
#define PEER_UDOT(r, q) do { int p[8]; _Pragma("unroll") for (int i = 0; i < 8; ++i) { int a = __builtin_amdgcn_sdot4((int)r[i].x, (int)xq0, 0, false); a = __builtin_amdgcn_sdot4((int)r[i].y, (int)xq1, a, false); \
                a = __builtin_amdgcn_sdot4((int)r[i].z, (int)xq2, a, false); p[i] = __builtin_amdgcn_sdot4((int)r[i].w, (int)xq3, a, false); } \
            _Pragma("unroll") for (int o = 4; o > 0; o >>= 1) { const bool up = (sub & o) != 0; \
                _Pragma("unroll") for (int i = 0; i < o; ++i) { const int keep = up ? p[i + o] : p[i], send = up ? p[i] : p[i + o]; p[i] = keep + __shfl_xor(send, o); } } \
            pd[8 * (q)] = (float)p[0] * sx; } while (0)
        for (int q = 0; q < 15; q += 3) {
            PEER_ROWS(rc, urs, uc, q + 2); PEER_UDOT(ra, q);
            PEER_ROWS(ra, urs, uc, q + 3); PEER_UDOT(rb, q + 1);
            if (q + 4 < 16) PEER_ROWS(rb, urs, uc, q + 4);
            PEER_UDOT(rc, q + 2);
        }
        PEER_UDOT(ra, 15);
    }
}
__device__ __forceinline__ void peer_combine4(const float* PD, const unsigned short* EXP16, const float* BEST, const float* SS2, const float* su, const float* sv, unsigned char* CC8, float* SCC, int t0, int lane) {
    typedef float f32x2v __attribute__((ext_vector_type(2)));
    f32x4 ssv[4][4]; unsigned ev[4]; f32x2v bv[4]; f32x2v pdv[4][8];
#pragma unroll
    for (int i = 0; i < 4; ++i) { const int t = t0 + i;
        const GAS f32x4* sp = (const GAS f32x4*)(SS2 + (size_t)t * 16);
#pragma unroll
        for (int q = 0; q < 4; ++q) ssv[i][q] = sp[q];
        ev[i] = ((const GAS unsigned*)(EXP16 + (size_t)t * 128))[lane];
        bv[i] = ((const GAS f32x2v*)(BEST + (size_t)t * 128))[lane];
#pragma unroll
        for (int j = 0; j < 8; ++j) pdv[i][j] = ((const GAS f32x2v*)(PD + ((size_t)j * T + t) * 128))[lane]; }
    float suv[4][2], svv[4][2];
#pragma unroll
    for (int i = 0; i < 4; ++i) { const unsigned e0 = ev[i] & 0xffffu, e1 = ev[i] >> 16; suv[i][0] = su[e0]; suv[i][1] = su[e1]; svv[i][0] = sv[e0]; svv[i][1] = sv[e1]; }
#pragma unroll
    for (int i = 0; i < 4; ++i) { const int t = t0 + i;
        float ssq = 0.f;
#pragma unroll
        for (int q = 0; q < 4; ++q) ssq += (ssv[i][q].x + ssv[i][q].y) + (ssv[i][q].z + ssv[i][q].w);
        const float rstd2 = 1.0f / sqrtf(ssq * (1.0f / D) + EPS);
        const float s0 = bv[i].x * rstd2, s1 = bv[i].y * rstd2;
        float mx = fmaxf(s0, s1);
#pragma unroll
        for (int o = 1; o < 8; o <<= 1) mx = fmaxf(mx, __shfl_xor(mx, o));
        const float e0 = __expf(s0 - mx), e1 = __expf(s1 - mx); float sm = e0 + e1;
#pragma unroll
        for (int o = 1; o < 8; o <<= 1) sm += __shfl_xor(sm, o);
        float d0 = 0.f, d1 = 0.f;
#pragma unroll
        for (int j = 0; j < 8; ++j) { d0 += pdv[i][j].x; d1 += pdv[i][j].y; }
        const float inv_sm = 1.0f / sm;
        const float c0 = e0 * inv_sm * gelu_erf(d0 * rstd2 * suv[i][0]) * svv[i][0], c1 = e1 * inv_sm * gelu_erf(d1 * rstd2 * suv[i][1]) * svv[i][1];
        float amax = fmaxf(fabsf(c0), fabsf(c1));
#pragma unroll
        for (int o = 1; o < 64; o <<= 1) amax = fmaxf(amax, __shfl_xor(amax, o));
        const float inv = amax > 0.f ? 127.0f / amax : 0.f;
        ((GAS unsigned short*)(CC8 + (size_t)t * 128))[lane] = (unsigned short)((__float2int_rn(c0 * inv) & 0xff) | ((__float2int_rn(c1 * inv) & 0xff) << 8));
        if (lane == 0) SCC[t] = amax * (1.0f / 127.0f); }
}
__device__ __forceinline__ void peer_v_phase(LAS unsigned char* lds, float* OUT, const float* X, const bf16* DELTA, const unsigned char* V8, const unsigned short* EXP16, const unsigned char* CC8, const float* SCC, int j, int w, int nw, int wave, int lane) {
    const int grp = lane >> 3, sub = lane & 7;
    LAS unsigned char* wl = lds + wave * 8192;
    const LAS unsigned char* evp = wl + grp * 256;
    const LAS unsigned char* ccp = wl + 2048 + grp * 128;
    const int stride = nw * NWAVES * 8;
    int tb = (w * NWAVES + wave) * 8;
    v4u pe0 = {0u, 0u, 0u, 0u}, pe1 = {0u, 0u, 0u, 0u}, pc0 = {0u, 0u, 0u, 0u};
    if (tb < T) { const GAS v4u* e = (const GAS v4u*)(EXP16 + (size_t)tb * 128) + lane; pe0 = e[0]; pe1 = e[64]; pc0 = ((const GAS v4u*)(CC8 + (size_t)tb * 128))[lane]; }
    const __amdgpu_buffer_rsrc_t vrs = __builtin_amdgcn_make_buffer_rsrc((void*)V8, (short)0, NEXP * D, 0x00020000); const unsigned vc = (unsigned)j * (NEXP * 128u) + 16u * sub;
    for (; tb < T; tb += stride) {
        *(LAS v4u*)(wl + 16 * lane) = pe0; *(LAS v4u*)(wl + 1024 + 16 * lane) = pe1; *(LAS v4u*)(wl + 2048 + 16 * lane) = pc0;
        if (tb + stride < T) { const GAS v4u* e = (const GAS v4u*)(EXP16 + (size_t)(tb + stride) * 128) + lane; pe0 = e[0]; pe1 = e[64]; pc0 = ((const GAS v4u*)(CC8 + (size_t)(tb + stride) * 128))[lane]; }
        const int t = tb + grp;
        const float scc = SCC[t];
        const size_t eo = (size_t)t * D + 128 * j + 16 * sub;
        const GAS f32x4* xp = (const GAS f32x4*)(X + eo); const GAS v4u* dp = (const GAS v4u*)(DELTA + eo);
        const f32x4 xv0 = xp[0], xv1 = xp[1], xv2 = xp[2], xv3 = xp[3]; const v4u da = dp[0], db = dp[1];
        int acc[16];
#pragma unroll
        for (int i = 0; i < 16; ++i) acc[i] = 0;
        LDS_WAIT();
        v4u rq[4][4];
#define PEER_LOADQ(r, qn) do { const unsigned long long _e4 = *(const LAS unsigned long long*)(evp + 8 * (qn)); const unsigned _lo = (unsigned)_e4, _hi = (unsigned)(_e4 >> 32); \
            r[0] = PEER_BL(vrs, _lo & 0xffffu, vc); r[1] = PEER_BL(vrs, _lo >> 16, vc); r[2] = PEER_BL(vrs, _hi & 0xffffu, vc); r[3] = PEER_BL(vrs, _hi >> 16, vc); } while (0)
#define PEER_T4(w_, r0, r1, r2, r3, cpk) do { const unsigned tl0 = __builtin_amdgcn_perm(r1, r0, 0x05010400u), th0 = __builtin_amdgcn_perm(r1, r0, 0x07030602u); \
            const unsigned tl1 = __builtin_amdgcn_perm(r3, r2, 0x05010400u), th1 = __builtin_amdgcn_perm(r3, r2, 0x07030602u); \
            acc[4 * (w_) + 0] = __builtin_amdgcn_sdot4((int)__builtin_amdgcn_perm(tl1, tl0, 0x05040100u), (int)(cpk), acc[4 * (w_) + 0], false); \
            acc[4 * (w_) + 1] = __builtin_amdgcn_sdot4((int)__builtin_amdgcn_perm(tl1, tl0, 0x07060302u), (int)(cpk), acc[4 * (w_) + 1], false); \
            acc[4 * (w_) + 2] = __builtin_amdgcn_sdot4((int)__builtin_amdgcn_perm(th1, th0, 0x05040100u), (int)(cpk), acc[4 * (w_) + 2], false); \
            acc[4 * (w_) + 3] = __builtin_amdgcn_sdot4((int)__builtin_amdgcn_perm(th1, th0, 0x07060302u), (int)(cpk), acc[4 * (w_) + 3], false); } while (0)
#define PEER_COMPQ(r, qn) do { const unsigned _c = *(const LAS unsigned*)(ccp + 4 * (qn)); \
            PEER_T4(0, r[0].x, r[1].x, r[2].x, r[3].x, _c); PEER_T4(1, r[0].y, r[1].y, r[2].y, r[3].y, _c); PEER_T4(2, r[0].z, r[1].z, r[2].z, r[3].z, _c); PEER_T4(3, r[0].w, r[1].w, r[2].w, r[3].w, _c); } while (0)
#pragma unroll
        for (int jq = 0; jq < 4; ++jq) PEER_LOADQ(rq[jq], jq);
        for (int it = 0; it < 8; ++it) {
#pragma unroll
            for (int jq = 0; jq < 4; ++jq) { PEER_COMPQ(rq[jq], 4 * it + jq); if (it < 7) PEER_LOADQ(rq[jq], 4 * it + 4 + jq); }
        }
        GAS f32x4* op = (GAS f32x4*)(OUT + eo);
        const f32x4 xv[4] = {xv0, xv1, xv2, xv3};
        const float dl[16] = {bf_lo(da.x), bf_hi(da.x), bf_lo(da.y), bf_hi(da.y), bf_lo(da.z), bf_hi(da.z), bf_lo(da.w), bf_hi(da.w), bf_lo(db.x), bf_hi(db.x), bf_lo(db.y), bf_hi(db.y), bf_lo(db.z), bf_hi(db.z), bf_lo(db.w), bf_hi(db.w)};
#pragma unroll
        for (int q = 0; q < 4; ++q) { f32x4 v = xv[q]; v.x += dl[4 * q + 0] + scc * (float)acc[4 * q + 0]; v.y += dl[4 * q + 1] + scc * (float)acc[4 * q + 1]; v.z += dl[4 * q + 2] + scc * (float)acc[4 * q + 2]; v.w += dl[4 * q + 3] + scc * (float)acc[4 * q + 3]; op[q] = v; }
    }
}
struct Args { const float* in[15]; float* out; unsigned char* ws; int ph_lo, ph_hi, li, pad; };
__global__ void __launch_bounds__(NWAVES * 64, 2) fwd_kernel(Args args) {
    extern __shared__ __attribute__((aligned(16))) unsigned char lds_raw[];
    LAS unsigned char* lds = (LAS unsigned char*)lds_raw;
    volatile LAS unsigned* MISC = (volatile LAS unsigned*)(lds + MISC_OFF);
    const int tid = threadIdx.x, lane = tid & 63, wave = __builtin_amdgcn_readfirstlane(tid >> 6);
    const int G = gridDim.x, bx = blockIdx.x;
    unsigned char* ws = args.ws;
    gu32* ctl = (gu32*)(ws + WS_CTL);
    for (int u = tid; u < (LDS_BYTES - LDSCTL_OFF) / 4; u += NWAVES * 64) ((LAS unsigned*)(lds + LDSCTL_OFF))[u] = 0u;
    __syncthreads();
    XcdBarrier bar; bar.bar = (unsigned*)(ctl + CW_BAR); bar.x = 0; bar.st = nullptr;
    if (N_LAUNCHES != PER_PHASE) bar = xcd_barrier_post((unsigned*)(ctl + CW_BAR) + args.li * XCD_BAR_WORDS, MISC + 8);
#define GRID_BAR() do { if (N_LAUNCHES != PER_PHASE) xcd_barrier(bar); } while (0)
    const int lo = args.ph_lo, hi = args.ph_hi;
#define IN(k) (lo <= (k) && (k) < hi)
#define BOTH(k) (IN(k) && IN((k) + 1))
#ifndef MK_REPEAT
#define MK_REPEAT -1
#endif
#define REP(k) for (int _r = 0; _r < ((MK_REPEAT == (k)) ? 2 : 1); ++_r)

    const float* x = args.in[0]; float* out = args.out;
    bf16* XB = (bf16*)(ws + WS_XB); bf16* WinT = (bf16*)(ws + WS_WIN); bf16* WoutT = (bf16*)(ws + WS_WOUT); bf16* WqT = (bf16*)(ws + WS_WQ);
    bf16* SK = (bf16*)(ws + WS_SK); bf16* PoolT = (bf16*)(ws + WS_POOLT); unsigned char* U8 = ws + WS_U8; unsigned char* V8 = ws + WS_V8; float* SU = (float*)(ws + WS_SU); float* SV = (float*)(ws + WS_SV);
    bf16* Y = (bf16*)(ws + WS_Y); bf16* AB = (bf16*)(ws + WS_AB); bf16* X1B = (bf16*)(ws + WS_X1B); bf16* QP = (bf16*)(ws + WS_QP);
    float* rstd1 = (float*)(ws + WS_RSTD1); float* SS2 = (float*)(ws + WS_SS2); unsigned short* EXPERTS = (unsigned short*)(ws + WS_EXP); float* BEST = (float*)(ws + WS_BEST);
    float* PD = (float*)(ws + WS_PD); bf16* DELTA = (bf16*)(ws + WS_DELTA); unsigned char* CC8 = ws + WS_CC; float* SCC = (float*)(ws + WS_SCC);
    const int gw = bx * NWAVES + wave, NGW = G * NWAVES;

    if (IN(0)) REP(0) {
        P0Args a{x, args.in[1], args.in[2], args.in[7], args.in[9], args.in[10], args.in[11], args.in[12], args.in[13], args.in[14], XB, WinT, WoutT, WqT, SK, PoolT, U8, V8, SU, SV, rstd1};
        p0_prologue(a, lds, gw, NGW, wave, lane);
        if (BOTH(0)) GRID_BAR();
    }
    if (IN(1)) REP(1) {
        pg8::Gemm g{XB, WinT, T, DIN, D}; pg8::StaticOrder S; S.init(T, DIN, G, bx);
        pg8::EpiScaleBf16 E{Y, DIN, rstd1};
        pg8::gemm_phase<pg8::EpiScaleBf16, pg8::StaticOrder, true, true>(lds + RING_OFF, g, S, E);
        if (BOTH(1)) GRID_BAR();
    }
    if (IN(2)) REP(2) {
        for (int u = bx; u < NB * 128 * 2; u += G) attn_unit(lds, Y, AB, args.in[3], args.in[4], args.in[5], args.in[6], u, tid, wave, lane);
        for (int u = bx; u < T / 128; u += G) pool_rows(Y, AB, args.in[8], u, tid);
        if (BOTH(2)) GRID_BAR();
    }
    if (IN(3)) REP(3) {
        pg8::Gemm g{AB, WoutT, T, D, D}; pg8::StaticOrder S; S.init(T, D, G, bx);
        pg8::EpiResid E{XB, DELTA, X1B, SS2, D};
        pg8::gemm_phase<pg8::EpiResid, pg8::StaticOrder, true, true>(lds + RING_OFF, g, S, E);
        if (BOTH(3)) GRID_BAR();
    }
    if (IN(4)) REP(4) {
        pg8::Gemm g{X1B, WqT, T, DQ, D}; pg8::StaticOrder S; S.init(T, DQ, G, bx);
        pg8::EpiScaleBf16 E{QP, DQ, nullptr};
        pg8::gemm_phase<pg8::EpiScaleBf16, pg8::StaticOrder, true, true>(lds + RING_OFF, g, S, E);
        if (BOTH(4)) GRID_BAR();
    }
    if (IN(5)) REP(5) {
        for (int u = bx; u < (T / 256) * 8; u += G) topk_unit(lds, QP, SK, EXPERTS, BEST, u, tid, wave, lane);
        if (BOTH(5)) GRID_BAR();
    }
    if (IN(6)) REP(6) {
        if ((G & 7) == 0) peer_u_phase(lds, X1B, U8, EXPERTS, PD, bx & 7, bx >> 3, G >> 3, wave, lane);
        else for (int j = 0; j < 8; ++j) peer_u_phase(lds, X1B, U8, EXPERTS, PD, j, bx, G, wave, lane);
        if (BOTH(6)) GRID_BAR();
    }
    if (IN(7)) REP(7) {
        for (int t0 = gw * 4; t0 < T; t0 += NGW * 4) peer_combine4(PD, EXPERTS, BEST, SS2, SU, SV, CC8, SCC, t0, lane);
        if (BOTH(7)) GRID_BAR();
    }
    if (IN(8)) {
        if ((G & 7) == 0) peer_v_phase(lds, out, x, DELTA, V8, EXPERTS, CC8, SCC, bx & 7, bx >> 3, G >> 3, wave, lane);
        else for (int j = 0; j < 8; ++j) peer_v_phase(lds, out, x, DELTA, V8, EXPERTS, CC8, SCC, j, bx, G, wave, lane);
    }
#undef IN
#undef BOTH
}

extern "C" void kernel_launch(void* const* d_in, const int* in_sizes, int n_in, void* d_out, int out_size, void* d_ws, size_t ws_size, hipStream_t stream) {
    static int grid = 0;
    if (grid == 0) {
        if (n_in != 15 || in_sizes[0] != T * D || out_size != T * D || ws_size < WS_END) { fprintf(stderr, "kernel_launch: unexpected shapes (n_in %d, in0 %d, out %d, ws %zu)\n", n_in, n_in > 0 ? in_sizes[0] : -1, out_size, ws_size); grid = -1; return; }
        int dev = 0, cus = 0, per_cu = 0;
        if (hipGetDevice(&dev) != hipSuccess || hipDeviceGetAttribute(&cus, hipDeviceAttributeMultiprocessorCount, dev) != hipSuccess) { grid = -1; return; }
        if (hipFuncSetAttribute((const void*)fwd_kernel, hipFuncAttributeMaxDynamicSharedMemorySize, LDS_BYTES) != hipSuccess) { fprintf(stderr, "kernel_launch: hipFuncSetAttribute failed\n"); grid = -1; return; }
        if (hipOccupancyMaxActiveBlocksPerMultiprocessor(&per_cu, (const void*)fwd_kernel, NWAVES * 64, LDS_BYTES) != hipSuccess || per_cu < 1) { fprintf(stderr, "kernel_launch: occupancy query reports %d blocks per CU\n", per_cu); }
        (void)hipGetLastError();
        grid = cus;
    }
    if (grid < 0) return;
    if (hipMemsetAsync((char*)d_ws + WS_CTL, 0, CTL_ZERO_BYTES, stream) != hipSuccess) return;
    Args a{};
    for (int i = 0; i < 15; ++i) a.in[i] = (const float*)d_in[i];
    a.out = (float*)d_out; a.ws = (unsigned char*)d_ws;
    for (int li = 0; li < N_LAUNCHES; ++li) {
        a.ph_lo = (N_LAUNCHES == PER_PHASE) ? li : 0; a.ph_hi = (N_LAUNCHES == PER_PHASE) ? li + 1 : PER_PHASE; a.li = (N_LAUNCHES == PER_PHASE) ? 0 : li;
        hipLaunchKernelGGL(fwd_kernel, dim3(grid), dim3(NWAVES * 64), LDS_BYTES, stream, a);
        const hipError_t le = hipPeekAtLastError();
        if (le != hipSuccess) { fprintf(stderr, "kernel_launch: launch %d failed: %s\n", li, hipGetErrorName(le)); break; }
    }
}
```

```cpp
#include <hip/hip_runtime.h>
#include <cstdio>
#include <cstdint>
namespace pg8 {
#define PG8_LAS __attribute__((address_space(3)))
typedef unsigned short bf16_t;
typedef short bf16x8 __attribute__((ext_vector_type(8)));
typedef float f32x4 __attribute__((ext_vector_type(4)));
typedef unsigned u32x4 __attribute__((ext_vector_type(4)));
constexpr int BM = 256, BK = 64, HALF = 128, HTB = HALF * BK * 2  , STAGE_BYTES = 8 * HTB, NXCD = 8, WGM = 8;

__host__ __device__ __forceinline__ int lds_byte(int r, int c) { const int st = (r >> 4) * 2 + (c >> 5), rr = r & 15, cc = c & 31, ob = rr * 64 + cc * 2; return st * 1024 + (ob ^ (((ob >> 9) & 1) << 5)); }
__host__ __device__ __forceinline__ void stage_rc(int b, int& R, int& C) { const int st = b / 1024, sb = b % 1024, swz = sb ^ (((sb >> 9) & 1) << 5); R = (st >> 1) * 16 + swz / 64; C = (st & 1) * 32 + (swz % 64) / 2; }
__host__ __device__ __forceinline__ int perm32(int rho) { const int n = rho >> 4, i = rho & 15; return 8 * (i >> 2) + 4 * n + (i & 3); }

struct Unit { int pm, pn; };
struct Gemm { const bf16_t* A; const bf16_t* Bt; int M, N, K; };

struct StaticOrder {
    int nM, nN, nwg, G, c;
    __host__ __device__ void init(int M, int N, int G_, int c_) { nM = M / BM; nN = N / BM; nwg = nM * nN; G = G_; c = c_; }
    __host__ __device__ bool next(int i, Unit& u) const {
        const long L = (long)i * G + c; if (L >= nwg) return false;
        int wgid = (int)L; { const int q = nwg / NXCD, r = nwg % NXCD, xcd = wgid % NXCD, off = wgid / NXCD; wgid = (xcd < r ? xcd * (q + 1) : r * (q + 1) + (xcd - r) * q) + off; }
        const int nig = WGM * nN, gid = wgid / nig, fm = gid * WGM, gsz = (nM - fm) < WGM ? (nM - fm) : WGM;
        u.pm = fm + ((wgid % nig) % gsz); u.pn = (wgid % nig) / gsz; return true;
    }
    __device__ __forceinline__ void a_ready(const Unit&) const {}
    __device__ __forceinline__ void done(const Unit&) const {}
};

__device__ __forceinline__ unsigned cvt_pk_bf16(float lo, float hi) { unsigned r; asm volatile("v_cvt_pk_bf16_f32 %0, %1, %2" : "=v"(r) : "v"(lo), "v"(hi)); return r; }
struct EpiScaleBf16 {
    static constexpr bool PERM = true, AFTER_DRAIN = false, PROBE_TWICE = false;
    bf16_t* O; int ldc; const float* rs;
    __device__ __forceinline__ void operator()(const f32x4 (&acc)[2][2][4][2], const Unit& u, int wr, int wc, int fr, int fq) const {
        const int row0 = u.pm * BM + wr * 64 + fr, col0 = u.pn * BM + wc * 32 + 8 * fq;
#pragma unroll
        for (int ai = 0; ai < 2; ++ai)
#pragma unroll
            for (int m = 0; m < 4; ++m) { const int row = row0 + ai * HALF + m * 16; const float s = rs ? rs[row] : 1.f; bf16_t* rowp = O + (size_t)row * ldc + col0;
#pragma unroll
                for (int bj = 0; bj < 2; ++bj) { const f32x4 v0 = acc[ai][bj][m][0] * s, v1 = acc[ai][bj][m][1] * s;
                    u32x4 w; w.x = cvt_pk_bf16(v0[0], v0[1]); w.y = cvt_pk_bf16(v0[2], v0[3]); w.z = cvt_pk_bf16(v1[0], v1[1]); w.w = cvt_pk_bf16(v1[2], v1[3]);
                    *(u32x4*)(rowp + bj * HALF) = w; } }
    }
};
struct EpiResid {
    static constexpr bool PERM = true, AFTER_DRAIN = false, PROBE_TWICE = false;
    const bf16_t* xbf; bf16_t* xb; float* ss; int ldc;
    __device__ __forceinline__ void operator()(const f32x4 (&acc)[2][2][4][2], const Unit& u, int wr, int wc, int fr, int fq) const {
        const int row0 = u.pm * BM + wr * 64 + fr, col0 = u.pn * BM + wc * 32 + 8 * fq;
#pragma unroll
        for (int ai = 0; ai < 2; ++ai)
#pragma unroll
            for (int m = 0; m < 4; ++m) { const int row = row0 + ai * HALF + m * 16; const size_t off = (size_t)row * ldc + col0; float q = 0.f;
#pragma unroll
                for (int bj = 0; bj < 2; ++bj) { const u32x4 xr = *(const u32x4*)(xbf + off + bj * HALF);
                    const f32x4 a0 = acc[ai][bj][m][0], a1 = acc[ai][bj][m][1];
                    f32x4 v0, v1;
                    v0[0] = a0[0] + __builtin_bit_cast(float, xr.x << 16); v0[1] = a0[1] + __builtin_bit_cast(float, xr.x & 0xffff0000u); v0[2] = a0[2] + __builtin_bit_cast(float, xr.y << 16); v0[3] = a0[3] + __builtin_bit_cast(float, xr.y & 0xffff0000u);
                    v1[0] = a1[0] + __builtin_bit_cast(float, xr.z << 16); v1[1] = a1[1] + __builtin_bit_cast(float, xr.z & 0xffff0000u); v1[2] = a1[2] + __builtin_bit_cast(float, xr.w << 16); v1[3] = a1[3] + __builtin_bit_cast(float, xr.w & 0xffff0000u);
                    u32x4 w; w.x = cvt_pk_bf16(v0[0], v0[1]); w.y = cvt_pk_bf16(v0[2], v0[3]); w.z = cvt_pk_bf16(v1[0], v1[1]); w.w = cvt_pk_bf16(v1[2], v1[3]);
                    *(u32x4*)(xb + off + bj * HALF) = w;
                    q += (v0[0] * v0[0] + v0[1] * v0[1]) + (v0[2] * v0[2] + v0[3] * v0[3]) + (v1[0] * v1[0] + v1[1] * v1[1]) + (v1[2] * v1[2] + v1[3] * v1[3]); }
                q += __shfl_xor(q, 16); q += __shfl_xor(q, 32);
                if (fq == 0) ss[(size_t)row * 16 + u.pn * 4 + wc] = q; }
    }
};
template <class Epi, class Sched, bool ALIGN_EPI = false, bool SP2 = false>
__device__ __forceinline__ void gemm_phase(PG8_LAS unsigned char* lds, const Gemm g, const Sched& S, const Epi& E) {
    const int tid = threadIdx.x, wid = __builtin_amdgcn_readfirstlane(tid >> 6), lane = tid & 63, wr = wid >> 2, wc = wid & 3, fr = lane & 15, fq = lane >> 4;
    const int K = g.K, nt = K / BK;
    unsigned voffA[2], voffB[2];
#pragma unroll
    for (int i = 0; i < 2; ++i) { int R, C; stage_rc(tid * 16 + i * 8192, R, C); const int Rb = Epi::PERM ? ((R & ~31) + perm32(R & 31)) : R;
        voffA[i] = (unsigned)(R * K + C) * 2u; voffB[i] = (unsigned)(Rb * K + C) * 2u; }
    const size_t kstep = (size_t)(BK * 2);
    const size_t hstep = (size_t)HALF * K * 2;
    const size_t tstep = 2 * hstep;
    const unsigned ldsw = (unsigned)wid * 1024u;
    const int aoff = lds_byte(wr * 64 + fr, fq * 8), boff = lds_byte(wc * 32 + fr, fq * 8);
#define PG8_SA(b, h) (((b) * 2 + (h)) * HTB)
#define PG8_SB(b, h) ((4 + (b) * 2 + (h)) * HTB)
#define PG8_STAGE(bufoff, gbase, voff) do { _Pragma("unroll") for (int _i = 0; _i < 2; ++_i) \
        __builtin_amdgcn_global_load_lds((const unsigned*)((const char*)(gbase) + (voff)[_i]), (PG8_LAS unsigned*)(lds + (bufoff) + ldsw + _i * 8192), 16, 0, 0); } while (0)
#define PG8_LDA(dst, b, h) do { _Pragma("unroll") for (int m = 0; m < 4; ++m) _Pragma("unroll") for (int k = 0; k < 2; ++k) dst[m][k] = *(const PG8_LAS bf16x8*)(lds + PG8_SA(b, h) + aoff + m * 2048 + k * 1024); } while (0)
#define PG8_LDB(dst, b, h) do { _Pragma("unroll") for (int n = 0; n < 2; ++n) _Pragma("unroll") for (int k = 0; k < 2; ++k) dst[n][k] = *(const PG8_LAS bf16x8*)(lds + PG8_SB(b, h) + boff + n * 2048 + k * 1024); } while (0)
#define PG8_MMA(ai, bj, At, Bt) do { __builtin_amdgcn_s_setprio(1); _Pragma("unroll") for (int m = 0; m < 4; ++m) _Pragma("unroll") for (int n = 0; n < 2; ++n) _Pragma("unroll") for (int k = 0; k < 2; ++k) \
        acc[ai][bj][m][n] = __builtin_amdgcn_mfma_f32_16x16x32_bf16(Bt[n][k], At[m][k], acc[ai][bj][m][n], 0, 0, 0); __builtin_amdgcn_s_setprio(0); } while (0)
#define PG8_WAIT_V(n) asm volatile("s_waitcnt vmcnt(" #n ")" ::: "memory")
#define PG8_WAIT_L(n) asm volatile("s_waitcnt lgkmcnt(" #n ")" ::: "memory")
#define PG8_BAR __builtin_amdgcn_s_barrier()
#define PG8_SCHED __builtin_amdgcn_sched_barrier(0)
    Unit cur, nxt; int ui = 0;
    if (!S.next(0, cur)) return;
    f32x4 acc[2][2][4][2];
#pragma unroll
    for (int a = 0; a < 2; ++a)
#pragma unroll
        for (int b = 0; b < 2; ++b)
#pragma unroll
            for (int m = 0; m < 4; ++m)
#pragma unroll
                for (int n = 0; n < 2; ++n) acc[a][b][m][n] = (f32x4){0.f, 0.f, 0.f, 0.f};
    bf16x8 At[4][2], B0[2][2], B1[2][2];
    const char* cA = (const char*)g.A + (size_t)cur.pm * tstep; const char* cB = (const char*)g.Bt + (size_t)cur.pn * tstep;
    S.a_ready(cur);
    if constexpr (SP2) {
        PG8_STAGE(PG8_SB(0, 0), cB, voffB); PG8_STAGE(PG8_SB(0, 1), cB + hstep, voffB); PG8_STAGE(PG8_SA(0, 0), cA, voffA); PG8_STAGE(PG8_SA(0, 1), cA + hstep, voffA);
        if (wr == 1) PG8_BAR;
        PG8_WAIT_V(2); PG8_BAR;
        PG8_STAGE(PG8_SB(1, 0), cB + kstep, voffB); PG8_STAGE(PG8_SA(1, 0), cA + kstep, voffA); PG8_STAGE(PG8_SB(1, 1), cB + hstep + kstep, voffB);
        PG8_WAIT_V(6); PG8_BAR;
    } else {
        PG8_STAGE(PG8_SB(0, 0), cB, voffB); PG8_STAGE(PG8_SA(0, 0), cA, voffA); PG8_STAGE(PG8_SB(0, 1), cB + hstep, voffB); PG8_STAGE(PG8_SA(0, 1), cA + hstep, voffA);
        if (wr == 1) PG8_BAR;
        PG8_WAIT_V(4); PG8_BAR;
        PG8_STAGE(PG8_SB(1, 0), cB + kstep, voffB); PG8_STAGE(PG8_SA(1, 0), cA + kstep, voffA); PG8_STAGE(PG8_SB(1, 1), cB + hstep + kstep, voffB);
        PG8_WAIT_V(6); PG8_BAR;
    }
    for (;;) {
        const bool has_next = S.next(ui + 1, nxt);
        const char* nA = has_next ? (const char*)g.A + (size_t)nxt.pm * tstep : cA; const char* nB = has_next ? (const char*)g.Bt + (size_t)nxt.pn * tstep : cB;
        for (int t = 0; t < nt; t += 2) {
            const bool last = (t == nt - 2);
            const char* a1 = cA + (size_t)(t + 1) * kstep;
            const char* a2 = last ? nA : cA + (size_t)(t + 2) * kstep; const char* b2 = last ? nB : cB + (size_t)(t + 2) * kstep;
            const char* a3 = a2 + kstep; const char* b3 = b2 + kstep;
            if (last && has_next) S.a_ready(nxt);
            if constexpr (SP2) {
            PG8_LDB(B0, 0, 0); PG8_LDB(B1, 0, 1); PG8_SCHED; PG8_LDA(At, 0, 0); PG8_STAGE(PG8_SA(1, 1), a1 + hstep, voffA);
            PG8_WAIT_V(8); PG8_WAIT_L(0); PG8_BAR; PG8_MMA(0, 0, At, B0); PG8_MMA(0, 1, At, B1); PG8_BAR; PG8_SCHED;
            PG8_LDA(At, 0, 1); PG8_STAGE(PG8_SB(0, 0), b2, voffB); PG8_STAGE(PG8_SB(0, 1), b2 + hstep, voffB); PG8_STAGE(PG8_SA(0, 0), a2, voffA);
            PG8_WAIT_V(8); PG8_WAIT_L(0); PG8_BAR; PG8_MMA(1, 0, At, B0); PG8_MMA(1, 1, At, B1); PG8_BAR; PG8_SCHED;
            PG8_LDB(B0, 1, 0); PG8_LDB(B1, 1, 1); PG8_SCHED; PG8_LDA(At, 1, 0); PG8_STAGE(PG8_SA(0, 1), a2 + hstep, voffA);
            PG8_WAIT_V(8); PG8_WAIT_L(0); PG8_BAR; PG8_MMA(0, 0, At, B0); PG8_MMA(0, 1, At, B1); PG8_BAR; PG8_SCHED;
            PG8_LDA(At, 1, 1); PG8_STAGE(PG8_SB(1, 0), b3, voffB); PG8_STAGE(PG8_SB(1, 1), b3 + hstep, voffB); PG8_STAGE(PG8_SA(1, 0), a3, voffA);
            PG8_WAIT_V(8); PG8_WAIT_L(0); PG8_BAR; PG8_MMA(1, 0, At, B0); PG8_MMA(1, 1, At, B1); PG8_BAR; PG8_SCHED;
            } else {
            PG8_LDB(B0, 0, 0); PG8_SCHED; PG8_LDA(At, 0, 0); PG8_STAGE(PG8_SA(1, 1), a1 + hstep, voffA);
            PG8_WAIT_L(8); PG8_BAR; PG8_WAIT_L(0); PG8_MMA(0, 0, At, B0); PG8_BAR; PG8_SCHED;
            PG8_LDB(B1, 0, 1); PG8_STAGE(PG8_SB(0, 0), b2, voffB);
            PG8_BAR; PG8_WAIT_L(0); PG8_MMA(0, 1, At, B1); PG8_BAR;
            PG8_LDA(At, 0, 1); PG8_STAGE(PG8_SA(0, 0), a2, voffA);
            PG8_BAR; PG8_WAIT_L(0); PG8_MMA(1, 0, At, B0); PG8_BAR; PG8_SCHED;
            PG8_STAGE(PG8_SB(0, 1), b2 + hstep, voffB);
            PG8_WAIT_V(6); PG8_BAR; PG8_MMA(1, 1, At, B1); PG8_BAR;
            PG8_LDB(B0, 1, 0); PG8_SCHED; PG8_LDA(At, 1, 0); PG8_STAGE(PG8_SA(0, 1), a2 + hstep, voffA);
            PG8_WAIT_L(8); PG8_BAR; PG8_WAIT_L(0); PG8_MMA(0, 0, At, B0); PG8_BAR; PG8_SCHED;
            PG8_LDB(B1, 1, 1); PG8_STAGE(PG8_SB(1, 0), b3, voffB);
            PG8_BAR; PG8_WAIT_L(0); PG8_MMA(0, 1, At, B1); PG8_BAR;
            PG8_LDA(At, 1, 1); PG8_STAGE(PG8_SA(1, 0), a3, voffA);
            PG8_BAR; PG8_WAIT_L(0); PG8_MMA(1, 0, At, B0); PG8_BAR; PG8_SCHED;
            PG8_STAGE(PG8_SB(1, 1), b3 + hstep, voffB);
            PG8_WAIT_V(6); PG8_BAR; PG8_MMA(1, 1, At, B1); PG8_BAR;
            }
        }
        if constexpr (ALIGN_EPI) { if (wr == 0) PG8_BAR; }
        if constexpr (!Epi::AFTER_DRAIN) { E(acc, cur, wr, wc, fr, fq);
#if defined(MK_EXTRA)
            if (Epi::PROBE_TWICE) { asm volatile("" ::: "memory"); E(acc, cur, wr, wc, fr, fq); }
#endif
            S.done(cur); }
        if (!has_next) break;
#pragma unroll
        for (int a = 0; a < 2; ++a)
#pragma unroll
            for (int b = 0; b < 2; ++b)
#pragma unroll
                for (int m = 0; m < 4; ++m)
#pragma unroll
                    for (int n = 0; n < 2; ++n) acc[a][b][m][n] = (f32x4){0.f, 0.f, 0.f, 0.f};
        cur = nxt; cA = nA; cB = nB; ++ui;
        if constexpr (ALIGN_EPI) { if (wr == 1) PG8_BAR; }
    }
    PG8_WAIT_V(0);
    if constexpr (!ALIGN_EPI) { if (wr == 0) PG8_BAR; }
    PG8_BAR;
    if constexpr (Epi::AFTER_DRAIN) { E.fused(acc, cur, wr, wc, fr, fq, lds, wid, lane); S.done(cur); }
#undef PG8_SA
#undef PG8_SB
#undef PG8_STAGE
#undef PG8_LDA
#undef PG8_LDB
#undef PG8_MMA
#undef PG8_WAIT_V
#undef PG8_WAIT_L
#undef PG8_BAR
#undef PG8_SCHED
}
}
constexpr int NWAVES = 8;
#ifndef MK_N_LAUNCHES
#define MK_N_LAUNCHES 1
#endif
constexpr int PER_PHASE = 9;
constexpr int N_LAUNCHES = MK_N_LAUNCHES;

constexpr int NB = 4, SEQ = 8192, T = NB * SEQ, D = 1024, DIN = 1280, NEXP = 16384, DQ = 2048;
constexpr float EPS = 1e-6f;

constexpr size_t MiB = 1u << 20;
constexpr size_t WS_CTL = 0, CTL_ZERO_BYTES = 1 * MiB;
constexpr size_t WS_WIN = 2 * MiB;
constexpr size_t WS_WOUT = 5 * MiB;
constexpr size_t WS_WQ = 7 * MiB;
constexpr size_t WS_SK = 11 * MiB;
constexpr size_t WS_POOLT = 11 * MiB + 512 * 1024;
constexpr size_t WS_RSTD1 = 12 * MiB;
constexpr size_t WS_SS2 = 13 * MiB;
constexpr size_t WS_SU = 15 * MiB;
constexpr size_t WS_SV = 15 * MiB + 256 * 1024;
constexpr size_t WS_EXP = 16 * MiB;
constexpr size_t WS_BEST = 24 * MiB;
constexpr size_t WS_CC = 40 * MiB;
constexpr size_t WS_SCC = 44 * MiB;
constexpr size_t WS_U8 = 56 * MiB;
constexpr size_t WS_V8 = 72 * MiB;
constexpr size_t WS_AB = 88 * MiB;
constexpr size_t WS_X1B = 152 * MiB;
constexpr size_t WS_PD = 216 * MiB;
constexpr size_t WS_DELTA = 360 * MiB;
constexpr size_t WS_XB = 216 * MiB;
constexpr size_t WS_Y = 280 * MiB;
constexpr size_t WS_QP = 216 * MiB;
constexpr size_t WS_END = 424 * MiB;
constexpr int CW_BAR = 4096;

constexpr int RING_OFF = 0, RING_BYTES = 131072;
constexpr int LDSCTL_OFF = RING_BYTES, MISC_OFF = LDSCTL_OFF + 320;
constexpr int LDS_BYTES = 147456;
#define GAS __attribute__((address_space(1)))
#define LAS __attribute__((address_space(3)))
typedef unsigned short bf16;
typedef unsigned v4u __attribute__((ext_vector_type(4)));
typedef float f32x4 __attribute__((ext_vector_type(4)));
typedef short bf16x8 __attribute__((ext_vector_type(8)));
typedef GAS unsigned gu32;
typedef GAS unsigned long long gu64;
#define RLX_AGENT __ATOMIC_RELAXED, __HIP_MEMORY_SCOPE_AGENT
#define LDS_WAIT() asm volatile("s_waitcnt lgkmcnt(0)" ::: "memory")
#define VM_WAIT() asm volatile("s_waitcnt vmcnt(0)" ::: "memory")
__device__ __forceinline__ unsigned long long rt() { return __builtin_amdgcn_s_memrealtime(); }
__device__ __forceinline__ unsigned f2bf(float f) { unsigned u = __builtin_bit_cast(unsigned, f); return (u + 0x7fffu + ((u >> 16) & 1u)) >> 16; }
__device__ __forceinline__ unsigned pk2(float lo, float hi) { return f2bf(lo) | (f2bf(hi) << 16); }
#define XB_TMO      128
#define XB_XCNT(j)  (256  + 64 * (j))
#define XB_XSUB(j)  (1280 + 64 * (j))
#define XB_XGEN(j)  (2304 + 64 * (j))
#define XB_TOP      3328
#define XB_TOPGEN   3392
#define XCD_BAR_WORDS 3456
#define XB_SPIN_CAP (1u << 18)

__device__ __forceinline__ unsigned xb_ld(unsigned* p)              { return __hip_atomic_load(p, __ATOMIC_RELAXED, __HIP_MEMORY_SCOPE_AGENT); }
__device__ __forceinline__ unsigned xb_add(unsigned* p, unsigned v) { return __hip_atomic_fetch_add(p, v, __ATOMIC_RELAXED, __HIP_MEMORY_SCOPE_AGENT); }
__device__ __forceinline__ unsigned xb_xcc_id() { return (unsigned)__builtin_amdgcn_s_getreg((3 << 11) | 20) & 0xFu; }
#define XB_SPIN(cond, bar) do { unsigned _sp = 0; while (cond) { __builtin_amdgcn_s_sleep(1); \
    if ((++_sp & 255u) == 0u) { if (xb_ld(&(bar)[XB_TMO])) break; if (_sp > XB_SPIN_CAP) { atomicAdd(&(bar)[XB_TMO], 1u); break; } } } } while (0)

struct XcdBarrier {
    unsigned* bar; unsigned x;
    volatile LAS unsigned* st;
};

__device__ __forceinline__ XcdBarrier xcd_barrier_post(unsigned* bar, volatile LAS unsigned* st) {
    XcdBarrier b; b.bar = bar; b.x = xb_xcc_id(); b.st = st;
    if (threadIdx.x == 0) (void)xb_add(&bar[XB_XCNT(b.x)], 1u);
    return b;
}
__device__ __forceinline__ void xcd_barrier_complete(unsigned* bar, unsigned x, unsigned& nloc, unsigned& nx) {
    const unsigned G = gridDim.x * gridDim.y * gridDim.z;
    unsigned sum, cnt, mine, sp = 0u;
    for (;;) {
        sum = 0u; cnt = 0u; mine = 0u;
#pragma unroll
        for (unsigned j = 0; j < 16; ++j) { const unsigned c = xb_ld(&bar[XB_XCNT(j)]); sum += c; cnt += (c > 0u) ? 1u : 0u; mine = (j == x) ? c : mine; }
        if (sum == G) break;
        __builtin_amdgcn_s_sleep(1);
        if ((++sp & 255u) == 0u) { if (xb_ld(&bar[XB_TMO])) break; if (sp > XB_SPIN_CAP) { atomicAdd(&bar[XB_TMO], 1u); break; } }
    }
    nloc = mine > 0u ? mine : 1u; nx = cnt > 0u ? cnt : 1u;
}

__device__ __forceinline__ void xcd_barrier(const XcdBarrier& b) {
    asm volatile("s_waitcnt vmcnt(0)" ::: "memory");
    __syncthreads();
    if (threadIdx.x == 0) {
        unsigned* bar = b.bar;
        __builtin_amdgcn_s_waitcnt(0);
        unsigned nloc = b.st[0], nx = b.st[1];
        if (nloc == 0u) { xcd_barrier_complete(bar, b.x, nloc, nx); b.st[0] = nloc; b.st[1] = nx; }
        const unsigned old = xb_add(&bar[XB_XSUB(b.x)], 1u);
        const unsigned gen = old / nloc;
        if (old + 1u == (gen + 1u) * nloc) {
            __builtin_amdgcn_fence(__ATOMIC_RELEASE, "agent");
            asm volatile("s_waitcnt vmcnt(0)" ::: "memory");
            const unsigned og = xb_add(&bar[XB_TOP], 1u);
            const unsigned tg = og / nx;
            if (og + 1u == (tg + 1u) * nx) xb_add(&bar[XB_TOPGEN], 1u);
            else XB_SPIN(xb_ld(&bar[XB_TOPGEN]) == tg, bar);
            __builtin_amdgcn_fence(__ATOMIC_ACQUIRE, "agent");
            xb_add(&bar[XB_XGEN(b.x)], 1u);
            asm volatile("s_waitcnt vmcnt(0)" ::: "memory");
        } else {
            XB_SPIN(xb_ld(&bar[XB_XGEN(b.x)]) == gen, bar);
            __builtin_amdgcn_fence(__ATOMIC_ACQUIRE, "agent");
            asm volatile("s_waitcnt vmcnt(0)" ::: "memory");
        }
    }
    __syncthreads();
}
typedef float f32x16 __attribute__((ext_vector_type(16)));
typedef __bf16 bf16x2_t __attribute__((ext_vector_type(2)));
#define MFMA32(a, b, c) __builtin_amdgcn_mfma_f32_32x32x16_bf16((a), (b), (c), 0, 0, 0)
__device__ __forceinline__ float bf_lo(unsigned u) { return __builtin_bit_cast(float, u << 16); }
__device__ __forceinline__ float bf_hi(unsigned u) { return __builtin_bit_cast(float, u & 0xffff0000u); }
__device__ __forceinline__ float dot2_bf16(unsigned w, unsigned x, float acc) { return __builtin_amdgcn_fdot2_f32_bf16(__builtin_bit_cast(bf16x2_t, w), __builtin_bit_cast(bf16x2_t, x), acc, false); }
__device__ __forceinline__ float wave_sum(float v) {
#pragma unroll
    for (int o = 1; o < 64; o <<= 1) v += __shfl_xor(v, o);
    return v;
}

__device__ __forceinline__ unsigned pack_i8x4(float a, float b, float c, float d) {
    return ((unsigned)__float2int_rn(a) & 0xffu) | (((unsigned)__float2int_rn(b) & 0xffu) << 8) | (((unsigned)__float2int_rn(c) & 0xffu) << 16) | (((unsigned)__float2int_rn(d) & 0xffu) << 24);
}

__device__ __forceinline__ void p0_transpose_item(const float* W, int K, int N, bf16* WT, const float* gk, LAS float* scr, int item, int lane) {
    const int nblk = N / 32, kb = item / nblk, nb = item % nblk, k0 = 64 * kb, n0 = 32 * nb;
    float wv[32];
#pragma unroll
    for (int i = 0; i < 32; ++i) wv[i] = W[(size_t)(k0 + 2 * i + (lane >> 5)) * N + n0 + (lane & 31)];
#pragma unroll
    for (int i = 0; i < 32; ++i) { const int kk = 2 * i + (lane >> 5); float w = wv[i]; if (gk) w *= gk[k0 + kk]; scr[kk * 33 + (lane & 31)] = w; }
    LDS_WAIT(); asm volatile("" ::: "memory");
    const int c = lane & 7;
#pragma unroll
    for (int j = 0; j < 4; ++j) { const int n = (lane >> 3) + 8 * j; const LAS float* s = scr + (8 * c) * 33 + n;
        v4u o; o.x = pk2(s[0 * 33], s[1 * 33]); o.y = pk2(s[2 * 33], s[3 * 33]); o.z = pk2(s[4 * 33], s[5 * 33]); o.w = pk2(s[6 * 33], s[7 * 33]);
        *(GAS v4u*)(WT + (size_t)(n0 + n) * K + k0 + 8 * c) = o; }
    LDS_WAIT(); asm volatile("" ::: "memory");
}
__device__ __forceinline__ float row_to_bf16(const float* src, bf16* dst, const float* g, int lane) {
    const GAS f32x4* xr = (const GAS f32x4*)src + lane; float s = 0.f;
    GAS unsigned long long* o8 = (GAS unsigned long long*)dst + lane;
#pragma unroll
    for (int j = 0; j < 4; ++j) { f32x4 v = xr[64 * j]; s += (v.x * v.x + v.y * v.y) + (v.z * v.z + v.w * v.w);
        if (g) { const f32x4 gv = ((const GAS f32x4*)g)[64 * j + lane]; v = v * gv; }
        o8[64 * j] = (unsigned long long)pk2(v.x, v.y) | ((unsigned long long)pk2(v.z, v.w) << 32); }
    return s;
}
__device__ __forceinline__ void row_to_i8(const float* src, unsigned char* dst, const float* g, float* sc, int m, int lane) {
    const GAS f32x4* xr = (const GAS f32x4*)src + lane; f32x4 v[4]; float amax = 0.f;
#pragma unroll
    for (int j = 0; j < 4; ++j) { v[j] = xr[64 * j]; if (g) { const f32x4 gv = ((const GAS f32x4*)g)[64 * j + lane]; v[j] = v[j] * gv; }
        amax = fmaxf(fmaxf(amax, fmaxf(fabsf(v[j].x), fabsf(v[j].y))), fmaxf(fabsf(v[j].z), fabsf(v[j].w))); }
#pragma unroll
    for (int o = 1; o < 64; o <<= 1) amax = fmaxf(amax, __shfl_xor(amax, o));
    const float inv = amax > 0.f ? 127.0f / amax : 0.f;
    GAS unsigned* o4 = (GAS unsigned*)dst + lane;
#pragma unroll
    for (int j = 0; j < 4; ++j) { const unsigned q0 = (unsigned)__float2int_rn(v[j].x * inv) & 0xffu, q1 = (unsigned)__float2int_rn(v[j].y * inv) & 0xffu, q2 = (unsigned)__float2int_rn(v[j].z * inv) & 0xffu, q3 = (unsigned)__float2int_rn(v[j].w * inv) & 0xffu;
        o4[64 * j] = q0 | (q1 << 8) | (q2 << 16) | (q3 << 24); }
    if (lane == 0) sc[m] = amax * (1.0f / 127.0f);
}
__device__ __forceinline__ void p0_poolfold_item(const float* w_in, const float* pool_w, const float* g1, bf16* WinT, int item, int lane) {
    const int kb = item & 15, nb = (item >> 4) & 15, g = item >> 8, k = 64 * kb + lane, n0 = 8 * nb;
    const GAS f32x4* wr = (const GAS f32x4*)(w_in + (size_t)k * DIN + 768 + 128 * g);
    const float* pw = pool_w + (size_t)g * 16384 + n0;
    float acc[8];
#pragma unroll
    for (int n = 0; n < 8; ++n) acc[n] = 0.f;
#pragma unroll 1
    for (int cb = 0; cb < 32; cb += 16) { f32x4 a[16];
#pragma unroll
        for (int c4 = 0; c4 < 16; ++c4) a[c4] = wr[cb + c4];
#pragma unroll
        for (int c4 = 0; c4 < 16; ++c4)
#pragma unroll
            for (int n = 0; n < 8; ++n) { const float* pp = pw + (4 * (cb + c4)) * 128 + n; acc[n] = fmaf(a[c4].x, pp[0], acc[n]); acc[n] = fmaf(a[c4].y, pp[128], acc[n]); acc[n] = fmaf(a[c4].z, pp[256], acc[n]); acc[n] = fmaf(a[c4].w, pp[384], acc[n]); } }
    const float gk = g1[k];
#pragma unroll
    for (int n = 0; n < 8; ++n) WinT[(size_t)(768 + 128 * g + n0 + n) * D + k] = (bf16)f2bf(acc[n] * gk);
}
struct P0Args { const float *x, *g1, *w_in, *pool_w, *w_out, *g2, *wq, *sk, *u, *v; bf16 *XB, *WinT, *WoutT, *WqT, *SK, *PoolT; unsigned char *U8, *V8; float *su, *sv; float* rstd1; };
__device__ __forceinline__ void p0_prologue(const P0Args& a, LAS unsigned char* lds, int gw, int NGW, int wave, int lane) {
    LAS float* scr = (LAS float*)(lds + RING_OFF + wave * 16384);
    constexpr int I_IN = (D / 64) * (768 / 32), I_OUT = (D / 64) * (D / 32), I_Q = (D / 64) * (DQ / 32), I_P = 4 * 16 * 16;
    constexpr int NITEMS = I_P + I_IN + I_OUT + I_Q;
    for (int it = gw; it < NITEMS; it += NGW) {
        int r = it;
        if (r < I_P) { p0_poolfold_item(a.w_in, a.pool_w, a.g1, a.WinT, r, lane); continue; } r -= I_P;
        if (r < I_IN) { const int kb = r / 24, nb = r % 24; p0_transpose_item(a.w_in, D, DIN, a.WinT, a.g1, scr, kb * 40 + nb, lane); continue; } r -= I_IN;
        if (r < I_OUT) { p0_transpose_item(a.w_out, D, D, a.WoutT, nullptr, scr, r, lane); continue; } r -= I_OUT;
        p0_transpose_item(a.wq, D, DQ, a.WqT, a.g2, scr, r, lane);
    }
    for (int m0 = gw; m0 < T; m0 += 4 * NGW) {
        f32x4 v[4][4];
#pragma unroll
        for (int r = 0; r < 4; ++r) { const int m = m0 + r * NGW < T ? m0 + r * NGW : m0; const GAS f32x4* xr = (const GAS f32x4*)(a.x + (size_t)m * D) + lane;
#pragma unroll
            for (int j = 0; j < 4; ++j) v[r][j] = xr[64 * j]; }
#pragma unroll
        for (int r = 0; r < 4; ++r) { const int m = m0 + r * NGW; if (m < T) {
            float s = 0.f; GAS unsigned long long* o8 = (GAS unsigned long long*)(a.XB + (size_t)m * D) + lane;
#pragma unroll
            for (int j = 0; j < 4; ++j) { const f32x4 w = v[r][j]; s += (w.x * w.x + w.y * w.y) + (w.z * w.z + w.w * w.w); o8[64 * j] = (unsigned long long)pk2(w.x, w.y) | ((unsigned long long)pk2(w.z, w.w) << 32); }
            s = wave_sum(s); if (lane == 0) a.rstd1[m] = 1.0f / sqrtf(s * (1.0f / D) + EPS); } }
    }
    for (int m0 = gw; m0 < 2 * NEXP; m0 += 4 * NGW) {
        f32x4 v[4][4];
#pragma unroll
        for (int r = 0; r < 4; ++r) { const int mm = m0 + r * NGW < 2 * NEXP ? m0 + r * NGW : m0; const bool isv = mm >= NEXP; const int m = isv ? mm - NEXP : mm;
            const GAS f32x4* xr = (const GAS f32x4*)((isv ? a.v : a.u) + (size_t)m * D) + lane;
#pragma unroll
            for (int j = 0; j < 4; ++j) v[r][j] = xr[64 * j]; }
#pragma unroll
        for (int r = 0; r < 4; ++r) { const int mm = m0 + r * NGW; if (mm < 2 * NEXP) { const bool isv = mm >= NEXP; const int m = isv ? mm - NEXP : mm;
            float amax = 0.f;
#pragma unroll
            for (int j = 0; j < 4; ++j) { if (!isv) { const f32x4 gv = ((const GAS f32x4*)a.g2)[64 * j + lane]; v[r][j] = v[r][j] * gv; }
                amax = fmaxf(fmaxf(amax, fmaxf(fabsf(v[r][j].x), fabsf(v[r][j].y))), fmaxf(fabsf(v[r][j].z), fabsf(v[r][j].w))); }
#pragma unroll
            for (int o = 1; o < 64; o <<= 1) amax = fmaxf(amax, __shfl_xor(amax, o));
            const float inv = amax > 0.f ? 127.0f / amax : 0.f;
            unsigned char* tb_ = (isv ? a.V8 : a.U8) + (size_t)m * 128 + ((4 * lane) & 127);
#pragma unroll
            for (int j = 0; j < 4; ++j) *(GAS unsigned*)(tb_ + (size_t)((4 * lane + 256 * j) >> 7) * ((size_t)NEXP * 128)) = pack_i8x4(v[r][j].x * inv, v[r][j].y * inv, v[r][j].z * inv, v[r][j].w * inv);
            if (lane == 0) (isv ? a.sv : a.su)[m] = amax * (1.0f / 127.0f); } }
    }
    for (int m = gw; m < 256; m += NGW) (void)row_to_bf16(a.sk + (size_t)m * D, a.SK + (size_t)m * D, nullptr, lane);
}

__device__ __forceinline__ int t5_bucket(int rel) {
    const int n = rel < 0 ? -rel : rel; const int base = rel > 0 ? 16 : 0;
    const int v = n < 8 ? n : (n < 12 ? 8 : (n < 16 ? 9 : (n < 23 ? 10 : (n < 32 ? 11 : (n < 46 ? 12 : (n < 64 ? 13 : (n < 91 ? 14 : 15)))))));
    return base + v;
}
__device__ __forceinline__ void attn_unit(LAS unsigned char* lds, const bf16* Y, bf16* AB, const float* qg, const float* kg, const float* sinks, const float* relb,
                                          int unit, int tid, int wave, int lane) {
    const int kvh = unit & 1, c = (unit >> 1) & 127, b = unit >> 8;
    LAS bf16* Ks = (LAS bf16*)lds;
    LAS bf16* Vt = (LAS bf16*)(lds + 27648);
    LAS float* bt = (LAS float*)(lds + 53248);
    const int row0 = b * SEQ + (c - 2) * 64;
#pragma unroll
    for (int rep = 0; rep < 3; ++rep) {
        const int it = tid + rep * 512, j = it >> 3, ch = it & 7;
        const bool valid = (c - 2 + (j >> 6)) >= 0;
        v4u kraw = {0u, 0u, 0u, 0u}, vraw = {0u, 0u, 0u, 0u};
        if (valid) { const bf16* rp = Y + (size_t)(row0 + j) * DIN; kraw = *(const GAS v4u*)(rp + 512 + 64 * kvh + 8 * ch); vraw = *(const GAS v4u*)(rp + 640 + 64 * kvh + 8 * ch); }
        float kf[8] = {bf_lo(kraw.x), bf_hi(kraw.x), bf_lo(kraw.y), bf_hi(kraw.y), bf_lo(kraw.z), bf_hi(kraw.z), bf_lo(kraw.w), bf_hi(kraw.w)};
        float ss = 0.f;
#pragma unroll
        for (int e = 0; e < 8; ++e) ss += kf[e] * kf[e];
        ss += __shfl_xor(ss, 1); ss += __shfl_xor(ss, 2); ss += __shfl_xor(ss, 4);
        const float r = 1.0f / sqrtf(ss * (1.0f / 64.0f) + EPS);
        const f32x4 g0 = *(const GAS f32x4*)(kg + 8 * ch), g1 = *(const GAS f32x4*)(kg + 8 * ch + 4);
        v4u ko; ko.x = pk2(kf[0] * r * g0.x, kf[1] * r * g0.y); ko.y = pk2(kf[2] * r * g0.z, kf[3] * r * g0.w); ko.z = pk2(kf[4] * r * g1.x, kf[5] * r * g1.y); ko.w = pk2(kf[6] * r * g1.z, kf[7] * r * g1.w);
        *(LAS v4u*)(Ks + j * 72 + 8 * ch) = ko;
        const int s16 = j >> 4, kk = j & 15, hh = (kk >> 2) & 1, jj = ((kk >> 3) << 2) | (kk & 3), pos = 16 * s16 + 8 * hh + jj;
        LAS bf16* vp = Vt + (8 * ch) * 200 + pos;
        vp[0 * 200] = (bf16)(vraw.x & 0xffffu); vp[1 * 200] = (bf16)(vraw.x >> 16); vp[2 * 200] = (bf16)(vraw.y & 0xffffu); vp[3 * 200] = (bf16)(vraw.y >> 16);
        vp[4 * 200] = (bf16)(vraw.z & 0xffffu); vp[5 * 200] = (bf16)(vraw.z >> 16); vp[6 * 200] = (bf16)(vraw.w & 0xffffu); vp[7 * 200] = (bf16)(vraw.w >> 16);
    }
#pragma unroll
    for (int rep = 0; rep < 2; ++rep) { const int it = tid + rep * 512, g = it >> 8, r = it & 255; bt[it] = relb[t5_bucket(r - 191) * 8 + kvh * 4 + g]; }
    LDS_WAIT(); __syncthreads();

    const int g = wave >> 1, i = 32 * (wave & 1) + (lane & 31), hh = lane >> 5, habs = kvh * 4 + g;
    const size_t qrow = (size_t)b * SEQ + (size_t)c * 64 + i;
    const bf16* qp = Y + qrow * DIN + habs * 64 + 8 * hh;
    v4u qraw[4]; float ss = 0.f;
#pragma unroll
    for (int s = 0; s < 4; ++s) { qraw[s] = *(const GAS v4u*)(qp + 16 * s);
        const float f0 = bf_lo(qraw[s].x), f1 = bf_hi(qraw[s].x), f2 = bf_lo(qraw[s].y), f3 = bf_hi(qraw[s].y), f4 = bf_lo(qraw[s].z), f5 = bf_hi(qraw[s].z), f6 = bf_lo(qraw[s].w), f7 = bf_hi(qraw[s].w);
        ss += (f0 * f0 + f1 * f1) + (f2 * f2 + f3 * f3) + (f4 * f4 + f5 * f5) + (f6 * f6 + f7 * f7); }
    ss += __shfl_xor(ss, 32);
    const float rq = 0.125f / sqrtf(ss * (1.0f / 64.0f) + EPS);
    bf16x8 qf[4];
#pragma unroll
    for (int s = 0; s < 4; ++s) { const f32x4 g0 = *(const GAS f32x4*)(qg + 16 * s + 8 * hh), g1 = *(const GAS f32x4*)(qg + 16 * s + 8 * hh + 4);
        v4u w; w.x = pk2(bf_lo(qraw[s].x) * rq * g0.x, bf_hi(qraw[s].x) * rq * g0.y); w.y = pk2(bf_lo(qraw[s].y) * rq * g0.z, bf_hi(qraw[s].y) * rq * g0.w);
        w.z = pk2(bf_lo(qraw[s].z) * rq * g1.x, bf_hi(qraw[s].z) * rq * g1.y); w.w = pk2(bf_lo(qraw[s].w) * rq * g1.z, bf_hi(qraw[s].w) * rq * g1.w);
        qf[s] = __builtin_bit_cast(bf16x8, w); }
    f32x16 sacc[6];
#pragma unroll
    for (int kt = 0; kt < 6; ++kt) {
#pragma unroll
        for (int r = 0; r < 16; ++r) sacc[kt][r] = 0.f;
#pragma unroll
        for (int s = 0; s < 4; ++s) { const bf16x8 a = *(const LAS bf16x8*)(Ks + (32 * kt + (lane & 31)) * 72 + 16 * s + 8 * hh); sacc[kt] = MFMA32(a, qf[s], sacc[kt]); }
    }
    const LAS float* btg = bt + g * 256 + 63 - i;
    float mx = -3.0e38f;
#pragma unroll
    for (int kt = 0; kt < 6; ++kt) { const bool masked = (c - 2 + (kt >> 1)) < 0;
#pragma unroll
        for (int r = 0; r < 16; ++r) { const int j = 32 * kt + (r & 3) + 8 * (r >> 2) + 4 * hh; float v = sacc[kt][r] + btg[j]; v = masked ? -1.0e30f : v; sacc[kt][r] = v; mx = fmaxf(mx, v); } }
    mx = fmaxf(mx, __shfl_xor(mx, 32));
    const float sink = sinks[habs], m = fmaxf(mx, sink);
    float sum = 0.f;
#pragma unroll
    for (int kt = 0; kt < 6; ++kt)
#pragma unroll
        for (int r = 0; r < 16; ++r) { const float p = __expf(sacc[kt][r] - m); sacc[kt][r] = p; sum += p; }
    sum += __shfl_xor(sum, 32);
    const float inv = 1.0f / (sum + __expf(sink - m));
    f32x16 oacc[2];
#pragma unroll
    for (int dt = 0; dt < 2; ++dt)
#pragma unroll
        for (int r = 0; r < 16; ++r) oacc[dt][r] = 0.f;
#pragma unroll
    for (int kt = 0; kt < 6; ++kt)
#pragma unroll
        for (int s2 = 0; s2 < 2; ++s2) {
            v4u w; w.x = pk2(sacc[kt][8 * s2 + 0], sacc[kt][8 * s2 + 1]); w.y = pk2(sacc[kt][8 * s2 + 2], sacc[kt][8 * s2 + 3]); w.z = pk2(sacc[kt][8 * s2 + 4], sacc[kt][8 * s2 + 5]); w.w = pk2(sacc[kt][8 * s2 + 6], sacc[kt][8 * s2 + 7]);
            const bf16x8 pb = __builtin_bit_cast(bf16x8, w);
#pragma unroll
            for (int dt = 0; dt < 2; ++dt) { const bf16x8 a = *(const LAS bf16x8*)(Vt + (32 * dt + (lane & 31)) * 200 + 32 * kt + 16 * s2 + 8 * hh); oacc[dt] = MFMA32(a, pb, oacc[dt]); }
        }
    bf16* op = AB + qrow * D + habs * 64;
#pragma unroll
    for (int dt = 0; dt < 2; ++dt)
#pragma unroll
        for (int q4 = 0; q4 < 4; ++q4) { const int d = 32 * dt + 8 * q4 + 4 * hh;
            const unsigned long long o = (unsigned long long)pk2(oacc[dt][4 * q4 + 0] * inv, oacc[dt][4 * q4 + 1] * inv) | ((unsigned long long)pk2(oacc[dt][4 * q4 + 2] * inv, oacc[dt][4 * q4 + 3] * inv) << 32);
            *(GAS unsigned long long*)(op + d) = o; }
    __syncthreads();
}

template <int W> __device__ __forceinline__ void pool_walk(const bf16* zc, bf16* oc, float s0, float s1, int pos0) {
    unsigned ring[16];
    float a0 = 0.f, a1 = 0.f;
#pragma unroll
    for (int q = 0; q < 16; ++q) ring[q] = 0u;
#pragma unroll
    for (int q = 1; q < W; ++q) { if (pos0 - q >= 0) { const unsigned u = *(const GAS unsigned*)(zc - (size_t)q * DIN); ring[(16 - q) & 15] = u; a0 += bf_lo(u); a1 += bf_hi(u); } }
    for (int rb = 0; rb < 64; rb += 16) {
#pragma unroll
        for (int i = 0; i < 16; ++i) {
            const unsigned u = *(const GAS unsigned*)(zc + (size_t)(rb + i) * DIN);
            const float c0 = bf_lo(u), c1 = bf_hi(u);
            a0 += c0; a1 += c1;
            const int pos = pos0 + rb + i; const float ic = 1.0f / (float)(pos + 1 < W ? pos + 1 : W);
            *(GAS unsigned*)(oc + (size_t)(rb + i) * D) = pk2((a0 * ic - c0) * s0, (a1 * ic - c1) * s1);
            const unsigned old = ring[(i + 17 - W) & 15];
            a0 -= bf_lo(old); a1 -= bf_hi(old);
            ring[i] = u;
        }
    }
}
__device__ __forceinline__ void pool_rows(const bf16* Y, bf16* AB, const float* pscale, int unit, int tid) {
    const int cp = tid & 255, seg = tid >> 8, g = cp >> 6;
    const int r0 = unit * 128 + seg * 64, pos0 = r0 & (SEQ - 1);
    const bf16* zc = Y + (size_t)r0 * DIN + 768 + 2 * cp; bf16* oc = AB + (size_t)r0 * D + 512 + 2 * cp;
    const float s0 = pscale[2 * cp], s1 = pscale[2 * cp + 1];
    if (g == 0) pool_walk<2>(zc, oc, s0, s1, pos0); else if (g == 1) pool_walk<4>(zc, oc, s0, s1, pos0); else if (g == 2) pool_walk<8>(zc, oc, s0, s1, pos0); else pool_walk<16>(zc, oc, s0, s1, pos0);
}

__device__ __forceinline__ int f2key(float f) { return __builtin_bit_cast(int, f); }
__device__ __forceinline__ float key2f(int k) { return __builtin_bit_cast(float, k); }
#define CE_DESC(a, b) do { const int _x = (a), _y = (b); (a) = _x > _y ? _x : _y; (b) = _x > _y ? _y : _x; } while (0)
__device__ __forceinline__ void sort16_desc(int (&a)[16]) {
#pragma unroll
    for (int k = 2; k <= 16; k <<= 1)
#pragma unroll
        for (int j = k >> 1; j > 0; j >>= 1)
#pragma unroll
            for (int i = 0; i < 16; ++i) { const int l = i ^ j; if (l > i) { if ((i & k) == 0) CE_DESC(a[i], a[l]); else CE_DESC(a[l], a[i]); } }
}
__device__ __forceinline__ void merge_top16(int (&a)[16], const int (&b)[16]) {
#pragma unroll
    for (int i = 0; i < 16; ++i) a[i] = a[i] > b[15 - i] ? a[i] : b[15 - i];
#pragma unroll
    for (int j = 8; j > 0; j >>= 1)
#pragma unroll
        for (int i = 0; i < 16; ++i) { const int l = i ^ j; if (l > i) CE_DESC(a[i], a[l]); }
}
__device__ __forceinline__ void top16_of_64(int (&g0)[16], int (&g1)[16], int (&g2)[16], int (&g3)[16]) {
    sort16_desc(g0); sort16_desc(g1); sort16_desc(g2); sort16_desc(g3);
    merge_top16(g0, g1); merge_top16(g2, g3); merge_top16(g0, g2);
}
__device__ __forceinline__ void topk_unit(LAS unsigned char* lds, const bf16* QP, const bf16* SK, unsigned short* EXPERTS, float* BEST, int unit, int tid, int wave, int lane) {
    const int h = unit & 7, tt = unit >> 3, hh = lane >> 5;
    const int tok = tt * 256 + wave * 32 + (lane & 31);
    LAS int* mine = (LAS int*)lds + tid * 33;
    int top[2][16];
#pragma unroll
    for (int p = 0; p < 2; ++p) {
        const bf16* qp = QP + (size_t)tok * DQ + h * 256 + p * 128 + 8 * hh;
        const bf16* kp = SK + (size_t)(h * 2 + p) * 16384 + (size_t)(lane & 31) * 128 + 8 * hh;
        f32x16 acc[4];
#pragma unroll
        for (int nt = 0; nt < 4; ++nt)
#pragma unroll
            for (int r = 0; r < 16; ++r) acc[nt][r] = 8.0f;
#pragma unroll
        for (int s = 0; s < 8; ++s) { const bf16x8 bq = __builtin_bit_cast(bf16x8, *(const GAS v4u*)(qp + 16 * s));
#pragma unroll
            for (int nt = 0; nt < 4; ++nt) { const bf16x8 a = __builtin_bit_cast(bf16x8, *(const GAS v4u*)(kp + (size_t)nt * 32 * 128 + 16 * s)); acc[nt] = MFMA32(a, bq, acc[nt]); } }
        int k0[16], k1[16], k2[16], k3[16];
#pragma unroll
        for (int r = 0; r < 16; ++r) { const int n = (r & 3) + 8 * (r >> 2) + 4 * hh;
            k0[r] = (f2key(acc[0][r]) & ~127) | n; k1[r] = (f2key(acc[1][r]) & ~127) | (32 + n); k2[r] = (f2key(acc[2][r]) & ~127) | (64 + n); k3[r] = (f2key(acc[3][r]) & ~127) | (96 + n); }
        top16_of_64(k0, k1, k2, k3);
#pragma unroll
        for (int r = 0; r < 16; ++r) k1[r] = __shfl_xor(k0[r], 32);
        merge_top16(k0, k1);
#pragma unroll
        for (int r = 0; r < 16; ++r) top[p][r] = k0[r];
    }
    int c0[16], c1[16], c2[16], c3[16];
    {
        float v1[16], v2[16];
#pragma unroll
        for (int r = 0; r < 16; ++r) { v1[r] = key2f(top[0][r] & ~127); v2[r] = key2f(top[1][r] & ~127); mine[r] = top[0][r]; mine[16 + r] = top[1][r]; }
        int cnt = 0;
#pragma unroll
        for (int i = 0; i < 16; ++i)
#pragma unroll
            for (int j = 0; j < 16; ++j) if ((i + 1) * (j + 1) <= 16) { const int key = (f2key(v1[i] + v2[j]) & ~255) | (i << 4) | j;
                if (cnt < 16) c0[cnt] = key; else if (cnt < 32) c1[cnt - 16] = key; else if (cnt < 48) c2[cnt - 32] = key; else c3[cnt - 48] = key; ++cnt; }
#pragma unroll
        for (int r = 0; r < 16; ++r) if (48 + r >= cnt) c3[r] = (int)0x80000000;
    }
    top16_of_64(c0, c1, c2, c3);
    LDS_WAIT();
    if (hh == 0) {
        int ev[16]; float bv[16];
#pragma unroll
        for (int r = 0; r < 16; ++r) { const int id = c0[r] & 255; const int ka = mine[id >> 4], kb = mine[16 + (id & 15)];
            ev[r] = (ka & 127) * 128 + (kb & 127); bv[r] = (key2f(ka & ~127) - 8.0f) + (key2f(kb & ~127) - 8.0f); }
        unsigned short* ep = EXPERTS + (size_t)tok * 128 + h * 16; float* bp = BEST + (size_t)tok * 128 + h * 16;
#pragma unroll
        for (int r = 0; r < 16; r += 8) *(GAS v4u*)(ep + r) = (v4u){(unsigned)ev[r] | ((unsigned)ev[r + 1] << 16), (unsigned)ev[r + 2] | ((unsigned)ev[r + 3] << 16), (unsigned)ev[r + 4] | ((unsigned)ev[r + 5] << 16), (unsigned)ev[r + 6] | ((unsigned)ev[r + 7] << 16)};
#pragma unroll
        for (int r = 0; r < 16; r += 4) *(GAS f32x4*)(bp + r) = (f32x4){bv[r], bv[r + 1], bv[r + 2], bv[r + 3]};
    }
    LDS_WAIT();
}

__device__ __forceinline__ float gelu_erf(float x) { return 0.5f * x * (1.0f + erff(x * 0.70710678118654752f)); }
#define PEER_BL(rs, e_, c_) __builtin_amdgcn_raw_buffer_load_b128(rs, (int)(((e_) << 7) + (c_)), 0, 0)
#define PEER_ROWS(r, rs, c_, q) do { const v4u _ev = *(const LAS v4u*)(evp + 16 * (q)); \
        r[0] = PEER_BL(rs, _ev.x & 0xffffu, c_); r[1] = PEER_BL(rs, _ev.x >> 16, c_); r[2] = PEER_BL(rs, _ev.y & 0xffffu, c_); r[3] = PEER_BL(rs, _ev.y >> 16, c_); \
        r[4] = PEER_BL(rs, _ev.z & 0xffffu, c_); r[5] = PEER_BL(rs, _ev.z >> 16, c_); r[6] = PEER_BL(rs, _ev.w & 0xffffu, c_); r[7] = PEER_BL(rs, _ev.w >> 16, c_); } while (0)
__device__ __forceinline__ void peer_u_phase(LAS unsigned char* lds, const bf16* X1B, const unsigned char* U8, const unsigned short* EXP16, float* PD, int j, int w, int nw, int wave, int lane) {
    const int grp = lane >> 3, sub = lane & 7;
    LAS unsigned char* wl = lds + wave * 8192;
    const LAS unsigned char* evp = wl + grp * 256;
    const int stride = nw * NWAVES * 8;
    int tb = (w * NWAVES + wave) * 8;
    v4u pe0 = {0u, 0u, 0u, 0u}, pe1 = {0u, 0u, 0u, 0u};
    v4u px0 = {0u, 0u, 0u, 0u}, px1 = {0u, 0u, 0u, 0u};
    if (tb < T) { const GAS v4u* e = (const GAS v4u*)(EXP16 + (size_t)tb * 128) + lane; pe0 = e[0]; pe1 = e[64];
        const GAS v4u* xp = (const GAS v4u*)(X1B + (size_t)(tb + grp) * D + 128 * j + 16 * sub); px0 = xp[0]; px1 = xp[1]; }
    const __amdgpu_buffer_rsrc_t urs = __builtin_amdgcn_make_buffer_rsrc((void*)U8, (short)0, NEXP * D, 0x00020000); const unsigned uc = (unsigned)j * (NEXP * 128u) + 16u * sub;
    for (; tb < T; tb += stride) {
        *(LAS v4u*)(wl + 16 * lane) = pe0; *(LAS v4u*)(wl + 1024 + 16 * lane) = pe1;
        const v4u xa = px0, xc = px1;
        if (tb + stride < T) { const GAS v4u* e = (const GAS v4u*)(EXP16 + (size_t)(tb + stride) * 128) + lane; pe0 = e[0]; pe1 = e[64];
            const GAS v4u* xp = (const GAS v4u*)(X1B + (size_t)(tb + stride + grp) * D + 128 * j + 16 * sub); px0 = xp[0]; px1 = xp[1]; }
        const int t = tb + grp;
        const f32x4 x0 = {bf_lo(xa.x), bf_hi(xa.x), bf_lo(xa.y), bf_hi(xa.y)}, x1 = {bf_lo(xa.z), bf_hi(xa.z), bf_lo(xa.w), bf_hi(xa.w)};
        const f32x4 x2 = {bf_lo(xc.x), bf_hi(xc.x), bf_lo(xc.y), bf_hi(xc.y)}, x3 = {bf_lo(xc.z), bf_hi(xc.z), bf_lo(xc.w), bf_hi(xc.w)};
        float amax = fmaxf(fmaxf(fmaxf(fabsf(x0.x), fabsf(x0.y)), fmaxf(fabsf(x0.z), fabsf(x0.w))), fmaxf(fmaxf(fabsf(x1.x), fabsf(x1.y)), fmaxf(fabsf(x1.z), fabsf(x1.w))));
        amax = fmaxf(amax, fmaxf(fmaxf(fmaxf(fabsf(x2.x), fabsf(x2.y)), fmaxf(fabsf(x2.z), fabsf(x2.w))), fmaxf(fmaxf(fabsf(x3.x), fabsf(x3.y)), fmaxf(fabsf(x3.z), fabsf(x3.w)))));
        amax = fmaxf(amax, __shfl_xor(amax, 1)); amax = fmaxf(amax, __shfl_xor(amax, 2)); amax = fmaxf(amax, __shfl_xor(amax, 4));
        const float inv = amax > 0.f ? 127.0f / amax : 0.f, sx = amax * (1.0f / 127.0f);
        const unsigned xq0 = pack_i8x4(x0.x * inv, x0.y * inv, x0.z * inv, x0.w * inv), xq1 = pack_i8x4(x1.x * inv, x1.y * inv, x1.z * inv, x1.w * inv);
        const unsigned xq2 = pack_i8x4(x2.x * inv, x2.y * inv, x2.z * inv, x2.w * inv), xq3 = pack_i8x4(x3.x * inv, x3.y * inv, x3.z * inv, x3.w * inv);
        float* pd = PD + ((size_t)j * T + t) * 128 + sub;
        LDS_WAIT();
        v4u ra[8], rb[8], rc[8];
        PEER_ROWS(ra, urs, uc, 0); PEER_ROWS(rb, urs, uc, 1);
#define PEER_UDOT(r, q) do { int p[8]; _Pragma("unroll") for (int i = 0; i < 8; ++i) { int a = __builtin_amdgcn_sdot4((int)r[i].x, (int)xq0, 0, false); a = __builtin_amdgcn_sdot4((int)r[i].y, (int)xq1, a, false); \
                a = __builtin_amdgcn_sdot4((int)r[i].z, (int)xq2, a, false); p[i] = __builtin_amdgcn_sdot4((int)r[i].w, (int)xq3, a, false); } \
            _Pragma("unroll") for (int o = 4; o > 0; o >>= 1) { const bool up = (sub & o) != 0; \
                _Pragma("unroll") for (int i = 0; i < o; ++i) { const int keep = up ? p[i + o] : p[i], send = up ? p[i] : p[i + o]; p[i] = keep + __shfl_xor(send, o); } } \
            pd[8 * (q)] = (float)p[0] * sx; } while (0)
        for (int q = 0; q < 15; q += 3) {
            PEER_ROWS(rc, urs, uc, q + 2); PEER_UDOT(ra, q);
            PEER_ROWS(ra, urs, uc, q + 3); PEER_UDOT(rb, q + 1);
            if (q + 4 < 16) PEER_ROWS(rb, urs, uc, q + 4);
            PEER_UDOT(rc, q + 2);
        }
        PEER_UDOT(ra, 15);
    }
}
__device__ __forceinline__ void peer_combine4(const float* PD, const unsigned short* EXP16, const float* BEST, const float* SS2, const float* su, const float* sv, unsigned char* CC8, float* SCC, int t0, int lane) {
    typedef float f32x2v __attribute__((ext_vector_type(2)));
    f32x4 ssv[4][4]; unsigned ev[4]; f32x2v bv[4]; f32x2v pdv[4][8];
#pragma unroll
    for (int i = 0; i < 4; ++i) { const int t = t0 + i;
        const GAS f32x4* sp = (const GAS f32x4*)(SS2 + (size_t)t * 16);
#pragma unroll
        for (int q = 0; q < 4; ++q) ssv[i][q] = sp[q];
        ev[i] = ((const GAS unsigned*)(EXP16 + (size_t)t * 128))[lane];
        bv[i] = ((const GAS f32x2v*)(BEST + (size_t)t * 128))[lane];
#pragma unroll
        for (int j = 0; j < 8; ++j) pdv[i][j] = ((const GAS f32x2v*)(PD + ((size_t)j * T + t) * 128))[lane]; }
    float suv[4][2], svv[4][2];
#pragma unroll
    for (int i = 0; i < 4; ++i) { const unsigned e0 = ev[i] & 0xffffu, e1 = ev[i] >> 16; suv[i][0] = su[e0]; suv[i][1] = su[e1]; svv[i][0] = sv[e0]; svv[i][1] = sv[e1]; }
#pragma unroll
    for (int i = 0; i < 4; ++i) { const int t = t0 + i;
        float ssq = 0.f;
#pragma unroll
        for (int q = 0; q < 4; ++q) ssq += (ssv[i][q].x + ssv[i][q].y) + (ssv[i][q].z + ssv[i][q].w);
        const float rstd2 = 1.0f / sqrtf(ssq * (1.0f / D) + EPS);
        const float s0 = bv[i].x * rstd2, s1 = bv[i].y * rstd2;
        float mx = fmaxf(s0, s1);
#pragma unroll
        for (int o = 1; o < 8; o <<= 1) mx = fmaxf(mx, __shfl_xor(mx, o));
        const float e0 = __expf(s0 - mx), e1 = __expf(s1 - mx); float sm = e0 + e1;
#pragma unroll
        for (int o = 1; o < 8; o <<= 1) sm += __shfl_xor(sm, o);
        float d0 = 0.f, d1 = 0.f;
#pragma unroll
        for (int j = 0; j < 8; ++j) { d0 += pdv[i][j].x; d1 += pdv[i][j].y; }
        const float inv_sm = 1.0f / sm;
        const float c0 = e0 * inv_sm * gelu_erf(d0 * rstd2 * suv[i][0]) * svv[i][0], c1 = e1 * inv_sm * gelu_erf(d1 * rstd2 * suv[i][1]) * svv[i][1];
        float amax = fmaxf(fabsf(c0), fabsf(c1));
#pragma unroll
        for (int o = 1; o < 64; o <<= 1) amax = fmaxf(amax, __shfl_xor(amax, o));
        const float inv = amax > 0.f ? 127.0f / amax : 0.f;
        ((GAS unsigned short*)(CC8 + (size_t)t * 128))[lane] = (unsigned short)((__float2int_rn(c0 * inv) & 0xff) | ((__float2int_rn(c1 * inv) & 0xff) << 8));
        if (lane == 0) SCC[t] = amax * (1.0f / 127.0f); }
}
__device__ __forceinline__ void peer_v_phase(LAS unsigned char* lds, float* OUT, const bf16* X1B, const unsigned char* V8, const unsigned short* EXP16, const unsigned char* CC8, const float* SCC, int j, int w, int nw, int wave, int lane) {
    const int grp = lane >> 3, sub = lane & 7;
    LAS unsigned char* wl = lds + wave * 8192;
    const LAS unsigned char* evp = wl + grp * 256;
    const LAS unsigned char* ccp = wl + 2048 + grp * 128;
    const int stride = nw * NWAVES * 8;
    int tb = (w * NWAVES + wave) * 8;
    v4u pe0 = {0u, 0u, 0u, 0u}, pe1 = {0u, 0u, 0u, 0u}, pc0 = {0u, 0u, 0u, 0u};
    if (tb < T) { const GAS v4u* e = (const GAS v4u*)(EXP16 + (size_t)tb * 128) + lane; pe0 = e[0]; pe1 = e[64]; pc0 = ((const GAS v4u*)(CC8 + (size_t)tb * 128))[lane]; }
    const __amdgpu_buffer_rsrc_t vrs = __builtin_amdgcn_make_buffer_rsrc((void*)V8, (short)0, NEXP * D, 0x00020000); const unsigned vc = (unsigned)j * (NEXP * 128u) + 16u * sub;
    for (; tb < T; tb += stride) {
        *(LAS v4u*)(wl + 16 * lane) = pe0; *(LAS v4u*)(wl + 1024 + 16 * lane) = pe1; *(LAS v4u*)(wl + 2048 + 16 * lane) = pc0;
        if (tb + stride < T) { const GAS v4u* e = (const GAS v4u*)(EXP16 + (size_t)(tb + stride) * 128) + lane; pe0 = e[0]; pe1 = e[64]; pc0 = ((const GAS v4u*)(CC8 + (size_t)(tb + stride) * 128))[lane]; }
        const int t = tb + grp;
        const float scc = SCC[t];
        const size_t eo = (size_t)t * D + 128 * j + 16 * sub;
        const GAS v4u* dp = (const GAS v4u*)(X1B + eo);
        const v4u da = dp[0], db = dp[1];
        int acc[16];
#pragma unroll
        for (int i = 0; i < 16; ++i) acc[i] = 0;
        LDS_WAIT();
        v4u rq[4][4];
#define PEER_LOADQ(r, qn) do { const unsigned long long _e4 = *(const LAS unsigned long long*)(evp + 8 * (qn)); const unsigned _lo = (unsigned)_e4, _hi = (unsigned)(_e4 >> 32); \
            r[0] = PEER_BL(vrs, _lo & 0xffffu, vc); r[1] = PEER_BL(vrs, _lo >> 16, vc); r[2] = PEER_BL(vrs, _hi & 0xffffu, vc); r[3] = PEER_BL(vrs, _hi >> 16, vc); } while (0)
#define PEER_T4(w_, r0, r1, r2, r3, cpk) do { const unsigned tl0 = __builtin_amdgcn_perm(r1, r0, 0x05010400u), th0 = __builtin_amdgcn_perm(r1, r0, 0x07030602u); \
            const unsigned tl1 = __builtin_amdgcn_perm(r3, r2, 0x05010400u), th1 = __builtin_amdgcn_perm(r3, r2, 0x07030602u); \
            acc[4 * (w_) + 0] = __builtin_amdgcn_sdot4((int)__builtin_amdgcn_perm(tl1, tl0, 0x05040100u), (int)(cpk), acc[4 * (w_) + 0], false); \
            acc[4 * (w_) + 1] = __builtin_amdgcn_sdot4((int)__builtin_amdgcn_perm(tl1, tl0, 0x07060302u), (int)(cpk), acc[4 * (w_) + 1], false); \
            acc[4 * (w_) + 2] = __builtin_amdgcn_sdot4((int)__builtin_amdgcn_perm(th1, th0, 0x05040100u), (int)(cpk), acc[4 * (w_) + 2], false); \
            acc[4 * (w_) + 3] = __builtin_amdgcn_sdot4((int)__builtin_amdgcn_perm(th1, th0, 0x07060302u), (int)(cpk), acc[4 * (w_) + 3], false); } while (0)
#define PEER_COMPQ(r, qn) do { const unsigned _c = *(const LAS unsigned*)(ccp + 4 * (qn)); \
            PEER_T4(0, r[0].x, r[1].x, r[2].x, r[3].x, _c); PEER_T4(1, r[0].y, r[1].y, r[2].y, r[3].y, _c); PEER_T4(2, r[0].z, r[1].z, r[2].z, r[3].z, _c); PEER_T4(3, r[0].w, r[1].w, r[2].w, r[3].w, _c); } while (0)
#pragma unroll
        for (int jq = 0; jq < 4; ++jq) PEER_LOADQ(rq[jq], jq);
        for (int it = 0; it < 8; ++it) {
#pragma unroll
            for (int jq = 0; jq < 4; ++jq) { PEER_COMPQ(rq[jq], 4 * it + jq); if (it < 7) PEER_LOADQ(rq[jq], 4 * it + 4 + jq); }
        }
        GAS f32x4* op = (GAS f32x4*)(OUT + eo);
        const float dl[16] = {bf_lo(da.x), bf_hi(da.x), bf_lo(da.y), bf_hi(da.y), bf_lo(da.z), bf_hi(da.z), bf_lo(da.w), bf_hi(da.w), bf_lo(db.x), bf_hi(db.x), bf_lo(db.y), bf_hi(db.y), bf_lo(db.z), bf_hi(db.z), bf_lo(db.w), bf_hi(db.w)};
#pragma unroll
        for (int q = 0; q < 4; ++q) { f32x4 v; v.x = dl[4 * q + 0] + scc * (float)acc[4 * q + 0]; v.y = dl[4 * q + 1] + scc * (float)acc[4 * q + 1]; v.z = dl[4 * q + 2] + scc * (float)acc[4 * q + 2]; v.w = dl[4 * q + 3] + scc * (float)acc[4 * q + 3]; op[q] = v; }
    }
}
struct Args { const float* in[15]; float* out; unsigned char* ws; int ph_lo, ph_hi, li, pad; };
__global__ void __launch_bounds__(NWAVES * 64, 2) fwd_kernel(Args args) {
    extern __shared__ __attribute__((aligned(16))) unsigned char lds_raw[];
    LAS unsigned char* lds = (LAS unsigned char*)lds_raw;
    volatile LAS unsigned* MISC = (volatile LAS unsigned*)(lds + MISC_OFF);
    const int tid = threadIdx.x, lane = tid & 63, wave = __builtin_amdgcn_readfirstlane(tid >> 6);
    const int G = gridDim.x, bx = blockIdx.x;
    unsigned char* ws = args.ws;
    gu32* ctl = (gu32*)(ws + WS_CTL);
    for (int u = tid; u < (LDS_BYTES - LDSCTL_OFF) / 4; u += NWAVES * 64) ((LAS unsigned*)(lds + LDSCTL_OFF))[u] = 0u;
    __syncthreads();
    XcdBarrier bar; bar.bar = (unsigned*)(ctl + CW_BAR); bar.x = 0; bar.st = nullptr;
    if (N_LAUNCHES != PER_PHASE) bar = xcd_barrier_post((unsigned*)(ctl + CW_BAR) + args.li * XCD_BAR_WORDS, MISC + 8);
#define GRID_BAR() do { if (N_LAUNCHES != PER_PHASE) xcd_barrier(bar); } while (0)
    const int lo = args.ph_lo, hi = args.ph_hi;
#define IN(k) (lo <= (k) && (k) < hi)
#define BOTH(k) (IN(k) && IN((k) + 1))
#ifndef MK_REPEAT
#define MK_REPEAT -1
#endif
#define REP(k) for (int _r = 0; _r < ((MK_REPEAT == (k)) ? 2 : 1); ++_r)

    const float* x = args.in[0]; float* out = args.out;
    bf16* XB = (bf16*)(ws + WS_XB); bf16* WinT = (bf16*)(ws + WS_WIN); bf16* WoutT = (bf16*)(ws + WS_WOUT); bf16* WqT = (bf16*)(ws + WS_WQ);
    bf16* SK = (bf16*)(ws + WS_SK); bf16* PoolT = (bf16*)(ws + WS_POOLT); unsigned char* U8 = ws + WS_U8; unsigned char* V8 = ws + WS_V8; float* SU = (float*)(ws + WS_SU); float* SV = (float*)(ws + WS_SV);
    bf16* Y = (bf16*)(ws + WS_Y); bf16* AB = (bf16*)(ws + WS_AB); bf16* X1B = (bf16*)(ws + WS_X1B); bf16* QP = (bf16*)(ws + WS_QP);
    float* rstd1 = (float*)(ws + WS_RSTD1); float* SS2 = (float*)(ws + WS_SS2); unsigned short* EXPERTS = (unsigned short*)(ws + WS_EXP); float* BEST = (float*)(ws + WS_BEST);
    float* PD = (float*)(ws + WS_PD); bf16* DELTA = (bf16*)(ws + WS_DELTA); unsigned char* CC8 = ws + WS_CC; float* SCC = (float*)(ws + WS_SCC);
    const int gw = bx * NWAVES + wave, NGW = G * NWAVES;

    if (IN(0)) REP(0) {
        P0Args a{x, args.in[1], args.in[2], args.in[7], args.in[9], args.in[10], args.in[11], args.in[12], args.in[13], args.in[14], XB, WinT, WoutT, WqT, SK, PoolT, U8, V8, SU, SV, rstd1};
        p0_prologue(a, lds, gw, NGW, wave, lane);
        if (BOTH(0)) GRID_BAR();
    }
    if (IN(1)) REP(1) {
        pg8::Gemm g{XB, WinT, T, DIN, D}; pg8::StaticOrder S; S.init(T, DIN, G, bx);
        pg8::EpiScaleBf16 E{Y, DIN, rstd1};
        pg8::gemm_phase<pg8::EpiScaleBf16, pg8::StaticOrder, true, true>(lds + RING_OFF, g, S, E);
        if (BOTH(1)) GRID_BAR();
    }
    if (IN(2)) REP(2) {
        for (int u = bx; u < NB * 128 * 2; u += G) attn_unit(lds, Y, AB, args.in[3], args.in[4], args.in[5], args.in[6], u, tid, wave, lane);
        for (int u = bx; u < T / 128; u += G) pool_rows(Y, AB, args.in[8], u, tid);
        if (BOTH(2)) GRID_BAR();
    }
    if (IN(3)) REP(3) {
        pg8::Gemm g{AB, WoutT, T, D, D}; pg8::StaticOrder S; S.init(T, D, G, bx);
        pg8::EpiResid E{XB, X1B, SS2, D};
        pg8::gemm_phase<pg8::EpiResid, pg8::StaticOrder, true, true>(lds + RING_OFF, g, S, E);
        if (BOTH(3)) GRID_BAR();
    }
    if (IN(4)) REP(4) {
        pg8::Gemm g{X1B, WqT, T, DQ, D}; pg8::StaticOrder S; S.init(T, DQ, G, bx);
        pg8::EpiScaleBf16 E{QP, DQ, nullptr};
        pg8::gemm_phase<pg8::EpiScaleBf16, pg8::StaticOrder, true, true>(lds + RING_OFF, g, S, E);
        if (BOTH(4)) GRID_BAR();
    }
    if (IN(5)) REP(5) {
        for (int u = bx; u < (T / 256) * 8; u += G) topk_unit(lds, QP, SK, EXPERTS, BEST, u, tid, wave, lane);
        if (BOTH(5)) GRID_BAR();
    }
    if (IN(6)) REP(6) {
        if ((G & 7) == 0) peer_u_phase(lds, X1B, U8, EXPERTS, PD, bx & 7, bx >> 3, G >> 3, wave, lane);
        else for (int j = 0; j < 8; ++j) peer_u_phase(lds, X1B, U8, EXPERTS, PD, j, bx, G, wave, lane);
        if (BOTH(6)) GRID_BAR();
    }
    if (IN(7)) REP(7) {
        for (int t0 = gw * 4; t0 < T; t0 += NGW * 4) peer_combine4(PD, EXPERTS, BEST, SS2, SU, SV, CC8, SCC, t0, lane);
        if (BOTH(7)) GRID_BAR();
    }
    if (IN(8)) {
        if ((G & 7) == 0) peer_v_phase(lds, out, X1B, V8, EXPERTS, CC8, SCC, bx & 7, bx >> 3, G >> 3, wave, lane);
        else for (int j = 0; j < 8; ++j) peer_v_phase(lds, out, X1B, V8, EXPERTS, CC8, SCC, j, bx, G, wave, lane);
    }
#undef IN
#undef BOTH
}

extern "C" void kernel_launch(void* const* d_in, const int* in_sizes, int n_in, void* d_out, int out_size, void* d_ws, size_t ws_size, hipStream_t stream) {
    static int grid = 0;
    if (grid == 0) {
        if (n_in != 15 || in_sizes[0] != T * D || out_size != T * D || ws_size < WS_END) { fprintf(stderr, "kernel_launch: unexpected shapes (n_in %d, in0 %d, out %d, ws %zu)\n", n_in, n_in > 0 ? in_sizes[0] : -1, out_size, ws_size); grid = -1; return; }
        int dev = 0, cus = 0, per_cu = 0;
        if (hipGetDevice(&dev) != hipSuccess || hipDeviceGetAttribute(&cus, hipDeviceAttributeMultiprocessorCount, dev) != hipSuccess) { grid = -1; return; }
        if (hipFuncSetAttribute((const void*)fwd_kernel, hipFuncAttributeMaxDynamicSharedMemorySize, LDS_BYTES) != hipSuccess) { fprintf(stderr, "kernel_launch: hipFuncSetAttribute failed\n"); grid = -1; return; }
        if (hipOccupancyMaxActiveBlocksPerMultiprocessor(&per_cu, (const void*)fwd_kernel, NWAVES * 64, LDS_BYTES) != hipSuccess || per_cu < 1) { fprintf(stderr, "kernel_launch: occupancy query reports %d blocks per CU\n", per_cu); }
        (void)hipGetLastError();
        grid = cus;
    }
    if (grid < 0) return;
    if (hipMemsetAsync((char*)d_ws + WS_CTL, 0, CTL_ZERO_BYTES, stream) != hipSuccess) return;
    Args a{};
    for (int i = 0; i < 15; ++i) a.in[i] = (const float*)d_in[i];
    a.out = (float*)d_out; a.ws = (unsigned char*)d_ws;
    for (int li = 0; li < N_LAUNCHES; ++li) {
        a.ph_lo = (N_LAUNCHES == PER_PHASE) ? li : 0; a.ph_hi = (N_LAUNCHES == PER_PHASE) ? li + 1 : PER_PHASE; a.li = (N_LAUNCHES == PER_PHASE) ? 0 : li;
        hipLaunchKernelGGL(fwd_kernel, dim3(grid), dim3(NWAVES * 64), LDS_BYTES, stream, a);
        const hipError_t le = hipPeekAtLastError();
        if (le != hipSuccess) { fprintf(stderr, "kernel_launch: launch %d failed: %s\n", li, hipGetErrorName(le)); break; }
    }
}
```

```cpp
#include <hip/hip_runtime.h>
#include <cstdio>
#include <cstdint>
namespace pg8 {
#define PG8_LAS __attribute__((address_space(3)))
typedef unsigned short bf16_t;
typedef short bf16x8 __attribute__((ext_vector_type(8)));
typedef float f32x4 __attribute__((ext_vector_type(4)));
typedef unsigned u32x4 __attribute__((ext_vector_type(4)));
constexpr int BM = 256, BK = 64, HALF = 128, HTB = HALF * BK * 2  , STAGE_BYTES = 8 * HTB, NXCD = 8, WGM = 8;

__host__ __device__ __forceinline__ int lds_byte(int r, int c) { const int st = (r >> 4) * 2 + (c >> 5), rr = r & 15, cc = c & 31, ob = rr * 64 + cc * 2; return st * 1024 + (ob ^ (((ob >> 9) & 1) << 5)); }
__host__ __device__ __forceinline__ void stage_rc(int b, int& R, int& C) { const int st = b / 1024, sb = b % 1024, swz = sb ^ (((sb >> 9) & 1) << 5); R = (st >> 1) * 16 + swz / 64; C = (st & 1) * 32 + (swz % 64) / 2; }
__host__ __device__ __forceinline__ int perm32(int rho) { const int n = rho >> 4, i = rho & 15; return 8 * (i >> 2) + 4 * n + (i & 3); }

struct Unit { int pm, pn; };
struct Gemm { const bf16_t* A; const bf16_t* Bt; int M, N, K; };

struct StaticOrder {
    int nM, nN, nwg, G, c;
    __host__ __device__ void init(int M, int N, int G_, int c_) { nM = M / BM; nN = N / BM; nwg = nM * nN; G = G_; c = c_; }
    __host__ __device__ bool next(int i, Unit& u) const {
        const long L = (long)i * G + c; if (L >= nwg) return false;
        int wgid = (int)L; { const int q = nwg / NXCD, r = nwg % NXCD, xcd = wgid % NXCD, off = wgid / NXCD; wgid = (xcd < r ? xcd * (q + 1) : r * (q + 1) + (xcd - r) * q) + off; }
        const int nig = WGM * nN, gid = wgid / nig, fm = gid * WGM, gsz = (nM - fm) < WGM ? (nM - fm) : WGM;
        u.pm = fm + ((wgid % nig) % gsz); u.pn = (wgid % nig) / gsz; return true;
    }
    __device__ __forceinline__ void a_ready(const Unit&) const {}
    __device__ __forceinline__ void done(const Unit&) const {}
};

__device__ __forceinline__ unsigned cvt_pk_bf16(float lo, float hi) { unsigned r; asm volatile("v_cvt_pk_bf16_f32 %0, %1, %2" : "=v"(r) : "v"(lo), "v"(hi)); return r; }
struct EpiScaleBf16 {
    static constexpr bool PERM = true, AFTER_DRAIN = false, PROBE_TWICE = false;
    bf16_t* O; int ldc; const float* rs;
    __device__ __forceinline__ void operator()(const f32x4 (&acc)[2][2][4][2], const Unit& u, int wr, int wc, int fr, int fq) const {
        const int row0 = u.pm * BM + wr * 64 + fr, col0 = u.pn * BM + wc * 32 + 8 * fq;
#pragma unroll
        for (int ai = 0; ai < 2; ++ai)
#pragma unroll
            for (int m = 0; m < 4; ++m) { const int row = row0 + ai * HALF + m * 16; const float s = rs ? rs[row] : 1.f; bf16_t* rowp = O + (size_t)row * ldc + col0;
#pragma unroll
                for (int bj = 0; bj < 2; ++bj) { const f32x4 v0 = acc[ai][bj][m][0] * s, v1 = acc[ai][bj][m][1] * s;
                    u32x4 w; w.x = cvt_pk_bf16(v0[0], v0[1]); w.y = cvt_pk_bf16(v0[2], v0[3]); w.z = cvt_pk_bf16(v1[0], v1[1]); w.w = cvt_pk_bf16(v1[2], v1[3]);
                    *(u32x4*)(rowp + bj * HALF) = w; } }
    }
};
struct EpiResid {
    static constexpr bool PERM = true, AFTER_DRAIN = false, PROBE_TWICE = false;
    const bf16_t* xbf; bf16_t* xb; float* ss; int ldc;
    __device__ __forceinline__ void operator()(const f32x4 (&acc)[2][2][4][2], const Unit& u, int wr, int wc, int fr, int fq) const {
        const int row0 = u.pm * BM + wr * 64 + fr, col0 = u.pn * BM + wc * 32 + 8 * fq;
#pragma unroll
        for (int ai = 0; ai < 2; ++ai)
#pragma unroll
            for (int m = 0; m < 4; ++m) { const int row = row0 + ai * HALF + m * 16; const size_t off = (size_t)row * ldc + col0; float q = 0.f;
#pragma unroll
                for (int bj = 0; bj < 2; ++bj) { const u32x4 xr = *(const u32x4*)(xbf + off + bj * HALF);
                    const f32x4 a0 = acc[ai][bj][m][0], a1 = acc[ai][bj][m][1];
                    f32x4 v0, v1;
                    v0[0] = a0[0] + __builtin_bit_cast(float, xr.x << 16); v0[1] = a0[1] + __builtin_bit_cast(float, xr.x & 0xffff0000u); v0[2] = a0[2] + __builtin_bit_cast(float, xr.y << 16); v0[3] = a0[3] + __builtin_bit_cast(float, xr.y & 0xffff0000u);
                    v1[0] = a1[0] + __builtin_bit_cast(float, xr.z << 16); v1[1] = a1[1] + __builtin_bit_cast(float, xr.z & 0xffff0000u); v1[2] = a1[2] + __builtin_bit_cast(float, xr.w << 16); v1[3] = a1[3] + __builtin_bit_cast(float, xr.w & 0xffff0000u);
                    u32x4 w; w.x = cvt_pk_bf16(v0[0], v0[1]); w.y = cvt_pk_bf16(v0[2], v0[3]); w.z = cvt_pk_bf16(v1[0], v1[1]); w.w = cvt_pk_bf16(v1[2], v1[3]);
                    *(u32x4*)(xb + off + bj * HALF) = w;
                    q += (v0[0] * v0[0] + v0[1] * v0[1]) + (v0[2] * v0[2] + v0[3] * v0[3]) + (v1[0] * v1[0] + v1[1] * v1[1]) + (v1[2] * v1[2] + v1[3] * v1[3]); }
                q += __shfl_xor(q, 16); q += __shfl_xor(q, 32);
                if (fq == 0) ss[(size_t)row * 16 + u.pn * 4 + wc] = q; }
    }
};
template <class Epi, class Sched, bool ALIGN_EPI = false, bool SP2 = false>
__device__ __forceinline__ void gemm_phase(PG8_LAS unsigned char* lds, const Gemm g, const Sched& S, const Epi& E) {
    const int tid = threadIdx.x, wid = __builtin_amdgcn_readfirstlane(tid >> 6), lane = tid & 63, wr = wid >> 2, wc = wid & 3, fr = lane & 15, fq = lane >> 4;
    const int K = g.K, nt = K / BK;
    unsigned voffA[2], voffB[2];
#pragma unroll
    for (int i = 0; i < 2; ++i) { int R, C; stage_rc(tid * 16 + i * 8192, R, C); const int Rb = Epi::PERM ? ((R & ~31) + perm32(R & 31)) : R;
        voffA[i] = (unsigned)(R * K + C) * 2u; voffB[i] = (unsigned)(Rb * K + C) * 2u; }
    const size_t kstep = (size_t)(BK * 2);
    const size_t hstep = (size_t)HALF * K * 2;
    const size_t tstep = 2 * hstep;
    const unsigned ldsw = (unsigned)wid * 1024u;
    const int aoff = lds_byte(wr * 64 + fr, fq * 8), boff = lds_byte(wc * 32 + fr, fq * 8);
#define PG8_SA(b, h) (((b) * 2 + (h)) * HTB)
#define PG8_SB(b, h) ((4 + (b) * 2 + (h)) * HTB)
#define PG8_STAGE(bufoff, gbase, voff) do { _Pragma("unroll") for (int _i = 0; _i < 2; ++_i) \
        __builtin_amdgcn_global_load_lds((const unsigned*)((const char*)(gbase) + (voff)[_i]), (PG8_LAS unsigned*)(lds + (bufoff) + ldsw + _i * 8192), 16, 0, 0); } while (0)
#define PG8_LDA(dst, b, h) do { _Pragma("unroll") for (int m = 0; m < 4; ++m) _Pragma("unroll") for (int k = 0; k < 2; ++k) dst[m][k] = *(const PG8_LAS bf16x8*)(lds + PG8_SA(b, h) + aoff + m * 2048 + k * 1024); } while (0)
#define PG8_LDB(dst, b, h) do { _Pragma("unroll") for (int n = 0; n < 2; ++n) _Pragma("unroll") for (int k = 0; k < 2; ++k) dst[n][k] = *(const PG8_LAS bf16x8*)(lds + PG8_SB(b, h) + boff + n * 2048 + k * 1024); } while (0)
#define PG8_MMA(ai, bj, At, Bt) do { __builtin_amdgcn_s_setprio(1); _Pragma("unroll") for (int m = 0; m < 4; ++m) _Pragma("unroll") for (int n = 0; n < 2; ++n) _Pragma("unroll") for (int k = 0; k < 2; ++k) \
        acc[ai][bj][m][n] = __builtin_amdgcn_mfma_f32_16x16x32_bf16(Bt[n][k], At[m][k], acc[ai][bj][m][n], 0, 0, 0); __builtin_amdgcn_s_setprio(0); } while (0)
#define PG8_WAIT_V(n) asm volatile("s_waitcnt vmcnt(" #n ")" ::: "memory")
#define PG8_WAIT_L(n) asm volatile("s_waitcnt lgkmcnt(" #n ")" ::: "memory")
#define PG8_BAR __builtin_amdgcn_s_barrier()
#define PG8_SCHED __builtin_amdgcn_sched_barrier(0)
    Unit cur, nxt; int ui = 0;
    if (!S.next(0, cur)) return;
    f32x4 acc[2][2][4][2];
#pragma unroll
    for (int a = 0; a < 2; ++a)
#pragma unroll
        for (int b = 0; b < 2; ++b)
#pragma unroll
            for (int m = 0; m < 4; ++m)
#pragma unroll
                for (int n = 0; n < 2; ++n) acc[a][b][m][n] = (f32x4){0.f, 0.f, 0.f, 0.f};
    bf16x8 At[4][2], B0[2][2], B1[2][2];
    const char* cA = (const char*)g.A + (size_t)cur.pm * tstep; const char* cB = (const char*)g.Bt + (size_t)cur.pn * tstep;
    S.a_ready(cur);
    if constexpr (SP2) {
        PG8_STAGE(PG8_SB(0, 0), cB, voffB); PG8_STAGE(PG8_SB(0, 1), cB + hstep, voffB); PG8_STAGE(PG8_SA(0, 0), cA, voffA); PG8_STAGE(PG8_SA(0, 1), cA + hstep, voffA);
        if (wr == 1) PG8_BAR;
        PG8_WAIT_V(2); PG8_BAR;
        PG8_STAGE(PG8_SB(1, 0), cB + kstep, voffB); PG8_STAGE(PG8_SA(1, 0), cA + kstep, voffA); PG8_STAGE(PG8_SB(1, 1), cB + hstep + kstep, voffB);
        PG8_WAIT_V(6); PG8_BAR;
    } else {
        PG8_STAGE(PG8_SB(0, 0), cB, voffB); PG8_STAGE(PG8_SA(0, 0), cA, voffA); PG8_STAGE(PG8_SB(0, 1), cB + hstep, voffB); PG8_STAGE(PG8_SA(0, 1), cA + hstep, voffA);
        if (wr == 1) PG8_BAR;
        PG8_WAIT_V(4); PG8_BAR;
        PG8_STAGE(PG8_SB(1, 0), cB + kstep, voffB); PG8_STAGE(PG8_SA(1, 0), cA + kstep, voffA); PG8_STAGE(PG8_SB(1, 1), cB + hstep + kstep, voffB);
        PG8_WAIT_V(6); PG8_BAR;
    }
    for (;;) {
        const bool has_next = S.next(ui + 1, nxt);
        const char* nA = has_next ? (const char*)g.A + (size_t)nxt.pm * tstep : cA; const char* nB = has_next ? (const char*)g.Bt + (size_t)nxt.pn * tstep : cB;
        for (int t = 0; t < nt; t += 2) {
            const bool last = (t == nt - 2);
            const char* a1 = cA + (size_t)(t + 1) * kstep;
            const char* a2 = last ? nA : cA + (size_t)(t + 2) * kstep; const char* b2 = last ? nB : cB + (size_t)(t + 2) * kstep;
            const char* a3 = a2 + kstep; const char* b3 = b2 + kstep;
            if (last && has_next) S.a_ready(nxt);
            if constexpr (SP2) {
            PG8_LDB(B0, 0, 0); PG8_LDB(B1, 0, 1); PG8_SCHED; PG8_LDA(At, 0, 0); PG8_STAGE(PG8_SA(1, 1), a1 + hstep, voffA);
            PG8_WAIT_V(8); PG8_WAIT_L(0); PG8_BAR; PG8_MMA(0, 0, At, B0); PG8_MMA(0, 1, At, B1); PG8_BAR; PG8_SCHED;
            PG8_LDA(At, 0, 1); PG8_STAGE(PG8_SB(0, 0), b2, voffB); PG8_STAGE(PG8_SB(0, 1), b2 + hstep, voffB); PG8_STAGE(PG8_SA(0, 0), a2, voffA);
            PG8_WAIT_V(8); PG8_WAIT_L(0); PG8_BAR; PG8_MMA(1, 0, At, B0); PG8_MMA(1, 1, At, B1); PG8_BAR; PG8_SCHED;
            PG8_LDB(B0, 1, 0); PG8_LDB(B1, 1, 1); PG8_SCHED; PG8_LDA(At, 1, 0); PG8_STAGE(PG8_SA(0, 1), a2 + hstep, voffA);
            PG8_WAIT_V(8); PG8_WAIT_L(0); PG8_BAR; PG8_MMA(0, 0, At, B0); PG8_MMA(0, 1, At, B1); PG8_BAR; PG8_SCHED;
            PG8_LDA(At, 1, 1); PG8_STAGE(PG8_SB(1, 0), b3, voffB); PG8_STAGE(PG8_SB(1, 1), b3 + hstep, voffB); PG8_STAGE(PG8_SA(1, 0), a3, voffA);
            PG8_WAIT_V(8); PG8_WAIT_L(0); PG8_BAR; PG8_MMA(1, 0, At, B0); PG8_MMA(1, 1, At, B1); PG8_BAR; PG8_SCHED;
            } else {
            PG8_LDB(B0, 0, 0); PG8_SCHED; PG8_LDA(At, 0, 0); PG8_STAGE(PG8_SA(1, 1), a1 + hstep, voffA);
            PG8_WAIT_L(8); PG8_BAR; PG8_WAIT_L(0); PG8_MMA(0, 0, At, B0); PG8_BAR; PG8_SCHED;
            PG8_LDB(B1, 0, 1); PG8_STAGE(PG8_SB(0, 0), b2, voffB);
            PG8_BAR; PG8_WAIT_L(0); PG8_MMA(0, 1, At, B1); PG8_BAR;
            PG8_LDA(At, 0, 1); PG8_STAGE(PG8_SA(0, 0), a2, voffA);
            PG8_BAR; PG8_WAIT_L(0); PG8_MMA(1, 0, At, B0); PG8_BAR; PG8_SCHED;
            PG8_STAGE(PG8_SB(0, 1), b2 + hstep, voffB);
            PG8_WAIT_V(6); PG8_BAR; PG8_MMA(1, 1, At, B1); PG8_BAR;
            PG8_LDB(B0, 1, 0); PG8_SCHED; PG8_LDA(At, 1, 0); PG8_STAGE(PG8_SA(0, 1), a2 + hstep, voffA);
            PG8_WAIT_L(8); PG8_BAR; PG8_WAIT_L(0); PG8_MMA(0, 0, At, B0); PG8_BAR; PG8_SCHED;
            PG8_LDB(B1, 1, 1); PG8_STAGE(PG8_SB(1, 0), b3, voffB);
            PG8_BAR; PG8_WAIT_L(0); PG8_MMA(0, 1, At, B1); PG8_BAR;
            PG8_LDA(At, 1, 1); PG8_STAGE(PG8_SA(1, 0), a3, voffA);
            PG8_BAR; PG8_WAIT_L(0); PG8_MMA(1, 0, At, B0); PG8_BAR; PG8_SCHED;
            PG8_STAGE(PG8_SB(1, 1), b3 + hstep, voffB);
            PG8_WAIT_V(6); PG8_BAR; PG8_MMA(1, 1, At, B1); PG8_BAR;
            }
        }
        if constexpr (ALIGN_EPI) { if (wr == 0) PG8_BAR; }
        if constexpr (!Epi::AFTER_DRAIN) { E(acc, cur, wr, wc, fr, fq);
#if defined(MK_EXTRA)
            if (Epi::PROBE_TWICE) { asm volatile("" ::: "memory"); E(acc, cur, wr, wc, fr, fq); }
#endif
            S.done(cur); }
        if (!has_next) break;
#pragma unroll
        for (int a = 0; a < 2; ++a)
#pragma unroll
            for (int b = 0; b < 2; ++b)
#pragma unroll
                for (int m = 0; m < 4; ++m)
#pragma unroll
                    for (int n = 0; n < 2; ++n) acc[a][b][m][n] = (f32x4){0.f, 0.f, 0.f, 0.f};
        cur = nxt; cA = nA; cB = nB; ++ui;
        if constexpr (ALIGN_EPI) { if (wr == 1) PG8_BAR; }
    }
    PG8_WAIT_V(0);
    if constexpr (!ALIGN_EPI) { if (wr == 0) PG8_BAR; }
    PG8_BAR;
    if constexpr (Epi::AFTER_DRAIN) { E.fused(acc, cur, wr, wc, fr, fq, lds, wid, lane); S.done(cur); }
#undef PG8_SA
#undef PG8_SB
#undef PG8_STAGE
#undef PG8_LDA
#undef PG8_LDB
#undef PG8_MMA
#undef PG8_WAIT_V
#undef PG8_WAIT_L
#undef PG8_BAR
#undef PG8_SCHED
}
}
constexpr int NWAVES = 8;
#ifndef MK_N_LAUNCHES
#define MK_N_LAUNCHES 1
#endif
constexpr int PER_PHASE = 9;
constexpr int N_LAUNCHES = MK_N_LAUNCHES;

constexpr int NB = 4, SEQ = 8192, T = NB * SEQ, D = 1024, DIN = 1280, NEXP = 16384, DQ = 2048;
constexpr float EPS = 1e-6f;

constexpr size_t MiB = 1u << 20;
constexpr size_t WS_CTL = 0, CTL_ZERO_BYTES = 1 * MiB;
constexpr size_t WS_WIN = 2 * MiB;
constexpr size_t WS_WOUT = 5 * MiB;
constexpr size_t WS_WQ = 7 * MiB;
constexpr size_t WS_SK = 11 * MiB;
constexpr size_t WS_POOLT = 11 * MiB + 512 * 1024;
constexpr size_t WS_RSTD1 = 12 * MiB;
constexpr size_t WS_SS2 = 13 * MiB;
constexpr size_t WS_SU = 15 * MiB;
constexpr size_t WS_SV = 15 * MiB + 256 * 1024;
constexpr size_t WS_EXP = 16 * MiB;
constexpr size_t WS_BEST = 24 * MiB;
constexpr size_t WS_CC = 40 * MiB;
constexpr size_t WS_SCC = 44 * MiB;
constexpr size_t WS_U8 = 56 * MiB;
constexpr size_t WS_V8 = 72 * MiB;
constexpr size_t WS_AB = 88 * MiB;
constexpr size_t WS_X1B = 152 * MiB;
constexpr size_t WS_PD = 216 * MiB;
constexpr size_t WS_DELTA = 360 * MiB;
constexpr size_t WS_XB = 216 * MiB;
constexpr size_t WS_Y = 280 * MiB;
constexpr size_t WS_QP = 216 * MiB;
constexpr size_t WS_END = 424 * MiB;
constexpr int CW_BAR = 4096;

constexpr int RING_OFF = 0, RING_BYTES = 131072;
constexpr int LDSCTL_OFF = RING_BYTES, MISC_OFF = LDSCTL_OFF + 320;
constexpr int LDS_BYTES = 147456;
#define GAS __attribute__((address_space(1)))
#define LAS __attribute__((address_space(3)))
typedef unsigned short bf16;
typedef unsigned v4u __attribute__((ext_vector_type(4)));
typedef float f32x4 __attribute__((ext_vector_type(4)));
typedef short bf16x8 __attribute__((ext_vector_type(8)));
typedef GAS unsigned gu32;
typedef GAS unsigned long long gu64;
#define RLX_AGENT __ATOMIC_RELAXED, __HIP_MEMORY_SCOPE_AGENT
#define LDS_WAIT() asm volatile("s_waitcnt lgkmcnt(0)" ::: "memory")
#define VM_WAIT() asm volatile("s_waitcnt vmcnt(0)" ::: "memory")
__device__ __forceinline__ unsigned long long rt() { return __builtin_amdgcn_s_memrealtime(); }
__device__ __forceinline__ unsigned f2bf(float f) { unsigned u = __builtin_bit_cast(unsigned, f); return (u + 0x7fffu + ((u >> 16) & 1u)) >> 16; }
__device__ __forceinline__ unsigned pk2(float lo, float hi) { return f2bf(lo) | (f2bf(hi) << 16); }
#define XB_TMO      128
#define XB_XCNT(j)  (256  + 64 * (j))
#define XB_XSUB(j)  (1280 + 64 * (j))
#define XB_XGEN(j)  (2304 + 64 * (j))
#define XB_TOP      3328
#define XB_TOPGEN   3392
#define XCD_BAR_WORDS 3456
#define XB_SPIN_CAP (1u << 18)

__device__ __forceinline__ unsigned xb_ld(unsigned* p)              { return __hip_atomic_load(p, __ATOMIC_RELAXED, __HIP_MEMORY_SCOPE_AGENT); }
__device__ __forceinline__ unsigned xb_add(unsigned* p, unsigned v) { return __hip_atomic_fetch_add(p, v, __ATOMIC_RELAXED, __HIP_MEMORY_SCOPE_AGENT); }
__device__ __forceinline__ unsigned xb_xcc_id() { return (unsigned)__builtin_amdgcn_s_getreg((3 << 11) | 20) & 0xFu; }
#define XB_SPIN(cond, bar) do { unsigned _sp = 0; while (cond) { __builtin_amdgcn_s_sleep(1); \
    if ((++_sp & 255u) == 0u) { if (xb_ld(&(bar)[XB_TMO])) break; if (_sp > XB_SPIN_CAP) { atomicAdd(&(bar)[XB_TMO], 1u); break; } } } } while (0)

struct XcdBarrier {
    unsigned* bar; unsigned x;
    volatile LAS unsigned* st;
};

__device__ __forceinline__ XcdBarrier xcd_barrier_post(unsigned* bar, volatile LAS unsigned* st) {
    XcdBarrier b; b.bar = bar; b.x = xb_xcc_id(); b.st = st;
    if (threadIdx.x == 0) (void)xb_add(&bar[XB_XCNT(b.x)], 1u);
    return b;
}
__device__ __forceinline__ void xcd_barrier_complete(unsigned* bar, unsigned x, unsigned& nloc, unsigned& nx) {
    const unsigned G = gridDim.x * gridDim.y * gridDim.z;
    unsigned sum, cnt, mine, sp = 0u;
    for (;;) {
        sum = 0u; cnt = 0u; mine = 0u;
#pragma unroll
        for (unsigned j = 0; j < 16; ++j) { const unsigned c = xb_ld(&bar[XB_XCNT(j)]); sum += c; cnt += (c > 0u) ? 1u : 0u; mine = (j == x) ? c : mine; }
        if (sum == G) break;
        __builtin_amdgcn_s_sleep(1);
        if ((++sp & 255u) == 0u) { if (xb_ld(&bar[XB_TMO])) break; if (sp > XB_SPIN_CAP) { atomicAdd(&bar[XB_TMO], 1u); break; } }
    }
    nloc = mine > 0u ? mine : 1u; nx = cnt > 0u ? cnt : 1u;
}

__device__ __forceinline__ void xcd_barrier(const XcdBarrier& b) {
    asm volatile("s_waitcnt vmcnt(0)" ::: "memory");
    __syncthreads();
    if (threadIdx.x == 0) {
        unsigned* bar = b.bar;
        __builtin_amdgcn_s_waitcnt(0);
        unsigned nloc = b.st[0], nx = b.st[1];
        if (nloc == 0u) { xcd_barrier_complete(bar, b.x, nloc, nx); b.st[0] = nloc; b.st[1] = nx; }
        const unsigned old = xb_add(&bar[XB_XSUB(b.x)], 1u);
        const unsigned gen = old / nloc;
        if (old + 1u == (gen + 1u) * nloc) {
            __builtin_amdgcn_fence(__ATOMIC_RELEASE, "agent");
            asm volatile("s_waitcnt vmcnt(0)" ::: "memory");
            const unsigned og = xb_add(&bar[XB_TOP], 1u);
            const unsigned tg = og / nx;
            if (og + 1u == (tg + 1u) * nx) xb_add(&bar[XB_TOPGEN], 1u);
            else XB_SPIN(xb_ld(&bar[XB_TOPGEN]) == tg, bar);
            __builtin_amdgcn_fence(__ATOMIC_ACQUIRE, "agent");
            xb_add(&bar[XB_XGEN(b.x)], 1u);
            asm volatile("s_waitcnt vmcnt(0)" ::: "memory");
        } else {
            XB_SPIN(xb_ld(&bar[XB_XGEN(b.x)]) == gen, bar);
            __builtin_amdgcn_fence(__ATOMIC_ACQUIRE, "agent");
            asm volatile("s_waitcnt vmcnt(0)" ::: "memory");
        }
    }
    __syncthreads();
}
typedef float f32x16 __attribute__((ext_vector_type(16)));
typedef __bf16 bf16x2_t __attribute__((ext_vector_type(2)));
#define MFMA32(a, b, c) __builtin_amdgcn_mfma_f32_32x32x16_bf16((a), (b), (c), 0, 0, 0)
__device__ __forceinline__ float bf_lo(unsigned u) { return __builtin_bit_cast(float, u << 16); }
__device__ __forceinline__ float bf_hi(unsigned u) { return __builtin_bit_cast(float, u & 0xffff0000u); }
__device__ __forceinline__ float dot2_bf16(unsigned w, unsigned x, float acc) { return __builtin_amdgcn_fdot2_f32_bf16(__builtin_bit_cast(bf16x2_t, w), __builtin_bit_cast(bf16x2_t, x), acc, false); }
__device__ __forceinline__ float wave_sum(float v) {
#pragma unroll
    for (int o = 1; o < 64; o <<= 1) v += __shfl_xor(v, o);
    return v;
}

__device__ __forceinline__ unsigned pack_i8x4(float a, float b, float c, float d) {
    return ((unsigned)__float2int_rn(a) & 0xffu) | (((unsigned)__float2int_rn(b) & 0xffu) << 8) | (((unsigned)__float2int_rn(c) & 0xffu) << 16) | (((unsigned)__float2int_rn(d) & 0xffu) << 24);
}

__device__ __forceinline__ void p0_transpose_item(const float* W, int K, int N, bf16* WT, const float* gk, LAS float* scr, int item, int lane) {
    const int nblk = N / 32, kb = item / nblk, nb = item % nblk, k0 = 64 * kb, n0 = 32 * nb;
    float wv[32];
#pragma unroll
    for (int i = 0; i < 32; ++i) wv[i] = W[(size_t)(k0 + 2 * i + (lane >> 5)) * N + n0 + (lane & 31)];
#pragma unroll
    for (int i = 0; i < 32; ++i) { const int kk = 2 * i + (lane >> 5); float w = wv[i]; if (gk) w *= gk[k0 + kk]; scr[kk * 33 + (lane & 31)] = w; }
    LDS_WAIT(); asm volatile("" ::: "memory");
    const int c = lane & 7;
#pragma unroll
    for (int j = 0; j < 4; ++j) { const int n = (lane >> 3) + 8 * j; const LAS float* s = scr + (8 * c) * 33 + n;
        v4u o; o.x = pk2(s[0 * 33], s[1 * 33]); o.y = pk2(s[2 * 33], s[3 * 33]); o.z = pk2(s[4 * 33], s[5 * 33]); o.w = pk2(s[6 * 33], s[7 * 33]);
        *(GAS v4u*)(WT + (size_t)(n0 + n) * K + k0 + 8 * c) = o; }
    LDS_WAIT(); asm volatile("" ::: "memory");
}
__device__ __forceinline__ float row_to_bf16(const float* src, bf16* dst, const float* g, int lane) {
    const GAS f32x4* xr = (const GAS f32x4*)src + lane; float s = 0.f;
    GAS unsigned long long* o8 = (GAS unsigned long long*)dst + lane;
#pragma unroll
    for (int j = 0; j < 4; ++j) { f32x4 v = xr[64 * j]; s += (v.x * v.x + v.y * v.y) + (v.z * v.z + v.w * v.w);
        if (g) { const f32x4 gv = ((const GAS f32x4*)g)[64 * j + lane]; v = v * gv; }
        o8[64 * j] = (unsigned long long)pk2(v.x, v.y) | ((unsigned long long)pk2(v.z, v.w) << 32); }
    return s;
}
__device__ __forceinline__ void row_to_i8(const float* src, unsigned char* dst, const float* g, float* sc, int m, int lane) {
    const GAS f32x4* xr = (const GAS f32x4*)src + lane; f32x4 v[4]; float amax = 0.f;
#pragma unroll
    for (int j = 0; j < 4; ++j) { v[j] = xr[64 * j]; if (g) { const f32x4 gv = ((const GAS f32x4*)g)[64 * j + lane]; v[j] = v[j] * gv; }
        amax = fmaxf(fmaxf(amax, fmaxf(fabsf(v[j].x), fabsf(v[j].y))), fmaxf(fabsf(v[j].z), fabsf(v[j].w))); }
#pragma unroll
    for (int o = 1; o < 64; o <<= 1) amax = fmaxf(amax, __shfl_xor(amax, o));
    const float inv = amax > 0.f ? 127.0f / amax : 0.f;
    GAS unsigned* o4 = (GAS unsigned*)dst + lane;
#pragma unroll
    for (int j = 0; j < 4; ++j) { const unsigned q0 = (unsigned)__float2int_rn(v[j].x * inv) & 0xffu, q1 = (unsigned)__float2int_rn(v[j].y * inv) & 0xffu, q2 = (unsigned)__float2int_rn(v[j].z * inv) & 0xffu, q3 = (unsigned)__float2int_rn(v[j].w * inv) & 0xffu;
        o4[64 * j] = q0 | (q1 << 8) | (q2 << 16) | (q3 << 24); }
    if (lane == 0) sc[m] = amax * (1.0f / 127.0f);
}
__device__ __forceinline__ void p0_poolfold_item(const float* w_in, const float* pool_w, const float* g1, bf16* WinT, int item, int lane) {
    const int kb = item & 15, nb = (item >> 4) & 15, g = item >> 8, k = 64 * kb + lane, n0 = 8 * nb;
    const GAS f32x4* wr = (const GAS f32x4*)(w_in + (size_t)k * DIN + 768 + 128 * g);
    const float* pw = pool_w + (size_t)g * 16384 + n0;
    float acc[8];
#pragma unroll
    for (int n = 0; n < 8; ++n) acc[n] = 0.f;
#pragma unroll 1
    for (int cb = 0; cb < 32; cb += 16) { f32x4 a[16];
#pragma unroll
        for (int c4 = 0; c4 < 16; ++c4) a[c4] = wr[cb + c4];
#pragma unroll
        for (int c4 = 0; c4 < 16; ++c4)
#pragma unroll
            for (int n = 0; n < 8; ++n) { const float* pp = pw + (4 * (cb + c4)) * 128 + n; acc[n] = fmaf(a[c4].x, pp[0], acc[n]); acc[n] = fmaf(a[c4].y, pp[128], acc[n]); acc[n] = fmaf(a[c4].z, pp[256], acc[n]); acc[n] = fmaf(a[c4].w, pp[384], acc[n]); } }
    const float gk = g1[k];
#pragma unroll
    for (int n = 0; n < 8; ++n) WinT[(size_t)(768 + 128 * g + n0 + n) * D + k] = (bf16)f2bf(acc[n] * gk);
}
struct P0Args { const float *x, *g1, *w_in, *pool_w, *w_out, *g2, *wq, *sk, *u, *v; bf16 *XB, *WinT, *WoutT, *WqT, *SK, *PoolT; unsigned char *U8, *V8; float *su, *sv; float* rstd1; };
__device__ __forceinline__ void p0_prologue(const P0Args& a, LAS unsigned char* lds, int gw, int NGW, int wave, int lane) {
    LAS float* scr = (LAS float*)(lds + RING_OFF + wave * 16384);
    constexpr int I_IN = (D / 64) * (768 / 32), I_P = 4 * 16 * 16;
    constexpr int NITEMS = I_P + I_IN;
    for (int it = gw; it < NITEMS; it += NGW) {
        int r = it;
        if (r < I_P) { p0_poolfold_item(a.w_in, a.pool_w, a.g1, a.WinT, r, lane); continue; } r -= I_P;
        { const int kb = r / 24, nb = r % 24; p0_transpose_item(a.w_in, D, DIN, a.WinT, a.g1, scr, kb * 40 + nb, lane); }
    }
    for (int m0 = gw; m0 < T; m0 += 4 * NGW) {
        f32x4 v[4][4];
#pragma unroll
        for (int r = 0; r < 4; ++r) { const int m = m0 + r * NGW < T ? m0 + r * NGW : m0; const GAS f32x4* xr = (const GAS f32x4*)(a.x + (size_t)m * D) + lane;
#pragma unroll
            for (int j = 0; j < 4; ++j) v[r][j] = xr[64 * j]; }
#pragma unroll
        for (int r = 0; r < 4; ++r) { const int m = m0 + r * NGW; if (m < T) {
            float s = 0.f; GAS unsigned long long* o8 = (GAS unsigned long long*)(a.XB + (size_t)m * D) + lane;
#pragma unroll
            for (int j = 0; j < 4; ++j) { const f32x4 w = v[r][j]; s += (w.x * w.x + w.y * w.y) + (w.z * w.z + w.w * w.w); o8[64 * j] = (unsigned long long)pk2(w.x, w.y) | ((unsigned long long)pk2(w.z, w.w) << 32); }
            s = wave_sum(s); if (lane == 0) a.rstd1[m] = 1.0f / sqrtf(s * (1.0f / D) + EPS); } }
    }
    for (int m0 = gw; m0 < 2 * NEXP; m0 += 4 * NGW) {
        f32x4 v[4][4];
#pragma unroll
        for (int r = 0; r < 4; ++r) { const int mm = m0 + r * NGW < 2 * NEXP ? m0 + r * NGW : m0; const bool isv = mm >= NEXP; const int m = isv ? mm - NEXP : mm;
            const GAS f32x4* xr = (const GAS f32x4*)((isv ? a.v : a.u) + (size_t)m * D) + lane;
#pragma unroll
            for (int j = 0; j < 4; ++j) v[r][j] = xr[64 * j]; }
#pragma unroll
        for (int r = 0; r < 4; ++r) { const int mm = m0 + r * NGW; if (mm < 2 * NEXP) { const bool isv = mm >= NEXP; const int m = isv ? mm - NEXP : mm;
            float amax = 0.f;
#pragma unroll
            for (int j = 0; j < 4; ++j) { if (!isv) { const f32x4 gv = ((const GAS f32x4*)a.g2)[64 * j + lane]; v[r][j] = v[r][j] * gv; }
                amax = fmaxf(fmaxf(amax, fmaxf(fabsf(v[r][j].x), fabsf(v[r][j].y))), fmaxf(fabsf(v[r][j].z), fabsf(v[r][j].w))); }
#pragma unroll
            for (int o = 1; o < 64; o <<= 1) amax = fmaxf(amax, __shfl_xor(amax, o));
            const float inv = amax > 0.f ? 127.0f / amax : 0.f;
            unsigned char* tb_ = (isv ? a.V8 : a.U8) + (size_t)m * 128 + ((4 * lane) & 127);
#pragma unroll
            for (int j = 0; j < 4; ++j) *(GAS unsigned*)(tb_ + (size_t)((4 * lane + 256 * j) >> 7) * ((size_t)NEXP * 128)) = pack_i8x4(v[r][j].x * inv, v[r][j].y * inv, v[r][j].z * inv, v[r][j].w * inv);
            if (lane == 0) (isv ? a.sv : a.su)[m] = amax * (1.0f / 127.0f); } }
    }
}
__device__ __forceinline__ void p1_late_weights(const P0Args& a, LAS unsigned char* lds, int gw, int NGW, int wave, int lane) {
    LAS float* scr = (LAS float*)(lds + RING_OFF + wave * 16384);
    constexpr int I_OUT = (D / 64) * (D / 32), I_Q = (D / 64) * (DQ / 32);
    for (int it = gw; it < I_OUT + I_Q; it += NGW) {
        if (it < I_OUT) p0_transpose_item(a.w_out, D, D, a.WoutT, nullptr, scr, it, lane);
        else p0_transpose_item(a.wq, D, DQ, a.WqT, a.g2, scr, it - I_OUT, lane);
    }
    for (int m = gw; m < 256; m += NGW) (void)row_to_bf16(a.sk + (size_t)m * D, a.SK + (size_t)m * D, nullptr, lane);
}

__device__ __forceinline__ int t5_bucket(int rel) {
    const int n = rel < 0 ? -rel : rel; const int base = rel > 0 ? 16 : 0;
    const int v = n < 8 ? n : (n < 12 ? 8 : (n < 16 ? 9 : (n < 23 ? 10 : (n < 32 ? 11 : (n < 46 ? 12 : (n < 64 ? 13 : (n < 91 ? 14 : 15)))))));
    return base + v;
}
__device__ __forceinline__ void attn_unit(LAS unsigned char* lds, const bf16* Y, bf16* AB, const float* qg, const float* kg, const float* sinks, const float* relb,
                                          int unit, int tid, int wave, int lane) {
    const int kvh = unit & 1, c = (unit >> 1) & 127, b = unit >> 8;
    LAS bf16* Ks = (LAS bf16*)lds;
    LAS bf16* Vt = (LAS bf16*)(lds + 27648);
    LAS float* bt = (LAS float*)(lds + 53248);
    const int row0 = b * SEQ + (c - 2) * 64;
#pragma unroll
    for (int rep = 0; rep < 3; ++rep) {
        const int it = tid + rep * 512, j = it >> 3, ch = it & 7;
        const bool valid = (c - 2 + (j >> 6)) >= 0;
        v4u kraw = {0u, 0u, 0u, 0u}, vraw = {0u, 0u, 0u, 0u};
        if (valid) { const bf16* rp = Y + (size_t)(row0 + j) * DIN; kraw = *(const GAS v4u*)(rp + 512 + 64 * kvh + 8 * ch); vraw = *(const GAS v4u*)(rp + 640 + 64 * kvh + 8 * ch); }
        float kf[8] = {bf_lo(kraw.x), bf_hi(kraw.x), bf_lo(kraw.y), bf_hi(kraw.y), bf_lo(kraw.z), bf_hi(kraw.z), bf_lo(kraw.w), bf_hi(kraw.w)};
        float ss = 0.f;
#pragma unroll
        for (int e = 0; e < 8; ++e) ss += kf[e] * kf[e];
        ss += __shfl_xor(ss, 1); ss += __shfl_xor(ss, 2); ss += __shfl_xor(ss, 4);
        const float r = 1.0f / sqrtf(ss * (1.0f / 64.0f) + EPS);
        const f32x4 g0 = *(const GAS f32x4*)(kg + 8 * ch), g1 = *(const GAS f32x4*)(kg + 8 * ch + 4);
        v4u ko; ko.x = pk2(kf[0] * r * g0.x, kf[1] * r * g0.y); ko.y = pk2(kf[2] * r * g0.z, kf[3] * r * g0.w); ko.z = pk2(kf[4] * r * g1.x, kf[5] * r * g1.y); ko.w = pk2(kf[6] * r * g1.z, kf[7] * r * g1.w);
        *(LAS v4u*)(Ks + j * 72 + 8 * ch) = ko;
        const int s16 = j >> 4, kk = j & 15, hh = (kk >> 2) & 1, jj = ((kk >> 3) << 2) | (kk & 3), pos = 16 * s16 + 8 * hh + jj;
        LAS bf16* vp = Vt + (8 * ch) * 200 + pos;
        vp[0 * 200] = (bf16)(vraw.x & 0xffffu); vp[1 * 200] = (bf16)(vraw.x >> 16); vp[2 * 200] = (bf16)(vraw.y & 0xffffu); vp[3 * 200] = (bf16)(vraw.y >> 16);
        vp[4 * 200] = (bf16)(vraw.z & 0xffffu); vp[5 * 200] = (bf16)(vraw.z >> 16); vp[6 * 200] = (bf16)(vraw.w & 0xffffu); vp[7 * 200] = (bf16)(vraw.w >> 16);
    }
#pragma unroll
    for (int rep = 0; rep < 2; ++rep) { const int it = tid + rep * 512, g = it >> 8, r = it & 255; bt[it] = relb[t5_bucket(r - 191) * 8 + kvh * 4 + g]; }
    LDS_WAIT(); __syncthreads();

    const int g = wave >> 1, i = 32 * (wave & 1) + (lane & 31), hh = lane >> 5, habs = kvh * 4 + g;
    const size_t qrow = (size_t)b * SEQ + (size_t)c * 64 + i;
    const bf16* qp = Y + qrow * DIN + habs * 64 + 8 * hh;
    v4u qraw[4]; float ss = 0.f;
#pragma unroll
    for (int s = 0; s < 4; ++s) { qraw[s] = *(const GAS v4u*)(qp + 16 * s);
        const float f0 = bf_lo(qraw[s].x), f1 = bf_hi(qraw[s].x), f2 = bf_lo(qraw[s].y), f3 = bf_hi(qraw[s].y), f4 = bf_lo(qraw[s].z), f5 = bf_hi(qraw[s].z), f6 = bf_lo(qraw[s].w), f7 = bf_hi(qraw[s].w);
        ss += (f0 * f0 + f1 * f1) + (f2 * f2 + f3 * f3) + (f4 * f4 + f5 * f5) + (f6 * f6 + f7 * f7); }
    ss += __shfl_xor(ss, 32);
    const float rq = 0.125f / sqrtf(ss * (1.0f / 64.0f) + EPS);
    bf16x8 qf[4];
#pragma unroll
    for (int s = 0; s < 4; ++s) { const f32x4 g0 = *(const GAS f32x4*)(qg + 16 * s + 8 * hh), g1 = *(const GAS f32x4*)(qg + 16 * s + 8 * hh + 4);
        v4u w; w.x = pk2(bf_lo(qraw[s].x) * rq * g0.x, bf_hi(qraw[s].x) * rq * g0.y); w.y = pk2(bf_lo(qraw[s].y) * rq * g0.z, bf_hi(qraw[s].y) * rq * g0.w);
        w.z = pk2(bf_lo(qraw[s].z) * rq * g1.x, bf_hi(qraw[s].z) * rq * g1.y); w.w = pk2(bf_lo(qraw[s].w) * rq * g1.z, bf_hi(qraw[s].w) * rq * g1.w);
        qf[s] = __builtin_bit_cast(bf16x8, w); }
    f32x16 sacc[6];
#pragma unroll
    for (int kt = 0; kt < 6; ++kt) {
#pragma unroll
        for (int r = 0; r < 16; ++r) sacc[kt][r] = 0.f;
#pragma unroll
        for (int s = 0; s < 4; ++s) { const bf16x8 a = *(const LAS bf16x8*)(Ks + (32 * kt + (lane & 31)) * 72 + 16 * s + 8 * hh); sacc[kt] = MFMA32(a, qf[s], sacc[kt]); }
    }
    const LAS float* btg = bt + g * 256 + 63 - i;
    float mx = -3.0e38f;
#pragma unroll
    for (int kt = 0; kt < 6; ++kt) { const bool masked = (c - 2 + (kt >> 1)) < 0;
#pragma unroll
        for (int r = 0; r < 16; ++r) { const int j = 32 * kt + (r & 3) + 8 * (r >> 2) + 4 * hh; float v = sacc[kt][r] + btg[j]; v = masked ? -1.0e30f : v; sacc[kt][r] = v; mx = fmaxf(mx, v); } }
    mx = fmaxf(mx, __shfl_xor(mx, 32));
    const float sink = sinks[habs], m = fmaxf(mx, sink);
    float sum = 0.f;
#pragma unroll
    for (int kt = 0; kt < 6; ++kt)
#pragma unroll
        for (int r = 0; r < 16; ++r) { const float p = __expf(sacc[kt][r] - m); sacc[kt][r] = p; sum += p; }
    sum += __shfl_xor(sum, 32);
    const float inv = 1.0f / (sum + __expf(sink - m));
    f32x16 oacc[2];
#pragma unroll
    for (int dt = 0; dt < 2; ++dt)
#pragma unroll
        for (int r = 0; r < 16; ++r) oacc[dt][r] = 0.f;
#pragma unroll
    for (int kt = 0; kt < 6; ++kt)
#pragma unroll
        for (int s2 = 0; s2 < 2; ++s2) {
            v4u w; w.x = pk2(sacc[kt][8 * s2 + 0], sacc[kt][8 * s2 + 1]); w.y = pk2(sacc[kt][8 * s2 + 2], sacc[kt][8 * s2 + 3]); w.z = pk2(sacc[kt][8 * s2 + 4], sacc[kt][8 * s2 + 5]); w.w = pk2(sacc[kt][8 * s2 + 6], sacc[kt][8 * s2 + 7]);
            const bf16x8 pb = __builtin_bit_cast(bf16x8, w);
#pragma unroll
            for (int dt = 0; dt < 2; ++dt) { const bf16x8 a = *(const LAS bf16x8*)(Vt + (32 * dt + (lane & 31)) * 200 + 32 * kt + 16 * s2 + 8 * hh); oacc[dt] = MFMA32(a, pb, oacc[dt]); }
        }
    bf16* op = AB + qrow * D + habs * 64;
#pragma unroll
    for (int dt = 0; dt < 2; ++dt)
#pragma unroll
        for (int q4 = 0; q4 < 4; ++q4) { const int d = 32 * dt + 8 * q4 + 4 * hh;
            const unsigned long long o = (unsigned long long)pk2(oacc[dt][4 * q4 + 0] * inv, oacc[dt][4 * q4 + 1] * inv) | ((unsigned long long)pk2(oacc[dt][4 * q4 + 2] * inv, oacc[dt][4 * q4 + 3] * inv) << 32);
            *(GAS unsigned long long*)(op + d) = o; }
    __syncthreads();
}

template <int W> __device__ __forceinline__ void pool_walk(const bf16* zc, bf16* oc, float s0, float s1, int pos0) {
    unsigned ring[16];
    float a0 = 0.f, a1 = 0.f;
#pragma unroll
    for (int q = 0; q < 16; ++q) ring[q] = 0u;
#pragma unroll
    for (int q = 1; q < W; ++q) { if (pos0 - q >= 0) { const unsigned u = *(const GAS unsigned*)(zc - (size_t)q * DIN); ring[(16 - q) & 15] = u; a0 += bf_lo(u); a1 += bf_hi(u); } }
    for (int rb = 0; rb < 64; rb += 16) {
#pragma unroll
        for (int i = 0; i < 16; ++i) {
            const unsigned u = *(const GAS unsigned*)(zc + (size_t)(rb + i) * DIN);
            const float c0 = bf_lo(u), c1 = bf_hi(u);
            a0 += c0; a1 += c1;
            const int pos = pos0 + rb + i; const float ic = 1.0f / (float)(pos + 1 < W ? pos + 1 : W);
            *(GAS unsigned*)(oc + (size_t)(rb + i) * D) = pk2((a0 * ic - c0) * s0, (a1 * ic - c1) * s1);
            const unsigned old = ring[(i + 17 - W) & 15];
            a0 -= bf_lo(old); a1 -= bf_hi(old);
            ring[i] = u;
        }
    }
}
__device__ __forceinline__ void pool_rows(const bf16* Y, bf16* AB, const float* pscale, int unit, int tid) {
    const int cp = tid & 255, seg = tid >> 8, g = cp >> 6;
    const int r0 = unit * 128 + seg * 64, pos0 = r0 & (SEQ - 1);
    const bf16* zc = Y + (size_t)r0 * DIN + 768 + 2 * cp; bf16* oc = AB + (size_t)r0 * D + 512 + 2 * cp;
    const float s0 = pscale[2 * cp], s1 = pscale[2 * cp + 1];
    if (g == 0) pool_walk<2>(zc, oc, s0, s1, pos0); else if (g == 1) pool_walk<4>(zc, oc, s0, s1, pos0); else if (g == 2) pool_walk<8>(zc, oc, s0, s1, pos0); else pool_walk<16>(zc, oc, s0, s1, pos0);
}

__device__ __forceinline__ int f2key(float f) { return __builtin_bit_cast(int, f); }
__device__ __forceinline__ float key2f(int k) { return __builtin_bit_cast(float, k); }
#define CE_DESC(a, b) do { const int _x = (a), _y = (b); (a) = _x > _y ? _x : _y; (b) = _x > _y ? _y : _x; } while (0)
__device__ __forceinline__ void sort16_desc(int (&a)[16]) {
#pragma unroll
    for (int k = 2; k <= 16; k <<= 1)
#pragma unroll
        for (int j = k >> 1; j > 0; j >>= 1)
#pragma unroll
            for (int i = 0; i < 16; ++i) { const int l = i ^ j; if (l > i) { if ((i & k) == 0) CE_DESC(a[i], a[l]); else CE_DESC(a[l], a[i]); } }
}
__device__ __forceinline__ void merge_top16(int (&a)[16], const int (&b)[16]) {
#pragma unroll
    for (int i = 0; i < 16; ++i) a[i] = a[i] > b[15 - i] ? a[i] : b[15 - i];
#pragma unroll
    for (int j = 8; j > 0; j >>= 1)
#pragma unroll
        for (int i = 0; i < 16; ++i) { const int l = i ^ j; if (l > i) CE_DESC(a[i], a[l]); }
}
__device__ __forceinline__ void top16_of_64(int (&g0)[16], int (&g1)[16], int (&g2)[16], int (&g3)[16]) {
    sort16_desc(g0); sort16_desc(g1); sort16_desc(g2); sort16_desc(g3);
    merge_top16(g0, g1); merge_top16(g2, g3); merge_top16(g0, g2);
}
__device__ __forceinline__ void topk_stage_keys(LAS unsigned char* lds, const bf16* SK, int h, int tid) {
#pragma unroll
    for (int i = 0; i < 8; ++i) { const int c = tid + 512 * i, p = c >> 11, n = (c >> 4) & 127, ch = c & 15;
        *(LAS v4u*)(lds + p * 34816 + n * 272 + ch * 16) = *(const GAS v4u*)(SK + ((size_t)(h * 2 + p) * 128 + n) * 128 + ch * 8); }
    LDS_WAIT(); __syncthreads();
}
__device__ __forceinline__ void topk_unit(LAS unsigned char* lds, const bf16* QP, const bf16* SK, unsigned short* EXPERTS, float* BEST, int unit, int tid, int wave, int lane) {
    const int h = unit & 7, tt = unit >> 3, hh = lane >> 5;
    const int tok = tt * 256 + wave * 32 + (lane & 31);
    LAS int* mine = (LAS int*)(lds + 69632) + tid * 33;
    int top[2][16];
#pragma unroll
    for (int p = 0; p < 2; ++p) {
        const bf16* qp = QP + (size_t)tok * DQ + h * 256 + p * 128 + 8 * hh;
        const LAS unsigned char* kp = lds + p * 34816 + (lane & 31) * 272 + 16 * hh;
        f32x16 acc[4];
#pragma unroll
        for (int nt = 0; nt < 4; ++nt)
#pragma unroll
            for (int r = 0; r < 16; ++r) acc[nt][r] = 8.0f;
#pragma unroll
        for (int s = 0; s < 8; ++s) { const bf16x8 bq = __builtin_bit_cast(bf16x8, *(const GAS v4u*)(qp + 16 * s));
#pragma unroll
            for (int nt = 0; nt < 4; ++nt) { const bf16x8 a = *(const LAS bf16x8*)(kp + nt * (32 * 272) + 32 * s); acc[nt] = MFMA32(a, bq, acc[nt]); } }
        int k0[16], k1[16], k2[16], k3[16];
#pragma unroll
        for (int r = 0; r < 16; ++r) { const int n = (r & 3) + 8 * (r >> 2) + 4 * hh;
            k0[r] = (f2key(acc[0][r]) & ~127) | n; k1[r] = (f2key(acc[1][r]) & ~127) | (32 + n); k2[r] = (f2key(acc[2][r]) & ~127) | (64 + n); k3[r] = (f2key(acc[3][r]) & ~127) | (96 + n); }
        top16_of_64(k0, k1, k2, k3);
#pragma unroll
        for (int r = 0; r < 16; ++r) k1[r] = __shfl_xor(k0[r], 32);
        merge_top16(k0, k1);
#pragma unroll
        for (int r = 0; r < 16; ++r) top[p][r] = k0[r];
    }
    int c0[16], c1[16], c2[16], c3[16];
    {
        float v1[16], v2[16];
#pragma unroll
        for (int r = 0; r < 16; ++r) { v1[r] = key2f(top[0][r] & ~127); v2[r] = key2f(top[1][r] & ~127); mine[r] = top[0][r]; mine[16 + r] = top[1][r]; }
        int cnt = 0;
#pragma unroll
        for (int i = 0; i < 16; ++i)
#pragma unroll
            for (int j = 0; j < 16; ++j) if ((i + 1) * (j + 1) <= 16) { const int key = (f2key(v1[i] + v2[j]) & ~255) | (i << 4) | j;
                if (cnt < 16) c0[cnt] = key; else if (cnt < 32) c1[cnt - 16] = key; else if (cnt < 48) c2[cnt - 32] = key; else c3[cnt - 48] = key; ++cnt; }
#pragma unroll
        for (int r = 0; r < 16; ++r) if (48 + r >= cnt) c3[r] = (int)0x80000000;
    }
    top16_of_64(c0, c1, c2, c3);
    LDS_WAIT();
    if (hh == 0) {
        int ev[16]; float bv[16];
#pragma unroll
        for (int r = 0; r < 16; ++r) { const int id = c0[r] & 255; const int ka = mine[id >> 4], kb = mine[16 + (id & 15)];
            ev[r] = (ka & 127) * 128 + (kb & 127); bv[r] = (key2f(ka & ~127) - 8.0f) + (key2f(kb & ~127) - 8.0f); }
        unsigned short* ep = EXPERTS + (size_t)tok * 128 + h * 16; float* bp = BEST + (size_t)tok * 128 + h * 16;
#pragma unroll
        for (int r = 0; r < 16; r += 8) *(GAS v4u*)(ep + r) = (v4u){(unsigned)ev[r] | ((unsigned)ev[r + 1] << 16), (unsigned)ev[r + 2] | ((unsigned)ev[r + 3] << 16), (unsigned)ev[r + 4] | ((unsigned)ev[r + 5] << 16), (unsigned)ev[r + 6] | ((unsigned)ev[r + 7] << 16)};
#pragma unroll
        for (int r = 0; r < 16; r += 4) *(GAS f32x4*)(bp + r) = (f32x4){bv[r], bv[r + 1], bv[r + 2], bv[r + 3]};
    }
    LDS_WAIT();
}

__device__ __forceinline__ float gelu_erf(float x) { return 0.5f * x * (1.0f + erff(x * 0.70710678118654752f)); }
#define PEER_BL(rs, e_, c_) __builtin_amdgcn_raw_buffer_load_b128(rs, (int)(((e_) << 7) + (c_)), 0, 0)
#define PEER_ROWS(r, rs, c_, q) do { const v4u _ev = *(const LAS v4u*)(evp + 16 * (q)); \
        r[0] = PEER_BL(rs, _ev.x & 0xffffu, c_); r[1] = PEER_BL(rs, _ev.x >> 16, c_); r[2] = PEER_BL(rs, _ev.y & 0xffffu, c_); r[3] = PEER_BL(rs, _ev.y >> 16, c_); \
        r[4] = PEER_BL(rs, _ev.z & 0xffffu, c_); r[5] = PEER_BL(rs, _ev.z >> 16, c_); r[6] = PEER_BL(rs, _ev.w & 0xffffu, c_); r[7] = PEER_BL(rs, _ev.w >> 16, c_); } while (0)
__device__ __forceinline__ void peer_u_phase(LAS unsigned char* lds, const bf16* X1B, const unsigned char* U8, const unsigned short* EXP16, float* PD, int j, int w, int nw, int wave, int lane) {
    const int grp = lane >> 3, sub = lane & 7;
    LAS unsigned char* wl = lds + wave * 8192;
    const LAS unsigned char* evp = wl + grp * 256;
    const int stride = nw * NWAVES * 8;
    int tb = (w * NWAVES + wave) * 8;
    v4u pe0 = {0u, 0u, 0u, 0u}, pe1 = {0u, 0u, 0u, 0u};
    v4u px0 = {0u, 0u, 0u, 0u}, px1 = {0u, 0u, 0u, 0u};
    if (tb < T) { const GAS v4u* e = (const GAS v4u*)(EXP16 + (size_t)tb * 128) + lane; pe0 = e[0]; pe1 = e[64];
        const GAS v4u* xp = (const GAS v4u*)(X1B + (size_t)(tb + grp) * D + 128 * j + 16 * sub); px0 = xp[0]; px1 = xp[1]; }
    const __amdgpu_buffer_rsrc_t urs = __builtin_amdgcn_make_buffer_rsrc((void*)U8, (short)0, NEXP * D, 0x00020000); const unsigned uc = (unsigned)j * (NEXP * 128u) + 16u * sub;
    for (; tb < T; tb += stride) {
        *(LAS v4u*)(wl + 16 * lane) = pe0; *(LAS v4u*)(wl + 1024 + 16 * lane) = pe1;
        const v4u xa = px0, xc = px1;
        if (tb + stride < T) { const GAS v4u* e = (const GAS v4u*)(EXP16 + (size_t)(tb + stride) * 128) + lane; pe0 = e[0]; pe1 = e[64];
            const GAS v4u* xp = (const GAS v4u*)(X1B + (size_t)(tb + stride + grp) * D + 128 * j + 16 * sub); px0 = xp[0]; px1 = xp[1]; }
        const int t = tb + grp;
        const f32x4 x0 = {bf_lo(xa.x), bf_hi(xa.x), bf_lo(xa.y), bf_hi(xa.y)}, x1 = {bf_lo(xa.z), bf_hi(xa.z), bf_lo(xa.w), bf_hi(xa.w)};
        const f32x4 x2 = {bf_lo(xc.x), bf_hi(xc.x), bf_lo(xc.y), bf_hi(xc.y)}, x3 = {bf_lo(xc.z), bf_hi(xc.z), bf_lo(xc.w), bf_hi(xc.w)};
        float amax = fmaxf(fmaxf(fmaxf(fabsf(x0.x), fabsf(x0.y)), fmaxf(fabsf(x0.z), fabsf(x0.w))), fmaxf(fmaxf(fabsf(x1.x), fabsf(x1.y)), fmaxf(fabsf(x1.z), fabsf(x1.w))));
        amax = fmaxf(amax, fmaxf(fmaxf(fmaxf(fabsf(x2.x), fabsf(x2.y)), fmaxf(fabsf(x2.z), fabsf(x2.w))), fmaxf(fmaxf(fabsf(x3.x), fabsf(x3.y)), fmaxf(fabsf(x3.z), fabsf(x3.w)))));
        amax = fmaxf(amax, __shfl_xor(amax, 1)); amax = fmaxf(amax, __shfl_xor(amax, 2)); amax = fmaxf(amax, __shfl_xor(amax, 4));
        const float inv = amax > 0.f ? 127.0f / amax : 0.f, sx = amax * (1.0f / 127.0f);
        const unsigned xq0 = pack_i8x4(x0.x * inv, x0.y * inv, x0.z * inv, x0.w * inv), xq1 = pack_i8x4(x1.x * inv, x1.y * inv, x1.z * inv, x1.w * inv);
        const unsigned xq2 = pack_i8x4(x2.x * inv, x2.y * inv, x2.z * inv, x2.w * inv), xq3 = pack_i8x4(x3.x * inv, x3.y * inv, x3.z * inv, x3.w * inv);
        _Float16* pd = (_Float16*)PD + ((size_t)j * T + t) * 128 + sub;
        LDS_WAIT();
        v4u ra[8], rb[8], rc[8];
        PEER_ROWS(ra, urs, uc, 0); PEER_ROWS(rb, urs, uc, 1);
#define PEER_UDOT(r, q) do { int p[8]; _Pragma("unroll") for (int i = 0; i < 8; ++i) { int a = __builtin_amdgcn_sdot4((int)r[i].x, (int)xq0, 0, false); a = __builtin_amdgcn_sdot4((int)r[i].y, (int)xq1, a, false); \
                a = __builtin_amdgcn_sdot4((int)r[i].z, (int)xq2, a, false); p[i] = __builtin_amdgcn_sdot4((int)r[i].w, (int)xq3, a, false); } \
            _Pragma("unroll") for (int o = 4; o > 0; o >>= 1) { const bool up = (sub & o) != 0; \
                _Pragma("unroll") for (int i = 0; i < o; ++i) { const int keep = up ? p[i + o] : p[i], send = up ? p[i] : p[i + o]; p[i] = keep + __shfl_xor(send, o); } } \
            pd[8 * (q)] = (_Float16)((float)p[0] * sx); } while (0)
        for (int q = 0; q < 15; q += 3) {
            PEER_ROWS(rc, urs, uc, q + 2); PEER_UDOT(ra, q);
            PEER_ROWS(ra, urs, uc, q + 3); PEER_UDOT(rb, q + 1);
            if (q + 4 < 16) PEER_ROWS(rb, urs, uc, q + 4);
            PEER_UDOT(rc, q + 2);
        }
        PEER_UDOT(ra, 15);
    }
}
__device__ __forceinline__ void peer_combine4(const float* PD, const unsigned short* EXP16, const float* BEST, const float* SS2, const float* su, const float* sv, unsigned char* CC8, float* SCC, int t0, int lane) {
    typedef float f32x2v __attribute__((ext_vector_type(2)));
    f32x4 ssv[4][4]; unsigned ev[4]; f32x2v bv[4]; f32x2v pdv[4][8];
#pragma unroll
    for (int i = 0; i < 4; ++i) { const int t = t0 + i;
        const GAS f32x4* sp = (const GAS f32x4*)(SS2 + (size_t)t * 16);
#pragma unroll
        for (int q = 0; q < 4; ++q) ssv[i][q] = sp[q];
        ev[i] = ((const GAS unsigned*)(EXP16 + (size_t)t * 128))[lane];
        bv[i] = ((const GAS f32x2v*)(BEST + (size_t)t * 128))[lane];
#pragma unroll
        for (int j = 0; j < 8; ++j) { typedef _Float16 h2v __attribute__((ext_vector_type(2))); const h2v hv = ((const GAS h2v*)((const _Float16*)PD + ((size_t)j * T + t) * 128))[lane]; pdv[i][j] = (f32x2v){(float)hv.x, (float)hv.y}; } }
    float suv[4][2], svv[4][2];
#pragma unroll
    for (int i = 0; i < 4; ++i) { const unsigned e0 = ev[i] & 0xffffu, e1 = ev[i] >> 16; suv[i][0] = su[e0]; suv[i][1] = su[e1]; svv[i][0] = sv[e0]; svv[i][1] = sv[e1]; }
#pragma unroll
    for (int i = 0; i < 4; ++i) { const int t = t0 + i;
        float ssq = 0.f;
#pragma unroll
        for (int q = 0; q < 4; ++q) ssq += (ssv[i][q].x + ssv[i][q].y) + (ssv[i][q].z + ssv[i][q].w);
        const float rstd2 = 1.0f / sqrtf(ssq * (1.0f / D) + EPS);
        const float s0 = bv[i].x * rstd2, s1 = bv[i].y * rstd2;
        float mx = fmaxf(s0, s1);
#pragma unroll
        for (int o = 1; o < 8; o <<= 1) mx = fmaxf(mx, __shfl_xor(mx, o));
        const float e0 = __expf(s0 - mx), e1 = __expf(s1 - mx); float sm = e0 + e1;
#pragma unroll
        for (int o = 1; o < 8; o <<= 1) sm += __shfl_xor(sm, o);
        float d0 = 0.f, d1 = 0.f;
#pragma unroll
        for (int j = 0; j < 8; ++j) { d0 += pdv[i][j].x; d1 += pdv[i][j].y; }
        const float inv_sm = 1.0f / sm;
        const float c0 = e0 * inv_sm * gelu_erf(d0 * rstd2 * suv[i][0]) * svv[i][0], c1 = e1 * inv_sm * gelu_erf(d1 * rstd2 * suv[i][1]) * svv[i][1];
        float amax = fmaxf(fabsf(c0), fabsf(c1));
#pragma unroll
        for (int o = 1; o < 64; o <<= 1) amax = fmaxf(amax, __shfl_xor(amax, o));
        const float inv = amax > 0.f ? 127.0f / amax : 0.f;
        ((GAS unsigned short*)(CC8 + (size_t)t * 128))[lane] = (unsigned short)((__float2int_rn(c0 * inv) & 0xff) | ((__float2int_rn(c1 * inv) & 0xff) << 8));
        if (lane == 0) SCC[t] = amax * (1.0f / 127.0f); }
}
__device__ __forceinline__ void peer_v_phase(LAS unsigned char* lds, float* OUT, const bf16* X1B, const unsigned char* V8, const unsigned short* EXP16, const unsigned char* CC8, const float* SCC, int j, int w, int nw, int wave, int lane) {
    const int grp = lane >> 3, sub = lane & 7;
    LAS unsigned char* wl = lds + wave * 8192;
    const LAS unsigned char* evp = wl + grp * 256;
    const LAS unsigned char* ccp = wl + 2048 + grp * 128;
    const int stride = nw * NWAVES * 8;
    int tb = (w * NWAVES + wave) * 8;
    v4u pe0 = {0u, 0u, 0u, 0u}, pe1 = {0u, 0u, 0u, 0u}, pc0 = {0u, 0u, 0u, 0u};
    if (tb < T) { const GAS v4u* e = (const GAS v4u*)(EXP16 + (size_t)tb * 128) + lane; pe0 = e[0]; pe1 = e[64]; pc0 = ((const GAS v4u*)(CC8 + (size_t)tb * 128))[lane]; }
    const __amdgpu_buffer_rsrc_t vrs = __builtin_amdgcn_make_buffer_rsrc((void*)V8, (short)0, NEXP * D, 0x00020000); const unsigned vc = (unsigned)j * (NEXP * 128u) + 16u * sub;
    for (; tb < T; tb += stride) {
        *(LAS v4u*)(wl + 16 * lane) = pe0; *(LAS v4u*)(wl + 1024 + 16 * lane) = pe1; *(LAS v4u*)(wl + 2048 + 16 * lane) = pc0;
        if (tb + stride < T) { const GAS v4u* e = (const GAS v4u*)(EXP16 + (size_t)(tb + stride) * 128) + lane; pe0 = e[0]; pe1 = e[64]; pc0 = ((const GAS v4u*)(CC8 + (size_t)(tb + stride) * 128))[lane]; }
        const int t = tb + grp;
        const float scc = SCC[t];
        const size_t eo = (size_t)t * D + 128 * j + 16 * sub;
        const GAS v4u* dp = (const GAS v4u*)(X1B + eo);
        const v4u da = dp[0], db = dp[1];
        int acc[16];
#pragma unroll
        for (int i = 0; i < 16; ++i) acc[i] = 0;
        LDS_WAIT();
        v4u rq[4][4];
#define PEER_LOADQ(r, qn) do { const unsigned long long _e4 = *(const LAS unsigned long long*)(evp + 8 * (qn)); const unsigned _lo = (unsigned)_e4, _hi = (unsigned)(_e4 >> 32); \
            r[0] = PEER_BL(vrs, _lo & 0xffffu, vc); r[1] = PEER_BL(vrs, _lo >> 16, vc); r[2] = PEER_BL(vrs, _hi & 0xffffu, vc); r[3] = PEER_BL(vrs, _hi >> 16, vc); } while (0)
#define PEER_T4(w_, r0, r1, r2, r3, cpk) do { const unsigned tl0 = __builtin_amdgcn_perm(r1, r0, 0x05010400u), th0 = __builtin_amdgcn_perm(r1, r0, 0x07030602u); \
            const unsigned tl1 = __builtin_amdgcn_perm(r3, r2, 0x05010400u), th1 = __builtin_amdgcn_perm(r3, r2, 0x07030602u); \
            acc[4 * (w_) + 0] = __builtin_amdgcn_sdot4((int)__builtin_amdgcn_perm(tl1, tl0, 0x05040100u), (int)(cpk), acc[4 * (w_) + 0], false); \
            acc[4 * (w_) + 1] = __builtin_amdgcn_sdot4((int)__builtin_amdgcn_perm(tl1, tl0, 0x07060302u), (int)(cpk), acc[4 * (w_) + 1], false); \
            acc[4 * (w_) + 2] = __builtin_amdgcn_sdot4((int)__builtin_amdgcn_perm(th1, th0, 0x05040100u), (int)(cpk), acc[4 * (w_) + 2], false); \
            acc[4 * (w_) + 3] = __builtin_amdgcn_sdot4((int)__builtin_amdgcn_perm(th1, th0, 0x07060302u), (int)(cpk), acc[4 * (w_) + 3], false); } while (0)
#define PEER_COMPQ(r, qn) do { const unsigned _c = *(const LAS unsigned*)(ccp + 4 * (qn)); \
            PEER_T4(0, r[0].x, r[1].x, r[2].x, r[3].x, _c); PEER_T4(1, r[0].y, r[1].y, r[2].y, r[3].y, _c); PEER_T4(2, r[0].z, r[1].z, r[2].z, r[3].z, _c); PEER_T4(3, r[0].w, r[1].w, r[2].w, r[3].w, _c); } while (0)
#pragma unroll
        for (int jq = 0; jq < 4; ++jq) PEER_LOADQ(rq[jq], jq);
        for (int it = 0; it < 8; ++it) {
#pragma unroll
            for (int jq = 0; jq < 4; ++jq) { PEER_COMPQ(rq[jq], 4 * it + jq); if (it < 7) PEER_LOADQ(rq[jq], 4 * it + 4 + jq); }
        }
        GAS f32x4* op = (GAS f32x4*)(OUT + eo);
        const float dl[16] = {bf_lo(da.x), bf_hi(da.x), bf_lo(da.y), bf_hi(da.y), bf_lo(da.z), bf_hi(da.z), bf_lo(da.w), bf_hi(da.w), bf_lo(db.x), bf_hi(db.x), bf_lo(db.y), bf_hi(db.y), bf_lo(db.z), bf_hi(db.z), bf_lo(db.w), bf_hi(db.w)};
#pragma unroll
        for (int q = 0; q < 4; ++q) { f32x4 v; v.x = dl[4 * q + 0] + scc * (float)acc[4 * q + 0]; v.y = dl[4 * q + 1] + scc * (float)acc[4 * q + 1]; v.z = dl[4 * q + 2] + scc * (float)acc[4 * q + 2]; v.w = dl[4 * q + 3] + scc * (float)acc[4 * q + 3]; op[q] = v; }
    }
}
struct Args { const float* in[15]; float* out; unsigned char* ws; int ph_lo, ph_hi, li, pad; };
__global__ void __launch_bounds__(NWAVES * 64, 2) fwd_kernel(Args args) {
    extern __shared__ __attribute__((aligned(16))) unsigned char lds_raw[];
    LAS unsigned char* lds = (LAS unsigned char*)lds_raw;
    volatile LAS unsigned* MISC = (volatile LAS unsigned*)(lds + MISC_OFF);
    const int tid = threadIdx.x, lane = tid & 63, wave = __builtin_amdgcn_readfirstlane(tid >> 6);
    const int G = gridDim.x, bx = blockIdx.x;
    unsigned char* ws = args.ws;
    gu32* ctl = (gu32*)(ws + WS_CTL);
    for (int u = tid; u < (LDS_BYTES - LDSCTL_OFF) / 4; u += NWAVES * 64) ((LAS unsigned*)(lds + LDSCTL_OFF))[u] = 0u;
    __syncthreads();
    XcdBarrier bar; bar.bar = (unsigned*)(ctl + CW_BAR); bar.x = 0; bar.st = nullptr;
    if (N_LAUNCHES != PER_PHASE) bar = xcd_barrier_post((unsigned*)(ctl + CW_BAR) + args.li * XCD_BAR_WORDS, MISC + 8);
#define GRID_BAR() do { if (N_LAUNCHES != PER_PHASE) xcd_barrier(bar); } while (0)
    const int lo = args.ph_lo, hi = args.ph_hi;
#define IN(k) (lo <= (k) && (k) < hi)
#define BOTH(k) (IN(k) && IN((k) + 1))
#ifndef MK_REPEAT
#define MK_REPEAT -1
#endif
#define REP(k) for (int _r = 0; _r < ((MK_REPEAT == (k)) ? 2 : 1); ++_r)

    const float* x = args.in[0]; float* out = args.out;
    bf16* XB = (bf16*)(ws + WS_XB); bf16* WinT = (bf16*)(ws + WS_WIN); bf16* WoutT = (bf16*)(ws + WS_WOUT); bf16* WqT = (bf16*)(ws + WS_WQ);
    bf16* SK = (bf16*)(ws + WS_SK); bf16* PoolT = (bf16*)(ws + WS_POOLT); unsigned char* U8 = ws + WS_U8; unsigned char* V8 = ws + WS_V8; float* SU = (float*)(ws + WS_SU); float* SV = (float*)(ws + WS_SV);
    bf16* Y = (bf16*)(ws + WS_Y); bf16* AB = (bf16*)(ws + WS_AB); bf16* X1B = (bf16*)(ws + WS_X1B); bf16* QP = (bf16*)(ws + WS_QP);
    float* rstd1 = (float*)(ws + WS_RSTD1); float* SS2 = (float*)(ws + WS_SS2); unsigned short* EXPERTS = (unsigned short*)(ws + WS_EXP); float* BEST = (float*)(ws + WS_BEST);
    float* PD = (float*)(ws + WS_PD); bf16* DELTA = (bf16*)(ws + WS_DELTA); unsigned char* CC8 = ws + WS_CC; float* SCC = (float*)(ws + WS_SCC);
    const int gw = bx * NWAVES + wave, NGW = G * NWAVES;

    const P0Args p0a{x, args.in[1], args.in[2], args.in[7], args.in[9], args.in[10], args.in[11], args.in[12], args.in[13], args.in[14], XB, WinT, WoutT, WqT, SK, PoolT, U8, V8, SU, SV, rstd1};
    if (IN(0)) REP(0) {
        p0_prologue(p0a, lds, gw, NGW, wave, lane);
        if (BOTH(0)) GRID_BAR();
    }
    if (IN(1)) REP(1) {
        pg8::Gemm g{XB, WinT, T, DIN, D}; pg8::StaticOrder S; S.init(T, DIN, G, bx);
        pg8::EpiScaleBf16 E{Y, DIN, rstd1};
        pg8::gemm_phase<pg8::EpiScaleBf16, pg8::StaticOrder, true, true>(lds + RING_OFF, g, S, E);
        { const int nwg1 = (T / 256) * (DIN / 256), rem = nwg1 % G;
          if (rem == 0) p1_late_weights(p0a, lds, gw, NGW, wave, lane); else if (bx >= rem) p1_late_weights(p0a, lds, (bx - rem) * NWAVES + wave, (G - rem) * NWAVES, wave, lane); }
        if (BOTH(1)) GRID_BAR();
    }
    if (IN(2)) REP(2) {
        for (int u = bx; u < NB * 128 * 2; u += G) attn_unit(lds, Y, AB, args.in[3], args.in[4], args.in[5], args.in[6], u, tid, wave, lane);
        for (int u = bx; u < T / 128; u += G) pool_rows(Y, AB, args.in[8], u, tid);
        if (BOTH(2)) GRID_BAR();
    }
    if (IN(3)) REP(3) {
        pg8::Gemm g{AB, WoutT, T, D, D}; pg8::StaticOrder S; S.init(T, D, G, bx);
        pg8::EpiResid E{XB, X1B, SS2, D};
        pg8::gemm_phase<pg8::EpiResid, pg8::StaticOrder, true, true>(lds + RING_OFF, g, S, E);
        if (BOTH(3)) GRID_BAR();
    }
    if (IN(4)) REP(4) {
        pg8::Gemm g{X1B, WqT, T, DQ, D}; pg8::StaticOrder S; S.init(T, DQ, G, bx);
        pg8::EpiScaleBf16 E{QP, DQ, nullptr};
        pg8::gemm_phase<pg8::EpiScaleBf16, pg8::StaticOrder, true, true>(lds + RING_OFF, g, S, E);
        if (BOTH(4)) GRID_BAR();
    }
    if (IN(5)) REP(5) {
        { int hs = -1; for (int u = bx; u < (T / 256) * 8; u += G) { if ((u & 7) != hs) { if (hs >= 0) __syncthreads(); hs = u & 7; topk_stage_keys(lds, SK, hs, tid); } topk_unit(lds, QP, SK, EXPERTS, BEST, u, tid, wave, lane); } }
        if (BOTH(5)) GRID_BAR();
    }
    if (IN(6)) REP(6) {
        if ((G & 7) == 0) peer_u_phase(lds, X1B, U8, EXPERTS, PD, bx & 7, bx >> 3, G >> 3, wave, lane);
        else for (int j = 0; j < 8; ++j) peer_u_phase(lds, X1B, U8, EXPERTS, PD, j, bx, G, wave, lane);
        if (BOTH(6)) GRID_BAR();
    }
    if (IN(7)) REP(7) {
        for (int t0 = gw * 4; t0 < T; t0 += NGW * 4) peer_combine4(PD, EXPERTS, BEST, SS2, SU, SV, CC8, SCC, t0, lane);
        if (BOTH(7)) GRID_BAR();
    }
    if (IN(8)) {
        if ((G & 7) == 0) peer_v_phase(lds, out, X1B, V8, EXPERTS, CC8, SCC, bx & 7, bx >> 3, G >> 3, wave, lane);
        else for (int j = 0; j < 8; ++j) peer_v_phase(lds, out, X1B, V8, EXPERTS, CC8, SCC, j, bx, G, wave, lane);
    }
#undef IN
#undef BOTH
}

extern "C" void kernel_launch(void* const* d_in, const int* in_sizes, int n_in, void* d_out, int out_size, void* d_ws, size_t ws_size, hipStream_t stream) {
    static int grid = 0;
    if (grid == 0) {
        if (n_in != 15 || in_sizes[0] != T * D || out_size != T * D || ws_size < WS_END) { fprintf(stderr, "kernel_launch: unexpected shapes (n_in %d, in0 %d, out %d, ws %zu)\n", n_in, n_in > 0 ? in_sizes[0] : -1, out_size, ws_size); grid = -1; return; }
        int dev = 0, cus = 0, per_cu = 0;
        if (hipGetDevice(&dev) != hipSuccess || hipDeviceGetAttribute(&cus, hipDeviceAttributeMultiprocessorCount, dev) != hipSuccess) { grid = -1; return; }
        if (hipFuncSetAttribute((const void*)fwd_kernel, hipFuncAttributeMaxDynamicSharedMemorySize, LDS_BYTES) != hipSuccess) { fprintf(stderr, "kernel_launch: hipFuncSetAttribute failed\n"); grid = -1; return; }
        if (hipOccupancyMaxActiveBlocksPerMultiprocessor(&per_cu, (const void*)fwd_kernel, NWAVES * 64, LDS_BYTES) != hipSuccess || per_cu < 1) { fprintf(stderr, "kernel_launch: occupancy query reports %d blocks per CU\n", per_cu); }
        (void)hipGetLastError();
        grid = cus;
    }
    if (grid < 0) return;
    if (hipMemsetAsync((char*)d_ws + WS_CTL, 0, CTL_ZERO_BYTES, stream) != hipSuccess) return;
    Args a{};
    for (int i = 0; i < 15; ++i) a.in[i] = (const float*)d_in[i];
    a.out = (float*)d_out; a.ws = (unsigned char*)d_ws;
    for (int li = 0; li < N_LAUNCHES; ++li) {
        a.ph_lo = (N_LAUNCHES == PER_PHASE) ? li : 0; a.ph_hi = (N_LAUNCHES == PER_PHASE) ? li + 1 : PER_PHASE; a.li = (N_LAUNCHES == PER_PHASE) ? 0 : li;
        hipLaunchKernelGGL(fwd_kernel, dim3(grid), dim3(NWAVES * 64), LDS_BYTES, stream, a);
        const hipError_t le = hipPeekAtLastError();
        if (le != hipSuccess) { fprintf(stderr, "kernel_launch: launch %d failed: %s\n", li, hipGetErrorName(le)); break; }
    }
}
```

```cpp
#include <hip/hip_runtime.h>
#include <cstdio>
#include <cstdint>
namespace pg8 {
#define PG8_LAS __attribute__((address_space(3)))
typedef unsigned short bf16_t;
typedef short bf16x8 __attribute__((ext_vector_type(8)));
typedef float f32x4 __attribute__((ext_vector_type(4)));
typedef unsigned u32x4 __attribute__((ext_vector_type(4)));
constexpr int BM = 256, BK = 64, HALF = 128, HTB = HALF * BK * 2  , STAGE_BYTES = 8 * HTB, NXCD = 8, WGM = 8;

__host__ __device__ __forceinline__ int lds_byte(int r, int c) { const int st = (r >> 4) * 2 + (c >> 5), rr = r & 15, cc = c & 31, ob = rr * 64 + cc * 2; return st * 1024 + (ob ^ (((ob >> 9) & 1) << 5)); }
__host__ __device__ __forceinline__ void stage_rc(int b, int& R, int& C) { const int st = b / 1024, sb = b % 1024, swz = sb ^ (((sb >> 9) & 1) << 5); R = (st >> 1) * 16 + swz / 64; C = (st & 1) * 32 + (swz % 64) / 2; }
__host__ __device__ __forceinline__ int perm32(int rho) { const int n = rho >> 4, i = rho & 15; return 8 * (i >> 2) + 4 * n + (i & 3); }

struct Unit { int pm, pn; };
struct Gemm { const bf16_t* A; const bf16_t* Bt; int M, N, K; };

struct StaticOrder {
    int nM, nN, nwg, G, c;
    __host__ __device__ void init(int M, int N, int G_, int c_) { nM = M / BM; nN = N / BM; nwg = nM * nN; G = G_; c = c_; }
    __host__ __device__ bool next(int i, Unit& u) const {
        const long L = (long)i * G + c; if (L >= nwg) return false;
        int wgid = (int)L; { const int q = nwg / NXCD, r = nwg % NXCD, xcd = wgid % NXCD, off = wgid / NXCD; wgid = (xcd < r ? xcd * (q + 1) : r * (q + 1) + (xcd - r) * q) + off; }
        const int nig = WGM * nN, gid = wgid / nig, fm = gid * WGM, gsz = (nM - fm) < WGM ? (nM - fm) : WGM;
        u.pm = fm + ((wgid % nig) % gsz); u.pn = (wgid % nig) / gsz; return true;
    }
    __device__ __forceinline__ void a_ready(const Unit&) const {}
    __device__ __forceinline__ void done(const Unit&) const {}
};

__device__ __forceinline__ unsigned cvt_pk_bf16(float lo, float hi) { unsigned r; asm volatile("v_cvt_pk_bf16_f32 %0, %1, %2" : "=v"(r) : "v"(lo), "v"(hi)); return r; }
struct EpiScaleBf16 {
    static constexpr bool PERM = true, AFTER_DRAIN = false, PROBE_TWICE = false;
    bf16_t* O; int ldc; const float* rs;
    __device__ __forceinline__ void operator()(const f32x4 (&acc)[2][2][4][2], const Unit& u, int wr, int wc, int fr, int fq) const {
        const int row0 = u.pm * BM + wr * 64 + fr, col0 = u.pn * BM + wc * 32 + 8 * fq;
#pragma unroll
        for (int ai = 0; ai < 2; ++ai)
#pragma unroll
            for (int m = 0; m < 4; ++m) { const int row = row0 + ai * HALF + m * 16; const float s = rs ? rs[row] : 1.f; bf16_t* rowp = O + (size_t)row * ldc + col0;
#pragma unroll
                for (int bj = 0; bj < 2; ++bj) { const f32x4 v0 = acc[ai][bj][m][0] * s, v1 = acc[ai][bj][m][1] * s;
                    u32x4 w; w.x = cvt_pk_bf16(v0[0], v0[1]); w.y = cvt_pk_bf16(v0[2], v0[3]); w.z = cvt_pk_bf16(v1[0], v1[1]); w.w = cvt_pk_bf16(v1[2], v1[3]);
                    *(u32x4*)(rowp + bj * HALF) = w; } }
    }
};
struct EpiResid {
    static constexpr bool PERM = true, AFTER_DRAIN = false, PROBE_TWICE = false;
    const bf16_t* xbf; bf16_t* xb; float* ss; int ldc;
    __device__ __forceinline__ void operator()(const f32x4 (&acc)[2][2][4][2], const Unit& u, int wr, int wc, int fr, int fq) const {
        const int row0 = u.pm * BM + wr * 64 + fr, col0 = u.pn * BM + wc * 32 + 8 * fq;
#pragma unroll
        for (int ai = 0; ai < 2; ++ai)
#pragma unroll
            for (int m = 0; m < 4; ++m) { const int row = row0 + ai * HALF + m * 16; const size_t off = (size_t)row * ldc + col0; float q = 0.f;
#pragma unroll
                for (int bj = 0; bj < 2; ++bj) { const u32x4 xr = *(const u32x4*)(xbf + off + bj * HALF);
                    const f32x4 a0 = acc[ai][bj][m][0], a1 = acc[ai][bj][m][1];
                    f32x4 v0, v1;
                    v0[0] = a0[0] + __builtin_bit_cast(float, xr.x << 16); v0[1] = a0[1] + __builtin_bit_cast(float, xr.x & 0xffff0000u); v0[2] = a0[2] + __builtin_bit_cast(float, xr.y << 16); v0[3] = a0[3] + __builtin_bit_cast(float, xr.y & 0xffff0000u);
                    v1[0] = a1[0] + __builtin_bit_cast(float, xr.z << 16); v1[1] = a1[1] + __builtin_bit_cast(float, xr.z & 0xffff0000u); v1[2] = a1[2] + __builtin_bit_cast(float, xr.w << 16); v1[3] = a1[3] + __builtin_bit_cast(float, xr.w & 0xffff0000u);
                    u32x4 w; w.x = cvt_pk_bf16(v0[0], v0[1]); w.y = cvt_pk_bf16(v0[2], v0[3]); w.z = cvt_pk_bf16(v1[0], v1[1]); w.w = cvt_pk_bf16(v1[2], v1[3]);
                    *(u32x4*)(xb + off + bj * HALF) = w;
                    q += (v0[0] * v0[0] + v0[1] * v0[1]) + (v0[2] * v0[2] + v0[3] * v0[3]) + (v1[0] * v1[0] + v1[1] * v1[1]) + (v1[2] * v1[2] + v1[3] * v1[3]); }
                q += __shfl_xor(q, 16); q += __shfl_xor(q, 32);
                if (fq == 0) ss[(size_t)row * 16 + u.pn * 4 + wc] = q; }
    }
};
template <class Epi, class Sched, bool ALIGN_EPI = false, bool SP2 = false>
__device__ __forceinline__ void gemm_phase(PG8_LAS unsigned char* lds, const Gemm g, const Sched& S, const Epi& E) {
    const int tid = threadIdx.x, wid = __builtin_amdgcn_readfirstlane(tid >> 6), lane = tid & 63, wr = wid >> 2, wc = wid & 3, fr = lane & 15, fq = lane >> 4;
    const int K = g.K, nt = K / BK;
    unsigned voffA[2], voffB[2];
#pragma unroll
    for (int i = 0; i < 2; ++i) { int R, C; stage_rc(tid * 16 + i * 8192, R, C); const int Rb = Epi::PERM ? ((R & ~31) + perm32(R & 31)) : R;
        voffA[i] = (unsigned)(R * K + C) * 2u; voffB[i] = (unsigned)(Rb * K + C) * 2u; }
    const size_t kstep = (size_t)(BK * 2);
    const size_t hstep = (size_t)HALF * K * 2;
    const size_t tstep = 2 * hstep;
    const unsigned ldsw = (unsigned)wid * 1024u;
    const int aoff = lds_byte(wr * 64 + fr, fq * 8), boff = lds_byte(wc * 32 + fr, fq * 8);
#define PG8_SA(b, h) (((b) * 2 + (h)) * HTB)
#define PG8_SB(b, h) ((4 + (b) * 2 + (h)) * HTB)
#define PG8_STAGE(bufoff, gbase, voff) do { _Pragma("unroll") for (int _i = 0; _i < 2; ++_i) \
        __builtin_amdgcn_global_load_lds((const unsigned*)((const char*)(gbase) + (voff)[_i]), (PG8_LAS unsigned*)(lds + (bufoff) + ldsw + _i * 8192), 16, 0, 0); } while (0)
#define PG8_LDA(dst, b, h) do { _Pragma("unroll") for (int m = 0; m < 4; ++m) _Pragma("unroll") for (int k = 0; k < 2; ++k) dst[m][k] = *(const PG8_LAS bf16x8*)(lds + PG8_SA(b, h) + aoff + m * 2048 + k * 1024); } while (0)
#define PG8_LDB(dst, b, h) do { _Pragma("unroll") for (int n = 0; n < 2; ++n) _Pragma("unroll") for (int k = 0; k < 2; ++k) dst[n][k] = *(const PG8_LAS bf16x8*)(lds + PG8_SB(b, h) + boff + n * 2048 + k * 1024); } while (0)
#define PG8_MMA(ai, bj, At, Bt) do { __builtin_amdgcn_s_setprio(1); _Pragma("unroll") for (int m = 0; m < 4; ++m) _Pragma("unroll") for (int n = 0; n < 2; ++n) _Pragma("unroll") for (int k = 0; k < 2; ++k) \
        acc[ai][bj][m][n] = __builtin_amdgcn_mfma_f32_16x16x32_bf16(Bt[n][k], At[m][k], acc[ai][bj][m][n], 0, 0, 0); __builtin_amdgcn_s_setprio(0); } while (0)
#define PG8_WAIT_V(n) asm volatile("s_waitcnt vmcnt(" #n ")" ::: "memory")
#define PG8_WAIT_L(n) asm volatile("s_waitcnt lgkmcnt(" #n ")" ::: "memory")
#define PG8_BAR __builtin_amdgcn_s_barrier()
#define PG8_SCHED __builtin_amdgcn_sched_barrier(0)
    Unit cur, nxt; int ui = 0;
    if (!S.next(0, cur)) return;
    f32x4 acc[2][2][4][2];
#pragma unroll
    for (int a = 0; a < 2; ++a)
#pragma unroll
        for (int b = 0; b < 2; ++b)
#pragma unroll
            for (int m = 0; m < 4; ++m)
#pragma unroll
                for (int n = 0; n < 2; ++n) acc[a][b][m][n] = (f32x4){0.f, 0.f, 0.f, 0.f};
    bf16x8 At[4][2], B0[2][2], B1[2][2];
    const char* cA = (const char*)g.A + (size_t)cur.pm * tstep; const char* cB = (const char*)g.Bt + (size_t)cur.pn * tstep;
    S.a_ready(cur);
    if constexpr (SP2) {
        PG8_STAGE(PG8_SB(0, 0), cB, voffB); PG8_STAGE(PG8_SB(0, 1), cB + hstep, voffB); PG8_STAGE(PG8_SA(0, 0), cA, voffA); PG8_STAGE(PG8_SA(0, 1), cA + hstep, voffA);
        if (wr == 1) PG8_BAR;
        PG8_WAIT_V(2); PG8_BAR;
        PG8_STAGE(PG8_SB(1, 0), cB + kstep, voffB); PG8_STAGE(PG8_SA(1, 0), cA + kstep, voffA); PG8_STAGE(PG8_SB(1, 1), cB + hstep + kstep, voffB);
        PG8_WAIT_V(6); PG8_BAR;
    } else {
        PG8_STAGE(PG8_SB(0, 0), cB, voffB); PG8_STAGE(PG8_SA(0, 0), cA, voffA); PG8_STAGE(PG8_SB(0, 1), cB + hstep, voffB); PG8_STAGE(PG8_SA(0, 1), cA + hstep, voffA);
        if (wr == 1) PG8_BAR;
        PG8_WAIT_V(4); PG8_BAR;
        PG8_STAGE(PG8_SB(1, 0), cB + kstep, voffB); PG8_STAGE(PG8_SA(1, 0), cA + kstep, voffA); PG8_STAGE(PG8_SB(1, 1), cB + hstep + kstep, voffB);
        PG8_WAIT_V(6); PG8_BAR;
    }
    for (;;) {
        const bool has_next = S.next(ui + 1, nxt);
        const char* nA = has_next ? (const char*)g.A + (size_t)nxt.pm * tstep : cA; const char* nB = has_next ? (const char*)g.Bt + (size_t)nxt.pn * tstep : cB;
        for (int t = 0; t < nt; t += 2) {
            const bool last = (t == nt - 2);
            const char* a1 = cA + (size_t)(t + 1) * kstep;
            const char* a2 = last ? nA : cA + (size_t)(t + 2) * kstep; const char* b2 = last ? nB : cB + (size_t)(t + 2) * kstep;
            const char* a3 = a2 + kstep; const char* b3 = b2 + kstep;
            if (last && has_next) S.a_ready(nxt);
            if constexpr (SP2) {
            PG8_LDB(B0, 0, 0); PG8_LDB(B1, 0, 1); PG8_SCHED; PG8_LDA(At, 0, 0); PG8_STAGE(PG8_SA(1, 1), a1 + hstep, voffA);
            PG8_WAIT_V(8); PG8_WAIT_L(0); PG8_BAR; PG8_MMA(0, 0, At, B0); PG8_MMA(0, 1, At, B1); PG8_BAR; PG8_SCHED;
            PG8_LDA(At, 0, 1); PG8_STAGE(PG8_SB(0, 0), b2, voffB); PG8_STAGE(PG8_SB(0, 1), b2 + hstep, voffB); PG8_STAGE(PG8_SA(0, 0), a2, voffA);
            PG8_WAIT_V(8); PG8_WAIT_L(0); PG8_BAR; PG8_MMA(1, 0, At, B0); PG8_MMA(1, 1, At, B1); PG8_BAR; PG8_SCHED;
            PG8_LDB(B0, 1, 0); PG8_LDB(B1, 1, 1); PG8_SCHED; PG8_LDA(At, 1, 0); PG8_STAGE(PG8_SA(0, 1), a2 + hstep, voffA);
            PG8_WAIT_V(8); PG8_WAIT_L(0); PG8_BAR; PG8_MMA(0, 0, At, B0); PG8_MMA(0, 1, At, B1); PG8_BAR; PG8_SCHED;
            PG8_LDA(At, 1, 1); PG8_STAGE(PG8_SB(1, 0), b3, voffB); PG8_STAGE(PG8_SB(1, 1), b3 + hstep, voffB); PG8_STAGE(PG8_SA(1, 0), a3, voffA);
            PG8_WAIT_V(8); PG8_WAIT_L(0); PG8_BAR; PG8_MMA(1, 0, At, B0); PG8_MMA(1, 1, At, B1); PG8_BAR; PG8_SCHED;
            } else {
            PG8_LDB(B0, 0, 0); PG8_SCHED; PG8_LDA(At, 0, 0); PG8_STAGE(PG8_SA(1, 1), a1 + hstep, voffA);
            PG8_WAIT_L(8); PG8_BAR; PG8_WAIT_L(0); PG8_MMA(0, 0, At, B0); PG8_BAR; PG8_SCHED;
            PG8_LDB(B1, 0, 1); PG8_STAGE(PG8_SB(0, 0), b2, voffB);
            PG8_BAR; PG8_WAIT_L(0); PG8_MMA(0, 1, At, B1); PG8_BAR;
            PG8_LDA(At, 0, 1); PG8_STAGE(PG8_SA(0, 0), a2, voffA);
            PG8_BAR; PG8_WAIT_L(0); PG8_MMA(1, 0, At, B0); PG8_BAR; PG8_SCHED;
            PG8_STAGE(PG8_SB(0, 1), b2 + hstep, voffB);
            PG8_WAIT_V(6); PG8_BAR; PG8_MMA(1, 1, At, B1); PG8_BAR;
            PG8_LDB(B0, 1, 0); PG8_SCHED; PG8_LDA(At, 1, 0); PG8_STAGE(PG8_SA(0, 1), a2 + hstep, voffA);
            PG8_WAIT_L(8); PG8_BAR; PG8_WAIT_L(0); PG8_MMA(0, 0, At, B0); PG8_BAR; PG8_SCHED;
            PG8_LDB(B1, 1, 1); PG8_STAGE(PG8_SB(1, 0), b3, voffB);
            PG8_BAR; PG8_WAIT_L(0); PG8_MMA(0, 1, At, B1); PG8_BAR;
            PG8_LDA(At, 1, 1); PG8_STAGE(PG8_SA(1, 0), a3, voffA);
            PG8_BAR; PG8_WAIT_L(0); PG8_MMA(1, 0, At, B0); PG8_BAR; PG8_SCHED;
            PG8_STAGE(PG8_SB(1, 1), b3 + hstep, voffB);
            PG8_WAIT_V(6); PG8_BAR; PG8_MMA(1, 1, At, B1); PG8_BAR;
            }
        }
        if constexpr (ALIGN_EPI) { if (wr == 0) PG8_BAR; }
        if constexpr (!Epi::AFTER_DRAIN) { E(acc, cur, wr, wc, fr, fq);
#if defined(MK_EXTRA)
            if (Epi::PROBE_TWICE) { asm volatile("" ::: "memory"); E(acc, cur, wr, wc, fr, fq); }
#endif
            S.done(cur); }
        if (!has_next) break;
#pragma unroll
        for (int a = 0; a < 2; ++a)
#pragma unroll
            for (int b = 0; b < 2; ++b)
#pragma unroll
                for (int m = 0; m < 4; ++m)
#pragma unroll
                    for (int n = 0; n < 2; ++n) acc[a][b][m][n] = (f32x4){0.f, 0.f, 0.f, 0.f};
        cur = nxt; cA = nA; cB = nB; ++ui;
        if constexpr (ALIGN_EPI) { if (wr == 1) PG8_BAR; }
    }
    PG8_WAIT_V(0);
    if constexpr (!ALIGN_EPI) { if (wr == 0) PG8_BAR; }
    PG8_BAR;
    if constexpr (Epi::AFTER_DRAIN) { E.fused(acc, cur, wr, wc, fr, fq, lds, wid, lane); S.done(cur); }
#undef PG8_SA
#undef PG8_SB
#undef PG8_STAGE
#undef PG8_LDA
#undef PG8_LDB
#undef PG8_MMA
#undef PG8_WAIT_V
#undef PG8_WAIT_L
#undef PG8_BAR
#undef PG8_SCHED
}
}
constexpr int NWAVES = 8;
#ifndef MK_N_LAUNCHES
#define MK_N_LAUNCHES 1
#endif
constexpr int PER_PHASE = 9;
constexpr int N_LAUNCHES = MK_N_LAUNCHES;

constexpr int NB = 4, SEQ = 8192, T = NB * SEQ, D = 1024, DIN = 1280, NEXP = 16384, DQ = 2048;
constexpr float EPS = 1e-6f;

constexpr size_t MiB = 1u << 20;
constexpr size_t WS_CTL = 0, CTL_ZERO_BYTES = 1 * MiB;
constexpr size_t WS_WIN = 2 * MiB;
constexpr size_t WS_WOUT = 5 * MiB;
constexpr size_t WS_WQ = 7 * MiB;
constexpr size_t WS_SK = 11 * MiB;
constexpr size_t WS_POOLT = 11 * MiB + 512 * 1024;
constexpr size_t WS_RSTD1 = 12 * MiB;
constexpr size_t WS_SS2 = 13 * MiB;
constexpr size_t WS_SU = 15 * MiB;
constexpr size_t WS_SV = 15 * MiB + 256 * 1024;
constexpr size_t WS_EXP = 16 * MiB;
constexpr size_t WS_BEST = 24 * MiB;
constexpr size_t WS_CC = 40 * MiB;
constexpr size_t WS_SCC = 44 * MiB;
constexpr size_t WS_U8 = 56 * MiB;
constexpr size_t WS_V8 = 72 * MiB;
constexpr size_t WS_AB = 88 * MiB;
constexpr size_t WS_X1B = 152 * MiB;
constexpr size_t WS_PD = 216 * MiB;
constexpr size_t WS_DELTA = 360 * MiB;
constexpr size_t WS_XB = 216 * MiB;
constexpr size_t WS_Y = 280 * MiB;
constexpr size_t WS_QP = 216 * MiB;
constexpr size_t WS_END = 424 * MiB;
constexpr int CW_BAR = 4096;

constexpr int RING_OFF = 0, RING_BYTES = 131072;
constexpr int LDS_BYTES = 163840;
constexpr int LDSCTL_OFF = LDS_BYTES - 512, MISC_OFF = LDSCTL_OFF + 320;
constexpr int PHASE_LDS_MAX = LDSCTL_OFF;
#define GAS __attribute__((address_space(1)))
#define LAS __attribute__((address_space(3)))
typedef unsigned short bf16;
typedef unsigned v4u __attribute__((ext_vector_type(4)));
typedef float f32x4 __attribute__((ext_vector_type(4)));
typedef short bf16x8 __attribute__((ext_vector_type(8)));
typedef GAS unsigned gu32;
typedef GAS unsigned long long gu64;
#define RLX_AGENT __ATOMIC_RELAXED, __HIP_MEMORY_SCOPE_AGENT
#define LDS_WAIT() asm volatile("s_waitcnt lgkmcnt(0)" ::: "memory")
#define VM_WAIT() asm volatile("s_waitcnt vmcnt(0)" ::: "memory")
__device__ __forceinline__ unsigned long long rt() { return __builtin_amdgcn_s_memrealtime(); }
__device__ __forceinline__ unsigned f2bf(float f) { unsigned u = __builtin_bit_cast(unsigned, f); return (u + 0x7fffu + ((u >> 16) & 1u)) >> 16; }
__device__ __forceinline__ unsigned pk2(float lo, float hi) { return f2bf(lo) | (f2bf(hi) << 16); }
#define XB_TMO      128
#define XB_XCNT(j)  (256  + 64 * (j))
#define XB_XSUB(j)  (1280 + 64 * (j))
#define XB_XGEN(j)  (2304 + 64 * (j))
#define XB_TOP      3328
#define XB_TOPGEN   3392
#define XCD_BAR_WORDS 3456
#define XB_SPIN_CAP (1u << 18)

__device__ __forceinline__ unsigned xb_ld(unsigned* p)              { return __hip_atomic_load(p, __ATOMIC_RELAXED, __HIP_MEMORY_SCOPE_AGENT); }
__device__ __forceinline__ unsigned xb_add(unsigned* p, unsigned v) { return __hip_atomic_fetch_add(p, v, __ATOMIC_RELAXED, __HIP_MEMORY_SCOPE_AGENT); }
__device__ __forceinline__ unsigned xb_xcc_id() { return (unsigned)__builtin_amdgcn_s_getreg((3 << 11) | 20) & 0xFu; }
#define XB_SPIN(cond, bar) do { unsigned _sp = 0; while (cond) { __builtin_amdgcn_s_sleep(1); \
    if ((++_sp & 255u) == 0u) { if (xb_ld(&(bar)[XB_TMO])) break; if (_sp > XB_SPIN_CAP) { atomicAdd(&(bar)[XB_TMO], 1u); break; } } } } while (0)

struct XcdBarrier {
    unsigned* bar; unsigned x;
    volatile LAS unsigned* st;
};

__device__ __forceinline__ XcdBarrier xcd_barrier_post(unsigned* bar, volatile LAS unsigned* st) {
    XcdBarrier b; b.bar = bar; b.x = xb_xcc_id(); b.st = st;
    if (threadIdx.x == 0) (void)xb_add(&bar[XB_XCNT(b.x)], 1u);
    return b;
}
__device__ __forceinline__ void xcd_barrier_complete(unsigned* bar, unsigned x, unsigned& nloc, unsigned& nx) {
    const unsigned G = gridDim.x * gridDim.y * gridDim.z;
    unsigned sum, cnt, mine, sp = 0u;
    for (;;) {
        sum = 0u; cnt = 0u; mine = 0u;
#pragma unroll
        for (unsigned j = 0; j < 16; ++j) { const unsigned c = xb_ld(&bar[XB_XCNT(j)]); sum += c; cnt += (c > 0u) ? 1u : 0u; mine = (j == x) ? c : mine; }
        if (sum == G) break;
        __builtin_amdgcn_s_sleep(1);
        if ((++sp & 255u) == 0u) { if (xb_ld(&bar[XB_TMO])) break; if (sp > XB_SPIN_CAP) { atomicAdd(&bar[XB_TMO], 1u); break; } }
    }
    nloc = mine > 0u ? mine : 1u; nx = cnt > 0u ? cnt : 1u;
}

__device__ __forceinline__ void xcd_barrier(const XcdBarrier& b) {
    asm volatile("s_waitcnt vmcnt(0)" ::: "memory");
    __syncthreads();
    if (threadIdx.x == 0) {
        unsigned* bar = b.bar;
        __builtin_amdgcn_s_waitcnt(0);
        unsigned nloc = b.st[0], nx = b.st[1];
        if (nloc == 0u) { xcd_barrier_complete(bar, b.x, nloc, nx); b.st[0] = nloc; b.st[1] = nx; }
        const unsigned old = xb_add(&bar[XB_XSUB(b.x)], 1u);
        const unsigned gen = old / nloc;
        if (old + 1u == (gen + 1u) * nloc) {
            __builtin_amdgcn_fence(__ATOMIC_RELEASE, "agent");
            asm volatile("s_waitcnt vmcnt(0)" ::: "memory");
            const unsigned og = xb_add(&bar[XB_TOP], 1u);
            const unsigned tg = og / nx;
            if (og + 1u == (tg + 1u) * nx) xb_add(&bar[XB_TOPGEN], 1u);
            else XB_SPIN(xb_ld(&bar[XB_TOPGEN]) == tg, bar);
            __builtin_amdgcn_fence(__ATOMIC_ACQUIRE, "agent");
            xb_add(&bar[XB_XGEN(b.x)], 1u);
            asm volatile("s_waitcnt vmcnt(0)" ::: "memory");
        } else {
            XB_SPIN(xb_ld(&bar[XB_XGEN(b.x)]) == gen, bar);
            __builtin_amdgcn_fence(__ATOMIC_ACQUIRE, "agent");
            asm volatile("s_waitcnt vmcnt(0)" ::: "memory");
        }
    }
    __syncthreads();
}
typedef float f32x16 __attribute__((ext_vector_type(16)));
typedef __bf16 bf16x2_t __attribute__((ext_vector_type(2)));
#define MFMA32(a, b, c) __builtin_amdgcn_mfma_f32_32x32x16_bf16((a), (b), (c), 0, 0, 0)
__device__ __forceinline__ float bf_lo(unsigned u) { return __builtin_bit_cast(float, u << 16); }
__device__ __forceinline__ float bf_hi(unsigned u) { return __builtin_bit_cast(float, u & 0xffff0000u); }
__device__ __forceinline__ float dot2_bf16(unsigned w, unsigned x, float acc) { return __builtin_amdgcn_fdot2_f32_bf16(__builtin_bit_cast(bf16x2_t, w), __builtin_bit_cast(bf16x2_t, x), acc, false); }
__device__ __forceinline__ float wave_sum(float v) {
#pragma unroll
    for (int o = 1; o < 64; o <<= 1) v += __shfl_xor(v, o);
    return v;
}

__device__ __forceinline__ unsigned pack_i8x4(float a, float b, float c, float d) {
    return ((unsigned)__float2int_rn(a) & 0xffu) | (((unsigned)__float2int_rn(b) & 0xffu) << 8) | (((unsigned)__float2int_rn(c) & 0xffu) << 16) | (((unsigned)__float2int_rn(d) & 0xffu) << 24);
}

__device__ __forceinline__ void p0_transpose_item(const float* W, int K, int N, bf16* WT, const float* gk, LAS float* scr, int item, int lane) {
    const int nblk = N / 32, kb = item / nblk, nb = item % nblk, k0 = 64 * kb, n0 = 32 * nb;
    float wv[32];
#pragma unroll
    for (int i = 0; i < 32; ++i) wv[i] = W[(size_t)(k0 + 2 * i + (lane >> 5)) * N + n0 + (lane & 31)];
#pragma unroll
    for (int i = 0; i < 32; ++i) { const int kk = 2 * i + (lane >> 5); float w = wv[i]; if (gk) w *= gk[k0 + kk]; scr[kk * 33 + (lane & 31)] = w; }
    LDS_WAIT(); asm volatile("" ::: "memory");
    const int c = lane & 7;
#pragma unroll
    for (int j = 0; j < 4; ++j) { const int n = (lane >> 3) + 8 * j; const LAS float* s = scr + (8 * c) * 33 + n;
        v4u o; o.x = pk2(s[0 * 33], s[1 * 33]); o.y = pk2(s[2 * 33], s[3 * 33]); o.z = pk2(s[4 * 33], s[5 * 33]); o.w = pk2(s[6 * 33], s[7 * 33]);
        *(GAS v4u*)(WT + (size_t)(n0 + n) * K + k0 + 8 * c) = o; }
    LDS_WAIT(); asm volatile("" ::: "memory");
}
__device__ __forceinline__ float row_to_bf16(const float* src, bf16* dst, const float* g, int lane) {
    const GAS f32x4* xr = (const GAS f32x4*)src + lane; float s = 0.f;
    GAS unsigned long long* o8 = (GAS unsigned long long*)dst + lane;
#pragma unroll
    for (int j = 0; j < 4; ++j) { f32x4 v = xr[64 * j]; s += (v.x * v.x + v.y * v.y) + (v.z * v.z + v.w * v.w);
        if (g) { const f32x4 gv = ((const GAS f32x4*)g)[64 * j + lane]; v = v * gv; }
        o8[64 * j] = (unsigned long long)pk2(v.x, v.y) | ((unsigned long long)pk2(v.z, v.w) << 32); }
    return s;
}
__device__ __forceinline__ void row_to_i8(const float* src, unsigned char* dst, const float* g, float* sc, int m, int lane) {
    const GAS f32x4* xr = (const GAS f32x4*)src + lane; f32x4 v[4]; float amax = 0.f;
#pragma unroll
    for (int j = 0; j < 4; ++j) { v[j] = xr[64 * j]; if (g) { const f32x4 gv = ((const GAS f32x4*)g)[64 * j + lane]; v[j] = v[j] * gv; }
        amax = fmaxf(fmaxf(amax, fmaxf(fabsf(v[j].x), fabsf(v[j].y))), fmaxf(fabsf(v[j].z), fabsf(v[j].w))); }
#pragma unroll
    for (int o = 1; o < 64; o <<= 1) amax = fmaxf(amax, __shfl_xor(amax, o));
    const float inv = amax > 0.f ? 127.0f / amax : 0.f;
    GAS unsigned* o4 = (GAS unsigned*)dst + lane;
#pragma unroll
    for (int j = 0; j < 4; ++j) { const unsigned q0 = (unsigned)__float2int_rn(v[j].x * inv) & 0xffu, q1 = (unsigned)__float2int_rn(v[j].y * inv) & 0xffu, q2 = (unsigned)__float2int_rn(v[j].z * inv) & 0xffu, q3 = (unsigned)__float2int_rn(v[j].w * inv) & 0xffu;
        o4[64 * j] = q0 | (q1 << 8) | (q2 << 16) | (q3 << 24); }
    if (lane == 0) sc[m] = amax * (1.0f / 127.0f);
}
__device__ __forceinline__ void p0_poolfold_item(const float* w_in, const float* pool_w, const float* g1, bf16* WinT, int item, int lane) {
    const int kb = item & 15, nb = (item >> 4) & 15, g = item >> 8, k = 64 * kb + lane, n0 = 8 * nb;
    const GAS f32x4* wr = (const GAS f32x4*)(w_in + (size_t)k * DIN + 768 + 128 * g);
    const float* pw = pool_w + (size_t)g * 16384 + n0;
    float acc[8];
#pragma unroll
    for (int n = 0; n < 8; ++n) acc[n] = 0.f;
#pragma unroll 1
    for (int cb = 0; cb < 32; cb += 16) { f32x4 a[16];
#pragma unroll
        for (int c4 = 0; c4 < 16; ++c4) a[c4] = wr[cb + c4];
#pragma unroll
        for (int c4 = 0; c4 < 16; ++c4)
#pragma unroll
            for (int n = 0; n < 8; ++n) { const float* pp = pw + (4 * (cb + c4)) * 128 + n; acc[n] = fmaf(a[c4].x, pp[0], acc[n]); acc[n] = fmaf(a[c4].y, pp[128], acc[n]); acc[n] = fmaf(a[c4].z, pp[256], acc[n]); acc[n] = fmaf(a[c4].w, pp[384], acc[n]); } }
    const float gk = g1[k];
#pragma unroll
    for (int n = 0; n < 8; ++n) WinT[(size_t)(768 + 128 * g + n0 + n) * D + k] = (bf16)f2bf(acc[n] * gk);
}
struct P0Args { const float *x, *g1, *w_in, *pool_w, *w_out, *g2, *wq, *sk, *u, *v; bf16 *XB, *WinT, *WoutT, *WqT, *SK, *PoolT; unsigned char *U8, *V8; float *su, *sv; float* rstd1; };
__device__ __forceinline__ void p0_prologue(const P0Args& a, LAS unsigned char* lds, int gw, int NGW, int wave, int lane) {
    LAS float* scr = (LAS float*)(lds + RING_OFF + wave * 16384);
    constexpr int I_IN = (D / 64) * (768 / 32), I_P = 4 * 16 * 16;
    constexpr int NITEMS = I_P + I_IN;
    for (int it = gw; it < NITEMS; it += NGW) {
        int r = it;
        if (r < I_P) { p0_poolfold_item(a.w_in, a.pool_w, a.g1, a.WinT, r, lane); continue; } r -= I_P;
        { const int kb = r / 24, nb = r % 24; p0_transpose_item(a.w_in, D, DIN, a.WinT, a.g1, scr, kb * 40 + nb, lane); }
    }
    for (int m0 = gw; m0 < T; m0 += 4 * NGW) {
        f32x4 v[4][4];
#pragma unroll
        for (int r = 0; r < 4; ++r) { const int m = m0 + r * NGW < T ? m0 + r * NGW : m0; const GAS f32x4* xr = (const GAS f32x4*)(a.x + (size_t)m * D) + lane;
#pragma unroll
            for (int j = 0; j < 4; ++j) v[r][j] = xr[64 * j]; }
#pragma unroll
        for (int r = 0; r < 4; ++r) { const int m = m0 + r * NGW; if (m < T) {
            float s = 0.f; GAS unsigned long long* o8 = (GAS unsigned long long*)(a.XB + (size_t)m * D) + lane;
#pragma unroll
            for (int j = 0; j < 4; ++j) { const f32x4 w = v[r][j]; s += (w.x * w.x + w.y * w.y) + (w.z * w.z + w.w * w.w); o8[64 * j] = (unsigned long long)pk2(w.x, w.y) | ((unsigned long long)pk2(w.z, w.w) << 32); }
            s = wave_sum(s); if (lane == 0) a.rstd1[m] = 1.0f / sqrtf(s * (1.0f / D) + EPS); } }
    }
    for (int m0 = gw; m0 < 2 * NEXP; m0 += 4 * NGW) {
        f32x4 v[4][4];
#pragma unroll
        for (int r = 0; r < 4; ++r) { const int mm = m0 + r * NGW < 2 * NEXP ? m0 + r * NGW : m0; const bool isv = mm >= NEXP; const int m = isv ? mm - NEXP : mm;
            const GAS f32x4* xr = (const GAS f32x4*)((isv ? a.v : a.u) + (size_t)m * D) + lane;
#pragma unroll
            for (int j = 0; j < 4; ++j) v[r][j] = xr[64 * j]; }
#pragma unroll
        for (int r = 0; r < 4; ++r) { const int mm = m0 + r * NGW; if (mm < 2 * NEXP) { const bool isv = mm >= NEXP; const int m = isv ? mm - NEXP : mm;
            float amax = 0.f;
#pragma unroll
            for (int j = 0; j < 4; ++j) { if (!isv) { const f32x4 gv = ((const GAS f32x4*)a.g2)[64 * j + lane]; v[r][j] = v[r][j] * gv; }
                amax = fmaxf(fmaxf(amax, fmaxf(fabsf(v[r][j].x), fabsf(v[r][j].y))), fmaxf(fabsf(v[r][j].z), fabsf(v[r][j].w))); }
#pragma unroll
            for (int o = 1; o < 64; o <<= 1) amax = fmaxf(amax, __shfl_xor(amax, o));
            const float inv = amax > 0.f ? 127.0f / amax : 0.f;
            unsigned char* tb_ = (isv ? a.V8 : a.U8) + (size_t)m * 128 + ((4 * lane) & 127);
#pragma unroll
            for (int j = 0; j < 4; ++j) *(GAS unsigned*)(tb_ + (size_t)((4 * lane + 256 * j) >> 7) * ((size_t)NEXP * 128)) = pack_i8x4(v[r][j].x * inv, v[r][j].y * inv, v[r][j].z * inv, v[r][j].w * inv);
            if (lane == 0) (isv ? a.sv : a.su)[m] = amax * (1.0f / 127.0f); } }
    }
}
__device__ __forceinline__ void p1_late_weights(const P0Args& a, LAS unsigned char* lds, int gw, int NGW, int wave, int lane) {
    LAS float* scr = (LAS float*)(lds + RING_OFF + wave * 16384);
    constexpr int I_OUT = (D / 64) * (D / 32), I_Q = (D / 64) * (DQ / 32);
    for (int it = gw; it < I_OUT + I_Q; it += NGW) {
        if (it < I_OUT) p0_transpose_item(a.w_out, D, D, a.WoutT, nullptr, scr, it, lane);
        else p0_transpose_item(a.wq, D, DQ, a.WqT, a.g2, scr, it - I_OUT, lane);
    }
    for (int m = gw; m < 256; m += NGW) (void)row_to_bf16(a.sk + (size_t)m * D, a.SK + (size_t)m * D, nullptr, lane);
}

__device__ __forceinline__ int t5_bucket(int rel) {
    const int n = rel < 0 ? -rel : rel; const int base = rel > 0 ? 16 : 0;
    const int v = n < 8 ? n : (n < 12 ? 8 : (n < 16 ? 9 : (n < 23 ? 10 : (n < 32 ? 11 : (n < 46 ? 12 : (n < 64 ? 13 : (n < 91 ? 14 : 15)))))));
    return base + v;
}
__device__ __forceinline__ void attn_unit(LAS unsigned char* lds, const bf16* Y, bf16* AB, const float* qg, const float* kg, const float* sinks, const float* relb,
                                          int unit, int tid, int wave, int lane) {
    const int kvh = unit & 1, c = (unit >> 1) & 127, b = unit >> 8;
    LAS bf16* Ks = (LAS bf16*)lds;
    LAS bf16* Vt = (LAS bf16*)(lds + 27648);
    LAS float* bt = (LAS float*)(lds + 53248);
    const int row0 = b * SEQ + (c - 2) * 64;
#pragma unroll
    for (int rep = 0; rep < 3; ++rep) {
        const int it = tid + rep * 512, j = it >> 3, ch = it & 7;
        const bool valid = (c - 2 + (j >> 6)) >= 0;
        v4u kraw = {0u, 0u, 0u, 0u}, vraw = {0u, 0u, 0u, 0u};
        if (valid) { const bf16* rp = Y + (size_t)(row0 + j) * DIN; kraw = *(const GAS v4u*)(rp + 512 + 64 * kvh + 8 * ch); vraw = *(const GAS v4u*)(rp + 640 + 64 * kvh + 8 * ch); }
        float kf[8] = {bf_lo(kraw.x), bf_hi(kraw.x), bf_lo(kraw.y), bf_hi(kraw.y), bf_lo(kraw.z), bf_hi(kraw.z), bf_lo(kraw.w), bf_hi(kraw.w)};
        float ss = 0.f;
#pragma unroll
        for (int e = 0; e < 8; ++e) ss += kf[e] * kf[e];
        ss += __shfl_xor(ss, 1); ss += __shfl_xor(ss, 2); ss += __shfl_xor(ss, 4);
        const float r = 1.0f / sqrtf(ss * (1.0f / 64.0f) + EPS);
        const f32x4 g0 = *(const GAS f32x4*)(kg + 8 * ch), g1 = *(const GAS f32x4*)(kg + 8 * ch + 4);
        v4u ko; ko.x = pk2(kf[0] * r * g0.x, kf[1] * r * g0.y); ko.y = pk2(kf[2] * r * g0.z, kf[3] * r * g0.w); ko.z = pk2(kf[4] * r * g1.x, kf[5] * r * g1.y); ko.w = pk2(kf[6] * r * g1.z, kf[7] * r * g1.w);
        *(LAS v4u*)(Ks + j * 72 + 8 * ch) = ko;
        const int s16 = j >> 4, kk = j & 15, hh = (kk >> 2) & 1, jj = ((kk >> 3) << 2) | (kk & 3), pos = 16 * s16 + 8 * hh + jj;
        LAS bf16* vp = Vt + (8 * ch) * 200 + pos;
        vp[0 * 200] = (bf16)(vraw.x & 0xffffu); vp[1 * 200] = (bf16)(vraw.x >> 16); vp[2 * 200] = (bf16)(vraw.y & 0xffffu); vp[3 * 200] = (bf16)(vraw.y >> 16);
        vp[4 * 200] = (bf16)(vraw.z & 0xffffu); vp[5 * 200] = (bf16)(vraw.z >> 16); vp[6 * 200] = (bf16)(vraw.w & 0xffffu); vp[7 * 200] = (bf16)(vraw.w >> 16);
    }
#pragma unroll
    for (int rep = 0; rep < 2; ++rep) { const int it = tid + rep * 512, g = it >> 8, r = it & 255; bt[it] = relb[t5_bucket(r - 191) * 8 + kvh * 4 + g]; }
    LDS_WAIT(); __syncthreads();

    const int g = wave >> 1, i = 32 * (wave & 1) + (lane & 31), hh = lane >> 5, habs = kvh * 4 + g;
    const size_t qrow = (size_t)b * SEQ + (size_t)c * 64 + i;
    const bf16* qp = Y + qrow * DIN + habs * 64 + 8 * hh;
    v4u qraw[4]; float ss = 0.f;
#pragma unroll
    for (int s = 0; s < 4; ++s) { qraw[s] = *(const GAS v4u*)(qp + 16 * s);
        const float f0 = bf_lo(qraw[s].x), f1 = bf_hi(qraw[s].x), f2 = bf_lo(qraw[s].y), f3 = bf_hi(qraw[s].y), f4 = bf_lo(qraw[s].z), f5 = bf_hi(qraw[s].z), f6 = bf_lo(qraw[s].w), f7 = bf_hi(qraw[s].w);
        ss += (f0 * f0 + f1 * f1) + (f2 * f2 + f3 * f3) + (f4 * f4 + f5 * f5) + (f6 * f6 + f7 * f7); }
    ss += __shfl_xor(ss, 32);
    const float rq = 0.125f / sqrtf(ss * (1.0f / 64.0f) + EPS);
    bf16x8 qf[4];
#pragma unroll
    for (int s = 0; s < 4; ++s) { const f32x4 g0 = *(const GAS f32x4*)(qg + 16 * s + 8 * hh), g1 = *(const GAS f32x4*)(qg + 16 * s + 8 * hh + 4);
        v4u w; w.x = pk2(bf_lo(qraw[s].x) * rq * g0.x, bf_hi(qraw[s].x) * rq * g0.y); w.y = pk2(bf_lo(qraw[s].y) * rq * g0.z, bf_hi(qraw[s].y) * rq * g0.w);
        w.z = pk2(bf_lo(qraw[s].z) * rq * g1.x, bf_hi(qraw[s].z) * rq * g1.y); w.w = pk2(bf_lo(qraw[s].w) * rq * g1.z, bf_hi(qraw[s].w) * rq * g1.w);
        qf[s] = __builtin_bit_cast(bf16x8, w); }
    f32x16 sacc[6];
#pragma unroll
    for (int kt = 0; kt < 6; ++kt) {
#pragma unroll
        for (int r = 0; r < 16; ++r) sacc[kt][r] = 0.f;
#pragma unroll
        for (int s = 0; s < 4; ++s) { const bf16x8 a = *(const LAS bf16x8*)(Ks + (32 * kt + (lane & 31)) * 72 + 16 * s + 8 * hh); sacc[kt] = MFMA32(a, qf[s], sacc[kt]); }
    }
    const LAS float* btg = bt + g * 256 + 63 - i;
    float mx = -3.0e38f;
#pragma unroll
    for (int kt = 0; kt < 6; ++kt) { const bool masked = (c - 2 + (kt >> 1)) < 0;
#pragma unroll
        for (int r = 0; r < 16; ++r) { const int j = 32 * kt + (r & 3) + 8 * (r >> 2) + 4 * hh; float v = sacc[kt][r] + btg[j]; v = masked ? -1.0e30f : v; sacc[kt][r] = v; mx = fmaxf(mx, v); } }
    mx = fmaxf(mx, __shfl_xor(mx, 32));
    const float sink = sinks[habs], m = fmaxf(mx, sink);
    float sum = 0.f;
#pragma unroll
    for (int kt = 0; kt < 6; ++kt)
#pragma unroll
        for (int r = 0; r < 16; ++r) { const float p = __expf(sacc[kt][r] - m); sacc[kt][r] = p; sum += p; }
    sum += __shfl_xor(sum, 32);
    const float inv = 1.0f / (sum + __expf(sink - m));
    f32x16 oacc[2];
#pragma unroll
    for (int dt = 0; dt < 2; ++dt)
#pragma unroll
        for (int r = 0; r < 16; ++r) oacc[dt][r] = 0.f;
#pragma unroll
    for (int kt = 0; kt < 6; ++kt)
#pragma unroll
        for (int s2 = 0; s2 < 2; ++s2) {
            v4u w; w.x = pk2(sacc[kt][8 * s2 + 0], sacc[kt][8 * s2 + 1]); w.y = pk2(sacc[kt][8 * s2 + 2], sacc[kt][8 * s2 + 3]); w.z = pk2(sacc[kt][8 * s2 + 4], sacc[kt][8 * s2 + 5]); w.w = pk2(sacc[kt][8 * s2 + 6], sacc[kt][8 * s2 + 7]);
            const bf16x8 pb = __builtin_bit_cast(bf16x8, w);
#pragma unroll
            for (int dt = 0; dt < 2; ++dt) { const bf16x8 a = *(const LAS bf16x8*)(Vt + (32 * dt + (lane & 31)) * 200 + 32 * kt + 16 * s2 + 8 * hh); oacc[dt] = MFMA32(a, pb, oacc[dt]); }
        }
    bf16* op = AB + qrow * D + habs * 64;
#pragma unroll
    for (int dt = 0; dt < 2; ++dt)
#pragma unroll
        for (int q4 = 0; q4 < 4; ++q4) { const int d = 32 * dt + 8 * q4 + 4 * hh;
            const unsigned long long o = (unsigned long long)pk2(oacc[dt][4 * q4 + 0] * inv, oacc[dt][4 * q4 + 1] * inv) | ((unsigned long long)pk2(oacc[dt][4 * q4 + 2] * inv, oacc[dt][4 * q4 + 3] * inv) << 32);
            *(GAS unsigned long long*)(op + d) = o; }
    __syncthreads();
}

template <int W> __device__ __forceinline__ void pool_walk(const bf16* zc, bf16* oc, float s0, float s1, int pos0) {
    unsigned ring[16];
    float a0 = 0.f, a1 = 0.f;
#pragma unroll
    for (int q = 0; q < 16; ++q) ring[q] = 0u;
#pragma unroll
    for (int q = 1; q < W; ++q) { if (pos0 - q >= 0) { const unsigned u = *(const GAS unsigned*)(zc - (size_t)q * DIN); ring[(16 - q) & 15] = u; a0 += bf_lo(u); a1 += bf_hi(u); } }
    for (int rb = 0; rb < 64; rb += 16) {
#pragma unroll
        for (int i = 0; i < 16; ++i) {
            const unsigned u = *(const GAS unsigned*)(zc + (size_t)(rb + i) * DIN);
            const float c0 = bf_lo(u), c1 = bf_hi(u);
            a0 += c0; a1 += c1;
            const int pos = pos0 + rb + i; const float ic = 1.0f / (float)(pos + 1 < W ? pos + 1 : W);
            *(GAS unsigned*)(oc + (size_t)(rb + i) * D) = pk2((a0 * ic - c0) * s0, (a1 * ic - c1) * s1);
            const unsigned old = ring[(i + 17 - W) & 15];
            a0 -= bf_lo(old); a1 -= bf_hi(old);
            ring[i] = u;
        }
    }
}
__device__ __forceinline__ void pool_rows(const bf16* Y, bf16* AB, const float* pscale, int unit, int tid) {
    const int cp = tid & 255, seg = tid >> 8, g = cp >> 6;
    const int r0 = unit * 128 + seg * 64, pos0 = r0 & (SEQ - 1);
    const bf16* zc = Y + (size_t)r0 * DIN + 768 + 2 * cp; bf16* oc = AB + (size_t)r0 * D + 512 + 2 * cp;
    const float s0 = pscale[2 * cp], s1 = pscale[2 * cp + 1];
    if (g == 0) pool_walk<2>(zc, oc, s0, s1, pos0); else if (g == 1) pool_walk<4>(zc, oc, s0, s1, pos0); else if (g == 2) pool_walk<8>(zc, oc, s0, s1, pos0); else pool_walk<16>(zc, oc, s0, s1, pos0);
}

__device__ __forceinline__ int f2key(float f) { return __builtin_bit_cast(int, f); }
__device__ __forceinline__ float key2f(int k) { return __builtin_bit_cast(float, k); }
#define CE_DESC(a, b) do { const int _x = (a), _y = (b); (a) = _x > _y ? _x : _y; (b) = _x > _y ? _y : _x; } while (0)
__device__ __forceinline__ void sort16_desc(int (&a)[16]) {
#pragma unroll
    for (int k = 2; k <= 16; k <<= 1)
#pragma unroll
        for (int j = k >> 1; j > 0; j >>= 1)
#pragma unroll
            for (int i = 0; i < 16; ++i) { const int l = i ^ j; if (l > i) { if ((i & k) == 0) CE_DESC(a[i], a[l]); else CE_DESC(a[l], a[i]); } }
}
__device__ __forceinline__ void merge_top16(int (&a)[16], const int (&b)[16]) {
#pragma unroll
    for (int i = 0; i < 16; ++i) a[i] = a[i] > b[15 - i] ? a[i] : b[15 - i];
#pragma unroll
    for (int j = 8; j > 0; j >>= 1)
#pragma unroll
        for (int i = 0; i < 16; ++i) { const int l = i ^ j; if (l > i) CE_DESC(a[i], a[l]); }
}
__device__ __forceinline__ void top16_of_64(int (&g0)[16], int (&g1)[16], int (&g2)[16], int (&g3)[16]) {
    sort16_desc(g0); sort16_desc(g1); sort16_desc(g2); sort16_desc(g3);
    merge_top16(g0, g1); merge_top16(g2, g3); merge_top16(g0, g2);
}
__device__ __forceinline__ void topk_stage_keys(LAS unsigned char* lds, const bf16* SK, int h, int tid) {
#pragma unroll
    for (int i = 0; i < 8; ++i) { const int c = tid + 512 * i, p = c >> 11, n = (c >> 4) & 127, ch = c & 15;
        *(LAS v4u*)(lds + p * 34816 + n * 272 + ch * 16) = *(const GAS v4u*)(SK + ((size_t)(h * 2 + p) * 128 + n) * 128 + ch * 8); }
    LDS_WAIT(); __syncthreads();
}
__device__ __forceinline__ void topk_unit(LAS unsigned char* lds, const bf16* QP, const bf16* SK, unsigned short* EXPERTS, float* BEST, int unit, int tid, int wave, int lane) {
    const int h = unit & 7, tt = unit >> 3, hh = lane >> 5;
    const int tok = tt * 256 + wave * 32 + (lane & 31);
    static_assert(69632 + 512 * 33 * 4 <= PHASE_LDS_MAX, "top-k LDS scratch runs into the LDS control words");
    LAS int* mine = (LAS int*)(lds + 69632) + tid * 33;
    int top[2][16];
#pragma unroll
    for (int p = 0; p < 2; ++p) {
        const bf16* qp = QP + (size_t)tok * DQ + h * 256 + p * 128 + 8 * hh;
        const LAS unsigned char* kp = lds + p * 34816 + (lane & 31) * 272 + 16 * hh;
        f32x16 acc[4];
#pragma unroll
        for (int nt = 0; nt < 4; ++nt)
#pragma unroll
            for (int r = 0; r < 16; ++r) acc[nt][r] = 8.0f;
#pragma unroll
        for (int s = 0; s < 8; ++s) { const bf16x8 bq = __builtin_bit_cast(bf16x8, *(const GAS v4u*)(qp + 16 * s));
#pragma unroll
            for (int nt = 0; nt < 4; ++nt) { const bf16x8 a = *(const LAS bf16x8*)(kp + nt * (32 * 272) + 32 * s); acc[nt] = MFMA32(a, bq, acc[nt]); } }
        int k0[16], k1[16], k2[16], k3[16];
#pragma unroll
        for (int r = 0; r < 16; ++r) { const int n = (r & 3) + 8 * (r >> 2) + 4 * hh;
            k0[r] = (f2key(acc[0][r]) & ~127) | n; k1[r] = (f2key(acc[1][r]) & ~127) | (32 + n); k2[r] = (f2key(acc[2][r]) & ~127) | (64 + n); k3[r] = (f2key(acc[3][r]) & ~127) | (96 + n); }
        top16_of_64(k0, k1, k2, k3);
#pragma unroll
        for (int r = 0; r < 16; ++r) k1[r] = __shfl_xor(k0[r], 32);
        merge_top16(k0, k1);
#pragma unroll
        for (int r = 0; r < 16; ++r) top[p][r] = k0[r];
    }
    int c0[16], c1[16], c2[16], c3[16];
    {
        float v1[16], v2[16];
#pragma unroll
        for (int r = 0; r < 16; ++r) { v1[r] = key2f(top[0][r] & ~127); v2[r] = key2f(top[1][r] & ~127); mine[r] = top[0][r]; mine[16 + r] = top[1][r]; }
        int cnt = 0;
#pragma unroll
        for (int i = 0; i < 16; ++i)
#pragma unroll
            for (int j = 0; j < 16; ++j) if ((i + 1) * (j + 1) <= 16) { const int key = (f2key(v1[i] + v2[j]) & ~255) | (i << 4) | j;
                if (cnt < 16) c0[cnt] = key; else if (cnt < 32) c1[cnt - 16] = key; else if (cnt < 48) c2[cnt - 32] = key; else c3[cnt - 48] = key; ++cnt; }
#pragma unroll
        for (int r = 0; r < 16; ++r) if (48 + r >= cnt) c3[r] = (int)0x80000000;
    }
    top16_of_64(c0, c1, c2, c3);
    LDS_WAIT();
    if (hh == 0) {
        int ev[16]; float bv[16];
#pragma unroll
        for (int r = 0; r < 16; ++r) { const int id = c0[r] & 255; const int ka = mine[id >> 4], kb = mine[16 + (id & 15)];
            ev[r] = (ka & 127) * 128 + (kb & 127); bv[r] = (key2f(ka & ~127) - 8.0f) + (key2f(kb & ~127) - 8.0f); }
        unsigned short* ep = EXPERTS + (size_t)tok * 128 + h * 16; float* bp = BEST + (size_t)tok * 128 + h * 16;
#pragma unroll
        for (int r = 0; r < 16; r += 8) *(GAS v4u*)(ep + r) = (v4u){(unsigned)ev[r] | ((unsigned)ev[r + 1] << 16), (unsigned)ev[r + 2] | ((unsigned)ev[r + 3] << 16), (unsigned)ev[r + 4] | ((unsigned)ev[r + 5] << 16), (unsigned)ev[r + 6] | ((unsigned)ev[r + 7] << 16)};
#pragma unroll
        for (int r = 0; r < 16; r += 4) *(GAS f32x4*)(bp + r) = (f32x4){bv[r], bv[r + 1], bv[r + 2], bv[r + 3]};
    }
    LDS_WAIT();
}

__device__ __forceinline__ float gelu_erf(float x) { return 0.5f * x * (1.0f + erff(x * 0.70710678118654752f)); }
#define PEER_BL(rs, e_, c_) __builtin_amdgcn_raw_buffer_load_b128(rs, (int)(((e_) << 7) + (c_)), 0, 0)
#define PEER_ROWS(r, rs, c_, q) do { const v4u _ev = *(const LAS v4u*)(evp + 16 * (q)); \
        r[0] = PEER_BL(rs, _ev.x & 0xffffu, c_); r[1] = PEER_BL(rs, _ev.x >> 16, c_); r[2] = PEER_BL(rs, _ev.y & 0xffffu, c_); r[3] = PEER_BL(rs, _ev.y >> 16, c_); \
        r[4] = PEER_BL(rs, _ev.z & 0xffffu, c_); r[5] = PEER_BL(rs, _ev.z >> 16, c_); r[6] = PEER_BL(rs, _ev.w & 0xffffu, c_); r[7] = PEER_BL(rs, _ev.w >> 16, c_); } while (0)
__device__ __forceinline__ void peer_u_phase(LAS unsigned char* lds, const bf16* X1B, const unsigned char* U8, const unsigned short* EXP16, float* PD, int j, int w, int nw, int wave, int lane) {
    const int grp = lane >> 3, sub = lane & 7;
    LAS unsigned char* wl = lds + wave * 8192;
    const LAS unsigned char* evp = wl + grp * 256;
    const int stride = nw * NWAVES * 8;
    int tb = (w * NWAVES + wave) * 8;
    v4u pe0 = {0u, 0u, 0u, 0u}, pe1 = {0u, 0u, 0u, 0u};
    v4u px0 = {0u, 0u, 0u, 0u}, px1 = {0u, 0u, 0u, 0u};
    if (tb < T) { const GAS v4u* e = (const GAS v4u*)(EXP16 + (size_t)tb * 128) + lane; pe0 = e[0]; pe1 = e[64];
        const GAS v4u* xp = (const GAS v4u*)(X1B + (size_t)(tb + grp) * D + 128 * j + 16 * sub); px0 = xp[0]; px1 = xp[1]; }
    const __amdgpu_buffer_rsrc_t urs = __builtin_amdgcn_make_buffer_rsrc((void*)U8, (short)0, NEXP * D, 0x00020000); const unsigned uc = (unsigned)j * (NEXP * 128u) + 16u * sub;
    for (; tb < T; tb += stride) {
        *(LAS v4u*)(wl + 16 * lane) = pe0; *(LAS v4u*)(wl + 1024 + 16 * lane) = pe1;
        const v4u xa = px0, xc = px1;
        if (tb + stride < T) { const GAS v4u* e = (const GAS v4u*)(EXP16 + (size_t)(tb + stride) * 128) + lane; pe0 = e[0]; pe1 = e[64];
            const GAS v4u* xp = (const GAS v4u*)(X1B + (size_t)(tb + stride + grp) * D + 128 * j + 16 * sub); px0 = xp[0]; px1 = xp[1]; }
        const int t = tb + grp;
        const f32x4 x0 = {bf_lo(xa.x), bf_hi(xa.x), bf_lo(xa.y), bf_hi(xa.y)}, x1 = {bf_lo(xa.z), bf_hi(xa.z), bf_lo(xa.w), bf_hi(xa.w)};
        const f32x4 x2 = {bf_lo(xc.x), bf_hi(xc.x), bf_lo(xc.y), bf_hi(xc.y)}, x3 = {bf_lo(xc.z), bf_hi(xc.z), bf_lo(xc.w), bf_hi(xc.w)};
        float amax = fmaxf(fmaxf(fmaxf(fabsf(x0.x), fabsf(x0.y)), fmaxf(fabsf(x0.z), fabsf(x0.w))), fmaxf(fmaxf(fabsf(x1.x), fabsf(x1.y)), fmaxf(fabsf(x1.z), fabsf(x1.w))));
        amax = fmaxf(amax, fmaxf(fmaxf(fmaxf(fabsf(x2.x), fabsf(x2.y)), fmaxf(fabsf(x2.z), fabsf(x2.w))), fmaxf(fmaxf(fabsf(x3.x), fabsf(x3.y)), fmaxf(fabsf(x3.z), fabsf(x3.w)))));
        amax = fmaxf(amax, __shfl_xor(amax, 1)); amax = fmaxf(amax, __shfl_xor(amax, 2)); amax = fmaxf(amax, __shfl_xor(amax, 4));
        const float inv = amax > 0.f ? 127.0f / amax : 0.f, sx = amax * (1.0f / 127.0f);
        const unsigned xq0 = pack_i8x4(x0.x * inv, x0.y * inv, x0.z * inv, x0.w * inv), xq1 = pack_i8x4(x1.x * inv, x1.y * inv, x1.z * inv, x1.w * inv);
        const unsigned xq2 = pack_i8x4(x2.x * inv, x2.y * inv, x2.z * inv, x2.w * inv), xq3 = pack_i8x4(x3.x * inv, x3.y * inv, x3.z * inv, x3.w * inv);
        LAS _Float16* pd = (LAS _Float16*)(wl + 4096) + grp * 128 + sub;
        LDS_WAIT();
        v4u ra[8], rb[8], rc[8];
        PEER_ROWS(ra, urs, uc, 0); PEER_ROWS(rb, urs, uc, 1);
#define PEER_UDOT(r, q) do { int p[8]; _Pragma("unroll") for (int i = 0; i < 8; ++i) { int a = __builtin_amdgcn_sdot4((int)r[i].x, (int)xq0, 0, false); a = __builtin_amdgcn_sdot4((int)r[i].y, (int)xq1, a, false); \
                a = __builtin_amdgcn_sdot4((int)r[i].z, (int)xq2, a, false); p[i] = __builtin_amdgcn_sdot4((int)r[i].w, (int)xq3, a, false); } \
            _Pragma("unroll") for (int o = 4; o > 0; o >>= 1) { const bool up = (sub & o) != 0; \
                _Pragma("unroll") for (int i = 0; i < o; ++i) { const int keep = up ? p[i + o] : p[i], send = up ? p[i] : p[i + o]; p[i] = keep + __shfl_xor(send, o); } } \
            pd[8 * (q)] = (_Float16)((float)p[0] * sx); } while (0)
        for (int q = 0; q < 15; q += 3) {
            PEER_ROWS(rc, urs, uc, q + 2); PEER_UDOT(ra, q);
            PEER_ROWS(ra, urs, uc, q + 3); PEER_UDOT(rb, q + 1);
            if (q + 4 < 16) PEER_ROWS(rb, urs, uc, q + 4);
            PEER_UDOT(rc, q + 2);
        }
        PEER_UDOT(ra, 15);
        LDS_WAIT();
#pragma unroll
        for (int qq = 0; qq < 2; ++qq) { const v4u pv = *(const LAS v4u*)(wl + 4096 + qq * 1024 + 16 * lane);
            *(GAS v4u*)((_Float16*)PD + ((size_t)j * T + tb + 4 * qq + (lane >> 4)) * 128 + 8 * (lane & 15)) = pv; }
    }
}
__device__ __forceinline__ void peer_stage_scales(LAS unsigned char* lds, const float* su, const float* sv, int tid) {
#pragma unroll
    for (int i = 0; i < 8; ++i) { *(LAS f32x4*)(lds + (size_t)(tid + 512 * i) * 16) = ((const GAS f32x4*)su)[tid + 512 * i]; *(LAS f32x4*)(lds + 65536 + (size_t)(tid + 512 * i) * 16) = ((const GAS f32x4*)sv)[tid + 512 * i]; }
    LDS_WAIT(); __syncthreads();
}
__device__ __forceinline__ void peer_combine4(LAS unsigned char* lds, const float* PD, const unsigned short* EXP16, const float* BEST, const float* SS2, unsigned char* CC8, float* SCC, int t0, int lane) {
    const LAS float* su = (const LAS float*)lds; const LAS float* sv = (const LAS float*)(lds + 65536);
    typedef float f32x2v __attribute__((ext_vector_type(2)));
    f32x4 ssv[4][4]; unsigned ev[4]; f32x2v bv[4]; f32x2v pdv[4][8];
#pragma unroll
    for (int i = 0; i < 4; ++i) { const int t = t0 + i;
        const GAS f32x4* sp = (const GAS f32x4*)(SS2 + (size_t)t * 16);
#pragma unroll
        for (int q = 0; q < 4; ++q) ssv[i][q] = sp[q];
        ev[i] = ((const GAS unsigned*)(EXP16 + (size_t)t * 128))[lane];
        bv[i] = ((const GAS f32x2v*)(BEST + (size_t)t * 128))[lane];
#pragma unroll
        for (int j = 0; j < 8; ++j) { typedef _Float16 h2v __attribute__((ext_vector_type(2))); const h2v hv = ((const GAS h2v*)((const _Float16*)PD + ((size_t)j * T + t) * 128))[lane]; pdv[i][j] = (f32x2v){(float)hv.x, (float)hv.y}; } }
    float suv[4][2], svv[4][2];
#pragma unroll
    for (int i = 0; i < 4; ++i) { const unsigned e0 = ev[i] & 0xffffu, e1 = ev[i] >> 16; suv[i][0] = su[e0]; suv[i][1] = su[e1]; svv[i][0] = sv[e0]; svv[i][1] = sv[e1]; }
#pragma unroll
    for (int i = 0; i < 4; ++i) { const int t = t0 + i;
        float ssq = 0.f;
#pragma unroll
        for (int q = 0; q < 4; ++q) ssq += (ssv[i][q].x + ssv[i][q].y) + (ssv[i][q].z + ssv[i][q].w);
        const float rstd2 = 1.0f / sqrtf(ssq * (1.0f / D) + EPS);
        const float s0 = bv[i].x * rstd2, s1 = bv[i].y * rstd2;
        float mx = fmaxf(s0, s1);
#pragma unroll
        for (int o = 1; o < 8; o <<= 1) mx = fmaxf(mx, __shfl_xor(mx, o));
        const float e0 = __expf(s0 - mx), e1 = __expf(s1 - mx); float sm = e0 + e1;
#pragma unroll
        for (int o = 1; o < 8; o <<= 1) sm += __shfl_xor(sm, o);
        float d0 = 0.f, d1 = 0.f;
#pragma unroll
        for (int j = 0; j < 8; ++j) { d0 += pdv[i][j].x; d1 += pdv[i][j].y; }
        const float inv_sm = 1.0f / sm;
        const float c0 = e0 * inv_sm * gelu_erf(d0 * rstd2 * suv[i][0]) * svv[i][0], c1 = e1 * inv_sm * gelu_erf(d1 * rstd2 * suv[i][1]) * svv[i][1];
        float amax = fmaxf(fabsf(c0), fabsf(c1));
#pragma unroll
        for (int o = 1; o < 64; o <<= 1) amax = fmaxf(amax, __shfl_xor(amax, o));
        const float inv = amax > 0.f ? 127.0f / amax : 0.f;
        ((GAS unsigned short*)(CC8 + (size_t)t * 128))[lane] = (unsigned short)((__float2int_rn(c0 * inv) & 0xff) | ((__float2int_rn(c1 * inv) & 0xff) << 8));
        if (lane == 0) SCC[t] = amax * (1.0f / 127.0f); }
}
__device__ __forceinline__ void peer_v_phase(LAS unsigned char* lds, float* OUT, const bf16* X1B, const unsigned char* V8, const unsigned short* EXP16, const unsigned char* CC8, const float* SCC, int j, int w, int nw, int wave, int lane) {
    const int grp = lane >> 3, sub = lane & 7;
    LAS unsigned char* wl = lds + wave * 8192;
    const LAS unsigned char* evp = wl + grp * 256;
    const LAS unsigned char* ccp = wl + 2048 + grp * 128;
    const int stride = nw * NWAVES * 8;
    int tb = (w * NWAVES + wave) * 8;
    v4u pe0 = {0u, 0u, 0u, 0u}, pe1 = {0u, 0u, 0u, 0u}, pc0 = {0u, 0u, 0u, 0u};
    if (tb < T) { const GAS v4u* e = (const GAS v4u*)(EXP16 + (size_t)tb * 128) + lane; pe0 = e[0]; pe1 = e[64]; pc0 = ((const GAS v4u*)(CC8 + (size_t)tb * 128))[lane]; }
    const __amdgpu_buffer_rsrc_t vrs = __builtin_amdgcn_make_buffer_rsrc((void*)V8, (short)0, NEXP * D, 0x00020000); const unsigned vc = (unsigned)j * (NEXP * 128u) + 16u * sub;
    for (; tb < T; tb += stride) {
        *(LAS v4u*)(wl + 16 * lane) = pe0; *(LAS v4u*)(wl + 1024 + 16 * lane) = pe1; *(LAS v4u*)(wl + 2048 + 16 * lane) = pc0;
        if (tb + stride < T) { const GAS v4u* e = (const GAS v4u*)(EXP16 + (size_t)(tb + stride) * 128) + lane; pe0 = e[0]; pe1 = e[64]; pc0 = ((const GAS v4u*)(CC8 + (size_t)(tb + stride) * 128))[lane]; }
        const int t = tb + grp;
        const float scc = SCC[t];
        const size_t eo = (size_t)t * D + 128 * j + 16 * sub;
        const GAS v4u* dp = (const GAS v4u*)(X1B + eo);
        const v4u da = dp[0], db = dp[1];
        int acc[16];
#pragma unroll
        for (int i = 0; i < 16; ++i) acc[i] = 0;
        LDS_WAIT();
        v4u rq[4][4];
#define PEER_LOADQ(r, qn) do { const unsigned long long _e4 = *(const LAS unsigned long long*)(evp + 8 * (qn)); const unsigned _lo = (unsigned)_e4, _hi = (unsigned)(_e4 >> 32); \
            r[0] = PEER_BL(vrs, _lo & 0xffffu, vc); r[1] = PEER_BL(vrs, _lo >> 16, vc); r[2] = PEER_BL(vrs, _hi & 0xffffu, vc); r[3] = PEER_BL(vrs, _hi >> 16, vc); } while (0)
#define PEER_T4(w_, r0, r1, r2, r3, cpk) do { const unsigned tl0 = __builtin_amdgcn_perm(r1, r0, 0x05010400u), th0 = __builtin_amdgcn_perm(r1, r0, 0x07030602u); \
            const unsigned tl1 = __builtin_amdgcn_perm(r3, r2, 0x05010400u), th1 = __builtin_amdgcn_perm(r3, r2, 0x07030602u); \
            acc[4 * (w_) + 0] = __builtin_amdgcn_sdot4((int)__builtin_amdgcn_perm(tl1, tl0, 0x05040100u), (int)(cpk), acc[4 * (w_) + 0], false); \
            acc[4 * (w_) + 1] = __builtin_amdgcn_sdot4((int)__builtin_amdgcn_perm(tl1, tl0, 0x07060302u), (int)(cpk), acc[4 * (w_) + 1], false); \
            acc[4 * (w_) + 2] = __builtin_amdgcn_sdot4((int)__builtin_amdgcn_perm(th1, th0, 0x05040100u), (int)(cpk), acc[4 * (w_) + 2], false); \
            acc[4 * (w_) + 3] = __builtin_amdgcn_sdot4((int)__builtin_amdgcn_perm(th1, th0, 0x07060302u), (int)(cpk), acc[4 * (w_) + 3], false); } while (0)
#define PEER_COMPQ(r, qn) do { const unsigned _c = *(const LAS unsigned*)(ccp + 4 * (qn)); \
            PEER_T4(0, r[0].x, r[1].x, r[2].x, r[3].x, _c); PEER_T4(1, r[0].y, r[1].y, r[2].y, r[3].y, _c); PEER_T4(2, r[0].z, r[1].z, r[2].z, r[3].z, _c); PEER_T4(3, r[0].w, r[1].w, r[2].w, r[3].w, _c); } while (0)
#pragma unroll
        for (int jq = 0; jq < 4; ++jq) PEER_LOADQ(rq[jq], jq);
        for (int it = 0; it < 8; ++it) {
#pragma unroll
            for (int jq = 0; jq < 4; ++jq) { PEER_COMPQ(rq[jq], 4 * it + jq); if (it < 7) PEER_LOADQ(rq[jq], 4 * it + 4 + jq); }
        }
        const float dl[16] = {bf_lo(da.x), bf_hi(da.x), bf_lo(da.y), bf_hi(da.y), bf_lo(da.z), bf_hi(da.z), bf_lo(da.w), bf_hi(da.w), bf_lo(db.x), bf_hi(db.x), bf_lo(db.y), bf_hi(db.y), bf_lo(db.z), bf_hi(db.z), bf_lo(db.w), bf_hi(db.w)};
#pragma unroll
        for (int q = 0; q < 4; ++q) { f32x4 v; v.x = dl[4 * q + 0] + scc * (float)acc[4 * q + 0]; v.y = dl[4 * q + 1] + scc * (float)acc[4 * q + 1]; v.z = dl[4 * q + 2] + scc * (float)acc[4 * q + 2]; v.w = dl[4 * q + 3] + scc * (float)acc[4 * q + 3];
            *(LAS f32x4*)(wl + 4096 + grp * 512 + sub * 64 + 16 * q) = v; }
        LDS_WAIT();
#pragma unroll
        for (int qq = 0; qq < 4; ++qq) { const f32x4 v = *(const LAS f32x4*)(wl + 4096 + qq * 1024 + 16 * lane);
            *(GAS f32x4*)(OUT + (size_t)(tb + 2 * qq + (lane >> 5)) * D + 128 * j + 4 * (lane & 31)) = v; }
    }
}
struct Args { const float* in[15]; float* out; unsigned char* ws; int ph_lo, ph_hi, li, pad; };
__global__ void __launch_bounds__(NWAVES * 64, 2) fwd_kernel(Args args) {
    extern __shared__ __attribute__((aligned(16))) unsigned char lds_raw[];
    LAS unsigned char* lds = (LAS unsigned char*)lds_raw;
    volatile LAS unsigned* MISC = (volatile LAS unsigned*)(lds + MISC_OFF);
    const int tid = threadIdx.x, lane = tid & 63, wave = __builtin_amdgcn_readfirstlane(tid >> 6);
    const int G = gridDim.x, bx = blockIdx.x;
    unsigned char* ws = args.ws;
    gu32* ctl = (gu32*)(ws + WS_CTL);
    for (int u = tid; u < (LDS_BYTES - LDSCTL_OFF) / 4; u += NWAVES * 64) ((LAS unsigned*)(lds + LDSCTL_OFF))[u] = 0u;
    __syncthreads();
    XcdBarrier bar; bar.bar = (unsigned*)(ctl + CW_BAR); bar.x = 0; bar.st = nullptr;
    if (N_LAUNCHES != PER_PHASE) bar = xcd_barrier_post((unsigned*)(ctl + CW_BAR) + args.li * XCD_BAR_WORDS, MISC + 8);
#define GRID_BAR() do { if (N_LAUNCHES != PER_PHASE) xcd_barrier(bar); } while (0)
    const int lo = args.ph_lo, hi = args.ph_hi;
#define IN(k) (lo <= (k) && (k) < hi)
#define BOTH(k) (IN(k) && IN((k) + 1))
#ifndef MK_REPEAT
#define MK_REPEAT -1
#endif
#define REP(k) for (int _r = 0; _r < ((MK_REPEAT == (k)) ? 2 : 1); ++_r)

    const float* x = args.in[0]; float* out = args.out;
    bf16* XB = (bf16*)(ws + WS_XB); bf16* WinT = (bf16*)(ws + WS_WIN); bf16* WoutT = (bf16*)(ws + WS_WOUT); bf16* WqT = (bf16*)(ws + WS_WQ);
    bf16* SK = (bf16*)(ws + WS_SK); bf16* PoolT = (bf16*)(ws + WS_POOLT); unsigned char* U8 = ws + WS_U8; unsigned char* V8 = ws + WS_V8; float* SU = (float*)(ws + WS_SU); float* SV = (float*)(ws + WS_SV);
    bf16* Y = (bf16*)(ws + WS_Y); bf16* AB = (bf16*)(ws + WS_AB); bf16* X1B = (bf16*)(ws + WS_X1B); bf16* QP = (bf16*)(ws + WS_QP);
    float* rstd1 = (float*)(ws + WS_RSTD1); float* SS2 = (float*)(ws + WS_SS2); unsigned short* EXPERTS = (unsigned short*)(ws + WS_EXP); float* BEST = (float*)(ws + WS_BEST);
    float* PD = (float*)(ws + WS_PD); bf16* DELTA = (bf16*)(ws + WS_DELTA); unsigned char* CC8 = ws + WS_CC; float* SCC = (float*)(ws + WS_SCC);
    const int gw = bx * NWAVES + wave, NGW = G * NWAVES;

    const P0Args p0a{x, args.in[1], args.in[2], args.in[7], args.in[9], args.in[10], args.in[11], args.in[12], args.in[13], args.in[14], XB, WinT, WoutT, WqT, SK, PoolT, U8, V8, SU, SV, rstd1};
    if (IN(0)) REP(0) {
        p0_prologue(p0a, lds, gw, NGW, wave, lane);
        if (BOTH(0)) GRID_BAR();
    }
    if (IN(1)) REP(1) {
        pg8::Gemm g{XB, WinT, T, DIN, D}; pg8::StaticOrder S; S.init(T, DIN, G, bx);
        pg8::EpiScaleBf16 E{Y, DIN, rstd1};
        pg8::gemm_phase<pg8::EpiScaleBf16, pg8::StaticOrder, true, true>(lds + RING_OFF, g, S, E);
        { const int nwg1 = (T / 256) * (DIN / 256), rem = nwg1 % G;
          if (rem == 0) p1_late_weights(p0a, lds, gw, NGW, wave, lane); else if (bx >= rem) p1_late_weights(p0a, lds, (bx - rem) * NWAVES + wave, (G - rem) * NWAVES, wave, lane); }
        if (BOTH(1)) GRID_BAR();
    }
    if (IN(2)) REP(2) {
        for (int u = bx; u < NB * 128 * 2; u += G) attn_unit(lds, Y, AB, args.in[3], args.in[4], args.in[5], args.in[6], u, tid, wave, lane);
        for (int u = bx; u < T / 128; u += G) pool_rows(Y, AB, args.in[8], u, tid);
        if (BOTH(2)) GRID_BAR();
    }
    if (IN(3)) REP(3) {
        pg8::Gemm g{AB, WoutT, T, D, D}; pg8::StaticOrder S; S.init(T, D, G, bx);
        pg8::EpiResid E{XB, X1B, SS2, D};
        pg8::gemm_phase<pg8::EpiResid, pg8::StaticOrder, true, true>(lds + RING_OFF, g, S, E);
        if (BOTH(3)) GRID_BAR();
    }
    if (IN(4)) REP(4) {
        pg8::Gemm g{X1B, WqT, T, DQ, D}; pg8::StaticOrder S; S.init(T, DQ, G, bx);
        pg8::EpiScaleBf16 E{QP, DQ, nullptr};
        pg8::gemm_phase<pg8::EpiScaleBf16, pg8::StaticOrder, true, true>(lds + RING_OFF, g, S, E);
        if (BOTH(4)) GRID_BAR();
    }
    if (IN(5)) REP(5) {
        { int hs = -1; for (int u = bx; u < (T / 256) * 8; u += G) { if ((u & 7) != hs) { if (hs >= 0) __syncthreads(); hs = u & 7; topk_stage_keys(lds, SK, hs, tid); } topk_unit(lds, QP, SK, EXPERTS, BEST, u, tid, wave, lane); } }
        if (BOTH(5)) GRID_BAR();
    }
    if (IN(6)) REP(6) {
        if ((G & 7) == 0) peer_u_phase(lds, X1B, U8, EXPERTS, PD, bx & 7, bx >> 3, G >> 3, wave, lane);
        else for (int j = 0; j < 8; ++j) peer_u_phase(lds, X1B, U8, EXPERTS, PD, j, bx, G, wave, lane);
        if (BOTH(6)) GRID_BAR();
    }
    if (IN(7)) REP(7) {
        peer_stage_scales(lds, SU, SV, tid);
        for (int t0 = gw * 4; t0 < T; t0 += NGW * 4) peer_combine4(lds, PD, EXPERTS, BEST, SS2, CC8, SCC, t0, lane);
        if (BOTH(7)) GRID_BAR();
    }
    if (IN(8)) {
        if ((G & 7) == 0) peer_v_phase(lds, out, X1B, V8, EXPERTS, CC8, SCC, bx & 7, bx >> 3, G >> 3, wave, lane);
        else for (int j = 0; j < 8; ++j) peer_v_phase(lds, out, X1B, V8, EXPERTS, CC8, SCC, j, bx, G, wave, lane);
    }
#undef IN
#undef BOTH
}

extern "C" void kernel_launch(void* const* d_in, const int* in_sizes, int n_in, void* d_out, int out_size, void* d_ws, size_t ws_size, hipStream_t stream) {
    static int grid = 0;
    if (grid == 0) {
        if (n_in != 15 || in_sizes[0] != T * D || out_size != T * D || ws_size < WS_END) { fprintf(stderr, "kernel_launch: unexpected shapes (n_in %d, in0 %d, out %d, ws %zu)\n", n_in, n_in > 0 ? in_sizes[0] : -1, out_size, ws_size); grid = -1; return; }
        int dev = 0, cus = 0, per_cu = 0;
        if (hipGetDevice(&dev) != hipSuccess || hipDeviceGetAttribute(&cus, hipDeviceAttributeMultiprocessorCount, dev) != hipSuccess) { grid = -1; return; }
        if (hipFuncSetAttribute((const void*)fwd_kernel, hipFuncAttributeMaxDynamicSharedMemorySize, LDS_BYTES) != hipSuccess) { fprintf(stderr, "kernel_launch: hipFuncSetAttribute failed\n"); grid = -1; return; }
        if (hipOccupancyMaxActiveBlocksPerMultiprocessor(&per_cu, (const void*)fwd_kernel, NWAVES * 64, LDS_BYTES) != hipSuccess || per_cu < 1) { fprintf(stderr, "kernel_launch: occupancy query reports %d blocks per CU\n", per_cu); }
        (void)hipGetLastError();
        grid = cus;
    }
    if (grid < 0) return;
    if (hipMemsetAsync((char*)d_ws + WS_CTL, 0, CTL_ZERO_BYTES, stream) != hipSuccess) return;
    Args a{};
    for (int i = 0; i < 15; ++i) a.in[i] = (const float*)d_in[i];
    a.out = (float*)d_out; a.ws = (unsigned char*)d_ws;
    for (int li = 0; li < N_LAUNCHES; ++li) {
        a.ph_lo = (N_LAUNCHES == PER_PHASE) ? li : 0; a.ph_hi = (N_LAUNCHES == PER_PHASE) ? li + 1 : PER_PHASE; a.li = (N_LAUNCHES == PER_PHASE) ? 0 : li;
        hipLaunchKernelGGL(fwd_kernel, dim3(grid), dim3(NWAVES * 64), LDS_BYTES, stream, a);
        const hipError_t le = hipPeekAtLastError();
        if (le != hipSuccess) { fprintf(stderr, "kernel_launch: launch %d failed: %s\n", li, hipGetErrorName(le)); break; }
    }
}
```

```cpp
#include <hip/hip_runtime.h>
#include <cstdio>
#include <cstdint>
namespace pg8 {
#define PG8_LAS __attribute__((address_space(3)))
typedef unsigned short bf16_t;
typedef short bf16x8 __attribute__((ext_vector_type(8)));
typedef float f32x4 __attribute__((ext_vector_type(4)));
typedef unsigned u32x4 __attribute__((ext_vector_type(4)));
constexpr int BM = 256, BK = 64, HALF = 128, HTB = HALF * BK * 2  , STAGE_BYTES = 8 * HTB, NXCD = 8, WGM = 8;

__host__ __device__ __forceinline__ int lds_byte(int r, int c) { const int st = (r >> 4) * 2 + (c >> 5), rr = r & 15, cc = c & 31, ob = rr * 64 + cc * 2; return st * 1024 + (ob ^ (((ob >> 9) & 1) << 5)); }
__host__ __device__ __forceinline__ void stage_rc(int b, int& R, int& C) { const int st = b / 1024, sb = b % 1024, swz = sb ^ (((sb >> 9) & 1) << 5); R = (st >> 1) * 16 + swz / 64; C = (st & 1) * 32 + (swz % 64) / 2; }
__host__ __device__ __forceinline__ int perm32(int rho) { const int n = rho >> 4, i = rho & 15; return 8 * (i >> 2) + 4 * n + (i & 3); }

struct Unit { int pm, pn; };
struct Gemm { const bf16_t* A; const bf16_t* Bt; int M, N, K; };

struct StaticOrder {
    int nM, nN, nwg, G, c;
    __host__ __device__ void init(int M, int N, int G_, int c_) { nM = M / BM; nN = N / BM; nwg = nM * nN; G = G_; c = c_; }
    __host__ __device__ bool next(int i, Unit& u) const {
        const long L = (long)i * G + c; if (L >= nwg) return false;
        int wgid = (int)L; { const int q = nwg / NXCD, r = nwg % NXCD, xcd = wgid % NXCD, off = wgid / NXCD; wgid = (xcd < r ? xcd * (q + 1) : r * (q + 1) + (xcd - r) * q) + off; }
        const int nig = WGM * nN, gid = wgid / nig, fm = gid * WGM, gsz = (nM - fm) < WGM ? (nM - fm) : WGM;
        u.pm = fm + ((wgid % nig) % gsz); u.pn = (wgid % nig) / gsz; return true;
    }
    __device__ __forceinline__ void a_ready(const Unit&) const {}
    __device__ __forceinline__ void done(const Unit&) const {}
};

__device__ __forceinline__ unsigned cvt_pk_bf16(float lo, float hi) { unsigned r; asm volatile("v_cvt_pk_bf16_f32 %0, %1, %2" : "=v"(r) : "v"(lo), "v"(hi)); return r; }
struct EpiScaleBf16 {
    static constexpr bool PERM = true, AFTER_DRAIN = false, PROBE_TWICE = false;
    bf16_t* O; int ldc; const float* rs;
    __device__ __forceinline__ void operator()(const f32x4 (&acc)[2][2][4][2], const Unit& u, int wr, int wc, int fr, int fq) const {
        const int row0 = u.pm * BM + wr * 64 + fr, col0 = u.pn * BM + wc * 32 + 8 * fq;
#pragma unroll
        for (int ai = 0; ai < 2; ++ai)
#pragma unroll
            for (int m = 0; m < 4; ++m) { const int row = row0 + ai * HALF + m * 16; const float s = rs ? rs[row] : 1.f; bf16_t* rowp = O + (size_t)row * ldc + col0;
#pragma unroll
                for (int bj = 0; bj < 2; ++bj) { const f32x4 v0 = acc[ai][bj][m][0] * s, v1 = acc[ai][bj][m][1] * s;
                    u32x4 w; w.x = cvt_pk_bf16(v0[0], v0[1]); w.y = cvt_pk_bf16(v0[2], v0[3]); w.z = cvt_pk_bf16(v1[0], v1[1]); w.w = cvt_pk_bf16(v1[2], v1[3]);
                    *(u32x4*)(rowp + bj * HALF) = w; } }
    }
};
struct EpiResid {
    static constexpr bool PERM = true, AFTER_DRAIN = false, PROBE_TWICE = false;
    const bf16_t* xbf; bf16_t* xb; float* ss; int ldc;
    __device__ __forceinline__ void operator()(const f32x4 (&acc)[2][2][4][2], const Unit& u, int wr, int wc, int fr, int fq) const {
        const int row0 = u.pm * BM + wr * 64 + fr, col0 = u.pn * BM + wc * 32 + 8 * fq;
#pragma unroll
        for (int ai = 0; ai < 2; ++ai)
#pragma unroll
            for (int m = 0; m < 4; ++m) { const int row = row0 + ai * HALF + m * 16; const size_t off = (size_t)row * ldc + col0; float q = 0.f;
#pragma unroll
                for (int bj = 0; bj < 2; ++bj) { const u32x4 xr = *(const u32x4*)(xbf + off + bj * HALF);
                    const f32x4 a0 = acc[ai][bj][m][0], a1 = acc[ai][bj][m][1];
                    f32x4 v0, v1;
                    v0[0] = a0[0] + __builtin_bit_cast(float, xr.x << 16); v0[1] = a0[1] + __builtin_bit_cast(float, xr.x & 0xffff0000u); v0[2] = a0[2] + __builtin_bit_cast(float, xr.y << 16); v0[3] = a0[3] + __builtin_bit_cast(float, xr.y & 0xffff0000u);
                    v1[0] = a1[0] + __builtin_bit_cast(float, xr.z << 16); v1[1] = a1[1] + __builtin_bit_cast(float, xr.z & 0xffff0000u); v1[2] = a1[2] + __builtin_bit_cast(float, xr.w << 16); v1[3] = a1[3] + __builtin_bit_cast(float, xr.w & 0xffff0000u);
                    u32x4 w; w.x = cvt_pk_bf16(v0[0], v0[1]); w.y = cvt_pk_bf16(v0[2], v0[3]); w.z = cvt_pk_bf16(v1[0], v1[1]); w.w = cvt_pk_bf16(v1[2], v1[3]);
                    *(u32x4*)(xb + off + bj * HALF) = w;
                    q += (v0[0] * v0[0] + v0[1] * v0[1]) + (v0[2] * v0[2] + v0[3] * v0[3]) + (v1[0] * v1[0] + v1[1] * v1[1]) + (v1[2] * v1[2] + v1[3] * v1[3]); }
                q += __shfl_xor(q, 16); q += __shfl_xor(q, 32);
                if (fq == 0) ss[(size_t)row * 16 + u.pn * 4 + wc] = q; }
    }
};
template <class Epi, class Sched, bool ALIGN_EPI = false, bool SP2 = false>
__device__ __forceinline__ void gemm_phase(PG8_LAS unsigned char* lds, const Gemm g, const Sched& S, const Epi& E) {
    const int tid = threadIdx.x, wid = __builtin_amdgcn_readfirstlane(tid >> 6), lane = tid & 63, wr = wid >> 2, wc = wid & 3, fr = lane & 15, fq = lane >> 4;
    const int K = g.K, nt = K / BK;
    unsigned voffA[2], voffB[2];
#pragma unroll
    for (int i = 0; i < 2; ++i) { int R, C; stage_rc(tid * 16 + i * 8192, R, C); const int Rb = Epi::PERM ? ((R & ~31) + perm32(R & 31)) : R;
        voffA[i] = (unsigned)(R * K + C) * 2u; voffB[i] = (unsigned)(Rb * K + C) * 2u; }
    const size_t kstep = (size_t)(BK * 2);
    const size_t hstep = (size_t)HALF * K * 2;
    const size_t tstep = 2 * hstep;
    const unsigned ldsw = (unsigned)wid * 1024u;
    const int aoff = lds_byte(wr * 64 + fr, fq * 8), boff = lds_byte(wc * 32 + fr, fq * 8);
#define PG8_SA(b, h) (((b) * 2 + (h)) * HTB)
#define PG8_SB(b, h) ((4 + (b) * 2 + (h)) * HTB)
#define PG8_STAGE(bufoff, gbase, voff) do { _Pragma("unroll") for (int _i = 0; _i < 2; ++_i) \
        __builtin_amdgcn_global_load_lds((const unsigned*)((const char*)(gbase) + (voff)[_i]), (PG8_LAS unsigned*)(lds + (bufoff) + ldsw + _i * 8192), 16, 0, 0); } while (0)
#define PG8_LDA(dst, b, h) do { _Pragma("unroll") for (int m = 0; m < 4; ++m) _Pragma("unroll") for (int k = 0; k < 2; ++k) dst[m][k] = *(const PG8_LAS bf16x8*)(lds + PG8_SA(b, h) + aoff + m * 2048 + k * 1024); } while (0)
#define PG8_LDB(dst, b, h) do { _Pragma("unroll") for (int n = 0; n < 2; ++n) _Pragma("unroll") for (int k = 0; k < 2; ++k) dst[n][k] = *(const PG8_LAS bf16x8*)(lds + PG8_SB(b, h) + boff + n * 2048 + k * 1024); } while (0)
#define PG8_MMA(ai, bj, At, Bt) do { __builtin_amdgcn_s_setprio(1); _Pragma("unroll") for (int m = 0; m < 4; ++m) _Pragma("unroll") for (int n = 0; n < 2; ++n) _Pragma("unroll") for (int k = 0; k < 2; ++k) \
        acc[ai][bj][m][n] = __builtin_amdgcn_mfma_f32_16x16x32_bf16(Bt[n][k], At[m][k], acc[ai][bj][m][n], 0, 0, 0); __builtin_amdgcn_s_setprio(0); } while (0)
#define PG8_WAIT_V(n) asm volatile("s_waitcnt vmcnt(" #n ")" ::: "memory")
#define PG8_WAIT_L(n) asm volatile("s_waitcnt lgkmcnt(" #n ")" ::: "memory")
#define PG8_BAR __builtin_amdgcn_s_barrier()
#define PG8_SCHED __builtin_amdgcn_sched_barrier(0)
    Unit cur, nxt; int ui = 0;
    if (!S.next(0, cur)) return;
    f32x4 acc[2][2][4][2];
#pragma unroll
    for (int a = 0; a < 2; ++a)
#pragma unroll
        for (int b = 0; b < 2; ++b)
#pragma unroll
            for (int m = 0; m < 4; ++m)
#pragma unroll
                for (int n = 0; n < 2; ++n) acc[a][b][m][n] = (f32x4){0.f, 0.f, 0.f, 0.f};
    bf16x8 At[4][2], B0[2][2], B1[2][2];
    const char* cA = (const char*)g.A + (size_t)cur.pm * tstep; const char* cB = (const char*)g.Bt + (size_t)cur.pn * tstep;
    S.a_ready(cur);
    if constexpr (SP2) {
        PG8_STAGE(PG8_SB(0, 0), cB, voffB); PG8_STAGE(PG8_SB(0, 1), cB + hstep, voffB); PG8_STAGE(PG8_SA(0, 0), cA, voffA); PG8_STAGE(PG8_SA(0, 1), cA + hstep, voffA);
        if (wr == 1) PG8_BAR;
        PG8_WAIT_V(2); PG8_BAR;
        PG8_STAGE(PG8_SB(1, 0), cB + kstep, voffB); PG8_STAGE(PG8_SA(1, 0), cA + kstep, voffA); PG8_STAGE(PG8_SB(1, 1), cB + hstep + kstep, voffB);
        PG8_WAIT_V(6); PG8_BAR;
    } else {
        PG8_STAGE(PG8_SB(0, 0), cB, voffB); PG8_STAGE(PG8_SA(0, 0), cA, voffA); PG8_STAGE(PG8_SB(0, 1), cB + hstep, voffB); PG8_STAGE(PG8_SA(0, 1), cA + hstep, voffA);
        if (wr == 1) PG8_BAR;
        PG8_WAIT_V(4); PG8_BAR;
        PG8_STAGE(PG8_SB(1, 0), cB + kstep, voffB); PG8_STAGE(PG8_SA(1, 0), cA + kstep, voffA); PG8_STAGE(PG8_SB(1, 1), cB + hstep + kstep, voffB);
        PG8_WAIT_V(6); PG8_BAR;
    }
    for (;;) {
        const bool has_next = S.next(ui + 1, nxt);
        const char* nA = has_next ? (const char*)g.A + (size_t)nxt.pm * tstep : cA; const char* nB = has_next ? (const char*)g.Bt + (size_t)nxt.pn * tstep : cB;
        for (int t = 0; t < nt; t += 2) {
            const bool last = (t == nt - 2);
            const char* a1 = cA + (size_t)(t + 1) * kstep;
            const char* a2 = last ? nA : cA + (size_t)(t + 2) * kstep; const char* b2 = last ? nB : cB + (size_t)(t + 2) * kstep;
            const char* a3 = a2 + kstep; const char* b3 = b2 + kstep;
            if (last && has_next) S.a_ready(nxt);
            if constexpr (SP2) {
            PG8_LDB(B0, 0, 0); PG8_LDB(B1, 0, 1); PG8_SCHED; PG8_LDA(At, 0, 0); PG8_STAGE(PG8_SA(1, 1), a1 + hstep, voffA);
            PG8_WAIT_V(8); PG8_WAIT_L(0); PG8_BAR; PG8_MMA(0, 0, At, B0); PG8_MMA(0, 1, At, B1); PG8_BAR; PG8_SCHED;
            PG8_LDA(At, 0, 1); PG8_STAGE(PG8_SB(0, 0), b2, voffB); PG8_STAGE(PG8_SB(0, 1), b2 + hstep, voffB); PG8_STAGE(PG8_SA(0, 0), a2, voffA);
            PG8_WAIT_V(8); PG8_WAIT_L(0); PG8_BAR; PG8_MMA(1, 0, At, B0); PG8_MMA(1, 1, At, B1); PG8_BAR; PG8_SCHED;
            PG8_LDB(B0, 1, 0); PG8_LDB(B1, 1, 1); PG8_SCHED; PG8_LDA(At, 1, 0); PG8_STAGE(PG8_SA(0, 1), a2 + hstep, voffA);
            PG8_WAIT_V(8); PG8_WAIT_L(0); PG8_BAR; PG8_MMA(0, 0, At, B0); PG8_MMA(0, 1, At, B1); PG8_BAR; PG8_SCHED;
            PG8_LDA(At, 1, 1); PG8_STAGE(PG8_SB(1, 0), b3, voffB); PG8_STAGE(PG8_SB(1, 1), b3 + hstep, voffB); PG8_STAGE(PG8_SA(1, 0), a3, voffA);
            PG8_WAIT_V(8); PG8_WAIT_L(0); PG8_BAR; PG8_MMA(1, 0, At, B0); PG8_MMA(1, 1, At, B1); PG8_BAR; PG8_SCHED;
            } else {
            PG8_LDB(B0, 0, 0); PG8_SCHED; PG8_LDA(At, 0, 0); PG8_STAGE(PG8_SA(1, 1), a1 + hstep, voffA);
            PG8_WAIT_L(8); PG8_BAR; PG8_WAIT_L(0); PG8_MMA(0, 0, At, B0); PG8_BAR; PG8_SCHED;
            PG8_LDB(B1, 0, 1); PG8_STAGE(PG8_SB(0, 0), b2, voffB);
            PG8_BAR; PG8_WAIT_L(0); PG8_MMA(0, 1, At, B1); PG8_BAR;
            PG8_LDA(At, 0, 1); PG8_STAGE(PG8_SA(0, 0), a2, voffA);
            PG8_BAR; PG8_WAIT_L(0); PG8_MMA(1, 0, At, B0); PG8_BAR; PG8_SCHED;
            PG8_STAGE(PG8_SB(0, 1), b2 + hstep, voffB);
            PG8_WAIT_V(6); PG8_BAR; PG8_MMA(1, 1, At, B1); PG8_BAR;
            PG8_LDB(B0, 1, 0); PG8_SCHED; PG8_LDA(At, 1, 0); PG8_STAGE(PG8_SA(0, 1), a2 + hstep, voffA);
            PG8_WAIT_L(8); PG8_BAR; PG8_WAIT_L(0); PG8_MMA(0, 0, At, B0); PG8_BAR; PG8_SCHED;
            PG8_LDB(B1, 1, 1); PG8_STAGE(PG8_SB(1, 0), b3, voffB);
            PG8_BAR; PG8_WAIT_L(0); PG8_MMA(0, 1, At, B1); PG8_BAR;
            PG8_LDA(At, 1, 1); PG8_STAGE(PG8_SA(1, 0), a3, voffA);
            PG8_BAR; PG8_WAIT_L(0); PG8_MMA(1, 0, At, B0); PG8_BAR; PG8_SCHED;
            PG8_STAGE(PG8_SB(1, 1), b3 + hstep, voffB);
            PG8_WAIT_V(6); PG8_BAR; PG8_MMA(1, 1, At, B1); PG8_BAR;
            }
        }
        if constexpr (ALIGN_EPI) { if (wr == 0) PG8_BAR; }
        if constexpr (!Epi::AFTER_DRAIN) { E(acc, cur, wr, wc, fr, fq);
#if defined(MK_EXTRA)
            if (Epi::PROBE_TWICE) { asm volatile("" ::: "memory"); E(acc, cur, wr, wc, fr, fq); }
#endif
            S.done(cur); }
        if (!has_next) break;
#pragma unroll
        for (int a = 0; a < 2; ++a)
#pragma unroll
            for (int b = 0; b < 2; ++b)
#pragma unroll
                for (int m = 0; m < 4; ++m)
#pragma unroll
                    for (int n = 0; n < 2; ++n) acc[a][b][m][n] = (f32x4){0.f, 0.f, 0.f, 0.f};
        cur = nxt; cA = nA; cB = nB; ++ui;
        if constexpr (ALIGN_EPI) { if (wr == 1) PG8_BAR; }
    }
    PG8_WAIT_V(0);
    if constexpr (!ALIGN_EPI) { if (wr == 0) PG8_BAR; }
    PG8_BAR;
    if constexpr (Epi::AFTER_DRAIN) { E.fused(acc, cur, wr, wc, fr, fq, lds, wid, lane); S.done(cur); }
#undef PG8_SA
#undef PG8_SB
#undef PG8_STAGE
#undef PG8_LDA
#undef PG8_LDB
#undef PG8_MMA
#undef PG8_WAIT_V
#undef PG8_WAIT_L
#undef PG8_BAR
#undef PG8_SCHED
}
}
constexpr int NWAVES = 8;
#ifndef MK_N_LAUNCHES
#define MK_N_LAUNCHES 1
#endif
constexpr int PER_PHASE = 9;
constexpr int N_LAUNCHES = MK_N_LAUNCHES;

constexpr int NB = 4, SEQ = 8192, T = NB * SEQ, D = 1024, DIN = 1280, NEXP = 16384, DQ = 2048;
constexpr float EPS = 1e-6f;

constexpr size_t MiB = 1u << 20;
constexpr size_t WS_CTL = 0, CTL_ZERO_BYTES = 1 * MiB;
constexpr size_t WS_WIN = 2 * MiB;
constexpr size_t WS_WOUT = 5 * MiB;
constexpr size_t WS_WQ = 7 * MiB;
constexpr size_t WS_SK = 11 * MiB;
constexpr size_t WS_POOLT = 11 * MiB + 512 * 1024;
constexpr size_t WS_RSTD1 = 12 * MiB;
constexpr size_t WS_SS2 = 13 * MiB;
constexpr size_t WS_SU = 15 * MiB;
constexpr size_t WS_SV = 15 * MiB + 256 * 1024;
constexpr size_t WS_EXP = 16 * MiB;
constexpr size_t WS_BEST = 24 * MiB;
constexpr size_t WS_CC = 40 * MiB;
constexpr size_t WS_SCC = 44 * MiB;
constexpr size_t WS_U8 = 56 * MiB;
constexpr size_t WS_V8 = 72 * MiB;
constexpr size_t WS_AB = 88 * MiB;
constexpr size_t WS_X1B = 152 * MiB;
constexpr size_t WS_PD = 216 * MiB;
constexpr size_t WS_DELTA = 360 * MiB;
constexpr size_t WS_XB = 216 * MiB;
constexpr size_t WS_Y = 280 * MiB;
constexpr size_t WS_QP = 216 * MiB;
constexpr size_t WS_END = 424 * MiB;
constexpr int CW_BAR = 4096;

constexpr int RING_OFF = 0, RING_BYTES = 131072;
constexpr int LDS_BYTES = 163840;
constexpr int LDSCTL_OFF = LDS_BYTES - 512, MISC_OFF = LDSCTL_OFF + 320;
constexpr int PHASE_LDS_MAX = LDSCTL_OFF;
#define GAS __attribute__((address_space(1)))
#define LAS __attribute__((address_space(3)))
typedef unsigned short bf16;
typedef unsigned v4u __attribute__((ext_vector_type(4)));
typedef float f32x4 __attribute__((ext_vector_type(4)));
typedef short bf16x8 __attribute__((ext_vector_type(8)));
typedef GAS unsigned gu32;
typedef GAS unsigned long long gu64;
#define RLX_AGENT __ATOMIC_RELAXED, __HIP_MEMORY_SCOPE_AGENT
#define LDS_WAIT() asm volatile("s_waitcnt lgkmcnt(0)" ::: "memory")
#define VM_WAIT() asm volatile("s_waitcnt vmcnt(0)" ::: "memory")
__device__ __forceinline__ unsigned long long rt() { return __builtin_amdgcn_s_memrealtime(); }
__device__ __forceinline__ unsigned f2bf(float f) { unsigned u = __builtin_bit_cast(unsigned, f); return (u + 0x7fffu + ((u >> 16) & 1u)) >> 16; }
__device__ __forceinline__ unsigned pk2(float lo, float hi) { return f2bf(lo) | (f2bf(hi) << 16); }
#define XB_TMO      128
#define XB_XCNT(j)  (256  + 64 * (j))
#define XB_XSUB(j)  (1280 + 64 * (j))
#define XB_XGEN(j)  (2304 + 64 * (j))
#define XB_TOP      3328
#define XB_TOPGEN   3392
#define XCD_BAR_WORDS 3456
#define XB_SPIN_CAP (1u << 18)

__device__ __forceinline__ unsigned xb_ld(unsigned* p)              { return __hip_atomic_load(p, __ATOMIC_RELAXED, __HIP_MEMORY_SCOPE_AGENT); }
__device__ __forceinline__ unsigned xb_add(unsigned* p, unsigned v) { return __hip_atomic_fetch_add(p, v, __ATOMIC_RELAXED, __HIP_MEMORY_SCOPE_AGENT); }
__device__ __forceinline__ unsigned xb_xcc_id() { return (unsigned)__builtin_amdgcn_s_getreg((3 << 11) | 20) & 0xFu; }
#define XB_SPIN(cond, bar) do { unsigned _sp = 0; while (cond) { __builtin_amdgcn_s_sleep(1); \
    if ((++_sp & 255u) == 0u) { if (xb_ld(&(bar)[XB_TMO])) break; if (_sp > XB_SPIN_CAP) { atomicAdd(&(bar)[XB_TMO], 1u); break; } } } } while (0)

struct XcdBarrier {
    unsigned* bar; unsigned x;
    volatile LAS unsigned* st;
};

__device__ __forceinline__ XcdBarrier xcd_barrier_post(unsigned* bar, volatile LAS unsigned* st) {
    XcdBarrier b; b.bar = bar; b.x = xb_xcc_id(); b.st = st;
    if (threadIdx.x == 0) (void)xb_add(&bar[XB_XCNT(b.x)], 1u);
    return b;
}
__device__ __forceinline__ void xcd_barrier_complete(unsigned* bar, unsigned x, unsigned& nloc, unsigned& nx) {
    const unsigned G = gridDim.x * gridDim.y * gridDim.z;
    unsigned sum, cnt, mine, sp = 0u;
    for (;;) {
        sum = 0u; cnt = 0u; mine = 0u;
#pragma unroll
        for (unsigned j = 0; j < 16; ++j) { const unsigned c = xb_ld(&bar[XB_XCNT(j)]); sum += c; cnt += (c > 0u) ? 1u : 0u; mine = (j == x) ? c : mine; }
        if (sum == G) break;
        __builtin_amdgcn_s_sleep(1);
        if ((++sp & 255u) == 0u) { if (xb_ld(&bar[XB_TMO])) break; if (sp > XB_SPIN_CAP) { atomicAdd(&bar[XB_TMO], 1u); break; } }
    }
    nloc = mine > 0u ? mine : 1u; nx = cnt > 0u ? cnt : 1u;
}

__device__ __forceinline__ void xcd_barrier(const XcdBarrier& b) {
    asm volatile("s_waitcnt vmcnt(0)" ::: "memory");
    __syncthreads();
    if (threadIdx.x == 0) {
        unsigned* bar = b.bar;
        __builtin_amdgcn_s_waitcnt(0);
        unsigned nloc = b.st[0], nx = b.st[1];
        if (nloc == 0u) { xcd_barrier_complete(bar, b.x, nloc, nx); b.st[0] = nloc; b.st[1] = nx; }
        const unsigned old = xb_add(&bar[XB_XSUB(b.x)], 1u);
        const unsigned gen = old / nloc;
        if (old + 1u == (gen + 1u) * nloc) {
            __builtin_amdgcn_fence(__ATOMIC_RELEASE, "agent");
            asm volatile("s_waitcnt vmcnt(0)" ::: "memory");
            const unsigned og = xb_add(&bar[XB_TOP], 1u);
            const unsigned tg = og / nx;
            if (og + 1u == (tg + 1u) * nx) xb_add(&bar[XB_TOPGEN], 1u);
            else XB_SPIN(xb_ld(&bar[XB_TOPGEN]) == tg, bar);
            __builtin_amdgcn_fence(__ATOMIC_ACQUIRE, "agent");
            xb_add(&bar[XB_XGEN(b.x)], 1u);
            asm volatile("s_waitcnt vmcnt(0)" ::: "memory");
        } else {
            XB_SPIN(xb_ld(&bar[XB_XGEN(b.x)]) == gen, bar);
            __builtin_amdgcn_fence(__ATOMIC_ACQUIRE, "agent");
            asm volatile("s_waitcnt vmcnt(0)" ::: "memory");
        }
    }
    __syncthreads();
}
typedef float f32x16 __attribute__((ext_vector_type(16)));
typedef __bf16 bf16x2_t __attribute__((ext_vector_type(2)));
#define MFMA32(a, b, c) __builtin_amdgcn_mfma_f32_32x32x16_bf16((a), (b), (c), 0, 0, 0)
__device__ __forceinline__ float bf_lo(unsigned u) { return __builtin_bit_cast(float, u << 16); }
__device__ __forceinline__ float bf_hi(unsigned u) { return __builtin_bit_cast(float, u & 0xffff0000u); }
__device__ __forceinline__ float dot2_bf16(unsigned w, unsigned x, float acc) { return __builtin_amdgcn_fdot2_f32_bf16(__builtin_bit_cast(bf16x2_t, w), __builtin_bit_cast(bf16x2_t, x), acc, false); }
__device__ __forceinline__ float wave_sum(float v) {
#pragma unroll
    for (int o = 1; o < 64; o <<= 1) v += __shfl_xor(v, o);
    return v;
}

__device__ __forceinline__ unsigned pack_i8x4(float a, float b, float c, float d) {
    return ((unsigned)__float2int_rn(a) & 0xffu) | (((unsigned)__float2int_rn(b) & 0xffu) << 8) | (((unsigned)__float2int_rn(c) & 0xffu) << 16) | (((unsigned)__float2int_rn(d) & 0xffu) << 24);
}

__device__ __forceinline__ void p0_transpose_item(const float* W, int K, int N, bf16* WT, const float* gk, LAS float* scr, int item, int lane) {
    const int nblk = N / 32, kb = item / nblk, nb = item % nblk, k0 = 64 * kb, n0 = 32 * nb;
    float wv[32];
#pragma unroll
    for (int i = 0; i < 32; ++i) wv[i] = W[(size_t)(k0 + 2 * i + (lane >> 5)) * N + n0 + (lane & 31)];
#pragma unroll
    for (int i = 0; i < 32; ++i) { const int kk = 2 * i + (lane >> 5); float w = wv[i]; if (gk) w *= gk[k0 + kk]; scr[kk * 33 + (lane & 31)] = w; }
    LDS_WAIT(); asm volatile("" ::: "memory");
    const int c = lane & 7;
#pragma unroll
    for (int j = 0; j < 4; ++j) { const int n = (lane >> 3) + 8 * j; const LAS float* s = scr + (8 * c) * 33 + n;
        v4u o; o.x = pk2(s[0 * 33], s[1 * 33]); o.y = pk2(s[2 * 33], s[3 * 33]); o.z = pk2(s[4 * 33], s[5 * 33]); o.w = pk2(s[6 * 33], s[7 * 33]);
        *(GAS v4u*)(WT + (size_t)(n0 + n) * K + k0 + 8 * c) = o; }
    LDS_WAIT(); asm volatile("" ::: "memory");
}
__device__ __forceinline__ float row_to_bf16(const float* src, bf16* dst, const float* g, int lane) {
    const GAS f32x4* xr = (const GAS f32x4*)src + lane; float s = 0.f;
    GAS unsigned long long* o8 = (GAS unsigned long long*)dst + lane;
#pragma unroll
    for (int j = 0; j < 4; ++j) { f32x4 v = xr[64 * j]; s += (v.x * v.x + v.y * v.y) + (v.z * v.z + v.w * v.w);
        if (g) { const f32x4 gv = ((const GAS f32x4*)g)[64 * j + lane]; v = v * gv; }
        o8[64 * j] = (unsigned long long)pk2(v.x, v.y) | ((unsigned long long)pk2(v.z, v.w) << 32); }
    return s;
}
__device__ __forceinline__ void row_to_i8(const float* src, unsigned char* dst, const float* g, float* sc, int m, int lane) {
    const GAS f32x4* xr = (const GAS f32x4*)src + lane; f32x4 v[4]; float amax = 0.f;
#pragma unroll
    for (int j = 0; j < 4; ++j) { v[j] = xr[64 * j]; if (g) { const f32x4 gv = ((const GAS f32x4*)g)[64 * j + lane]; v[j] = v[j] * gv; }
        amax = fmaxf(fmaxf(amax, fmaxf(fabsf(v[j].x), fabsf(v[j].y))), fmaxf(fabsf(v[j].z), fabsf(v[j].w))); }
#pragma unroll
    for (int o = 1; o < 64; o <<= 1) amax = fmaxf(amax, __shfl_xor(amax, o));
    const float inv = amax > 0.f ? 127.0f / amax : 0.f;
    GAS unsigned* o4 = (GAS unsigned*)dst + lane;
#pragma unroll
    for (int j = 0; j < 4; ++j) { const unsigned q0 = (unsigned)__float2int_rn(v[j].x * inv) & 0xffu, q1 = (unsigned)__float2int_rn(v[j].y * inv) & 0xffu, q2 = (unsigned)__float2int_rn(v[j].z * inv) & 0xffu, q3 = (unsigned)__float2int_rn(v[j].w * inv) & 0xffu;
        o4[64 * j] = q0 | (q1 << 8) | (q2 << 16) | (q3 << 24); }
    if (lane == 0) sc[m] = amax * (1.0f / 127.0f);
}
__device__ __forceinline__ void p0_poolfold_item(const float* w_in, const float* pool_w, const float* g1, bf16* WinT, int item, int lane) {
    const int kb = item & 15, nb = (item >> 4) & 15, g = item >> 8, k = 64 * kb + lane, n0 = 8 * nb;
    const GAS f32x4* wr = (const GAS f32x4*)(w_in + (size_t)k * DIN + 768 + 128 * g);
    const float* pw = pool_w + (size_t)g * 16384 + n0;
    float acc[8];
#pragma unroll
    for (int n = 0; n < 8; ++n) acc[n] = 0.f;
#pragma unroll 1
    for (int cb = 0; cb < 32; cb += 16) { f32x4 a[16];
#pragma unroll
        for (int c4 = 0; c4 < 16; ++c4) a[c4] = wr[cb + c4];
#pragma unroll
        for (int c4 = 0; c4 < 16; ++c4)
#pragma unroll
            for (int n = 0; n < 8; ++n) { const float* pp = pw + (4 * (cb + c4)) * 128 + n; acc[n] = fmaf(a[c4].x, pp[0], acc[n]); acc[n] = fmaf(a[c4].y, pp[128], acc[n]); acc[n] = fmaf(a[c4].z, pp[256], acc[n]); acc[n] = fmaf(a[c4].w, pp[384], acc[n]); } }
    const float gk = g1[k];
#pragma unroll
    for (int n = 0; n < 8; ++n) WinT[(size_t)(768 + 128 * g + n0 + n) * D + k] = (bf16)f2bf(acc[n] * gk);
}
struct P0Args { const float *x, *g1, *w_in, *pool_w, *w_out, *g2, *wq, *sk, *u, *v; bf16 *XB, *WinT, *WoutT, *WqT, *SK, *PoolT; unsigned char *U8, *V8; float *su, *sv; float* rstd1; };
__device__ __forceinline__ void p0_prologue(const P0Args& a, LAS unsigned char* lds, int gw, int NGW, int wave, int lane) {
    LAS float* scr = (LAS float*)(lds + RING_OFF + wave * 16384);
    constexpr int I_IN = (D / 64) * (768 / 32), I_P = 4 * 16 * 16;
    constexpr int NITEMS = I_P + I_IN;
    for (int it = gw; it < NITEMS; it += NGW) {
        int r = it;
        if (r < I_P) { p0_poolfold_item(a.w_in, a.pool_w, a.g1, a.WinT, r, lane); continue; } r -= I_P;
        { const int kb = r / 24, nb = r % 24; p0_transpose_item(a.w_in, D, DIN, a.WinT, a.g1, scr, kb * 40 + nb, lane); }
    }
    for (int m0 = gw; m0 < T; m0 += 4 * NGW) {
        f32x4 v[4][4];
#pragma unroll
        for (int r = 0; r < 4; ++r) { const int m = m0 + r * NGW < T ? m0 + r * NGW : m0; const GAS f32x4* xr = (const GAS f32x4*)(a.x + (size_t)m * D) + lane;
#pragma unroll
            for (int j = 0; j < 4; ++j) v[r][j] = xr[64 * j]; }
#pragma unroll
        for (int r = 0; r < 4; ++r) { const int m = m0 + r * NGW; if (m < T) {
            float s = 0.f; GAS unsigned long long* o8 = (GAS unsigned long long*)(a.XB + (size_t)m * D) + lane;
#pragma unroll
            for (int j = 0; j < 4; ++j) { const f32x4 w = v[r][j]; s += (w.x * w.x + w.y * w.y) + (w.z * w.z + w.w * w.w); o8[64 * j] = (unsigned long long)pk2(w.x, w.y) | ((unsigned long long)pk2(w.z, w.w) << 32); }
            s = wave_sum(s); if (lane == 0) a.rstd1[m] = 1.0f / sqrtf(s * (1.0f / D) + EPS); } }
    }
    for (int m0 = gw; m0 < 2 * NEXP; m0 += 4 * NGW) {
        f32x4 v[4][4];
#pragma unroll
        for (int r = 0; r < 4; ++r) { const int mm = m0 + r * NGW < 2 * NEXP ? m0 + r * NGW : m0; const bool isv = mm >= NEXP; const int m = isv ? mm - NEXP : mm;
            const GAS f32x4* xr = (const GAS f32x4*)((isv ? a.v : a.u) + (size_t)m * D) + lane;
#pragma unroll
            for (int j = 0; j < 4; ++j) v[r][j] = xr[64 * j]; }
#pragma unroll
        for (int r = 0; r < 4; ++r) { const int mm = m0 + r * NGW; if (mm < 2 * NEXP) { const bool isv = mm >= NEXP; const int m = isv ? mm - NEXP : mm;
            float amax = 0.f;
#pragma unroll
            for (int j = 0; j < 4; ++j) { if (!isv) { const f32x4 gv = ((const GAS f32x4*)a.g2)[64 * j + lane]; v[r][j] = v[r][j] * gv; }
                amax = fmaxf(fmaxf(amax, fmaxf(fabsf(v[r][j].x), fabsf(v[r][j].y))), fmaxf(fabsf(v[r][j].z), fabsf(v[r][j].w))); }
#pragma unroll
            for (int o = 1; o < 64; o <<= 1) amax = fmaxf(amax, __shfl_xor(amax, o));
            const float inv = amax > 0.f ? 127.0f / amax : 0.f;
            unsigned char* tb_ = (isv ? a.V8 : a.U8) + (size_t)m * 128 + ((4 * lane) & 127);
#pragma unroll
            for (int j = 0; j < 4; ++j) *(GAS unsigned*)(tb_ + (size_t)((4 * lane + 256 * j) >> 7) * ((size_t)NEXP * 128)) = pack_i8x4(v[r][j].x * inv, v[r][j].y * inv, v[r][j].z * inv, v[r][j].w * inv);
            if (lane == 0) (isv ? a.sv : a.su)[m] = amax * (1.0f / 127.0f); } }
    }
}
__device__ __forceinline__ void p1_late_weights(const P0Args& a, LAS unsigned char* lds, int gw, int NGW, int wave, int lane) {
    LAS float* scr = (LAS float*)(lds + RING_OFF + wave * 16384);
    constexpr int I_OUT = (D / 64) * (D / 32), I_Q = (D / 64) * (DQ / 32);
    for (int it = gw; it < I_OUT + I_Q; it += NGW) {
        if (it < I_OUT) p0_transpose_item(a.w_out, D, D, a.WoutT, nullptr, scr, it, lane);
        else p0_transpose_item(a.wq, D, DQ, a.WqT, a.g2, scr, it - I_OUT, lane);
    }
    for (int m = gw; m < 256; m += NGW) (void)row_to_bf16(a.sk + (size_t)m * D, a.SK + (size_t)m * D, nullptr, lane);
}

__device__ __forceinline__ int t5_bucket(int rel) {
    const int n = rel < 0 ? -rel : rel; const int base = rel > 0 ? 16 : 0;
    const int v = n < 8 ? n : (n < 12 ? 8 : (n < 16 ? 9 : (n < 23 ? 10 : (n < 32 ? 11 : (n < 46 ? 12 : (n < 64 ? 13 : (n < 91 ? 14 : 15)))))));
    return base + v;
}
__device__ __forceinline__ void attn_unit(LAS unsigned char* lds, const bf16* Y, bf16* AB, const float* qg, const float* kg, const float* sinks, const float* relb,
                                          int unit, int tid, int wave, int lane) {
    const int kvh = unit & 1, c = (unit >> 1) & 127, b = unit >> 8;
    LAS bf16* Ks = (LAS bf16*)lds;
    LAS bf16* Vt = (LAS bf16*)(lds + 27648);
    LAS float* bt = (LAS float*)(lds + 53248);
    const int row0 = b * SEQ + (c - 2) * 64;
#pragma unroll
    for (int rep = 0; rep < 3; ++rep) {
        const int it = tid + rep * 512, j = it >> 3, ch = it & 7;
        const bool valid = (c - 2 + (j >> 6)) >= 0;
        v4u kraw = {0u, 0u, 0u, 0u}, vraw = {0u, 0u, 0u, 0u};
        if (valid) { const bf16* rp = Y + (size_t)(row0 + j) * DIN; kraw = *(const GAS v4u*)(rp + 512 + 64 * kvh + 8 * ch); vraw = *(const GAS v4u*)(rp + 640 + 64 * kvh + 8 * ch); }
        float kf[8] = {bf_lo(kraw.x), bf_hi(kraw.x), bf_lo(kraw.y), bf_hi(kraw.y), bf_lo(kraw.z), bf_hi(kraw.z), bf_lo(kraw.w), bf_hi(kraw.w)};
        float ss = 0.f;
#pragma unroll
        for (int e = 0; e < 8; ++e) ss += kf[e] * kf[e];
        ss += __shfl_xor(ss, 1); ss += __shfl_xor(ss, 2); ss += __shfl_xor(ss, 4);
        const float r = 1.0f / sqrtf(ss * (1.0f / 64.0f) + EPS);
        const f32x4 g0 = *(const GAS f32x4*)(kg + 8 * ch), g1 = *(const GAS f32x4*)(kg + 8 * ch + 4);
        v4u ko; ko.x = pk2(kf[0] * r * g0.x, kf[1] * r * g0.y); ko.y = pk2(kf[2] * r * g0.z, kf[3] * r * g0.w); ko.z = pk2(kf[4] * r * g1.x, kf[5] * r * g1.y); ko.w = pk2(kf[6] * r * g1.z, kf[7] * r * g1.w);
        *(LAS v4u*)(Ks + j * 72 + 8 * ch) = ko;
        const int s16 = j >> 4, kk = j & 15, hh = (kk >> 2) & 1, jj = ((kk >> 3) << 2) | (kk & 3), pos = 16 * s16 + 8 * hh + jj;
        LAS bf16* vp = Vt + (8 * ch) * 200 + pos;
        vp[0 * 200] = (bf16)(vraw.x & 0xffffu); vp[1 * 200] = (bf16)(vraw.x >> 16); vp[2 * 200] = (bf16)(vraw.y & 0xffffu); vp[3 * 200] = (bf16)(vraw.y >> 16);
        vp[4 * 200] = (bf16)(vraw.z & 0xffffu); vp[5 * 200] = (bf16)(vraw.z >> 16); vp[6 * 200] = (bf16)(vraw.w & 0xffffu); vp[7 * 200] = (bf16)(vraw.w >> 16);
    }
#pragma unroll
    for (int rep = 0; rep < 2; ++rep) { const int it = tid + rep * 512, g = it >> 8, r = it & 255; bt[it] = relb[t5_bucket(r - 191) * 8 + kvh * 4 + g]; }
    LDS_WAIT(); __syncthreads();

    const int g = wave >> 1, i = 32 * (wave & 1) + (lane & 31), hh = lane >> 5, habs = kvh * 4 + g;
    const size_t qrow = (size_t)b * SEQ + (size_t)c * 64 + i;
    const bf16* qp = Y + qrow * DIN + habs * 64 + 8 * hh;
    v4u qraw[4]; float ss = 0.f;
#pragma unroll
    for (int s = 0; s < 4; ++s) { qraw[s] = *(const GAS v4u*)(qp + 16 * s);
        const float f0 = bf_lo(qraw[s].x), f1 = bf_hi(qraw[s].x), f2 = bf_lo(qraw[s].y), f3 = bf_hi(qraw[s].y), f4 = bf_lo(qraw[s].z), f5 = bf_hi(qraw[s].z), f6 = bf_lo(qraw[s].w), f7 = bf_hi(qraw[s].w);
        ss += (f0 * f0 + f1 * f1) + (f2 * f2 + f3 * f3) + (f4 * f4 + f5 * f5) + (f6 * f6 + f7 * f7); }
    ss += __shfl_xor(ss, 32);
    const float rq = 0.125f / sqrtf(ss * (1.0f / 64.0f) + EPS);
    bf16x8 qf[4];
#pragma unroll
    for (int s = 0; s < 4; ++s) { const f32x4 g0 = *(const GAS f32x4*)(qg + 16 * s + 8 * hh), g1 = *(const GAS f32x4*)(qg + 16 * s + 8 * hh + 4);
        v4u w; w.x = pk2(bf_lo(qraw[s].x) * rq * g0.x, bf_hi(qraw[s].x) * rq * g0.y); w.y = pk2(bf_lo(qraw[s].y) * rq * g0.z, bf_hi(qraw[s].y) * rq * g0.w);
        w.z = pk2(bf_lo(qraw[s].z) * rq * g1.x, bf_hi(qraw[s].z) * rq * g1.y); w.w = pk2(bf_lo(qraw[s].w) * rq * g1.z, bf_hi(qraw[s].w) * rq * g1.w);
        qf[s] = __builtin_bit_cast(bf16x8, w); }
    f32x16 sacc[6];
#pragma unroll
    for (int kt = 0; kt < 6; ++kt) {
#pragma unroll
        for (int r = 0; r < 16; ++r) sacc[kt][r] = 0.f;
#pragma unroll
        for (int s = 0; s < 4; ++s) { const bf16x8 a = *(const LAS bf16x8*)(Ks + (32 * kt + (lane & 31)) * 72 + 16 * s + 8 * hh); sacc[kt] = MFMA32(a, qf[s], sacc[kt]); }
    }
    const LAS float* btg = bt + g * 256 + 63 - i;
    float mx = -3.0e38f;
#pragma unroll
    for (int kt = 0; kt < 6; ++kt) { const bool masked = (c - 2 + (kt >> 1)) < 0;
#pragma unroll
        for (int r = 0; r < 16; ++r) { const int j = 32 * kt + (r & 3) + 8 * (r >> 2) + 4 * hh; float v = sacc[kt][r] + btg[j]; v = masked ? -1.0e30f : v; sacc[kt][r] = v; mx = fmaxf(mx, v); } }
    mx = fmaxf(mx, __shfl_xor(mx, 32));
    const float sink = sinks[habs], m = fmaxf(mx, sink);
    float sum = 0.f;
#pragma unroll
    for (int kt = 0; kt < 6; ++kt)
#pragma unroll
        for (int r = 0; r < 16; ++r) { const float p = __expf(sacc[kt][r] - m); sacc[kt][r] = p; sum += p; }
    sum += __shfl_xor(sum, 32);
    const float inv = 1.0f / (sum + __expf(sink - m));
    f32x16 oacc[2];
#pragma unroll
    for (int dt = 0; dt < 2; ++dt)
#pragma unroll
        for (int r = 0; r < 16; ++r) oacc[dt][r] = 0.f;
#pragma unroll
    for (int kt = 0; kt < 6; ++kt)
#pragma unroll
        for (int s2 = 0; s2 < 2; ++s2) {
            v4u w; w.x = pk2(sacc[kt][8 * s2 + 0], sacc[kt][8 * s2 + 1]); w.y = pk2(sacc[kt][8 * s2 + 2], sacc[kt][8 * s2 + 3]); w.z = pk2(sacc[kt][8 * s2 + 4], sacc[kt][8 * s2 + 5]); w.w = pk2(sacc[kt][8 * s2 + 6], sacc[kt][8 * s2 + 7]);
            const bf16x8 pb = __builtin_bit_cast(bf16x8, w);
#pragma unroll
            for (int dt = 0; dt < 2; ++dt) { const bf16x8 a = *(const LAS bf16x8*)(Vt + (32 * dt + (lane & 31)) * 200 + 32 * kt + 16 * s2 + 8 * hh); oacc[dt] = MFMA32(a, pb, oacc[dt]); }
        }
    bf16* op = AB + qrow * D + habs * 64;
#pragma unroll
    for (int dt = 0; dt < 2; ++dt)
#pragma unroll
        for (int q4 = 0; q4 < 4; ++q4) { const int d = 32 * dt + 8 * q4 + 4 * hh;
            const unsigned long long o = (unsigned long long)pk2(oacc[dt][4 * q4 + 0] * inv, oacc[dt][4 * q4 + 1] * inv) | ((unsigned long long)pk2(oacc[dt][4 * q4 + 2] * inv, oacc[dt][4 * q4 + 3] * inv) << 32);
            *(GAS unsigned long long*)(op + d) = o; }
    __syncthreads();
}

template <int W, bool START> __device__ __forceinline__ void pool_walk(const bf16* zc, bf16* oc, float s0, float s1, int pos0) {
    unsigned ring[16];
    float a0 = 0.f, a1 = 0.f;
#pragma unroll
    for (int q = 0; q < 16; ++q) ring[q] = 0u;
#pragma unroll
    for (int q = 1; q < W; ++q) { if (pos0 - q >= 0) { const unsigned u = *(const GAS unsigned*)(zc - (size_t)q * DIN); ring[(16 - q) & 15] = u; a0 += bf_lo(u); a1 += bf_hi(u); } }
    for (int rb = 0; rb < 64; rb += 16) {
#pragma unroll
        for (int i = 0; i < 16; ++i) {
            const unsigned u = *(const GAS unsigned*)(zc + (size_t)(rb + i) * DIN);
            const float c0 = bf_lo(u), c1 = bf_hi(u);
            a0 += c0; a1 += c1;
            float ic = 1.0f / (float)W; if (START) { const int pos = pos0 + rb + i; ic = 1.0f / (float)(pos + 1 < W ? pos + 1 : W); }
            *(GAS unsigned*)(oc + (size_t)(rb + i) * D) = pk2((a0 * ic - c0) * s0, (a1 * ic - c1) * s1);
            const unsigned old = ring[(i + 17 - W) & 15];
            a0 -= bf_lo(old); a1 -= bf_hi(old);
            ring[i] = u;
        }
    }
}
__device__ __forceinline__ void pool_rows(const bf16* Y, bf16* AB, const float* pscale, int unit, int tid) {
    const int cp = tid & 255, seg = tid >> 8, g = cp >> 6;
    const int r0 = unit * 128 + seg * 64, pos0 = r0 & (SEQ - 1);
    const bf16* zc = Y + (size_t)r0 * DIN + 768 + 2 * cp; bf16* oc = AB + (size_t)r0 * D + 512 + 2 * cp;
    const float s0 = pscale[2 * cp], s1 = pscale[2 * cp + 1];
    if (pos0 >= 16) { if (g == 0) pool_walk<2, false>(zc, oc, s0, s1, pos0); else if (g == 1) pool_walk<4, false>(zc, oc, s0, s1, pos0); else if (g == 2) pool_walk<8, false>(zc, oc, s0, s1, pos0); else pool_walk<16, false>(zc, oc, s0, s1, pos0); }
    else { if (g == 0) pool_walk<2, true>(zc, oc, s0, s1, pos0); else if (g == 1) pool_walk<4, true>(zc, oc, s0, s1, pos0); else if (g == 2) pool_walk<8, true>(zc, oc, s0, s1, pos0); else pool_walk<16, true>(zc, oc, s0, s1, pos0); }
}

__device__ __forceinline__ int f2key(float f) { return __builtin_bit_cast(int, f); }
__device__ __forceinline__ float key2f(int k) { return __builtin_bit_cast(float, k); }
#define CE_DESC(a, b) do { const int _x = (a), _y = (b); (a) = _x > _y ? _x : _y; (b) = _x > _y ? _y : _x; } while (0)
__device__ __forceinline__ void sort16_desc(int (&a)[16]) {
#pragma unroll
    for (int k = 2; k <= 16; k <<= 1)
#pragma unroll
        for (int j = k >> 1; j > 0; j >>= 1)
#pragma unroll
            for (int i = 0; i < 16; ++i) { const int l = i ^ j; if (l > i) { if ((i & k) == 0) CE_DESC(a[i], a[l]); else CE_DESC(a[l], a[i]); } }
}
__device__ __forceinline__ void merge_top16(int (&a)[16], const int (&b)[16]) {
#pragma unroll
    for (int i = 0; i < 16; ++i) a[i] = a[i] > b[15 - i] ? a[i] : b[15 - i];
#pragma unroll
    for (int j = 8; j > 0; j >>= 1)
#pragma unroll
        for (int i = 0; i < 16; ++i) { const int l = i ^ j; if (l > i) CE_DESC(a[i], a[l]); }
}
__device__ __forceinline__ void top16_of_64(int (&g0)[16], int (&g1)[16], int (&g2)[16], int (&g3)[16]) {
    sort16_desc(g0); sort16_desc(g1); sort16_desc(g2); sort16_desc(g3);
    merge_top16(g0, g1); merge_top16(g2, g3); merge_top16(g0, g2);
}
__device__ __forceinline__ void topk_stage_keys(LAS unsigned char* lds, const bf16* SK, int h, int tid) {
#pragma unroll
    for (int i = 0; i < 8; ++i) { const int c = tid + 512 * i, p = c >> 11, n = (c >> 4) & 127, ch = c & 15;
        *(LAS v4u*)(lds + p * 34816 + n * 272 + ch * 16) = *(const GAS v4u*)(SK + ((size_t)(h * 2 + p) * 128 + n) * 128 + ch * 8); }
    LDS_WAIT(); __syncthreads();
}
__device__ __forceinline__ void topk_unit(LAS unsigned char* lds, const bf16* QP, const bf16* SK, unsigned short* EXPERTS, float* BEST, int unit, int tid, int wave, int lane) {
    const int h = unit & 7, tt = unit >> 3, hh = lane >> 5;
    const int tok = tt * 256 + wave * 32 + (lane & 31);
    static_assert(69632 + 512 * 33 * 4 <= PHASE_LDS_MAX, "top-k LDS scratch runs into the LDS control words");
    LAS int* mine = (LAS int*)(lds + 69632) + tid * 33;
    int top[2][16];
#pragma unroll
    for (int p = 0; p < 2; ++p) {
        const bf16* qp = QP + (size_t)tok * DQ + h * 256 + p * 128 + 8 * hh;
        const LAS unsigned char* kp = lds + p * 34816 + (lane & 31) * 272 + 16 * hh;
        f32x16 acc[4];
#pragma unroll
        for (int nt = 0; nt < 4; ++nt)
#pragma unroll
            for (int r = 0; r < 16; ++r) acc[nt][r] = 8.0f;
#pragma unroll
        for (int s = 0; s < 8; ++s) { const bf16x8 bq = __builtin_bit_cast(bf16x8, *(const GAS v4u*)(qp + 16 * s));
#pragma unroll
            for (int nt = 0; nt < 4; ++nt) { const bf16x8 a = *(const LAS bf16x8*)(kp + nt * (32 * 272) + 32 * s); acc[nt] = MFMA32(a, bq, acc[nt]); } }
        int k0[16], k1[16], k2[16], k3[16];
#pragma unroll
        for (int r = 0; r < 16; ++r) { const int n = (r & 3) + 8 * (r >> 2) + 4 * hh;
            k0[r] = (f2key(acc[0][r]) & ~127) | n; k1[r] = (f2key(acc[1][r]) & ~127) | (32 + n); k2[r] = (f2key(acc[2][r]) & ~127) | (64 + n); k3[r] = (f2key(acc[3][r]) & ~127) | (96 + n); }
        top16_of_64(k0, k1, k2, k3);
#pragma unroll
        for (int r = 0; r < 16; ++r) k1[r] = __shfl_xor(k0[r], 32);
        merge_top16(k0, k1);
#pragma unroll
        for (int r = 0; r < 16; ++r) top[p][r] = k0[r];
    }
    int c0[16], c1[16], c2[16], c3[16];
    {
        float v1[16], v2[16];
#pragma unroll
        for (int r = 0; r < 16; ++r) { v1[r] = key2f(top[0][r] & ~127); v2[r] = key2f(top[1][r] & ~127); mine[r] = top[0][r]; mine[16 + r] = top[1][r]; }
        int cnt = 0;
#pragma unroll
        for (int i = 0; i < 16; ++i)
#pragma unroll
            for (int j = 0; j < 16; ++j) if ((i + 1) * (j + 1) <= 16) { const int key = (f2key(v1[i] + v2[j]) & ~255) | (i << 4) | j;
                if (cnt < 16) c0[cnt] = key; else if (cnt < 32) c1[cnt - 16] = key; else if (cnt < 48) c2[cnt - 32] = key; else c3[cnt - 48] = key; ++cnt; }
#pragma unroll
        for (int r = 0; r < 16; ++r) if (48 + r >= cnt) c3[r] = (int)0x80000000;
    }
    top16_of_64(c0, c1, c2, c3);
    LDS_WAIT();
    if (hh == 0) {
        int ev[16]; float bv[16];
#pragma unroll
        for (int r = 0; r < 16; ++r) { const int id = c0[r] & 255; const int ka = mine[id >> 4], kb = mine[16 + (id & 15)];
            ev[r] = (ka & 127) * 128 + (kb & 127); bv[r] = (key2f(ka & ~127) - 8.0f) + (key2f(kb & ~127) - 8.0f); }
        unsigned short* ep = EXPERTS + (size_t)tok * 128 + h * 16; float* bp = BEST + (size_t)tok * 128 + h * 16;
#pragma unroll
        for (int r = 0; r < 16; r += 8) *(GAS v4u*)(ep + r) = (v4u){(unsigned)ev[r] | ((unsigned)ev[r + 1] << 16), (unsigned)ev[r + 2] | ((unsigned)ev[r + 3] << 16), (unsigned)ev[r + 4] | ((unsigned)ev[r + 5] << 16), (unsigned)ev[r + 6] | ((unsigned)ev[r + 7] << 16)};
#pragma unroll
        for (int r = 0; r < 16; r += 4) *(GAS f32x4*)(bp + r) = (f32x4){bv[r], bv[r + 1], bv[r + 2], bv[r + 3]};
    }
    LDS_WAIT();
}

__device__ __forceinline__ float gelu_erf(float x) { return 0.5f * x * (1.0f + erff(x * 0.70710678118654752f)); }
#define PEER_BL(rs, e_, c_) __builtin_amdgcn_raw_buffer_load_b128(rs, (int)(((e_) << 7) + (c_)), 0, 0)
#define PEER_ROWS(r, rs, c_, q) do { const v4u _ev = *(const LAS v4u*)(evp + 16 * (q)); \
        r[0] = PEER_BL(rs, _ev.x & 0xffffu, c_); r[1] = PEER_BL(rs, _ev.x >> 16, c_); r[2] = PEER_BL(rs, _ev.y & 0xffffu, c_); r[3] = PEER_BL(rs, _ev.y >> 16, c_); \
        r[4] = PEER_BL(rs, _ev.z & 0xffffu, c_); r[5] = PEER_BL(rs, _ev.z >> 16, c_); r[6] = PEER_BL(rs, _ev.w & 0xffffu, c_); r[7] = PEER_BL(rs, _ev.w >> 16, c_); } while (0)
__device__ __forceinline__ void peer_u_phase(LAS unsigned char* lds, const bf16* X1B, const unsigned char* U8, const unsigned short* EXP16, float* PD, int j, int w, int nw, int wave, int lane) {
    const int grp = lane >> 3, sub = lane & 7;
    LAS unsigned char* wl = lds + wave * 8192;
    const LAS unsigned char* evp = wl + grp * 256;
    const int stride = nw * NWAVES * 8;
    int tb = (w * NWAVES + wave) * 8;
    v4u pe0 = {0u, 0u, 0u, 0u}, pe1 = {0u, 0u, 0u, 0u};
    v4u px0 = {0u, 0u, 0u, 0u}, px1 = {0u, 0u, 0u, 0u};
    if (tb < T) { const GAS v4u* e = (const GAS v4u*)(EXP16 + (size_t)tb * 128) + lane; pe0 = e[0]; pe1 = e[64];
        const GAS v4u* xp = (const GAS v4u*)(X1B + (size_t)(tb + grp) * D + 128 * j + 16 * sub); px0 = xp[0]; px1 = xp[1]; }
    const __amdgpu_buffer_rsrc_t urs = __builtin_amdgcn_make_buffer_rsrc((void*)U8, (short)0, NEXP * D, 0x00020000); const unsigned uc = (unsigned)j * (NEXP * 128u) + 16u * sub;
    for (; tb < T; tb += stride) {
        *(LAS v4u*)(wl + 16 * lane) = pe0; *(LAS v4u*)(wl + 1024 + 16 * lane) = pe1;
        const v4u xa = px0, xc = px1;
        if (tb + stride < T) { const GAS v4u* e = (const GAS v4u*)(EXP16 + (size_t)(tb + stride) * 128) + lane; pe0 = e[0]; pe1 = e[64];
            const GAS v4u* xp = (const GAS v4u*)(X1B + (size_t)(tb + stride + grp) * D + 128 * j + 16 * sub); px0 = xp[0]; px1 = xp[1]; }
        const int t = tb + grp;
        const f32x4 x0 = {bf_lo(xa.x), bf_hi(xa.x), bf_lo(xa.y), bf_hi(xa.y)}, x1 = {bf_lo(xa.z), bf_hi(xa.z), bf_lo(xa.w), bf_hi(xa.w)};
        const f32x4 x2 = {bf_lo(xc.x), bf_hi(xc.x), bf_lo(xc.y), bf_hi(xc.y)}, x3 = {bf_lo(xc.z), bf_hi(xc.z), bf_lo(xc.w), bf_hi(xc.w)};
        float amax = fmaxf(fmaxf(fmaxf(fabsf(x0.x), fabsf(x0.y)), fmaxf(fabsf(x0.z), fabsf(x0.w))), fmaxf(fmaxf(fabsf(x1.x), fabsf(x1.y)), fmaxf(fabsf(x1.z), fabsf(x1.w))));
        amax = fmaxf(amax, fmaxf(fmaxf(fmaxf(fabsf(x2.x), fabsf(x2.y)), fmaxf(fabsf(x2.z), fabsf(x2.w))), fmaxf(fmaxf(fabsf(x3.x), fabsf(x3.y)), fmaxf(fabsf(x3.z), fabsf(x3.w)))));
        amax = fmaxf(amax, __shfl_xor(amax, 1)); amax = fmaxf(amax, __shfl_xor(amax, 2)); amax = fmaxf(amax, __shfl_xor(amax, 4));
        const float inv = amax > 0.f ? 127.0f / amax : 0.f, sx = amax * (1.0f / 127.0f);
        const unsigned xq0 = pack_i8x4(x0.x * inv, x0.y * inv, x0.z * inv, x0.w * inv), xq1 = pack_i8x4(x1.x * inv, x1.y * inv, x1.z * inv, x1.w * inv);
        const unsigned xq2 = pack_i8x4(x2.x * inv, x2.y * inv, x2.z * inv, x2.w * inv), xq3 = pack_i8x4(x3.x * inv, x3.y * inv, x3.z * inv, x3.w * inv);
        LAS _Float16* pd = (LAS _Float16*)(wl + 4096) + grp * 128 + sub;
        LDS_WAIT();
        v4u ra[8], rb[8], rc[8];
        PEER_ROWS(ra, urs, uc, 0); PEER_ROWS(rb, urs, uc, 1);
#define PEER_UDOT(r, q) do { int p[8]; _Pragma("unroll") for (int i = 0; i < 8; ++i) { int a = __builtin_amdgcn_sdot4((int)r[i].x, (int)xq0, 0, false); a = __builtin_amdgcn_sdot4((int)r[i].y, (int)xq1, a, false); \
                a = __builtin_amdgcn_sdot4((int)r[i].z, (int)xq2, a, false); p[i] = __builtin_amdgcn_sdot4((int)r[i].w, (int)xq3, a, false); } \
            _Pragma("unroll") for (int o = 4; o > 0; o >>= 1) { const bool up = (sub & o) != 0; \
                _Pragma("unroll") for (int i = 0; i < o; ++i) { const int keep = up ? p[i + o] : p[i], send = up ? p[i] : p[i + o]; p[i] = keep + __shfl_xor(send, o); } } \
            pd[8 * (q)] = (_Float16)((float)p[0] * sx); } while (0)
        for (int q = 0; q < 15; q += 3) {
            PEER_ROWS(rc, urs, uc, q + 2); PEER_UDOT(ra, q);
            PEER_ROWS(ra, urs, uc, q + 3); PEER_UDOT(rb, q + 1);
            if (q + 4 < 16) PEER_ROWS(rb, urs, uc, q + 4);
            PEER_UDOT(rc, q + 2);
        }
        PEER_UDOT(ra, 15);
        LDS_WAIT();
#pragma unroll
        for (int qq = 0; qq < 2; ++qq) { const v4u pv = *(const LAS v4u*)(wl + 4096 + qq * 1024 + 16 * lane);
            *(GAS v4u*)((_Float16*)PD + ((size_t)j * T + tb + 4 * qq + (lane >> 4)) * 128 + 8 * (lane & 15)) = pv; }
    }
}
__device__ __forceinline__ void peer_stage_scales(LAS unsigned char* lds, const float* su, const float* sv, int tid) {
#pragma unroll
    for (int i = 0; i < 8; ++i) { *(LAS f32x4*)(lds + (size_t)(tid + 512 * i) * 16) = ((const GAS f32x4*)su)[tid + 512 * i]; *(LAS f32x4*)(lds + 65536 + (size_t)(tid + 512 * i) * 16) = ((const GAS f32x4*)sv)[tid + 512 * i]; }
    LDS_WAIT(); __syncthreads();
}
__device__ __forceinline__ void peer_combine4(LAS unsigned char* lds, const float* PD, const unsigned short* EXP16, const float* BEST, const float* SS2, unsigned char* CC8, float* SCC, int t0, int lane) {
    const LAS float* su = (const LAS float*)lds; const LAS float* sv = (const LAS float*)(lds + 65536);
    typedef float f32x2v __attribute__((ext_vector_type(2)));
    f32x4 ssv[4][4]; unsigned ev[4]; f32x2v bv[4]; f32x2v pdv[4][8];
#pragma unroll
    for (int i = 0; i < 4; ++i) { const int t = t0 + i;
        const GAS f32x4* sp = (const GAS f32x4*)(SS2 + (size_t)t * 16);
#pragma unroll
        for (int q = 0; q < 4; ++q) ssv[i][q] = sp[q];
        ev[i] = ((const GAS unsigned*)(EXP16 + (size_t)t * 128))[lane];
        bv[i] = ((const GAS f32x2v*)(BEST + (size_t)t * 128))[lane];
#pragma unroll
        for (int j = 0; j < 8; ++j) { typedef _Float16 h2v __attribute__((ext_vector_type(2))); const h2v hv = ((const GAS h2v*)((const _Float16*)PD + ((size_t)j * T + t) * 128))[lane]; pdv[i][j] = (f32x2v){(float)hv.x, (float)hv.y}; } }
    float suv[4][2], svv[4][2];
#pragma unroll
    for (int i = 0; i < 4; ++i) { const unsigned e0 = ev[i] & 0xffffu, e1 = ev[i] >> 16; suv[i][0] = su[e0]; suv[i][1] = su[e1]; svv[i][0] = sv[e0]; svv[i][1] = sv[e1]; }
#pragma unroll
    for (int i = 0; i < 4; ++i) { const int t = t0 + i;
        float ssq = 0.f;
#pragma unroll
        for (int q = 0; q < 4; ++q) ssq += (ssv[i][q].x + ssv[i][q].y) + (ssv[i][q].z + ssv[i][q].w);
        const float rstd2 = 1.0f / sqrtf(ssq * (1.0f / D) + EPS);
        const float s0 = bv[i].x * rstd2, s1 = bv[i].y * rstd2;
        float mx = fmaxf(s0, s1);
#pragma unroll
        for (int o = 1; o < 8; o <<= 1) mx = fmaxf(mx, __shfl_xor(mx, o));
        const float e0 = __expf(s0 - mx), e1 = __expf(s1 - mx); float sm = e0 + e1;
#pragma unroll
        for (int o = 1; o < 8; o <<= 1) sm += __shfl_xor(sm, o);
        float d0 = 0.f, d1 = 0.f;
#pragma unroll
        for (int j = 0; j < 8; ++j) { d0 += pdv[i][j].x; d1 += pdv[i][j].y; }
        const float inv_sm = 1.0f / sm;
        const float c0 = e0 * inv_sm * gelu_erf(d0 * rstd2 * suv[i][0]) * svv[i][0], c1 = e1 * inv_sm * gelu_erf(d1 * rstd2 * suv[i][1]) * svv[i][1];
        float amax = fmaxf(fabsf(c0), fabsf(c1));
#pragma unroll
        for (int o = 1; o < 64; o <<= 1) amax = fmaxf(amax, __shfl_xor(amax, o));
        const float inv = amax > 0.f ? 127.0f / amax : 0.f;
        ((GAS unsigned short*)(CC8 + (size_t)t * 128))[lane] = (unsigned short)((__float2int_rn(c0 * inv) & 0xff) | ((__float2int_rn(c1 * inv) & 0xff) << 8));
        if (lane == 0) SCC[t] = amax * (1.0f / 127.0f); }
}
__device__ __forceinline__ void peer_v_phase(LAS unsigned char* lds, float* OUT, const bf16* X1B, const unsigned char* V8, const unsigned short* EXP16, const unsigned char* CC8, const float* SCC, int j, int w, int nw, int wave, int lane) {
    const int grp = lane >> 3, sub = lane & 7;
    LAS unsigned char* wl = lds + wave * 8192;
    const LAS unsigned char* evp = wl + grp * 256;
    const LAS unsigned char* ccp = wl + 2048 + grp * 128;
    const int stride = nw * NWAVES * 8;
    int tb = (w * NWAVES + wave) * 8;
    v4u pe0 = {0u, 0u, 0u, 0u}, pe1 = {0u, 0u, 0u, 0u}, pc0 = {0u, 0u, 0u, 0u};
    if (tb < T) { const GAS v4u* e = (const GAS v4u*)(EXP16 + (size_t)tb * 128) + lane; pe0 = e[0]; pe1 = e[64]; pc0 = ((const GAS v4u*)(CC8 + (size_t)tb * 128))[lane]; }
    const __amdgpu_buffer_rsrc_t vrs = __builtin_amdgcn_make_buffer_rsrc((void*)V8, (short)0, NEXP * D, 0x00020000); const unsigned vc = (unsigned)j * (NEXP * 128u) + 16u * sub;
    for (; tb < T; tb += stride) {
        *(LAS v4u*)(wl + 16 * lane) = pe0; *(LAS v4u*)(wl + 1024 + 16 * lane) = pe1; *(LAS v4u*)(wl + 2048 + 16 * lane) = pc0;
        if (tb + stride < T) { const GAS v4u* e = (const GAS v4u*)(EXP16 + (size_t)(tb + stride) * 128) + lane; pe0 = e[0]; pe1 = e[64]; pc0 = ((const GAS v4u*)(CC8 + (size_t)(tb + stride) * 128))[lane]; }
        const int t = tb + grp;
        const float scc = SCC[t];
        const size_t eo = (size_t)t * D + 128 * j + 16 * sub;
        const GAS v4u* dp = (const GAS v4u*)(X1B + eo);
        const v4u da = dp[0], db = dp[1];
        int acc[16];
#pragma unroll
        for (int i = 0; i < 16; ++i) acc[i] = 0;
        LDS_WAIT();
        v4u rq[4][4];
#define PEER_LOADQ(r, qn) do { const unsigned long long _e4 = *(const LAS unsigned long long*)(evp + 8 * (qn)); const unsigned _lo = (unsigned)_e4, _hi = (unsigned)(_e4 >> 32); \
            r[0] = PEER_BL(vrs, _lo & 0xffffu, vc); r[1] = PEER_BL(vrs, _lo >> 16, vc); r[2] = PEER_BL(vrs, _hi & 0xffffu, vc); r[3] = PEER_BL(vrs, _hi >> 16, vc); } while (0)
#define PEER_T4(w_, r0, r1, r2, r3, cpk) do { const unsigned tl0 = __builtin_amdgcn_perm(r1, r0, 0x05010400u), th0 = __builtin_amdgcn_perm(r1, r0, 0x07030602u); \
            const unsigned tl1 = __builtin_amdgcn_perm(r3, r2, 0x05010400u), th1 = __builtin_amdgcn_perm(r3, r2, 0x07030602u); \
            acc[4 * (w_) + 0] = __builtin_amdgcn_sdot4((int)__builtin_amdgcn_perm(tl1, tl0, 0x05040100u), (int)(cpk), acc[4 * (w_) + 0], false); \
            acc[4 * (w_) + 1] = __builtin_amdgcn_sdot4((int)__builtin_amdgcn_perm(tl1, tl0, 0x07060302u), (int)(cpk), acc[4 * (w_) + 1], false); \
            acc[4 * (w_) + 2] = __builtin_amdgcn_sdot4((int)__builtin_amdgcn_perm(th1, th0, 0x05040100u), (int)(cpk), acc[4 * (w_) + 2], false); \
            acc[4 * (w_) + 3] = __builtin_amdgcn_sdot4((int)__builtin_amdgcn_perm(th1, th0, 0x07060302u), (int)(cpk), acc[4 * (w_) + 3], false); } while (0)
#define PEER_COMPQ(r, qn) do { const unsigned _c = *(const LAS unsigned*)(ccp + 4 * (qn)); \
            PEER_T4(0, r[0].x, r[1].x, r[2].x, r[3].x, _c); PEER_T4(1, r[0].y, r[1].y, r[2].y, r[3].y, _c); PEER_T4(2, r[0].z, r[1].z, r[2].z, r[3].z, _c); PEER_T4(3, r[0].w, r[1].w, r[2].w, r[3].w, _c); } while (0)
#pragma unroll
        for (int jq = 0; jq < 4; ++jq) PEER_LOADQ(rq[jq], jq);
        for (int it = 0; it < 8; ++it) {
#pragma unroll
            for (int jq = 0; jq < 4; ++jq) { PEER_COMPQ(rq[jq], 4 * it + jq); if (it < 7) PEER_LOADQ(rq[jq], 4 * it + 4 + jq); }
        }
        const float dl[16] = {bf_lo(da.x), bf_hi(da.x), bf_lo(da.y), bf_hi(da.y), bf_lo(da.z), bf_hi(da.z), bf_lo(da.w), bf_hi(da.w), bf_lo(db.x), bf_hi(db.x), bf_lo(db.y), bf_hi(db.y), bf_lo(db.z), bf_hi(db.z), bf_lo(db.w), bf_hi(db.w)};
#pragma unroll
        for (int q = 0; q < 4; ++q) { f32x4 v; v.x = dl[4 * q + 0] + scc * (float)acc[4 * q + 0]; v.y = dl[4 * q + 1] + scc * (float)acc[4 * q + 1]; v.z = dl[4 * q + 2] + scc * (float)acc[4 * q + 2]; v.w = dl[4 * q + 3] + scc * (float)acc[4 * q + 3];
            *(LAS f32x4*)(wl + 4096 + grp * 512 + sub * 64 + 16 * q) = v; }
        LDS_WAIT();
#pragma unroll
        for (int qq = 0; qq < 4; ++qq) { const f32x4 v = *(const LAS f32x4*)(wl + 4096 + qq * 1024 + 16 * lane);
            *(GAS f32x4*)(OUT + (size_t)(tb + 2 * qq + (lane >> 5)) * D + 128 * j + 4 * (lane & 31)) = v; }
    }
}
struct Args { const float* in[15]; float* out; unsigned char* ws; int ph_lo, ph_hi, li, pad; };
__global__ void __launch_bounds__(NWAVES * 64, 2) fwd_kernel(Args args) {
    extern __shared__ __attribute__((aligned(16))) unsigned char lds_raw[];
    LAS unsigned char* lds = (LAS unsigned char*)lds_raw;
    volatile LAS unsigned* MISC = (volatile LAS unsigned*)(lds + MISC_OFF);
    const int tid = threadIdx.x, lane = tid & 63, wave = __builtin_amdgcn_readfirstlane(tid >> 6);
    const int G = gridDim.x, bx = blockIdx.x;
    unsigned char* ws = args.ws;
    gu32* ctl = (gu32*)(ws + WS_CTL);
    for (int u = tid; u < (LDS_BYTES - LDSCTL_OFF) / 4; u += NWAVES * 64) ((LAS unsigned*)(lds + LDSCTL_OFF))[u] = 0u;
    __syncthreads();
    XcdBarrier bar; bar.bar = (unsigned*)(ctl + CW_BAR); bar.x = 0; bar.st = nullptr;
    if (N_LAUNCHES != PER_PHASE) bar = xcd_barrier_post((unsigned*)(ctl + CW_BAR) + args.li * XCD_BAR_WORDS, MISC + 8);
#define GRID_BAR() do { if (N_LAUNCHES != PER_PHASE) xcd_barrier(bar); } while (0)
    const int lo = args.ph_lo, hi = args.ph_hi;
#define IN(k) (lo <= (k) && (k) < hi)
#define BOTH(k) (IN(k) && IN((k) + 1))
#ifndef MK_REPEAT
#define MK_REPEAT -1
#endif
#define REP(k) for (int _r = 0; _r < ((MK_REPEAT == (k)) ? 2 : 1); ++_r)

    const float* x = args.in[0]; float* out = args.out;
    bf16* XB = (bf16*)(ws + WS_XB); bf16* WinT = (bf16*)(ws + WS_WIN); bf16* WoutT = (bf16*)(ws + WS_WOUT); bf16* WqT = (bf16*)(ws + WS_WQ);
    bf16* SK = (bf16*)(ws + WS_SK); bf16* PoolT = (bf16*)(ws + WS_POOLT); unsigned char* U8 = ws + WS_U8; unsigned char* V8 = ws + WS_V8; float* SU = (float*)(ws + WS_SU); float* SV = (float*)(ws + WS_SV);
    bf16* Y = (bf16*)(ws + WS_Y); bf16* AB = (bf16*)(ws + WS_AB); bf16* X1B = (bf16*)(ws + WS_X1B); bf16* QP = (bf16*)(ws + WS_QP);
    float* rstd1 = (float*)(ws + WS_RSTD1); float* SS2 = (float*)(ws + WS_SS2); unsigned short* EXPERTS = (unsigned short*)(ws + WS_EXP); float* BEST = (float*)(ws + WS_BEST);
    float* PD = (float*)(ws + WS_PD); bf16* DELTA = (bf16*)(ws + WS_DELTA); unsigned char* CC8 = ws + WS_CC; float* SCC = (float*)(ws + WS_SCC);
    const int gw = bx * NWAVES + wave, NGW = G * NWAVES;

    const P0Args p0a{x, args.in[1], args.in[2], args.in[7], args.in[9], args.in[10], args.in[11], args.in[12], args.in[13], args.in[14], XB, WinT, WoutT, WqT, SK, PoolT, U8, V8, SU, SV, rstd1};
    if (IN(0)) REP(0) {
        p0_prologue(p0a, lds, gw, NGW, wave, lane);
        if (BOTH(0)) GRID_BAR();
    }
    if (IN(1)) REP(1) {
        pg8::Gemm g{XB, WinT, T, DIN, D}; pg8::StaticOrder S; S.init(T, DIN, G, bx);
        pg8::EpiScaleBf16 E{Y, DIN, rstd1};
        pg8::gemm_phase<pg8::EpiScaleBf16, pg8::StaticOrder, true, true>(lds + RING_OFF, g, S, E);
        { const int nwg1 = (T / 256) * (DIN / 256), rem = nwg1 % G;
          if (rem == 0) p1_late_weights(p0a, lds, gw, NGW, wave, lane); else if (bx >= rem) p1_late_weights(p0a, lds, (bx - rem) * NWAVES + wave, (G - rem) * NWAVES, wave, lane); }
        if (BOTH(1)) GRID_BAR();
    }
    if (IN(2)) REP(2) {
        for (int u = bx; u < NB * 128 * 2; u += G) attn_unit(lds, Y, AB, args.in[3], args.in[4], args.in[5], args.in[6], u, tid, wave, lane);
        for (int u = bx; u < T / 128; u += G) pool_rows(Y, AB, args.in[8], u, tid);
        if (BOTH(2)) GRID_BAR();
    }
    if (IN(3)) REP(3) {
        pg8::Gemm g{AB, WoutT, T, D, D}; pg8::StaticOrder S; S.init(T, D, G, bx);
        pg8::EpiResid E{XB, X1B, SS2, D};
        pg8::gemm_phase<pg8::EpiResid, pg8::StaticOrder, true, true>(lds + RING_OFF, g, S, E);
        if (BOTH(3)) GRID_BAR();
    }
    if (IN(4)) REP(4) {
        pg8::Gemm g{X1B, WqT, T, DQ, D}; pg8::StaticOrder S; S.init(T, DQ, G, bx);
        pg8::EpiScaleBf16 E{QP, DQ, nullptr};
        pg8::gemm_phase<pg8::EpiScaleBf16, pg8::StaticOrder, true, true>(lds + RING_OFF, g, S, E);
        if (BOTH(4)) GRID_BAR();
    }
    if (IN(5)) REP(5) {
        { int hs = -1; for (int u = bx; u < (T / 256) * 8; u += G) { if ((u & 7) != hs) { if (hs >= 0) __syncthreads(); hs = u & 7; topk_stage_keys(lds, SK, hs, tid); } topk_unit(lds, QP, SK, EXPERTS, BEST, u, tid, wave, lane); } }
        if (BOTH(5)) GRID_BAR();
    }
    if (IN(6)) REP(6) {
        if ((G & 7) == 0) peer_u_phase(lds, X1B, U8, EXPERTS, PD, bx & 7, bx >> 3, G >> 3, wave, lane);
        else for (int j = 0; j < 8; ++j) peer_u_phase(lds, X1B, U8, EXPERTS, PD, j, bx, G, wave, lane);
        if (BOTH(6)) GRID_BAR();
    }
    if (IN(7)) REP(7) {
        peer_stage_scales(lds, SU, SV, tid);
        for (int t0 = gw * 4; t0 < T; t0 += NGW * 4) peer_combine4(lds, PD, EXPERTS, BEST, SS2, CC8, SCC, t0, lane);
        if (BOTH(7)) GRID_BAR();
    }
    if (IN(8)) {
        if ((G & 7) == 0) peer_v_phase(lds, out, X1B, V8, EXPERTS, CC8, SCC, bx & 7, bx >> 3, G >> 3, wave, lane);
        else for (int j = 0; j < 8; ++j) peer_v_phase(lds, out, X1B, V8, EXPERTS, CC8, SCC, j, bx, G, wave, lane);
    }
#undef IN
#undef BOTH
}

extern "C" void kernel_launch(void* const* d_in, const int* in_sizes, int n_in, void* d_out, int out_size, void* d_ws, size_t ws_size, hipStream_t stream) {
    static int grid = 0;
    if (grid == 0) {
        if (n_in != 15 || in_sizes[0] != T * D || out_size != T * D || ws_size < WS_END) { fprintf(stderr, "kernel_launch: unexpected shapes (n_in %d, in0 %d, out %d, ws %zu)\n", n_in, n_in > 0 ? in_sizes[0] : -1, out_size, ws_size); grid = -1; return; }
        int dev = 0, cus = 0, per_cu = 0;
        if (hipGetDevice(&dev) != hipSuccess || hipDeviceGetAttribute(&cus, hipDeviceAttributeMultiprocessorCount, dev) != hipSuccess) { grid = -1; return; }
        if (hipFuncSetAttribute((const void*)fwd_kernel, hipFuncAttributeMaxDynamicSharedMemorySize, LDS_BYTES) != hipSuccess) { fprintf(stderr, "kernel_launch: hipFuncSetAttribute failed\n"); grid = -1; return; }
        if (hipOccupancyMaxActiveBlocksPerMultiprocessor(&per_cu, (const void*)fwd_kernel, NWAVES * 64, LDS_BYTES) != hipSuccess || per_cu < 1) { fprintf(stderr, "kernel_launch: occupancy query reports %d blocks per CU\n", per_cu); }
        (void)hipGetLastError();
        grid = cus;
    }
    if (grid < 0) return;
    if (hipMemsetAsync((char*)d_ws + WS_CTL, 0, CTL_ZERO_BYTES, stream) != hipSuccess) return;
    Args a{};
    for (int i = 0; i < 15; ++i) a.in[i] = (const float*)d_in[i];
    a.out = (float*)d_out; a.ws = (unsigned char*)d_ws;
    for (int li = 0; li < N_LAUNCHES; ++li) {
        a.ph_lo = (N_LAUNCHES == PER_PHASE) ? li : 0; a.ph_hi = (N_LAUNCHES == PER_PHASE) ? li + 1 : PER_PHASE; a.li = (N_LAUNCHES == PER_PHASE) ? 0 : li;
        hipLaunchKernelGGL(fwd_kernel, dim3(grid), dim3(NWAVES * 64), LDS_BYTES, stream, a);
        const hipError_t le = hipPeekAtLastError();
        if (le != hipSuccess) { fprintf(stderr, "kernel_launch: launch %d failed: %s\n", li, hipGetErrorName(le)); break; }
    }
}
```

```cpp
#include <hip/hip_runtime.h>
#include <cstdio>
#include <cstdint>
namespace pg8 {
#define PG8_LAS __attribute__((address_space(3)))
typedef unsigned short bf16_t;
typedef short bf16x8 __attribute__((ext_vector_type(8)));
typedef float f32x4 __attribute__((ext_vector_type(4)));
typedef unsigned u32x4 __attribute__((ext_vector_type(4)));
constexpr int BM = 256, BK = 64, HALF = 128, HTB = HALF * BK * 2  , STAGE_BYTES = 8 * HTB, NXCD = 8, WGM = 8;

__host__ __device__ __forceinline__ int lds_byte(int r, int c) { const int st = (r >> 4) * 2 + (c >> 5), rr = r & 15, cc = c & 31, ob = rr * 64 + cc * 2; return st * 1024 + (ob ^ (((ob >> 9) & 1) << 5)); }
__host__ __device__ __forceinline__ void stage_rc(int b, int& R, int& C) { const int st = b / 1024, sb = b % 1024, swz = sb ^ (((sb >> 9) & 1) << 5); R = (st >> 1) * 16 + swz / 64; C = (st & 1) * 32 + (swz % 64) / 2; }
__host__ __device__ __forceinline__ int perm32(int rho) { const int n = rho >> 4, i = rho & 15; return 8 * (i >> 2) + 4 * n + (i & 3); }

struct Unit { int pm, pn; };
struct Gemm { const bf16_t* A; const bf16_t* Bt; int M, N, K; };

struct StaticOrder {
    int nM, nN, nwg, G, c;
    __host__ __device__ void init(int M, int N, int G_, int c_) { nM = M / BM; nN = N / BM; nwg = nM * nN; G = G_; c = c_; }
    __host__ __device__ bool next(int i, Unit& u) const {
        const long L = (long)i * G + c; if (L >= nwg) return false;
        int wgid = (int)L; { const int q = nwg / NXCD, r = nwg % NXCD, xcd = wgid % NXCD, off = wgid / NXCD; wgid = (xcd < r ? xcd * (q + 1) : r * (q + 1) + (xcd - r) * q) + off; }
        const int nig = WGM * nN, gid = wgid / nig, fm = gid * WGM, gsz = (nM - fm) < WGM ? (nM - fm) : WGM;
        u.pm = fm + ((wgid % nig) % gsz); u.pn = (wgid % nig) / gsz; return true;
    }
    __device__ __forceinline__ void a_ready(const Unit&) const {}
    __device__ __forceinline__ void done(const Unit&) const {}
};

__device__ __forceinline__ unsigned cvt_pk_bf16(float lo, float hi) { unsigned r; asm volatile("v_cvt_pk_bf16_f32 %0, %1, %2" : "=v"(r) : "v"(lo), "v"(hi)); return r; }
struct EpiScaleBf16 {
    static constexpr bool PERM = true, AFTER_DRAIN = false, PROBE_TWICE = false;
    bf16_t* O; int ldc; const float* rs;
    __device__ __forceinline__ void operator()(const f32x4 (&acc)[2][2][4][2], const Unit& u, int wr, int wc, int fr, int fq) const {
        const int row0 = u.pm * BM + wr * 64 + fr, col0 = u.pn * BM + wc * 32 + 8 * fq;
#pragma unroll
        for (int ai = 0; ai < 2; ++ai)
#pragma unroll
            for (int m = 0; m < 4; ++m) { const int row = row0 + ai * HALF + m * 16; const float s = rs ? rs[row] : 1.f; bf16_t* rowp = O + (size_t)row * ldc + col0;
#pragma unroll
                for (int bj = 0; bj < 2; ++bj) { const f32x4 v0 = acc[ai][bj][m][0] * s, v1 = acc[ai][bj][m][1] * s;
                    u32x4 w; w.x = cvt_pk_bf16(v0[0], v0[1]); w.y = cvt_pk_bf16(v0[2], v0[3]); w.z = cvt_pk_bf16(v1[0], v1[1]); w.w = cvt_pk_bf16(v1[2], v1[3]);
                    *(u32x4*)(rowp + bj * HALF) = w; } }
    }
};
struct EpiResid {
    static constexpr bool PERM = true, AFTER_DRAIN = false, PROBE_TWICE = false;
    const bf16_t* xbf; bf16_t* xb; float* ss; int ldc;
    __device__ __forceinline__ void operator()(const f32x4 (&acc)[2][2][4][2], const Unit& u, int wr, int wc, int fr, int fq) const {
        const int row0 = u.pm * BM + wr * 64 + fr, col0 = u.pn * BM + wc * 32 + 8 * fq;
#pragma unroll
        for (int ai = 0; ai < 2; ++ai)
#pragma unroll
            for (int m = 0; m < 4; ++m) { const int row = row0 + ai * HALF + m * 16; const size_t off = (size_t)row * ldc + col0; float q = 0.f;
#pragma unroll
                for (int bj = 0; bj < 2; ++bj) { const u32x4 xr = *(const u32x4*)(xbf + off + bj * HALF);
                    const f32x4 a0 = acc[ai][bj][m][0], a1 = acc[ai][bj][m][1];
                    f32x4 v0, v1;
                    v0[0] = a0[0] + __builtin_bit_cast(float, xr.x << 16); v0[1] = a0[1] + __builtin_bit_cast(float, xr.x & 0xffff0000u); v0[2] = a0[2] + __builtin_bit_cast(float, xr.y << 16); v0[3] = a0[3] + __builtin_bit_cast(float, xr.y & 0xffff0000u);
                    v1[0] = a1[0] + __builtin_bit_cast(float, xr.z << 16); v1[1] = a1[1] + __builtin_bit_cast(float, xr.z & 0xffff0000u); v1[2] = a1[2] + __builtin_bit_cast(float, xr.w << 16); v1[3] = a1[3] + __builtin_bit_cast(float, xr.w & 0xffff0000u);
                    u32x4 w; w.x = cvt_pk_bf16(v0[0], v0[1]); w.y = cvt_pk_bf16(v0[2], v0[3]); w.z = cvt_pk_bf16(v1[0], v1[1]); w.w = cvt_pk_bf16(v1[2], v1[3]);
                    *(u32x4*)(xb + off + bj * HALF) = w;
                    q += (v0[0] * v0[0] + v0[1] * v0[1]) + (v0[2] * v0[2] + v0[3] * v0[3]) + (v1[0] * v1[0] + v1[1] * v1[1]) + (v1[2] * v1[2] + v1[3] * v1[3]); }
                q += __shfl_xor(q, 16); q += __shfl_xor(q, 32);
                if (fq == 0) ss[(size_t)row * 16 + u.pn * 4 + wc] = q; }
    }
};
template <class Epi, class Sched, bool ALIGN_EPI = false, bool SP2 = false>
__device__ __forceinline__ void gemm_phase(PG8_LAS unsigned char* lds, const Gemm g, const Sched& S, const Epi& E) {
    const int tid = threadIdx.x, wid = __builtin_amdgcn_readfirstlane(tid >> 6), lane = tid & 63, wr = wid >> 2, wc = wid & 3, fr = lane & 15, fq = lane >> 4;
    const int K = g.K, nt = K / BK;
    unsigned voffA[2], voffB[2];
#pragma unroll
    for (int i = 0; i < 2; ++i) { int R, C; stage_rc(tid * 16 + i * 8192, R, C); const int Rb = Epi::PERM ? ((R & ~31) + perm32(R & 31)) : R;
        voffA[i] = (unsigned)(R * K + C) * 2u; voffB[i] = (unsigned)(Rb * K + C) * 2u; }
    const size_t kstep = (size_t)(BK * 2);
    const size_t hstep = (size_t)HALF * K * 2;
    const size_t tstep = 2 * hstep;
    const unsigned ldsw = (unsigned)wid * 1024u;
    const int aoff = lds_byte(wr * 64 + fr, fq * 8), boff = lds_byte(wc * 32 + fr, fq * 8);
#define PG8_SA(b, h) (((b) * 2 + (h)) * HTB)
#define PG8_SB(b, h) ((4 + (b) * 2 + (h)) * HTB)
#define PG8_STAGE(bufoff, gbase, voff) do { _Pragma("unroll") for (int _i = 0; _i < 2; ++_i) \
        __builtin_amdgcn_global_load_lds((const unsigned*)((const char*)(gbase) + (voff)[_i]), (PG8_LAS unsigned*)(lds + (bufoff) + ldsw + _i * 8192), 16, 0, 0); } while (0)
#define PG8_LDA(dst, b, h) do { _Pragma("unroll") for (int m = 0; m < 4; ++m) _Pragma("unroll") for (int k = 0; k < 2; ++k) dst[m][k] = *(const PG8_LAS bf16x8*)(lds + PG8_SA(b, h) + aoff + m * 2048 + k * 1024); } while (0)
#define PG8_LDB(dst, b, h) do { _Pragma("unroll") for (int n = 0; n < 2; ++n) _Pragma("unroll") for (int k = 0; k < 2; ++k) dst[n][k] = *(const PG8_LAS bf16x8*)(lds + PG8_SB(b, h) + boff + n * 2048 + k * 1024); } while (0)
#define PG8_MMA(ai, bj, At, Bt) do { __builtin_amdgcn_s_setprio(1); _Pragma("unroll") for (int m = 0; m < 4; ++m) _Pragma("unroll") for (int n = 0; n < 2; ++n) _Pragma("unroll") for (int k = 0; k < 2; ++k) \
        acc[ai][bj][m][n] = __builtin_amdgcn_mfma_f32_16x16x32_bf16(Bt[n][k], At[m][k], acc[ai][bj][m][n], 0, 0, 0); __builtin_amdgcn_s_setprio(0); } while (0)
#define PG8_WAIT_V(n) asm volatile("s_waitcnt vmcnt(" #n ")" ::: "memory")
#define PG8_WAIT_L(n) asm volatile("s_waitcnt lgkmcnt(" #n ")" ::: "memory")
#define PG8_BAR __builtin_amdgcn_s_barrier()
#define PG8_SCHED __builtin_amdgcn_sched_barrier(0)
    Unit cur, nxt; int ui = 0;
    if (!S.next(0, cur)) return;
    f32x4 acc[2][2][4][2];
#pragma unroll
    for (int a = 0; a < 2; ++a)
#pragma unroll
        for (int b = 0; b < 2; ++b)
#pragma unroll
            for (int m = 0; m < 4; ++m)
#pragma unroll
                for (int n = 0; n < 2; ++n) acc[a][b][m][n] = (f32x4){0.f, 0.f, 0.f, 0.f};
    bf16x8 At[4][2], B0[2][2], B1[2][2];
    const char* cA = (const char*)g.A + (size_t)cur.pm * tstep; const char* cB = (const char*)g.Bt + (size_t)cur.pn * tstep;
    S.a_ready(cur);
    if constexpr (SP2) {
        PG8_STAGE(PG8_SB(0, 0), cB, voffB); PG8_STAGE(PG8_SB(0, 1), cB + hstep, voffB); PG8_STAGE(PG8_SA(0, 0), cA, voffA); PG8_STAGE(PG8_SA(0, 1), cA + hstep, voffA);
        if (wr == 1) PG8_BAR;
        PG8_WAIT_V(2); PG8_BAR;
        PG8_STAGE(PG8_SB(1, 0), cB + kstep, voffB); PG8_STAGE(PG8_SA(1, 0), cA + kstep, voffA); PG8_STAGE(PG8_SB(1, 1), cB + hstep + kstep, voffB);
        PG8_WAIT_V(6); PG8_BAR;
    } else {
        PG8_STAGE(PG8_SB(0, 0), cB, voffB); PG8_STAGE(PG8_SA(0, 0), cA, voffA); PG8_STAGE(PG8_SB(0, 1), cB + hstep, voffB); PG8_STAGE(PG8_SA(0, 1), cA + hstep, voffA);
        if (wr == 1) PG8_BAR;
        PG8_WAIT_V(4); PG8_BAR;
        PG8_STAGE(PG8_SB(1, 0), cB + kstep, voffB); PG8_STAGE(PG8_SA(1, 0), cA + kstep, voffA); PG8_STAGE(PG8_SB(1, 1), cB + hstep + kstep, voffB);
        PG8_WAIT_V(6); PG8_BAR;
    }
    for (;;) {
        const bool has_next = S.next(ui + 1, nxt);
        const char* nA = has_next ? (const char*)g.A + (size_t)nxt.pm * tstep : cA; const char* nB = has_next ? (const char*)g.Bt + (size_t)nxt.pn * tstep : cB;
        for (int t = 0; t < nt; t += 2) {
            const bool last = (t == nt - 2);
            const char* a1 = cA + (size_t)(t + 1) * kstep;
            const char* a2 = last ? nA : cA + (size_t)(t + 2) * kstep; const char* b2 = last ? nB : cB + (size_t)(t + 2) * kstep;
            const char* a3 = a2 + kstep; const char* b3 = b2 + kstep;
            if (last && has_next) S.a_ready(nxt);
            if constexpr (SP2) {
            PG8_LDB(B0, 0, 0); PG8_LDB(B1, 0, 1); PG8_SCHED; PG8_LDA(At, 0, 0); PG8_STAGE(PG8_SA(1, 1), a1 + hstep, voffA);
            PG8_WAIT_V(8); PG8_WAIT_L(0); PG8_BAR; PG8_MMA(0, 0, At, B0); PG8_MMA(0, 1, At, B1); PG8_BAR; PG8_SCHED;
            PG8_LDA(At, 0, 1); PG8_STAGE(PG8_SB(0, 0), b2, voffB); PG8_STAGE(PG8_SB(0, 1), b2 + hstep, voffB); PG8_STAGE(PG8_SA(0, 0), a2, voffA);
            PG8_WAIT_V(8); PG8_WAIT_L(0); PG8_BAR; PG8_MMA(1, 0, At, B0); PG8_MMA(1, 1, At, B1); PG8_BAR; PG8_SCHED;
            PG8_LDB(B0, 1, 0); PG8_LDB(B1, 1, 1); PG8_SCHED; PG8_LDA(At, 1, 0); PG8_STAGE(PG8_SA(0, 1), a2 + hstep, voffA);
            PG8_WAIT_V(8); PG8_WAIT_L(0); PG8_BAR; PG8_MMA(0, 0, At, B0); PG8_MMA(0, 1, At, B1); PG8_BAR; PG8_SCHED;
            PG8_LDA(At, 1, 1); PG8_STAGE(PG8_SB(1, 0), b3, voffB); PG8_STAGE(PG8_SB(1, 1), b3 + hstep, voffB); PG8_STAGE(PG8_SA(1, 0), a3, voffA);
            PG8_WAIT_V(8); PG8_WAIT_L(0); PG8_BAR; PG8_MMA(1, 0, At, B0); PG8_MMA(1, 1, At, B1); PG8_BAR; PG8_SCHED;
            } else {
            PG8_LDB(B0, 0, 0); PG8_SCHED; PG8_LDA(At, 0, 0); PG8_STAGE(PG8_SA(1, 1), a1 + hstep, voffA);
            PG8_WAIT_L(8); PG8_BAR; PG8_WAIT_L(0); PG8_MMA(0, 0, At, B0); PG8_BAR; PG8_SCHED;
            PG8_LDB(B1, 0, 1); PG8_STAGE(PG8_SB(0, 0), b2, voffB);
            PG8_BAR; PG8_WAIT_L(0); PG8_MMA(0, 1, At, B1); PG8_BAR;
            PG8_LDA(At, 0, 1); PG8_STAGE(PG8_SA(0, 0), a2, voffA);
            PG8_BAR; PG8_WAIT_L(0); PG8_MMA(1, 0, At, B0); PG8_BAR; PG8_SCHED;
            PG8_STAGE(PG8_SB(0, 1), b2 + hstep, voffB);
            PG8_WAIT_V(6); PG8_BAR; PG8_MMA(1, 1, At, B1); PG8_BAR;
            PG8_LDB(B0, 1, 0); PG8_SCHED; PG8_LDA(At, 1, 0); PG8_STAGE(PG8_SA(0, 1), a2 + hstep, voffA);
            PG8_WAIT_L(8); PG8_BAR; PG8_WAIT_L(0); PG8_MMA(0, 0, At, B0); PG8_BAR; PG8_SCHED;
            PG8_LDB(B1, 1, 1); PG8_STAGE(PG8_SB(1, 0), b3, voffB);
            PG8_BAR; PG8_WAIT_L(0); PG8_MMA(0, 1, At, B1); PG8_BAR;
            PG8_LDA(At, 1, 1); PG8_STAGE(PG8_SA(1, 0), a3, voffA);
            PG8_BAR; PG8_WAIT_L(0); PG8_MMA(1, 0, At, B0); PG8_BAR; PG8_SCHED;
            PG8_STAGE(PG8_SB(1, 1), b3 + hstep, voffB);
            PG8_WAIT_V(6); PG8_BAR; PG8_MMA(1, 1, At, B1); PG8_BAR;
            }
        }
        if constexpr (ALIGN_EPI) { if (wr == 0) PG8_BAR; }
        if constexpr (!Epi::AFTER_DRAIN) { E(acc, cur, wr, wc, fr, fq);
#if defined(MK_EXTRA)
            if (Epi::PROBE_TWICE) { asm volatile("" ::: "memory"); E(acc, cur, wr, wc, fr, fq); }
#endif
            S.done(cur); }
        if (!has_next) break;
#pragma unroll
        for (int a = 0; a < 2; ++a)
#pragma unroll
            for (int b = 0; b < 2; ++b)
#pragma unroll
                for (int m = 0; m < 4; ++m)
#pragma unroll
                    for (int n = 0; n < 2; ++n) acc[a][b][m][n] = (f32x4){0.f, 0.f, 0.f, 0.f};
        cur = nxt; cA = nA; cB = nB; ++ui;
        if constexpr (ALIGN_EPI) { if (wr == 1) PG8_BAR; }
    }
    PG8_WAIT_V(0);
    if constexpr (!ALIGN_EPI) { if (wr == 0) PG8_BAR; }
    PG8_BAR;
    if constexpr (Epi::AFTER_DRAIN) { E.fused(acc, cur, wr, wc, fr, fq, lds, wid, lane); S.done(cur); }
#undef PG8_SA
#undef PG8_SB
#undef PG8_STAGE
#undef PG8_LDA
#undef PG8_LDB
#undef PG8_MMA
#undef PG8_WAIT_V
#undef PG8_WAIT_L
#undef PG8_BAR
#undef PG8_SCHED
}
}
constexpr int NWAVES = 8;
#ifndef MK_N_LAUNCHES
#define MK_N_LAUNCHES 1
#endif
constexpr int PER_PHASE = 9;
constexpr int N_LAUNCHES = MK_N_LAUNCHES;

constexpr int NB = 4, SEQ = 8192, T = NB * SEQ, D = 1024, DIN = 1280, NEXP = 16384, DQ = 2048;
constexpr float EPS = 1e-6f;

constexpr size_t MiB = 1u << 20;
constexpr size_t WS_CTL = 0, CTL_ZERO_BYTES = 1 * MiB;
constexpr size_t WS_WIN = 2 * MiB;
constexpr size_t WS_WOUT = 5 * MiB;
constexpr size_t WS_WQ = 7 * MiB;
constexpr size_t WS_SK = 11 * MiB;
constexpr size_t WS_POOLT = 11 * MiB + 512 * 1024;
constexpr size_t WS_RSTD1 = 12 * MiB;
constexpr size_t WS_SS2 = 13 * MiB;
constexpr size_t WS_SU = 15 * MiB;
constexpr size_t WS_SV = 15 * MiB + 256 * 1024;
constexpr size_t WS_EXP = 16 * MiB;
constexpr size_t WS_BEST = 24 * MiB;
constexpr size_t WS_CC = 40 * MiB;
constexpr size_t WS_SCC = 44 * MiB;
constexpr size_t WS_U8 = 56 * MiB;
constexpr size_t WS_V8 = 72 * MiB;
constexpr size_t WS_AB = 88 * MiB;
constexpr size_t WS_X1B = 152 * MiB;
constexpr size_t WS_PD = 216 * MiB;
constexpr size_t WS_DELTA = 360 * MiB;
constexpr size_t WS_XB = 216 * MiB;
constexpr size_t WS_Y = 280 * MiB;
constexpr size_t WS_QP = 216 * MiB;
constexpr size_t WS_END = 424 * MiB;
constexpr int CW_BAR = 4096;

constexpr int RING_OFF = 0, RING_BYTES = 131072;
constexpr int LDS_BYTES = 163840;
constexpr int LDSCTL_OFF = LDS_BYTES - 512, MISC_OFF = LDSCTL_OFF + 320;
constexpr int PHASE_LDS_MAX = LDSCTL_OFF;
#define GAS __attribute__((address_space(1)))
#define LAS __attribute__((address_space(3)))
typedef unsigned short bf16;
typedef unsigned v4u __attribute__((ext_vector_type(4)));
typedef float f32x4 __attribute__((ext_vector_type(4)));
typedef short bf16x8 __attribute__((ext_vector_type(8)));
typedef GAS unsigned gu32;
typedef GAS unsigned long long gu64;
#define RLX_AGENT __ATOMIC_RELAXED, __HIP_MEMORY_SCOPE_AGENT
#define LDS_WAIT() asm volatile("s_waitcnt lgkmcnt(0)" ::: "memory")
#define VM_WAIT() asm volatile("s_waitcnt vmcnt(0)" ::: "memory")
__device__ __forceinline__ unsigned long long rt() { return __builtin_amdgcn_s_memrealtime(); }
__device__ __forceinline__ unsigned f2bf(float f) { unsigned u = __builtin_bit_cast(unsigned, f); return (u + 0x7fffu + ((u >> 16) & 1u)) >> 16; }
__device__ __forceinline__ unsigned pk2(float lo, float hi) { return f2bf(lo) | (f2bf(hi) << 16); }
#define XB_TMO      128
#define XB_XCNT(j)  (256  + 64 * (j))
#define XB_XSUB(j)  (1280 + 64 * (j))
#define XB_XGEN(j)  (2304 + 64 * (j))
#define XB_TOP      3328
#define XB_TOPGEN   3392
#define XCD_BAR_WORDS 3456
#define XB_SPIN_CAP (1u << 18)

__device__ __forceinline__ unsigned xb_ld(unsigned* p)              { return __hip_atomic_load(p, __ATOMIC_RELAXED, __HIP_MEMORY_SCOPE_AGENT); }
__device__ __forceinline__ unsigned xb_add(unsigned* p, unsigned v) { return __hip_atomic_fetch_add(p, v, __ATOMIC_RELAXED, __HIP_MEMORY_SCOPE_AGENT); }
__device__ __forceinline__ unsigned xb_xcc_id() { return (unsigned)__builtin_amdgcn_s_getreg((3 << 11) | 20) & 0xFu; }
#define XB_SPIN(cond, bar) do { unsigned _sp = 0; while (cond) { __builtin_amdgcn_s_sleep(1); \
    if ((++_sp & 255u) == 0u) { if (xb_ld(&(bar)[XB_TMO])) break; if (_sp > XB_SPIN_CAP) { atomicAdd(&(bar)[XB_TMO], 1u); break; } } } } while (0)

struct XcdBarrier {
    unsigned* bar; unsigned x;
    volatile LAS unsigned* st;
};

__device__ __forceinline__ XcdBarrier xcd_barrier_post(unsigned* bar, volatile LAS unsigned* st) {
    XcdBarrier b; b.bar = bar; b.x = xb_xcc_id(); b.st = st;
    if (threadIdx.x == 0) (void)xb_add(&bar[XB_XCNT(b.x)], 1u);
    return b;
}
__device__ __forceinline__ void xcd_barrier_complete(unsigned* bar, unsigned x, unsigned& nloc, unsigned& nx) {
    const unsigned G = gridDim.x * gridDim.y * gridDim.z;
    unsigned sum, cnt, mine, sp = 0u;
    for (;;) {
        sum = 0u; cnt = 0u; mine = 0u;
#pragma unroll
        for (unsigned j = 0; j < 16; ++j) { const unsigned c = xb_ld(&bar[XB_XCNT(j)]); sum += c; cnt += (c > 0u) ? 1u : 0u; mine = (j == x) ? c : mine; }
        if (sum == G) break;
        __builtin_amdgcn_s_sleep(1);
        if ((++sp & 255u) == 0u) { if (xb_ld(&bar[XB_TMO])) break; if (sp > XB_SPIN_CAP) { atomicAdd(&bar[XB_TMO], 1u); break; } }
    }
    nloc = mine > 0u ? mine : 1u; nx = cnt > 0u ? cnt : 1u;
}

__device__ __forceinline__ void xcd_barrier(const XcdBarrier& b) {
    asm volatile("s_waitcnt vmcnt(0)" ::: "memory");
    __syncthreads();
    if (threadIdx.x == 0) {
        unsigned* bar = b.bar;
        __builtin_amdgcn_s_waitcnt(0);
        unsigned nloc = b.st[0], nx = b.st[1];
        if (nloc == 0u) { xcd_barrier_complete(bar, b.x, nloc, nx); b.st[0] = nloc; b.st[1] = nx; }
        const unsigned old = xb_add(&bar[XB_XSUB(b.x)], 1u);
        const unsigned gen = old / nloc;
        if (old + 1u == (gen + 1u) * nloc) {
            __builtin_amdgcn_fence(__ATOMIC_RELEASE, "agent");
            asm volatile("s_waitcnt vmcnt(0)" ::: "memory");
            const unsigned og = xb_add(&bar[XB_TOP], 1u);
            const unsigned tg = og / nx;
            if (og + 1u == (tg + 1u) * nx) xb_add(&bar[XB_TOPGEN], 1u);
            else XB_SPIN(xb_ld(&bar[XB_TOPGEN]) == tg, bar);
            __builtin_amdgcn_fence(__ATOMIC_ACQUIRE, "agent");
            xb_add(&bar[XB_XGEN(b.x)], 1u);
            asm volatile("s_waitcnt vmcnt(0)" ::: "memory");
        } else {
            XB_SPIN(xb_ld(&bar[XB_XGEN(b.x)]) == gen, bar);
            __builtin_amdgcn_fence(__ATOMIC_ACQUIRE, "agent");
            asm volatile("s_waitcnt vmcnt(0)" ::: "memory");
        }
    }
    __syncthreads();
}
typedef float f32x16 __attribute__((ext_vector_type(16)));
typedef __bf16 bf16x2_t __attribute__((ext_vector_type(2)));
#define MFMA32(a, b, c) __builtin_amdgcn_mfma_f32_32x32x16_bf16((a), (b), (c), 0, 0, 0)
__device__ __forceinline__ float bf_lo(unsigned u) { return __builtin_bit_cast(float, u << 16); }
__device__ __forceinline__ float bf_hi(unsigned u) { return __builtin_bit_cast(float, u & 0xffff0000u); }
__device__ __forceinline__ float dot2_bf16(unsigned w, unsigned x, float acc) { return __builtin_amdgcn_fdot2_f32_bf16(__builtin_bit_cast(bf16x2_t, w), __builtin_bit_cast(bf16x2_t, x), acc, false); }
__device__ __forceinline__ float wave_sum(float v) {
#pragma unroll
    for (int o = 1; o < 64; o <<= 1) v += __shfl_xor(v, o);
    return v;
}

__device__ __forceinline__ unsigned pack_i8x4(float a, float b, float c, float d) {
    return ((unsigned)__float2int_rn(a) & 0xffu) | (((unsigned)__float2int_rn(b) & 0xffu) << 8) | (((unsigned)__float2int_rn(c) & 0xffu) << 16) | (((unsigned)__float2int_rn(d) & 0xffu) << 24);
}

__device__ __forceinline__ void p0_transpose_item(const float* W, int K, int N, bf16* WT, const float* gk, LAS float* scr, int item, int lane) {
    const int nblk = N / 32, kb = item / nblk, nb = item % nblk, k0 = 64 * kb, n0 = 32 * nb;
    float wv[32];
#pragma unroll
    for (int i = 0; i < 32; ++i) wv[i] = W[(size_t)(k0 + 2 * i + (lane >> 5)) * N + n0 + (lane & 31)];
#pragma unroll
    for (int i = 0; i < 32; ++i) { const int kk = 2 * i + (lane >> 5); float w = wv[i]; if (gk) w *= gk[k0 + kk]; scr[kk * 33 + (lane & 31)] = w; }
    LDS_WAIT(); asm volatile("" ::: "memory");
    const int c = lane & 7;
#pragma unroll
    for (int j = 0; j < 4; ++j) { const int n = (lane >> 3) + 8 * j; const LAS float* s = scr + (8 * c) * 33 + n;
        v4u o; o.x = pk2(s[0 * 33], s[1 * 33]); o.y = pk2(s[2 * 33], s[3 * 33]); o.z = pk2(s[4 * 33], s[5 * 33]); o.w = pk2(s[6 * 33], s[7 * 33]);
        *(GAS v4u*)(WT + (size_t)(n0 + n) * K + k0 + 8 * c) = o; }
    LDS_WAIT(); asm volatile("" ::: "memory");
}
__device__ __forceinline__ float row_to_bf16(const float* src, bf16* dst, const float* g, int lane) {
    const GAS f32x4* xr = (const GAS f32x4*)src + lane; float s = 0.f;
    GAS unsigned long long* o8 = (GAS unsigned long long*)dst + lane;
#pragma unroll
    for (int j = 0; j < 4; ++j) { f32x4 v = xr[64 * j]; s += (v.x * v.x + v.y * v.y) + (v.z * v.z + v.w * v.w);
        if (g) { const f32x4 gv = ((const GAS f32x4*)g)[64 * j + lane]; v = v * gv; }
        o8[64 * j] = (unsigned long long)pk2(v.x, v.y) | ((unsigned long long)pk2(v.z, v.w) << 32); }
    return s;
}
__device__ __forceinline__ void row_to_i8(const float* src, unsigned char* dst, const float* g, float* sc, int m, int lane) {
    const GAS f32x4* xr = (const GAS f32x4*)src + lane; f32x4 v[4]; float amax = 0.f;
#pragma unroll
    for (int j = 0; j < 4; ++j) { v[j] = xr[64 * j]; if (g) { const f32x4 gv = ((const GAS f32x4*)g)[64 * j + lane]; v[j] = v[j] * gv; }
        amax = fmaxf(fmaxf(amax, fmaxf(fabsf(v[j].x), fabsf(v[j].y))), fmaxf(fabsf(v[j].z), fabsf(v[j].w))); }
#pragma unroll
    for (int o = 1; o < 64; o <<= 1) amax = fmaxf(amax, __shfl_xor(amax, o));
    const float inv = amax > 0.f ? 127.0f / amax : 0.f;
    GAS unsigned* o4 = (GAS unsigned*)dst + lane;
#pragma unroll
    for (int j = 0; j < 4; ++j) { const unsigned q0 = (unsigned)__float2int_rn(v[j].x * inv) & 0xffu, q1 = (unsigned)__float2int_rn(v[j].y * inv) & 0xffu, q2 = (unsigned)__float2int_rn(v[j].z * inv) & 0xffu, q3 = (unsigned)__float2int_rn(v[j].w * inv) & 0xffu;
        o4[64 * j] = q0 | (q1 << 8) | (q2 << 16) | (q3 << 24); }
    if (lane == 0) sc[m] = amax * (1.0f / 127.0f);
}
__device__ __forceinline__ void p0_poolfold_wg(const float* w_in, const float* pool_w, const float* g1, bf16* WinT, LAS unsigned char* lds, int item, int tid) {
    const int g = item & 3, kb = item >> 2, k0 = 16 * kb;
    LAS float* pw = (LAS float*)lds;
    LAS float* wt = (LAS float*)(lds + 65536);
#pragma unroll
    for (int i = 0; i < 8; ++i) *(LAS f32x4*)(pw + 4 * (tid + 512 * i)) = ((const GAS f32x4*)(pool_w + (size_t)g * 16384))[tid + 512 * i];
    { const int r = tid >> 5, c4 = tid & 31; *(LAS f32x4*)(wt + r * 128 + 4 * c4) = *(const GAS f32x4*)(w_in + (size_t)(k0 + r) * DIN + 768 + 128 * g + 4 * c4); }
    LDS_WAIT(); __syncthreads();
    const int kr = tid >> 5, nq = tid & 31;
    f32x4 acc = {0.f, 0.f, 0.f, 0.f};
#pragma unroll 4
    for (int c4 = 0; c4 < 32; ++c4) { const f32x4 a = *(const LAS f32x4*)(wt + kr * 128 + 4 * c4);
        acc = acc + a.x * *(const LAS f32x4*)(pw + (4 * c4 + 0) * 128 + 4 * nq); acc = acc + a.y * *(const LAS f32x4*)(pw + (4 * c4 + 1) * 128 + 4 * nq);
        acc = acc + a.z * *(const LAS f32x4*)(pw + (4 * c4 + 2) * 128 + 4 * nq); acc = acc + a.w * *(const LAS f32x4*)(pw + (4 * c4 + 3) * 128 + 4 * nq); }
    const float gk = g1[k0 + kr];
    bf16* o = WinT + (size_t)(768 + 128 * g + 4 * nq) * D + k0 + kr;
    o[0] = (bf16)f2bf(acc.x * gk); o[D] = (bf16)f2bf(acc.y * gk); o[2 * D] = (bf16)f2bf(acc.z * gk); o[3 * D] = (bf16)f2bf(acc.w * gk);
    __syncthreads();
}
struct P0Args { const float *x, *g1, *w_in, *pool_w, *w_out, *g2, *wq, *sk, *u, *v; bf16 *XB, *WinT, *WoutT, *WqT, *SK, *PoolT; unsigned char *U8, *V8; float *su, *sv; float* rstd1; };
__device__ __forceinline__ void p0_prologue(const P0Args& a, LAS unsigned char* lds, int gw, int NGW, int wave, int lane) {
    LAS float* scr = (LAS float*)(lds + RING_OFF + wave * 16384);
    for (int it = gw / NWAVES; it < 4 * (D / 16); it += NGW / NWAVES) p0_poolfold_wg(a.w_in, a.pool_w, a.g1, a.WinT, lds, it, wave * 64 + lane);
    constexpr int I_IN = (D / 64) * (768 / 32);
    for (int it = gw; it < I_IN; it += NGW) { const int kb = it / 24, nb = it % 24; p0_transpose_item(a.w_in, D, DIN, a.WinT, a.g1, scr, kb * 40 + nb, lane); }
    for (int m0 = gw; m0 < T; m0 += 4 * NGW) {
        f32x4 v[4][4];
#pragma unroll
        for (int r = 0; r < 4; ++r) { const int m = m0 + r * NGW < T ? m0 + r * NGW : m0; const GAS f32x4* xr = (const GAS f32x4*)(a.x + (size_t)m * D) + lane;
#pragma unroll
            for (int j = 0; j < 4; ++j) v[r][j] = xr[64 * j]; }
#pragma unroll
        for (int r = 0; r < 4; ++r) { const int m = m0 + r * NGW; if (m < T) {
            float s = 0.f; GAS unsigned long long* o8 = (GAS unsigned long long*)(a.XB + (size_t)m * D) + lane;
#pragma unroll
            for (int j = 0; j < 4; ++j) { const f32x4 w = v[r][j]; s += (w.x * w.x + w.y * w.y) + (w.z * w.z + w.w * w.w); o8[64 * j] = (unsigned long long)pk2(w.x, w.y) | ((unsigned long long)pk2(w.z, w.w) << 32); }
            s = wave_sum(s); if (lane == 0) a.rstd1[m] = 1.0f / sqrtf(s * (1.0f / D) + EPS); } }
    }
    for (int m0 = gw; m0 < 2 * NEXP; m0 += 4 * NGW) {
        f32x4 v[4][4];
#pragma unroll
        for (int r = 0; r < 4; ++r) { const int mm = m0 + r * NGW < 2 * NEXP ? m0 + r * NGW : m0; const bool isv = mm >= NEXP; const int m = isv ? mm - NEXP : mm;
            const GAS f32x4* xr = (const GAS f32x4*)((isv ? a.v : a.u) + (size_t)m * D) + lane;
#pragma unroll
            for (int j = 0; j < 4; ++j) v[r][j] = xr[64 * j]; }
#pragma unroll
        for (int r = 0; r < 4; ++r) { const int mm = m0 + r * NGW; if (mm < 2 * NEXP) { const bool isv = mm >= NEXP; const int m = isv ? mm - NEXP : mm;
            float amax = 0.f;
#pragma unroll
            for (int j = 0; j < 4; ++j) { if (!isv) { const f32x4 gv = ((const GAS f32x4*)a.g2)[64 * j + lane]; v[r][j] = v[r][j] * gv; }
                amax = fmaxf(fmaxf(amax, fmaxf(fabsf(v[r][j].x), fabsf(v[r][j].y))), fmaxf(fabsf(v[r][j].z), fabsf(v[r][j].w))); }
#pragma unroll
            for (int o = 1; o < 64; o <<= 1) amax = fmaxf(amax, __shfl_xor(amax, o));
            const float inv = amax > 0.f ? 127.0f / amax : 0.f;
            unsigned char* tb_ = (isv ? a.V8 : a.U8) + (size_t)m * 128 + ((4 * lane) & 127);
#pragma unroll
            for (int j = 0; j < 4; ++j) *(GAS unsigned*)(tb_ + (size_t)((4 * lane + 256 * j) >> 7) * ((size_t)NEXP * 128)) = pack_i8x4(v[r][j].x * inv, v[r][j].y * inv, v[r][j].z * inv, v[r][j].w * inv);
            if (lane == 0) (isv ? a.sv : a.su)[m] = amax * (1.0f / 127.0f); } }
    }
}
__device__ __forceinline__ void p1_late_weights(const P0Args& a, LAS unsigned char* lds, int gw, int NGW, int wave, int lane) {
    LAS float* scr = (LAS float*)(lds + RING_OFF + wave * 16384);
    constexpr int I_OUT = (D / 64) * (D / 32), I_Q = (D / 64) * (DQ / 32);
    for (int it = gw; it < I_OUT + I_Q; it += NGW) {
        if (it < I_OUT) p0_transpose_item(a.w_out, D, D, a.WoutT, nullptr, scr, it, lane);
        else p0_transpose_item(a.wq, D, DQ, a.WqT, a.g2, scr, it - I_OUT, lane);
    }
    for (int m = gw; m < 256; m += NGW) (void)row_to_bf16(a.sk + (size_t)m * D, a.SK + (size_t)m * D, nullptr, lane);
}

__device__ __forceinline__ int t5_bucket(int rel) {
    const int n = rel < 0 ? -rel : rel; const int base = rel > 0 ? 16 : 0;
    const int v = n < 8 ? n : (n < 12 ? 8 : (n < 16 ? 9 : (n < 23 ? 10 : (n < 32 ? 11 : (n < 46 ? 12 : (n < 64 ? 13 : (n < 91 ? 14 : 15)))))));
    return base + v;
}
__device__ __forceinline__ void attn_unit(LAS unsigned char* lds, const bf16* Y, bf16* AB, const float* qg, const float* kg, const float* sinks, const float* relb,
                                          int unit, int tid, int wave, int lane) {
    const int kvh = unit & 1, c = (unit >> 1) & 127, b = unit >> 8;
    LAS bf16* Ks = (LAS bf16*)lds;
    LAS bf16* Vt = (LAS bf16*)(lds + 27648);
    LAS float* bt = (LAS float*)(lds + 53248);
    const int row0 = b * SEQ + (c - 2) * 64;
#pragma unroll
    for (int rep = 0; rep < 3; ++rep) {
        const int it = tid + rep * 512, j = it >> 3, ch = it & 7;
        const bool valid = (c - 2 + (j >> 6)) >= 0;
        v4u kraw = {0u, 0u, 0u, 0u}, vraw = {0u, 0u, 0u, 0u};
        if (valid) { const bf16* rp = Y + (size_t)(row0 + j) * DIN; kraw = *(const GAS v4u*)(rp + 512 + 64 * kvh + 8 * ch); vraw = *(const GAS v4u*)(rp + 640 + 64 * kvh + 8 * ch); }
        float kf[8] = {bf_lo(kraw.x), bf_hi(kraw.x), bf_lo(kraw.y), bf_hi(kraw.y), bf_lo(kraw.z), bf_hi(kraw.z), bf_lo(kraw.w), bf_hi(kraw.w)};
        float ss = 0.f;
#pragma unroll
        for (int e = 0; e < 8; ++e) ss += kf[e] * kf[e];
        ss += __shfl_xor(ss, 1); ss += __shfl_xor(ss, 2); ss += __shfl_xor(ss, 4);
        const float r = 1.0f / sqrtf(ss * (1.0f / 64.0f) + EPS);
        const f32x4 g0 = *(const GAS f32x4*)(kg + 8 * ch), g1 = *(const GAS f32x4*)(kg + 8 * ch + 4);
        v4u ko; ko.x = pk2(kf[0] * r * g0.x, kf[1] * r * g0.y); ko.y = pk2(kf[2] * r * g0.z, kf[3] * r * g0.w); ko.z = pk2(kf[4] * r * g1.x, kf[5] * r * g1.y); ko.w = pk2(kf[6] * r * g1.z, kf[7] * r * g1.w);
        *(LAS v4u*)(Ks + j * 72 + 8 * ch) = ko;
        const int s16 = j >> 4, kk = j & 15, hh = (kk >> 2) & 1, jj = ((kk >> 3) << 2) | (kk & 3), pos = 16 * s16 + 8 * hh + jj;
        LAS bf16* vp = Vt + (8 * ch) * 200 + pos;
        vp[0 * 200] = (bf16)(vraw.x & 0xffffu); vp[1 * 200] = (bf16)(vraw.x >> 16); vp[2 * 200] = (bf16)(vraw.y & 0xffffu); vp[3 * 200] = (bf16)(vraw.y >> 16);
        vp[4 * 200] = (bf16)(vraw.z & 0xffffu); vp[5 * 200] = (bf16)(vraw.z >> 16); vp[6 * 200] = (bf16)(vraw.w & 0xffffu); vp[7 * 200] = (bf16)(vraw.w >> 16);
    }
#pragma unroll
    for (int rep = 0; rep < 2; ++rep) { const int it = tid + rep * 512, g = it >> 8, r = it & 255; bt[it] = relb[t5_bucket(r - 191) * 8 + kvh * 4 + g]; }
    LDS_WAIT(); __syncthreads();

    const int g = wave >> 1, i = 32 * (wave & 1) + (lane & 31), hh = lane >> 5, habs = kvh * 4 + g;
    const size_t qrow = (size_t)b * SEQ + (size_t)c * 64 + i;
    const bf16* qp = Y + qrow * DIN + habs * 64 + 8 * hh;
    v4u qraw[4]; float ss = 0.f;
#pragma unroll
    for (int s = 0; s < 4; ++s) { qraw[s] = *(const GAS v4u*)(qp + 16 * s);
        const float f0 = bf_lo(qraw[s].x), f1 = bf_hi(qraw[s].x), f2 = bf_lo(qraw[s].y), f3 = bf_hi(qraw[s].y), f4 = bf_lo(qraw[s].z), f5 = bf_hi(qraw[s].z), f6 = bf_lo(qraw[s].w), f7 = bf_hi(qraw[s].w);
        ss += (f0 * f0 + f1 * f1) + (f2 * f2 + f3 * f3) + (f4 * f4 + f5 * f5) + (f6 * f6 + f7 * f7); }
    ss += __shfl_xor(ss, 32);
    const float rq = 0.125f / sqrtf(ss * (1.0f / 64.0f) + EPS);
    bf16x8 qf[4];
#pragma unroll
    for (int s = 0; s < 4; ++s) { const f32x4 g0 = *(const GAS f32x4*)(qg + 16 * s + 8 * hh), g1 = *(const GAS f32x4*)(qg + 16 * s + 8 * hh + 4);
        v4u w; w.x = pk2(bf_lo(qraw[s].x) * rq * g0.x, bf_hi(qraw[s].x) * rq * g0.y); w.y = pk2(bf_lo(qraw[s].y) * rq * g0.z, bf_hi(qraw[s].y) * rq * g0.w);
        w.z = pk2(bf_lo(qraw[s].z) * rq * g1.x, bf_hi(qraw[s].z) * rq * g1.y); w.w = pk2(bf_lo(qraw[s].w) * rq * g1.z, bf_hi(qraw[s].w) * rq * g1.w);
        qf[s] = __builtin_bit_cast(bf16x8, w); }
    f32x16 sacc[6];
#pragma unroll
    for (int kt = 0; kt < 6; ++kt) {
#pragma unroll
        for (int r = 0; r < 16; ++r) sacc[kt][r] = 0.f;
#pragma unroll
        for (int s = 0; s < 4; ++s) { const bf16x8 a = *(const LAS bf16x8*)(Ks + (32 * kt + (lane & 31)) * 72 + 16 * s + 8 * hh); sacc[kt] = MFMA32(a, qf[s], sacc[kt]); }
    }
    const LAS float* btg = bt + g * 256 + 63 - i;
    float mx = -3.0e38f;
#pragma unroll
    for (int kt = 0; kt < 6; ++kt) { const bool masked = (c - 2 + (kt >> 1)) < 0;
#pragma unroll
        for (int r = 0; r < 16; ++r) { const int j = 32 * kt + (r & 3) + 8 * (r >> 2) + 4 * hh; float v = sacc[kt][r] + btg[j]; v = masked ? -1.0e30f : v; sacc[kt][r] = v; mx = fmaxf(mx, v); } }
    mx = fmaxf(mx, __shfl_xor(mx, 32));
    const float sink = sinks[habs], m = fmaxf(mx, sink);
    float sum = 0.f;
#pragma unroll
    for (int kt = 0; kt < 6; ++kt)
#pragma unroll
        for (int r = 0; r < 16; ++r) { const float p = __expf(sacc[kt][r] - m); sacc[kt][r] = p; sum += p; }
    sum += __shfl_xor(sum, 32);
    const float inv = 1.0f / (sum + __expf(sink - m));
    f32x16 oacc[2];
#pragma unroll
    for (int dt = 0; dt < 2; ++dt)
#pragma unroll
        for (int r = 0; r < 16; ++r) oacc[dt][r] = 0.f;
#pragma unroll
    for (int kt = 0; kt < 6; ++kt)
#pragma unroll
        for (int s2 = 0; s2 < 2; ++s2) {
            v4u w; w.x = pk2(sacc[kt][8 * s2 + 0], sacc[kt][8 * s2 + 1]); w.y = pk2(sacc[kt][8 * s2 + 2], sacc[kt][8 * s2 + 3]); w.z = pk2(sacc[kt][8 * s2 + 4], sacc[kt][8 * s2 + 5]); w.w = pk2(sacc[kt][8 * s2 + 6], sacc[kt][8 * s2 + 7]);
            const bf16x8 pb = __builtin_bit_cast(bf16x8, w);
#pragma unroll
            for (int dt = 0; dt < 2; ++dt) { const bf16x8 a = *(const LAS bf16x8*)(Vt + (32 * dt + (lane & 31)) * 200 + 32 * kt + 16 * s2 + 8 * hh); oacc[dt] = MFMA32(a, pb, oacc[dt]); }
        }
    bf16* op = AB + qrow * D + habs * 64;
#pragma unroll
    for (int dt = 0; dt < 2; ++dt)
#pragma unroll
        for (int q4 = 0; q4 < 4; ++q4) { const int d = 32 * dt + 8 * q4 + 4 * hh;
            const unsigned long long o = (unsigned long long)pk2(oacc[dt][4 * q4 + 0] * inv, oacc[dt][4 * q4 + 1] * inv) | ((unsigned long long)pk2(oacc[dt][4 * q4 + 2] * inv, oacc[dt][4 * q4 + 3] * inv) << 32);
            *(GAS unsigned long long*)(op + d) = o; }
    __syncthreads();
}

template <int W, bool START> __device__ __forceinline__ void pool_walk(const bf16* zc, bf16* oc, float s0, float s1, int pos0) {
    unsigned ring[16];
    float a0 = 0.f, a1 = 0.f;
#pragma unroll
    for (int q = 0; q < 16; ++q) ring[q] = 0u;
#pragma unroll
    for (int q = 1; q < W; ++q) { if (pos0 - q >= 0) { const unsigned u = *(const GAS unsigned*)(zc - (size_t)q * DIN); ring[(16 - q) & 15] = u; a0 += bf_lo(u); a1 += bf_hi(u); } }
    for (int rb = 0; rb < 64; rb += 16) {
#pragma unroll
        for (int i = 0; i < 16; ++i) {
            const unsigned u = *(const GAS unsigned*)(zc + (size_t)(rb + i) * DIN);
            const float c0 = bf_lo(u), c1 = bf_hi(u);
            a0 += c0; a1 += c1;
            float ic = 1.0f / (float)W; if (START) { const int pos = pos0 + rb + i; ic = 1.0f / (float)(pos + 1 < W ? pos + 1 : W); }
            *(GAS unsigned*)(oc + (size_t)(rb + i) * D) = pk2((a0 * ic - c0) * s0, (a1 * ic - c1) * s1);
            const unsigned old = ring[(i + 17 - W) & 15];
            a0 -= bf_lo(old); a1 -= bf_hi(old);
            ring[i] = u;
        }
    }
}
__device__ __forceinline__ void pool_rows(const bf16* Y, bf16* AB, const float* pscale, int unit, int tid) {
    const int cp = tid & 255, seg = tid >> 8, g = cp >> 6;
    const int r0 = unit * 128 + seg * 64, pos0 = r0 & (SEQ - 1);
    const bf16* zc = Y + (size_t)r0 * DIN + 768 + 2 * cp; bf16* oc = AB + (size_t)r0 * D + 512 + 2 * cp;
    const float s0 = pscale[2 * cp], s1 = pscale[2 * cp + 1];
    if (pos0 >= 16) { if (g == 0) pool_walk<2, false>(zc, oc, s0, s1, pos0); else if (g == 1) pool_walk<4, false>(zc, oc, s0, s1, pos0); else if (g == 2) pool_walk<8, false>(zc, oc, s0, s1, pos0); else pool_walk<16, false>(zc, oc, s0, s1, pos0); }
    else { if (g == 0) pool_walk<2, true>(zc, oc, s0, s1, pos0); else if (g == 1) pool_walk<4, true>(zc, oc, s0, s1, pos0); else if (g == 2) pool_walk<8, true>(zc, oc, s0, s1, pos0); else pool_walk<16, true>(zc, oc, s0, s1, pos0); }
}

__device__ __forceinline__ int f2key(float f) { return __builtin_bit_cast(int, f); }
__device__ __forceinline__ float key2f(int k) { return __builtin_bit_cast(float, k); }
#define CE_DESC(a, b) do { const int _x = (a), _y = (b); (a) = _x > _y ? _x : _y; (b) = _x > _y ? _y : _x; } while (0)
__device__ __forceinline__ void sort16_desc(int (&a)[16]) {
#pragma unroll
    for (int k = 2; k <= 16; k <<= 1)
#pragma unroll
        for (int j = k >> 1; j > 0; j >>= 1)
#pragma unroll
            for (int i = 0; i < 16; ++i) { const int l = i ^ j; if (l > i) { if ((i & k) == 0) CE_DESC(a[i], a[l]); else CE_DESC(a[l], a[i]); } }
}
__device__ __forceinline__ void merge_top16(int (&a)[16], const int (&b)[16]) {
#pragma unroll
    for (int i = 0; i < 16; ++i) a[i] = a[i] > b[15 - i] ? a[i] : b[15 - i];
#pragma unroll
    for (int j = 8; j > 0; j >>= 1)
#pragma unroll
        for (int i = 0; i < 16; ++i) { const int l = i ^ j; if (l > i) CE_DESC(a[i], a[l]); }
}
__device__ __forceinline__ void top16_of_64(int (&g0)[16], int (&g1)[16], int (&g2)[16], int (&g3)[16]) {
    sort16_desc(g0); sort16_desc(g1); sort16_desc(g2); sort16_desc(g3);
    merge_top16(g0, g1); merge_top16(g2, g3); merge_top16(g0, g2);
}
__device__ __forceinline__ void topk_stage_keys(LAS unsigned char* lds, const bf16* SK, int h, int tid) {
#pragma unroll
    for (int i = 0; i < 8; ++i) { const int c = tid + 512 * i, p = c >> 11, n = (c >> 4) & 127, ch = c & 15;
        *(LAS v4u*)(lds + p * 34816 + n * 272 + ch * 16) = *(const GAS v4u*)(SK + ((size_t)(h * 2 + p) * 128 + n) * 128 + ch * 8); }
    LDS_WAIT(); __syncthreads();
}
__device__ __forceinline__ void topk_unit(LAS unsigned char* lds, const bf16* QP, const bf16* SK, unsigned short* EXPERTS, float* BEST, int unit, int tid, int wave, int lane) {
    const int h = unit & 7, tt = unit >> 3, hh = lane >> 5;
    const int tok = tt * 256 + wave * 32 + (lane & 31);
    static_assert(69632 + 512 * 33 * 4 <= PHASE_LDS_MAX, "top-k LDS scratch runs into the LDS control words");
    LAS int* mine = (LAS int*)(lds + 69632) + tid * 33;
    int top[2][16];
#pragma unroll
    for (int p = 0; p < 2; ++p) {
        const bf16* qp = QP + (size_t)tok * DQ + h * 256 + p * 128 + 8 * hh;
        const LAS unsigned char* kp = lds + p * 34816 + (lane & 31) * 272 + 16 * hh;
        f32x16 acc[4];
#pragma unroll
        for (int nt = 0; nt < 4; ++nt)
#pragma unroll
            for (int r = 0; r < 16; ++r) acc[nt][r] = 8.0f;
#pragma unroll
        for (int s = 0; s < 8; ++s) { const bf16x8 bq = __builtin_bit_cast(bf16x8, *(const GAS v4u*)(qp + 16 * s));
#pragma unroll
            for (int nt = 0; nt < 4; ++nt) { const bf16x8 a = *(const LAS bf16x8*)(kp + nt * (32 * 272) + 32 * s); acc[nt] = MFMA32(a, bq, acc[nt]); } }
        int k0[16], k1[16], k2[16], k3[16];
#pragma unroll
        for (int r = 0; r < 16; ++r) { const int n = (r & 3) + 8 * (r >> 2) + 4 * hh;
            k0[r] = (f2key(acc[0][r]) & ~127) | n; k1[r] = (f2key(acc[1][r]) & ~127) | (32 + n); k2[r] = (f2key(acc[2][r]) & ~127) | (64 + n); k3[r] = (f2key(acc[3][r]) & ~127) | (96 + n); }
        top16_of_64(k0, k1, k2, k3);
#pragma unroll
        for (int r = 0; r < 16; ++r) k1[r] = __shfl_xor(k0[r], 32);
        merge_top16(k0, k1);
#pragma unroll
        for (int r = 0; r < 16; ++r) top[p][r] = k0[r];
    }
    int c0[16], c1[16], c2[16], c3[16];
    {
        float v1[16], v2[16];
#pragma unroll
        for (int r = 0; r < 16; ++r) { v1[r] = key2f(top[0][r] & ~127); v2[r] = key2f(top[1][r] & ~127); mine[r] = top[0][r]; mine[16 + r] = top[1][r]; }
        int cnt = 0;
#pragma unroll
        for (int i = 0; i < 16; ++i)
#pragma unroll
            for (int j = 0; j < 16; ++j) if ((i + 1) * (j + 1) <= 16) { const int key = (f2key(v1[i] + v2[j]) & ~255) | (i << 4) | j;
                if (cnt < 16) c0[cnt] = key; else if (cnt < 32) c1[cnt - 16] = key; else if (cnt < 48) c2[cnt - 32] = key; else c3[cnt - 48] = key; ++cnt; }
#pragma unroll
        for (int r = 0; r < 16; ++r) if (48 + r >= cnt) c3[r] = (int)0x80000000;
    }
    top16_of_64(c0, c1, c2, c3);
    LDS_WAIT();
    if (hh == 0) {
        int ev[16]; float bv[16];
#pragma unroll
        for (int r = 0; r < 16; ++r) { const int id = c0[r] & 255; const int ka = mine[id >> 4], kb = mine[16 + (id & 15)];
            ev[r] = (ka & 127) * 128 + (kb & 127); bv[r] = (key2f(ka & ~127) - 8.0f) + (key2f(kb & ~127) - 8.0f); }
        unsigned short* ep = EXPERTS + (size_t)tok * 128 + h * 16; float* bp = BEST + (size_t)tok * 128 + h * 16;
#pragma unroll
        for (int r = 0; r < 16; r += 8) *(GAS v4u*)(ep + r) = (v4u){(unsigned)ev[r] | ((unsigned)ev[r + 1] << 16), (unsigned)ev[r + 2] | ((unsigned)ev[r + 3] << 16), (unsigned)ev[r + 4] | ((unsigned)ev[r + 5] << 16), (unsigned)ev[r + 6] | ((unsigned)ev[r + 7] << 16)};
#pragma unroll
        for (int r = 0; r < 16; r += 4) *(GAS f32x4*)(bp + r) = (f32x4){bv[r], bv[r + 1], bv[r + 2], bv[r + 3]};
    }
    LDS_WAIT();
}

__device__ __forceinline__ float gelu_erf(float x) { return 0.5f * x * (1.0f + erff(x * 0.70710678118654752f)); }
#define PEER_BL(rs, e_, c_) __builtin_amdgcn_raw_buffer_load_b128(rs, (int)(((e_) << 7) + (c_)), 0, 0)
#define PEER_ROWS(r, rs, c_, q) do { const v4u _ev = *(const LAS v4u*)(evp + 16 * (q)); \
        r[0] = PEER_BL(rs, _ev.x & 0xffffu, c_); r[1] = PEER_BL(rs, _ev.x >> 16, c_); r[2] = PEER_BL(rs, _ev.y & 0xffffu, c_); r[3] = PEER_BL(rs, _ev.y >> 16, c_); \
        r[4] = PEER_BL(rs, _ev.z & 0xffffu, c_); r[5] = PEER_BL(rs, _ev.z >> 16, c_); r[6] = PEER_BL(rs, _ev.w & 0xffffu, c_); r[7] = PEER_BL(rs, _ev.w >> 16, c_); } while (0)
__device__ __forceinline__ void peer_u_phase(LAS unsigned char* lds, const bf16* X1B, const unsigned char* U8, const unsigned short* EXP16, float* PD, int j, int w, int nw, int wave, int lane) {
    const int grp = lane >> 3, sub = lane & 7;
    LAS unsigned char* wl = lds + wave * 8192;
    const LAS unsigned char* evp = wl + grp * 256;
    const int stride = nw * NWAVES * 8;
    int tb = (w * NWAVES + wave) * 8;
    v4u pe0 = {0u, 0u, 0u, 0u}, pe1 = {0u, 0u, 0u, 0u};
    v4u px0 = {0u, 0u, 0u, 0u}, px1 = {0u, 0u, 0u, 0u};
    if (tb < T) { const GAS v4u* e = (const GAS v4u*)(EXP16 + (size_t)tb * 128) + lane; pe0 = e[0]; pe1 = e[64];
        const GAS v4u* xp = (const GAS v4u*)(X1B + (size_t)(tb + grp) * D + 128 * j + 16 * sub); px0 = xp[0]; px1 = xp[1]; }
    const __amdgpu_buffer_rsrc_t urs = __builtin_amdgcn_make_buffer_rsrc((void*)U8, (short)0, NEXP * D, 0x00020000); const unsigned uc = (unsigned)j * (NEXP * 128u) + 16u * sub;
    for (; tb < T; tb += stride) {
        *(LAS v4u*)(wl + 16 * lane) = pe0; *(LAS v4u*)(wl + 1024 + 16 * lane) = pe1;
        const v4u xa = px0, xc = px1;
        if (tb + stride < T) { const GAS v4u* e = (const GAS v4u*)(EXP16 + (size_t)(tb + stride) * 128) + lane; pe0 = e[0]; pe1 = e[64];
            const GAS v4u* xp = (const GAS v4u*)(X1B + (size_t)(tb + stride + grp) * D + 128 * j + 16 * sub); px0 = xp[0]; px1 = xp[1]; }
        const int t = tb + grp;
        const f32x4 x0 = {bf_lo(xa.x), bf_hi(xa.x), bf_lo(xa.y), bf_hi(xa.y)}, x1 = {bf_lo(xa.z), bf_hi(xa.z), bf_lo(xa.w), bf_hi(xa.w)};
        const f32x4 x2 = {bf_lo(xc.x), bf_hi(xc.x), bf_lo(xc.y), bf_hi(xc.y)}, x3 = {bf_lo(xc.z), bf_hi(xc.z), bf_lo(xc.w), bf_hi(xc.w)};
        float amax = fmaxf(fmaxf(fmaxf(fabsf(x0.x), fabsf(x0.y)), fmaxf(fabsf(x0.z), fabsf(x0.w))), fmaxf(fmaxf(fabsf(x1.x), fabsf(x1.y)), fmaxf(fabsf(x1.z), fabsf(x1.w))));
        amax = fmaxf(amax, fmaxf(fmaxf(fmaxf(fabsf(x2.x), fabsf(x2.y)), fmaxf(fabsf(x2.z), fabsf(x2.w))), fmaxf(fmaxf(fabsf(x3.x), fabsf(x3.y)), fmaxf(fabsf(x3.z), fabsf(x3.w)))));
        amax = fmaxf(amax, __shfl_xor(amax, 1)); amax = fmaxf(amax, __shfl_xor(amax, 2)); amax = fmaxf(amax, __shfl_xor(amax, 4));
        const float inv = amax > 0.f ? 127.0f / amax : 0.f, sx = amax * (1.0f / 127.0f);
        const unsigned xq0 = pack_i8x4(x0.x * inv, x0.y * inv, x0.z * inv, x0.w * inv), xq1 = pack_i8x4(x1.x * inv, x1.y * inv, x1.z * inv, x1.w * inv);
        const unsigned xq2 = pack_i8x4(x2.x * inv, x2.y * inv, x2.z * inv, x2.w * inv), xq3 = pack_i8x4(x3.x * inv, x3.y * inv, x3.z * inv, x3.w * inv);
        LAS _Float16* pd = (LAS _Float16*)(wl + 4096) + grp * 128 + sub;
        LDS_WAIT();
        v4u ra[8], rb[8], rc[8];
        PEER_ROWS(ra, urs, uc, 0); PEER_ROWS(rb, urs, uc, 1);
#define PEER_UDOT(r, q) do { int p[8]; _Pragma("unroll") for (int i = 0; i < 8; ++i) { int a = __builtin_amdgcn_sdot4((int)r[i].x, (int)xq0, 0, false); a = __builtin_amdgcn_sdot4((int)r[i].y, (int)xq1, a, false); \
                a = __builtin_amdgcn_sdot4((int)r[i].z, (int)xq2, a, false); p[i] = __builtin_amdgcn_sdot4((int)r[i].w, (int)xq3, a, false); } \
            _Pragma("unroll") for (int o = 4; o > 0; o >>= 1) { const bool up = (sub & o) != 0; \
                _Pragma("unroll") for (int i = 0; i < o; ++i) { const int keep = up ? p[i + o] : p[i], send = up ? p[i] : p[i + o]; p[i] = keep + __shfl_xor(send, o); } } \
            pd[8 * (q)] = (_Float16)((float)p[0] * sx); } while (0)
        for (int q = 0; q < 15; q += 3) {
            PEER_ROWS(rc, urs, uc, q + 2); PEER_UDOT(ra, q);
            PEER_ROWS(ra, urs, uc, q + 3); PEER_UDOT(rb, q + 1);
            if (q + 4 < 16) PEER_ROWS(rb, urs, uc, q + 4);
            PEER_UDOT(rc, q + 2);
        }
        PEER_UDOT(ra, 15);
        LDS_WAIT();
#pragma unroll
        for (int qq = 0; qq < 2; ++qq) { const v4u pv = *(const LAS v4u*)(wl + 4096 + qq * 1024 + 16 * lane);
            *(GAS v4u*)((_Float16*)PD + ((size_t)j * T + tb + 4 * qq + (lane >> 4)) * 128 + 8 * (lane & 15)) = pv; }
    }
}
__device__ __forceinline__ void peer_stage_scales(LAS unsigned char* lds, const float* su, const float* sv, int tid) {
#pragma unroll
    for (int i = 0; i < 8; ++i) { *(LAS f32x4*)(lds + (size_t)(tid + 512 * i) * 16) = ((const GAS f32x4*)su)[tid + 512 * i]; *(LAS f32x4*)(lds + 65536 + (size_t)(tid + 512 * i) * 16) = ((const GAS f32x4*)sv)[tid + 512 * i]; }
    LDS_WAIT(); __syncthreads();
}
__device__ __forceinline__ void peer_combine4(LAS unsigned char* lds, const float* PD, const unsigned short* EXP16, const float* BEST, const float* SS2, unsigned char* CC8, float* SCC, int t0, int lane) {
    const LAS float* su = (const LAS float*)lds; const LAS float* sv = (const LAS float*)(lds + 65536);
    typedef float f32x2v __attribute__((ext_vector_type(2)));
    f32x4 ssv[4][4]; unsigned ev[4]; f32x2v bv[4]; f32x2v pdv[4][8];
#pragma unroll
    for (int i = 0; i < 4; ++i) { const int t = t0 + i;
        const GAS f32x4* sp = (const GAS f32x4*)(SS2 + (size_t)t * 16);
#pragma unroll
        for (int q = 0; q < 4; ++q) ssv[i][q] = sp[q];
        ev[i] = ((const GAS unsigned*)(EXP16 + (size_t)t * 128))[lane];
        bv[i] = ((const GAS f32x2v*)(BEST + (size_t)t * 128))[lane];
#pragma unroll
        for (int j = 0; j < 8; ++j) { typedef _Float16 h2v __attribute__((ext_vector_type(2))); const h2v hv = ((const GAS h2v*)((const _Float16*)PD + ((size_t)j * T + t) * 128))[lane]; pdv[i][j] = (f32x2v){(float)hv.x, (float)hv.y}; } }
    float suv[4][2], svv[4][2];
#pragma unroll
    for (int i = 0; i < 4; ++i) { const unsigned e0 = ev[i] & 0xffffu, e1 = ev[i] >> 16; suv[i][0] = su[e0]; suv[i][1] = su[e1]; svv[i][0] = sv[e0]; svv[i][1] = sv[e1]; }
#pragma unroll
    for (int i = 0; i < 4; ++i) { const int t = t0 + i;
        float ssq = 0.f;
#pragma unroll
        for (int q = 0; q < 4; ++q) ssq += (ssv[i][q].x + ssv[i][q].y) + (ssv[i][q].z + ssv[i][q].w);
        const float rstd2 = 1.0f / sqrtf(ssq * (1.0f / D) + EPS);
        const float s0 = bv[i].x * rstd2, s1 = bv[i].y * rstd2;
        float mx = fmaxf(s0, s1);
#pragma unroll
        for (int o = 1; o < 8; o <<= 1) mx = fmaxf(mx, __shfl_xor(mx, o));
        const float e0 = __expf(s0 - mx), e1 = __expf(s1 - mx); float sm = e0 + e1;
#pragma unroll
        for (int o = 1; o < 8; o <<= 1) sm += __shfl_xor(sm, o);
        float d0 = 0.f, d1 = 0.f;
#pragma unroll
        for (int j = 0; j < 8; ++j) { d0 += pdv[i][j].x; d1 += pdv[i][j].y; }
        const float inv_sm = 1.0f / sm;
        const float c0 = e0 * inv_sm * gelu_erf(d0 * rstd2 * suv[i][0]) * svv[i][0], c1 = e1 * inv_sm * gelu_erf(d1 * rstd2 * suv[i][1]) * svv[i][1];
        float amax = fmaxf(fabsf(c0), fabsf(c1));
#pragma unroll
        for (int o = 1; o < 64; o <<= 1) amax = fmaxf(amax, __shfl_xor(amax, o));
        const float inv = amax > 0.f ? 127.0f / amax : 0.f;
        ((GAS unsigned short*)(CC8 + (size_t)t * 128))[lane] = (unsigned short)((__float2int_rn(c0 * inv) & 0xff) | ((__float2int_rn(c1 * inv) & 0xff) << 8));
        if (lane == 0) SCC[t] = amax * (1.0f / 127.0f); }
}
__device__ __forceinline__ void peer_v_phase(LAS unsigned char* lds, float* OUT, const bf16* X1B, const unsigned char* V8, const unsigned short* EXP16, const unsigned char* CC8, const float* SCC, int j, int w, int nw, int wave, int lane) {
    const int grp = lane >> 3, sub = lane & 7;
    LAS unsigned char* wl = lds + wave * 8192;
    const LAS unsigned char* evp = wl + grp * 256;
    const LAS unsigned char* ccp = wl + 2048 + grp * 128;
    const int stride = nw * NWAVES * 8;
    int tb = (w * NWAVES + wave) * 8;
    v4u pe0 = {0u, 0u, 0u, 0u}, pe1 = {0u, 0u, 0u, 0u}, pc0 = {0u, 0u, 0u, 0u};
    if (tb < T) { const GAS v4u* e = (const GAS v4u*)(EXP16 + (size_t)tb * 128) + lane; pe0 = e[0]; pe1 = e[64]; pc0 = ((const GAS v4u*)(CC8 + (size_t)tb * 128))[lane]; }
    const __amdgpu_buffer_rsrc_t vrs = __builtin_amdgcn_make_buffer_rsrc((void*)V8, (short)0, NEXP * D, 0x00020000); const unsigned vc = (unsigned)j * (NEXP * 128u) + 16u * sub;
    for (; tb < T; tb += stride) {
        *(LAS v4u*)(wl + 16 * lane) = pe0; *(LAS v4u*)(wl + 1024 + 16 * lane) = pe1; *(LAS v4u*)(wl + 2048 + 16 * lane) = pc0;
        if (tb + stride < T) { const GAS v4u* e = (const GAS v4u*)(EXP16 + (size_t)(tb + stride) * 128) + lane; pe0 = e[0]; pe1 = e[64]; pc0 = ((const GAS v4u*)(CC8 + (size_t)(tb + stride) * 128))[lane]; }
        const int t = tb + grp;
        const float scc = SCC[t];
        const size_t eo = (size_t)t * D + 128 * j + 16 * sub;
        const GAS v4u* dp = (const GAS v4u*)(X1B + eo);
        const v4u da = dp[0], db = dp[1];
        int acc[16];
#pragma unroll
        for (int i = 0; i < 16; ++i) acc[i] = 0;
        LDS_WAIT();
        v4u rq[4][4];
#define PEER_LOADQ(r, qn) do { const unsigned long long _e4 = *(const LAS unsigned long long*)(evp + 8 * (qn)); const unsigned _lo = (unsigned)_e4, _hi = (unsigned)(_e4 >> 32); \
            r[0] = PEER_BL(vrs, _lo & 0xffffu, vc); r[1] = PEER_BL(vrs, _lo >> 16, vc); r[2] = PEER_BL(vrs, _hi & 0xffffu, vc); r[3] = PEER_BL(vrs, _hi >> 16, vc); } while (0)
#define PEER_T4(w_, r0, r1, r2, r3, cpk) do { const unsigned tl0 = __builtin_amdgcn_perm(r1, r0, 0x05010400u), th0 = __builtin_amdgcn_perm(r1, r0, 0x07030602u); \
            const unsigned tl1 = __builtin_amdgcn_perm(r3, r2, 0x05010400u), th1 = __builtin_amdgcn_perm(r3, r2, 0x07030602u); \
            acc[4 * (w_) + 0] = __builtin_amdgcn_sdot4((int)__builtin_amdgcn_perm(tl1, tl0, 0x05040100u), (int)(cpk), acc[4 * (w_) + 0], false); \
            acc[4 * (w_) + 1] = __builtin_amdgcn_sdot4((int)__builtin_amdgcn_perm(tl1, tl0, 0x07060302u), (int)(cpk), acc[4 * (w_) + 1], false); \
            acc[4 * (w_) + 2] = __builtin_amdgcn_sdot4((int)__builtin_amdgcn_perm(th1, th0, 0x05040100u), (int)(cpk), acc[4 * (w_) + 2], false); \
            acc[4 * (w_) + 3] = __builtin_amdgcn_sdot4((int)__builtin_amdgcn_perm(th1, th0, 0x07060302u), (int)(cpk), acc[4 * (w_) + 3], false); } while (0)
#define PEER_COMPQ(r, qn) do { const unsigned _c = *(const LAS unsigned*)(ccp + 4 * (qn)); \
            PEER_T4(0, r[0].x, r[1].x, r[2].x, r[3].x, _c); PEER_T4(1, r[0].y, r[1].y, r[2].y, r[3].y, _c); PEER_T4(2, r[0].z, r[1].z, r[2].z, r[3].z, _c); PEER_T4(3, r[0].w, r[1].w, r[2].w, r[3].w, _c); } while (0)
#pragma unroll
        for (int jq = 0; jq < 4; ++jq) PEER_LOADQ(rq[jq], jq);
        for (int it = 0; it < 8; ++it) {
#pragma unroll
            for (int jq = 0; jq < 4; ++jq) { PEER_COMPQ(rq[jq], 4 * it + jq); if (it < 7) PEER_LOADQ(rq[jq], 4 * it + 4 + jq); }
        }
        const float dl[16] = {bf_lo(da.x), bf_hi(da.x), bf_lo(da.y), bf_hi(da.y), bf_lo(da.z), bf_hi(da.z), bf_lo(da.w), bf_hi(da.w), bf_lo(db.x), bf_hi(db.x), bf_lo(db.y), bf_hi(db.y), bf_lo(db.z), bf_hi(db.z), bf_lo(db.w), bf_hi(db.w)};
#pragma unroll
        for (int q = 0; q < 4; ++q) { f32x4 v; v.x = dl[4 * q + 0] + scc * (float)acc[4 * q + 0]; v.y = dl[4 * q + 1] + scc * (float)acc[4 * q + 1]; v.z = dl[4 * q + 2] + scc * (float)acc[4 * q + 2]; v.w = dl[4 * q + 3] + scc * (float)acc[4 * q + 3];
            *(LAS f32x4*)(wl + 4096 + grp * 512 + sub * 64 + 16 * q) = v; }
        LDS_WAIT();
#pragma unroll
        for (int qq = 0; qq < 4; ++qq) { const f32x4 v = *(const LAS f32x4*)(wl + 4096 + qq * 1024 + 16 * lane);
            *(GAS f32x4*)(OUT + (size_t)(tb + 2 * qq + (lane >> 5)) * D + 128 * j + 4 * (lane & 31)) = v; }
    }
}
struct Args { const float* in[15]; float* out; unsigned char* ws; int ph_lo, ph_hi, li, pad; };
__global__ void __launch_bounds__(NWAVES * 64, 2) fwd_kernel(Args args) {
    extern __shared__ __attribute__((aligned(16))) unsigned char lds_raw[];
    LAS unsigned char* lds = (LAS unsigned char*)lds_raw;
    volatile LAS unsigned* MISC = (volatile LAS unsigned*)(lds + MISC_OFF);
    const int tid = threadIdx.x, lane = tid & 63, wave = __builtin_amdgcn_readfirstlane(tid >> 6);
    const int G = gridDim.x, bx = blockIdx.x;
    unsigned char* ws = args.ws;
    gu32* ctl = (gu32*)(ws + WS_CTL);
    for (int u = tid; u < (LDS_BYTES - LDSCTL_OFF) / 4; u += NWAVES * 64) ((LAS unsigned*)(lds + LDSCTL_OFF))[u] = 0u;
    __syncthreads();
    XcdBarrier bar; bar.bar = (unsigned*)(ctl + CW_BAR); bar.x = 0; bar.st = nullptr;
    if (N_LAUNCHES != PER_PHASE) bar = xcd_barrier_post((unsigned*)(ctl + CW_BAR) + args.li * XCD_BAR_WORDS, MISC + 8);
#define GRID_BAR() do { if (N_LAUNCHES != PER_PHASE) xcd_barrier(bar); } while (0)
    const int lo = args.ph_lo, hi = args.ph_hi;
#define IN(k) (lo <= (k) && (k) < hi)
#define BOTH(k) (IN(k) && IN((k) + 1))
#ifndef MK_REPEAT
#define MK_REPEAT -1
#endif
#define REP(k) for (int _r = 0; _r < ((MK_REPEAT == (k)) ? 2 : 1); ++_r)

    const float* x = args.in[0]; float* out = args.out;
    bf16* XB = (bf16*)(ws + WS_XB); bf16* WinT = (bf16*)(ws + WS_WIN); bf16* WoutT = (bf16*)(ws + WS_WOUT); bf16* WqT = (bf16*)(ws + WS_WQ);
    bf16* SK = (bf16*)(ws + WS_SK); bf16* PoolT = (bf16*)(ws + WS_POOLT); unsigned char* U8 = ws + WS_U8; unsigned char* V8 = ws + WS_V8; float* SU = (float*)(ws + WS_SU); float* SV = (float*)(ws + WS_SV);
    bf16* Y = (bf16*)(ws + WS_Y); bf16* AB = (bf16*)(ws + WS_AB); bf16* X1B = (bf16*)(ws + WS_X1B); bf16* QP = (bf16*)(ws + WS_QP);
    float* rstd1 = (float*)(ws + WS_RSTD1); float* SS2 = (float*)(ws + WS_SS2); unsigned short* EXPERTS = (unsigned short*)(ws + WS_EXP); float* BEST = (float*)(ws + WS_BEST);
    float* PD = (float*)(ws + WS_PD); bf16* DELTA = (bf16*)(ws + WS_DELTA); unsigned char* CC8 = ws + WS_CC; float* SCC = (float*)(ws + WS_SCC);
    const int gw = bx * NWAVES + wave, NGW = G * NWAVES;

    const P0Args p0a{x, args.in[1], args.in[2], args.in[7], args.in[9], args.in[10], args.in[11], args.in[12], args.in[13], args.in[14], XB, WinT, WoutT, WqT, SK, PoolT, U8, V8, SU, SV, rstd1};
    if (IN(0)) REP(0) {
        p0_prologue(p0a, lds, gw, NGW, wave, lane);
        if (BOTH(0)) GRID_BAR();
    }
    if (IN(1)) REP(1) {
        pg8::Gemm g{XB, WinT, T, DIN, D}; pg8::StaticOrder S; S.init(T, DIN, G, bx);
        pg8::EpiScaleBf16 E{Y, DIN, rstd1};
        pg8::gemm_phase<pg8::EpiScaleBf16, pg8::StaticOrder, true, true>(lds + RING_OFF, g, S, E);
        { const int nwg1 = (T / 256) * (DIN / 256), rem = nwg1 % G;
          if (rem == 0) p1_late_weights(p0a, lds, gw, NGW, wave, lane); else if (bx >= rem) p1_late_weights(p0a, lds, (bx - rem) * NWAVES + wave, (G - rem) * NWAVES, wave, lane); }
        if (BOTH(1)) GRID_BAR();
    }
    if (IN(2)) REP(2) {
        for (int u = bx; u < NB * 128 * 2; u += G) attn_unit(lds, Y, AB, args.in[3], args.in[4], args.in[5], args.in[6], u, tid, wave, lane);
        for (int u = bx; u < T / 128; u += G) pool_rows(Y, AB, args.in[8], u, tid);
        if (BOTH(2)) GRID_BAR();
    }
    if (IN(3)) REP(3) {
        pg8::Gemm g{AB, WoutT, T, D, D}; pg8::StaticOrder S; S.init(T, D, G, bx);
        pg8::EpiResid E{XB, X1B, SS2, D};
        pg8::gemm_phase<pg8::EpiResid, pg8::StaticOrder, true, true>(lds + RING_OFF, g, S, E);
        if (BOTH(3)) GRID_BAR();
    }
    if (IN(4)) REP(4) {
        pg8::Gemm g{X1B, WqT, T, DQ, D}; pg8::StaticOrder S; S.init(T, DQ, G, bx);
        pg8::EpiScaleBf16 E{QP, DQ, nullptr};
        pg8::gemm_phase<pg8::EpiScaleBf16, pg8::StaticOrder, true, true>(lds + RING_OFF, g, S, E);
        if (BOTH(4)) GRID_BAR();
    }
    if (IN(5)) REP(5) {
        { int hs = -1; for (int u = bx; u < (T / 256) * 8; u += G) { if ((u & 7) != hs) { if (hs >= 0) __syncthreads(); hs = u & 7; topk_stage_keys(lds, SK, hs, tid); } topk_unit(lds, QP, SK, EXPERTS, BEST, u, tid, wave, lane); } }
        if (BOTH(5)) GRID_BAR();
    }
    if (IN(6)) REP(6) {
        if ((G & 7) == 0) peer_u_phase(lds, X1B, U8, EXPERTS, PD, bx & 7, bx >> 3, G >> 3, wave, lane);
        else for (int j = 0; j < 8; ++j) peer_u_phase(lds, X1B, U8, EXPERTS, PD, j, bx, G, wave, lane);
        if (BOTH(6)) GRID_BAR();
    }
    if (IN(7)) REP(7) {
        peer_stage_scales(lds, SU, SV, tid);
        for (int t0 = gw * 4; t0 < T; t0 += NGW * 4) peer_combine4(lds, PD, EXPERTS, BEST, SS2, CC8, SCC, t0, lane);
        if (BOTH(7)) GRID_BAR();
    }
    if (IN(8)) {
        if ((G & 7) == 0) peer_v_phase(lds, out, X1B, V8, EXPERTS, CC8, SCC, bx & 7, bx >> 3, G >> 3, wave, lane);
        else for (int j = 0; j < 8; ++j) peer_v_phase(lds, out, X1B, V8, EXPERTS, CC8, SCC, j, bx, G, wave, lane);
    }
#undef IN
#undef BOTH
}

extern "C" void kernel_launch(void* const* d_in, const int* in_sizes, int n_in, void* d_out, int out_size, void* d_ws, size_t ws_size, hipStream_t stream) {
    static int grid = 0;
    if (grid == 0) {
        if (n_in != 15 || in_sizes[0] != T * D || out_size != T * D || ws_size < WS_END) { fprintf(stderr, "kernel_launch: unexpected shapes (n_in %d, in0 %d, out %d, ws %zu)\n", n_in, n_in > 0 ? in_sizes[0] : -1, out_size, ws_size); grid = -1; return; }
        int dev = 0, cus = 0, per_cu = 0;
        if (hipGetDevice(&dev) != hipSuccess || hipDeviceGetAttribute(&cus, hipDeviceAttributeMultiprocessorCount, dev) != hipSuccess) { grid = -1; return; }
        if (hipFuncSetAttribute((const void*)fwd_kernel, hipFuncAttributeMaxDynamicSharedMemorySize, LDS_BYTES) != hipSuccess) { fprintf(stderr, "kernel_launch: hipFuncSetAttribute failed\n"); grid = -1; return; }
        if (hipOccupancyMaxActiveBlocksPerMultiprocessor(&per_cu, (const void*)fwd_kernel, NWAVES * 64, LDS_BYTES) != hipSuccess || per_cu < 1) { fprintf(stderr, "kernel_launch: occupancy query reports %d blocks per CU\n", per_cu); }
        (void)hipGetLastError();
        grid = cus;
    }
    if (grid < 0) return;
    if (hipMemsetAsync((char*)d_ws + WS_CTL, 0, CTL_ZERO_BYTES, stream) != hipSuccess) return;
    Args a{};
    for (int i = 0; i < 15; ++i) a.in[i] = (const float*)d_in[i];
    a.out = (float*)d_out; a.ws = (unsigned char*)d_ws;
    for (int li = 0; li < N_LAUNCHES; ++li) {
        a.ph_lo = (N_LAUNCHES == PER_PHASE) ? li : 0; a.ph_hi = (N_LAUNCHES == PER_PHASE) ? li + 1 : PER_PHASE; a.li = (N_LAUNCHES == PER_PHASE) ? 0 : li;
        hipLaunchKernelGGL(fwd_kernel, dim3(grid), dim3(NWAVES * 64), LDS_BYTES, stream, a);
        const hipError_t le = hipPeekAtLastError();
        if (le != hipSuccess) { fprintf(stderr, "kernel_launch: launch %d failed: %s\n", li, hipGetErrorName(le)); break; }
    }
}
```

```cpp
#include <hip/hip_runtime.h>
#include <cstdio>
#include <cstdint>
namespace pg8 {
#define PG8_LAS __attribute__((address_space(3)))
typedef unsigned short bf16_t;
typedef short bf16x8 __attribute__((ext_vector_type(8)));
typedef float f32x4 __attribute__((ext_vector_type(4)));
typedef unsigned u32x4 __attribute__((ext_vector_type(4)));
constexpr int BM = 256, BK = 64, HALF = 128, HTB = HALF * BK * 2  , STAGE_BYTES = 8 * HTB, NXCD = 8, WGM = 8;

__host__ __device__ __forceinline__ int lds_byte(int r, int c) { const int st = (r >> 4) * 2 + (c >> 5), rr = r & 15, cc = c & 31, ob = rr * 64 + cc * 2; return st * 1024 + (ob ^ (((ob >> 9) & 1) << 5)); }
__host__ __device__ __forceinline__ void stage_rc(int b, int& R, int& C) { const int st = b / 1024, sb = b % 1024, swz = sb ^ (((sb >> 9) & 1) << 5); R = (st >> 1) * 16 + swz / 64; C = (st & 1) * 32 + (swz % 64) / 2; }
__host__ __device__ __forceinline__ int perm32(int rho) { const int n = rho >> 4, i = rho & 15; return 8 * (i >> 2) + 4 * n + (i & 3); }

struct Unit { int pm, pn; };
struct Gemm { const bf16_t* A; const bf16_t* Bt; int M, N, K; };

struct StaticOrder {
    int nM, nN, nwg, G, c;
    __host__ __device__ void init(int M, int N, int G_, int c_) { nM = M / BM; nN = N / BM; nwg = nM * nN; G = G_; c = c_; }
    __host__ __device__ bool next(int i, Unit& u) const {
        const long L = (long)i * G + c; if (L >= nwg) return false;
        int wgid = (int)L; { const int q = nwg / NXCD, r = nwg % NXCD, xcd = wgid % NXCD, off = wgid / NXCD; wgid = (xcd < r ? xcd * (q + 1) : r * (q + 1) + (xcd - r) * q) + off; }
        const int nig = WGM * nN, gid = wgid / nig, fm = gid * WGM, gsz = (nM - fm) < WGM ? (nM - fm) : WGM;
        u.pm = fm + ((wgid % nig) % gsz); u.pn = (wgid % nig) / gsz; return true;
    }
    __device__ __forceinline__ void a_ready(const Unit&) const {}
    __device__ __forceinline__ void done(const Unit&) const {}
};

__device__ __forceinline__ unsigned cvt_pk_bf16(float lo, float hi) { unsigned r; asm volatile("v_cvt_pk_bf16_f32 %0, %1, %2" : "=v"(r) : "v"(lo), "v"(hi)); return r; }
struct EpiScaleBf16 {
    static constexpr bool PERM = true, AFTER_DRAIN = false, PROBE_TWICE = false;
    bf16_t* O; int ldc; const float* rs;
    __device__ __forceinline__ void operator()(const f32x4 (&acc)[2][2][4][2], const Unit& u, int wr, int wc, int fr, int fq) const {
        const int row0 = u.pm * BM + wr * 64 + fr, col0 = u.pn * BM + wc * 32 + 8 * fq;
#pragma unroll
        for (int ai = 0; ai < 2; ++ai)
#pragma unroll
            for (int m = 0; m < 4; ++m) { const int row = row0 + ai * HALF + m * 16; const float s = rs ? rs[row] : 1.f; bf16_t* rowp = O + (size_t)row * ldc + col0;
#pragma unroll
                for (int bj = 0; bj < 2; ++bj) { const f32x4 v0 = acc[ai][bj][m][0] * s, v1 = acc[ai][bj][m][1] * s;
                    u32x4 w; w.x = cvt_pk_bf16(v0[0], v0[1]); w.y = cvt_pk_bf16(v0[2], v0[3]); w.z = cvt_pk_bf16(v1[0], v1[1]); w.w = cvt_pk_bf16(v1[2], v1[3]);
                    *(u32x4*)(rowp + bj * HALF) = w; } }
    }
};
struct EpiResid {
    static constexpr bool PERM = true, AFTER_DRAIN = false, PROBE_TWICE = false;
    const bf16_t* xbf; bf16_t* xb; float* ss; int ldc;
    __device__ __forceinline__ void operator()(const f32x4 (&acc)[2][2][4][2], const Unit& u, int wr, int wc, int fr, int fq) const {
        const int row0 = u.pm * BM + wr * 64 + fr, col0 = u.pn * BM + wc * 32 + 8 * fq;
#pragma unroll
        for (int ai = 0; ai < 2; ++ai)
#pragma unroll
            for (int m = 0; m < 4; ++m) { const int row = row0 + ai * HALF + m * 16; const size_t off = (size_t)row * ldc + col0; float q = 0.f;
#pragma unroll
                for (int bj = 0; bj < 2; ++bj) { const u32x4 xr = *(const u32x4*)(xbf + off + bj * HALF);
                    const f32x4 a0 = acc[ai][bj][m][0], a1 = acc[ai][bj][m][1];
                    f32x4 v0, v1;
                    v0[0] = a0[0] + __builtin_bit_cast(float, xr.x << 16); v0[1] = a0[1] + __builtin_bit_cast(float, xr.x & 0xffff0000u); v0[2] = a0[2] + __builtin_bit_cast(float, xr.y << 16); v0[3] = a0[3] + __builtin_bit_cast(float, xr.y & 0xffff0000u);
                    v1[0] = a1[0] + __builtin_bit_cast(float, xr.z << 16); v1[1] = a1[1] + __builtin_bit_cast(float, xr.z & 0xffff0000u); v1[2] = a1[2] + __builtin_bit_cast(float, xr.w << 16); v1[3] = a1[3] + __builtin_bit_cast(float, xr.w & 0xffff0000u);
                    u32x4 w; w.x = cvt_pk_bf16(v0[0], v0[1]); w.y = cvt_pk_bf16(v0[2], v0[3]); w.z = cvt_pk_bf16(v1[0], v1[1]); w.w = cvt_pk_bf16(v1[2], v1[3]);
                    *(u32x4*)(xb + off + bj * HALF) = w;
                    q += (v0[0] * v0[0] + v0[1] * v0[1]) + (v0[2] * v0[2] + v0[3] * v0[3]) + (v1[0] * v1[0] + v1[1] * v1[1]) + (v1[2] * v1[2] + v1[3] * v1[3]); }
                q += __shfl_xor(q, 16); q += __shfl_xor(q, 32);
                if (fq == 0) ss[(size_t)row * 16 + u.pn * 4 + wc] = q; }
    }
};
template <class Epi, class Sched, bool ALIGN_EPI = false, bool SP2 = false>
__device__ __forceinline__ void gemm_phase(PG8_LAS unsigned char* lds, const Gemm g, const Sched& S, const Epi& E) {
    const int tid = threadIdx.x, wid = __builtin_amdgcn_readfirstlane(tid >> 6), lane = tid & 63, wr = wid >> 2, wc = wid & 3, fr = lane & 15, fq = lane >> 4;
    const int K = g.K, nt = K / BK;
    unsigned voffA[2], voffB[2];
#pragma unroll
    for (int i = 0; i < 2; ++i) { int R, C; stage_rc(tid * 16 + i * 8192, R, C); const int Rb = Epi::PERM ? ((R & ~31) + perm32(R & 31)) : R;
        voffA[i] = (unsigned)(R * K + C) * 2u; voffB[i] = (unsigned)(Rb * K + C) * 2u; }
    const size_t kstep = (size_t)(BK * 2);
    const size_t hstep = (size_t)HALF * K * 2;
    const size_t tstep = 2 * hstep;
    const unsigned ldsw = (unsigned)wid * 1024u;
    const int aoff = lds_byte(wr * 64 + fr, fq * 8), boff = lds_byte(wc * 32 + fr, fq * 8);
#define PG8_SA(b, h) (((b) * 2 + (h)) * HTB)
#define PG8_SB(b, h) ((4 + (b) * 2 + (h)) * HTB)
#define PG8_STAGE(bufoff, gbase, voff) do { _Pragma("unroll") for (int _i = 0; _i < 2; ++_i) \
        __builtin_amdgcn_global_load_lds((const unsigned*)((const char*)(gbase) + (voff)[_i]), (PG8_LAS unsigned*)(lds + (bufoff) + ldsw + _i * 8192), 16, 0, 0); } while (0)
#define PG8_LDA(dst, b, h) do { _Pragma("unroll") for (int m = 0; m < 4; ++m) _Pragma("unroll") for (int k = 0; k < 2; ++k) dst[m][k] = *(const PG8_LAS bf16x8*)(lds + PG8_SA(b, h) + aoff + m * 2048 + k * 1024); } while (0)
#define PG8_LDB(dst, b, h) do { _Pragma("unroll") for (int n = 0; n < 2; ++n) _Pragma("unroll") for (int k = 0; k < 2; ++k) dst[n][k] = *(const PG8_LAS bf16x8*)(lds + PG8_SB(b, h) + boff + n * 2048 + k * 1024); } while (0)
#define PG8_MMA(ai, bj, At, Bt) do { __builtin_amdgcn_s_setprio(1); _Pragma("unroll") for (int m = 0; m < 4; ++m) _Pragma("unroll") for (int n = 0; n < 2; ++n) _Pragma("unroll") for (int k = 0; k < 2; ++k) \
        acc[ai][bj][m][n] = __builtin_amdgcn_mfma_f32_16x16x32_bf16(Bt[n][k], At[m][k], acc[ai][bj][m][n], 0, 0, 0); __builtin_amdgcn_s_setprio(0); } while (0)
#define PG8_WAIT_V(n) asm volatile("s_waitcnt vmcnt(" #n ")" ::: "memory")
#define PG8_WAIT_L(n) asm volatile("s_waitcnt lgkmcnt(" #n ")" ::: "memory")
#define PG8_BAR __builtin_amdgcn_s_barrier()
#define PG8_SCHED __builtin_amdgcn_sched_barrier(0)
    Unit cur, nxt; int ui = 0;
    if (!S.next(0, cur)) return;
    f32x4 acc[2][2][4][2];
#pragma unroll
    for (int a = 0; a < 2; ++a)
#pragma unroll
        for (int b = 0; b < 2; ++b)
#pragma unroll
            for (int m = 0; m < 4; ++m)
#pragma unroll
                for (int n = 0; n < 2; ++n) acc[a][b][m][n] = (f32x4){0.f, 0.f, 0.f, 0.f};
    bf16x8 At[4][2], B0[2][2], B1[2][2];
    const char* cA = (const char*)g.A + (size_t)cur.pm * tstep; const char* cB = (const char*)g.Bt + (size_t)cur.pn * tstep;
    S.a_ready(cur);
    if constexpr (SP2) {
        PG8_STAGE(PG8_SB(0, 0), cB, voffB); PG8_STAGE(PG8_SB(0, 1), cB + hstep, voffB); PG8_STAGE(PG8_SA(0, 0), cA, voffA); PG8_STAGE(PG8_SA(0, 1), cA + hstep, voffA);
        if (wr == 1) PG8_BAR;
        PG8_WAIT_V(2); PG8_BAR;
        PG8_STAGE(PG8_SB(1, 0), cB + kstep, voffB); PG8_STAGE(PG8_SA(1, 0), cA + kstep, voffA); PG8_STAGE(PG8_SB(1, 1), cB + hstep + kstep, voffB);
        PG8_WAIT_V(6); PG8_BAR;
    } else {
        PG8_STAGE(PG8_SB(0, 0), cB, voffB); PG8_STAGE(PG8_SA(0, 0), cA, voffA); PG8_STAGE(PG8_SB(0, 1), cB + hstep, voffB); PG8_STAGE(PG8_SA(0, 1), cA + hstep, voffA);
        if (wr == 1) PG8_BAR;
        PG8_WAIT_V(4); PG8_BAR;
        PG8_STAGE(PG8_SB(1, 0), cB + kstep, voffB); PG8_STAGE(PG8_SA(1, 0), cA + kstep, voffA); PG8_STAGE(PG8_SB(1, 1), cB + hstep + kstep, voffB);
        PG8_WAIT_V(6); PG8_BAR;
    }
    for (;;) {
        const bool has_next = S.next(ui + 1, nxt);
        const char* nA = has_next ? (const char*)g.A + (size_t)nxt.pm * tstep : cA; const char* nB = has_next ? (const char*)g.Bt + (size_t)nxt.pn * tstep : cB;
        for (int t = 0; t < nt; t += 2) {
            const bool last = (t == nt - 2);
            const char* a1 = cA + (size_t)(t + 1) * kstep;
            const char* a2 = last ? nA : cA + (size_t)(t + 2) * kstep; const char* b2 = last ? nB : cB + (size_t)(t + 2) * kstep;
            const char* a3 = a2 + kstep; const char* b3 = b2 + kstep;
            if (last && has_next) S.a_ready(nxt);
            if constexpr (SP2) {
            PG8_LDB(B0, 0, 0); PG8_LDB(B1, 0, 1); PG8_SCHED; PG8_LDA(At, 0, 0); PG8_STAGE(PG8_SA(1, 1), a1 + hstep, voffA);
            PG8_WAIT_V(8); PG8_WAIT_L(0); PG8_BAR; PG8_MMA(0, 0, At, B0); PG8_MMA(0, 1, At, B1); PG8_BAR; PG8_SCHED;
            PG8_LDA(At, 0, 1); PG8_STAGE(PG8_SB(0, 0), b2, voffB); PG8_STAGE(PG8_SB(0, 1), b2 + hstep, voffB); PG8_STAGE(PG8_SA(0, 0), a2, voffA);
            PG8_WAIT_V(8); PG8_WAIT_L(0); PG8_BAR; PG8_MMA(1, 0, At, B0); PG8_MMA(1, 1, At, B1); PG8_BAR; PG8_SCHED;
            PG8_LDB(B0, 1, 0); PG8_LDB(B1, 1, 1); PG8_SCHED; PG8_LDA(At, 1, 0); PG8_STAGE(PG8_SA(0, 1), a2 + hstep, voffA);
            PG8_WAIT_V(8); PG8_WAIT_L(0); PG8_BAR; PG8_MMA(0, 0, At, B0); PG8_MMA(0, 1, At, B1); PG8_BAR; PG8_SCHED;
            PG8_LDA(At, 1, 1); PG8_STAGE(PG8_SB(1, 0), b3, voffB); PG8_STAGE(PG8_SB(1, 1), b3 + hstep, voffB); PG8_STAGE(PG8_SA(1, 0), a3, voffA);
            PG8_WAIT_V(8); PG8_WAIT_L(0); PG8_BAR; PG8_MMA(1, 0, At, B0); PG8_MMA(1, 1, At, B1); PG8_BAR; PG8_SCHED;
            } else {
            PG8_LDB(B0, 0, 0); PG8_SCHED; PG8_LDA(At, 0, 0); PG8_STAGE(PG8_SA(1, 1), a1 + hstep, voffA);
            PG8_WAIT_L(8); PG8_BAR; PG8_WAIT_L(0); PG8_MMA(0, 0, At, B0); PG8_BAR; PG8_SCHED;
            PG8_LDB(B1, 0, 1); PG8_STAGE(PG8_SB(0, 0), b2, voffB);
            PG8_BAR; PG8_WAIT_L(0); PG8_MMA(0, 1, At, B1); PG8_BAR;
            PG8_LDA(At, 0, 1); PG8_STAGE(PG8_SA(0, 0), a2, voffA);
            PG8_BAR; PG8_WAIT_L(0); PG8_MMA(1, 0, At, B0); PG8_BAR; PG8_SCHED;
            PG8_STAGE(PG8_SB(0, 1), b2 + hstep, voffB);
            PG8_WAIT_V(6); PG8_BAR; PG8_MMA(1, 1, At, B1); PG8_BAR;
            PG8_LDB(B0, 1, 0); PG8_SCHED; PG8_LDA(At, 1, 0); PG8_STAGE(PG8_SA(0, 1), a2 + hstep, voffA);
            PG8_WAIT_L(8); PG8_BAR; PG8_WAIT_L(0); PG8_MMA(0, 0, At, B0); PG8_BAR; PG8_SCHED;
            PG8_LDB(B1, 1, 1); PG8_STAGE(PG8_SB(1, 0), b3, voffB);
            PG8_BAR; PG8_WAIT_L(0); PG8_MMA(0, 1, At, B1); PG8_BAR;
            PG8_LDA(At, 1, 1); PG8_STAGE(PG8_SA(1, 0), a3, voffA);
            PG8_BAR; PG8_WAIT_L(0); PG8_MMA(1, 0, At, B0); PG8_BAR; PG8_SCHED;
            PG8_STAGE(PG8_SB(1, 1), b3 + hstep, voffB);
            PG8_WAIT_V(6); PG8_BAR; PG8_MMA(1, 1, At, B1); PG8_BAR;
            }
        }
        if constexpr (ALIGN_EPI) { if (wr == 0) PG8_BAR; }
        if constexpr (!Epi::AFTER_DRAIN) { E(acc, cur, wr, wc, fr, fq);
#if defined(MK_EXTRA)
            if (Epi::PROBE_TWICE) { asm volatile("" ::: "memory"); E(acc, cur, wr, wc, fr, fq); }
#endif
            S.done(cur); }
        if (!has_next) break;
#pragma unroll
        for (int a = 0; a < 2; ++a)
#pragma unroll
            for (int b = 0; b < 2; ++b)
#pragma unroll
                for (int m = 0; m < 4; ++m)
#pragma unroll
                    for (int n = 0; n < 2; ++n) acc[a][b][m][n] = (f32x4){0.f, 0.f, 0.f, 0.f};
        cur = nxt; cA = nA; cB = nB; ++ui;
        if constexpr (ALIGN_EPI) { if (wr == 1) PG8_BAR; }
    }
    PG8_WAIT_V(0);
    if constexpr (!ALIGN_EPI) { if (wr == 0) PG8_BAR; }
    PG8_BAR;
    if constexpr (Epi::AFTER_DRAIN) { E.fused(acc, cur, wr, wc, fr, fq, lds, wid, lane); S.done(cur); }
#undef PG8_SA
#undef PG8_SB
#undef PG8_STAGE
#undef PG8_LDA
#undef PG8_LDB
#undef PG8_MMA
#undef PG8_WAIT_V
#undef PG8_WAIT_L
#undef PG8_BAR
#undef PG8_SCHED
}
}
constexpr int NWAVES = 8;
#ifndef MK_N_LAUNCHES
#define MK_N_LAUNCHES 1
#endif
constexpr int PER_PHASE = 9;
constexpr int N_LAUNCHES = MK_N_LAUNCHES;

constexpr int NB = 4, SEQ = 8192, T = NB * SEQ, D = 1024, DIN = 1280, NEXP = 16384, DQ = 2048;
constexpr float EPS = 1e-6f;

constexpr size_t MiB = 1u << 20;
constexpr size_t WS_CTL = 0, CTL_ZERO_BYTES = 1 * MiB;
constexpr size_t WS_WIN = 2 * MiB;
constexpr size_t WS_WOUT = 5 * MiB;
constexpr size_t WS_WQ = 7 * MiB;
constexpr size_t WS_SK = 11 * MiB;
constexpr size_t WS_POOLT = 11 * MiB + 512 * 1024;
constexpr size_t WS_RSTD1 = 12 * MiB;
constexpr size_t WS_SS2 = 13 * MiB;
constexpr size_t WS_SU = 15 * MiB;
constexpr size_t WS_SV = 15 * MiB + 256 * 1024;
constexpr size_t WS_EXP = 16 * MiB;
constexpr size_t WS_BEST = 24 * MiB;
constexpr size_t WS_CC = 40 * MiB;
constexpr size_t WS_SCC = 44 * MiB;
constexpr size_t WS_U8 = 56 * MiB;
constexpr size_t WS_V8 = 72 * MiB;
constexpr size_t WS_AB = 88 * MiB;
constexpr size_t WS_X1B = 152 * MiB;
constexpr size_t WS_PD = 216 * MiB;
constexpr size_t WS_DELTA = 360 * MiB;
constexpr size_t WS_XB = 216 * MiB;
constexpr size_t WS_Y = 280 * MiB;
constexpr size_t WS_QP = 216 * MiB;
constexpr size_t WS_END = 424 * MiB;
constexpr int CW_BAR = 4096;

constexpr int RING_OFF = 0, RING_BYTES = 131072;
constexpr int LDS_BYTES = 163840;
constexpr int LDSCTL_OFF = LDS_BYTES - 512, MISC_OFF = LDSCTL_OFF + 320;
constexpr int PHASE_LDS_MAX = LDSCTL_OFF;
#define GAS __attribute__((address_space(1)))
#define LAS __attribute__((address_space(3)))
typedef unsigned short bf16;
typedef unsigned v4u __attribute__((ext_vector_type(4)));
typedef float f32x4 __attribute__((ext_vector_type(4)));
typedef short bf16x8 __attribute__((ext_vector_type(8)));
typedef GAS unsigned gu32;
typedef GAS unsigned long long gu64;
#define RLX_AGENT __ATOMIC_RELAXED, __HIP_MEMORY_SCOPE_AGENT
#define LDS_WAIT() asm volatile("s_waitcnt lgkmcnt(0)" ::: "memory")
#define VM_WAIT() asm volatile("s_waitcnt vmcnt(0)" ::: "memory")
__device__ __forceinline__ unsigned long long rt() { return __builtin_amdgcn_s_memrealtime(); }
__device__ __forceinline__ unsigned f2bf(float f) { unsigned u = __builtin_bit_cast(unsigned, f); return (u + 0x7fffu + ((u >> 16) & 1u)) >> 16; }
__device__ __forceinline__ unsigned pk2(float lo, float hi) { return f2bf(lo) | (f2bf(hi) << 16); }
#define XB_TMO      128
#define XB_XCNT(j)  (256  + 64 * (j))
#define XB_XSUB(j)  (1280 + 64 * (j))
#define XB_XGEN(j)  (2304 + 64 * (j))
#define XB_TOP      3328
#define XB_TOPGEN   3392
#define XCD_BAR_WORDS 3456
#define XB_SPIN_CAP (1u << 18)

__device__ __forceinline__ unsigned xb_ld(unsigned* p)              { return __hip_atomic_load(p, __ATOMIC_RELAXED, __HIP_MEMORY_SCOPE_AGENT); }
__device__ __forceinline__ unsigned xb_add(unsigned* p, unsigned v) { return __hip_atomic_fetch_add(p, v, __ATOMIC_RELAXED, __HIP_MEMORY_SCOPE_AGENT); }
__device__ __forceinline__ unsigned xb_xcc_id() { return (unsigned)__builtin_amdgcn_s_getreg((3 << 11) | 20) & 0xFu; }
#define XB_SPIN(cond, bar) do { unsigned _sp = 0; while (cond) { __builtin_amdgcn_s_sleep(1); \
    if ((++_sp & 255u) == 0u) { if (xb_ld(&(bar)[XB_TMO])) break; if (_sp > XB_SPIN_CAP) { atomicAdd(&(bar)[XB_TMO], 1u); break; } } } } while (0)

struct XcdBarrier {
    unsigned* bar; unsigned x;
    volatile LAS unsigned* st;
};

__device__ __forceinline__ XcdBarrier xcd_barrier_post(unsigned* bar, volatile LAS unsigned* st) {
    XcdBarrier b; b.bar = bar; b.x = xb_xcc_id(); b.st = st;
    if (threadIdx.x == 0) (void)xb_add(&bar[XB_XCNT(b.x)], 1u);
    return b;
}
__device__ __forceinline__ void xcd_barrier_complete(unsigned* bar, unsigned x, unsigned& nloc, unsigned& nx) {
    const unsigned G = gridDim.x * gridDim.y * gridDim.z;
    unsigned sum, cnt, mine, sp = 0u;
    for (;;) {
        sum = 0u; cnt = 0u; mine = 0u;
#pragma unroll
        for (unsigned j = 0; j < 16; ++j) { const unsigned c = xb_ld(&bar[XB_XCNT(j)]); sum += c; cnt += (c > 0u) ? 1u : 0u; mine = (j == x) ? c : mine; }
        if (sum == G) break;
        __builtin_amdgcn_s_sleep(1);
        if ((++sp & 255u) == 0u) { if (xb_ld(&bar[XB_TMO])) break; if (sp > XB_SPIN_CAP) { atomicAdd(&bar[XB_TMO], 1u); break; } }
    }
    nloc = mine > 0u ? mine : 1u; nx = cnt > 0u ? cnt : 1u;
}

__device__ __forceinline__ void xcd_barrier(const XcdBarrier& b) {
    asm volatile("s_waitcnt vmcnt(0)" ::: "memory");
    __syncthreads();
    if (threadIdx.x == 0) {
        unsigned* bar = b.bar;
        __builtin_amdgcn_s_waitcnt(0);
        unsigned nloc = b.st[0], nx = b.st[1];
        if (nloc == 0u) { xcd_barrier_complete(bar, b.x, nloc, nx); b.st[0] = nloc; b.st[1] = nx; }
        const unsigned old = xb_add(&bar[XB_XSUB(b.x)], 1u);
        const unsigned gen = old / nloc;
        if (old + 1u == (gen + 1u) * nloc) {
            __builtin_amdgcn_fence(__ATOMIC_RELEASE, "agent");
            asm volatile("s_waitcnt vmcnt(0)" ::: "memory");
            const unsigned og = xb_add(&bar[XB_TOP], 1u);
            const unsigned tg = og / nx;
            if (og + 1u == (tg + 1u) * nx) xb_add(&bar[XB_TOPGEN], 1u);
            else XB_SPIN(xb_ld(&bar[XB_TOPGEN]) == tg, bar);
            __builtin_amdgcn_fence(__ATOMIC_ACQUIRE, "agent");
            xb_add(&bar[XB_XGEN(b.x)], 1u);
            asm volatile("s_waitcnt vmcnt(0)" ::: "memory");
        } else {
            XB_SPIN(xb_ld(&bar[XB_XGEN(b.x)]) == gen, bar);
            __builtin_amdgcn_fence(__ATOMIC_ACQUIRE, "agent");
            asm volatile("s_waitcnt vmcnt(0)" ::: "memory");
        }
    }
    __syncthreads();
}
typedef float f32x16 __attribute__((ext_vector_type(16)));
typedef __bf16 bf16x2_t __attribute__((ext_vector_type(2)));
#define MFMA32(a, b, c) __builtin_amdgcn_mfma_f32_32x32x16_bf16((a), (b), (c), 0, 0, 0)
__device__ __forceinline__ float bf_lo(unsigned u) { return __builtin_bit_cast(float, u << 16); }
__device__ __forceinline__ float bf_hi(unsigned u) { return __builtin_bit_cast(float, u & 0xffff0000u); }
__device__ __forceinline__ float dot2_bf16(unsigned w, unsigned x, float acc) { return __builtin_amdgcn_fdot2_f32_bf16(__builtin_bit_cast(bf16x2_t, w), __builtin_bit_cast(bf16x2_t, x), acc, false); }
__device__ __forceinline__ float wave_sum(float v) {
#pragma unroll
    for (int o = 1; o < 64; o <<= 1) v += __shfl_xor(v, o);
    return v;
}

__device__ __forceinline__ unsigned pack_i8x4(float a, float b, float c, float d) {
    return ((unsigned)__float2int_rn(a) & 0xffu) | (((unsigned)__float2int_rn(b) & 0xffu) << 8) | (((unsigned)__float2int_rn(c) & 0xffu) << 16) | (((unsigned)__float2int_rn(d) & 0xffu) << 24);
}

__device__ __forceinline__ void p0_transpose_item(const float* W, int K, int N, bf16* WT, const float* gk, LAS float* scr, int item, int lane) {
    const int nblk = N / 32, kb = item / nblk, nb = item % nblk, k0 = 64 * kb, n0 = 32 * nb;
    float wv[32];
#pragma unroll
    for (int i = 0; i < 32; ++i) wv[i] = W[(size_t)(k0 + 2 * i + (lane >> 5)) * N + n0 + (lane & 31)];
#pragma unroll
    for (int i = 0; i < 32; ++i) { const int kk = 2 * i + (lane >> 5); float w = wv[i]; if (gk) w *= gk[k0 + kk]; scr[kk * 33 + (lane & 31)] = w; }
    LDS_WAIT(); asm volatile("" ::: "memory");
    const int c = lane & 7;
#pragma unroll
    for (int j = 0; j < 4; ++j) { const int n = (lane >> 3) + 8 * j; const LAS float* s = scr + (8 * c) * 33 + n;
        v4u o; o.x = pk2(s[0 * 33], s[1 * 33]); o.y = pk2(s[2 * 33], s[3 * 33]); o.z = pk2(s[4 * 33], s[5 * 33]); o.w = pk2(s[6 * 33], s[7 * 33]);
        *(GAS v4u*)(WT + (size_t)(n0 + n) * K + k0 + 8 * c) = o; }
    LDS_WAIT(); asm volatile("" ::: "memory");
}
__device__ __forceinline__ float row_to_bf16(const float* src, bf16* dst, const float* g, int lane) {
    const GAS f32x4* xr = (const GAS f32x4*)src + lane; float s = 0.f;
    GAS unsigned long long* o8 = (GAS unsigned long long*)dst + lane;
#pragma unroll
    for (int j = 0; j < 4; ++j) { f32x4 v = xr[64 * j]; s += (v.x * v.x + v.y * v.y) + (v.z * v.z + v.w * v.w);
        if (g) { const f32x4 gv = ((const GAS f32x4*)g)[64 * j + lane]; v = v * gv; }
        o8[64 * j] = (unsigned long long)pk2(v.x, v.y) | ((unsigned long long)pk2(v.z, v.w) << 32); }
    return s;
}
__device__ __forceinline__ void row_to_i8(const float* src, unsigned char* dst, const float* g, float* sc, int m, int lane) {
    const GAS f32x4* xr = (const GAS f32x4*)src + lane; f32x4 v[4]; float amax = 0.f;
#pragma unroll
    for (int j = 0; j < 4; ++j) { v[j] = xr[64 * j]; if (g) { const f32x4 gv = ((const GAS f32x4*)g)[64 * j + lane]; v[j] = v[j] * gv; }
        amax = fmaxf(fmaxf(amax, fmaxf(fabsf(v[j].x), fabsf(v[j].y))), fmaxf(fabsf(v[j].z), fabsf(v[j].w))); }
#pragma unroll
    for (int o = 1; o < 64; o <<= 1) amax = fmaxf(amax, __shfl_xor(amax, o));
    const float inv = amax > 0.f ? 127.0f / amax : 0.f;
    GAS unsigned* o4 = (GAS unsigned*)dst + lane;
#pragma unroll
    for (int j = 0; j < 4; ++j) { const unsigned q0 = (unsigned)__float2int_rn(v[j].x * inv) & 0xffu, q1 = (unsigned)__float2int_rn(v[j].y * inv) & 0xffu, q2 = (unsigned)__float2int_rn(v[j].z * inv) & 0xffu, q3 = (unsigned)__float2int_rn(v[j].w * inv) & 0xffu;
        o4[64 * j] = q0 | (q1 << 8) | (q2 << 16) | (q3 << 24); }
    if (lane == 0) sc[m] = amax * (1.0f / 127.0f);
}
__device__ __forceinline__ void p0_poolfold_wg(const float* w_in, const float* pool_w, const float* g1, bf16* WinT, LAS unsigned char* lds, int item, int tid) {
    const int g = item & 3, kb = item >> 2, k0 = 16 * kb;
    LAS float* pw = (LAS float*)lds;
    LAS float* wt = (LAS float*)(lds + 65536);
#pragma unroll
    for (int i = 0; i < 8; ++i) *(LAS f32x4*)(pw + 4 * (tid + 512 * i)) = ((const GAS f32x4*)(pool_w + (size_t)g * 16384))[tid + 512 * i];
    { const int r = tid >> 5, c4 = tid & 31; *(LAS f32x4*)(wt + r * 128 + 4 * c4) = *(const GAS f32x4*)(w_in + (size_t)(k0 + r) * DIN + 768 + 128 * g + 4 * c4); }
    LDS_WAIT(); __syncthreads();
    const int kr = tid >> 5, nq = tid & 31;
    f32x4 acc = {0.f, 0.f, 0.f, 0.f};
#pragma unroll 4
    for (int c4 = 0; c4 < 32; ++c4) { const f32x4 a = *(const LAS f32x4*)(wt + kr * 128 + 4 * c4);
        acc = acc + a.x * *(const LAS f32x4*)(pw + (4 * c4 + 0) * 128 + 4 * nq); acc = acc + a.y * *(const LAS f32x4*)(pw + (4 * c4 + 1) * 128 + 4 * nq);
        acc = acc + a.z * *(const LAS f32x4*)(pw + (4 * c4 + 2) * 128 + 4 * nq); acc = acc + a.w * *(const LAS f32x4*)(pw + (4 * c4 + 3) * 128 + 4 * nq); }
    const float gk = g1[k0 + kr];
    bf16* o = WinT + (size_t)(768 + 128 * g + 4 * nq) * D + k0 + kr;
    o[0] = (bf16)f2bf(acc.x * gk); o[D] = (bf16)f2bf(acc.y * gk); o[2 * D] = (bf16)f2bf(acc.z * gk); o[3 * D] = (bf16)f2bf(acc.w * gk);
    __syncthreads();
}
struct P0Args { const float *x, *g1, *w_in, *pool_w, *w_out, *g2, *wq, *sk, *u, *v; bf16 *XB, *WinT, *WoutT, *WqT, *SK, *PoolT; unsigned char *U8, *V8; float *su, *sv; float* rstd1; };
__device__ __forceinline__ void p0_prologue(const P0Args& a, LAS unsigned char* lds, int gw, int NGW, int wave, int lane) {
    LAS float* scr = (LAS float*)(lds + RING_OFF + wave * 16384);
    for (int it = gw / NWAVES; it < 4 * (D / 16); it += NGW / NWAVES) p0_poolfold_wg(a.w_in, a.pool_w, a.g1, a.WinT, lds, it, wave * 64 + lane);
    constexpr int I_IN = (D / 64) * (768 / 32);
    for (int it = gw; it < I_IN; it += NGW) { const int kb = it / 24, nb = it % 24; p0_transpose_item(a.w_in, D, DIN, a.WinT, a.g1, scr, kb * 40 + nb, lane); }
    for (int m0 = gw; m0 < T; m0 += 4 * NGW) {
        f32x4 v[4][4];
#pragma unroll
        for (int r = 0; r < 4; ++r) { const int m = m0 + r * NGW < T ? m0 + r * NGW : m0; const GAS f32x4* xr = (const GAS f32x4*)(a.x + (size_t)m * D) + lane;
#pragma unroll
            for (int j = 0; j < 4; ++j) v[r][j] = xr[64 * j]; }
#pragma unroll
        for (int r = 0; r < 4; ++r) { const int m = m0 + r * NGW; if (m < T) {
            float s = 0.f; GAS unsigned long long* o8 = (GAS unsigned long long*)(a.XB + (size_t)m * D) + lane;
#pragma unroll
            for (int j = 0; j < 4; ++j) { const f32x4 w = v[r][j]; s += (w.x * w.x + w.y * w.y) + (w.z * w.z + w.w * w.w); o8[64 * j] = (unsigned long long)pk2(w.x, w.y) | ((unsigned long long)pk2(w.z, w.w) << 32); }
            s = wave_sum(s); if (lane == 0) a.rstd1[m] = 1.0f / sqrtf(s * (1.0f / D) + EPS); } }
    }
    for (int m0 = gw; m0 < 2 * NEXP; m0 += 4 * NGW) {
        f32x4 v[4][4];
#pragma unroll
        for (int r = 0; r < 4; ++r) { const int mm = m0 + r * NGW < 2 * NEXP ? m0 + r * NGW : m0; const bool isv = mm >= NEXP; const int m = isv ? mm - NEXP : mm;
            const GAS f32x4* xr = (const GAS f32x4*)((isv ? a.v : a.u) + (size_t)m * D) + lane;
#pragma unroll
            for (int j = 0; j < 4; ++j) v[r][j] = xr[64 * j]; }
#pragma unroll
        for (int r = 0; r < 4; ++r) { const int mm = m0 + r * NGW; if (mm < 2 * NEXP) { const bool isv = mm >= NEXP; const int m = isv ? mm - NEXP : mm;
            float amax = 0.f;
#pragma unroll
            for (int j = 0; j < 4; ++j) { if (!isv) { const f32x4 gv = ((const GAS f32x4*)a.g2)[64 * j + lane]; v[r][j] = v[r][j] * gv; }
                amax = fmaxf(fmaxf(amax, fmaxf(fabsf(v[r][j].x), fabsf(v[r][j].y))), fmaxf(fabsf(v[r][j].z), fabsf(v[r][j].w))); }
#pragma unroll
            for (int o = 1; o < 64; o <<= 1) amax = fmaxf(amax, __shfl_xor(amax, o));
            const float inv = amax > 0.f ? 127.0f / amax : 0.f;
            unsigned char* tb_ = (isv ? a.V8 : a.U8) + (size_t)m * 128 + ((4 * lane) & 127);
#pragma unroll
            for (int j = 0; j < 4; ++j) *(GAS unsigned*)(tb_ + (size_t)((4 * lane + 256 * j) >> 7) * ((size_t)NEXP * 128)) = pack_i8x4(v[r][j].x * inv, v[r][j].y * inv, v[r][j].z * inv, v[r][j].w * inv);
            if (lane == 0) (isv ? a.sv : a.su)[m] = amax * (1.0f / 127.0f); } }
    }
}
__device__ __forceinline__ void p1_late_weights(const P0Args& a, LAS unsigned char* lds, int gw, int NGW, int wave, int lane) {
    LAS float* scr = (LAS float*)(lds + RING_OFF + wave * 16384);
    constexpr int I_OUT = (D / 64) * (D / 32), I_Q = (D / 64) * (DQ / 32);
    for (int it = gw; it < I_OUT + I_Q; it += NGW) {
        if (it < I_OUT) p0_transpose_item(a.w_out, D, D, a.WoutT, nullptr, scr, it, lane);
        else p0_transpose_item(a.wq, D, DQ, a.WqT, a.g2, scr, it - I_OUT, lane);
    }
    for (int m = gw; m < 256; m += NGW) (void)row_to_bf16(a.sk + (size_t)m * D, a.SK + (size_t)m * D, nullptr, lane);
}

__device__ __forceinline__ int t5_bucket(int rel) {
    const int n = rel < 0 ? -rel : rel; const int base = rel > 0 ? 16 : 0;
    const int v = n < 8 ? n : (n < 12 ? 8 : (n < 16 ? 9 : (n < 23 ? 10 : (n < 32 ? 11 : (n < 46 ? 12 : (n < 64 ? 13 : (n < 91 ? 14 : 15)))))));
    return base + v;
}
__device__ __forceinline__ void attn_unit(LAS unsigned char* lds, const bf16* Y, bf16* AB, const float* qg, const float* kg, const float* sinks, const float* relb,
                                          int unit, int tid, int wave, int lane) {
    const int kvh = unit & 1, c = (unit >> 1) & 127, b = unit >> 8;
    LAS bf16* Ks = (LAS bf16*)lds;
    LAS bf16* Vt = (LAS bf16*)(lds + 27648);
    LAS float* bt = (LAS float*)(lds + 53248);
    const int row0 = b * SEQ + (c - 2) * 64;
#pragma unroll
    for (int rep = 0; rep < 3; ++rep) {
        const int it = tid + rep * 512, j = it >> 3, ch = it & 7;
        const bool valid = (c - 2 + (j >> 6)) >= 0;
        v4u kraw = {0u, 0u, 0u, 0u}, vraw = {0u, 0u, 0u, 0u};
        if (valid) { const bf16* rp = Y + (size_t)(row0 + j) * DIN; kraw = *(const GAS v4u*)(rp + 512 + 64 * kvh + 8 * ch); vraw = *(const GAS v4u*)(rp + 640 + 64 * kvh + 8 * ch); }
        float kf[8] = {bf_lo(kraw.x), bf_hi(kraw.x), bf_lo(kraw.y), bf_hi(kraw.y), bf_lo(kraw.z), bf_hi(kraw.z), bf_lo(kraw.w), bf_hi(kraw.w)};
        float ss = 0.f;
#pragma unroll
        for (int e = 0; e < 8; ++e) ss += kf[e] * kf[e];
        ss += __shfl_xor(ss, 1); ss += __shfl_xor(ss, 2); ss += __shfl_xor(ss, 4);
        const float r = 1.0f / sqrtf(ss * (1.0f / 64.0f) + EPS);
        const f32x4 g0 = *(const GAS f32x4*)(kg + 8 * ch), g1 = *(const GAS f32x4*)(kg + 8 * ch + 4);
        v4u ko; ko.x = pk2(kf[0] * r * g0.x, kf[1] * r * g0.y); ko.y = pk2(kf[2] * r * g0.z, kf[3] * r * g0.w); ko.z = pk2(kf[4] * r * g1.x, kf[5] * r * g1.y); ko.w = pk2(kf[6] * r * g1.z, kf[7] * r * g1.w);
        *(LAS v4u*)(Ks + j * 72 + 8 * ch) = ko;
        const int s16 = j >> 4, kk = j & 15, hh = (kk >> 2) & 1, jj = ((kk >> 3) << 2) | (kk & 3), pos = 16 * s16 + 8 * hh + jj;
        LAS bf16* vp = Vt + (8 * ch) * 200 + pos;
        vp[0 * 200] = (bf16)(vraw.x & 0xffffu); vp[1 * 200] = (bf16)(vraw.x >> 16); vp[2 * 200] = (bf16)(vraw.y & 0xffffu); vp[3 * 200] = (bf16)(vraw.y >> 16);
        vp[4 * 200] = (bf16)(vraw.z & 0xffffu); vp[5 * 200] = (bf16)(vraw.z >> 16); vp[6 * 200] = (bf16)(vraw.w & 0xffffu); vp[7 * 200] = (bf16)(vraw.w >> 16);
    }
#pragma unroll
    for (int rep = 0; rep < 2; ++rep) { const int it = tid + rep * 512, g = it >> 8, r = it & 255; bt[it] = relb[t5_bucket(r - 191) * 8 + kvh * 4 + g]; }
    LDS_WAIT(); __syncthreads();

    const int g = wave >> 1, i = 32 * (wave & 1) + (lane & 31), hh = lane >> 5, habs = kvh * 4 + g;
    const size_t qrow = (size_t)b * SEQ + (size_t)c * 64 + i;
    const bf16* qp = Y + qrow * DIN + habs * 64 + 8 * hh;
    v4u qraw[4]; float ss = 0.f;
#pragma unroll
    for (int s = 0; s < 4; ++s) { qraw[s] = *(const GAS v4u*)(qp + 16 * s);
        const float f0 = bf_lo(qraw[s].x), f1 = bf_hi(qraw[s].x), f2 = bf_lo(qraw[s].y), f3 = bf_hi(qraw[s].y), f4 = bf_lo(qraw[s].z), f5 = bf_hi(qraw[s].z), f6 = bf_lo(qraw[s].w), f7 = bf_hi(qraw[s].w);
        ss += (f0 * f0 + f1 * f1) + (f2 * f2 + f3 * f3) + (f4 * f4 + f5 * f5) + (f6 * f6 + f7 * f7); }
    ss += __shfl_xor(ss, 32);
    const float rq = 0.125f / sqrtf(ss * (1.0f / 64.0f) + EPS);
    bf16x8 qf[4];
#pragma unroll
    for (int s = 0; s < 4; ++s) { const f32x4 g0 = *(const GAS f32x4*)(qg + 16 * s + 8 * hh), g1 = *(const GAS f32x4*)(qg + 16 * s + 8 * hh + 4);
        v4u w; w.x = pk2(bf_lo(qraw[s].x) * rq * g0.x, bf_hi(qraw[s].x) * rq * g0.y); w.y = pk2(bf_lo(qraw[s].y) * rq * g0.z, bf_hi(qraw[s].y) * rq * g0.w);
        w.z = pk2(bf_lo(qraw[s].z) * rq * g1.x, bf_hi(qraw[s].z) * rq * g1.y); w.w = pk2(bf_lo(qraw[s].w) * rq * g1.z, bf_hi(qraw[s].w) * rq * g1.w);
        qf[s] = __builtin_bit_cast(bf16x8, w); }
    f32x16 sacc[6];
#pragma unroll
    for (int kt = 0; kt < 6; ++kt) {
#pragma unroll
        for (int r = 0; r < 16; ++r) sacc[kt][r] = 0.f;
#pragma unroll
        for (int s = 0; s < 4; ++s) { const bf16x8 a = *(const LAS bf16x8*)(Ks + (32 * kt + (lane & 31)) * 72 + 16 * s + 8 * hh); sacc[kt] = MFMA32(a, qf[s], sacc[kt]); }
    }
    const LAS float* btg = bt + g * 256 + 63 - i;
    float mx = -3.0e38f;
#pragma unroll
    for (int kt = 0; kt < 6; ++kt) { const bool masked = (c - 2 + (kt >> 1)) < 0;
#pragma unroll
        for (int r = 0; r < 16; ++r) { const int j = 32 * kt + (r & 3) + 8 * (r >> 2) + 4 * hh; float v = sacc[kt][r] + btg[j]; v = masked ? -1.0e30f : v; sacc[kt][r] = v; mx = fmaxf(mx, v); } }
    mx = fmaxf(mx, __shfl_xor(mx, 32));
    const float sink = sinks[habs], m = fmaxf(mx, sink);
    float sum = 0.f;
#pragma unroll
    for (int kt = 0; kt < 6; ++kt)
#pragma unroll
        for (int r = 0; r < 16; ++r) { const float p = __expf(sacc[kt][r] - m); sacc[kt][r] = p; sum += p; }
    sum += __shfl_xor(sum, 32);
    const float inv = 1.0f / (sum + __expf(sink - m));
    f32x16 oacc[2];
#pragma unroll
    for (int dt = 0; dt < 2; ++dt)
#pragma unroll
        for (int r = 0; r < 16; ++r) oacc[dt][r] = 0.f;
#pragma unroll
    for (int kt = 0; kt < 6; ++kt)
#pragma unroll
        for (int s2 = 0; s2 < 2; ++s2) {
            v4u w; w.x = pk2(sacc[kt][8 * s2 + 0], sacc[kt][8 * s2 + 1]); w.y = pk2(sacc[kt][8 * s2 + 2], sacc[kt][8 * s2 + 3]); w.z = pk2(sacc[kt][8 * s2 + 4], sacc[kt][8 * s2 + 5]); w.w = pk2(sacc[kt][8 * s2 + 6], sacc[kt][8 * s2 + 7]);
            const bf16x8 pb = __builtin_bit_cast(bf16x8, w);
#pragma unroll
            for (int dt = 0; dt < 2; ++dt) { const bf16x8 a = *(const LAS bf16x8*)(Vt + (32 * dt + (lane & 31)) * 200 + 32 * kt + 16 * s2 + 8 * hh); oacc[dt] = MFMA32(a, pb, oacc[dt]); }
        }
    bf16* op = AB + qrow * D + habs * 64;
#pragma unroll
    for (int dt = 0; dt < 2; ++dt)
#pragma unroll
        for (int q4 = 0; q4 < 4; ++q4) { const int d = 32 * dt + 8 * q4 + 4 * hh;
            const unsigned long long o = (unsigned long long)pk2(oacc[dt][4 * q4 + 0] * inv, oacc[dt][4 * q4 + 1] * inv) | ((unsigned long long)pk2(oacc[dt][4 * q4 + 2] * inv, oacc[dt][4 * q4 + 3] * inv) << 32);
            *(GAS unsigned long long*)(op + d) = o; }
    __syncthreads();
}

template <int W, bool START> __device__ __forceinline__ void pool_walk(const bf16* zc, bf16* oc, float s0, float s1, int pos0) {
    unsigned ring[16];
    float a0 = 0.f, a1 = 0.f;
#pragma unroll
    for (int q = 0; q < 16; ++q) ring[q] = 0u;
#pragma unroll
    for (int q = 1; q < W; ++q) { if (pos0 - q >= 0) { const unsigned u = *(const GAS unsigned*)(zc - (size_t)q * DIN); ring[(16 - q) & 15] = u; a0 += bf_lo(u); a1 += bf_hi(u); } }
    for (int rb = 0; rb < 64; rb += 16) {
#pragma unroll
        for (int i = 0; i < 16; ++i) {
            const unsigned u = *(const GAS unsigned*)(zc + (size_t)(rb + i) * DIN);
            const float c0 = bf_lo(u), c1 = bf_hi(u);
            a0 += c0; a1 += c1;
            float ic = 1.0f / (float)W; if (START) { const int pos = pos0 + rb + i; ic = 1.0f / (float)(pos + 1 < W ? pos + 1 : W); }
            *(GAS unsigned*)(oc + (size_t)(rb + i) * D) = pk2((a0 * ic - c0) * s0, (a1 * ic - c1) * s1);
            const unsigned old = ring[(i + 17 - W) & 15];
            a0 -= bf_lo(old); a1 -= bf_hi(old);
            ring[i] = u;
        }
    }
}
__device__ __forceinline__ void pool_rows(const bf16* Y, bf16* AB, const float* pscale, int unit, int tid) {
    const int cp = tid & 255, seg = tid >> 8, g = cp >> 6;
    const int r0 = unit * 128 + seg * 64, pos0 = r0 & (SEQ - 1);
    const bf16* zc = Y + (size_t)r0 * DIN + 768 + 2 * cp; bf16* oc = AB + (size_t)r0 * D + 512 + 2 * cp;
    const float s0 = pscale[2 * cp], s1 = pscale[2 * cp + 1];
    if (pos0 >= 16) { if (g == 0) pool_walk<2, false>(zc, oc, s0, s1, pos0); else if (g == 1) pool_walk<4, false>(zc, oc, s0, s1, pos0); else if (g == 2) pool_walk<8, false>(zc, oc, s0, s1, pos0); else pool_walk<16, false>(zc, oc, s0, s1, pos0); }
    else { if (g == 0) pool_walk<2, true>(zc, oc, s0, s1, pos0); else if (g == 1) pool_walk<4, true>(zc, oc, s0, s1, pos0); else if (g == 2) pool_walk<8, true>(zc, oc, s0, s1, pos0); else pool_walk<16, true>(zc, oc, s0, s1, pos0); }
}

__device__ __forceinline__ int f2key(float f) { return __builtin_bit_cast(int, f); }
__device__ __forceinline__ float key2f(int k) { return __builtin_bit_cast(float, k); }
#define CE_DESC(a, b) do { const int _x = (a), _y = (b); (a) = _x > _y ? _x : _y; (b) = _x > _y ? _y : _x; } while (0)
__device__ __forceinline__ void sort16_desc(int (&a)[16]) {
#pragma unroll
    for (int k = 2; k <= 16; k <<= 1)
#pragma unroll
        for (int j = k >> 1; j > 0; j >>= 1)
#pragma unroll
            for (int i = 0; i < 16; ++i) { const int l = i ^ j; if (l > i) { if ((i & k) == 0) CE_DESC(a[i], a[l]); else CE_DESC(a[l], a[i]); } }
}
__device__ __forceinline__ void merge_top16(int (&a)[16], const int (&b)[16]) {
#pragma unroll
    for (int i = 0; i < 16; ++i) a[i] = a[i] > b[15 - i] ? a[i] : b[15 - i];
#pragma unroll
    for (int j = 8; j > 0; j >>= 1)
#pragma unroll
        for (int i = 0; i < 16; ++i) { const int l = i ^ j; if (l > i) CE_DESC(a[i], a[l]); }
}
__device__ __forceinline__ void top16_of_64(int (&g0)[16], int (&g1)[16], int (&g2)[16], int (&g3)[16]) {
    sort16_desc(g0); sort16_desc(g1); sort16_desc(g2); sort16_desc(g3);
    merge_top16(g0, g1); merge_top16(g2, g3); merge_top16(g0, g2);
}
__device__ __forceinline__ void topk_stage_keys(LAS unsigned char* lds, const bf16* SK, int h, int tid) {
#pragma unroll
    for (int i = 0; i < 8; ++i) { const int c = tid + 512 * i, p = c >> 11, n = (c >> 4) & 127, ch = c & 15;
        *(LAS v4u*)(lds + p * 34816 + n * 272 + ch * 16) = *(const GAS v4u*)(SK + ((size_t)(h * 2 + p) * 128 + n) * 128 + ch * 8); }
    LDS_WAIT(); __syncthreads();
}
__device__ __forceinline__ void topk_unit(LAS unsigned char* lds, const bf16* QP, const bf16* SK, unsigned short* EXPERTS, float* BEST, int unit, int tid, int wave, int lane) {
    const int h = unit & 7, tt = unit >> 3, hh = lane >> 5;
    const int tok = tt * 256 + wave * 32 + (lane & 31);
    static_assert(69632 + 512 * 33 * 4 <= PHASE_LDS_MAX, "top-k LDS scratch runs into the LDS control words");
    LAS int* mine = (LAS int*)(lds + 69632) + tid * 33;
    int top[2][16];
#pragma unroll
    for (int p = 0; p < 2; ++p) {
        const bf16* qp = QP + (size_t)tok * DQ + h * 256 + p * 128 + 8 * hh;
        const LAS unsigned char* kp = lds + p * 34816 + (lane & 31) * 272 + 16 * hh;
        f32x16 acc[4];
#pragma unroll
        for (int nt = 0; nt < 4; ++nt)
#pragma unroll
            for (int r = 0; r < 16; ++r) acc[nt][r] = 8.0f;
#pragma unroll
        for (int s = 0; s < 8; ++s) { const bf16x8 bq = __builtin_bit_cast(bf16x8, *(const GAS v4u*)(qp + 16 * s));
#pragma unroll
            for (int nt = 0; nt < 4; ++nt) { const bf16x8 a = *(const LAS bf16x8*)(kp + nt * (32 * 272) + 32 * s); acc[nt] = MFMA32(a, bq, acc[nt]); } }
        int k0[16], k1[16], k2[16], k3[16];
#pragma unroll
        for (int r = 0; r < 16; ++r) { const int n = (r & 3) + 8 * (r >> 2) + 4 * hh;
            k0[r] = (f2key(acc[0][r]) & ~127) | n; k1[r] = (f2key(acc[1][r]) & ~127) | (32 + n); k2[r] = (f2key(acc[2][r]) & ~127) | (64 + n); k3[r] = (f2key(acc[3][r]) & ~127) | (96 + n); }
        top16_of_64(k0, k1, k2, k3);
#pragma unroll
        for (int r = 0; r < 16; ++r) k1[r] = __shfl_xor(k0[r], 32);
        merge_top16(k0, k1);
#pragma unroll
        for (int r = 0; r < 16; ++r) top[p][r] = k0[r];
    }
    int c0[16], c1[16], c2[16], c3[16];
    {
        float v1[16], v2[16];
#pragma unroll
        for (int r = 0; r < 16; ++r) { v1[r] = key2f(top[0][r] & ~127); v2[r] = key2f(top[1][r] & ~127); mine[r] = top[0][r]; mine[16 + r] = top[1][r]; }
        int cnt = 0;
#pragma unroll
        for (int i = 0; i < 16; ++i)
#pragma unroll
            for (int j = 0; j < 16; ++j) if ((i + 1) * (j + 1) <= 16) { const int key = (f2key(v1[i] + v2[j]) & ~255) | (i << 4) | j;
                if (cnt < 16) c0[cnt] = key; else if (cnt < 32) c1[cnt - 16] = key; else if (cnt < 48) c2[cnt - 32] = key; else c3[cnt - 48] = key; ++cnt; }
#pragma unroll
        for (int r = 0; r < 16; ++r) if (48 + r >= cnt) c3[r] = (int)0x80000000;
    }
    top16_of_64(c0, c1, c2, c3);
    LDS_WAIT();
    if (hh == 0) {
        int ev[16]; float bv[16];
#pragma unroll
        for (int r = 0; r < 16; ++r) { const int id = c0[r] & 255; const int ka = mine[id >> 4], kb = mine[16 + (id & 15)];
            ev[r] = (ka & 127) * 128 + (kb & 127); bv[r] = (key2f(ka & ~127) - 8.0f) + (key2f(kb & ~127) - 8.0f); }
        unsigned short* ep = EXPERTS + (size_t)tok * 128 + h * 16; float* bp = BEST + (size_t)tok * 128 + h * 16;
#pragma unroll
        for (int r = 0; r < 16; r += 8) *(GAS v4u*)(ep + r) = (v4u){(unsigned)ev[r] | ((unsigned)ev[r + 1] << 16), (unsigned)ev[r + 2] | ((unsigned)ev[r + 3] << 16), (unsigned)ev[r + 4] | ((unsigned)ev[r + 5] << 16), (unsigned)ev[r + 6] | ((unsigned)ev[r + 7] << 16)};
#pragma unroll
        for (int r = 0; r < 16; r += 4) *(GAS f32x4*)(bp + r) = (f32x4){bv[r], bv[r + 1], bv[r + 2], bv[r + 3]};
    }
    LDS_WAIT();
}

__device__ __forceinline__ float gelu_erf(float x) { return 0.5f * x * (1.0f + erff(x * 0.70710678118654752f)); }
#define PEER_BL(rs, e_, c_) __builtin_amdgcn_raw_buffer_load_b128(rs, (int)(((e_) << 7) + (c_)), 0, 0)
#define PEER_ROWS(r, rs, c_, q) do { const v4u _ev = *(const LAS v4u*)(evp + 16 * (q)); \
        r[0] = PEER_BL(rs, _ev.x & 0xffffu, c_); r[1] = PEER_BL(rs, _ev.x >> 16, c_); r[2] = PEER_BL(rs, _ev.y & 0xffffu, c_); r[3] = PEER_BL(rs, _ev.y >> 16, c_); \
        r[4] = PEER_BL(rs, _ev.z & 0xffffu, c_); r[5] = PEER_BL(rs, _ev.z >> 16, c_); r[6] = PEER_BL(rs, _ev.w & 0xffffu, c_); r[7] = PEER_BL(rs, _ev.w >> 16, c_); } while (0)
__device__ __forceinline__ void peer_u_phase(LAS unsigned char* lds, const bf16* X1B, const unsigned char* U8, const unsigned short* EXP16, float* PD, int j, int w, int nw, int wave, int lane) {
    const int grp = lane >> 3, sub = lane & 7;
    LAS unsigned char* wl = lds + wave * 8192;
    const LAS unsigned char* evp = wl + grp * 256;
    const int stride = nw * NWAVES * 8;
    int tb = (w * NWAVES + wave) * 8;
    v4u pe0 = {0u, 0u, 0u, 0u}, pe1 = {0u, 0u, 0u, 0u};
    v4u px0 = {0u, 0u, 0u, 0u}, px1 = {0u, 0u, 0u, 0u};
    if (tb < T) { const GAS v4u* e = (const GAS v4u*)(EXP16 + (size_t)tb * 128) + lane; pe0 = e[0]; pe1 = e[64];
        const GAS v4u* xp = (const GAS v4u*)(X1B + (size_t)(tb + grp) * D + 128 * j + 16 * sub); px0 = xp[0]; px1 = xp[1]; }
    const __amdgpu_buffer_rsrc_t urs = __builtin_amdgcn_make_buffer_rsrc((void*)U8, (short)0, NEXP * D, 0x00020000); const unsigned uc = (unsigned)j * (NEXP * 128u) + 16u * sub;
    for (; tb < T; tb += stride) {
        *(LAS v4u*)(wl + 16 * lane) = pe0; *(LAS v4u*)(wl + 1024 + 16 * lane) = pe1;
        const v4u xa = px0, xc = px1;
        if (tb + stride < T) { const GAS v4u* e = (const GAS v4u*)(EXP16 + (size_t)(tb + stride) * 128) + lane; pe0 = e[0]; pe1 = e[64];
            const GAS v4u* xp = (const GAS v4u*)(X1B + (size_t)(tb + stride + grp) * D + 128 * j + 16 * sub); px0 = xp[0]; px1 = xp[1]; }
        const int t = tb + grp;
        const f32x4 x0 = {bf_lo(xa.x), bf_hi(xa.x), bf_lo(xa.y), bf_hi(xa.y)}, x1 = {bf_lo(xa.z), bf_hi(xa.z), bf_lo(xa.w), bf_hi(xa.w)};
        const f32x4 x2 = {bf_lo(xc.x), bf_hi(xc.x), bf_lo(xc.y), bf_hi(xc.y)}, x3 = {bf_lo(xc.z), bf_hi(xc.z), bf_lo(xc.w), bf_hi(xc.w)};
        float amax = fmaxf(fmaxf(fmaxf(fabsf(x0.x), fabsf(x0.y)), fmaxf(fabsf(x0.z), fabsf(x0.w))), fmaxf(fmaxf(fabsf(x1.x), fabsf(x1.y)), fmaxf(fabsf(x1.z), fabsf(x1.w))));
        amax = fmaxf(amax, fmaxf(fmaxf(fmaxf(fabsf(x2.x), fabsf(x2.y)), fmaxf(fabsf(x2.z), fabsf(x2.w))), fmaxf(fmaxf(fabsf(x3.x), fabsf(x3.y)), fmaxf(fabsf(x3.z), fabsf(x3.w)))));
        amax = fmaxf(amax, __shfl_xor(amax, 1)); amax = fmaxf(amax, __shfl_xor(amax, 2)); amax = fmaxf(amax, __shfl_xor(amax, 4));
        const float inv = amax > 0.f ? 127.0f / amax : 0.f, sx = amax * (1.0f / 127.0f);
        const unsigned xq0 = pack_i8x4(x0.x * inv, x0.y * inv, x0.z * inv, x0.w * inv), xq1 = pack_i8x4(x1.x * inv, x1.y * inv, x1.z * inv, x1.w * inv);
        const unsigned xq2 = pack_i8x4(x2.x * inv, x2.y * inv, x2.z * inv, x2.w * inv), xq3 = pack_i8x4(x3.x * inv, x3.y * inv, x3.z * inv, x3.w * inv);
        const bool up4 = (sub & 4) != 0, up2 = (sub & 2) != 0, up1 = (sub & 1) != 0;
        LAS _Float16* pd = (LAS _Float16*)(wl + 4096) + grp * 128 + sub;
        LDS_WAIT();
        v4u ra[8], rb[8], rc[8];
        PEER_ROWS(ra, urs, uc, 0); PEER_ROWS(rb, urs, uc, 1);
#define PEER_UDOT(r, q) do { int p[8]; _Pragma("unroll") for (int i = 0; i < 8; ++i) { int a = __builtin_amdgcn_sdot4((int)r[i].x, (int)xq0, 0, false); a = __builtin_amdgcn_sdot4((int)r[i].y, (int)xq1, a, false); \
                a = __builtin_amdgcn_sdot4((int)r[i].z, (int)xq2, a, false); p[i] = __builtin_amdgcn_sdot4((int)r[i].w, (int)xq3, a, false); } \
            _Pragma("unroll") for (int i = 0; i < 4; ++i) { const int keep = up4 ? p[i + 4] : p[i], send = up4 ? p[i] : p[i + 4]; p[i] = keep + __builtin_amdgcn_mov_dpp(send, 0x141, 0xF, 0xF, true); } \
            _Pragma("unroll") for (int i = 0; i < 2; ++i) { const int keep = up2 ? p[i + 2] : p[i], send = up2 ? p[i] : p[i + 2]; p[i] = keep + __builtin_amdgcn_mov_dpp(send, 0x4E, 0xF, 0xF, true); } \
            { const int keep = up1 ? p[1] : p[0], send = up1 ? p[0] : p[1]; p[0] = keep + __builtin_amdgcn_mov_dpp(send, 0xB1, 0xF, 0xF, true); } \
            pd[8 * (q)] = (_Float16)((float)p[0] * sx); } while (0)
        for (int q = 0; q < 15; q += 3) {
            PEER_ROWS(rc, urs, uc, q + 2); PEER_UDOT(ra, q);
            PEER_ROWS(ra, urs, uc, q + 3); PEER_UDOT(rb, q + 1);
            if (q + 4 < 16) PEER_ROWS(rb, urs, uc, q + 4);
            PEER_UDOT(rc, q + 2);
        }
        PEER_UDOT(ra, 15);
        LDS_WAIT();
#pragma unroll
        for (int qq = 0; qq < 2; ++qq) { const v4u pv = *(const LAS v4u*)(wl + 4096 + qq * 1024 + 16 * lane);
            *(GAS v4u*)((_Float16*)PD + ((size_t)j * T + tb + 4 * qq + (lane >> 4)) * 128 + 8 * (lane & 15)) = pv; }
    }
}
__device__ __forceinline__ void peer_stage_scales(LAS unsigned char* lds, const float* su, const float* sv, int tid) {
#pragma unroll
    for (int i = 0; i < 8; ++i) { *(LAS f32x4*)(lds + (size_t)(tid + 512 * i) * 16) = ((const GAS f32x4*)su)[tid + 512 * i]; *(LAS f32x4*)(lds + 65536 + (size_t)(tid + 512 * i) * 16) = ((const GAS f32x4*)sv)[tid + 512 * i]; }
    LDS_WAIT(); __syncthreads();
}
__device__ __forceinline__ void peer_combine4(LAS unsigned char* lds, const float* PD, const unsigned short* EXP16, const float* BEST, const float* SS2, unsigned char* CC8, float* SCC, int t0, int lane) {
    const LAS float* su = (const LAS float*)lds; const LAS float* sv = (const LAS float*)(lds + 65536);
    typedef float f32x2v __attribute__((ext_vector_type(2)));
    f32x4 ssv[4][4]; unsigned ev[4]; f32x2v bv[4]; f32x2v pdv[4][8];
#pragma unroll
    for (int i = 0; i < 4; ++i) { const int t = t0 + i;
        const GAS f32x4* sp = (const GAS f32x4*)(SS2 + (size_t)t * 16);
#pragma unroll
        for (int q = 0; q < 4; ++q) ssv[i][q] = sp[q];
        ev[i] = ((const GAS unsigned*)(EXP16 + (size_t)t * 128))[lane];
        bv[i] = ((const GAS f32x2v*)(BEST + (size_t)t * 128))[lane];
#pragma unroll
        for (int j = 0; j < 8; ++j) { typedef _Float16 h2v __attribute__((ext_vector_type(2))); const h2v hv = ((const GAS h2v*)((const _Float16*)PD + ((size_t)j * T + t) * 128))[lane]; pdv[i][j] = (f32x2v){(float)hv.x, (float)hv.y}; } }
    float suv[4][2], svv[4][2];
#pragma unroll
    for (int i = 0; i < 4; ++i) { const unsigned e0 = ev[i] & 0xffffu, e1 = ev[i] >> 16; suv[i][0] = su[e0]; suv[i][1] = su[e1]; svv[i][0] = sv[e0]; svv[i][1] = sv[e1]; }
#pragma unroll
    for (int i = 0; i < 4; ++i) { const int t = t0 + i;
        float ssq = 0.f;
#pragma unroll
        for (int q = 0; q < 4; ++q) ssq += (ssv[i][q].x + ssv[i][q].y) + (ssv[i][q].z + ssv[i][q].w);
        const float rstd2 = 1.0f / sqrtf(ssq * (1.0f / D) + EPS);
        const float s0 = bv[i].x * rstd2, s1 = bv[i].y * rstd2;
        float mx = fmaxf(s0, s1);
#pragma unroll
        for (int o = 1; o < 8; o <<= 1) mx = fmaxf(mx, __shfl_xor(mx, o));
        const float e0 = __expf(s0 - mx), e1 = __expf(s1 - mx); float sm = e0 + e1;
#pragma unroll
        for (int o = 1; o < 8; o <<= 1) sm += __shfl_xor(sm, o);
        float d0 = 0.f, d1 = 0.f;
#pragma unroll
        for (int j = 0; j < 8; ++j) { d0 += pdv[i][j].x; d1 += pdv[i][j].y; }
        const float inv_sm = 1.0f / sm;
        const float c0 = e0 * inv_sm * gelu_erf(d0 * rstd2 * suv[i][0]) * svv[i][0], c1 = e1 * inv_sm * gelu_erf(d1 * rstd2 * suv[i][1]) * svv[i][1];
        float amax = fmaxf(fabsf(c0), fabsf(c1));
#pragma unroll
        for (int o = 1; o < 64; o <<= 1) amax = fmaxf(amax, __shfl_xor(amax, o));
        const float inv = amax > 0.f ? 127.0f / amax : 0.f;
        ((GAS unsigned short*)(CC8 + (size_t)t * 128))[lane] = (unsigned short)((__float2int_rn(c0 * inv) & 0xff) | ((__float2int_rn(c1 * inv) & 0xff) << 8));
        if (lane == 0) SCC[t] = amax * (1.0f / 127.0f); }
}
__device__ __forceinline__ void peer_v_phase(LAS unsigned char* lds, float* OUT, const bf16* X1B, const unsigned char* V8, const unsigned short* EXP16, const unsigned char* CC8, const float* SCC, int j, int w, int nw, int wave, int lane) {
    const int grp = lane >> 3, sub = lane & 7;
    LAS unsigned char* wl = lds + wave * 8192;
    const LAS unsigned char* evp = wl + grp * 256;
    const LAS unsigned char* ccp = wl + 2048 + grp * 128;
    const int stride = nw * NWAVES * 8;
    int tb = (w * NWAVES + wave) * 8;
    v4u pe0 = {0u, 0u, 0u, 0u}, pe1 = {0u, 0u, 0u, 0u}, pc0 = {0u, 0u, 0u, 0u};
    if (tb < T) { const GAS v4u* e = (const GAS v4u*)(EXP16 + (size_t)tb * 128) + lane; pe0 = e[0]; pe1 = e[64]; pc0 = ((const GAS v4u*)(CC8 + (size_t)tb * 128))[lane]; }
    const __amdgpu_buffer_rsrc_t vrs = __builtin_amdgcn_make_buffer_rsrc((void*)V8, (short)0, NEXP * D, 0x00020000); const unsigned vc = (unsigned)j * (NEXP * 128u) + 16u * sub;
    for (; tb < T; tb += stride) {
        *(LAS v4u*)(wl + 16 * lane) = pe0; *(LAS v4u*)(wl + 1024 + 16 * lane) = pe1; *(LAS v4u*)(wl + 2048 + 16 * lane) = pc0;
        if (tb + stride < T) { const GAS v4u* e = (const GAS v4u*)(EXP16 + (size_t)(tb + stride) * 128) + lane; pe0 = e[0]; pe1 = e[64]; pc0 = ((const GAS v4u*)(CC8 + (size_t)(tb + stride) * 128))[lane]; }
        const int t = tb + grp;
        const float scc = SCC[t];
        const size_t eo = (size_t)t * D + 128 * j + 16 * sub;
        const GAS v4u* dp = (const GAS v4u*)(X1B + eo);
        const v4u da = dp[0], db = dp[1];
        int acc[16];
#pragma unroll
        for (int i = 0; i < 16; ++i) acc[i] = 0;
        LDS_WAIT();
        v4u rq[4][4];
#define PEER_LOADQ(r, qn) do { const unsigned long long _e4 = *(const LAS unsigned long long*)(evp + 8 * (qn)); const unsigned _lo = (unsigned)_e4, _hi = (unsigned)(_e4 >> 32); \
            r[0] = PEER_BL(vrs, _lo & 0xffffu, vc); r[1] = PEER_BL(vrs, _lo >> 16, vc); r[2] = PEER_BL(vrs, _hi & 0xffffu, vc); r[3] = PEER_BL(vrs, _hi >> 16, vc); } while (0)
#define PEER_T4(w_, r0, r1, r2, r3, cpk) do { const unsigned tl0 = __builtin_amdgcn_perm(r1, r0, 0x05010400u), th0 = __builtin_amdgcn_perm(r1, r0, 0x07030602u); \
            const unsigned tl1 = __builtin_amdgcn_perm(r3, r2, 0x05010400u), th1 = __builtin_amdgcn_perm(r3, r2, 0x07030602u); \
            acc[4 * (w_) + 0] = __builtin_amdgcn_sdot4((int)__builtin_amdgcn_perm(tl1, tl0, 0x05040100u), (int)(cpk), acc[4 * (w_) + 0], false); \
            acc[4 * (w_) + 1] = __builtin_amdgcn_sdot4((int)__builtin_amdgcn_perm(tl1, tl0, 0x07060302u), (int)(cpk), acc[4 * (w_) + 1], false); \
            acc[4 * (w_) + 2] = __builtin_amdgcn_sdot4((int)__builtin_amdgcn_perm(th1, th0, 0x05040100u), (int)(cpk), acc[4 * (w_) + 2], false); \
            acc[4 * (w_) + 3] = __builtin_amdgcn_sdot4((int)__builtin_amdgcn_perm(th1, th0, 0x07060302u), (int)(cpk), acc[4 * (w_) + 3], false); } while (0)
#define PEER_COMPQ(r, qn) do { const unsigned _c = *(const LAS unsigned*)(ccp + 4 * (qn)); \
            PEER_T4(0, r[0].x, r[1].x, r[2].x, r[3].x, _c); PEER_T4(1, r[0].y, r[1].y, r[2].y, r[3].y, _c); PEER_T4(2, r[0].z, r[1].z, r[2].z, r[3].z, _c); PEER_T4(3, r[0].w, r[1].w, r[2].w, r[3].w, _c); } while (0)
#pragma unroll
        for (int jq = 0; jq < 4; ++jq) PEER_LOADQ(rq[jq], jq);
        for (int it = 0; it < 8; ++it) {
#pragma unroll
            for (int jq = 0; jq < 4; ++jq) { PEER_COMPQ(rq[jq], 4 * it + jq); if (it < 7) PEER_LOADQ(rq[jq], 4 * it + 4 + jq); }
        }
        const float dl[16] = {bf_lo(da.x), bf_hi(da.x), bf_lo(da.y), bf_hi(da.y), bf_lo(da.z), bf_hi(da.z), bf_lo(da.w), bf_hi(da.w), bf_lo(db.x), bf_hi(db.x), bf_lo(db.y), bf_hi(db.y), bf_lo(db.z), bf_hi(db.z), bf_lo(db.w), bf_hi(db.w)};
#pragma unroll
        for (int q = 0; q < 4; ++q) { f32x4 v; v.x = dl[4 * q + 0] + scc * (float)acc[4 * q + 0]; v.y = dl[4 * q + 1] + scc * (float)acc[4 * q + 1]; v.z = dl[4 * q + 2] + scc * (float)acc[4 * q + 2]; v.w = dl[4 * q + 3] + scc * (float)acc[4 * q + 3];
            *(LAS f32x4*)(wl + 4096 + grp * 512 + sub * 64 + 16 * q) = v; }
        LDS_WAIT();
#pragma unroll
        for (int qq = 0; qq < 4; ++qq) { const f32x4 v = *(const LAS f32x4*)(wl + 4096 + qq * 1024 + 16 * lane);
            *(GAS f32x4*)(OUT + (size_t)(tb + 2 * qq + (lane >> 5)) * D + 128 * j + 4 * (lane & 31)) = v; }
    }
}
struct Args { const float* in[15]; float* out; unsigned char* ws; int ph_lo, ph_hi, li, pad; };
__global__ void __launch_bounds__(NWAVES * 64, 2) fwd_kernel(Args args) {
    extern __shared__ __attribute__((aligned(16))) unsigned char lds_raw[];
    LAS unsigned char* lds = (LAS unsigned char*)lds_raw;
    volatile LAS unsigned* MISC = (volatile LAS unsigned*)(lds + MISC_OFF);
    const int tid = threadIdx.x, lane = tid & 63, wave = __builtin_amdgcn_readfirstlane(tid >> 6);
    const int G = gridDim.x, bx = blockIdx.x;
    unsigned char* ws = args.ws;
    gu32* ctl = (gu32*)(ws + WS_CTL);
    for (int u = tid; u < (LDS_BYTES - LDSCTL_OFF) / 4; u += NWAVES * 64) ((LAS unsigned*)(lds + LDSCTL_OFF))[u] = 0u;
    __syncthreads();
    XcdBarrier bar; bar.bar = (unsigned*)(ctl + CW_BAR); bar.x = 0; bar.st = nullptr;
    if (N_LAUNCHES != PER_PHASE) bar = xcd_barrier_post((unsigned*)(ctl + CW_BAR) + args.li * XCD_BAR_WORDS, MISC + 8);
#define GRID_BAR() do { if (N_LAUNCHES != PER_PHASE) xcd_barrier(bar); } while (0)
    const int lo = args.ph_lo, hi = args.ph_hi;
#define IN(k) (lo <= (k) && (k) < hi)
#define BOTH(k) (IN(k) && IN((k) + 1))
#ifndef MK_REPEAT
#define MK_REPEAT -1
#endif
#define REP(k) for (int _r = 0; _r < ((MK_REPEAT == (k)) ? 2 : 1); ++_r)

    const float* x = args.in[0]; float* out = args.out;
    bf16* XB = (bf16*)(ws + WS_XB); bf16* WinT = (bf16*)(ws + WS_WIN); bf16* WoutT = (bf16*)(ws + WS_WOUT); bf16* WqT = (bf16*)(ws + WS_WQ);
    bf16* SK = (bf16*)(ws + WS_SK); bf16* PoolT = (bf16*)(ws + WS_POOLT); unsigned char* U8 = ws + WS_U8; unsigned char* V8 = ws + WS_V8; float* SU = (float*)(ws + WS_SU); float* SV = (float*)(ws + WS_SV);
    bf16* Y = (bf16*)(ws + WS_Y); bf16* AB = (bf16*)(ws + WS_AB); bf16* X1B = (bf16*)(ws + WS_X1B); bf16* QP = (bf16*)(ws + WS_QP);
    float* rstd1 = (float*)(ws + WS_RSTD1); float* SS2 = (float*)(ws + WS_SS2); unsigned short* EXPERTS = (unsigned short*)(ws + WS_EXP); float* BEST = (float*)(ws + WS_BEST);
    float* PD = (float*)(ws + WS_PD); bf16* DELTA = (bf16*)(ws + WS_DELTA); unsigned char* CC8 = ws + WS_CC; float* SCC = (float*)(ws + WS_SCC);
    const int gw = bx * NWAVES + wave, NGW = G * NWAVES;

    const P0Args p0a{x, args.in[1], args.in[2], args.in[7], args.in[9], args.in[10], args.in[11], args.in[12], args.in[13], args.in[14], XB, WinT, WoutT, WqT, SK, PoolT, U8, V8, SU, SV, rstd1};
    if (IN(0)) REP(0) {
        p0_prologue(p0a, lds, gw, NGW, wave, lane);
        if (BOTH(0)) GRID_BAR();
    }
    if (IN(1)) REP(1) {
        pg8::Gemm g{XB, WinT, T, DIN, D}; pg8::StaticOrder S; S.init(T, DIN, G, bx);
        pg8::EpiScaleBf16 E{Y, DIN, rstd1};
        pg8::gemm_phase<pg8::EpiScaleBf16, pg8::StaticOrder, true, true>(lds + RING_OFF, g, S, E);
        { const int nwg1 = (T / 256) * (DIN / 256), rem = nwg1 % G;
          if (rem == 0) p1_late_weights(p0a, lds, gw, NGW, wave, lane); else if (bx >= rem) p1_late_weights(p0a, lds, (bx - rem) * NWAVES + wave, (G - rem) * NWAVES, wave, lane); }
        if (BOTH(1)) GRID_BAR();
    }
    if (IN(2)) REP(2) {
        for (int u = bx; u < NB * 128 * 2; u += G) attn_unit(lds, Y, AB, args.in[3], args.in[4], args.in[5], args.in[6], u, tid, wave, lane);
        for (int u = bx; u < T / 128; u += G) pool_rows(Y, AB, args.in[8], u, tid);
        if (BOTH(2)) GRID_BAR();
    }
    if (IN(3)) REP(3) {
        pg8::Gemm g{AB, WoutT, T, D, D}; pg8::StaticOrder S; S.init(T, D, G, bx);
        pg8::EpiResid E{XB, X1B, SS2, D};
        pg8::gemm_phase<pg8::EpiResid, pg8::StaticOrder, true, true>(lds + RING_OFF, g, S, E);
        if (BOTH(3)) GRID_BAR();
    }
    if (IN(4)) REP(4) {
        pg8::Gemm g{X1B, WqT, T, DQ, D}; pg8::StaticOrder S; S.init(T, DQ, G, bx);
        pg8::EpiScaleBf16 E{QP, DQ, nullptr};
        pg8::gemm_phase<pg8::EpiScaleBf16, pg8::StaticOrder, true, true>(lds + RING_OFF, g, S, E);
        if (BOTH(4)) GRID_BAR();
    }
    if (IN(5)) REP(5) {
        { int hs = -1; for (int u = bx; u < (T / 256) * 8; u += G) { if ((u & 7) != hs) { if (hs >= 0) __syncthreads(); hs = u & 7; topk_stage_keys(lds, SK, hs, tid); } topk_unit(lds, QP, SK, EXPERTS, BEST, u, tid, wave, lane); } }
        if (BOTH(5)) GRID_BAR();
    }
    if (IN(6)) REP(6) {
        if ((G & 7) == 0) peer_u_phase(lds, X1B, U8, EXPERTS, PD, bx & 7, bx >> 3, G >> 3, wave, lane);
        else for (int j = 0; j < 8; ++j) peer_u_phase(lds, X1B, U8, EXPERTS, PD, j, bx, G, wave, lane);
        if (BOTH(6)) GRID_BAR();
    }
    if (IN(7)) REP(7) {
        peer_stage_scales(lds, SU, SV, tid);
        for (int t0 = gw * 4; t0 < T; t0 += NGW * 4) peer_combine4(lds, PD, EXPERTS, BEST, SS2, CC8, SCC, t0, lane);
        if (BOTH(7)) GRID_BAR();
    }
    if (IN(8)) {
        if ((G & 7) == 0) peer_v_phase(lds, out, X1B, V8, EXPERTS, CC8, SCC, bx & 7, bx >> 3, G >> 3, wave, lane);
        else for (int j = 0; j < 8; ++j) peer_v_phase(lds, out, X1B, V8, EXPERTS, CC8, SCC, j, bx, G, wave, lane);
    }
#undef IN
#undef BOTH
}

extern "C" void kernel_launch(void* const* d_in, const int* in_sizes, int n_in, void* d_out, int out_size, void* d_ws, size_t ws_size, hipStream_t stream) {
    static int grid = 0;
    if (grid == 0) {
        if (n_in != 15 || in_sizes[0] != T * D || out_size != T * D || ws_size < WS_END) { fprintf(stderr, "kernel_launch: unexpected shapes (n_in %d, in0 %d, out %d, ws %zu)\n", n_in, n_in > 0 ? in_sizes[0] : -1, out_size, ws_size); grid = -1; return; }
        int dev = 0, cus = 0, per_cu = 0;
        if (hipGetDevice(&dev) != hipSuccess || hipDeviceGetAttribute(&cus, hipDeviceAttributeMultiprocessorCount, dev) != hipSuccess) { grid = -1; return; }
        if (hipFuncSetAttribute((const void*)fwd_kernel, hipFuncAttributeMaxDynamicSharedMemorySize, LDS_BYTES) != hipSuccess) { fprintf(stderr, "kernel_launch: hipFuncSetAttribute failed\n"); grid = -1; return; }
        if (hipOccupancyMaxActiveBlocksPerMultiprocessor(&per_cu, (const void*)fwd_kernel, NWAVES * 64, LDS_BYTES) != hipSuccess || per_cu < 1) { fprintf(stderr, "kernel_launch: occupancy query reports %d blocks per CU\n", per_cu); }
        (void)hipGetLastError();
        grid = cus;
    }
    if (grid < 0) return;
    if (hipMemsetAsync((char*)d_ws + WS_CTL, 0, CTL_ZERO_BYTES, stream) != hipSuccess) return;
    Args a{};
    for (int i = 0; i < 15; ++i) a.in[i] = (const float*)d_in[i];
    a.out = (float*)d_out; a.ws = (unsigned char*)d_ws;
    for (int li = 0; li < N_LAUNCHES; ++li) {
        a.ph_lo = (N_LAUNCHES == PER_PHASE) ? li : 0; a.ph_hi = (N_LAUNCHES == PER_PHASE) ? li + 1 : PER_PHASE; a.li = (N_LAUNCHES == PER_PHASE) ? 0 : li;
        hipLaunchKernelGGL(fwd_kernel, dim3(grid), dim3(NWAVES * 64), LDS_BYTES, stream, a);
        const hipError_t le = hipPeekAtLastError();
        if (le != hipSuccess) { fprintf(stderr, "kernel_launch: launch %d failed: %s\n", li, hipGetErrorName(le)); break; }
    }
}
```

```cpp
#include <hip/hip_runtime.h>
#include <cstdio>
#include <cstdint>
namespace pg8 {
#define PG8_LAS __attribute__((address_space(3)))
typedef unsigned short bf16_t;
typedef short bf16x8 __attribute__((ext_vector_type(8)));
typedef float f32x4 __attribute__((ext_vector_type(4)));
typedef unsigned u32x4 __attribute__((ext_vector_type(4)));
constexpr int BM = 256, BK = 64, HALF = 128, HTB = HALF * BK * 2  , STAGE_BYTES = 8 * HTB, NXCD = 8, WGM = 8;

__host__ __device__ __forceinline__ int lds_byte(int r, int c) { const int st = (r >> 4) * 2 + (c >> 5), rr = r & 15, cc = c & 31, ob = rr * 64 + cc * 2; return st * 1024 + (ob ^ (((ob >> 9) & 1) << 5)); }
__host__ __device__ __forceinline__ void stage_rc(int b, int& R, int& C) { const int st = b / 1024, sb = b % 1024, swz = sb ^ (((sb >> 9) & 1) << 5); R = (st >> 1) * 16 + swz / 64; C = (st & 1) * 32 + (swz % 64) / 2; }
__host__ __device__ __forceinline__ int perm32(int rho) { const int n = rho >> 4, i = rho & 15; return 8 * (i >> 2) + 4 * n + (i & 3); }

struct Unit { int pm, pn; };
struct Gemm { const bf16_t* A; const bf16_t* Bt; int M, N, K; };

struct StaticOrder {
    int nM, nN, nwg, G, c;
    __host__ __device__ void init(int M, int N, int G_, int c_) { nM = M / BM; nN = N / BM; nwg = nM * nN; G = G_; c = c_; }
    __host__ __device__ bool next(int i, Unit& u) const {
        const long L = (long)i * G + c; if (L >= nwg) return false;
        int wgid = (int)L; { const int q = nwg / NXCD, r = nwg % NXCD, xcd = wgid % NXCD, off = wgid / NXCD; wgid = (xcd < r ? xcd * (q + 1) : r * (q + 1) + (xcd - r) * q) + off; }
        const int nig = WGM * nN, gid = wgid / nig, fm = gid * WGM, gsz = (nM - fm) < WGM ? (nM - fm) : WGM;
        u.pm = fm + ((wgid % nig) % gsz); u.pn = (wgid % nig) / gsz; return true;
    }
    __device__ __forceinline__ void a_ready(const Unit&) const {}
    __device__ __forceinline__ void done(const Unit&) const {}
};

__device__ __forceinline__ unsigned cvt_pk_bf16(float lo, float hi) { unsigned r; asm volatile("v_cvt_pk_bf16_f32 %0, %1, %2" : "=v"(r) : "v"(lo), "v"(hi)); return r; }
struct EpiScaleBf16 {
    static constexpr bool PERM = true, AFTER_DRAIN = false, PROBE_TWICE = false;
    bf16_t* O; int ldc; const float* rs;
    __device__ __forceinline__ void operator()(const f32x4 (&acc)[2][2][4][2], const Unit& u, int wr, int wc, int fr, int fq) const {
        const int row0 = u.pm * BM + wr * 64 + fr, col0 = u.pn * BM + wc * 32 + 8 * fq;
#pragma unroll
        for (int ai = 0; ai < 2; ++ai)
#pragma unroll
            for (int m = 0; m < 4; ++m) { const int row = row0 + ai * HALF + m * 16; const float s = rs ? rs[row] : 1.f; bf16_t* rowp = O + (size_t)row * ldc + col0;
#pragma unroll
                for (int bj = 0; bj < 2; ++bj) { const f32x4 v0 = acc[ai][bj][m][0] * s, v1 = acc[ai][bj][m][1] * s;
                    u32x4 w; w.x = cvt_pk_bf16(v0[0], v0[1]); w.y = cvt_pk_bf16(v0[2], v0[3]); w.z = cvt_pk_bf16(v1[0], v1[1]); w.w = cvt_pk_bf16(v1[2], v1[3]);
                    *(u32x4*)(rowp + bj * HALF) = w; } }
    }
};
struct EpiResid {
    static constexpr bool PERM = true, AFTER_DRAIN = false, PROBE_TWICE = false;
    const bf16_t* xbf; bf16_t* xb; float* ss; int ldc;
    __device__ __forceinline__ void operator()(const f32x4 (&acc)[2][2][4][2], const Unit& u, int wr, int wc, int fr, int fq) const {
        const int row0 = u.pm * BM + wr * 64 + fr, col0 = u.pn * BM + wc * 32 + 8 * fq;
#pragma unroll
        for (int ai = 0; ai < 2; ++ai)
#pragma unroll
            for (int m = 0; m < 4; ++m) { const int row = row0 + ai * HALF + m * 16; const size_t off = (size_t)row * ldc + col0; float q = 0.f;
#pragma unroll
                for (int bj = 0; bj < 2; ++bj) { const u32x4 xr = *(const u32x4*)(xbf + off + bj * HALF);
                    const f32x4 a0 = acc[ai][bj][m][0], a1 = acc[ai][bj][m][1];
                    f32x4 v0, v1;
                    v0[0] = a0[0] + __builtin_bit_cast(float, xr.x << 16); v0[1] = a0[1] + __builtin_bit_cast(float, xr.x & 0xffff0000u); v0[2] = a0[2] + __builtin_bit_cast(float, xr.y << 16); v0[3] = a0[3] + __builtin_bit_cast(float, xr.y & 0xffff0000u);
                    v1[0] = a1[0] + __builtin_bit_cast(float, xr.z << 16); v1[1] = a1[1] + __builtin_bit_cast(float, xr.z & 0xffff0000u); v1[2] = a1[2] + __builtin_bit_cast(float, xr.w << 16); v1[3] = a1[3] + __builtin_bit_cast(float, xr.w & 0xffff0000u);
                    u32x4 w; w.x = cvt_pk_bf16(v0[0], v0[1]); w.y = cvt_pk_bf16(v0[2], v0[3]); w.z = cvt_pk_bf16(v1[0], v1[1]); w.w = cvt_pk_bf16(v1[2], v1[3]);
                    *(u32x4*)(xb + off + bj * HALF) = w;
                    q += (v0[0] * v0[0] + v0[1] * v0[1]) + (v0[2] * v0[2] + v0[3] * v0[3]) + (v1[0] * v1[0] + v1[1] * v1[1]) + (v1[2] * v1[2] + v1[3] * v1[3]); }
                q += __shfl_xor(q, 16); q += __shfl_xor(q, 32);
                if (fq == 0) ss[(size_t)row * 16 + u.pn * 4 + wc] = q; }
    }
};
template <class Epi, class Sched, bool ALIGN_EPI = false, bool SP2 = false>
__device__ __forceinline__ void gemm_phase(PG8_LAS unsigned char* lds, const Gemm g, const Sched& S, const Epi& E) {
    const int tid = threadIdx.x, wid = __builtin_amdgcn_readfirstlane(tid >> 6), lane = tid & 63, wr = wid >> 2, wc = wid & 3, fr = lane & 15, fq = lane >> 4;
    const int K = g.K, nt = K / BK;
    unsigned voffA[2], voffB[2];
#pragma unroll
    for (int i = 0; i < 2; ++i) { int R, C; stage_rc(tid * 16 + i * 8192, R, C); const int Rb = Epi::PERM ? ((R & ~31) + perm32(R & 31)) : R;
        voffA[i] = (unsigned)(R * K + C) * 2u; voffB[i] = (unsigned)(Rb * K + C) * 2u; }
    const size_t kstep = (size_t)(BK * 2);
    const size_t hstep = (size_t)HALF * K * 2;
    const size_t tstep = 2 * hstep;
    const unsigned ldsw = (unsigned)wid * 1024u;
    const int aoff = lds_byte(wr * 64 + fr, fq * 8), boff = lds_byte(wc * 32 + fr, fq * 8);
#define PG8_SA(b, h) (((b) * 2 + (h)) * HTB)
#define PG8_SB(b, h) ((4 + (b) * 2 + (h)) * HTB)
#define PG8_STAGE(bufoff, gbase, voff) do { _Pragma("unroll") for (int _i = 0; _i < 2; ++_i) \
        __builtin_amdgcn_global_load_lds((const unsigned*)((const char*)(gbase) + (voff)[_i]), (PG8_LAS unsigned*)(lds + (bufoff) + ldsw + _i * 8192), 16, 0, 0); } while (0)
#define PG8_LDA(dst, b, h) do { _Pragma("unroll") for (int m = 0; m < 4; ++m) _Pragma("unroll") for (int k = 0; k < 2; ++k) dst[m][k] = *(const PG8_LAS bf16x8*)(lds + PG8_SA(b, h) + aoff + m * 2048 + k * 1024); } while (0)
#define PG8_LDB(dst, b, h) do { _Pragma("unroll") for (int n = 0; n < 2; ++n) _Pragma("unroll") for (int k = 0; k < 2; ++k) dst[n][k] = *(const PG8_LAS bf16x8*)(lds + PG8_SB(b, h) + boff + n * 2048 + k * 1024); } while (0)
#define PG8_MMA(ai, bj, At, Bt) do { __builtin_amdgcn_s_setprio(1); _Pragma("unroll") for (int m = 0; m < 4; ++m) _Pragma("unroll") for (int n = 0; n < 2; ++n) _Pragma("unroll") for (int k = 0; k < 2; ++k) \
        acc[ai][bj][m][n] = __builtin_amdgcn_mfma_f32_16x16x32_bf16(Bt[n][k], At[m][k], acc[ai][bj][m][n], 0, 0, 0); __builtin_amdgcn_s_setprio(0); } while (0)
#define PG8_WAIT_V(n) asm volatile("s_waitcnt vmcnt(" #n ")" ::: "memory")
#define PG8_WAIT_L(n) asm volatile("s_waitcnt lgkmcnt(" #n ")" ::: "memory")
#define PG8_BAR __builtin_amdgcn_s_barrier()
#define PG8_SCHED __builtin_amdgcn_sched_barrier(0)
    Unit cur, nxt; int ui = 0;
    if (!S.next(0, cur)) return;
    f32x4 acc[2][2][4][2];
#pragma unroll
    for (int a = 0; a < 2; ++a)
#pragma unroll
        for (int b = 0; b < 2; ++b)
#pragma unroll
            for (int m = 0; m < 4; ++m)
#pragma unroll
                for (int n = 0; n < 2; ++n) acc[a][b][m][n] = (f32x4){0.f, 0.f, 0.f, 0.f};
    bf16x8 At[4][2], B0[2][2], B1[2][2];
    const char* cA = (const char*)g.A + (size_t)cur.pm * tstep; const char* cB = (const char*)g.Bt + (size_t)cur.pn * tstep;
    S.a_ready(cur);
    if constexpr (SP2) {
        PG8_STAGE(PG8_SB(0, 0), cB, voffB); PG8_STAGE(PG8_SB(0, 1), cB + hstep, voffB); PG8_STAGE(PG8_SA(0, 0), cA, voffA); PG8_STAGE(PG8_SA(0, 1), cA + hstep, voffA);
        if (wr == 1) PG8_BAR;
        PG8_WAIT_V(2); PG8_BAR;
        PG8_STAGE(PG8_SB(1, 0), cB + kstep, voffB); PG8_STAGE(PG8_SA(1, 0), cA + kstep, voffA); PG8_STAGE(PG8_SB(1, 1), cB + hstep + kstep, voffB);
        PG8_WAIT_V(6); PG8_BAR;
    } else {
        PG8_STAGE(PG8_SB(0, 0), cB, voffB); PG8_STAGE(PG8_SA(0, 0), cA, voffA); PG8_STAGE(PG8_SB(0, 1), cB + hstep, voffB); PG8_STAGE(PG8_SA(0, 1), cA + hstep, voffA);
        if (wr == 1) PG8_BAR;
        PG8_WAIT_V(4); PG8_BAR;
        PG8_STAGE(PG8_SB(1, 0), cB + kstep, voffB); PG8_STAGE(PG8_SA(1, 0), cA + kstep, voffA); PG8_STAGE(PG8_SB(1, 1), cB + hstep + kstep, voffB);
        PG8_WAIT_V(6); PG8_BAR;
    }
    for (;;) {
        const bool has_next = S.next(ui + 1, nxt);
        const char* nA = has_next ? (const char*)g.A + (size_t)nxt.pm * tstep : cA; const char* nB = has_next ? (const char*)g.Bt + (size_t)nxt.pn * tstep : cB;
        for (int t = 0; t < nt; t += 2) {
            const bool last = (t == nt - 2);
            const char* a1 = cA + (size_t)(t + 1) * kstep;
            const char* a2 = last ? nA : cA + (size_t)(t + 2) * kstep; const char* b2 = last ? nB : cB + (size_t)(t + 2) * kstep;
            const char* a3 = a2 + kstep; const char* b3 = b2 + kstep;
            if (last && has_next) S.a_ready(nxt);
            if constexpr (SP2) {
            PG8_LDB(B0, 0, 0); PG8_LDB(B1, 0, 1); PG8_SCHED; PG8_LDA(At, 0, 0); PG8_STAGE(PG8_SA(1, 1), a1 + hstep, voffA);
            PG8_WAIT_V(8); PG8_WAIT_L(0); PG8_BAR; PG8_MMA(0, 0, At, B0); PG8_MMA(0, 1, At, B1); PG8_BAR; PG8_SCHED;
            PG8_LDA(At, 0, 1); PG8_STAGE(PG8_SB(0, 0), b2, voffB); PG8_STAGE(PG8_SB(0, 1), b2 + hstep, voffB); PG8_STAGE(PG8_SA(0, 0), a2, voffA);
            PG8_WAIT_V(8); PG8_WAIT_L(0); PG8_BAR; PG8_MMA(1, 0, At, B0); PG8_MMA(1, 1, At, B1); PG8_BAR; PG8_SCHED;
            PG8_LDB(B0, 1, 0); PG8_LDB(B1, 1, 1); PG8_SCHED; PG8_LDA(At, 1, 0); PG8_STAGE(PG8_SA(0, 1), a2 + hstep, voffA);
            PG8_WAIT_V(8); PG8_WAIT_L(0); PG8_BAR; PG8_MMA(0, 0, At, B0); PG8_MMA(0, 1, At, B1); PG8_BAR; PG8_SCHED;
            PG8_LDA(At, 1, 1); PG8_STAGE(PG8_SB(1, 0), b3, voffB); PG8_STAGE(PG8_SB(1, 1), b3 + hstep, voffB); PG8_STAGE(PG8_SA(1, 0), a3, voffA);
            PG8_WAIT_V(8); PG8_WAIT_L(0); PG8_BAR; PG8_MMA(1, 0, At, B0); PG8_MMA(1, 1, At, B1); PG8_BAR; PG8_SCHED;
            } else {
            PG8_LDB(B0, 0, 0); PG8_SCHED; PG8_LDA(At, 0, 0); PG8_STAGE(PG8_SA(1, 1), a1 + hstep, voffA);
            PG8_WAIT_L(8); PG8_BAR; PG8_WAIT_L(0); PG8_MMA(0, 0, At, B0); PG8_BAR; PG8_SCHED;
            PG8_LDB(B1, 0, 1); PG8_STAGE(PG8_SB(0, 0), b2, voffB);
            PG8_BAR; PG8_WAIT_L(0); PG8_MMA(0, 1, At, B1); PG8_BAR;
            PG8_LDA(At, 0, 1); PG8_STAGE(PG8_SA(0, 0), a2, voffA);
            PG8_BAR; PG8_WAIT_L(0); PG8_MMA(1, 0, At, B0); PG8_BAR; PG8_SCHED;
            PG8_STAGE(PG8_SB(0, 1), b2 + hstep, voffB);
            PG8_WAIT_V(6); PG8_BAR; PG8_MMA(1, 1, At, B1); PG8_BAR;
            PG8_LDB(B0, 1, 0); PG8_SCHED; PG8_LDA(At, 1, 0); PG8_STAGE(PG8_SA(0, 1), a2 + hstep, voffA);
            PG8_WAIT_L(8); PG8_BAR; PG8_WAIT_L(0); PG8_MMA(0, 0, At, B0); PG8_BAR; PG8_SCHED;
            PG8_LDB(B1, 1, 1); PG8_STAGE(PG8_SB(1, 0), b3, voffB);
            PG8_BAR; PG8_WAIT_L(0); PG8_MMA(0, 1, At, B1); PG8_BAR;
            PG8_LDA(At, 1, 1); PG8_STAGE(PG8_SA(1, 0), a3, voffA);
            PG8_BAR; PG8_WAIT_L(0); PG8_MMA(1, 0, At, B0); PG8_BAR; PG8_SCHED;
            PG8_STAGE(PG8_SB(1, 1), b3 + hstep, voffB);
            PG8_WAIT_V(6); PG8_BAR; PG8_MMA(1, 1, At, B1); PG8_BAR;
            }
        }
        if constexpr (ALIGN_EPI) { if (wr == 0) PG8_BAR; }
        if constexpr (!Epi::AFTER_DRAIN) { E(acc, cur, wr, wc, fr, fq);
#if defined(MK_EXTRA)
            if (Epi::PROBE_TWICE) { asm volatile("" ::: "memory"); E(acc, cur, wr, wc, fr, fq); }
#endif
            S.done(cur); }
        if (!has_next) break;
#pragma unroll
        for (int a = 0; a < 2; ++a)
#pragma unroll
            for (int b = 0; b < 2; ++b)
#pragma unroll
                for (int m = 0; m < 4; ++m)
#pragma unroll
                    for (int n = 0; n < 2; ++n) acc[a][b][m][n] = (f32x4){0.f, 0.f, 0.f, 0.f};
        cur = nxt; cA = nA; cB = nB; ++ui;
        if constexpr (ALIGN_EPI) { if (wr == 1) PG8_BAR; }
    }
    PG8_WAIT_V(0);
    if constexpr (!ALIGN_EPI) { if (wr == 0) PG8_BAR; }
    PG8_BAR;
    if constexpr (Epi::AFTER_DRAIN) { E.fused(acc, cur, wr, wc, fr, fq, lds, wid, lane); S.done(cur); }
#undef PG8_SA
#undef PG8_SB
#undef PG8_STAGE
#undef PG8_LDA
#undef PG8_LDB
#undef PG8_MMA
#undef PG8_WAIT_V
#undef PG8_WAIT_L
#undef PG8_BAR
#undef PG8_SCHED
}
}
constexpr int NWAVES = 8;
#ifndef MK_N_LAUNCHES
#define MK_N_LAUNCHES 1
#endif
constexpr int PER_PHASE = 9;
constexpr int N_LAUNCHES = MK_N_LAUNCHES;

constexpr int NB = 4, SEQ = 8192, T = NB * SEQ, D = 1024, DIN = 1280, NEXP = 16384, DQ = 2048;
constexpr float EPS = 1e-6f;

constexpr size_t MiB = 1u << 20;
constexpr size_t WS_CTL = 0, CTL_ZERO_BYTES = 1 * MiB;
constexpr size_t WS_WIN = 2 * MiB;
constexpr size_t WS_WOUT = 5 * MiB;
constexpr size_t WS_WQ = 7 * MiB;
constexpr size_t WS_SK = 11 * MiB;
constexpr size_t WS_POOLT = 11 * MiB + 512 * 1024;
constexpr size_t WS_RSTD1 = 12 * MiB;
constexpr size_t WS_SS2 = 13 * MiB;
constexpr size_t WS_SU = 15 * MiB;
constexpr size_t WS_SV = 15 * MiB + 256 * 1024;
constexpr size_t WS_EXP = 16 * MiB;
constexpr size_t WS_BEST = 24 * MiB;
constexpr size_t WS_CC = 40 * MiB;
constexpr size_t WS_SCC = 44 * MiB;
constexpr size_t WS_U8 = 56 * MiB;
constexpr size_t WS_V8 = 72 * MiB;
constexpr size_t WS_AB = 88 * MiB;
constexpr size_t WS_X1B = 152 * MiB;
constexpr size_t WS_PD = 216 * MiB;
constexpr size_t WS_DELTA = 360 * MiB;
constexpr size_t WS_XB = 216 * MiB;
constexpr size_t WS_Y = 280 * MiB;
constexpr size_t WS_QP = 216 * MiB;
constexpr size_t WS_END = 424 * MiB;
constexpr int CW_BAR = 4096;

constexpr int RING_OFF = 0, RING_BYTES = 131072;
constexpr int LDS_BYTES = 163840;
constexpr int LDSCTL_OFF = LDS_BYTES - 512, MISC_OFF = LDSCTL_OFF + 320;
constexpr int PHASE_LDS_MAX = LDSCTL_OFF;
#define GAS __attribute__((address_space(1)))
#define LAS __attribute__((address_space(3)))
typedef unsigned short bf16;
typedef unsigned v4u __attribute__((ext_vector_type(4)));
typedef float f32x4 __attribute__((ext_vector_type(4)));
typedef short bf16x8 __attribute__((ext_vector_type(8)));
typedef GAS unsigned gu32;
typedef GAS unsigned long long gu64;
#define RLX_AGENT __ATOMIC_RELAXED, __HIP_MEMORY_SCOPE_AGENT
#define LDS_WAIT() asm volatile("s_waitcnt lgkmcnt(0)" ::: "memory")
#define VM_WAIT() asm volatile("s_waitcnt vmcnt(0)" ::: "memory")
__device__ __forceinline__ unsigned long long rt() { return __builtin_amdgcn_s_memrealtime(); }
__device__ __forceinline__ unsigned f2bf(float f) { unsigned u = __builtin_bit_cast(unsigned, f); return (u + 0x7fffu + ((u >> 16) & 1u)) >> 16; }
__device__ __forceinline__ unsigned pk2(float lo, float hi) { return f2bf(lo) | (f2bf(hi) << 16); }
#define XB_TMO      128
#define XB_XCNT(j)  (256  + 64 * (j))
#define XB_XSUB(j)  (1280 + 64 * (j))
#define XB_XGEN(j)  (2304 + 64 * (j))
#define XB_TOP      3328
#define XB_TOPGEN   3392
#define XCD_BAR_WORDS 3456
#define XB_SPIN_CAP (1u << 18)

__device__ __forceinline__ unsigned xb_ld(unsigned* p)              { return __hip_atomic_load(p, __ATOMIC_RELAXED, __HIP_MEMORY_SCOPE_AGENT); }
__device__ __forceinline__ unsigned xb_add(unsigned* p, unsigned v) { return __hip_atomic_fetch_add(p, v, __ATOMIC_RELAXED, __HIP_MEMORY_SCOPE_AGENT); }
__device__ __forceinline__ unsigned xb_xcc_id() { return (unsigned)__builtin_amdgcn_s_getreg((3 << 11) | 20) & 0xFu; }
#define XB_SPIN(cond, bar) do { unsigned _sp = 0; while (cond) { __builtin_amdgcn_s_sleep(1); \
    if ((++_sp & 255u) == 0u) { if (xb_ld(&(bar)[XB_TMO])) break; if (_sp > XB_SPIN_CAP) { atomicAdd(&(bar)[XB_TMO], 1u); break; } } } } while (0)

struct XcdBarrier {
    unsigned* bar; unsigned x;
    volatile LAS unsigned* st;
};

__device__ __forceinline__ XcdBarrier xcd_barrier_post(unsigned* bar, volatile LAS unsigned* st) {
    XcdBarrier b; b.bar = bar; b.x = xb_xcc_id(); b.st = st;
    if (threadIdx.x == 0) (void)xb_add(&bar[XB_XCNT(b.x)], 1u);
    return b;
}
__device__ __forceinline__ void xcd_barrier_complete(unsigned* bar, unsigned x, unsigned& nloc, unsigned& nx) {
    const unsigned G = gridDim.x * gridDim.y * gridDim.z;
    unsigned sum, cnt, mine, sp = 0u;
    for (;;) {
        sum = 0u; cnt = 0u; mine = 0u;
#pragma unroll
        for (unsigned j = 0; j < 16; ++j) { const unsigned c = xb_ld(&bar[XB_XCNT(j)]); sum += c; cnt += (c > 0u) ? 1u : 0u; mine = (j == x) ? c : mine; }
        if (sum == G) break;
        __builtin_amdgcn_s_sleep(1);
        if ((++sp & 255u) == 0u) { if (xb_ld(&bar[XB_TMO])) break; if (sp > XB_SPIN_CAP) { atomicAdd(&bar[XB_TMO], 1u); break; } }
    }
    nloc = mine > 0u ? mine : 1u; nx = cnt > 0u ? cnt : 1u;
}

__device__ __forceinline__ void xcd_barrier(const XcdBarrier& b) {
    asm volatile("s_waitcnt vmcnt(0)" ::: "memory");
    __syncthreads();
    if (threadIdx.x == 0) {
        unsigned* bar = b.bar;
        __builtin_amdgcn_s_waitcnt(0);
        unsigned nloc = b.st[0], nx = b.st[1];
        if (nloc == 0u) { xcd_barrier_complete(bar, b.x, nloc, nx); b.st[0] = nloc; b.st[1] = nx; }
        const unsigned old = xb_add(&bar[XB_XSUB(b.x)], 1u);
        const unsigned gen = old / nloc;
        if (old + 1u == (gen + 1u) * nloc) {
            __builtin_amdgcn_fence(__ATOMIC_RELEASE, "agent");
            asm volatile("s_waitcnt vmcnt(0)" ::: "memory");
            const unsigned og = xb_add(&bar[XB_TOP], 1u);
            const unsigned tg = og / nx;
            if (og + 1u == (tg + 1u) * nx) xb_add(&bar[XB_TOPGEN], 1u);
            else XB_SPIN(xb_ld(&bar[XB_TOPGEN]) == tg, bar);
            __builtin_amdgcn_fence(__ATOMIC_ACQUIRE, "agent");
            xb_add(&bar[XB_XGEN(b.x)], 1u);
            asm volatile("s_waitcnt vmcnt(0)" ::: "memory");
        } else {
            XB_SPIN(xb_ld(&bar[XB_XGEN(b.x)]) == gen, bar);
            __builtin_amdgcn_fence(__ATOMIC_ACQUIRE, "agent");
            asm volatile("s_waitcnt vmcnt(0)" ::: "memory");
        }
    }
    __syncthreads();
}
typedef float f32x16 __attribute__((ext_vector_type(16)));
typedef __bf16 bf16x2_t __attribute__((ext_vector_type(2)));
#define MFMA32(a, b, c) __builtin_amdgcn_mfma_f32_32x32x16_bf16((a), (b), (c), 0, 0, 0)
__device__ __forceinline__ float bf_lo(unsigned u) { return __builtin_bit_cast(float, u << 16); }
__device__ __forceinline__ float bf_hi(unsigned u) { return __builtin_bit_cast(float, u & 0xffff0000u); }
__device__ __forceinline__ float dot2_bf16(unsigned w, unsigned x, float acc) { return __builtin_amdgcn_fdot2_f32_bf16(__builtin_bit_cast(bf16x2_t, w), __builtin_bit_cast(bf16x2_t, x), acc, false); }
__device__ __forceinline__ float wave_sum(float v) {
#pragma unroll
    for (int o = 1; o < 64; o <<= 1) v += __shfl_xor(v, o);
    return v;
}

__device__ __forceinline__ unsigned pack_i8x4(float a, float b, float c, float d) {
    return ((unsigned)__float2int_rn(a) & 0xffu) | (((unsigned)__float2int_rn(b) & 0xffu) << 8) | (((unsigned)__float2int_rn(c) & 0xffu) << 16) | (((unsigned)__float2int_rn(d) & 0xffu) << 24);
}

__device__ __forceinline__ void p0_transpose_item(const float* W, int K, int N, bf16* WT, const float* gk, LAS float* scr, int item, int lane) {
    const int nblk = N / 32, kb = item / nblk, nb = item % nblk, k0 = 64 * kb, n0 = 32 * nb;
    float wv[32];
#pragma unroll
    for (int i = 0; i < 32; ++i) wv[i] = W[(size_t)(k0 + 2 * i + (lane >> 5)) * N + n0 + (lane & 31)];
#pragma unroll
    for (int i = 0; i < 32; ++i) { const int kk = 2 * i + (lane >> 5); float w = wv[i]; if (gk) w *= gk[k0 + kk]; scr[kk * 33 + (lane & 31)] = w; }
    LDS_WAIT(); asm volatile("" ::: "memory");
    const int c = lane & 7;
#pragma unroll
    for (int j = 0; j < 4; ++j) { const int n = (lane >> 3) + 8 * j; const LAS float* s = scr + (8 * c) * 33 + n;
        v4u o; o.x = pk2(s[0 * 33], s[1 * 33]); o.y = pk2(s[2 * 33], s[3 * 33]); o.z = pk2(s[4 * 33], s[5 * 33]); o.w = pk2(s[6 * 33], s[7 * 33]);
        *(GAS v4u*)(WT + (size_t)(n0 + n) * K + k0 + 8 * c) = o; }
    LDS_WAIT(); asm volatile("" ::: "memory");
}
__device__ __forceinline__ float row_to_bf16(const float* src, bf16* dst, const float* g, int lane) {
    const GAS f32x4* xr = (const GAS f32x4*)src + lane; float s = 0.f;
    GAS unsigned long long* o8 = (GAS unsigned long long*)dst + lane;
#pragma unroll
    for (int j = 0; j < 4; ++j) { f32x4 v = xr[64 * j]; s += (v.x * v.x + v.y * v.y) + (v.z * v.z + v.w * v.w);
        if (g) { const f32x4 gv = ((const GAS f32x4*)g)[64 * j + lane]; v = v * gv; }
        o8[64 * j] = (unsigned long long)pk2(v.x, v.y) | ((unsigned long long)pk2(v.z, v.w) << 32); }
    return s;
}
__device__ __forceinline__ void row_to_i8(const float* src, unsigned char* dst, const float* g, float* sc, int m, int lane) {
    const GAS f32x4* xr = (const GAS f32x4*)src + lane; f32x4 v[4]; float amax = 0.f;
#pragma unroll
    for (int j = 0; j < 4; ++j) { v[j] = xr[64 * j]; if (g) { const f32x4 gv = ((const GAS f32x4*)g)[64 * j + lane]; v[j] = v[j] * gv; }
        amax = fmaxf(fmaxf(amax, fmaxf(fabsf(v[j].x), fabsf(v[j].y))), fmaxf(fabsf(v[j].z), fabsf(v[j].w))); }
#pragma unroll
    for (int o = 1; o < 64; o <<= 1) amax = fmaxf(amax, __shfl_xor(amax, o));
    const float inv = amax > 0.f ? 127.0f / amax : 0.f;
    GAS unsigned* o4 = (GAS unsigned*)dst + lane;
#pragma unroll
    for (int j = 0; j < 4; ++j) { const unsigned q0 = (unsigned)__float2int_rn(v[j].x * inv) & 0xffu, q1 = (unsigned)__float2int_rn(v[j].y * inv) & 0xffu, q2 = (unsigned)__float2int_rn(v[j].z * inv) & 0xffu, q3 = (unsigned)__float2int_rn(v[j].w * inv) & 0xffu;
        o4[64 * j] = q0 | (q1 << 8) | (q2 << 16) | (q3 << 24); }
    if (lane == 0) sc[m] = amax * (1.0f / 127.0f);
}
__device__ __forceinline__ void p0_poolfold_wg(const float* w_in, const float* pool_w, const float* g1, bf16* WinT, LAS unsigned char* lds, int item, int tid) {
    const int g = item & 3, kb = item >> 2, k0 = 16 * kb;
    LAS float* pw = (LAS float*)lds;
    LAS float* wt = (LAS float*)(lds + 65536);
#pragma unroll
    for (int i = 0; i < 8; ++i) *(LAS f32x4*)(pw + 4 * (tid + 512 * i)) = ((const GAS f32x4*)(pool_w + (size_t)g * 16384))[tid + 512 * i];
    { const int r = tid >> 5, c4 = tid & 31; *(LAS f32x4*)(wt + r * 128 + 4 * c4) = *(const GAS f32x4*)(w_in + (size_t)(k0 + r) * DIN + 768 + 128 * g + 4 * c4); }
    LDS_WAIT(); __syncthreads();
    const int kr = tid >> 5, nq = tid & 31;
    f32x4 acc = {0.f, 0.f, 0.f, 0.f};
#pragma unroll 4
    for (int c4 = 0; c4 < 32; ++c4) { const f32x4 a = *(const LAS f32x4*)(wt + kr * 128 + 4 * c4);
        acc = acc + a.x * *(const LAS f32x4*)(pw + (4 * c4 + 0) * 128 + 4 * nq); acc = acc + a.y * *(const LAS f32x4*)(pw + (4 * c4 + 1) * 128 + 4 * nq);
        acc = acc + a.z * *(const LAS f32x4*)(pw + (4 * c4 + 2) * 128 + 4 * nq); acc = acc + a.w * *(const LAS f32x4*)(pw + (4 * c4 + 3) * 128 + 4 * nq); }
    const float gk = g1[k0 + kr];
    bf16* o = WinT + (size_t)(768 + 128 * g + 4 * nq) * D + k0 + kr;
    o[0] = (bf16)f2bf(acc.x * gk); o[D] = (bf16)f2bf(acc.y * gk); o[2 * D] = (bf16)f2bf(acc.z * gk); o[3 * D] = (bf16)f2bf(acc.w * gk);
    __syncthreads();
}
struct P0Args { const float *x, *g1, *w_in, *pool_w, *w_out, *g2, *wq, *sk, *u, *v; bf16 *XB, *WinT, *WoutT, *WqT, *SK, *PoolT; unsigned char *U8, *V8; float *su, *sv; float* rstd1; };
__device__ __forceinline__ void p0_prologue(const P0Args& a, LAS unsigned char* lds, int gw, int NGW, int wave, int lane) {
    LAS float* scr = (LAS float*)(lds + RING_OFF + wave * 16384);
    for (int it = gw / NWAVES; it < 4 * (D / 16); it += NGW / NWAVES) p0_poolfold_wg(a.w_in, a.pool_w, a.g1, a.WinT, lds, it, wave * 64 + lane);
    constexpr int I_IN = (D / 64) * (768 / 32);
    for (int it = gw; it < I_IN; it += NGW) { const int kb = it / 24, nb = it % 24; p0_transpose_item(a.w_in, D, DIN, a.WinT, a.g1, scr, kb * 40 + nb, lane); }
    for (int m0 = gw; m0 < T; m0 += 4 * NGW) {
        f32x4 v[4][4];
#pragma unroll
        for (int r = 0; r < 4; ++r) { const int m = m0 + r * NGW < T ? m0 + r * NGW : m0; const GAS f32x4* xr = (const GAS f32x4*)(a.x + (size_t)m * D) + lane;
#pragma unroll
            for (int j = 0; j < 4; ++j) v[r][j] = xr[64 * j]; }
#pragma unroll
        for (int r = 0; r < 4; ++r) { const int m = m0 + r * NGW; if (m < T) {
            float s = 0.f; GAS unsigned long long* o8 = (GAS unsigned long long*)(a.XB + (size_t)m * D) + lane;
#pragma unroll
            for (int j = 0; j < 4; ++j) { const f32x4 w = v[r][j]; s += (w.x * w.x + w.y * w.y) + (w.z * w.z + w.w * w.w); o8[64 * j] = (unsigned long long)pk2(w.x, w.y) | ((unsigned long long)pk2(w.z, w.w) << 32); }
            s = wave_sum(s); if (lane == 0) a.rstd1[m] = 1.0f / sqrtf(s * (1.0f / D) + EPS); } }
    }
    for (int m0 = gw; m0 < 2 * NEXP; m0 += 4 * NGW) {
        f32x4 v[4][4];
#pragma unroll
        for (int r = 0; r < 4; ++r) { const int mm = m0 + r * NGW < 2 * NEXP ? m0 + r * NGW : m0; const bool isv = mm >= NEXP; const int m = isv ? mm - NEXP : mm;
            const GAS f32x4* xr = (const GAS f32x4*)((isv ? a.v : a.u) + (size_t)m * D) + lane;
#pragma unroll
            for (int j = 0; j < 4; ++j) v[r][j] = xr[64 * j]; }
#pragma unroll
        for (int r = 0; r < 4; ++r) { const int mm = m0 + r * NGW; if (mm < 2 * NEXP) { const bool isv = mm >= NEXP; const int m = isv ? mm - NEXP : mm;
            float amax = 0.f;
#pragma unroll
            for (int j = 0; j < 4; ++j) { if (!isv) { const f32x4 gv = ((const GAS f32x4*)a.g2)[64 * j + lane]; v[r][j] = v[r][j] * gv; }
                amax = fmaxf(fmaxf(amax, fmaxf(fabsf(v[r][j].x), fabsf(v[r][j].y))), fmaxf(fabsf(v[r][j].z), fabsf(v[r][j].w))); }
#pragma unroll
            for (int o = 1; o < 64; o <<= 1) amax = fmaxf(amax, __shfl_xor(amax, o));
            const float inv = amax > 0.f ? 127.0f / amax : 0.f;
            unsigned char* tb_ = (isv ? a.V8 : a.U8) + (size_t)m * 128 + ((4 * lane) & 127);
#pragma unroll
            for (int j = 0; j < 4; ++j) *(GAS unsigned*)(tb_ + (size_t)((4 * lane + 256 * j) >> 7) * ((size_t)NEXP * 128)) = pack_i8x4(v[r][j].x * inv, v[r][j].y * inv, v[r][j].z * inv, v[r][j].w * inv);
            if (lane == 0) (isv ? a.sv : a.su)[m] = amax * (1.0f / 127.0f); } }
    }
}
__device__ __forceinline__ void p1_late_weights(const P0Args& a, LAS unsigned char* lds, int gw, int NGW, int wave, int lane) {
    LAS float* scr = (LAS float*)(lds + RING_OFF + wave * 16384);
    constexpr int I_OUT = (D / 64) * (D / 32), I_Q = (D / 64) * (DQ / 32);
    for (int it = gw; it < I_OUT + I_Q; it += NGW) {
        if (it < I_OUT) p0_transpose_item(a.w_out, D, D, a.WoutT, nullptr, scr, it, lane);
        else p0_transpose_item(a.wq, D, DQ, a.WqT, a.g2, scr, it - I_OUT, lane);
    }
    for (int m = gw; m < 256; m += NGW) (void)row_to_bf16(a.sk + (size_t)m * D, a.SK + (size_t)m * D, nullptr, lane);
}

__device__ __forceinline__ int t5_bucket(int rel) {
    const int n = rel < 0 ? -rel : rel; const int base = rel > 0 ? 16 : 0;
    const int v = n < 8 ? n : (n < 12 ? 8 : (n < 16 ? 9 : (n < 23 ? 10 : (n < 32 ? 11 : (n < 46 ? 12 : (n < 64 ? 13 : (n < 91 ? 14 : 15)))))));
    return base + v;
}
__device__ __forceinline__ void attn_unit(LAS unsigned char* lds, const bf16* Y, bf16* AB, const float* qg, const float* kg, const float* sinks, const float* relb,
                                          int unit, int tid, int wave, int lane) {
    const int kvh = unit & 1, c = (unit >> 1) & 127, b = unit >> 8;
    LAS bf16* Ks = (LAS bf16*)lds;
    LAS bf16* Vt = (LAS bf16*)(lds + 27648);
    LAS float* bt = (LAS float*)(lds + 53248);
    const int row0 = b * SEQ + (c - 2) * 64;
#pragma unroll
    for (int rep = 0; rep < 3; ++rep) {
        const int it = tid + rep * 512, j = it >> 3, ch = it & 7;
        const bool valid = (c - 2 + (j >> 6)) >= 0;
        v4u kraw = {0u, 0u, 0u, 0u}, vraw = {0u, 0u, 0u, 0u};
        if (valid) { const bf16* rp = Y + (size_t)(row0 + j) * DIN; kraw = *(const GAS v4u*)(rp + 512 + 64 * kvh + 8 * ch); vraw = *(const GAS v4u*)(rp + 640 + 64 * kvh + 8 * ch); }
        float kf[8] = {bf_lo(kraw.x), bf_hi(kraw.x), bf_lo(kraw.y), bf_hi(kraw.y), bf_lo(kraw.z), bf_hi(kraw.z), bf_lo(kraw.w), bf_hi(kraw.w)};
        float ss = 0.f;
#pragma unroll
        for (int e = 0; e < 8; ++e) ss += kf[e] * kf[e];
        ss += __shfl_xor(ss, 1); ss += __shfl_xor(ss, 2); ss += __shfl_xor(ss, 4);
        const float r = 1.0f / sqrtf(ss * (1.0f / 64.0f) + EPS);
        const f32x4 g0 = *(const GAS f32x4*)(kg + 8 * ch), g1 = *(const GAS f32x4*)(kg + 8 * ch + 4);
        v4u ko; ko.x = pk2(kf[0] * r * g0.x, kf[1] * r * g0.y); ko.y = pk2(kf[2] * r * g0.z, kf[3] * r * g0.w); ko.z = pk2(kf[4] * r * g1.x, kf[5] * r * g1.y); ko.w = pk2(kf[6] * r * g1.z, kf[7] * r * g1.w);
        *(LAS v4u*)(Ks + j * 72 + 8 * ch) = ko;
        const int s16 = j >> 4, kk = j & 15, hh = (kk >> 2) & 1, jj = ((kk >> 3) << 2) | (kk & 3), pos = 16 * s16 + 8 * hh + jj;
        LAS bf16* vp = Vt + (8 * ch) * 200 + pos;
        vp[0 * 200] = (bf16)(vraw.x & 0xffffu); vp[1 * 200] = (bf16)(vraw.x >> 16); vp[2 * 200] = (bf16)(vraw.y & 0xffffu); vp[3 * 200] = (bf16)(vraw.y >> 16);
        vp[4 * 200] = (bf16)(vraw.z & 0xffffu); vp[5 * 200] = (bf16)(vraw.z >> 16); vp[6 * 200] = (bf16)(vraw.w & 0xffffu); vp[7 * 200] = (bf16)(vraw.w >> 16);
    }
#pragma unroll
    for (int rep = 0; rep < 2; ++rep) { const int it = tid + rep * 512, g = it >> 8, r = it & 255; bt[it] = relb[t5_bucket(r - 191) * 8 + kvh * 4 + g]; }
    LDS_WAIT(); __syncthreads();

    const int g = wave >> 1, i = 32 * (wave & 1) + (lane & 31), hh = lane >> 5, habs = kvh * 4 + g;
    const size_t qrow = (size_t)b * SEQ + (size_t)c * 64 + i;
    const bf16* qp = Y + qrow * DIN + habs * 64 + 8 * hh;
    v4u qraw[4]; float ss = 0.f;
#pragma unroll
    for (int s = 0; s < 4; ++s) { qraw[s] = *(const GAS v4u*)(qp + 16 * s);
        const float f0 = bf_lo(qraw[s].x), f1 = bf_hi(qraw[s].x), f2 = bf_lo(qraw[s].y), f3 = bf_hi(qraw[s].y), f4 = bf_lo(qraw[s].z), f5 = bf_hi(qraw[s].z), f6 = bf_lo(qraw[s].w), f7 = bf_hi(qraw[s].w);
        ss += (f0 * f0 + f1 * f1) + (f2 * f2 + f3 * f3) + (f4 * f4 + f5 * f5) + (f6 * f6 + f7 * f7); }
    ss += __shfl_xor(ss, 32);
    const float rq = 0.125f / sqrtf(ss * (1.0f / 64.0f) + EPS);
    bf16x8 qf[4];
#pragma unroll
    for (int s = 0; s < 4; ++s) { const f32x4 g0 = *(const GAS f32x4*)(qg + 16 * s + 8 * hh), g1 = *(const GAS f32x4*)(qg + 16 * s + 8 * hh + 4);
        v4u w; w.x = pk2(bf_lo(qraw[s].x) * rq * g0.x, bf_hi(qraw[s].x) * rq * g0.y); w.y = pk2(bf_lo(qraw[s].y) * rq * g0.z, bf_hi(qraw[s].y) * rq * g0.w);
        w.z = pk2(bf_lo(qraw[s].z) * rq * g1.x, bf_hi(qraw[s].z) * rq * g1.y); w.w = pk2(bf_lo(qraw[s].w) * rq * g1.z, bf_hi(qraw[s].w) * rq * g1.w);
        qf[s] = __builtin_bit_cast(bf16x8, w); }
    f32x16 sacc[6];
#pragma unroll
    for (int kt = 0; kt < 6; ++kt) {
#pragma unroll
        for (int r = 0; r < 16; ++r) sacc[kt][r] = 0.f;
#pragma unroll
        for (int s = 0; s < 4; ++s) { const bf16x8 a = *(const LAS bf16x8*)(Ks + (32 * kt + (lane & 31)) * 72 + 16 * s + 8 * hh); sacc[kt] = MFMA32(a, qf[s], sacc[kt]); }
    }
    const LAS float* btg = bt + g * 256 + 63 - i;
    float mx = -3.0e38f;
#pragma unroll
    for (int kt = 0; kt < 6; ++kt) { const bool masked = (c - 2 + (kt >> 1)) < 0;
#pragma unroll
        for (int r = 0; r < 16; ++r) { const int j = 32 * kt + (r & 3) + 8 * (r >> 2) + 4 * hh; float v = sacc[kt][r] + btg[j]; v = masked ? -1.0e30f : v; sacc[kt][r] = v; mx = fmaxf(mx, v); } }
    mx = fmaxf(mx, __shfl_xor(mx, 32));
    const float sink = sinks[habs], m = fmaxf(mx, sink);
    float sum = 0.f;
#pragma unroll
    for (int kt = 0; kt < 6; ++kt)
#pragma unroll
        for (int r = 0; r < 16; ++r) { const float p = __expf(sacc[kt][r] - m); sacc[kt][r] = p; sum += p; }
    sum += __shfl_xor(sum, 32);
    const float inv = 1.0f / (sum + __expf(sink - m));
    f32x16 oacc[2];
#pragma unroll
    for (int dt = 0; dt < 2; ++dt)
#pragma unroll
        for (int r = 0; r < 16; ++r) oacc[dt][r] = 0.f;
#pragma unroll
    for (int kt = 0; kt < 6; ++kt)
#pragma unroll
        for (int s2 = 0; s2 < 2; ++s2) {
            v4u w; w.x = pk2(sacc[kt][8 * s2 + 0], sacc[kt][8 * s2 + 1]); w.y = pk2(sacc[kt][8 * s2 + 2], sacc[kt][8 * s2 + 3]); w.z = pk2(sacc[kt][8 * s2 + 4], sacc[kt][8 * s2 + 5]); w.w = pk2(sacc[kt][8 * s2 + 6], sacc[kt][8 * s2 + 7]);
            const bf16x8 pb = __builtin_bit_cast(bf16x8, w);
#pragma unroll
            for (int dt = 0; dt < 2; ++dt) { const bf16x8 a = *(const LAS bf16x8*)(Vt + (32 * dt + (lane & 31)) * 200 + 32 * kt + 16 * s2 + 8 * hh); oacc[dt] = MFMA32(a, pb, oacc[dt]); }
        }
    bf16* op = AB + qrow * D + habs * 64;
#pragma unroll
    for (int dt = 0; dt < 2; ++dt)
#pragma unroll
        for (int q4 = 0; q4 < 4; ++q4) { const int d = 32 * dt + 8 * q4 + 4 * hh;
            const unsigned long long o = (unsigned long long)pk2(oacc[dt][4 * q4 + 0] * inv, oacc[dt][4 * q4 + 1] * inv) | ((unsigned long long)pk2(oacc[dt][4 * q4 + 2] * inv, oacc[dt][4 * q4 + 3] * inv) << 32);
            *(GAS unsigned long long*)(op + d) = o; }
    __syncthreads();
}

template <int W, bool START> __device__ __forceinline__ void pool_walk(const bf16* zc, bf16* oc, float s0, float s1, int pos0) {
    unsigned ring[16];
    float a0 = 0.f, a1 = 0.f;
    unsigned zr[64];
#pragma unroll
    for (int i = 0; i < 64; ++i) zr[i] = *(const GAS unsigned*)(zc + (size_t)i * DIN);
#pragma unroll
    for (int q = 0; q < 16; ++q) ring[q] = 0u;
#pragma unroll
    for (int q = 1; q < W; ++q) { if (pos0 - q >= 0) { const unsigned u = *(const GAS unsigned*)(zc - (size_t)q * DIN); ring[(16 - q) & 15] = u; a0 += bf_lo(u); a1 += bf_hi(u); } }
#pragma unroll
    for (int rb = 0; rb < 64; rb += 16) {
#pragma unroll
        for (int i = 0; i < 16; ++i) {
            const unsigned u = zr[rb + i];
            const float c0 = bf_lo(u), c1 = bf_hi(u);
            a0 += c0; a1 += c1;
            float ic = 1.0f / (float)W; if (START) { const int pos = pos0 + rb + i; ic = 1.0f / (float)(pos + 1 < W ? pos + 1 : W); }
            *(GAS unsigned*)(oc + (size_t)(rb + i) * D) = pk2((a0 * ic - c0) * s0, (a1 * ic - c1) * s1);
            const unsigned old = ring[(i + 17 - W) & 15];
            a0 -= bf_lo(old); a1 -= bf_hi(old);
            ring[i] = u;
        }
    }
}
__device__ __forceinline__ void pool_rows(const bf16* Y, bf16* AB, const float* pscale, int unit, int tid) {
    const int cp = tid & 255, seg = tid >> 8, g = cp >> 6;
    const int r0 = unit * 128 + seg * 64, pos0 = r0 & (SEQ - 1);
    const bf16* zc = Y + (size_t)r0 * DIN + 768 + 2 * cp; bf16* oc = AB + (size_t)r0 * D + 512 + 2 * cp;
    const float s0 = pscale[2 * cp], s1 = pscale[2 * cp + 1];
    if (pos0 >= 16) { if (g == 0) pool_walk<2, false>(zc, oc, s0, s1, pos0); else if (g == 1) pool_walk<4, false>(zc, oc, s0, s1, pos0); else if (g == 2) pool_walk<8, false>(zc, oc, s0, s1, pos0); else pool_walk<16, false>(zc, oc, s0, s1, pos0); }
    else { if (g == 0) pool_walk<2, true>(zc, oc, s0, s1, pos0); else if (g == 1) pool_walk<4, true>(zc, oc, s0, s1, pos0); else if (g == 2) pool_walk<8, true>(zc, oc, s0, s1, pos0); else pool_walk<16, true>(zc, oc, s0, s1, pos0); }
}

__device__ __forceinline__ int f2key(float f) { return __builtin_bit_cast(int, f); }
__device__ __forceinline__ float key2f(int k) { return __builtin_bit_cast(float, k); }
#define CE_DESC(a, b) do { const int _x = (a), _y = (b); (a) = _x > _y ? _x : _y; (b) = _x > _y ? _y : _x; } while (0)
__device__ __forceinline__ void sort16_desc(int (&a)[16]) {
#pragma unroll
    for (int k = 2; k <= 16; k <<= 1)
#pragma unroll
        for (int j = k >> 1; j > 0; j >>= 1)
#pragma unroll
            for (int i = 0; i < 16; ++i) { const int l = i ^ j; if (l > i) { if ((i & k) == 0) CE_DESC(a[i], a[l]); else CE_DESC(a[l], a[i]); } }
}
__device__ __forceinline__ void merge_top16(int (&a)[16], const int (&b)[16]) {
#pragma unroll
    for (int i = 0; i < 16; ++i) a[i] = a[i] > b[15 - i] ? a[i] : b[15 - i];
#pragma unroll
    for (int j = 8; j > 0; j >>= 1)
#pragma unroll
        for (int i = 0; i < 16; ++i) { const int l = i ^ j; if (l > i) CE_DESC(a[i], a[l]); }
}
__device__ __forceinline__ void top16_of_64(int (&g0)[16], int (&g1)[16], int (&g2)[16], int (&g3)[16]) {
    sort16_desc(g0); sort16_desc(g1); sort16_desc(g2); sort16_desc(g3);
    merge_top16(g0, g1); merge_top16(g2, g3); merge_top16(g0, g2);
}
__device__ __forceinline__ void topk_stage_keys(LAS unsigned char* lds, const bf16* SK, int h, int tid) {
#pragma unroll
    for (int i = 0; i < 8; ++i) { const int c = tid + 512 * i, p = c >> 11, n = (c >> 4) & 127, ch = c & 15;
        *(LAS v4u*)(lds + p * 34816 + n * 272 + ch * 16) = *(const GAS v4u*)(SK + ((size_t)(h * 2 + p) * 128 + n) * 128 + ch * 8); }
    LDS_WAIT(); __syncthreads();
}
__device__ __forceinline__ void topk_unit(LAS unsigned char* lds, const bf16* QP, const bf16* SK, unsigned short* EXPERTS, float* BEST, int unit, int tid, int wave, int lane) {
    const int h = unit & 7, tt = unit >> 3, hh = lane >> 5;
    const int tok = tt * 256 + wave * 32 + (lane & 31);
    static_assert(69632 + 512 * 33 * 4 <= PHASE_LDS_MAX, "top-k LDS scratch runs into the LDS control words");
    LAS int* mine = (LAS int*)(lds + 69632) + tid * 33;
    int top[2][16];
#pragma unroll
    for (int p = 0; p < 2; ++p) {
        const bf16* qp = QP + (size_t)tok * DQ + h * 256 + p * 128 + 8 * hh;
        const LAS unsigned char* kp = lds + p * 34816 + (lane & 31) * 272 + 16 * hh;
        f32x16 acc[4];
#pragma unroll
        for (int nt = 0; nt < 4; ++nt)
#pragma unroll
            for (int r = 0; r < 16; ++r) acc[nt][r] = 8.0f;
#pragma unroll
        for (int s = 0; s < 8; ++s) { const bf16x8 bq = __builtin_bit_cast(bf16x8, *(const GAS v4u*)(qp + 16 * s));
#pragma unroll
            for (int nt = 0; nt < 4; ++nt) { const bf16x8 a = *(const LAS bf16x8*)(kp + nt * (32 * 272) + 32 * s); acc[nt] = MFMA32(a, bq, acc[nt]); } }
        int k0[16], k1[16], k2[16], k3[16];
#pragma unroll
        for (int r = 0; r < 16; ++r) { const int n = (r & 3) + 8 * (r >> 2) + 4 * hh;
            k0[r] = (f2key(acc[0][r]) & ~127) | n; k1[r] = (f2key(acc[1][r]) & ~127) | (32 + n); k2[r] = (f2key(acc[2][r]) & ~127) | (64 + n); k3[r] = (f2key(acc[3][r]) & ~127) | (96 + n); }
        top16_of_64(k0, k1, k2, k3);
#pragma unroll
        for (int r = 0; r < 16; ++r) k1[r] = __shfl_xor(k0[r], 32);
        merge_top16(k0, k1);
#pragma unroll
        for (int r = 0; r < 16; ++r) top[p][r] = k0[r];
    }
    int c0[16], c1[16], c2[16], c3[16];
    {
        float v1[16], v2[16];
#pragma unroll
        for (int r = 0; r < 16; ++r) { v1[r] = key2f(top[0][r] & ~127); v2[r] = key2f(top[1][r] & ~127); mine[r] = top[0][r]; mine[16 + r] = top[1][r]; }
        int cnt = 0;
#pragma unroll
        for (int i = 0; i < 16; ++i)
#pragma unroll
            for (int j = 0; j < 16; ++j) if ((i + 1) * (j + 1) <= 16) { const int key = (f2key(v1[i] + v2[j]) & ~255) | (i << 4) | j;
                if (cnt < 16) c0[cnt] = key; else if (cnt < 32) c1[cnt - 16] = key; else if (cnt < 48) c2[cnt - 32] = key; else c3[cnt - 48] = key; ++cnt; }
#pragma unroll
        for (int r = 0; r < 16; ++r) if (48 + r >= cnt) c3[r] = (int)0x80000000;
    }
    top16_of_64(c0, c1, c2, c3);
    LDS_WAIT();
    if (hh == 0) {
        int ev[16]; float bv[16];
#pragma unroll
        for (int r = 0; r < 16; ++r) { const int id = c0[r] & 255; const int ka = mine[id >> 4], kb = mine[16 + (id & 15)];
            ev[r] = (ka & 127) * 128 + (kb & 127); bv[r] = (key2f(ka & ~127) - 8.0f) + (key2f(kb & ~127) - 8.0f); }
        unsigned short* ep = EXPERTS + (size_t)tok * 128 + h * 16; float* bp = BEST + (size_t)tok * 128 + h * 16;
#pragma unroll
        for (int r = 0; r < 16; r += 8) *(GAS v4u*)(ep + r) = (v4u){(unsigned)ev[r] | ((unsigned)ev[r + 1] << 16), (unsigned)ev[r + 2] | ((unsigned)ev[r + 3] << 16), (unsigned)ev[r + 4] | ((unsigned)ev[r + 5] << 16), (unsigned)ev[r + 6] | ((unsigned)ev[r + 7] << 16)};
#pragma unroll
        for (int r = 0; r < 16; r += 4) *(GAS f32x4*)(bp + r) = (f32x4){bv[r], bv[r + 1], bv[r + 2], bv[r + 3]};
    }
    LDS_WAIT();
}

__device__ __forceinline__ float gelu_erf(float x) { return 0.5f * x * (1.0f + erff(x * 0.70710678118654752f)); }
#define PEER_BL(rs, e_, c_) __builtin_amdgcn_raw_buffer_load_b128(rs, (int)(((e_) << 7) + (c_)), 0, 0)
#define PEER_ROWS(r, rs, c_, q) do { const v4u _ev = *(const LAS v4u*)(evp + 16 * (q)); \
        r[0] = PEER_BL(rs, _ev.x & 0xffffu, c_); r[1] = PEER_BL(rs, _ev.x >> 16, c_); r[2] = PEER_BL(rs, _ev.y & 0xffffu, c_); r[3] = PEER_BL(rs, _ev.y >> 16, c_); \
        r[4] = PEER_BL(rs, _ev.z & 0xffffu, c_); r[5] = PEER_BL(rs, _ev.z >> 16, c_); r[6] = PEER_BL(rs, _ev.w & 0xffffu, c_); r[7] = PEER_BL(rs, _ev.w >> 16, c_); } while (0)
__device__ __forceinline__ void peer_u_phase(LAS unsigned char* lds, const bf16* X1B, const unsigned char* U8, const unsigned short* EXP16, float* PD, int j, int w, int nw, int wave, int lane) {
    const int grp = lane >> 3, sub = lane & 7;
    LAS unsigned char* wl = lds + wave * 8192;
    const LAS unsigned char* evp = wl + grp * 256;
    const int stride = nw * NWAVES * 8;
    int tb = (w * NWAVES + wave) * 8;
    v4u pe0 = {0u, 0u, 0u, 0u}, pe1 = {0u, 0u, 0u, 0u};
    v4u px0 = {0u, 0u, 0u, 0u}, px1 = {0u, 0u, 0u, 0u};
    if (tb < T) { const GAS v4u* e = (const GAS v4u*)(EXP16 + (size_t)tb * 128) + lane; pe0 = e[0]; pe1 = e[64];
        const GAS v4u* xp = (const GAS v4u*)(X1B + (size_t)(tb + grp) * D + 128 * j + 16 * sub); px0 = xp[0]; px1 = xp[1]; }
    const __amdgpu_buffer_rsrc_t urs = __builtin_amdgcn_make_buffer_rsrc((void*)U8, (short)0, NEXP * D, 0x00020000); const unsigned uc = (unsigned)j * (NEXP * 128u) + 16u * sub;
    for (; tb < T; tb += stride) {
        *(LAS v4u*)(wl + 16 * lane) = pe0; *(LAS v4u*)(wl + 1024 + 16 * lane) = pe1;
        const v4u xa = px0, xc = px1;
        if (tb + stride < T) { const GAS v4u* e = (const GAS v4u*)(EXP16 + (size_t)(tb + stride) * 128) + lane; pe0 = e[0]; pe1 = e[64];
            const GAS v4u* xp = (const GAS v4u*)(X1B + (size_t)(tb + stride + grp) * D + 128 * j + 16 * sub); px0 = xp[0]; px1 = xp[1]; }
        const int t = tb + grp;
        const f32x4 x0 = {bf_lo(xa.x), bf_hi(xa.x), bf_lo(xa.y), bf_hi(xa.y)}, x1 = {bf_lo(xa.z), bf_hi(xa.z), bf_lo(xa.w), bf_hi(xa.w)};
        const f32x4 x2 = {bf_lo(xc.x), bf_hi(xc.x), bf_lo(xc.y), bf_hi(xc.y)}, x3 = {bf_lo(xc.z), bf_hi(xc.z), bf_lo(xc.w), bf_hi(xc.w)};
        float amax = fmaxf(fmaxf(fmaxf(fabsf(x0.x), fabsf(x0.y)), fmaxf(fabsf(x0.z), fabsf(x0.w))), fmaxf(fmaxf(fabsf(x1.x), fabsf(x1.y)), fmaxf(fabsf(x1.z), fabsf(x1.w))));
        amax = fmaxf(amax, fmaxf(fmaxf(fmaxf(fabsf(x2.x), fabsf(x2.y)), fmaxf(fabsf(x2.z), fabsf(x2.w))), fmaxf(fmaxf(fabsf(x3.x), fabsf(x3.y)), fmaxf(fabsf(x3.z), fabsf(x3.w)))));
        amax = fmaxf(amax, __shfl_xor(amax, 1)); amax = fmaxf(amax, __shfl_xor(amax, 2)); amax = fmaxf(amax, __shfl_xor(amax, 4));
        const float inv = amax > 0.f ? 127.0f / amax : 0.f, sx = amax * (1.0f / 127.0f);
        const unsigned xq0 = pack_i8x4(x0.x * inv, x0.y * inv, x0.z * inv, x0.w * inv), xq1 = pack_i8x4(x1.x * inv, x1.y * inv, x1.z * inv, x1.w * inv);
        const unsigned xq2 = pack_i8x4(x2.x * inv, x2.y * inv, x2.z * inv, x2.w * inv), xq3 = pack_i8x4(x3.x * inv, x3.y * inv, x3.z * inv, x3.w * inv);
        const bool up4 = (sub & 4) != 0, up2 = (sub & 2) != 0, up1 = (sub & 1) != 0;
        LAS _Float16* pd = (LAS _Float16*)(wl + 4096) + grp * 128 + sub;
        LDS_WAIT();
        v4u ra[8], rb[8], rc[8];
        PEER_ROWS(ra, urs, uc, 0); PEER_ROWS(rb, urs, uc, 1);
#define PEER_UDOT(r, q) do { int p[8]; _Pragma("unroll") for (int i = 0; i < 8; ++i) { int a = __builtin_amdgcn_sdot4((int)r[i].x, (int)xq0, 0, false); a = __builtin_amdgcn_sdot4((int)r[i].y, (int)xq1, a, false); \
                a = __builtin_amdgcn_sdot4((int)r[i].z, (int)xq2, a, false); p[i] = __builtin_amdgcn_sdot4((int)r[i].w, (int)xq3, a, false); } \
            _Pragma("unroll") for (int i = 0; i < 4; ++i) { const int keep = up4 ? p[i + 4] : p[i], send = up4 ? p[i] : p[i + 4]; p[i] = keep + __builtin_amdgcn_mov_dpp(send, 0x141, 0xF, 0xF, true); } \
            _Pragma("unroll") for (int i = 0; i < 2; ++i) { const int keep = up2 ? p[i + 2] : p[i], send = up2 ? p[i] : p[i + 2]; p[i] = keep + __builtin_amdgcn_mov_dpp(send, 0x4E, 0xF, 0xF, true); } \
            { const int keep = up1 ? p[1] : p[0], send = up1 ? p[0] : p[1]; p[0] = keep + __builtin_amdgcn_mov_dpp(send, 0xB1, 0xF, 0xF, true); } \
            pd[8 * (q)] = (_Float16)((float)p[0] * sx); } while (0)
        for (int q = 0; q < 15; q += 3) {
            PEER_ROWS(rc, urs, uc, q + 2); PEER_UDOT(ra, q);
            PEER_ROWS(ra, urs, uc, q + 3); PEER_UDOT(rb, q + 1);
            if (q + 4 < 16) PEER_ROWS(rb, urs, uc, q + 4);
            PEER_UDOT(rc, q + 2);
        }
        PEER_UDOT(ra, 15);
        LDS_WAIT();
#pragma unroll
        for (int qq = 0; qq < 2; ++qq) { const v4u pv = *(const LAS v4u*)(wl + 4096 + qq * 1024 + 16 * lane);
            *(GAS v4u*)((_Float16*)PD + ((size_t)j * T + tb + 4 * qq + (lane >> 4)) * 128 + 8 * (lane & 15)) = pv; }
    }
}
__device__ __forceinline__ void peer_stage_scales(LAS unsigned char* lds, const float* su, const float* sv, int tid) {
#pragma unroll
    for (int i = 0; i < 8; ++i) { *(LAS f32x4*)(lds + (size_t)(tid + 512 * i) * 16) = ((const GAS f32x4*)su)[tid + 512 * i]; *(LAS f32x4*)(lds + 65536 + (size_t)(tid + 512 * i) * 16) = ((const GAS f32x4*)sv)[tid + 512 * i]; }
    LDS_WAIT(); __syncthreads();
}
__device__ __forceinline__ void peer_combine4(LAS unsigned char* lds, const float* PD, const unsigned short* EXP16, const float* BEST, const float* SS2, unsigned char* CC8, float* SCC, int t0, int lane) {
    const LAS float* su = (const LAS float*)lds; const LAS float* sv = (const LAS float*)(lds + 65536);
    typedef float f32x2v __attribute__((ext_vector_type(2)));
    f32x4 ssv[4][4]; unsigned ev[4]; f32x2v bv[4]; f32x2v pdv[4][8];
#pragma unroll
    for (int i = 0; i < 4; ++i) { const int t = t0 + i;
        const GAS f32x4* sp = (const GAS f32x4*)(SS2 + (size_t)t * 16);
#pragma unroll
        for (int q = 0; q < 4; ++q) ssv[i][q] = sp[q];
        ev[i] = ((const GAS unsigned*)(EXP16 + (size_t)t * 128))[lane];
        bv[i] = ((const GAS f32x2v*)(BEST + (size_t)t * 128))[lane];
#pragma unroll
        for (int j = 0; j < 8; ++j) { typedef _Float16 h2v __attribute__((ext_vector_type(2))); const h2v hv = ((const GAS h2v*)((const _Float16*)PD + ((size_t)j * T + t) * 128))[lane]; pdv[i][j] = (f32x2v){(float)hv.x, (float)hv.y}; } }
    float suv[4][2], svv[4][2];
#pragma unroll
    for (int i = 0; i < 4; ++i) { const unsigned e0 = ev[i] & 0xffffu, e1 = ev[i] >> 16; suv[i][0] = su[e0]; suv[i][1] = su[e1]; svv[i][0] = sv[e0]; svv[i][1] = sv[e1]; }
#pragma unroll
    for (int i = 0; i < 4; ++i) { const int t = t0 + i;
        float ssq = 0.f;
#pragma unroll
        for (int q = 0; q < 4; ++q) ssq += (ssv[i][q].x + ssv[i][q].y) + (ssv[i][q].z + ssv[i][q].w);
        const float rstd2 = 1.0f / sqrtf(ssq * (1.0f / D) + EPS);
        const float s0 = bv[i].x * rstd2, s1 = bv[i].y * rstd2;
        float mx = fmaxf(s0, s1);
#pragma unroll
        for (int o = 1; o < 8; o <<= 1) mx = fmaxf(mx, __shfl_xor(mx, o));
        const float e0 = __expf(s0 - mx), e1 = __expf(s1 - mx); float sm = e0 + e1;
#pragma unroll
        for (int o = 1; o < 8; o <<= 1) sm += __shfl_xor(sm, o);
        float d0 = 0.f, d1 = 0.f;
#pragma unroll
        for (int j = 0; j < 8; ++j) { d0 += pdv[i][j].x; d1 += pdv[i][j].y; }
        const float inv_sm = 1.0f / sm;
        const float c0 = e0 * inv_sm * gelu_erf(d0 * rstd2 * suv[i][0]) * svv[i][0], c1 = e1 * inv_sm * gelu_erf(d1 * rstd2 * suv[i][1]) * svv[i][1];
        float amax = fmaxf(fabsf(c0), fabsf(c1));
#pragma unroll
        for (int o = 1; o < 64; o <<= 1) amax = fmaxf(amax, __shfl_xor(amax, o));
        const float inv = amax > 0.f ? 127.0f / amax : 0.f;
        ((GAS unsigned short*)(CC8 + (size_t)t * 128))[lane] = (unsigned short)((__float2int_rn(c0 * inv) & 0xff) | ((__float2int_rn(c1 * inv) & 0xff) << 8));
        if (lane == 0) SCC[t] = amax * (1.0f / 127.0f); }
}
__device__ __forceinline__ void peer_v_phase(LAS unsigned char* lds, float* OUT, const bf16* X1B, const unsigned char* V8, const unsigned short* EXP16, const unsigned char* CC8, const float* SCC, int j, int w, int nw, int wave, int lane) {
    const int grp = lane >> 3, sub = lane & 7;
    LAS unsigned char* wl = lds + wave * 8192;
    const LAS unsigned char* evp = wl + grp * 256;
    const LAS unsigned char* ccp = wl + 2048 + grp * 128;
    const int stride = nw * NWAVES * 8;
    int tb = (w * NWAVES + wave) * 8;
    v4u pe0 = {0u, 0u, 0u, 0u}, pe1 = {0u, 0u, 0u, 0u}, pc0 = {0u, 0u, 0u, 0u};
    if (tb < T) { const GAS v4u* e = (const GAS v4u*)(EXP16 + (size_t)tb * 128) + lane; pe0 = e[0]; pe1 = e[64]; pc0 = ((const GAS v4u*)(CC8 + (size_t)tb * 128))[lane]; }
    const __amdgpu_buffer_rsrc_t vrs = __builtin_amdgcn_make_buffer_rsrc((void*)V8, (short)0, NEXP * D, 0x00020000); const unsigned vc = (unsigned)j * (NEXP * 128u) + 16u * sub;
    for (; tb < T; tb += stride) {
        *(LAS v4u*)(wl + 16 * lane) = pe0; *(LAS v4u*)(wl + 1024 + 16 * lane) = pe1; *(LAS v4u*)(wl + 2048 + 16 * lane) = pc0;
        if (tb + stride < T) { const GAS v4u* e = (const GAS v4u*)(EXP16 + (size_t)(tb + stride) * 128) + lane; pe0 = e[0]; pe1 = e[64]; pc0 = ((const GAS v4u*)(CC8 + (size_t)(tb + stride) * 128))[lane]; }
        const int t = tb + grp;
        const float scc = SCC[t];
        const size_t eo = (size_t)t * D + 128 * j + 16 * sub;
        const GAS v4u* dp = (const GAS v4u*)(X1B + eo);
        const v4u da = dp[0], db = dp[1];
        int acc[16];
#pragma unroll
        for (int i = 0; i < 16; ++i) acc[i] = 0;
        LDS_WAIT();
        v4u rq[4][4];
#define PEER_LOADQ(r, qn) do { const unsigned long long _e4 = *(const LAS unsigned long long*)(evp + 8 * (qn)); const unsigned _lo = (unsigned)_e4, _hi = (unsigned)(_e4 >> 32); \
            r[0] = PEER_BL(vrs, _lo & 0xffffu, vc); r[1] = PEER_BL(vrs, _lo >> 16, vc); r[2] = PEER_BL(vrs, _hi & 0xffffu, vc); r[3] = PEER_BL(vrs, _hi >> 16, vc); } while (0)
#define PEER_T4(w_, r0, r1, r2, r3, cpk) do { const unsigned tl0 = __builtin_amdgcn_perm(r1, r0, 0x05010400u), th0 = __builtin_amdgcn_perm(r1, r0, 0x07030602u); \
            const unsigned tl1 = __builtin_amdgcn_perm(r3, r2, 0x05010400u), th1 = __builtin_amdgcn_perm(r3, r2, 0x07030602u); \
            acc[4 * (w_) + 0] = __builtin_amdgcn_sdot4((int)__builtin_amdgcn_perm(tl1, tl0, 0x05040100u), (int)(cpk), acc[4 * (w_) + 0], false); \
            acc[4 * (w_) + 1] = __builtin_amdgcn_sdot4((int)__builtin_amdgcn_perm(tl1, tl0, 0x07060302u), (int)(cpk), acc[4 * (w_) + 1], false); \
            acc[4 * (w_) + 2] = __builtin_amdgcn_sdot4((int)__builtin_amdgcn_perm(th1, th0, 0x05040100u), (int)(cpk), acc[4 * (w_) + 2], false); \
            acc[4 * (w_) + 3] = __builtin_amdgcn_sdot4((int)__builtin_amdgcn_perm(th1, th0, 0x07060302u), (int)(cpk), acc[4 * (w_) + 3], false); } while (0)
#define PEER_COMPQ(r, qn) do { const unsigned _c = *(const LAS unsigned*)(ccp + 4 * (qn)); \
            PEER_T4(0, r[0].x, r[1].x, r[2].x, r[3].x, _c); PEER_T4(1, r[0].y, r[1].y, r[2].y, r[3].y, _c); PEER_T4(2, r[0].z, r[1].z, r[2].z, r[3].z, _c); PEER_T4(3, r[0].w, r[1].w, r[2].w, r[3].w, _c); } while (0)
#pragma unroll
        for (int jq = 0; jq < 4; ++jq) PEER_LOADQ(rq[jq], jq);
        for (int it = 0; it < 8; ++it) {
#pragma unroll
            for (int jq = 0; jq < 4; ++jq) { PEER_COMPQ(rq[jq], 4 * it + jq); if (it < 7) PEER_LOADQ(rq[jq], 4 * it + 4 + jq); }
        }
        const float dl[16] = {bf_lo(da.x), bf_hi(da.x), bf_lo(da.y), bf_hi(da.y), bf_lo(da.z), bf_hi(da.z), bf_lo(da.w), bf_hi(da.w), bf_lo(db.x), bf_hi(db.x), bf_lo(db.y), bf_hi(db.y), bf_lo(db.z), bf_hi(db.z), bf_lo(db.w), bf_hi(db.w)};
#pragma unroll
        for (int q = 0; q < 4; ++q) { f32x4 v; v.x = dl[4 * q + 0] + scc * (float)acc[4 * q + 0]; v.y = dl[4 * q + 1] + scc * (float)acc[4 * q + 1]; v.z = dl[4 * q + 2] + scc * (float)acc[4 * q + 2]; v.w = dl[4 * q + 3] + scc * (float)acc[4 * q + 3];
            *(LAS f32x4*)(wl + 4096 + grp * 512 + sub * 64 + 16 * q) = v; }
        LDS_WAIT();
#pragma unroll
        for (int qq = 0; qq < 4; ++qq) { const f32x4 v = *(const LAS f32x4*)(wl + 4096 + qq * 1024 + 16 * lane);
            *(GAS f32x4*)(OUT + (size_t)(tb + 2 * qq + (lane >> 5)) * D + 128 * j + 4 * (lane & 31)) = v; }
    }
}
struct Args { const float* in[15]; float* out; unsigned char* ws; int ph_lo, ph_hi, li, pad; };
__global__ void __launch_bounds__(NWAVES * 64, 2) fwd_kernel(Args args) {
    extern __shared__ __attribute__((aligned(16))) unsigned char lds_raw[];
    LAS unsigned char* lds = (LAS unsigned char*)lds_raw;
    volatile LAS unsigned* MISC = (volatile LAS unsigned*)(lds + MISC_OFF);
    const int tid = threadIdx.x, lane = tid & 63, wave = __builtin_amdgcn_readfirstlane(tid >> 6);
    const int G = gridDim.x, bx = blockIdx.x;
    unsigned char* ws = args.ws;
    gu32* ctl = (gu32*)(ws + WS_CTL);
    for (int u = tid; u < (LDS_BYTES - LDSCTL_OFF) / 4; u += NWAVES * 64) ((LAS unsigned*)(lds + LDSCTL_OFF))[u] = 0u;
    __syncthreads();
    XcdBarrier bar; bar.bar = (unsigned*)(ctl + CW_BAR); bar.x = 0; bar.st = nullptr;
    if (N_LAUNCHES != PER_PHASE) bar = xcd_barrier_post((unsigned*)(ctl + CW_BAR) + args.li * XCD_BAR_WORDS, MISC + 8);
#define GRID_BAR() do { if (N_LAUNCHES != PER_PHASE) xcd_barrier(bar); } while (0)
    const int lo = args.ph_lo, hi = args.ph_hi;
#define IN(k) (lo <= (k) && (k) < hi)
#define BOTH(k) (IN(k) && IN((k) + 1))
#ifndef MK_REPEAT
#define MK_REPEAT -1
#endif
#define REP(k) for (int _r = 0; _r < ((MK_REPEAT == (k)) ? 2 : 1); ++_r)

    const float* x = args.in[0]; float* out = args.out;
    bf16* XB = (bf16*)(ws + WS_XB); bf16* WinT = (bf16*)(ws + WS_WIN); bf16* WoutT = (bf16*)(ws + WS_WOUT); bf16* WqT = (bf16*)(ws + WS_WQ);
    bf16* SK = (bf16*)(ws + WS_SK); bf16* PoolT = (bf16*)(ws + WS_POOLT); unsigned char* U8 = ws + WS_U8; unsigned char* V8 = ws + WS_V8; float* SU = (float*)(ws + WS_SU); float* SV = (float*)(ws + WS_SV);
    bf16* Y = (bf16*)(ws + WS_Y); bf16* AB = (bf16*)(ws + WS_AB); bf16* X1B = (bf16*)(ws + WS_X1B); bf16* QP = (bf16*)(ws + WS_QP);
    float* rstd1 = (float*)(ws + WS_RSTD1); float* SS2 = (float*)(ws + WS_SS2); unsigned short* EXPERTS = (unsigned short*)(ws + WS_EXP); float* BEST = (float*)(ws + WS_BEST);
    float* PD = (float*)(ws + WS_PD); bf16* DELTA = (bf16*)(ws + WS_DELTA); unsigned char* CC8 = ws + WS_CC; float* SCC = (float*)(ws + WS_SCC);
    const int gw = bx * NWAVES + wave, NGW = G * NWAVES;

    const P0Args p0a{x, args.in[1], args.in[2], args.in[7], args.in[9], args.in[10], args.in[11], args.in[12], args.in[13], args.in[14], XB, WinT, WoutT, WqT, SK, PoolT, U8, V8, SU, SV, rstd1};
    if (IN(0)) REP(0) {
        p0_prologue(p0a, lds, gw, NGW, wave, lane);
        if (BOTH(0)) GRID_BAR();
    }
    if (IN(1)) REP(1) {
        pg8::Gemm g{XB, WinT, T, DIN, D}; pg8::StaticOrder S; S.init(T, DIN, G, bx);
        pg8::EpiScaleBf16 E{Y, DIN, rstd1};
        pg8::gemm_phase<pg8::EpiScaleBf16, pg8::StaticOrder, true, true>(lds + RING_OFF, g, S, E);
        { const int nwg1 = (T / 256) * (DIN / 256), rem = nwg1 % G;
          if (rem == 0) p1_late_weights(p0a, lds, gw, NGW, wave, lane); else if (bx >= rem) p1_late_weights(p0a, lds, (bx - rem) * NWAVES + wave, (G - rem) * NWAVES, wave, lane); }
        if (BOTH(1)) GRID_BAR();
    }
    if (IN(2)) REP(2) {
        for (int u = bx; u < NB * 128 * 2; u += G) attn_unit(lds, Y, AB, args.in[3], args.in[4], args.in[5], args.in[6], u, tid, wave, lane);
        for (int u = bx; u < T / 128; u += G) pool_rows(Y, AB, args.in[8], u, tid);
        if (BOTH(2)) GRID_BAR();
    }
    if (IN(3)) REP(3) {
        pg8::Gemm g{AB, WoutT, T, D, D}; pg8::StaticOrder S; S.init(T, D, G, bx);
        pg8::EpiResid E{XB, X1B, SS2, D};
        pg8::gemm_phase<pg8::EpiResid, pg8::StaticOrder, true, true>(lds + RING_OFF, g, S, E);
        if (BOTH(3)) GRID_BAR();
    }
    if (IN(4)) REP(4) {
        pg8::Gemm g{X1B, WqT, T, DQ, D}; pg8::StaticOrder S; S.init(T, DQ, G, bx);
        pg8::EpiScaleBf16 E{QP, DQ, nullptr};
        pg8::gemm_phase<pg8::EpiScaleBf16, pg8::StaticOrder, true, true>(lds + RING_OFF, g, S, E);
        if (BOTH(4)) GRID_BAR();
    }
    if (IN(5)) REP(5) {
        { int hs = -1; for (int u = bx; u < (T / 256) * 8; u += G) { if ((u & 7) != hs) { if (hs >= 0) __syncthreads(); hs = u & 7; topk_stage_keys(lds, SK, hs, tid); } topk_unit(lds, QP, SK, EXPERTS, BEST, u, tid, wave, lane); } }
        if (BOTH(5)) GRID_BAR();
    }
    if (IN(6)) REP(6) {
        if ((G & 7) == 0) peer_u_phase(lds, X1B, U8, EXPERTS, PD, bx & 7, bx >> 3, G >> 3, wave, lane);
        else for (int j = 0; j < 8; ++j) peer_u_phase(lds, X1B, U8, EXPERTS, PD, j, bx, G, wave, lane);
        if (BOTH(6)) GRID_BAR();
    }
    if (IN(7)) REP(7) {
        peer_stage_scales(lds, SU, SV, tid);
        for (int t0 = gw * 4; t0 < T; t0 += NGW * 4) peer_combine4(lds, PD, EXPERTS, BEST, SS2, CC8, SCC, t0, lane);
        if (BOTH(7)) GRID_BAR();
    }
    if (IN(8)) {
        if ((G & 7) == 0) peer_v_phase(lds, out, X1B, V8, EXPERTS, CC8, SCC, bx & 7, bx >> 3, G >> 3, wave, lane);
        else for (int j = 0; j < 8; ++j) peer_v_phase(lds, out, X1B, V8, EXPERTS, CC8, SCC, j, bx, G, wave, lane);
    }
#undef IN
#undef BOTH
}

extern "C" void kernel_launch(void* const* d_in, const int* in_sizes, int n_in, void* d_out, int out_size, void* d_ws, size_t ws_size, hipStream_t stream) {
    static int grid = 0;
    if (grid == 0) {
        if (n_in != 15 || in_sizes[0] != T * D || out_size != T * D || ws_size < WS_END) { fprintf(stderr, "kernel_launch: unexpected shapes (n_in %d, in0 %d, out %d, ws %zu)\n", n_in, n_in > 0 ? in_sizes[0] : -1, out_size, ws_size); grid = -1; return; }
        int dev = 0, cus = 0, per_cu = 0;
        if (hipGetDevice(&dev) != hipSuccess || hipDeviceGetAttribute(&cus, hipDeviceAttributeMultiprocessorCount, dev) != hipSuccess) { grid = -1; return; }
        if (hipFuncSetAttribute((const void*)fwd_kernel, hipFuncAttributeMaxDynamicSharedMemorySize, LDS_BYTES) != hipSuccess) { fprintf(stderr, "kernel_launch: hipFuncSetAttribute failed\n"); grid = -1; return; }
        if (hipOccupancyMaxActiveBlocksPerMultiprocessor(&per_cu, (const void*)fwd_kernel, NWAVES * 64, LDS_BYTES) != hipSuccess || per_cu < 1) { fprintf(stderr, "kernel_launch: occupancy query reports %d blocks per CU\n", per_cu); }
        (void)hipGetLastError();
        grid = cus;
    }
    if (grid < 0) return;
    if (hipMemsetAsync((char*)d_ws + WS_CTL, 0, CTL_ZERO_BYTES, stream) != hipSuccess) return;
    Args a{};
    for (int i = 0; i < 15; ++i) a.in[i] = (const float*)d_in[i];
    a.out = (float*)d_out; a.ws = (unsigned char*)d_ws;
    for (int li = 0; li < N_LAUNCHES; ++li) {
        a.ph_lo = (N_LAUNCHES == PER_PHASE) ? li : 0; a.ph_hi = (N_LAUNCHES == PER_PHASE) ? li + 1 : PER_PHASE; a.li = (N_LAUNCHES == PER_PHASE) ? 0 : li;
        hipLaunchKernelGGL(fwd_kernel, dim3(grid), dim3(NWAVES * 64), LDS_BYTES, stream, a);
        const hipError_t le = hipPeekAtLastError();
        if (le != hipSuccess) { fprintf(stderr, "kernel_launch: launch %d failed: %s\n", li, hipGetErrorName(le)); break; }
    }
}
```

```cpp
#include <hip/hip_runtime.h>
#include <cstdio>
#include <cstdint>
namespace pg8 {
#define PG8_LAS __attribute__((address_space(3)))
typedef unsigned short bf16_t;
typedef short bf16x8 __attribute__((ext_vector_type(8)));
typedef float f32x4 __attribute__((ext_vector_type(4)));
typedef unsigned u32x4 __attribute__((ext_vector_type(4)));
constexpr int BM = 256, BK = 64, HALF = 128, HTB = HALF * BK * 2  , STAGE_BYTES = 8 * HTB, NXCD = 8, WGM = 8;

__host__ __device__ __forceinline__ int lds_byte(int r, int c) { const int st = (r >> 4) * 2 + (c >> 5), rr = r & 15, cc = c & 31, ob = rr * 64 + cc * 2; return st * 1024 + (ob ^ (((ob >> 9) & 1) << 5)); }
__host__ __device__ __forceinline__ void stage_rc(int b, int& R, int& C) { const int st = b / 1024, sb = b % 1024, swz = sb ^ (((sb >> 9) & 1) << 5); R = (st >> 1) * 16 + swz / 64; C = (st & 1) * 32 + (swz % 64) / 2; }
__host__ __device__ __forceinline__ int perm32(int rho) { const int n = rho >> 4, i = rho & 15; return 8 * (i >> 2) + 4 * n + (i & 3); }

struct Unit { int pm, pn; };
struct Gemm { const bf16_t* A; const bf16_t* Bt; int M, N, K; };

struct StaticOrder {
    int nM, nN, nwg, G, c;
    __host__ __device__ void init(int M, int N, int G_, int c_) { nM = M / BM; nN = N / BM; nwg = nM * nN; G = G_; c = c_; }
    __host__ __device__ bool next(int i, Unit& u) const {
        const long L = (long)i * G + c; if (L >= nwg) return false;
        int wgid = (int)L; { const int q = nwg / NXCD, r = nwg % NXCD, xcd = wgid % NXCD, off = wgid / NXCD; wgid = (xcd < r ? xcd * (q + 1) : r * (q + 1) + (xcd - r) * q) + off; }
        const int nig = WGM * nN, gid = wgid / nig, fm = gid * WGM, gsz = (nM - fm) < WGM ? (nM - fm) : WGM;
        u.pm = fm + ((wgid % nig) % gsz); u.pn = (wgid % nig) / gsz; return true;
    }
    __device__ __forceinline__ void a_ready(const Unit&) const {}
    __device__ __forceinline__ void done(const Unit&) const {}
};

__device__ __forceinline__ unsigned cvt_pk_bf16(float lo, float hi) { unsigned r; asm volatile("v_cvt_pk_bf16_f32 %0, %1, %2" : "=v"(r) : "v"(lo), "v"(hi)); return r; }
struct EpiScaleBf16 {
    static constexpr bool PERM = true, AFTER_DRAIN = false, PROBE_TWICE = false;
    bf16_t* O; int ldc; const float* rs;
    __device__ __forceinline__ void operator()(const f32x4 (&acc)[2][2][4][2], const Unit& u, int wr, int wc, int fr, int fq) const {
        const int row0 = u.pm * BM + wr * 64 + fr, col0 = u.pn * BM + wc * 32 + 8 * fq;
#pragma unroll
        for (int ai = 0; ai < 2; ++ai)
#pragma unroll
            for (int m = 0; m < 4; ++m) { const int row = row0 + ai * HALF + m * 16; const float s = rs ? rs[row] : 1.f; bf16_t* rowp = O + (size_t)row * ldc + col0;
#pragma unroll
                for (int bj = 0; bj < 2; ++bj) { const f32x4 v0 = acc[ai][bj][m][0] * s, v1 = acc[ai][bj][m][1] * s;
                    u32x4 w; w.x = cvt_pk_bf16(v0[0], v0[1]); w.y = cvt_pk_bf16(v0[2], v0[3]); w.z = cvt_pk_bf16(v1[0], v1[1]); w.w = cvt_pk_bf16(v1[2], v1[3]);
                    *(u32x4*)(rowp + bj * HALF) = w; } }
    }
};
struct EpiResid {
    static constexpr bool PERM = true, AFTER_DRAIN = false, PROBE_TWICE = false;
    const bf16_t* xbf; bf16_t* xb; float* ss; int ldc;
    __device__ __forceinline__ void operator()(const f32x4 (&acc)[2][2][4][2], const Unit& u, int wr, int wc, int fr, int fq) const {
        const int row0 = u.pm * BM + wr * 64 + fr, col0 = u.pn * BM + wc * 32 + 8 * fq;
#pragma unroll
        for (int ai = 0; ai < 2; ++ai)
#pragma unroll
            for (int m = 0; m < 4; ++m) { const int row = row0 + ai * HALF + m * 16; const size_t off = (size_t)row * ldc + col0; float q = 0.f;
#pragma unroll
                for (int bj = 0; bj < 2; ++bj) { const u32x4 xr = *(const u32x4*)(xbf + off + bj * HALF);
                    const f32x4 a0 = acc[ai][bj][m][0], a1 = acc[ai][bj][m][1];
                    f32x4 v0, v1;
                    v0[0] = a0[0] + __builtin_bit_cast(float, xr.x << 16); v0[1] = a0[1] + __builtin_bit_cast(float, xr.x & 0xffff0000u); v0[2] = a0[2] + __builtin_bit_cast(float, xr.y << 16); v0[3] = a0[3] + __builtin_bit_cast(float, xr.y & 0xffff0000u);
                    v1[0] = a1[0] + __builtin_bit_cast(float, xr.z << 16); v1[1] = a1[1] + __builtin_bit_cast(float, xr.z & 0xffff0000u); v1[2] = a1[2] + __builtin_bit_cast(float, xr.w << 16); v1[3] = a1[3] + __builtin_bit_cast(float, xr.w & 0xffff0000u);
                    u32x4 w; w.x = cvt_pk_bf16(v0[0], v0[1]); w.y = cvt_pk_bf16(v0[2], v0[3]); w.z = cvt_pk_bf16(v1[0], v1[1]); w.w = cvt_pk_bf16(v1[2], v1[3]);
                    *(u32x4*)(xb + off + bj * HALF) = w;
                    q += (v0[0] * v0[0] + v0[1] * v0[1]) + (v0[2] * v0[2] + v0[3] * v0[3]) + (v1[0] * v1[0] + v1[1] * v1[1]) + (v1[2] * v1[2] + v1[3] * v1[3]); }
                q += __shfl_xor(q, 16); q += __shfl_xor(q, 32);
                if (fq == 0) ss[(size_t)row * 16 + u.pn * 4 + wc] = q; }
    }
};
template <class Epi, class Sched, bool ALIGN_EPI = false, bool SP2 = false>
__device__ __forceinline__ void gemm_phase(PG8_LAS unsigned char* lds, const Gemm g, const Sched& S, const Epi& E) {
    const int tid = threadIdx.x, wid = __builtin_amdgcn_readfirstlane(tid >> 6), lane = tid & 63, wr = wid >> 2, wc = wid & 3, fr = lane & 15, fq = lane >> 4;
    const int K = g.K, nt = K / BK;
    unsigned voffA[2], voffB[2];
#pragma unroll
    for (int i = 0; i < 2; ++i) { int R, C; stage_rc(tid * 16 + i * 8192, R, C); const int Rb = Epi::PERM ? ((R & ~31) + perm32(R & 31)) : R;
        voffA[i] = (unsigned)(R * K + C) * 2u; voffB[i] = (unsigned)(Rb * K + C) * 2u; }
    const size_t kstep = (size_t)(BK * 2);
    const size_t hstep = (size_t)HALF * K * 2;
    const size_t tstep = 2 * hstep;
    const unsigned ldsw = (unsigned)wid * 1024u;
    const int aoff = lds_byte(wr * 64 + fr, fq * 8), boff = lds_byte(wc * 32 + fr, fq * 8);
#define PG8_SA(b, h) (((b) * 2 + (h)) * HTB)
#define PG8_SB(b, h) ((4 + (b) * 2 + (h)) * HTB)
#define PG8_STAGE(bufoff, gbase, voff) do { _Pragma("unroll") for (int _i = 0; _i < 2; ++_i) \
        __builtin_amdgcn_global_load_lds((const unsigned*)((const char*)(gbase) + (voff)[_i]), (PG8_LAS unsigned*)(lds + (bufoff) + ldsw + _i * 8192), 16, 0, 0); } while (0)
#define PG8_LDA(dst, b, h) do { _Pragma("unroll") for (int m = 0; m < 4; ++m) _Pragma("unroll") for (int k = 0; k < 2; ++k) dst[m][k] = *(const PG8_LAS bf16x8*)(lds + PG8_SA(b, h) + aoff + m * 2048 + k * 1024); } while (0)
#define PG8_LDB(dst, b, h) do { _Pragma("unroll") for (int n = 0; n < 2; ++n) _Pragma("unroll") for (int k = 0; k < 2; ++k) dst[n][k] = *(const PG8_LAS bf16x8*)(lds + PG8_SB(b, h) + boff + n * 2048 + k * 1024); } while (0)
#define PG8_MMA(ai, bj, At, Bt) do { __builtin_amdgcn_s_setprio(1); _Pragma("unroll") for (int m = 0; m < 4; ++m) _Pragma("unroll") for (int n = 0; n < 2; ++n) _Pragma("unroll") for (int k = 0; k < 2; ++k) \
        acc[ai][bj][m][n] = __builtin_amdgcn_mfma_f32_16x16x32_bf16(Bt[n][k], At[m][k], acc[ai][bj][m][n], 0, 0, 0); __builtin_amdgcn_s_setprio(0); } while (0)
#define PG8_WAIT_V(n) asm volatile("s_waitcnt vmcnt(" #n ")" ::: "memory")
#define PG8_WAIT_L(n) asm volatile("s_waitcnt lgkmcnt(" #n ")" ::: "memory")
#define PG8_BAR __builtin_amdgcn_s_barrier()
#define PG8_SCHED __builtin_amdgcn_sched_barrier(0)
    Unit cur, nxt; int ui = 0;
    if (!S.next(0, cur)) return;
    f32x4 acc[2][2][4][2];
#pragma unroll
    for (int a = 0; a < 2; ++a)
#pragma unroll
        for (int b = 0; b < 2; ++b)
#pragma unroll
            for (int m = 0; m < 4; ++m)
#pragma unroll
                for (int n = 0; n < 2; ++n) acc[a][b][m][n] = (f32x4){0.f, 0.f, 0.f, 0.f};
    bf16x8 At[4][2], B0[2][2], B1[2][2];
    const char* cA = (const char*)g.A + (size_t)cur.pm * tstep; const char* cB = (const char*)g.Bt + (size_t)cur.pn * tstep;
    S.a_ready(cur);
    if constexpr (SP2) {
        PG8_STAGE(PG8_SB(0, 0), cB, voffB); PG8_STAGE(PG8_SB(0, 1), cB + hstep, voffB); PG8_STAGE(PG8_SA(0, 0), cA, voffA); PG8_STAGE(PG8_SA(0, 1), cA + hstep, voffA);
        if (wr == 1) PG8_BAR;
        PG8_WAIT_V(2); PG8_BAR;
        PG8_STAGE(PG8_SB(1, 0), cB + kstep, voffB); PG8_STAGE(PG8_SA(1, 0), cA + kstep, voffA); PG8_STAGE(PG8_SB(1, 1), cB + hstep + kstep, voffB);
        PG8_WAIT_V(6); PG8_BAR;
    } else {
        PG8_STAGE(PG8_SB(0, 0), cB, voffB); PG8_STAGE(PG8_SA(0, 0), cA, voffA); PG8_STAGE(PG8_SB(0, 1), cB + hstep, voffB); PG8_STAGE(PG8_SA(0, 1), cA + hstep, voffA);
        if (wr == 1) PG8_BAR;
        PG8_WAIT_V(4); PG8_BAR;
        PG8_STAGE(PG8_SB(1, 0), cB + kstep, voffB); PG8_STAGE(PG8_SA(1, 0), cA + kstep, voffA); PG8_STAGE(PG8_SB(1, 1), cB + hstep + kstep, voffB);
        PG8_WAIT_V(6); PG8_BAR;
    }
    for (;;) {
        const bool has_next = S.next(ui + 1, nxt);
        const char* nA = has_next ? (const char*)g.A + (size_t)nxt.pm * tstep : cA; const char* nB = has_next ? (const char*)g.Bt + (size_t)nxt.pn * tstep : cB;
        for (int t = 0; t < nt; t += 2) {
            const bool last = (t == nt - 2);
            const char* a1 = cA + (size_t)(t + 1) * kstep;
            const char* a2 = last ? nA : cA + (size_t)(t + 2) * kstep; const char* b2 = last ? nB : cB + (size_t)(t + 2) * kstep;
            const char* a3 = a2 + kstep; const char* b3 = b2 + kstep;
            if (last && has_next) S.a_ready(nxt);
            if constexpr (SP2) {
            PG8_LDB(B0, 0, 0); PG8_LDB(B1, 0, 1); PG8_SCHED; PG8_LDA(At, 0, 0); PG8_STAGE(PG8_SA(1, 1), a1 + hstep, voffA);
            PG8_WAIT_V(8); PG8_WAIT_L(0); PG8_BAR; PG8_MMA(0, 0, At, B0); PG8_MMA(0, 1, At, B1); PG8_BAR; PG8_SCHED;
            PG8_LDA(At, 0, 1); PG8_STAGE(PG8_SB(0, 0), b2, voffB); PG8_STAGE(PG8_SB(0, 1), b2 + hstep, voffB); PG8_STAGE(PG8_SA(0, 0), a2, voffA);
            PG8_WAIT_V(8); PG8_WAIT_L(0); PG8_BAR; PG8_MMA(1, 0, At, B0); PG8_MMA(1, 1, At, B1); PG8_BAR; PG8_SCHED;
            PG8_LDB(B0, 1, 0); PG8_LDB(B1, 1, 1); PG8_SCHED; PG8_LDA(At, 1, 0); PG8_STAGE(PG8_SA(0, 1), a2 + hstep, voffA);
            PG8_WAIT_V(8); PG8_WAIT_L(0); PG8_BAR; PG8_MMA(0, 0, At, B0); PG8_MMA(0, 1, At, B1); PG8_BAR; PG8_SCHED;
            PG8_LDA(At, 1, 1); PG8_STAGE(PG8_SB(1, 0), b3, voffB); PG8_STAGE(PG8_SB(1, 1), b3 + hstep, voffB); PG8_STAGE(PG8_SA(1, 0), a3, voffA);
            PG8_WAIT_V(8); PG8_WAIT_L(0); PG8_BAR; PG8_MMA(1, 0, At, B0); PG8_MMA(1, 1, At, B1); PG8_BAR; PG8_SCHED;
            } else {
            PG8_LDB(B0, 0, 0); PG8_SCHED; PG8_LDA(At, 0, 0); PG8_STAGE(PG8_SA(1, 1), a1 + hstep, voffA);
            PG8_WAIT_L(8); PG8_BAR; PG8_WAIT_L(0); PG8_MMA(0, 0, At, B0); PG8_BAR; PG8_SCHED;
            PG8_LDB(B1, 0, 1); PG8_STAGE(PG8_SB(0, 0), b2, voffB);
            PG8_BAR; PG8_WAIT_L(0); PG8_MMA(0, 1, At, B1); PG8_BAR;
            PG8_LDA(At, 0, 1); PG8_STAGE(PG8_SA(0, 0), a2, voffA);
            PG8_BAR; PG8_WAIT_L(0); PG8_MMA(1, 0, At, B0); PG8_BAR; PG8_SCHED;
            PG8_STAGE(PG8_SB(0, 1), b2 + hstep, voffB);
            PG8_WAIT_V(6); PG8_BAR; PG8_MMA(1, 1, At, B1); PG8_BAR;
            PG8_LDB(B0, 1, 0); PG8_SCHED; PG8_LDA(At, 1, 0); PG8_STAGE(PG8_SA(0, 1), a2 + hstep, voffA);
            PG8_WAIT_L(8); PG8_BAR; PG8_WAIT_L(0); PG8_MMA(0, 0, At, B0); PG8_BAR; PG8_SCHED;
            PG8_LDB(B1, 1, 1); PG8_STAGE(PG8_SB(1, 0), b3, voffB);
            PG8_BAR; PG8_WAIT_L(0); PG8_MMA(0, 1, At, B1); PG8_BAR;
            PG8_LDA(At, 1, 1); PG8_STAGE(PG8_SA(1, 0), a3, voffA);
            PG8_BAR; PG8_WAIT_L(0); PG8_MMA(1, 0, At, B0); PG8_BAR; PG8_SCHED;
            PG8_STAGE(PG8_SB(1, 1), b3 + hstep, voffB);
            PG8_WAIT_V(6); PG8_BAR; PG8_MMA(1, 1, At, B1); PG8_BAR;
            }
        }
        if constexpr (ALIGN_EPI) { if (wr == 0) PG8_BAR; }
        if constexpr (!Epi::AFTER_DRAIN) { E(acc, cur, wr, wc, fr, fq);
#if defined(MK_EXTRA)
            if (Epi::PROBE_TWICE) { asm volatile("" ::: "memory"); E(acc, cur, wr, wc, fr, fq); }
#endif
            S.done(cur); }
        if (!has_next) break;
#pragma unroll
        for (int a = 0; a < 2; ++a)
#pragma unroll
            for (int b = 0; b < 2; ++b)
#pragma unroll
                for (int m = 0; m < 4; ++m)
#pragma unroll
                    for (int n = 0; n < 2; ++n) acc[a][b][m][n] = (f32x4){0.f, 0.f, 0.f, 0.f};
        cur = nxt; cA = nA; cB = nB; ++ui;
        if constexpr (ALIGN_EPI) { if (wr == 1) PG8_BAR; }
    }
    PG8_WAIT_V(0);
    if constexpr (!ALIGN_EPI) { if (wr == 0) PG8_BAR; }
    PG8_BAR;
    if constexpr (Epi::AFTER_DRAIN) { E.fused(acc, cur, wr, wc, fr, fq, lds, wid, lane); S.done(cur); }
#undef PG8_SA
#undef PG8_SB
#undef PG8_STAGE
#undef PG8_LDA
#undef PG8_LDB
#undef PG8_MMA
#undef PG8_WAIT_V
#undef PG8_WAIT_L
#undef PG8_BAR
#undef PG8_SCHED
}
}
constexpr int NWAVES = 8;
#ifndef MK_N_LAUNCHES
#define MK_N_LAUNCHES 1
#endif
constexpr int PER_PHASE = 9;
constexpr int N_LAUNCHES = MK_N_LAUNCHES;

constexpr int NB = 4, SEQ = 8192, T = NB * SEQ, D = 1024, DIN = 1280, NEXP = 16384, DQ = 2048;
constexpr float EPS = 1e-6f;

constexpr size_t MiB = 1u << 20;
constexpr size_t WS_CTL = 0, CTL_ZERO_BYTES = 1 * MiB;
constexpr size_t WS_WIN = 2 * MiB;
constexpr size_t WS_WOUT = 5 * MiB;
constexpr size_t WS_WQ = 7 * MiB;
constexpr size_t WS_SK = 11 * MiB;
constexpr size_t WS_POOLT = 11 * MiB + 512 * 1024;
constexpr size_t WS_RSTD1 = 12 * MiB;
constexpr size_t WS_SS2 = 13 * MiB;
constexpr size_t WS_SU = 15 * MiB;
constexpr size_t WS_SV = 15 * MiB + 256 * 1024;
constexpr size_t WS_EXP = 16 * MiB;
constexpr size_t WS_BEST = 24 * MiB;
constexpr size_t WS_CC = 40 * MiB;
constexpr size_t WS_SCC = 44 * MiB;
constexpr size_t WS_U8 = 56 * MiB;
constexpr size_t WS_V8 = 72 * MiB;
constexpr size_t WS_AB = 88 * MiB;
constexpr size_t WS_X1B = 152 * MiB;
constexpr size_t WS_PD = 216 * MiB;
constexpr size_t WS_DELTA = 360 * MiB;
constexpr size_t WS_XB = 216 * MiB;
constexpr size_t WS_Y = 280 * MiB;
constexpr size_t WS_QP = 216 * MiB;
constexpr size_t WS_END = 424 * MiB;
constexpr int CW_BAR = 4096;

constexpr int RING_OFF = 0, RING_BYTES = 131072;
constexpr int LDS_BYTES = 163840;
constexpr int LDSCTL_OFF = LDS_BYTES - 512, MISC_OFF = LDSCTL_OFF + 320;
constexpr int PHASE_LDS_MAX = LDSCTL_OFF;
#define GAS __attribute__((address_space(1)))
#define LAS __attribute__((address_space(3)))
typedef unsigned short bf16;
typedef unsigned v4u __attribute__((ext_vector_type(4)));
typedef float f32x4 __attribute__((ext_vector_type(4)));
typedef short bf16x8 __attribute__((ext_vector_type(8)));
typedef GAS unsigned gu32;
typedef GAS unsigned long long gu64;
#define RLX_AGENT __ATOMIC_RELAXED, __HIP_MEMORY_SCOPE_AGENT
#define LDS_WAIT() asm volatile("s_waitcnt lgkmcnt(0)" ::: "memory")
#define VM_WAIT() asm volatile("s_waitcnt vmcnt(0)" ::: "memory")
__device__ __forceinline__ unsigned long long rt() { return __builtin_amdgcn_s_memrealtime(); }
__device__ __forceinline__ unsigned f2bf(float f) { unsigned u = __builtin_bit_cast(unsigned, f); return (u + 0x7fffu + ((u >> 16) & 1u)) >> 16; }
__device__ __forceinline__ unsigned pk2(float lo, float hi) { return f2bf(lo) | (f2bf(hi) << 16); }
#define XB_TMO      128
#define XB_XCNT(j)  (256  + 64 * (j))
#define XB_XSUB(j)  (1280 + 64 * (j))
#define XB_XGEN(j)  (2304 + 64 * (j))
#define XB_TOP      3328
#define XB_TOPGEN   3392
#define XCD_BAR_WORDS 3456
#define XB_SPIN_CAP (1u << 18)

__device__ __forceinline__ unsigned xb_ld(unsigned* p)              { return __hip_atomic_load(p, __ATOMIC_RELAXED, __HIP_MEMORY_SCOPE_AGENT); }
__device__ __forceinline__ unsigned xb_add(unsigned* p, unsigned v) { return __hip_atomic_fetch_add(p, v, __ATOMIC_RELAXED, __HIP_MEMORY_SCOPE_AGENT); }
__device__ __forceinline__ unsigned xb_xcc_id() { return (unsigned)__builtin_amdgcn_s_getreg((3 << 11) | 20) & 0xFu; }
#define XB_SPIN(cond, bar) do { unsigned _sp = 0; while (cond) { __builtin_amdgcn_s_sleep(1); \
    if ((++_sp & 255u) == 0u) { if (xb_ld(&(bar)[XB_TMO])) break; if (_sp > XB_SPIN_CAP) { atomicAdd(&(bar)[XB_TMO], 1u); break; } } } } while (0)

struct XcdBarrier {
    unsigned* bar; unsigned x;
    volatile LAS unsigned* st;
};

__device__ __forceinline__ XcdBarrier xcd_barrier_post(unsigned* bar, volatile LAS unsigned* st) {
    XcdBarrier b; b.bar = bar; b.x = xb_xcc_id(); b.st = st;
    if (threadIdx.x == 0) (void)xb_add(&bar[XB_XCNT(b.x)], 1u);
    return b;
}
__device__ __forceinline__ void xcd_barrier_complete(unsigned* bar, unsigned x, unsigned& nloc, unsigned& nx) {
    const unsigned G = gridDim.x * gridDim.y * gridDim.z;
    unsigned sum, cnt, mine, sp = 0u;
    for (;;) {
        sum = 0u; cnt = 0u; mine = 0u;
#pragma unroll
        for (unsigned j = 0; j < 16; ++j) { const unsigned c = xb_ld(&bar[XB_XCNT(j)]); sum += c; cnt += (c > 0u) ? 1u : 0u; mine = (j == x) ? c : mine; }
        if (sum == G) break;
        __builtin_amdgcn_s_sleep(1);
        if ((++sp & 255u) == 0u) { if (xb_ld(&bar[XB_TMO])) break; if (sp > XB_SPIN_CAP) { atomicAdd(&bar[XB_TMO], 1u); break; } }
    }
    nloc = mine > 0u ? mine : 1u; nx = cnt > 0u ? cnt : 1u;
}

__device__ __forceinline__ void xcd_barrier(const XcdBarrier& b) {
    asm volatile("s_waitcnt vmcnt(0)" ::: "memory");
    __syncthreads();
    if (threadIdx.x == 0) {
        unsigned* bar = b.bar;
        __builtin_amdgcn_s_waitcnt(0);
        unsigned nloc = b.st[0], nx = b.st[1];
        if (nloc == 0u) { xcd_barrier_complete(bar, b.x, nloc, nx); b.st[0] = nloc; b.st[1] = nx; }
        const unsigned old = xb_add(&bar[XB_XSUB(b.x)], 1u);
        const unsigned gen = old / nloc;
        if (old + 1u == (gen + 1u) * nloc) {
            __builtin_amdgcn_fence(__ATOMIC_RELEASE, "agent");
            asm volatile("s_waitcnt vmcnt(0)" ::: "memory");
            const unsigned og = xb_add(&bar[XB_TOP], 1u);
            const unsigned tg = og / nx;
            if (og + 1u == (tg + 1u) * nx) xb_add(&bar[XB_TOPGEN], 1u);
            else XB_SPIN(xb_ld(&bar[XB_TOPGEN]) == tg, bar);
            __builtin_amdgcn_fence(__ATOMIC_ACQUIRE, "agent");
            xb_add(&bar[XB_XGEN(b.x)], 1u);
            asm volatile("s_waitcnt vmcnt(0)" ::: "memory");
        } else {
            XB_SPIN(xb_ld(&bar[XB_XGEN(b.x)]) == gen, bar);
            __builtin_amdgcn_fence(__ATOMIC_ACQUIRE, "agent");
            asm volatile("s_waitcnt vmcnt(0)" ::: "memory");
        }
    }
    __syncthreads();
}
typedef float f32x16 __attribute__((ext_vector_type(16)));
typedef int v4i_t __attribute__((ext_vector_type(4)));
typedef __bf16 bf16x2_t __attribute__((ext_vector_type(2)));
#define MFMA32(a, b, c) __builtin_amdgcn_mfma_f32_32x32x16_bf16((a), (b), (c), 0, 0, 0)
__device__ __forceinline__ float bf_lo(unsigned u) { return __builtin_bit_cast(float, u << 16); }
__device__ __forceinline__ float bf_hi(unsigned u) { return __builtin_bit_cast(float, u & 0xffff0000u); }
__device__ __forceinline__ float dot2_bf16(unsigned w, unsigned x, float acc) { return __builtin_amdgcn_fdot2_f32_bf16(__builtin_bit_cast(bf16x2_t, w), __builtin_bit_cast(bf16x2_t, x), acc, false); }
__device__ __forceinline__ float wave_sum(float v) {
#pragma unroll
    for (int o = 1; o < 64; o <<= 1) v += __shfl_xor(v, o);
    return v;
}

__device__ __forceinline__ unsigned pack_i8x4(float a, float b, float c, float d) {
    return ((unsigned)__float2int_rn(a) & 0xffu) | (((unsigned)__float2int_rn(b) & 0xffu) << 8) | (((unsigned)__float2int_rn(c) & 0xffu) << 16) | (((unsigned)__float2int_rn(d) & 0xffu) << 24);
}

__device__ __forceinline__ void p0_transpose_item(const float* W, int K, int N, bf16* WT, const float* gk, LAS float* scr, int item, int lane) {
    const int nblk = N / 32, kb = item / nblk, nb = item % nblk, k0 = 64 * kb, n0 = 32 * nb;
    float wv[32];
#pragma unroll
    for (int i = 0; i < 32; ++i) wv[i] = W[(size_t)(k0 + 2 * i + (lane >> 5)) * N + n0 + (lane & 31)];
#pragma unroll
    for (int i = 0; i < 32; ++i) { const int kk = 2 * i + (lane >> 5); float w = wv[i]; if (gk) w *= gk[k0 + kk]; scr[kk * 33 + (lane & 31)] = w; }
    LDS_WAIT(); asm volatile("" ::: "memory");
    const int c = lane & 7;
#pragma unroll
    for (int j = 0; j < 4; ++j) { const int n = (lane >> 3) + 8 * j; const LAS float* s = scr + (8 * c) * 33 + n;
        v4u o; o.x = pk2(s[0 * 33], s[1 * 33]); o.y = pk2(s[2 * 33], s[3 * 33]); o.z = pk2(s[4 * 33], s[5 * 33]); o.w = pk2(s[6 * 33], s[7 * 33]);
        *(GAS v4u*)(WT + (size_t)(n0 + n) * K + k0 + 8 * c) = o; }
    LDS_WAIT(); asm volatile("" ::: "memory");
}
__device__ __forceinline__ float row_to_bf16(const float* src, bf16* dst, const float* g, int lane) {
    const GAS f32x4* xr = (const GAS f32x4*)src + lane; float s = 0.f;
    GAS unsigned long long* o8 = (GAS unsigned long long*)dst + lane;
#pragma unroll
    for (int j = 0; j < 4; ++j) { f32x4 v = xr[64 * j]; s += (v.x * v.x + v.y * v.y) + (v.z * v.z + v.w * v.w);
        if (g) { const f32x4 gv = ((const GAS f32x4*)g)[64 * j + lane]; v = v * gv; }
        o8[64 * j] = (unsigned long long)pk2(v.x, v.y) | ((unsigned long long)pk2(v.z, v.w) << 32); }
    return s;
}
__device__ __forceinline__ void row_to_i8(const float* src, unsigned char* dst, const float* g, float* sc, int m, int lane) {
    const GAS f32x4* xr = (const GAS f32x4*)src + lane; f32x4 v[4]; float amax = 0.f;
#pragma unroll
    for (int j = 0; j < 4; ++j) { v[j] = xr[64 * j]; if (g) { const f32x4 gv = ((const GAS f32x4*)g)[64 * j + lane]; v[j] = v[j] * gv; }
        amax = fmaxf(fmaxf(amax, fmaxf(fabsf(v[j].x), fabsf(v[j].y))), fmaxf(fabsf(v[j].z), fabsf(v[j].w))); }
#pragma unroll
    for (int o = 1; o < 64; o <<= 1) amax = fmaxf(amax, __shfl_xor(amax, o));
    const float inv = amax > 0.f ? 127.0f / amax : 0.f;
    GAS unsigned* o4 = (GAS unsigned*)dst + lane;
#pragma unroll
    for (int j = 0; j < 4; ++j) { const unsigned q0 = (unsigned)__float2int_rn(v[j].x * inv) & 0xffu, q1 = (unsigned)__float2int_rn(v[j].y * inv) & 0xffu, q2 = (unsigned)__float2int_rn(v[j].z * inv) & 0xffu, q3 = (unsigned)__float2int_rn(v[j].w * inv) & 0xffu;
        o4[64 * j] = q0 | (q1 << 8) | (q2 << 16) | (q3 << 24); }
    if (lane == 0) sc[m] = amax * (1.0f / 127.0f);
}
__device__ __forceinline__ void p0_poolfold_wg(const float* w_in, const float* pool_w, const float* g1, bf16* WinT, LAS unsigned char* lds, int item, int tid) {
    const int g = item & 3, kb = item >> 2, k0 = 16 * kb;
    LAS float* pw = (LAS float*)lds;
    LAS float* wt = (LAS float*)(lds + 65536);
#pragma unroll
    for (int i = 0; i < 8; ++i) *(LAS f32x4*)(pw + 4 * (tid + 512 * i)) = ((const GAS f32x4*)(pool_w + (size_t)g * 16384))[tid + 512 * i];
    { const int r = tid >> 5, c4 = tid & 31; *(LAS f32x4*)(wt + r * 128 + 4 * c4) = *(const GAS f32x4*)(w_in + (size_t)(k0 + r) * DIN + 768 + 128 * g + 4 * c4); }
    LDS_WAIT(); __syncthreads();
    const int kr = tid >> 5, nq = tid & 31;
    f32x4 acc = {0.f, 0.f, 0.f, 0.f};
#pragma unroll 4
    for (int c4 = 0; c4 < 32; ++c4) { const f32x4 a = *(const LAS f32x4*)(wt + kr * 128 + 4 * c4);
        acc = acc + a.x * *(const LAS f32x4*)(pw + (4 * c4 + 0) * 128 + 4 * nq); acc = acc + a.y * *(const LAS f32x4*)(pw + (4 * c4 + 1) * 128 + 4 * nq);
        acc = acc + a.z * *(const LAS f32x4*)(pw + (4 * c4 + 2) * 128 + 4 * nq); acc = acc + a.w * *(const LAS f32x4*)(pw + (4 * c4 + 3) * 128 + 4 * nq); }
    const float gk = g1[k0 + kr];
    bf16* o = WinT + (size_t)(768 + 128 * g + 4 * nq) * D + k0 + kr;
    o[0] = (bf16)f2bf(acc.x * gk); o[D] = (bf16)f2bf(acc.y * gk); o[2 * D] = (bf16)f2bf(acc.z * gk); o[3 * D] = (bf16)f2bf(acc.w * gk);
    __syncthreads();
}
struct P0Args { const float *x, *g1, *w_in, *pool_w, *w_out, *g2, *wq, *sk, *u, *v; bf16 *XB, *WinT, *WoutT, *WqT, *SK, *PoolT; unsigned char *U8, *V8; float *su, *sv; float* rstd1; };
__device__ __forceinline__ void p0_prologue(const P0Args& a, LAS unsigned char* lds, int gw, int NGW, int wave, int lane) {
    LAS float* scr = (LAS float*)(lds + RING_OFF + wave * 16384);
    for (int it = gw / NWAVES; it < 4 * (D / 16); it += NGW / NWAVES) p0_poolfold_wg(a.w_in, a.pool_w, a.g1, a.WinT, lds, it, wave * 64 + lane);
    constexpr int I_IN = (D / 64) * (768 / 32);
    for (int it = gw; it < I_IN; it += NGW) { const int kb = it / 24, nb = it % 24; p0_transpose_item(a.w_in, D, DIN, a.WinT, a.g1, scr, kb * 40 + nb, lane); }
    for (int m0 = gw; m0 < T; m0 += 4 * NGW) {
        f32x4 v[4][4];
#pragma unroll
        for (int r = 0; r < 4; ++r) { const int m = m0 + r * NGW < T ? m0 + r * NGW : m0; const GAS f32x4* xr = (const GAS f32x4*)(a.x + (size_t)m * D) + lane;
#pragma unroll
            for (int j = 0; j < 4; ++j) v[r][j] = xr[64 * j]; }
#pragma unroll
        for (int r = 0; r < 4; ++r) { const int m = m0 + r * NGW; if (m < T) {
            float s = 0.f; GAS unsigned long long* o8 = (GAS unsigned long long*)(a.XB + (size_t)m * D) + lane;
#pragma unroll
            for (int j = 0; j < 4; ++j) { const f32x4 w = v[r][j]; s += (w.x * w.x + w.y * w.y) + (w.z * w.z + w.w * w.w); o8[64 * j] = (unsigned long long)pk2(w.x, w.y) | ((unsigned long long)pk2(w.z, w.w) << 32); }
            s = wave_sum(s); if (lane == 0) a.rstd1[m] = 1.0f / sqrtf(s * (1.0f / D) + EPS); } }
    }
    for (int m0 = gw; m0 < 2 * NEXP; m0 += 4 * NGW) {
        f32x4 v[4][4];
#pragma unroll
        for (int r = 0; r < 4; ++r) { const int mm = m0 + r * NGW < 2 * NEXP ? m0 + r * NGW : m0; const bool isv = mm >= NEXP; const int m = isv ? mm - NEXP : mm;
            const GAS f32x4* xr = (const GAS f32x4*)((isv ? a.v : a.u) + (size_t)m * D) + lane;
#pragma unroll
            for (int j = 0; j < 4; ++j) v[r][j] = xr[64 * j]; }
#pragma unroll
        for (int r = 0; r < 4; ++r) { const int mm = m0 + r * NGW; if (mm < 2 * NEXP) { const bool isv = mm >= NEXP; const int m = isv ? mm - NEXP : mm;
            float amax = 0.f;
#pragma unroll
            for (int j = 0; j < 4; ++j) { if (!isv) { const f32x4 gv = ((const GAS f32x4*)a.g2)[64 * j + lane]; v[r][j] = v[r][j] * gv; }
                amax = fmaxf(fmaxf(amax, fmaxf(fabsf(v[r][j].x), fabsf(v[r][j].y))), fmaxf(fabsf(v[r][j].z), fabsf(v[r][j].w))); }
#pragma unroll
            for (int o = 1; o < 64; o <<= 1) amax = fmaxf(amax, __shfl_xor(amax, o));
            if (!isv) {
            const float inv = amax > 0.f ? 127.0f / amax : 0.f;
            unsigned char* tb_ = a.U8 + (size_t)m * 128 + ((4 * lane) & 127);
#pragma unroll
            for (int j = 0; j < 4; ++j) *(GAS unsigned*)(tb_ + (size_t)((4 * lane + 256 * j) >> 7) * ((size_t)NEXP * 128)) = pack_i8x4(v[r][j].x * inv, v[r][j].y * inv, v[r][j].z * inv, v[r][j].w * inv);
            if (lane == 0) a.su[m] = amax * (1.0f / 127.0f);
            } else {
            const float inv = amax > 0.f ? 7.0f / amax : 0.f;
#pragma unroll
            for (int j = 0; j < 4; ++j) { const int q0_ = __float2int_rn(v[r][j].x * inv), q1_ = __float2int_rn(v[r][j].y * inv), q2_ = __float2int_rn(v[r][j].z * inv), q3_ = __float2int_rn(v[r][j].w * inv);
                const unsigned lo_ = (unsigned)(q0_ + 8) | ((unsigned)(q1_ + 8) << 8) | ((unsigned)(q2_ + 8) << 16) | ((unsigned)(q3_ + 8) << 24);
                const unsigned hi_ = (((unsigned)q0_ & 15u) << 4) | (((unsigned)q1_ & 15u) << 12) | (((unsigned)q2_ & 15u) << 20) | (((unsigned)q3_ & 15u) << 28);
                const unsigned mine_ = (lane & 1) ? hi_ : lo_;
                const unsigned other_ = (unsigned)__shfl_xor((int)mine_, 1);
                if ((lane & 1) == 0) *(GAS unsigned*)(a.V8 + (size_t)j * ((size_t)NEXP * 128) + (size_t)m * 128 + 4 * (lane >> 1)) = mine_ | other_; }
            if (lane == 0) a.sv[m] = amax * (1.0f / 7.0f);
            } } }
    }
}
__device__ __forceinline__ void p1_late_weights(const P0Args& a, LAS unsigned char* lds, int gw, int NGW, int wave, int lane) {
    LAS float* scr = (LAS float*)(lds + RING_OFF + wave * 16384);
    constexpr int I_OUT = (D / 64) * (D / 32), I_Q = (D / 64) * (DQ / 32);
    for (int it = gw; it < I_OUT + I_Q; it += NGW) {
        if (it < I_OUT) p0_transpose_item(a.w_out, D, D, a.WoutT, nullptr, scr, it, lane);
        else p0_transpose_item(a.wq, D, DQ, a.WqT, a.g2, scr, it - I_OUT, lane);
    }
    for (int m = gw; m < 256; m += NGW) (void)row_to_bf16(a.sk + (size_t)m * D, a.SK + (size_t)m * D, nullptr, lane);
}

__device__ __forceinline__ int t5_bucket(int rel) {
    const int n = rel < 0 ? -rel : rel; const int base = rel > 0 ? 16 : 0;
    const int v = n < 8 ? n : (n < 12 ? 8 : (n < 16 ? 9 : (n < 23 ? 10 : (n < 32 ? 11 : (n < 46 ? 12 : (n < 64 ? 13 : (n < 91 ? 14 : 15)))))));
    return base + v;
}
__device__ __forceinline__ void attn_unit(LAS unsigned char* lds, const bf16* Y, bf16* AB, const float* qg, const float* kg, const float* sinks, const float* relb,
                                          int unit, int tid, int wave, int lane) {
    const int kvh = unit & 1, c = (unit >> 1) & 127, b = unit >> 8;
    LAS bf16* Ks = (LAS bf16*)lds;
    LAS bf16* Vt = (LAS bf16*)(lds + 27648);
    LAS float* bt = (LAS float*)(lds + 53248);
    const int row0 = b * SEQ + (c - 2) * 64;
#pragma unroll
    for (int rep = 0; rep < 3; ++rep) {
        const int it = tid + rep * 512, j = it >> 3, ch = it & 7;
        const bool valid = (c - 2 + (j >> 6)) >= 0;
        v4u kraw = {0u, 0u, 0u, 0u}, vraw = {0u, 0u, 0u, 0u};
        if (valid) { const bf16* rp = Y + (size_t)(row0 + j) * DIN; kraw = *(const GAS v4u*)(rp + 512 + 64 * kvh + 8 * ch); vraw = *(const GAS v4u*)(rp + 640 + 64 * kvh + 8 * ch); }
        float kf[8] = {bf_lo(kraw.x), bf_hi(kraw.x), bf_lo(kraw.y), bf_hi(kraw.y), bf_lo(kraw.z), bf_hi(kraw.z), bf_lo(kraw.w), bf_hi(kraw.w)};
        float ss = 0.f;
#pragma unroll
        for (int e = 0; e < 8; ++e) ss += kf[e] * kf[e];
        ss += __shfl_xor(ss, 1); ss += __shfl_xor(ss, 2); ss += __shfl_xor(ss, 4);
        const float r = 1.0f / sqrtf(ss * (1.0f / 64.0f) + EPS);
        const f32x4 g0 = *(const GAS f32x4*)(kg + 8 * ch), g1 = *(const GAS f32x4*)(kg + 8 * ch + 4);
        v4u ko; ko.x = pk2(kf[0] * r * g0.x, kf[1] * r * g0.y); ko.y = pk2(kf[2] * r * g0.z, kf[3] * r * g0.w); ko.z = pk2(kf[4] * r * g1.x, kf[5] * r * g1.y); ko.w = pk2(kf[6] * r * g1.z, kf[7] * r * g1.w);
        *(LAS v4u*)(Ks + j * 72 + 8 * ch) = ko;
        const int s16 = j >> 4, kk = j & 15, hh = (kk >> 2) & 1, jj = ((kk >> 3) << 2) | (kk & 3), pos = 16 * s16 + 8 * hh + jj;
        LAS bf16* vp = Vt + (8 * ch) * 200 + pos;
        vp[0 * 200] = (bf16)(vraw.x & 0xffffu); vp[1 * 200] = (bf16)(vraw.x >> 16); vp[2 * 200] = (bf16)(vraw.y & 0xffffu); vp[3 * 200] = (bf16)(vraw.y >> 16);
        vp[4 * 200] = (bf16)(vraw.z & 0xffffu); vp[5 * 200] = (bf16)(vraw.z >> 16); vp[6 * 200] = (bf16)(vraw.w & 0xffffu); vp[7 * 200] = (bf16)(vraw.w >> 16);
    }
#pragma unroll
    for (int rep = 0; rep < 2; ++rep) { const int it = tid + rep * 512, g = it >> 8, r = it & 255; bt[it] = relb[t5_bucket(r - 191) * 8 + kvh * 4 + g]; }
    LDS_WAIT(); __syncthreads();

    const int g = wave >> 1, i = 32 * (wave & 1) + (lane & 31), hh = lane >> 5, habs = kvh * 4 + g;
    const size_t qrow = (size_t)b * SEQ + (size_t)c * 64 + i;
    const bf16* qp = Y + qrow * DIN + habs * 64 + 8 * hh;
    v4u qraw[4]; float ss = 0.f;
#pragma unroll
    for (int s = 0; s < 4; ++s) { qraw[s] = *(const GAS v4u*)(qp + 16 * s);
        const float f0 = bf_lo(qraw[s].x), f1 = bf_hi(qraw[s].x), f2 = bf_lo(qraw[s].y), f3 = bf_hi(qraw[s].y), f4 = bf_lo(qraw[s].z), f5 = bf_hi(qraw[s].z), f6 = bf_lo(qraw[s].w), f7 = bf_hi(qraw[s].w);
        ss += (f0 * f0 + f1 * f1) + (f2 * f2 + f3 * f3) + (f4 * f4 + f5 * f5) + (f6 * f6 + f7 * f7); }
    ss += __shfl_xor(ss, 32);
    const float rq = 0.125f / sqrtf(ss * (1.0f / 64.0f) + EPS);
    bf16x8 qf[4];
#pragma unroll
    for (int s = 0; s < 4; ++s) { const f32x4 g0 = *(const GAS f32x4*)(qg + 16 * s + 8 * hh), g1 = *(const GAS f32x4*)(qg + 16 * s + 8 * hh + 4);
        v4u w; w.x = pk2(bf_lo(qraw[s].x) * rq * g0.x, bf_hi(qraw[s].x) * rq * g0.y); w.y = pk2(bf_lo(qraw[s].y) * rq * g0.z, bf_hi(qraw[s].y) * rq * g0.w);
        w.z = pk2(bf_lo(qraw[s].z) * rq * g1.x, bf_hi(qraw[s].z) * rq * g1.y); w.w = pk2(bf_lo(qraw[s].w) * rq * g1.z, bf_hi(qraw[s].w) * rq * g1.w);
        qf[s] = __builtin_bit_cast(bf16x8, w); }
    f32x16 sacc[6];
#pragma unroll
    for (int kt = 0; kt < 6; ++kt) {
#pragma unroll
        for (int r = 0; r < 16; ++r) sacc[kt][r] = 0.f;
#pragma unroll
        for (int s = 0; s < 4; ++s) { const bf16x8 a = *(const LAS bf16x8*)(Ks + (32 * kt + (lane & 31)) * 72 + 16 * s + 8 * hh); sacc[kt] = MFMA32(a, qf[s], sacc[kt]); }
    }
    const LAS float* btg = bt + g * 256 + 63 - i;
    float mx = -3.0e38f;
#pragma unroll
    for (int kt = 0; kt < 6; ++kt) { const bool masked = (c - 2 + (kt >> 1)) < 0;
#pragma unroll
        for (int r = 0; r < 16; ++r) { const int j = 32 * kt + (r & 3) + 8 * (r >> 2) + 4 * hh; float v = sacc[kt][r] + btg[j]; v = masked ? -1.0e30f : v; sacc[kt][r] = v; mx = fmaxf(mx, v); } }
    mx = fmaxf(mx, __shfl_xor(mx, 32));
    const float sink = sinks[habs], m = fmaxf(mx, sink);
    float sum = 0.f;
#pragma unroll
    for (int kt = 0; kt < 6; ++kt)
#pragma unroll
        for (int r = 0; r < 16; ++r) { const float p = __expf(sacc[kt][r] - m); sacc[kt][r] = p; sum += p; }
    sum += __shfl_xor(sum, 32);
    const float inv = 1.0f / (sum + __expf(sink - m));
    f32x16 oacc[2];
#pragma unroll
    for (int dt = 0; dt < 2; ++dt)
#pragma unroll
        for (int r = 0; r < 16; ++r) oacc[dt][r] = 0.f;
#pragma unroll
    for (int kt = 0; kt < 6; ++kt)
#pragma unroll
        for (int s2 = 0; s2 < 2; ++s2) {
            v4u w; w.x = pk2(sacc[kt][8 * s2 + 0], sacc[kt][8 * s2 + 1]); w.y = pk2(sacc[kt][8 * s2 + 2], sacc[kt][8 * s2 + 3]); w.z = pk2(sacc[kt][8 * s2 + 4], sacc[kt][8 * s2 + 5]); w.w = pk2(sacc[kt][8 * s2 + 6], sacc[kt][8 * s2 + 7]);
            const bf16x8 pb = __builtin_bit_cast(bf16x8, w);
#pragma unroll
            for (int dt = 0; dt < 2; ++dt) { const bf16x8 a = *(const LAS bf16x8*)(Vt + (32 * dt + (lane & 31)) * 200 + 32 * kt + 16 * s2 + 8 * hh); oacc[dt] = MFMA32(a, pb, oacc[dt]); }
        }
    bf16* op = AB + qrow * D + habs * 64;
#pragma unroll
    for (int dt = 0; dt < 2; ++dt)
#pragma unroll
        for (int q4 = 0; q4 < 4; ++q4) { const int d = 32 * dt + 8 * q4 + 4 * hh;
            const unsigned long long o = (unsigned long long)pk2(oacc[dt][4 * q4 + 0] * inv, oacc[dt][4 * q4 + 1] * inv) | ((unsigned long long)pk2(oacc[dt][4 * q4 + 2] * inv, oacc[dt][4 * q4 + 3] * inv) << 32);
            *(GAS unsigned long long*)(op + d) = o; }
    __syncthreads();
}

template <int W, bool START> __device__ __forceinline__ void pool_walk(const bf16* zc, bf16* oc, float s0, float s1, int pos0) {
    unsigned ring[16];
    float a0 = 0.f, a1 = 0.f;
    unsigned zr[64];
#pragma unroll
    for (int i = 0; i < 64; ++i) zr[i] = *(const GAS unsigned*)(zc + (size_t)i * DIN);
#pragma unroll
    for (int q = 0; q < 16; ++q) ring[q] = 0u;
#pragma unroll
    for (int q = 1; q < W; ++q) { if (pos0 - q >= 0) { const unsigned u = *(const GAS unsigned*)(zc - (size_t)q * DIN); ring[(16 - q) & 15] = u; a0 += bf_lo(u); a1 += bf_hi(u); } }
#pragma unroll
    for (int rb = 0; rb < 64; rb += 16) {
#pragma unroll
        for (int i = 0; i < 16; ++i) {
            const unsigned u = zr[rb + i];
            const float c0 = bf_lo(u), c1 = bf_hi(u);
            a0 += c0; a1 += c1;
            float ic = 1.0f / (float)W; if (START) { const int pos = pos0 + rb + i; ic = 1.0f / (float)(pos + 1 < W ? pos + 1 : W); }
            *(GAS unsigned*)(oc + (size_t)(rb + i) * D) = pk2((a0 * ic - c0) * s0, (a1 * ic - c1) * s1);
            const unsigned old = ring[(i + 17 - W) & 15];
            a0 -= bf_lo(old); a1 -= bf_hi(old);
            ring[i] = u;
        }
    }
}
__device__ __forceinline__ void pool_rows(const bf16* Y, bf16* AB, const float* pscale, int unit, int tid) {
    const int cp = tid & 255, seg = tid >> 8, g = cp >> 6;
    const int r0 = unit * 128 + seg * 64, pos0 = r0 & (SEQ - 1);
    const bf16* zc = Y + (size_t)r0 * DIN + 768 + 2 * cp; bf16* oc = AB + (size_t)r0 * D + 512 + 2 * cp;
    const float s0 = pscale[2 * cp], s1 = pscale[2 * cp + 1];
    if (pos0 >= 16) { if (g == 0) pool_walk<2, false>(zc, oc, s0, s1, pos0); else if (g == 1) pool_walk<4, false>(zc, oc, s0, s1, pos0); else if (g == 2) pool_walk<8, false>(zc, oc, s0, s1, pos0); else pool_walk<16, false>(zc, oc, s0, s1, pos0); }
    else { if (g == 0) pool_walk<2, true>(zc, oc, s0, s1, pos0); else if (g == 1) pool_walk<4, true>(zc, oc, s0, s1, pos0); else if (g == 2) pool_walk<8, true>(zc, oc, s0, s1, pos0); else pool_walk<16, true>(zc, oc, s0, s1, pos0); }
}

__device__ __forceinline__ int f2key(float f) { return __builtin_bit_cast(int, f); }
__device__ __forceinline__ float key2f(int k) { return __builtin_bit_cast(float, k); }
#define CE_DESC(a, b) do { const int _x = (a), _y = (b); (a) = _x > _y ? _x : _y; (b) = _x > _y ? _y : _x; } while (0)
__device__ __forceinline__ void sort16_desc(int (&a)[16]) {
#pragma unroll
    for (int k = 2; k <= 16; k <<= 1)
#pragma unroll
        for (int j = k >> 1; j > 0; j >>= 1)
#pragma unroll
            for (int i = 0; i < 16; ++i) { const int l = i ^ j; if (l > i) { if ((i & k) == 0) CE_DESC(a[i], a[l]); else CE_DESC(a[l], a[i]); } }
}
__device__ __forceinline__ void merge_top16(int (&a)[16], const int (&b)[16]) {
#pragma unroll
    for (int i = 0; i < 16; ++i) a[i] = a[i] > b[15 - i] ? a[i] : b[15 - i];
#pragma unroll
    for (int j = 8; j > 0; j >>= 1)
#pragma unroll
        for (int i = 0; i < 16; ++i) { const int l = i ^ j; if (l > i) CE_DESC(a[i], a[l]); }
}
__device__ __forceinline__ void top16_of_64(int (&g0)[16], int (&g1)[16], int (&g2)[16], int (&g3)[16]) {
    sort16_desc(g0); sort16_desc(g1); sort16_desc(g2); sort16_desc(g3);
    merge_top16(g0, g1); merge_top16(g2, g3); merge_top16(g0, g2);
}
__device__ __forceinline__ void topk_stage_keys(LAS unsigned char* lds, const bf16* SK, int h, int tid) {
#pragma unroll
    for (int i = 0; i < 8; ++i) { const int c = tid + 512 * i, p = c >> 11, n = (c >> 4) & 127, ch = c & 15;
        *(LAS v4u*)(lds + p * 34816 + n * 272 + ch * 16) = *(const GAS v4u*)(SK + ((size_t)(h * 2 + p) * 128 + n) * 128 + ch * 8); }
    LDS_WAIT(); __syncthreads();
}
__device__ __forceinline__ void topk_unit(LAS unsigned char* lds, const bf16* QP, const bf16* SK, unsigned short* EXPERTS, float* BEST, int unit, int tid, int wave, int lane) {
    const int h = unit & 7, tt = unit >> 3, hh = lane >> 5;
    const int tok = tt * 256 + wave * 32 + (lane & 31);
    static_assert(69632 + 512 * 33 * 4 <= PHASE_LDS_MAX, "top-k LDS scratch runs into the LDS control words");
    LAS int* mine = (LAS int*)(lds + 69632) + tid * 33;
    int top[2][16];
#pragma unroll
    for (int p = 0; p < 2; ++p) {
        const bf16* qp = QP + (size_t)tok * DQ + h * 256 + p * 128 + 8 * hh;
        const LAS unsigned char* kp = lds + p * 34816 + (lane & 31) * 272 + 16 * hh;
        f32x16 acc[4];
#pragma unroll
        for (int nt = 0; nt < 4; ++nt)
#pragma unroll
            for (int r = 0; r < 16; ++r) acc[nt][r] = 8.0f;
#pragma unroll
        for (int s = 0; s < 8; ++s) { const bf16x8 bq = __builtin_bit_cast(bf16x8, *(const GAS v4u*)(qp + 16 * s));
#pragma unroll
            for (int nt = 0; nt < 4; ++nt) { const bf16x8 a = *(const LAS bf16x8*)(kp + nt * (32 * 272) + 32 * s); acc[nt] = MFMA32(a, bq, acc[nt]); } }
        int k0[16], k1[16], k2[16], k3[16];
#pragma unroll
        for (int r = 0; r < 16; ++r) { const int n = (r & 3) + 8 * (r >> 2) + 4 * hh;
            k0[r] = (f2key(acc[0][r]) & ~127) | n; k1[r] = (f2key(acc[1][r]) & ~127) | (32 + n); k2[r] = (f2key(acc[2][r]) & ~127) | (64 + n); k3[r] = (f2key(acc[3][r]) & ~127) | (96 + n); }
        top16_of_64(k0, k1, k2, k3);
#pragma unroll
        for (int r = 0; r < 16; ++r) k1[r] = __shfl_xor(k0[r], 32);
        merge_top16(k0, k1);
#pragma unroll
        for (int r = 0; r < 16; ++r) top[p][r] = k0[r];
    }
    int c0[16], c1[16], c2[16], c3[16];
    {
        float v1[16], v2[16];
#pragma unroll
        for (int r = 0; r < 16; ++r) { v1[r] = key2f(top[0][r] & ~127); v2[r] = key2f(top[1][r] & ~127); mine[r] = top[0][r]; mine[16 + r] = top[1][r]; }
        int cnt = 0;
#pragma unroll
        for (int i = 0; i < 16; ++i)
#pragma unroll
            for (int j = 0; j < 16; ++j) if ((i + 1) * (j + 1) <= 16) { const int key = (f2key(v1[i] + v2[j]) & ~255) | (i << 4) | j;
                if (cnt < 16) c0[cnt] = key; else if (cnt < 32) c1[cnt - 16] = key; else if (cnt < 48) c2[cnt - 32] = key; else c3[cnt - 48] = key; ++cnt; }
#pragma unroll
        for (int r = 0; r < 16; ++r) if (48 + r >= cnt) c3[r] = (int)0x80000000;
    }
    top16_of_64(c0, c1, c2, c3);
    LDS_WAIT();
    if (hh == 0) {
        int ev[16]; float bv[16];
#pragma unroll
        for (int r = 0; r < 16; ++r) { const int id = c0[r] & 255; const int ka = mine[id >> 4], kb = mine[16 + (id & 15)];
            ev[r] = (ka & 127) * 128 + (kb & 127); bv[r] = (key2f(ka & ~127) - 8.0f) + (key2f(kb & ~127) - 8.0f); }
        unsigned short* ep = EXPERTS + (size_t)tok * 128 + h * 16; float* bp = BEST + (size_t)tok * 128 + h * 16;
#pragma unroll
        for (int r = 0; r < 16; r += 8) *(GAS v4u*)(ep + r) = (v4u){(unsigned)ev[r] | ((unsigned)ev[r + 1] << 16), (unsigned)ev[r + 2] | ((unsigned)ev[r + 3] << 16), (unsigned)ev[r + 4] | ((unsigned)ev[r + 5] << 16), (unsigned)ev[r + 6] | ((unsigned)ev[r + 7] << 16)};
#pragma unroll
        for (int r = 0; r < 16; r += 4) *(GAS f32x4*)(bp + r) = (f32x4){bv[r], bv[r + 1], bv[r + 2], bv[r + 3]};
    }
    LDS_WAIT();
}

__device__ __forceinline__ float gelu_erf(float x) { return 0.5f * x * (1.0f + erff(x * 0.70710678118654752f)); }
#define PEER_BL(rs, e_, c_) __builtin_amdgcn_raw_buffer_load_b128(rs, (int)(((e_) << 7) + (c_)), 0, 0)
#define PEER_ROWS(r, rs, c_, q) do { const v4u _ev = *(const LAS v4u*)(evp + 16 * (q)); \
        r[0] = PEER_BL(rs, _ev.x & 0xffffu, c_); r[1] = PEER_BL(rs, _ev.x >> 16, c_); r[2] = PEER_BL(rs, _ev.y & 0xffffu, c_); r[3] = PEER_BL(rs, _ev.y >> 16, c_); \
        r[4] = PEER_BL(rs, _ev.z & 0xffffu, c_); r[5] = PEER_BL(rs, _ev.z >> 16, c_); r[6] = PEER_BL(rs, _ev.w & 0xffffu, c_); r[7] = PEER_BL(rs, _ev.w >> 16, c_); } while (0)
__device__ __forceinline__ void peer_u_phase(LAS unsigned char* lds, const bf16* X1B, const unsigned char* U8, const unsigned short* EXP16, float* PD, int j, int w, int nw, int wave, int lane) {
    const int grp = lane >> 3, sub = lane & 7;
    LAS unsigned char* wl = lds + wave * 8192;
    const LAS unsigned char* evp = wl + grp * 256;
    const int stride = nw * NWAVES * 8;
    int tb = (w * NWAVES + wave) * 8;
    v4u pe0 = {0u, 0u, 0u, 0u}, pe1 = {0u, 0u, 0u, 0u};
    v4u px0 = {0u, 0u, 0u, 0u}, px1 = {0u, 0u, 0u, 0u};
    if (tb < T) { const GAS v4u* e = (const GAS v4u*)(EXP16 + (size_t)tb * 128) + lane; pe0 = e[0]; pe1 = e[64];
        const GAS v4u* xp = (const GAS v4u*)(X1B + (size_t)(tb + grp) * D + 128 * j + 16 * sub); px0 = xp[0]; px1 = xp[1]; }
    const __amdgpu_buffer_rsrc_t urs = __builtin_amdgcn_make_buffer_rsrc((void*)U8, (short)0, NEXP * D, 0x00020000); const unsigned uc = (unsigned)j * (NEXP * 128u) + 16u * sub;
    for (; tb < T; tb += stride) {
        *(LAS v4u*)(wl + 16 * lane) = pe0; *(LAS v4u*)(wl + 1024 + 16 * lane) = pe1;
        const v4u xa = px0, xc = px1;
        if (tb + stride < T) { const GAS v4u* e = (const GAS v4u*)(EXP16 + (size_t)(tb + stride) * 128) + lane; pe0 = e[0]; pe1 = e[64];
            const GAS v4u* xp = (const GAS v4u*)(X1B + (size_t)(tb + stride + grp) * D + 128 * j + 16 * sub); px0 = xp[0]; px1 = xp[1]; }
        const int t = tb + grp;
        const f32x4 x0 = {bf_lo(xa.x), bf_hi(xa.x), bf_lo(xa.y), bf_hi(xa.y)}, x1 = {bf_lo(xa.z), bf_hi(xa.z), bf_lo(xa.w), bf_hi(xa.w)};
        const f32x4 x2 = {bf_lo(xc.x), bf_hi(xc.x), bf_lo(xc.y), bf_hi(xc.y)}, x3 = {bf_lo(xc.z), bf_hi(xc.z), bf_lo(xc.w), bf_hi(xc.w)};
        float amax = fmaxf(fmaxf(fmaxf(fabsf(x0.x), fabsf(x0.y)), fmaxf(fabsf(x0.z), fabsf(x0.w))), fmaxf(fmaxf(fabsf(x1.x), fabsf(x1.y)), fmaxf(fabsf(x1.z), fabsf(x1.w))));
        amax = fmaxf(amax, fmaxf(fmaxf(fmaxf(fabsf(x2.x), fabsf(x2.y)), fmaxf(fabsf(x2.z), fabsf(x2.w))), fmaxf(fmaxf(fabsf(x3.x), fabsf(x3.y)), fmaxf(fabsf(x3.z), fabsf(x3.w)))));
        amax = fmaxf(amax, __shfl_xor(amax, 1)); amax = fmaxf(amax, __shfl_xor(amax, 2)); amax = fmaxf(amax, __shfl_xor(amax, 4));
        const float inv = amax > 0.f ? 127.0f / amax : 0.f, sx = amax * (1.0f / 127.0f);
        const unsigned xq0 = pack_i8x4(x0.x * inv, x0.y * inv, x0.z * inv, x0.w * inv), xq1 = pack_i8x4(x1.x * inv, x1.y * inv, x1.z * inv, x1.w * inv);
        const unsigned xq2 = pack_i8x4(x2.x * inv, x2.y * inv, x2.z * inv, x2.w * inv), xq3 = pack_i8x4(x3.x * inv, x3.y * inv, x3.z * inv, x3.w * inv);
        const bool up4 = (sub & 4) != 0, up2 = (sub & 2) != 0, up1 = (sub & 1) != 0;
        LAS _Float16* pd = (LAS _Float16*)(wl + 4096) + grp * 128 + sub;
        LDS_WAIT();
        v4u ra[8], rb[8], rc[8];
        PEER_ROWS(ra, urs, uc, 0); PEER_ROWS(rb, urs, uc, 1);
#define PEER_UDOT(r, q) do { int p[8]; _Pragma("unroll") for (int i = 0; i < 8; ++i) { int a = __builtin_amdgcn_sdot4((int)r[i].x, (int)xq0, 0, false); a = __builtin_amdgcn_sdot4((int)r[i].y, (int)xq1, a, false); \
                a = __builtin_amdgcn_sdot4((int)r[i].z, (int)xq2, a, false); p[i] = __builtin_amdgcn_sdot4((int)r[i].w, (int)xq3, a, false); } \
            _Pragma("unroll") for (int i = 0; i < 4; ++i) { const int keep = up4 ? p[i + 4] : p[i], send = up4 ? p[i] : p[i + 4]; p[i] = keep + __builtin_amdgcn_mov_dpp(send, 0x141, 0xF, 0xF, true); } \
            _Pragma("unroll") for (int i = 0; i < 2; ++i) { const int keep = up2 ? p[i + 2] : p[i], send = up2 ? p[i] : p[i + 2]; p[i] = keep + __builtin_amdgcn_mov_dpp(send, 0x4E, 0xF, 0xF, true); } \
            { const int keep = up1 ? p[1] : p[0], send = up1 ? p[0] : p[1]; p[0] = keep + __builtin_amdgcn_mov_dpp(send, 0xB1, 0xF, 0xF, true); } \
            pd[8 * (q)] = (_Float16)((float)p[0] * sx); } while (0)
        for (int q = 0; q < 15; q += 3) {
            PEER_ROWS(rc, urs, uc, q + 2); PEER_UDOT(ra, q);
            PEER_ROWS(ra, urs, uc, q + 3); PEER_UDOT(rb, q + 1);
            if (q + 4 < 16) PEER_ROWS(rb, urs, uc, q + 4);
            PEER_UDOT(rc, q + 2);
        }
        PEER_UDOT(ra, 15);
        LDS_WAIT();
#pragma unroll
        for (int qq = 0; qq < 2; ++qq) { const v4u pv = *(const LAS v4u*)(wl + 4096 + qq * 1024 + 16 * lane);
            *(GAS v4u*)((_Float16*)PD + ((size_t)j * T + tb + 4 * qq + (lane >> 4)) * 128 + 8 * (lane & 15)) = pv; }
    }
}
__device__ __forceinline__ void peer_stage_scales(LAS unsigned char* lds, const float* su, const float* sv, int tid) {
#pragma unroll
    for (int i = 0; i < 8; ++i) { *(LAS f32x4*)(lds + (size_t)(tid + 512 * i) * 16) = ((const GAS f32x4*)su)[tid + 512 * i]; *(LAS f32x4*)(lds + 65536 + (size_t)(tid + 512 * i) * 16) = ((const GAS f32x4*)sv)[tid + 512 * i]; }
    LDS_WAIT(); __syncthreads();
}
__device__ __forceinline__ void peer_combine4(LAS unsigned char* lds, const float* PD, const unsigned short* EXP16, const float* BEST, const float* SS2, unsigned char* CC8, float* SCC, int t0, int lane) {
    const LAS float* su = (const LAS float*)lds; const LAS float* sv = (const LAS float*)(lds + 65536);
    typedef float f32x2v __attribute__((ext_vector_type(2)));
    f32x4 ssv[4][4]; unsigned ev[4]; f32x2v bv[4]; f32x2v pdv[4][8];
#pragma unroll
    for (int i = 0; i < 4; ++i) { const int t = t0 + i;
        const GAS f32x4* sp = (const GAS f32x4*)(SS2 + (size_t)t * 16);
#pragma unroll
        for (int q = 0; q < 4; ++q) ssv[i][q] = sp[q];
        ev[i] = ((const GAS unsigned*)(EXP16 + (size_t)t * 128))[lane];
        bv[i] = ((const GAS f32x2v*)(BEST + (size_t)t * 128))[lane];
#pragma unroll
        for (int j = 0; j < 8; ++j) { typedef _Float16 h2v __attribute__((ext_vector_type(2))); const h2v hv = ((const GAS h2v*)((const _Float16*)PD + ((size_t)j * T + t) * 128))[lane]; pdv[i][j] = (f32x2v){(float)hv.x, (float)hv.y}; } }
    float suv[4][2], svv[4][2];
#pragma unroll
    for (int i = 0; i < 4; ++i) { const unsigned e0 = ev[i] & 0xffffu, e1 = ev[i] >> 16; suv[i][0] = su[e0]; suv[i][1] = su[e1]; svv[i][0] = sv[e0]; svv[i][1] = sv[e1]; }
#pragma unroll
    for (int i = 0; i < 4; ++i) { const int t = t0 + i;
        float ssq = 0.f;
#pragma unroll
        for (int q = 0; q < 4; ++q) ssq += (ssv[i][q].x + ssv[i][q].y) + (ssv[i][q].z + ssv[i][q].w);
        const float rstd2 = 1.0f / sqrtf(ssq * (1.0f / D) + EPS);
        const float s0 = bv[i].x * rstd2, s1 = bv[i].y * rstd2;
        float mx = fmaxf(s0, s1);
#pragma unroll
        for (int o = 1; o < 8; o <<= 1) mx = fmaxf(mx, __shfl_xor(mx, o));
        const float e0 = __expf(s0 - mx), e1 = __expf(s1 - mx); float sm = e0 + e1;
#pragma unroll
        for (int o = 1; o < 8; o <<= 1) sm += __shfl_xor(sm, o);
        float d0 = 0.f, d1 = 0.f;
#pragma unroll
        for (int j = 0; j < 8; ++j) { d0 += pdv[i][j].x; d1 += pdv[i][j].y; }
        const float inv_sm = 1.0f / sm;
        const float c0 = e0 * inv_sm * gelu_erf(d0 * rstd2 * suv[i][0]) * svv[i][0], c1 = e1 * inv_sm * gelu_erf(d1 * rstd2 * suv[i][1]) * svv[i][1];
        float amax = fmaxf(fabsf(c0), fabsf(c1));
#pragma unroll
        for (int o = 1; o < 64; o <<= 1) amax = fmaxf(amax, __shfl_xor(amax, o));
        const float inv = amax > 0.f ? 127.0f / amax : 0.f;
        const int q0_ = __float2int_rn(c0 * inv), q1_ = __float2int_rn(c1 * inv);
        ((GAS unsigned short*)(CC8 + (size_t)t * 128))[lane] = (unsigned short)((q0_ & 0xff) | ((q1_ & 0xff) << 8));
        int cs_ = q0_ + q1_;
#pragma unroll
        for (int o = 1; o < 64; o <<= 1) cs_ += __shfl_xor(cs_, o);
        if (lane == 0) { SCC[2 * t] = amax * (1.0f / 127.0f); SCC[2 * t + 1] = (float)cs_; } }
}
__device__ __forceinline__ void peer_v_phase(LAS unsigned char* lds, float* OUT, const bf16* X1B, const unsigned char* V4, const unsigned short* EXP16, const unsigned char* CC8, const float* SCC, int j, int w, int nw, int wave, int lane) {
    const int grp = lane >> 3, sub = lane & 7;
    unsigned csel[4];
#pragma unroll
    for (int k_ = 0; k_ < 4; ++k_) csel[k_] = (0x0c0c0c0cu & ~(0xffu << (8 * (lane & 3)))) | ((unsigned)k_ << (8 * (lane & 3)));
    LAS unsigned char* wl = lds + wave * 12288;
    const LAS unsigned char* evp = wl + grp * 256;
    const LAS unsigned char* ccp = wl + 2048 + grp * 128;
    const int stride = nw * NWAVES * 8;
    int tb = (w * NWAVES + wave) * 8;
    v4u pe0 = {0u, 0u, 0u, 0u}, pe1 = {0u, 0u, 0u, 0u}, pc0 = {0u, 0u, 0u, 0u};
    if (tb < T) { const GAS v4u* e = (const GAS v4u*)(EXP16 + (size_t)tb * 128) + lane; pe0 = e[0]; pe1 = e[64]; pc0 = ((const GAS v4u*)(CC8 + (size_t)tb * 128))[lane]; }
    const __amdgpu_buffer_rsrc_t vrs = __builtin_amdgcn_make_buffer_rsrc((void*)V4, (short)0, 4 * NEXP * 128, 0x00020000); const unsigned vc = (unsigned)j * (NEXP * 128u) + 16u * sub;
    for (; tb < T; tb += stride) {
        *(LAS v4u*)(wl + 16 * lane) = pe0; *(LAS v4u*)(wl + 1024 + 16 * lane) = pe1; *(LAS v4u*)(wl + 2048 + 16 * lane) = pc0;
        if (tb + stride < T) { const GAS v4u* e = (const GAS v4u*)(EXP16 + (size_t)(tb + stride) * 128) + lane; pe0 = e[0]; pe1 = e[64]; pc0 = ((const GAS v4u*)(CC8 + (size_t)(tb + stride) * 128))[lane]; }
        const int t = tb + grp;
        const float scc = SCC[2 * t], csum8 = 8.0f * SCC[2 * t + 1];
        const size_t eo = (size_t)t * D + 256 * j + 32 * sub;
        const GAS v4u* dp = (const GAS v4u*)(X1B + eo);
        const v4u d0 = dp[0], d1 = dp[1], d2 = dp[2], d3 = dp[3];
        v4i_t accf[4], accl[4];
#pragma unroll
        for (int w_ = 0; w_ < 4; ++w_) { accf[w_] = (v4i_t){0, 0, 0, 0}; accl[w_] = (v4i_t){0, 0, 0, 0}; }
        LDS_WAIT();
        v4u rq[4][4];
#define PEER_LOADQ(r, qn) do { const unsigned long long _e4 = *(const LAS unsigned long long*)(evp + 8 * (qn)); const unsigned _lo = (unsigned)_e4, _hi = (unsigned)(_e4 >> 32); \
            r[0] = PEER_BL(vrs, _lo & 0xffffu, vc); r[1] = PEER_BL(vrs, _lo >> 16, vc); r[2] = PEER_BL(vrs, _hi & 0xffffu, vc); r[3] = PEER_BL(vrs, _hi >> 16, vc); } while (0)
#define PEER_COMPQ(r, qn) do { const unsigned _c = *(const LAS unsigned*)(ccp + 4 * (qn)); \
            _Pragma("unroll") for (int k_ = 0; k_ < 4; ++k_) { const int cd_ = (int)__builtin_amdgcn_perm(0u, _c, csel[k_]); \
                _Pragma("unroll") for (int w_ = 0; w_ < 4; ++w_) { const unsigned x_ = r[k_][w_]; \
                    accf[w_] = __builtin_amdgcn_mfma_i32_4x4x4i8(cd_, (int)x_, accf[w_], 0, 0, 0); \
                    accl[w_] = __builtin_amdgcn_mfma_i32_4x4x4i8(cd_, (int)(x_ & 0x0f0f0f0fu), accl[w_], 0, 0, 0); } } } while (0)
#pragma unroll
        for (int jq = 0; jq < 4; ++jq) PEER_LOADQ(rq[jq], jq);
#pragma unroll 1
        for (int it = 0; it < 8; ++it) {
#pragma unroll
            for (int jq = 0; jq < 4; ++jq) { PEER_COMPQ(rq[jq], 4 * it + jq); if (it < 7) PEER_LOADQ(rq[jq], 4 * it + 4 + jq); }
        }
        const unsigned dw[16] = {d0.x, d0.y, d0.z, d0.w, d1.x, d1.y, d1.z, d1.w, d2.x, d2.y, d2.z, d2.w, d3.x, d3.y, d3.z, d3.w};
#pragma unroll
        for (int m_ = 0; m_ < 8; ++m_) { const int w_ = m_ >> 1; f32x4 v; float a0_, a1_, a2_, a3_;
            if ((m_ & 1) == 0) { a0_ = (float)accl[w_][0] - csum8; a1_ = (float)accl[w_][1] - csum8; a2_ = (float)accl[w_][2] - csum8; a3_ = (float)accl[w_][3] - csum8; }
            else { a0_ = (float)((accf[w_][0] - accl[w_][0]) >> 4); a1_ = (float)((accf[w_][1] - accl[w_][1]) >> 4); a2_ = (float)((accf[w_][2] - accl[w_][2]) >> 4); a3_ = (float)((accf[w_][3] - accl[w_][3]) >> 4); }
            v.x = bf_lo(dw[2 * m_]) + scc * a0_; v.y = bf_hi(dw[2 * m_]) + scc * a1_; v.z = bf_lo(dw[2 * m_ + 1]) + scc * a2_; v.w = bf_hi(dw[2 * m_ + 1]) + scc * a3_;
            *(LAS f32x4*)(wl + 4096 + grp * 1024 + sub * 128 + 16 * m_) = v; }
        LDS_WAIT();
#pragma unroll
        for (int qq = 0; qq < 8; ++qq) { const f32x4 v = *(const LAS f32x4*)(wl + 4096 + qq * 1024 + 16 * lane);
            *(GAS f32x4*)(OUT + (size_t)(tb + qq) * D + 256 * j + 4 * lane) = v; }
    }
}
struct Args { const float* in[15]; float* out; unsigned char* ws; int ph_lo, ph_hi, li, pad; };
__global__ void __launch_bounds__(NWAVES * 64, 2) fwd_kernel(Args args) {
    extern __shared__ __attribute__((aligned(16))) unsigned char lds_raw[];
    LAS unsigned char* lds = (LAS unsigned char*)lds_raw;
    volatile LAS unsigned* MISC = (volatile LAS unsigned*)(lds + MISC_OFF);
    const int tid = threadIdx.x, lane = tid & 63, wave = __builtin_amdgcn_readfirstlane(tid >> 6);
    const int G = gridDim.x, bx = blockIdx.x;
    unsigned char* ws = args.ws;
    gu32* ctl = (gu32*)(ws + WS_CTL);
    for (int u = tid; u < (LDS_BYTES - LDSCTL_OFF) / 4; u += NWAVES * 64) ((LAS unsigned*)(lds + LDSCTL_OFF))[u] = 0u;
    __syncthreads();
    XcdBarrier bar; bar.bar = (unsigned*)(ctl + CW_BAR); bar.x = 0; bar.st = nullptr;
    if (N_LAUNCHES != PER_PHASE) bar = xcd_barrier_post((unsigned*)(ctl + CW_BAR) + args.li * XCD_BAR_WORDS, MISC + 8);
#define GRID_BAR() do { if (N_LAUNCHES != PER_PHASE) xcd_barrier(bar); } while (0)
    const int lo = args.ph_lo, hi = args.ph_hi;
#define IN(k) (lo <= (k) && (k) < hi)
#define BOTH(k) (IN(k) && IN((k) + 1))
#ifndef MK_REPEAT
#define MK_REPEAT -1
#endif
#define REP(k) for (int _r = 0; _r < ((MK_REPEAT == (k)) ? 2 : 1); ++_r)

    const float* x = args.in[0]; float* out = args.out;
    bf16* XB = (bf16*)(ws + WS_XB); bf16* WinT = (bf16*)(ws + WS_WIN); bf16* WoutT = (bf16*)(ws + WS_WOUT); bf16* WqT = (bf16*)(ws + WS_WQ);
    bf16* SK = (bf16*)(ws + WS_SK); bf16* PoolT = (bf16*)(ws + WS_POOLT); unsigned char* U8 = ws + WS_U8; unsigned char* V8 = ws + WS_V8; float* SU = (float*)(ws + WS_SU); float* SV = (float*)(ws + WS_SV);
    bf16* Y = (bf16*)(ws + WS_Y); bf16* AB = (bf16*)(ws + WS_AB); bf16* X1B = (bf16*)(ws + WS_X1B); bf16* QP = (bf16*)(ws + WS_QP);
    float* rstd1 = (float*)(ws + WS_RSTD1); float* SS2 = (float*)(ws + WS_SS2); unsigned short* EXPERTS = (unsigned short*)(ws + WS_EXP); float* BEST = (float*)(ws + WS_BEST);
    float* PD = (float*)(ws + WS_PD); bf16* DELTA = (bf16*)(ws + WS_DELTA); unsigned char* CC8 = ws + WS_CC; float* SCC = (float*)(ws + WS_SCC);
    const int gw = bx * NWAVES + wave, NGW = G * NWAVES;

    const P0Args p0a{x, args.in[1], args.in[2], args.in[7], args.in[9], args.in[10], args.in[11], args.in[12], args.in[13], args.in[14], XB, WinT, WoutT, WqT, SK, PoolT, U8, V8, SU, SV, rstd1};
    if (IN(0)) REP(0) {
        p0_prologue(p0a, lds, gw, NGW, wave, lane);
        if (BOTH(0)) GRID_BAR();
    }
    if (IN(1)) REP(1) {
        pg8::Gemm g{XB, WinT, T, DIN, D}; pg8::StaticOrder S; S.init(T, DIN, G, bx);
        pg8::EpiScaleBf16 E{Y, DIN, rstd1};
        pg8::gemm_phase<pg8::EpiScaleBf16, pg8::StaticOrder, true, true>(lds + RING_OFF, g, S, E);
        { const int nwg1 = (T / 256) * (DIN / 256), rem = nwg1 % G;
          if (rem == 0) p1_late_weights(p0a, lds, gw, NGW, wave, lane); else if (bx >= rem) p1_late_weights(p0a, lds, (bx - rem) * NWAVES + wave, (G - rem) * NWAVES, wave, lane); }
        if (BOTH(1)) GRID_BAR();
    }
    if (IN(2)) REP(2) {
        for (int u = bx; u < NB * 128 * 2; u += G) attn_unit(lds, Y, AB, args.in[3], args.in[4], args.in[5], args.in[6], u, tid, wave, lane);
        for (int u = bx; u < T / 128; u += G) pool_rows(Y, AB, args.in[8], u, tid);
        if (BOTH(2)) GRID_BAR();
    }
    if (IN(3)) REP(3) {
        pg8::Gemm g{AB, WoutT, T, D, D}; pg8::StaticOrder S; S.init(T, D, G, bx);
        pg8::EpiResid E{XB, X1B, SS2, D};
        pg8::gemm_phase<pg8::EpiResid, pg8::StaticOrder, true, true>(lds + RING_OFF, g, S, E);
        if (BOTH(3)) GRID_BAR();
    }
    if (IN(4)) REP(4) {
        pg8::Gemm g{X1B, WqT, T, DQ, D}; pg8::StaticOrder S; S.init(T, DQ, G, bx);
        pg8::EpiScaleBf16 E{QP, DQ, nullptr};
        pg8::gemm_phase<pg8::EpiScaleBf16, pg8::StaticOrder, true, true>(lds + RING_OFF, g, S, E);
        if (BOTH(4)) GRID_BAR();
    }
    if (IN(5)) REP(5) {
        { int hs = -1; for (int u = bx; u < (T / 256) * 8; u += G) { if ((u & 7) != hs) { if (hs >= 0) __syncthreads(); hs = u & 7; topk_stage_keys(lds, SK, hs, tid); } topk_unit(lds, QP, SK, EXPERTS, BEST, u, tid, wave, lane); } }
        if (BOTH(5)) GRID_BAR();
    }
    if (IN(6)) REP(6) {
        if ((G & 7) == 0) peer_u_phase(lds, X1B, U8, EXPERTS, PD, bx & 7, bx >> 3, G >> 3, wave, lane);
        else for (int j = 0; j < 8; ++j) peer_u_phase(lds, X1B, U8, EXPERTS, PD, j, bx, G, wave, lane);
        if (BOTH(6)) GRID_BAR();
    }
    if (IN(7)) REP(7) {
        peer_stage_scales(lds, SU, SV, tid);
        for (int t0 = gw * 4; t0 < T; t0 += NGW * 4) peer_combine4(lds, PD, EXPERTS, BEST, SS2, CC8, SCC, t0, lane);
        if (BOTH(7)) GRID_BAR();
    }
    if (IN(8)) {
        if ((G & 7) == 0) peer_v_phase(lds, out, X1B, V8, EXPERTS, CC8, SCC, bx & 3, bx >> 2, G >> 2, wave, lane);
        else for (int j = 0; j < 4; ++j) peer_v_phase(lds, out, X1B, V8, EXPERTS, CC8, SCC, j, bx, G, wave, lane);
    }
#undef IN
#undef BOTH
}

extern "C" void kernel_launch(void* const* d_in, const int* in_sizes, int n_in, void* d_out, int out_size, void* d_ws, size_t ws_size, hipStream_t stream) {
    static int grid = 0;
    if (grid == 0) {
        if (n_in != 15 || in_sizes[0] != T * D || out_size != T * D || ws_size < WS_END) { fprintf(stderr, "kernel_launch: unexpected shapes (n_in %d, in0 %d, out %d, ws %zu)\n", n_in, n_in > 0 ? in_sizes[0] : -1, out_size, ws_size); grid = -1; return; }
        int dev = 0, cus = 0, per_cu = 0;
        if (hipGetDevice(&dev) != hipSuccess || hipDeviceGetAttribute(&cus, hipDeviceAttributeMultiprocessorCount, dev) != hipSuccess) { grid = -1; return; }
        if (hipFuncSetAttribute((const void*)fwd_kernel, hipFuncAttributeMaxDynamicSharedMemorySize, LDS_BYTES) != hipSuccess) { fprintf(stderr, "kernel_launch: hipFuncSetAttribute failed\n"); grid = -1; return; }
        if (hipOccupancyMaxActiveBlocksPerMultiprocessor(&per_cu, (const void*)fwd_kernel, NWAVES * 64, LDS_BYTES) != hipSuccess || per_cu < 1) { fprintf(stderr, "kernel_launch: occupancy query reports %d blocks per CU\n", per_cu); }
        (void)hipGetLastError();
        grid = cus;
    }
    if (grid < 0) return;
    if (hipMemsetAsync((char*)d_ws + WS_CTL, 0, CTL_ZERO_BYTES, stream) != hipSuccess) return;
    Args a{};
    for (int i = 0; i < 15; ++i) a.in[i] = (const float*)d_in[i];
    a.out = (float*)d_out; a.ws = (unsigned char*)d_ws;
    for (int li = 0; li < N_LAUNCHES; ++li) {
        a.ph_lo = (N_LAUNCHES == PER_PHASE) ? li : 0; a.ph_hi = (N_LAUNCHES == PER_PHASE) ? li + 1 : PER_PHASE; a.li = (N_LAUNCHES == PER_PHASE) ? 0 : li;
        hipLaunchKernelGGL(fwd_kernel, dim3(grid), dim3(NWAVES * 64), LDS_BYTES, stream, a);
        const hipError_t le = hipPeekAtLastError();
        if (le != hipSuccess) { fprintf(stderr, "kernel_launch: launch %d failed: %s\n", li, hipGetErrorName(le)); break; }
    }
}
```
